# Optimizing an MI355X kernel written in HIP

```python
import jax, jax.numpy as jnp
from jax import lax
import numpy as np

D_MODEL = 1024
BATCH = 16
SEQ = 2048
DEPTH = 4

GRID_W = 64
CTX_LEN = 256
N_MIXERS = 2
N_A_LAYERS = (DEPTH + N_MIXERS - 1) // N_MIXERS
N_B_LAYERS = DEPTH // N_MIXERS
DN_ALPHA = (2.0 * DEPTH) ** 0.25
DN_BETA = (8.0 * DEPTH) ** -0.25
LN_EPS = 1e-5
CHUNK = 128
ROWS_PER_CHUNK = CHUNK // GRID_W
A_WIDTH = D_MODEL
A_HEADS = 8
A_GROUP = A_WIDTH // A_HEADS
GLA_HEADS = 4
GLA_DK = D_MODEL // 2 // GLA_HEADS
GLA_DV = D_MODEL // GLA_HEADS
GLA_QK = GLA_HEADS * GLA_DK
GLA_V = GLA_HEADS * GLA_DV
GLA_GATE_RANK = 16
GLA_TAU = 16.0
GLA_CHUNK = 64
GLA_IN = 2 * GLA_QK + 2 * GLA_V + 2 * GLA_GATE_RANK
PEER_HEADS = 8
PEER_NKEYS = 128
PEER_EXPERTS = PEER_NKEYS * PEER_NKEYS
PEER_QDIM = 128
PEER_HALF = PEER_QDIM // 2
PEER_TOPK = 16
PEER_BLOCK = 128

kernel_name = "hybrid_chunkmlp_gla_peer_prefix_dit"


def layer_norm(x, g, b):
    xf = x.astype(jnp.float32)
    mu = jnp.mean(xf, axis=-1, keepdims=True)
    var = jnp.mean(jnp.square(xf - mu), axis=-1, keepdims=True)
    y = (xf - mu) * lax.rsqrt(var + LN_EPS)
    return (y * g + b).astype(x.dtype)


def chunk_mlp(h, n_chunks, w_in, norm_g, norm_b, w_s, b_s, w_out):
    bsz, t, _ = h.shape
    z = jax.nn.gelu(h @ w_in)
    u, v = jnp.split(z, 2, axis=-1)
    v = layer_norm(v, norm_g, norm_b)
    vb = v.reshape(bsz, n_chunks, CHUNK, A_HEADS, A_GROUP)
    s = jnp.einsum('hpq,bnqhc->bnphc', w_s, vb) + b_s.T[None, None, :, :, None]
    return (u * s.reshape(bsz, t, A_WIDTH)) @ w_out


def gla_chunked(q, k, v, g, s0):
    bsz, t, h, dk = q.shape
    dv = v.shape[-1]
    n = t // GLA_CHUNK
    f32 = jnp.float32
    q = q.astype(f32).reshape(bsz, n, GLA_CHUNK, h, dk)
    k = k.astype(f32).reshape(bsz, n, GLA_CHUNK, h, dk)
    v = v.astype(f32).reshape(bsz, n, GLA_CHUNK, h, dv)
    b = jnp.cumsum(g.astype(f32).reshape(bsz, n, GLA_CHUNK, h, dk), axis=2)
    b_end = b[:, :, -1:]
    q_in = q * jnp.exp(b)
    k_in = k * jnp.exp(-b)
    k_end = k * jnp.exp(b_end - b)
    att = jnp.einsum('bnihd,bnjhd->bnhij', q_in, k_in)
    mask = jnp.tril(jnp.ones((GLA_CHUNK, GLA_CHUNK), dtype=bool))
    att = jnp.where(mask, att, 0.0)
    o_intra = jnp.einsum('bnhij,bnjhe->bnihe', att, v)

    def step(state, inp):
        qc, kc, vc, dc = inp
        o = jnp.einsum('bihd,bhde->bihe', qc, state)
        state = dc[..., None] * state + jnp.einsum('bjhd,bjhe->bhde', kc, vc)
        return state, o

    xs = (jnp.moveaxis(q_in, 1, 0), jnp.moveaxis(k_end, 1, 0), jnp.moveaxis(v, 1, 0),
          jnp.moveaxis(jnp.exp(b_end[:, :, 0]), 1, 0))
    s_fin, o_inter = lax.scan(step, s0.astype(f32), xs)
    o = o_intra + jnp.moveaxis(o_inter, 0, 1)
    return o.reshape(bsz, t, h, dv), s_fin


def gla_reverse(q, k, v, g, s0):
    o, s_fin = gla_chunked(jnp.flip(q, 1), jnp.flip(k, 1), jnp.flip(v, 1), jnp.flip(g, 1), s0)
    return jnp.flip(o, 1), s_fin


def gla_project(h, w_in, w_gate, gate_bias):
    bsz, t, _ = h.shape
    z = h @ w_in
    q, k, v, r, gl = jnp.split(z, [GLA_QK, 2 * GLA_QK, 2 * GLA_QK + GLA_V, 2 * GLA_QK + 2 * GLA_V], axis=-1)
    q = q.reshape(bsz, t, GLA_HEADS, GLA_DK) * (GLA_DK ** -0.5)
    k = k.reshape(bsz, t, GLA_HEADS, GLA_DK)
    v = v.reshape(bsz, t, GLA_HEADS, GLA_DV)
    gl = gl.reshape(bsz, t, 2, GLA_GATE_RANK)
    zg = (jnp.einsum('btjr,jrd->btjd', gl, w_gate) + gate_bias).astype(jnp.float32)
    glog = (jax.nn.log_sigmoid(zg) / GLA_TAU).reshape(bsz, t, 2, GLA_HEADS, GLA_DK)
    return q, k, v, r, glog


def gla_readout(o, r, gn_g, w_out):
    bsz, t = o.shape[:2]
    mu = jnp.mean(o, axis=-1, keepdims=True)
    var = jnp.mean(jnp.square(o - mu), axis=-1, keepdims=True)
    y = ((o - mu) * lax.rsqrt(var + LN_EPS)).reshape(bsz, t, GLA_V) * gn_g
    return (y.astype(r.dtype) * jax.nn.silu(r)) @ w_out


def gla_mixer(h_lat, h_ctx, w_in, w_gate, gate_bias, gn_g, w_out, need_ctx_out):
    qc, kc, vc, rc, gc = gla_project(h_ctx, w_in, w_gate, gate_bias)
    ql, kl, vl, rl, gll = gla_project(h_lat, w_in, w_gate, gate_bias)
    s0 = jnp.zeros((h_ctx.shape[0], GLA_HEADS, GLA_DK, GLA_DV), jnp.float32)
    o_cf, s_f = gla_chunked(qc, kc, vc, gc[:, :, 0], s0)
    o_cb, s_b = gla_reverse(qc, kc, vc, gc[:, :, 1], s0)
    o_lf, _ = gla_chunked(ql, kl, vl, gll[:, :, 0], s_f)
    o_lb, _ = gla_reverse(ql, kl, vl, gll[:, :, 1], s_b)
    out_lat = gla_readout(o_lf + o_lb, rl, gn_g, w_out)
    out_ctx = gla_readout(o_cf + o_cb, rc, gn_g, w_out) if need_ctx_out else None
    return out_lat, out_ctx


def peer_ffn(h, w_q, sub_keys, u_tab, v_tab):
    bsz, t, d = h.shape
    blocks = h.reshape(-1, PEER_BLOCK, d)

    def one_block(xb):
        q = (xb @ w_q).reshape(PEER_BLOCK, PEER_HEADS, 2, PEER_HALF)
        s = jnp.einsum('thpd,pkd->thpk', q, sub_keys).astype(jnp.float32)
        s1, i1 = lax.top_k(s[:, :, 0], PEER_TOPK)
        s2, i2 = lax.top_k(s[:, :, 1], PEER_TOPK)
        cand_s = (s1[..., :, None] + s2[..., None, :]).reshape(PEER_BLOCK, PEER_HEADS, PEER_TOPK * PEER_TOPK)
        cand_i = (i1[..., :, None] * PEER_NKEYS + i2[..., None, :]).reshape(PEER_BLOCK, PEER_HEADS, PEER_TOPK * PEER_TOPK)
        top_s, pos = lax.top_k(cand_s, PEER_TOPK)
        idx = jnp.take_along_axis(cand_i, pos, axis=-1)
        wts = jax.nn.softmax(top_s, axis=-1).astype(xb.dtype)
        act = jax.nn.gelu(jnp.einsum('thkd,td->thk', u_tab[idx], xb)) * wts
        return jnp.einsum('thk,thkd->td', act, v_tab[idx])

    return lax.map(one_block, blocks).reshape(bsz, t, d)


def setup_inputs(seed: int = 0) -> dict:
    key = jax.random.key(seed)
    ks = jax.random.split(key, 24)
    f32 = jnp.float32

    def nrm(k, shape, s):
        return jax.random.normal(k, shape, f32) * s

    d = D_MODEL
    return {
        "x": nrm(ks[0], (BATCH, SEQ, d), 1.0),
        "c": nrm(ks[1], (BATCH, d), 1.0),
        "ctx": nrm(ks[2], (BATCH, CTX_LEN, d), 1.0),
        "c_ctx": nrm(ks[3], (d,), 1.0),
        "w_mod": nrm(ks[4], (DEPTH, d, 6 * d), 0.5 * d ** -0.5),
        "b_mod": nrm(ks[5], (DEPTH, 6 * d), 0.01),
        "ln_g": 1.0 + nrm(ks[6], (DEPTH, 2, d), 0.01),
        "ln_b": nrm(ks[7], (DEPTH, 2, d), 0.01),
        "a_w_in": nrm(ks[8], (N_A_LAYERS, d, 2 * A_WIDTH), d ** -0.5),
        "a_norm_g": 1.0 + nrm(ks[9], (N_A_LAYERS, A_WIDTH), 0.01),
        "a_norm_b": nrm(ks[10], (N_A_LAYERS, A_WIDTH), 0.01),
        "a_w_s": nrm(ks[11], (N_A_LAYERS, A_HEADS, CHUNK, CHUNK), CHUNK ** -0.5),
        "a_b_s": 1.0 + nrm(ks[12], (N_A_LAYERS, A_HEADS, CHUNK), 0.01),
        "a_w_out": nrm(ks[13], (N_A_LAYERS, A_WIDTH, d), DN_BETA * A_WIDTH ** -0.5),
        "b_w_in": nrm(ks[14], (N_B_LAYERS, d, GLA_IN), d ** -0.5),
        "b_w_gate": nrm(ks[15], (N_B_LAYERS, 2, GLA_GATE_RANK, GLA_QK), GLA_GATE_RANK ** -0.5),
        "b_gate_bias": nrm(ks[16], (N_B_LAYERS, 2, GLA_QK), 0.01),
        "b_gn_g": 1.0 + nrm(ks[17], (N_B_LAYERS, GLA_V), 0.01),
        "b_w_out": nrm(ks[18], (N_B_LAYERS, GLA_V, d), DN_BETA * GLA_V ** -0.5),
        "p_w_q": nrm(ks[19], (DEPTH, d, PEER_HEADS * PEER_QDIM), d ** -0.5),
        "p_keys": nrm(ks[20], (DEPTH, 2, PEER_NKEYS, PEER_HALF), PEER_HALF ** -0.5),
        "p_u": nrm(ks[21], (DEPTH, PEER_EXPERTS, d), d ** -0.5),
        "p_v": nrm(ks[22], (DEPTH, PEER_EXPERTS, d), DN_BETA),
    }


def reference(x, c, ctx, c_ctx, w_mod, b_mod, ln_g, ln_b,
              a_w_in, a_norm_g, a_norm_b, a_w_s, a_b_s, a_w_out,
              b_w_in, b_w_gate, b_gate_bias, b_gn_g, b_w_out,
              p_w_q, p_keys, p_u, p_v):
    bsz, seq, d = x.shape
    rows = seq // GRID_W
    lat_chunks = rows // ROWS_PER_CHUNK
    ctx_chunks = ctx.shape[1] // CHUNK
    sc = jax.nn.silu(c)
    sc_ctx = jax.nn.silu(c_ctx)
    for i in range(DEPTH):
        last = i == DEPTH - 1
        m = (sc @ w_mod[i] + b_mod[i]).reshape(bsz, 6, d)
        mc = (sc_ctx @ w_mod[i] + b_mod[i]).reshape(6, d)
        sh1, s1, g1, sh2, s2, g2 = [m[:, j, None, :] for j in range(6)]
        sh1c, s1c, g1c, sh2c, s2c, g2c = [mc[j] for j in range(6)]
        h_lat = x * (1.0 + s1) + sh1
        if i % N_MIXERS == 0:
            j = i // N_MIXERS
            prm = (a_w_in[j], a_norm_g[j], a_norm_b[j], a_w_s[j], a_b_s[j], a_w_out[j])
            mix_lat = chunk_mlp(h_lat, lat_chunks, *prm)
            mix_ctx = None if last else chunk_mlp(ctx * (1.0 + s1c) + sh1c, ctx_chunks, *prm)
        else:
            j = i // N_MIXERS
            h_ctx = ctx * (1.0 + s1c) + sh1c
            mix_lat, mix_ctx = gla_mixer(h_lat, h_ctx, b_w_in[j], b_w_gate[j], b_gate_bias[j],
                                         b_gn_g[j], b_w_out[j], not last)
        x = layer_norm(DN_ALPHA * x + g1 * mix_lat, ln_g[i, 0], ln_b[i, 0])
        ffn_lat = peer_ffn(x * (1.0 + s2) + sh2, p_w_q[i], p_keys[i], p_u[i], p_v[i])
        x = layer_norm(DN_ALPHA * x + g2 * ffn_lat, ln_g[i, 1], ln_b[i, 1])
        if not last:
            ctx = layer_norm(DN_ALPHA * ctx + g1c * mix_ctx, ln_g[i, 0], ln_b[i, 0])
            ffn_ctx = peer_ffn(ctx * (1.0 + s2c) + sh2c, p_w_q[i], p_keys[i], p_u[i], p_v[i])
            ctx = layer_norm(DN_ALPHA * ctx + g2c * ffn_ctx, ln_g[i, 1], ln_b[i, 1])
    return x
```

```cpp
#include <hip/hip_runtime.h>
#include <hip/hip_cooperative_groups.h>
#include <cstdio>
#include <cstdint>
namespace cg = cooperative_groups;

#define LAS __attribute__((address_space(3)))
#define DI __device__ __forceinline__
typedef unsigned short bf16_t;
typedef short bf16x8 __attribute__((ext_vector_type(8)));
typedef float f32x4 __attribute__((ext_vector_type(4)));
typedef float f32x2 __attribute__((ext_vector_type(2)));
typedef unsigned u32x4 __attribute__((ext_vector_type(4)));
typedef unsigned u32x2 __attribute__((ext_vector_type(2)));
typedef __bf16 bf16v2 __attribute__((ext_vector_type(2)));

constexpr int D = 1024, NB = 16, SEQ = 2048, CTXL = 256, DEPTH = 4;
constexpr int TL = NB * SEQ, TC = NB * CTXL, T = TL + TC;
constexpr int NEXP = 16384;
constexpr float LN_EPS = 1e-5f;
constexpr float DN_ALPHA = 1.6817928305074290f;
constexpr int NTHR = 512, NWAVE = 8;
constexpr int LDS_BYTES = 140 * 1024;
constexpr int WBIN_N = 3328;

constexpr size_t al256(size_t x) { return (x + 255) & ~(size_t)255; }
constexpr size_t WS_CTL = 0;
constexpr size_t WS_MOD = 65536;
constexpr size_t WS_STATS = al256(WS_MOD + (size_t)4 * 17 * 6144 * 4);
constexpr size_t WS_GL = al256(WS_STATS + (size_t)T * 2 * 4);
constexpr size_t WS_DEC = al256(WS_GL + (size_t)T * 32 * 4);
constexpr size_t WS_WSB = al256(WS_DEC + (size_t)2 * 576 * 512 * 4);
constexpr size_t WS_WAIN = al256(WS_WSB + (size_t)2 * 8 * 128 * 128 * 2);
constexpr size_t WS_WAOUT = WS_WAIN + (size_t)2 * 2048 * 1024 * 2;
constexpr size_t WS_WBIN = WS_WAOUT + (size_t)2 * 1024 * 1024 * 2;
constexpr size_t WS_WBOUT = WS_WBIN + (size_t)2 * WBIN_N * 1024 * 2;
constexpr size_t WS_WQ = WS_WBOUT + (size_t)2 * 1024 * 1024 * 2;
constexpr size_t WS_UT = WS_WQ + (size_t)4 * 1024 * 1024 * 2;
constexpr size_t WS_VT = WS_UT + (size_t)4 * NEXP * 1024 * 2;
constexpr size_t WS_XS = WS_VT + (size_t)4 * NEXP * 1024 * 2;
constexpr size_t WS_R1 = WS_XS + (size_t)T * 1024 * 4;
constexpr size_t WS_R2 = WS_R1 + (size_t)T * 3072 * 2;
constexpr size_t WS_H1 = WS_R2 + (size_t)T * 3072 * 2;
constexpr size_t WS_END = WS_H1 + (size_t)T * 1024 * 2;
constexpr size_t SZ_T1K = (size_t)T * 1024 * 2;
constexpr size_t SZ_T512 = (size_t)T * 512 * 2;

struct Params { const float* in[23]; float* out; unsigned char* ws; int ph_lo, ph_hi; };

DI unsigned pk_bf16(float lo, float hi) { f32x2 v = {lo, hi}; return __builtin_bit_cast(unsigned, __builtin_convertvector(v, bf16v2)); }
DI float bf_lo(unsigned w) { return __uint_as_float(w << 16); }
DI float bf_hi(unsigned w) { return __uint_as_float(w & 0xffff0000u); }
DI float bf1(bf16_t b) { return __uint_as_float(((unsigned)b) << 16); }
DI bf16_t f2bf(float f) { return (bf16_t)(pk_bf16(f, 0.f) & 0xffffu); }
DI float gelu_tanh(float x) { const float u = 0.7978845608028654f * (x + 0.044715f * x * x * x); return __fdividef(x, 1.0f + __expf(-2.0f * u)); }
DI float silu_f(float x) { return __fdividef(x, 1.0f + __expf(-x)); }
DI float logsig_f(float z) { return fminf(z, 0.f) - log1pf(expf(-fabsf(z))); }
DI float wave_sum(float v) {
#pragma unroll
    for (int o = 32; o > 0; o >>= 1) v += __shfl_xor(v, o, 64);
    return v;
}
DI float dot2bf(unsigned a, unsigned b, float c) { return __builtin_amdgcn_fdot2_f32_bf16(__builtin_bit_cast(bf16v2, a), __builtin_bit_cast(bf16v2, b), c, false); }
DI f32x4 mfma16(bf16x8 a, bf16x8 b, f32x4 c) { return __builtin_amdgcn_mfma_f32_16x16x32_bf16(a, b, c, 0, 0, 0); }
DI bf16x8 frag_ld(const bf16_t* X, int ld, int row0, int k0, int lane) { return *(const bf16x8*)(X + (size_t)(row0 + (lane & 15)) * ld + k0 + 8 * (lane >> 4)); }
DI int mod_batch(int row) { return row < TL ? (row >> 11) : NB; }

DI void grid_barrier(unsigned* ctr, unsigned& target) {
    asm volatile("s_waitcnt vmcnt(0)" ::: "memory");
    __syncthreads();
    target += gridDim.x;
    if (threadIdx.x == 0) {
        __builtin_amdgcn_fence(__ATOMIC_RELEASE, "agent");
        asm volatile("s_waitcnt vmcnt(0)" ::: "memory");
        __hip_atomic_fetch_add(ctr, 1u, __ATOMIC_RELAXED, __HIP_MEMORY_SCOPE_AGENT);
        while (__hip_atomic_load(ctr, __ATOMIC_RELAXED, __HIP_MEMORY_SCOPE_AGENT) < target) __builtin_amdgcn_s_sleep(2);
        __builtin_amdgcn_fence(__ATOMIC_ACQUIRE, "agent");
        asm volatile("s_waitcnt vmcnt(0)" ::: "memory");
    }
    __syncthreads();
}

namespace pg8 {
constexpr int BM = 256, BK = 64, HALF = 128, HTB = HALF * BK * 2, STAGE_BYTES = 8 * HTB, NXCD = 8, WGM = 8;
__host__ __device__ __forceinline__ int lds_byte(int r, int c) { const int st = (r >> 4) * 2 + (c >> 5), rr = r & 15, cc = c & 31, ob = rr * 64 + cc * 2; return st * 1024 + (ob ^ (((ob >> 9) & 1) << 5)); }
__host__ __device__ __forceinline__ void stage_rc(int b, int& R, int& C) { const int st = b / 1024, sb = b % 1024, swz = sb ^ (((sb >> 9) & 1) << 5); R = (st >> 1) * 16 + swz / 64; C = (st & 1) * 32 + (swz % 64) / 2; }
__host__ __device__ __forceinline__ int perm32(int rho) { const int n = rho >> 4, i = rho & 15; return 8 * (i >> 2) + 4 * n + (i & 3); }
struct Unit { int pm, pn; };
struct Gemm { const bf16_t* A; const bf16_t* Bt; int M, N, K; };
struct StaticOrder {
    int nM, nN, nwg, G, c;
    __device__ void init(int M, int N, int G_, int c_) { nM = M / BM; nN = N / BM; nwg = nM * nN; G = G_; c = c_; }
    __device__ bool next(int i, Unit& u) const {
        const long L = (long)i * G + c; if (L >= nwg) return false;
        int wgid = (int)L; { const int q = nwg / NXCD, r = nwg % NXCD, xcd = wgid % NXCD, off = wgid / NXCD; wgid = (xcd < r ? xcd * (q + 1) : r * (q + 1) + (xcd - r) * q) + off; }
        const int nig = WGM * nN, gid = wgid / nig, fm = gid * WGM, gsz = (nM - fm) < WGM ? (nM - fm) : WGM;
        u.pm = fm + ((wgid % nig) % gsz); u.pn = (wgid % nig) / gsz; return true;
    }
};

template <class Epi>
__device__ __forceinline__ void gemm_phase(LAS unsigned char* lds, const Gemm g, const StaticOrder& S, const Epi& E, const int tid) {
    const int wid = __builtin_amdgcn_readfirstlane(tid >> 6), lane = tid & 63, wr = wid >> 2, wc = wid & 3, fr = lane & 15, fq = lane >> 4;
    const int K = g.K, nt = K / BK;
    unsigned voffA[2], voffB[2];
#pragma unroll
    for (int i = 0; i < 2; ++i) { int R, C; stage_rc(tid * 16 + i * 8192, R, C); const int Rb = Epi::PERM ? ((R & ~31) + perm32(R & 31)) : R;
        voffA[i] = (unsigned)(R * K + C) * 2u; voffB[i] = (unsigned)(Rb * K + C) * 2u; }
    const size_t kstep = (size_t)(BK * 2);
    const size_t hstep = (size_t)HALF * K * 2;
    const size_t tstep = 2 * hstep;
    const unsigned ldsw = (unsigned)wid * 1024u;
    const int aoff = lds_byte(wr * 64 + fr, fq * 8), boff = lds_byte(wc * 32 + fr, fq * 8);
#define PG8_SA(b, h) (((b) * 2 + (h)) * HTB)
#define PG8_SB(b, h) ((4 + (b) * 2 + (h)) * HTB)
#define PG8_STAGE(bufoff, gbase, voff) do { _Pragma("unroll") for (int _i = 0; _i < 2; ++_i) \
        __builtin_amdgcn_global_load_lds((const unsigned*)((const char*)(gbase) + (voff)[_i]), (LAS unsigned*)(lds + (bufoff) + ldsw + _i * 8192), 16, 0, 0); } while (0)
#define PG8_LDA(dst, b, h) do { _Pragma("unroll") for (int m = 0; m < 4; ++m) _Pragma("unroll") for (int k = 0; k < 2; ++k) dst[m][k] = *(const LAS bf16x8*)(lds + PG8_SA(b, h) + aoff + m * 2048 + k * 1024); } while (0)
#define PG8_LDB(dst, b, h) do { _Pragma("unroll") for (int n = 0; n < 2; ++n) _Pragma("unroll") for (int k = 0; k < 2; ++k) dst[n][k] = *(const LAS bf16x8*)(lds + PG8_SB(b, h) + boff + n * 2048 + k * 1024); } while (0)
#define PG8_MMA(ai, bj, At, Bt) do { __builtin_amdgcn_s_setprio(1); _Pragma("unroll") for (int m = 0; m < 4; ++m) _Pragma("unroll") for (int n = 0; n < 2; ++n) _Pragma("unroll") for (int k = 0; k < 2; ++k) \
        acc[ai][bj][m][n] = __builtin_amdgcn_mfma_f32_16x16x32_bf16(Bt[n][k], At[m][k], acc[ai][bj][m][n], 0, 0, 0); __builtin_amdgcn_s_setprio(0); } while (0)
#define PG8_WAIT_V(n) asm volatile("s_waitcnt vmcnt(" #n ")" ::: "memory")
#define PG8_WAIT_L(n) asm volatile("s_waitcnt lgkmcnt(" #n ")" ::: "memory")
#define PG8_BAR __builtin_amdgcn_s_barrier()
#define PG8_SCHED __builtin_amdgcn_sched_barrier(0)
    Unit cur, nxt; int ui = 0;
    if (!S.next(0, cur)) return;
    f32x4 acc[2][2][4][2];
#pragma unroll
    for (int a = 0; a < 2; ++a)
#pragma unroll
        for (int b = 0; b < 2; ++b)
#pragma unroll
            for (int m = 0; m < 4; ++m)
#pragma unroll
                for (int n = 0; n < 2; ++n) acc[a][b][m][n] = (f32x4){0.f, 0.f, 0.f, 0.f};
    bf16x8 At[4][2], B0[2][2], B1[2][2];
    const char* cA = (const char*)g.A + (size_t)cur.pm * tstep; const char* cB = (const char*)g.Bt + (size_t)cur.pn * tstep;
    PG8_STAGE(PG8_SB(0, 0), cB, voffB); PG8_STAGE(PG8_SA(0, 0), cA, voffA); PG8_STAGE(PG8_SB(0, 1), cB + hstep, voffB); PG8_STAGE(PG8_SA(0, 1), cA + hstep, voffA);
    if (wr == 1) PG8_BAR;
    PG8_WAIT_V(4); PG8_BAR;
    PG8_STAGE(PG8_SB(1, 0), cB + kstep, voffB); PG8_STAGE(PG8_SA(1, 0), cA + kstep, voffA); PG8_STAGE(PG8_SB(1, 1), cB + hstep + kstep, voffB);
    PG8_WAIT_V(6); PG8_BAR;
    for (;;) {
        const bool has_next = S.next(ui + 1, nxt);
        const char* nA = has_next ? (const char*)g.A + (size_t)nxt.pm * tstep : cA; const char* nB = has_next ? (const char*)g.Bt + (size_t)nxt.pn * tstep : cB;
        for (int t = 0; t < nt; t += 2) {
            const bool last = (t == nt - 2);
            const char* a1 = cA + (size_t)(t + 1) * kstep;
            const char* a2 = last ? nA : cA + (size_t)(t + 2) * kstep; const char* b2 = last ? nB : cB + (size_t)(t + 2) * kstep;
            const char* a3 = a2 + kstep; const char* b3 = b2 + kstep;
            PG8_LDB(B0, 0, 0); PG8_SCHED; PG8_LDA(At, 0, 0); PG8_STAGE(PG8_SA(1, 1), a1 + hstep, voffA);
            PG8_WAIT_L(8); PG8_BAR; PG8_WAIT_L(0); PG8_MMA(0, 0, At, B0); PG8_BAR; PG8_SCHED;
            PG8_LDB(B1, 0, 1); PG8_STAGE(PG8_SB(0, 0), b2, voffB);
            PG8_BAR; PG8_WAIT_L(0); PG8_MMA(0, 1, At, B1); PG8_BAR;
            PG8_LDA(At, 0, 1); PG8_STAGE(PG8_SA(0, 0), a2, voffA);
            PG8_BAR; PG8_WAIT_L(0); PG8_MMA(1, 0, At, B0); PG8_BAR; PG8_SCHED;
            PG8_STAGE(PG8_SB(0, 1), b2 + hstep, voffB);
            PG8_WAIT_V(6); PG8_BAR; PG8_MMA(1, 1, At, B1); PG8_BAR;
            PG8_LDB(B0, 1, 0); PG8_SCHED; PG8_LDA(At, 1, 0); PG8_STAGE(PG8_SA(0, 1), a2 + hstep, voffA);
            PG8_WAIT_L(8); PG8_BAR; PG8_WAIT_L(0); PG8_MMA(0, 0, At, B0); PG8_BAR; PG8_SCHED;
            PG8_LDB(B1, 1, 1); PG8_STAGE(PG8_SB(1, 0), b3, voffB);
            PG8_BAR; PG8_WAIT_L(0); PG8_MMA(0, 1, At, B1); PG8_BAR;
            PG8_LDA(At, 1, 1); PG8_STAGE(PG8_SA(1, 0), a3, voffA);
            PG8_BAR; PG8_WAIT_L(0); PG8_MMA(1, 0, At, B0); PG8_BAR; PG8_SCHED;
            PG8_STAGE(PG8_SB(1, 1), b3 + hstep, voffB);
            PG8_WAIT_V(6); PG8_BAR; PG8_MMA(1, 1, At, B1); PG8_BAR;
        }
        E(acc, cur, wr, wc, fr, fq);
        if (!has_next) break;
#pragma unroll
        for (int a = 0; a < 2; ++a)
#pragma unroll
            for (int b = 0; b < 2; ++b)
#pragma unroll
                for (int m = 0; m < 4; ++m)
#pragma unroll
                    for (int n = 0; n < 2; ++n) acc[a][b][m][n] = (f32x4){0.f, 0.f, 0.f, 0.f};
        cur = nxt; cA = nA; cB = nB; ++ui;
    }
    PG8_WAIT_V(0);
    if (wr == 0) PG8_BAR;
    PG8_BAR;
#undef PG8_SA
#undef PG8_SB
#undef PG8_STAGE
#undef PG8_LDA
#undef PG8_LDB
#undef PG8_MMA
#undef PG8_WAIT_V
#undef PG8_WAIT_L
#undef PG8_BAR
#undef PG8_SCHED
}

template <int ACT  > struct EpiBf16 {
    static constexpr bool PERM = true;
    bf16_t* O; int ldc;
    __device__ __forceinline__ void operator()(const f32x4 (&acc)[2][2][4][2], const Unit& u, int wr, int wc, int fr, int fq) const {
        const int row0 = u.pm * BM + wr * 64 + fr, col0 = u.pn * BM + wc * 32 + 8 * fq;
#pragma unroll
        for (int ai = 0; ai < 2; ++ai)
#pragma unroll
            for (int m = 0; m < 4; ++m) { bf16_t* rowp = O + (size_t)(row0 + ai * HALF + m * 16) * ldc + col0;
#pragma unroll
                for (int bj = 0; bj < 2; ++bj) { f32x4 v0 = acc[ai][bj][m][0], v1 = acc[ai][bj][m][1];
                    if (ACT == 1) {
#pragma unroll
                        for (int j = 0; j < 4; ++j) { v0[j] = gelu_tanh(v0[j]); v1[j] = gelu_tanh(v1[j]); } }
                    u32x4 w; w.x = pk_bf16(v0[0], v0[1]); w.y = pk_bf16(v0[2], v0[3]); w.z = pk_bf16(v1[0], v1[1]); w.w = pk_bf16(v1[2], v1[3]);
                    *(u32x4*)(rowp + bj * HALF) = w; } }
    }
};
struct EpiRes {
    static constexpr bool PERM = false;
    const float* src_lat; const float* src_ctx; float* dst; const float* modL; int gate_idx;
    __device__ __forceinline__ void operator()(const f32x4 (&acc)[2][2][4][2], const Unit& u, int wr, int wc, int fr, int fq) const {
        const bool isctx = u.pm >= (TL / BM);
        const float* sb = isctx ? src_ctx + (size_t)(u.pm - TL / BM) * BM * D : src_lat + (size_t)u.pm * BM * D;
        const int mb = isctx ? NB : (u.pm >> 3);
        const float* gv = modL + (size_t)mb * 6144 + gate_idx * 1024;
        const int rl = wr * 64 + fr, col0 = u.pn * BM + wc * 32 + 4 * fq;
        f32x4 g[2][2];
#pragma unroll
        for (int bj = 0; bj < 2; ++bj)
#pragma unroll
            for (int n = 0; n < 2; ++n) g[bj][n] = *(const f32x4*)(gv + col0 + bj * HALF + n * 16);
#pragma unroll
        for (int ai = 0; ai < 2; ++ai)
#pragma unroll
            for (int m = 0; m < 4; ++m) { const int r = rl + ai * HALF + m * 16; const float* sp = sb + (size_t)r * D + col0; float* dp = dst + ((size_t)u.pm * BM + r) * D + col0;
#pragma unroll
                for (int bj = 0; bj < 2; ++bj)
#pragma unroll
                    for (int n = 0; n < 2; ++n) { const f32x4 x = *(const f32x4*)(sp + bj * HALF + n * 16); *(f32x4*)(dp + bj * HALF + n * 16) = x * DN_ALPHA + g[bj][n] * acc[ai][bj][m][n]; } }
    }
};
struct EpiGlaProj {
    static constexpr bool PERM = true;
    bf16_t* QG; bf16_t* KG; bf16_t* VG; bf16_t* RG; float* GL;
    __device__ __forceinline__ void operator()(const f32x4 (&acc)[2][2][4][2], const Unit& u, int wr, int wc, int fr, int fq) const {
        const int row0 = u.pm * BM + wr * 64 + fr, pn = u.pn;
        if (pn < 12) {
            bf16_t* base; int ld, colt; float sc = 1.f;
            if (pn < 2) { base = QG; ld = 512; colt = pn * BM; sc = 0.08838834764831845f; }
            else if (pn < 4) { base = KG; ld = 512; colt = (pn - 2) * BM; }
            else if (pn < 8) { base = VG; ld = 1024; colt = (pn - 4) * BM; }
            else { base = RG; ld = 1024; colt = (pn - 8) * BM; }
            const int col0 = colt + wc * 32 + 8 * fq;
#pragma unroll
            for (int ai = 0; ai < 2; ++ai)
#pragma unroll
                for (int m = 0; m < 4; ++m) { bf16_t* rowp = base + (size_t)(row0 + ai * HALF + m * 16) * ld + col0;
#pragma unroll
                    for (int bj = 0; bj < 2; ++bj) { const f32x4 v0 = acc[ai][bj][m][0] * sc, v1 = acc[ai][bj][m][1] * sc;
                        u32x4 w; w.x = pk_bf16(v0[0], v0[1]); w.y = pk_bf16(v0[2], v0[3]); w.z = pk_bf16(v1[0], v1[1]); w.w = pk_bf16(v1[2], v1[3]);
                        *(u32x4*)(rowp + bj * HALF) = w; } }
        } else if (wc == 0) {
#pragma unroll
            for (int ai = 0; ai < 2; ++ai)
#pragma unroll
                for (int m = 0; m < 4; ++m) { float* gp = GL + (size_t)(row0 + ai * HALF + m * 16) * 32 + 8 * fq;
                    *(f32x4*)gp = acc[ai][0][m][0]; *(f32x4*)(gp + 4) = acc[ai][0][m][1]; }
        }
    }
};
}

struct Ctx {
    const Params* p; unsigned char* ws; unsigned char* smem; int tid, lane, wave, G, bid;
};

DI void phase_prologue(const Ctx& c) {
    const Params& p = *c.p; unsigned char* ws = c.ws;
    const int tid = c.tid;
    constexpr int N_MOD = 192, N_TR = 4736, N_WS = 64, N_TAB = 8192;
    constexpr int N_ALL = N_MOD + N_TR + N_WS + N_TAB;
    for (int u = c.bid; u < N_ALL; u += c.G) {
        if (u < N_MOD) {
            const int l = u / 48, n0 = (u % 48) * 128;
            float* sc = (float*)c.smem;
            float* red = (float*)(c.smem + 17 * 1024 * 4);
            __syncthreads();
            for (int i = tid; i < 17 * 1024; i += NTHR) { const int b = i >> 10, k = i & 1023; const float v = (b < NB) ? p.in[1][b * 1024 + k] : p.in[3][k]; sc[i] = silu_f(v); }
            __syncthreads();
            const int c4 = (tid & 31) * 4, kg = tid >> 5;
            float acc[17][4];
#pragma unroll
            for (int b = 0; b < 17; ++b) { acc[b][0] = 0.f; acc[b][1] = 0.f; acc[b][2] = 0.f; acc[b][3] = 0.f; }
            const float* wp = p.in[4] + ((size_t)l * 1024 + (size_t)kg * 64) * 6144 + n0 + c4;
#pragma unroll 4
            for (int kk = 0; kk < 64; ++kk) {
                const f32x4 w = *(const f32x4*)(wp + (size_t)kk * 6144);
                const int k = kg * 64 + kk;
#pragma unroll
                for (int b = 0; b < 17; ++b) { const float s = sc[b * 1024 + k]; acc[b][0] += s * w[0]; acc[b][1] += s * w[1]; acc[b][2] += s * w[2]; acc[b][3] += s * w[3]; }
            }
#pragma unroll
            for (int b = 0; b < 17; ++b)
#pragma unroll
                for (int j = 0; j < 4; ++j) acc[b][j] += __shfl_xor(acc[b][j], 32, 64);
            if ((tid & 32) == 0) {
#pragma unroll
                for (int b = 0; b < 17; ++b)
#pragma unroll
                    for (int j = 0; j < 4; ++j) red[(c.wave * 17 + b) * 128 + c4 + j] = acc[b][j];
            }
            __syncthreads();
            for (int o = tid; o < 17 * 128; o += NTHR) { const int b = o >> 7, n = o & 127; float s = 0.f;
#pragma unroll
                for (int w = 0; w < 8; ++w) s += red[(w * 17 + b) * 128 + n];
                ((float*)(ws + WS_MOD))[((size_t)l * 17 + b) * 6144 + n0 + n] = s + p.in[5][l * 6144 + n0 + n]; }
        } else if (u < N_MOD + N_TR) {
            int v = u - N_MOD; const float* src; bf16_t* dst; int N, Npad;
            if (v < 1024) { const int j = v / 512; v %= 512; src = p.in[8] + (size_t)j * 1024 * 2048; dst = (bf16_t*)(ws + WS_WAIN) + (size_t)j * 2048 * 1024; N = 2048; Npad = 2048; }
            else if (v < 1536) { v -= 1024; const int j = v / 256; v %= 256; src = p.in[13] + (size_t)j * 1024 * 1024; dst = (bf16_t*)(ws + WS_WAOUT) + (size_t)j * 1024 * 1024; N = 1024; Npad = 1024; }
            else if (v < 3200) { v -= 1536; const int j = v / 832; v %= 832; src = p.in[14] + (size_t)j * 1024 * 3104; dst = (bf16_t*)(ws + WS_WBIN) + (size_t)j * WBIN_N * 1024; N = 3104; Npad = WBIN_N; }
            else if (v < 3712) { v -= 3200; const int j = v / 256; v %= 256; src = p.in[18] + (size_t)j * 1024 * 1024; dst = (bf16_t*)(ws + WS_WBOUT) + (size_t)j * 1024 * 1024; N = 1024; Npad = 1024; }
            else { v -= 3712; const int j = v / 256; v %= 256; src = p.in[19] + (size_t)j * 1024 * 1024; dst = (bf16_t*)(ws + WS_WQ) + (size_t)j * 1024 * 1024; N = 1024; Npad = 1024; }
            (void)Npad;
            const int ntn = v >> 4, ktile = v & 15, n0 = ntn * 64, k0 = ktile * 64;
            float* tl = (float*)c.smem;
            __syncthreads();
#pragma unroll
            for (int i = 0; i < 2; ++i) { const int kk = (tid >> 4) + 32 * i, nn = (tid & 15) * 4;
                f32x4 x = {0.f, 0.f, 0.f, 0.f};
                if (n0 + nn < N) x = *(const f32x4*)(src + (size_t)(k0 + kk) * N + n0 + nn);
                tl[kk * 65 + nn] = x[0]; tl[kk * 65 + nn + 1] = x[1]; tl[kk * 65 + nn + 2] = x[2]; tl[kk * 65 + nn + 3] = x[3]; }
            __syncthreads();
            { const int nn = tid >> 3, kk8 = (tid & 7) * 8; float x[8];
#pragma unroll
              for (int j = 0; j < 8; ++j) x[j] = tl[(kk8 + j) * 65 + nn];
              u32x4 w; w.x = pk_bf16(x[0], x[1]); w.y = pk_bf16(x[2], x[3]); w.z = pk_bf16(x[4], x[5]); w.w = pk_bf16(x[6], x[7]);
              *(u32x4*)(dst + (size_t)(n0 + nn) * 1024 + k0 + kk8) = w; }
        } else if (u < N_MOD + N_TR + N_WS) {
            const int v = u - N_MOD - N_TR; const size_t e = (size_t)v * 4096 + (size_t)tid * 8;
            const f32x4 a = *(const f32x4*)(p.in[11] + e), b = *(const f32x4*)(p.in[11] + e + 4);
            u32x4 w; w.x = pk_bf16(a[0], a[1]); w.y = pk_bf16(a[2], a[3]); w.z = pk_bf16(b[0], b[1]); w.w = pk_bf16(b[2], b[3]);
            *(u32x4*)((bf16_t*)(ws + WS_WSB) + e) = w;
        } else {
            const int v = u - N_MOD - N_TR - N_WS; const int tab = v >> 12; const size_t off = (size_t)(v & 4095) * 16384;
            const float* src = p.in[21 + tab] + off; bf16_t* dst = (bf16_t*)(ws + (tab ? WS_VT : WS_UT)) + off;
#pragma unroll
            for (int i = 0; i < 4; ++i) { const size_t e = (size_t)i * 4096 + (size_t)tid * 8;
                const f32x4 a = __builtin_nontemporal_load((const f32x4*)(src + e)), b = __builtin_nontemporal_load((const f32x4*)(src + e + 4));
                u32x4 w; w.x = pk_bf16(a[0], a[1]); w.y = pk_bf16(a[2], a[3]); w.z = pk_bf16(b[0], b[1]); w.w = pk_bf16(b[2], b[3]);
                *(u32x4*)(dst + e) = w; }
        }
    }
}

DI void phase_mod0(const Ctx& c) {
    const Params& p = *c.p; const float* MOD = (const float*)(c.ws + WS_MOD); bf16_t* H1 = (bf16_t*)(c.ws + WS_H1);
    for (int row = c.bid * NWAVE + c.wave; row < T; row += c.G * NWAVE) {
        const float* src = row < TL ? p.in[0] + (size_t)row * D : p.in[2] + (size_t)(row - TL) * D;
        const float* m = MOD + (size_t)mod_batch(row) * 6144;
#pragma unroll
        for (int j = 0; j < 4; ++j) { const int col = 4 * c.lane + 256 * j;
            const f32x4 x = *(const f32x4*)(src + col), sh = *(const f32x4*)(m + col), s = *(const f32x4*)(m + 1024 + col);
            const f32x4 h = x * (s + 1.0f) + sh; u32x2 w; w.x = pk_bf16(h[0], h[1]); w.y = pk_bf16(h[2], h[3]);
            *(u32x2*)(H1 + (size_t)row * D + col) = w; }
    }
}

DI void phase_vstats(const Ctx& c) {
    const bf16_t* UV = (const bf16_t*)(c.ws + WS_R1); float* ST = (float*)(c.ws + WS_STATS);
    for (int row = c.bid * NWAVE + c.wave; row < T; row += c.G * NWAVE) {
        const bf16_t* vp = UV + (size_t)row * 2048 + 1024;
        const u32x4 a = *(const u32x4*)(vp + 8 * c.lane), b = *(const u32x4*)(vp + 512 + 8 * c.lane);
        float x[16];
#pragma unroll
        for (int j = 0; j < 4; ++j) { x[2 * j] = bf_lo(a[j]); x[2 * j + 1] = bf_hi(a[j]); x[8 + 2 * j] = bf_lo(b[j]); x[9 + 2 * j] = bf_hi(b[j]); }
        float s = 0.f;
#pragma unroll
        for (int j = 0; j < 16; ++j) s += x[j];
        const float mean = wave_sum(s) * (1.0f / 1024.0f);
        float q = 0.f;
#pragma unroll
        for (int j = 0; j < 16; ++j) { const float d = x[j] - mean; q += d * d; }
        const float var = wave_sum(q) * (1.0f / 1024.0f);
        if (c.lane == 0) { ST[2 * row] = mean; ST[2 * row + 1] = rsqrtf(var + LN_EPS); }
    }
}

DI void phase_spatial(const Ctx& c, int j) {
    const Params& p = *c.p; unsigned char* ws = c.ws;
    const bf16_t* UV = (const bf16_t*)(ws + WS_R1); const float* ST = (const float*)(ws + WS_STATS); bf16_t* Y = (bf16_t*)(ws + WS_R2);
    const bf16_t* WSB = (const bf16_t*)(ws + WS_WSB) + (size_t)j * 8 * 128 * 128;
    const float* ng = p.in[9] + j * 1024; const float* nb = p.in[10] + j * 1024; const float* bs = p.in[12] + j * 8 * 128;
    constexpr int LD = 136;
    bf16_t* WsL = (bf16_t*)c.smem;
    bf16_t* VnT = WsL + 128 * LD;
    const int tid = c.tid, lane = c.lane, w = c.wave, g = lane >> 4, cc = lane & 15;
    for (int u = c.bid; u < (T / 128) * 8; u += c.G) {
        const int chunk = u >> 3, h = u & 7, r0 = chunk * 128;
        __syncthreads();
        { const int cg8 = tid & 15; float gg[8], bb[8];
#pragma unroll
          for (int e = 0; e < 8; ++e) { gg[e] = ng[h * 128 + cg8 * 8 + e]; bb[e] = nb[h * 128 + cg8 * 8 + e]; }
#pragma unroll
          for (int i = 0; i < 4; ++i) { const int idx = i * 512 + tid, tok = idx >> 4;
              const u32x4 v = *(const u32x4*)(UV + (size_t)(r0 + tok) * 2048 + 1024 + h * 128 + cg8 * 8);
              const float mean = ST[2 * (r0 + tok)], rstd = ST[2 * (r0 + tok) + 1];
              float x[8];
#pragma unroll
              for (int e = 0; e < 4; ++e) { x[2 * e] = bf_lo(v[e]); x[2 * e + 1] = bf_hi(v[e]); }
#pragma unroll
              for (int e = 0; e < 8; ++e) VnT[(cg8 * 8 + e) * LD + tok] = f2bf((x[e] - mean) * rstd * gg[e] + bb[e]);
              const int pp = idx >> 4;
              *(u32x4*)(WsL + pp * LD + cg8 * 8) = *(const u32x4*)(WSB + ((size_t)h * 128 + pp) * 128 + cg8 * 8); } }
        __syncthreads();
        f32x4 acc[8];
#pragma unroll
        for (int ct = 0; ct < 8; ++ct) acc[ct] = (f32x4){0.f, 0.f, 0.f, 0.f};
#pragma unroll
        for (int ks = 0; ks < 4; ++ks) {
            const bf16x8 bfr = frag_ld(WsL, LD, 16 * w, 32 * ks, lane);
#pragma unroll
            for (int ct = 0; ct < 8; ++ct) acc[ct] = mfma16(frag_ld(VnT, LD, 16 * ct, 32 * ks, lane), bfr, acc[ct]);
        }
        const int pp = 16 * w + cc; const float bsv = bs[h * 128 + pp];
        const size_t rowo = (size_t)(r0 + pp);
#pragma unroll
        for (int ct = 0; ct < 8; ++ct) { const int ch = h * 128 + 16 * ct + 4 * g;
            const u32x2 uu = *(const u32x2*)(UV + rowo * 2048 + ch);
            const float y0 = bf_lo(uu.x) * (acc[ct][0] + bsv), y1 = bf_hi(uu.x) * (acc[ct][1] + bsv), y2 = bf_lo(uu.y) * (acc[ct][2] + bsv), y3 = bf_hi(uu.y) * (acc[ct][3] + bsv);
            u32x2 o; o.x = pk_bf16(y0, y1); o.y = pk_bf16(y2, y3);
            *(u32x2*)(Y + rowo * D + ch) = o; }
    }
}

DI void phase_ln1(const Ctx& c, int L) {
    const Params& p = *c.p; float* XS = (float*)(c.ws + WS_XS); const float* MOD = (const float*)(c.ws + WS_MOD) + (size_t)L * 17 * 6144;
    bf16_t* H2 = (bf16_t*)(c.ws + WS_R2 + SZ_T1K);
    const float* lg = p.in[6] + (size_t)(L * 2 + 0) * D; const float* lb = p.in[7] + (size_t)(L * 2 + 0) * D;
    for (int row = c.bid * NWAVE + c.wave; row < T; row += c.G * NWAVE) {
        float* xp = XS + (size_t)row * D; const float* m = MOD + (size_t)mod_batch(row) * 6144;
        f32x4 x[4]; float s = 0.f;
#pragma unroll
        for (int j = 0; j < 4; ++j) { x[j] = *(const f32x4*)(xp + 4 * c.lane + 256 * j); s += (x[j][0] + x[j][1]) + (x[j][2] + x[j][3]); }
        const float mean = wave_sum(s) * (1.0f / 1024.0f);
        float q = 0.f;
#pragma unroll
        for (int j = 0; j < 4; ++j) { const f32x4 d = x[j] - mean; q += (d[0] * d[0] + d[1] * d[1]) + (d[2] * d[2] + d[3] * d[3]); }
        const float rstd = rsqrtf(wave_sum(q) * (1.0f / 1024.0f) + LN_EPS);
#pragma unroll
        for (int j = 0; j < 4; ++j) { const int col = 4 * c.lane + 256 * j;
            const f32x4 y = (x[j] - mean) * rstd * *(const f32x4*)(lg + col) + *(const f32x4*)(lb + col);
            *(f32x4*)(xp + col) = y;
            const f32x4 h = y * (*(const f32x4*)(m + 4 * 1024 + col) + 1.0f) + *(const f32x4*)(m + 3 * 1024 + col);
            u32x2 w; w.x = pk_bf16(h[0], h[1]); w.y = pk_bf16(h[2], h[3]);
            *(u32x2*)(H2 + (size_t)row * D + col) = w; }
    }
}

DI int f2key(float v) { const int i = __float_as_int(v); return i ^ ((i >> 31) & 0x7fffffff); }
DI float key2f(int k) { return __int_as_float(k ^ ((k >> 31) & 0x7fffffff)); }
DI void top16_half(const float* kh  , const bf16_t* q64, int (&t)[16]) {
    float q[64];
#pragma unroll
    for (int i = 0; i < 8; ++i) { const u32x4 v = *(const u32x4*)(q64 + 8 * i);
#pragma unroll
        for (int e = 0; e < 4; ++e) { q[8 * i + 2 * e] = bf_lo(v[e]); q[8 * i + 2 * e + 1] = bf_hi(v[e]); } }
#pragma unroll
    for (int i = 0; i < 16; ++i) t[i] = (int)0x80000000;
    for (int k = 0; k < 128; ++k) {
        const float* kr = kh + k * 64;
        float s0 = 0.f, s1 = 0.f, s2 = 0.f, s3 = 0.f;
#pragma unroll
        for (int d = 0; d < 64; d += 4) { const f32x4 kv = *(const f32x4*)(kr + d); s0 += q[d] * kv[0]; s1 += q[d + 1] * kv[1]; s2 += q[d + 2] * kv[2]; s3 += q[d + 3] * kv[3]; }
        int key = (f2key((s0 + s1) + (s2 + s3)) & ~127) | (127 - k);
#pragma unroll
        for (int i = 0; i < 16; ++i) { const int hi = max(key, t[i]); key = min(key, t[i]); t[i] = hi; }
    }
}
DI void phase_route(const Ctx& c, int L) {
    const Params& p = *c.p; unsigned char* ws = c.ws;
    float* keys = (float*)c.smem;
    unsigned* ilist = (unsigned*)(c.smem + 65536);
    __syncthreads();
    { const float* gk = p.in[20] + (size_t)L * 2 * 128 * 64;
      for (int i = c.tid; i < 2 * 128 * 64 / 4; i += NTHR) ((f32x4*)keys)[i] = ((const f32x4*)gk)[i]; }
    __syncthreads();
    const bf16_t* QP = (const bf16_t*)(ws + WS_R1); int* IDX = (int*)(ws + WS_R1 + SZ_T1K); float* WT = (float*)(ws + WS_R1 + SZ_T1K + (size_t)T * 128 * 4);
    unsigned* myl = ilist + c.tid * 8; const unsigned char* mylb = (const unsigned char*)myl;
    for (int task = c.bid * NWAVE + c.wave; task < T * 8 / 64; task += c.G * NWAVE) {
        const int item = task * 64 + c.lane, tok = item >> 3, h = item & 7;
        const bf16_t* qp = QP + (size_t)tok * D + h * 128;
        int t1[16], t2[16];
        top16_half(keys, qp, t1);
        top16_half(keys + 128 * 64, qp + 64, t2);
        float v1[16], v2[16];
#pragma unroll
        for (int i = 0; i < 16; ++i) { v1[i] = key2f(t1[i] & ~127); v2[i] = key2f(t2[i] & ~127); }
#pragma unroll
        for (int i = 0; i < 4; ++i) {
            myl[i] = (unsigned)(127 - (t1[4 * i] & 127)) | ((unsigned)(127 - (t1[4 * i + 1] & 127)) << 8) | ((unsigned)(127 - (t1[4 * i + 2] & 127)) << 16) | ((unsigned)(127 - (t1[4 * i + 3] & 127)) << 24);
            myl[4 + i] = (unsigned)(127 - (t2[4 * i] & 127)) | ((unsigned)(127 - (t2[4 * i + 1] & 127)) << 8) | ((unsigned)(127 - (t2[4 * i + 2] & 127)) << 16) | ((unsigned)(127 - (t2[4 * i + 3] & 127)) << 24); }
        int f[16];
#pragma unroll
        for (int i = 0; i < 16; ++i) f[i] = (int)0x80000000;
#pragma unroll
        for (int a = 0; a < 16; ++a)
#pragma unroll
            for (int b = 0; b < 16; ++b)
                if ((a + 1) * (b + 1) <= 16) {
                    int key = (f2key(v1[a] + v2[b]) & ~255) | (255 - (a * 16 + b));
#pragma unroll
                    for (int i = 0; i < 16; ++i) { const int hi = max(key, f[i]); key = min(key, f[i]); f[i] = hi; }
                }
        float e[16], se = 0.f; int fi[16];
        const float vmax = key2f(f[0] & ~255);
#pragma unroll
        for (int i = 0; i < 16; ++i) { const int code = 255 - (f[i] & 255); fi[i] = (int)mylb[code >> 4] * 128 + (int)mylb[16 + (code & 15)];
            e[i] = __expf(key2f(f[i] & ~255) - vmax); se += e[i]; }
        const float inv = 1.0f / se;
        int* ip = IDX + (size_t)tok * 128 + h * 16; float* wp = WT + (size_t)tok * 128 + h * 16;
#pragma unroll
        for (int i = 0; i < 16; i += 4) { *(int4*)(ip + i) = make_int4(fi[i], fi[i + 1], fi[i + 2], fi[i + 3]); *(f32x4*)(wp + i) = (f32x4){e[i] * inv, e[i + 1] * inv, e[i + 2] * inv, e[i + 3] * inv}; }
    }
}

DI void phase_experts(const Ctx& c, int L) {
    const Params& p = *c.p; unsigned char* ws = c.ws; const int lane = c.lane;
    const bf16_t* H2 = (const bf16_t*)(ws + WS_R2 + SZ_T1K);
    const int* IDX = (const int*)(ws + WS_R1 + SZ_T1K); const float* WT = (const float*)(ws + WS_R1 + SZ_T1K + (size_t)T * 128 * 4);
    const bf16_t* UT = (const bf16_t*)(ws + WS_UT) + (size_t)L * NEXP * 1024; const bf16_t* VT = (const bf16_t*)(ws + WS_VT) + (size_t)L * NEXP * 1024;
    float* XS = (float*)(ws + WS_XS); bf16_t* H1 = (bf16_t*)(ws + WS_H1);
    const float* MOD = (const float*)(ws + WS_MOD) + (size_t)L * 17 * 6144;
    const float* lg = p.in[6] + (size_t)(L * 2 + 1) * D; const float* lb = p.in[7] + (size_t)(L * 2 + 1) * D;
    const int nrows = (L == DEPTH - 1) ? TL : T;
    for (int row = c.bid * NWAVE + c.wave; row < nrows; row += c.G * NWAVE) {
        const u32x4 xa = *(const u32x4*)(H2 + (size_t)row * D + 8 * lane), xb = *(const u32x4*)(H2 + (size_t)row * D + 512 + 8 * lane);
        const int id0 = IDX[(size_t)row * 128 + lane], id1 = IDX[(size_t)row * 128 + 64 + lane];
        const float w0 = WT[(size_t)row * 128 + lane], w1 = WT[(size_t)row * 128 + 64 + lane];
        float z0 = 0.f, z1 = 0.f;
#pragma unroll
        for (int hh = 0; hh < 2; ++hh) {
            const int idr = hh ? id1 : id0; float zz = 0.f;
            for (int e0 = 0; e0 < 64; e0 += 8) {
                u32x4 ra[8], rb[8];
#pragma unroll
                for (int k = 0; k < 8; ++k) { const int ex = __builtin_amdgcn_readlane(idr, e0 + k); const bf16_t* up = UT + (size_t)ex * 1024;
                    ra[k] = *(const u32x4*)(up + 8 * lane); rb[k] = *(const u32x4*)(up + 512 + 8 * lane); }
#pragma unroll
                for (int k = 0; k < 8; ++k) { float d = 0.f;
#pragma unroll
                    for (int j = 0; j < 4; ++j) { d = dot2bf(ra[k][j], xa[j], d); d = dot2bf(rb[k][j], xb[j], d); }
                    d = wave_sum(d);
                    zz = (lane == e0 + k) ? d : zz; }
            }
            if (hh) z1 = zz; else z0 = zz;
        }
        const float a0 = gelu_tanh(z0) * w0, a1 = gelu_tanh(z1) * w1;
        float o[16];
#pragma unroll
        for (int j = 0; j < 16; ++j) o[j] = 0.f;
#pragma unroll
        for (int hh = 0; hh < 2; ++hh) {
            const int idr = hh ? id1 : id0; const float ar = hh ? a1 : a0;
            for (int e0 = 0; e0 < 64; e0 += 8) {
                u32x4 ra[8], rb[8];
#pragma unroll
                for (int k = 0; k < 8; ++k) { const int ex = __builtin_amdgcn_readlane(idr, e0 + k); const bf16_t* vp = VT + (size_t)ex * 1024;
                    ra[k] = *(const u32x4*)(vp + 8 * lane); rb[k] = *(const u32x4*)(vp + 512 + 8 * lane); }
#pragma unroll
                for (int k = 0; k < 8; ++k) { const float a = __int_as_float(__builtin_amdgcn_readlane(__float_as_int(ar), e0 + k));
#pragma unroll
                    for (int j = 0; j < 4; ++j) { o[2 * j] += a * bf_lo(ra[k][j]); o[2 * j + 1] += a * bf_hi(ra[k][j]); o[8 + 2 * j] += a * bf_lo(rb[k][j]); o[9 + 2 * j] += a * bf_hi(rb[k][j]); } }
            }
        }
        float* xp = XS + (size_t)row * D; const int mb = mod_batch(row); const float* m = MOD + (size_t)mb * 6144;
        float y[16]; float s = 0.f;
#pragma unroll
        for (int hf = 0; hf < 2; ++hf)
#pragma unroll
            for (int qd = 0; qd < 2; ++qd) { const int col = 512 * hf + 8 * lane + 4 * qd;
                const f32x4 x1 = *(const f32x4*)(xp + col), g2 = *(const f32x4*)(m + 5 * 1024 + col);
#pragma unroll
                for (int j = 0; j < 4; ++j) { const float v = DN_ALPHA * x1[j] + g2[j] * o[8 * hf + 4 * qd + j]; y[8 * hf + 4 * qd + j] = v; s += v; } }
        const float mean = wave_sum(s) * (1.0f / 1024.0f);
        float q = 0.f;
#pragma unroll
        for (int j = 0; j < 16; ++j) { const float d = y[j] - mean; q += d * d; }
        const float rstd = rsqrtf(wave_sum(q) * (1.0f / 1024.0f) + LN_EPS);
        const float* mn = (const float*)(ws + WS_MOD) + (size_t)(L + 1 < DEPTH ? L + 1 : L) * 17 * 6144 + (size_t)mb * 6144;
#pragma unroll
        for (int hf = 0; hf < 2; ++hf)
#pragma unroll
            for (int qd = 0; qd < 2; ++qd) { const int col = 512 * hf + 8 * lane + 4 * qd;
                const f32x4 gg = *(const f32x4*)(lg + col), bb = *(const f32x4*)(lb + col); f32x4 x2;
#pragma unroll
                for (int j = 0; j < 4; ++j) x2[j] = (y[8 * hf + 4 * qd + j] - mean) * rstd * gg[j] + bb[j];
                if (L == DEPTH - 1) { *(f32x4*)(p.out + (size_t)row * D + col) = x2; }
                else { *(f32x4*)(xp + col) = x2;
                    const f32x4 h = x2 * (*(const f32x4*)(mn + 1024 + col) + 1.0f) + *(const f32x4*)(mn + col);
                    u32x2 w; w.x = pk_bf16(h[0], h[1]); w.y = pk_bf16(h[2], h[3]);
                    *(u32x2*)(H1 + (size_t)row * D + col) = w; } }
    }
}

DI void phase_gla_prep(const Ctx& c, int j) {
    const Params& p = *c.p; unsigned char* ws = c.ws; const int tid = c.tid;
    const bf16_t* QG = (const bf16_t*)(ws + WS_R1); const bf16_t* KG = (const bf16_t*)(ws + WS_R1 + SZ_T512);
    const float* GL = (const float*)(ws + WS_GL); float* DEC = (float*)(ws + WS_DEC);
    float* gl = (float*)c.smem;
    for (int ch = c.bid; ch < T / 64; ch += c.G) {
        const int r0 = ch * 64;
        __syncthreads();
        for (int i = tid; i < 64 * 32 / 4; i += NTHR) ((f32x4*)gl)[i] = ((const f32x4*)(GL + (size_t)r0 * 32))[i];
        __syncthreads();
#pragma unroll
        for (int dir = 0; dir < 2; ++dir) {
            float wg[16];
#pragma unroll
            for (int r = 0; r < 16; ++r) wg[r] = p.in[15][((size_t)(j * 2 + dir) * 16 + r) * 512 + tid];
            const float bias = p.in[16][(size_t)(j * 2 + dir) * 512 + tid];
            float total = 0.f;
            for (int i = 0; i < 64; ++i) { float z = bias;
#pragma unroll
                for (int r = 0; r < 16; ++r) z += gl[i * 32 + dir * 16 + r] * wg[r];
                total += logsig_f(z) * (1.0f / 16.0f); }
            DEC[((size_t)dir * (T / 64) + ch) * 512 + tid] = expf(total);
            bf16_t* QIN = (bf16_t*)(ws + WS_R2) + (size_t)dir * T * 512; bf16_t* KIN = (bf16_t*)(ws + WS_R2 + SZ_T1K) + (size_t)dir * T * 512; bf16_t* KEND = (bf16_t*)(ws + WS_R2 + 2 * SZ_T1K) + (size_t)dir * T * 512;
            float cum = 0.f;
            for (int ii = 0; ii < 64; ++ii) { const int i = dir ? 63 - ii : ii; float z = bias;
#pragma unroll
                for (int r = 0; r < 16; ++r) z += gl[i * 32 + dir * 16 + r] * wg[r];
                cum += logsig_f(z) * (1.0f / 16.0f);
                const size_t o = (size_t)(r0 + i) * 512 + tid;
                const float qv = bf1(QG[o]), kv = bf1(KG[o]);
                QIN[o] = f2bf(qv * expf(cum)); KIN[o] = f2bf(kv * expf(-cum)); KEND[o] = f2bf(kv * expf(total - cum)); }
        }
    }
}

DI void phase_gla_scan(const Ctx& c) {
    unsigned char* ws = c.ws; const int tid = c.tid, lane = c.lane, w = c.wave, g = lane >> 4, cc = lane & 15;
    const bf16_t* VG = (const bf16_t*)(ws + WS_R1 + 2 * SZ_T512); const float* DEC = (const float*)(ws + WS_DEC); bf16_t* O = (bf16_t*)(ws + WS_H1);
    constexpr int LDQ = 136, LDJ = 72;
    bf16_t* Qs = (bf16_t*)c.smem;
    bf16_t* Ks = Qs + 64 * LDQ;
    bf16_t* KEt = Ks + 64 * LDQ;
    bf16_t* Vt = KEt + 128 * LDJ;
    bf16_t* At = Vt + 64 * LDJ;
    bf16_t* St = At + 64 * LDJ;
    float* dec = (float*)(St + 64 * LDQ);
    for (int u = c.bid; u < NB * 4 * 4; u += c.G) {
        const int b = u >> 4, h = (u >> 2) & 3, es = u & 3;
        for (int dir = 0; dir < 2; ++dir) {
            const bf16_t* QIN = (const bf16_t*)(ws + WS_R2) + (size_t)dir * T * 512; const bf16_t* KIN = (const bf16_t*)(ws + WS_R2 + SZ_T1K) + (size_t)dir * T * 512; const bf16_t* KEND = (const bf16_t*)(ws + WS_R2 + 2 * SZ_T1K) + (size_t)dir * T * 512;
            f32x4 accS[4];
#pragma unroll
            for (int et = 0; et < 4; ++et) accS[et] = (f32x4){0.f, 0.f, 0.f, 0.f};
            __syncthreads();
            for (int i = tid; i < 64 * LDQ / 2; i += NTHR) ((unsigned*)St)[i] = 0u;
            for (int cs = 0; cs < 36; ++cs) {
                int r0;
                if (dir == 0) r0 = (cs < 4) ? TL + b * CTXL + 64 * cs : b * SEQ + 64 * (cs - 4);
                else r0 = (cs < 4) ? TL + b * CTXL + 64 * (3 - cs) : b * SEQ + 64 * (35 - cs);
                const int chunk = r0 >> 6;
#pragma unroll
                for (int it = 0; it < 2; ++it) { const int idx = it * 512 + tid, tok = idx >> 4, d8 = (idx & 15) * 8;
                    const size_t go = (size_t)(r0 + tok) * 512 + h * 128 + d8;
                    *(u32x4*)(Qs + tok * LDQ + d8) = *(const u32x4*)(QIN + go);
                    *(u32x4*)(Ks + tok * LDQ + d8) = *(const u32x4*)(KIN + go);
                    const u32x4 ke = *(const u32x4*)(KEND + go);
#pragma unroll
                    for (int e = 0; e < 4; ++e) { KEt[(d8 + 2 * e) * LDJ + tok] = (bf16_t)(ke[e] & 0xffffu); KEt[(d8 + 2 * e + 1) * LDJ + tok] = (bf16_t)(ke[e] >> 16); } }
                { const int tok = tid >> 3, e8 = (tid & 7) * 8;
                  const u32x4 vv = *(const u32x4*)(VG + (size_t)(r0 + tok) * 1024 + h * 256 + es * 64 + e8);
#pragma unroll
                  for (int e = 0; e < 4; ++e) { Vt[(e8 + 2 * e) * LDJ + tok] = (bf16_t)(vv[e] & 0xffffu); Vt[(e8 + 2 * e + 1) * LDJ + tok] = (bf16_t)(vv[e] >> 16); } }
                if (tid < 128) dec[tid] = DEC[((size_t)dir * (T / 64) + chunk) * 512 + h * 128 + tid];
                __syncthreads();
                { const int it = w >> 1;
#pragma unroll
                  for (int jj = 0; jj < 2; ++jj) { const int jt = 2 * (w & 1) + jj; f32x4 a = {0.f, 0.f, 0.f, 0.f};
#pragma unroll
                      for (int ks = 0; ks < 4; ++ks) a = mfma16(frag_ld(Qs, LDQ, 16 * it, 32 * ks, lane), frag_ld(Ks, LDQ, 16 * jt, 32 * ks, lane), a);
                      const int jcol = 16 * jt + cc;
#pragma unroll
                      for (int r = 0; r < 4; ++r) { const int i = 16 * it + 4 * g + r; const bool keep = dir ? (jcol >= i) : (jcol <= i);
                          At[i * LDJ + jcol] = f2bf(keep ? a[r] : 0.f); } } }
                __syncthreads();
                { const int it = w >> 1;
#pragma unroll
                  for (int ee = 0; ee < 2; ++ee) { const int et = 2 * (w & 1) + ee; f32x4 a = {0.f, 0.f, 0.f, 0.f};
#pragma unroll
                      for (int ks = 0; ks < 2; ++ks) a = mfma16(frag_ld(At, LDJ, 16 * it, 32 * ks, lane), frag_ld(Vt, LDJ, 16 * et, 32 * ks, lane), a);
#pragma unroll
                      for (int ks = 0; ks < 4; ++ks) a = mfma16(frag_ld(Qs, LDQ, 16 * it, 32 * ks, lane), frag_ld(St, LDQ, 16 * et, 32 * ks, lane), a);
                      const int ecol = h * 256 + es * 64 + 16 * et + cc;
#pragma unroll
                      for (int r = 0; r < 4; ++r) { const size_t oo = (size_t)(r0 + 16 * it + 4 * g + r) * 1024 + ecol;
                          float v = a[r]; if (dir) v += bf1(O[oo]); O[oo] = f2bf(v); } } }
#pragma unroll
                for (int et = 0; et < 4; ++et) {
#pragma unroll
                    for (int r = 0; r < 4; ++r) accS[et][r] *= dec[16 * w + 4 * g + r];
#pragma unroll
                    for (int ks = 0; ks < 2; ++ks) accS[et] = mfma16(frag_ld(KEt, LDJ, 16 * w, 32 * ks, lane), frag_ld(Vt, LDJ, 16 * et, 32 * ks, lane), accS[et]);
                }
                __syncthreads();
#pragma unroll
                for (int et = 0; et < 4; ++et) { u32x2 sv; sv.x = pk_bf16(accS[et][0], accS[et][1]); sv.y = pk_bf16(accS[et][2], accS[et][3]);
                    *(u32x2*)(St + (16 * et + cc) * LDQ + 16 * w + 4 * g) = sv; }
            }
        }
    }
}

DI void phase_gla_readout(const Ctx& c, int j) {
    const Params& p = *c.p; unsigned char* ws = c.ws;
    const bf16_t* O = (const bf16_t*)(ws + WS_H1); const bf16_t* RG = (const bf16_t*)(ws + WS_R1 + 2 * SZ_T512 + SZ_T1K); bf16_t* Y = (bf16_t*)(ws + WS_R2);
    const float* gn = p.in[17] + (size_t)j * 1024;
    for (int row = c.bid * NWAVE + c.wave; row < T; row += c.G * NWAVE) {
#pragma unroll
        for (int hd = 0; hd < 4; ++hd) { const int col = 4 * c.lane + 256 * hd;
            const u32x2 ov = *(const u32x2*)(O + (size_t)row * D + col), rv = *(const u32x2*)(RG + (size_t)row * D + col);
            const float x0 = bf_lo(ov.x), x1 = bf_hi(ov.x), x2 = bf_lo(ov.y), x3 = bf_hi(ov.y);
            const float mean = wave_sum((x0 + x1) + (x2 + x3)) * (1.0f / 256.0f);
            const float d0 = x0 - mean, d1 = x1 - mean, d2 = x2 - mean, d3 = x3 - mean;
            const float rstd = rsqrtf(wave_sum((d0 * d0 + d1 * d1) + (d2 * d2 + d3 * d3)) * (1.0f / 256.0f) + LN_EPS);
            const f32x4 gg = *(const f32x4*)(gn + col);
            const float r0 = bf_lo(rv.x), r1 = bf_hi(rv.x), r2 = bf_lo(rv.y), r3 = bf_hi(rv.y);
            u32x2 o; o.x = pk_bf16(d0 * rstd * gg[0] * silu_f(r0), d1 * rstd * gg[1] * silu_f(r1)); o.y = pk_bf16(d2 * rstd * gg[2] * silu_f(r2), d3 * rstd * gg[3] * silu_f(r3));
            *(u32x2*)(Y + (size_t)row * D + col) = o; }
    }
}

constexpr int N_PHASES = 2 + 2 * 8 + 2 * 9;

__global__ void __launch_bounds__(NTHR, 2) mega_fwd(Params p) {
    extern __shared__ __attribute__((aligned(16))) unsigned char smem[];
    cg::grid_group grid = cg::this_grid();
    Ctx c; c.p = &p; c.ws = p.ws; c.smem = smem; c.tid = threadIdx.x; c.lane = c.tid & 63; c.wave = __builtin_amdgcn_readfirstlane(c.tid >> 6); c.G = gridDim.x; c.bid = blockIdx.x;
    unsigned char* ws = p.ws;
    unsigned* ctr = (unsigned*)(ws + WS_CTL);
    unsigned target = 0;
    const int lo = p.ph_lo, hi = p.ph_hi;
    int ph = 0;
#ifndef PH_ONLY
#define PH_ONLY -1
#endif
#define RUN(id, ...) do { if ((PH_ONLY < 0 || PH_ONLY == (id)) && ph >= lo && ph < hi) { { int t_ = threadIdx.x; asm volatile("" : "+v"(t_)); c.tid = t_; c.lane = t_ & 63; c.wave = __builtin_amdgcn_readfirstlane(t_ >> 6); ws = p.ws; asm volatile("" : "+s"(ws)); c.ws = ws; } __VA_ARGS__; if (ph + 1 < hi) { if (ph == 0) grid.sync(); else grid_barrier(ctr, target); } } ++ph; } while (0)
    LAS unsigned char* lds = (LAS unsigned char*)smem;
    const float* MOD = (const float*)(ws + WS_MOD);

    RUN(0, phase_prologue(c));
    RUN(1, phase_mod0(c));
    for (int L = 0; L < DEPTH; ++L) {
        const int j = L >> 1;
        if ((L & 1) == 0) {
            RUN(2, { pg8::Gemm g{(const bf16_t*)(ws + WS_H1), (const bf16_t*)(ws + WS_WAIN) + (size_t)j * 2048 * 1024, T, 2048, 1024}; pg8::StaticOrder S; S.init(T, 2048, c.G, c.bid);
                  pg8::EpiBf16<1> E{(bf16_t*)(ws + WS_R1), 2048}; pg8::gemm_phase(lds, g, S, E, c.tid); });
            RUN(3, phase_vstats(c));
            RUN(4, phase_spatial(c, j));
        } else {
            RUN(5, { pg8::Gemm g{(const bf16_t*)(ws + WS_H1), (const bf16_t*)(ws + WS_WBIN) + (size_t)j * WBIN_N * 1024, T, WBIN_N, 1024}; pg8::StaticOrder S; S.init(T, WBIN_N, c.G, c.bid);
                  pg8::EpiGlaProj E{(bf16_t*)(ws + WS_R1), (bf16_t*)(ws + WS_R1 + SZ_T512), (bf16_t*)(ws + WS_R1 + 2 * SZ_T512), (bf16_t*)(ws + WS_R1 + 2 * SZ_T512 + SZ_T1K), (float*)(ws + WS_GL)};
                  pg8::gemm_phase(lds, g, S, E, c.tid); });
            RUN(6, phase_gla_prep(c, j));
            RUN(7, phase_gla_scan(c));
            RUN(8, phase_gla_readout(c, j));
        }
        RUN(9, { const bf16_t* W = (L & 1) ? (const bf16_t*)(ws + WS_WBOUT) + (size_t)j * 1024 * 1024 : (const bf16_t*)(ws + WS_WAOUT) + (size_t)j * 1024 * 1024;
              pg8::Gemm g{(const bf16_t*)(ws + WS_R2), W, T, 1024, 1024}; pg8::StaticOrder S; S.init(T, 1024, c.G, c.bid);
              pg8::EpiRes E{L == 0 ? p.in[0] : (const float*)(ws + WS_XS), L == 0 ? p.in[2] : (const float*)(ws + WS_XS) + (size_t)TL * D, (float*)(ws + WS_XS), MOD + (size_t)L * 17 * 6144, 2};
              pg8::gemm_phase(lds, g, S, E, c.tid); });
        RUN(10, phase_ln1(c, L));
        RUN(11, { pg8::Gemm g{(const bf16_t*)(ws + WS_R2 + SZ_T1K), (const bf16_t*)(ws + WS_WQ) + (size_t)L * 1024 * 1024, T, 1024, 1024}; pg8::StaticOrder S; S.init(T, 1024, c.G, c.bid);
              pg8::EpiBf16<0> E{(bf16_t*)(ws + WS_R1), 1024}; pg8::gemm_phase(lds, g, S, E, c.tid); });
        RUN(12, phase_route(c, L));
        RUN(13, phase_experts(c, L));
    }
#undef RUN
}

extern "C" void kernel_launch(void* const* d_in, const int* in_sizes, int n_in, void* d_out, int out_size, void* d_ws, size_t ws_size, hipStream_t stream) {
    static int grid = 0;
    if (grid == 0) {
        if (n_in != 23 || out_size != TL * D || ws_size < WS_END) { fprintf(stderr, "kernel_launch: unexpected shapes: n_in %d out %d ws %zu (need %zu)\n", n_in, out_size, ws_size, (size_t)WS_END); grid = -1; return; }
        int dev = 0, cus = 0, per_cu = 0;
        if (hipGetDevice(&dev) != hipSuccess || hipDeviceGetAttribute(&cus, hipDeviceAttributeMultiprocessorCount, dev) != hipSuccess) { fprintf(stderr, "kernel_launch: device query failed\n"); grid = -1; return; }
        if (hipFuncSetAttribute((const void*)mega_fwd, hipFuncAttributeMaxDynamicSharedMemorySize, LDS_BYTES) != hipSuccess) { fprintf(stderr, "kernel_launch: hipFuncSetAttribute failed\n"); grid = -1; return; }
        if (hipOccupancyMaxActiveBlocksPerMultiprocessor(&per_cu, (const void*)mega_fwd, NTHR, LDS_BYTES) != hipSuccess || per_cu < 1) { fprintf(stderr, "kernel_launch: occupancy query says %d blocks per CU\n", per_cu); grid = -1; return; }
        grid = cus;
    }
    if (grid < 0) return;
    (void)hipMemsetAsync((char*)d_ws + WS_CTL, 0, 65536, stream);
    Params p{};
    for (int i = 0; i < 23; ++i) p.in[i] = (const float*)d_in[i];
    p.out = (float*)d_out; p.ws = (unsigned char*)d_ws; p.ph_lo = 0; p.ph_hi = N_PHASES;
    void* args[] = {&p};
    const hipError_t e = hipLaunchCooperativeKernel((const void*)mega_fwd, dim3(grid), dim3(NTHR), args, LDS_BYTES, stream);
    if (e != hipSuccess) fprintf(stderr, "kernel_launch: cooperative launch failed: %s (grid %d)\n", hipGetErrorString(e), grid);
}
```

```cpp
#include <hip/hip_runtime.h>
#include <hip/hip_cooperative_groups.h>
#include <cstdio>
#include <cstdint>
namespace cg = cooperative_groups;

#define LAS __attribute__((address_space(3)))
#define DI __device__ __forceinline__
typedef unsigned short bf16_t;
typedef short bf16x8 __attribute__((ext_vector_type(8)));
typedef float f32x4 __attribute__((ext_vector_type(4)));
typedef float f32x2 __attribute__((ext_vector_type(2)));
typedef unsigned u32x4 __attribute__((ext_vector_type(4)));
typedef unsigned u32x2 __attribute__((ext_vector_type(2)));
typedef __bf16 bf16v2 __attribute__((ext_vector_type(2)));

constexpr int D = 1024, NB = 16, SEQ = 2048, CTXL = 256, DEPTH = 4;
constexpr int TL = NB * SEQ, TC = NB * CTXL, T = TL + TC;
constexpr int NEXP = 16384;
constexpr float LN_EPS = 1e-5f;
constexpr float DN_ALPHA = 1.6817928305074290f;
constexpr int NTHR = 512, NWAVE = 8;
constexpr int LDS_BYTES = 140 * 1024;
constexpr int WBIN_N = 3328;

constexpr size_t al256(size_t x) { return (x + 255) & ~(size_t)255; }
constexpr size_t WS_CTL = 0;
constexpr size_t WS_MOD = 65536;
constexpr size_t WS_STATS = al256(WS_MOD + (size_t)4 * 17 * 6144 * 4);
constexpr size_t WS_GL = al256(WS_STATS + (size_t)T * 2 * 4);
constexpr size_t WS_DEC = al256(WS_GL + (size_t)T * 32 * 4);
constexpr size_t WS_WSB = al256(WS_DEC + (size_t)2 * 576 * 512 * 4);
constexpr size_t WS_WAIN = al256(WS_WSB + (size_t)2 * 8 * 128 * 128 * 2);
constexpr size_t WS_WAOUT = WS_WAIN + (size_t)2 * 2048 * 1024 * 2;
constexpr size_t WS_WBIN = WS_WAOUT + (size_t)2 * 1024 * 1024 * 2;
constexpr size_t WS_WBOUT = WS_WBIN + (size_t)2 * WBIN_N * 1024 * 2;
constexpr size_t WS_WQ = WS_WBOUT + (size_t)2 * 1024 * 1024 * 2;
constexpr size_t WS_UT = WS_WQ + (size_t)4 * 1024 * 1024 * 2;
constexpr size_t WS_VT = WS_UT + (size_t)4 * NEXP * 1024;
constexpr size_t WS_SU = WS_VT + (size_t)4 * NEXP * 1024;
constexpr size_t WS_SV = WS_SU + (size_t)4 * NEXP * 4;
constexpr size_t WS_XS = WS_SV + (size_t)4 * NEXP * 4;
constexpr size_t WS_R1 = WS_XS + (size_t)T * 1024 * 4;
constexpr size_t WS_R2 = WS_R1 + (size_t)T * 3072 * 2;
constexpr size_t WS_H1 = WS_R2 + (size_t)T * 3072 * 2;
constexpr size_t WS_END = WS_H1 + (size_t)T * 1024 * 2;
constexpr size_t SZ_T1K = (size_t)T * 1024 * 2;
constexpr size_t SZ_T512 = (size_t)T * 512 * 2;

struct Params { const float* in[23]; float* out; unsigned char* ws; int ph_lo, ph_hi; };

DI unsigned pk_bf16(float lo, float hi) { f32x2 v = {lo, hi}; return __builtin_bit_cast(unsigned, __builtin_convertvector(v, bf16v2)); }
DI float bf_lo(unsigned w) { return __uint_as_float(w << 16); }
DI float bf_hi(unsigned w) { return __uint_as_float(w & 0xffff0000u); }
DI float bf1(bf16_t b) { return __uint_as_float(((unsigned)b) << 16); }
DI bf16_t f2bf(float f) { return (bf16_t)(pk_bf16(f, 0.f) & 0xffffu); }
DI float gelu_tanh(float x) { const float u = 0.7978845608028654f * (x + 0.044715f * x * x * x); return __fdividef(x, 1.0f + __expf(-2.0f * u)); }
DI float silu_f(float x) { return __fdividef(x, 1.0f + __expf(-x)); }
DI float logsig_f(float z) { return fminf(z, 0.f) - log1pf(expf(-fabsf(z))); }
DI float wave_sum(float v) {
#pragma unroll
    for (int o = 32; o > 0; o >>= 1) v += __shfl_xor(v, o, 64);
    return v;
}
DI float wave_max(float v) {
#pragma unroll
    for (int o = 32; o > 0; o >>= 1) v = fmaxf(v, __shfl_xor(v, o, 64));
    return v;
}
template <int CTRL> DI float dpp_mov(float x) { return __builtin_bit_cast(float, __builtin_amdgcn_mov_dpp(__builtin_bit_cast(int, x), CTRL, 0xf, 0xf, true)); }
DI float reduce4(float p0, float p1, float p2, float p3) {
    const auto a = __builtin_amdgcn_permlane32_swap(__float_as_uint(p0), __float_as_uint(p2), false, false); const float q0 = __uint_as_float(a[0]) + __uint_as_float(a[1]);
    const auto b = __builtin_amdgcn_permlane32_swap(__float_as_uint(p1), __float_as_uint(p3), false, false); const float q1 = __uint_as_float(b[0]) + __uint_as_float(b[1]);
    const auto c = __builtin_amdgcn_permlane16_swap(__float_as_uint(q0), __float_as_uint(q1), false, false); float s = __uint_as_float(c[0]) + __uint_as_float(c[1]);
    s += dpp_mov<0x128>(s); s += dpp_mov<0x124>(s); s += dpp_mov<0x122>(s); s += dpp_mov<0x121>(s);
    return s;
}
DI float dot2bf(unsigned a, unsigned b, float c) { return __builtin_amdgcn_fdot2_f32_bf16(__builtin_bit_cast(bf16v2, a), __builtin_bit_cast(bf16v2, b), c, false); }
DI f32x4 mfma16(bf16x8 a, bf16x8 b, f32x4 c) { return __builtin_amdgcn_mfma_f32_16x16x32_bf16(a, b, c, 0, 0, 0); }
DI bf16x8 frag_ld(const bf16_t* X, int ld, int row0, int k0, int lane) { return *(const bf16x8*)(X + (size_t)(row0 + (lane & 15)) * ld + k0 + 8 * (lane >> 4)); }
DI int mod_batch(int row) { return row < TL ? (row >> 11) : NB; }

DI void grid_barrier(unsigned* ctr, unsigned& target) {
    asm volatile("s_waitcnt vmcnt(0)" ::: "memory");
    __syncthreads();
    target += gridDim.x;
    if (threadIdx.x == 0) {
        __builtin_amdgcn_fence(__ATOMIC_RELEASE, "agent");
        asm volatile("s_waitcnt vmcnt(0)" ::: "memory");
        __hip_atomic_fetch_add(ctr, 1u, __ATOMIC_RELAXED, __HIP_MEMORY_SCOPE_AGENT);
        while (__hip_atomic_load(ctr, __ATOMIC_RELAXED, __HIP_MEMORY_SCOPE_AGENT) < target) __builtin_amdgcn_s_sleep(2);
        __builtin_amdgcn_fence(__ATOMIC_ACQUIRE, "agent");
        asm volatile("s_waitcnt vmcnt(0)" ::: "memory");
    }
    __syncthreads();
}

namespace pg8 {
constexpr int BM = 256, BK = 64, HALF = 128, HTB = HALF * BK * 2, STAGE_BYTES = 8 * HTB, NXCD = 8, WGM = 8;
__host__ __device__ __forceinline__ int lds_byte(int r, int c) { const int st = (r >> 4) * 2 + (c >> 5), rr = r & 15, cc = c & 31, ob = rr * 64 + cc * 2; return st * 1024 + (ob ^ (((ob >> 9) & 1) << 5)); }
__host__ __device__ __forceinline__ void stage_rc(int b, int& R, int& C) { const int st = b / 1024, sb = b % 1024, swz = sb ^ (((sb >> 9) & 1) << 5); R = (st >> 1) * 16 + swz / 64; C = (st & 1) * 32 + (swz % 64) / 2; }
__host__ __device__ __forceinline__ int perm32(int rho) { const int n = rho >> 4, i = rho & 15; return 8 * (i >> 2) + 4 * n + (i & 3); }
struct Unit { int pm, pn; };
struct Gemm { const bf16_t* A; const bf16_t* Bt; int M, N, K; };
struct StaticOrder {
    int nM, nN, nwg, G, c;
    __device__ void init(int M, int N, int G_, int c_) { nM = M / BM; nN = N / BM; nwg = nM * nN; G = G_; c = c_; }
    __device__ bool next(int i, Unit& u) const {
        const long L = (long)i * G + c; if (L >= nwg) return false;
        int wgid = (int)L; { const int q = nwg / NXCD, r = nwg % NXCD, xcd = wgid % NXCD, off = wgid / NXCD; wgid = (xcd < r ? xcd * (q + 1) : r * (q + 1) + (xcd - r) * q) + off; }
        const int nig = WGM * nN, gid = wgid / nig, fm = gid * WGM, gsz = (nM - fm) < WGM ? (nM - fm) : WGM;
        u.pm = fm + ((wgid % nig) % gsz); u.pn = (wgid % nig) / gsz; return true;
    }
};

template <class Epi>
__device__ __forceinline__ void gemm_phase(LAS unsigned char* lds, const Gemm g, const StaticOrder& S, const Epi& E, const int tid) {
    const int wid = __builtin_amdgcn_readfirstlane(tid >> 6), lane = tid & 63, wr = wid >> 2, wc = wid & 3, fr = lane & 15, fq = lane >> 4;
    const int K = g.K, nt = K / BK;
    unsigned voffA[2], voffB[2];
#pragma unroll
    for (int i = 0; i < 2; ++i) { int R, C; stage_rc(tid * 16 + i * 8192, R, C); const int Rb = Epi::PERM ? ((R & ~31) + perm32(R & 31)) : R;
        voffA[i] = (unsigned)(R * K + C) * 2u; voffB[i] = (unsigned)(Rb * K + C) * 2u; }
    const size_t kstep = (size_t)(BK * 2);
    const size_t hstep = (size_t)HALF * K * 2;
    const size_t tstep = 2 * hstep;
    const unsigned ldsw = (unsigned)wid * 1024u;
    const int aoff = lds_byte(wr * 64 + fr, fq * 8), boff = lds_byte(wc * 32 + fr, fq * 8);
#define PG8_SA(b, h) (((b) * 2 + (h)) * HTB)
#define PG8_SB(b, h) ((4 + (b) * 2 + (h)) * HTB)
#define PG8_STAGE(bufoff, gbase, voff) do { _Pragma("unroll") for (int _i = 0; _i < 2; ++_i) \
        __builtin_amdgcn_global_load_lds((const unsigned*)((const char*)(gbase) + (voff)[_i]), (LAS unsigned*)(lds + (bufoff) + ldsw + _i * 8192), 16, 0, 0); } while (0)
#define PG8_LDA(dst, b, h) do { _Pragma("unroll") for (int m = 0; m < 4; ++m) _Pragma("unroll") for (int k = 0; k < 2; ++k) dst[m][k] = *(const LAS bf16x8*)(lds + PG8_SA(b, h) + aoff + m * 2048 + k * 1024); } while (0)
#define PG8_LDB(dst, b, h) do { _Pragma("unroll") for (int n = 0; n < 2; ++n) _Pragma("unroll") for (int k = 0; k < 2; ++k) dst[n][k] = *(const LAS bf16x8*)(lds + PG8_SB(b, h) + boff + n * 2048 + k * 1024); } while (0)
#define PG8_MMA(ai, bj, At, Bt) do { __builtin_amdgcn_s_setprio(1); _Pragma("unroll") for (int m = 0; m < 4; ++m) _Pragma("unroll") for (int n = 0; n < 2; ++n) _Pragma("unroll") for (int k = 0; k < 2; ++k) \
        acc[ai][bj][m][n] = __builtin_amdgcn_mfma_f32_16x16x32_bf16(Bt[n][k], At[m][k], acc[ai][bj][m][n], 0, 0, 0); __builtin_amdgcn_s_setprio(0); } while (0)
#define PG8_WAIT_V(n) asm volatile("s_waitcnt vmcnt(" #n ")" ::: "memory")
#define PG8_WAIT_L(n) asm volatile("s_waitcnt lgkmcnt(" #n ")" ::: "memory")
#define PG8_BAR __builtin_amdgcn_s_barrier()
#define PG8_SCHED __builtin_amdgcn_sched_barrier(0)
    Unit cur, nxt; int ui = 0;
    if (!S.next(0, cur)) return;
    f32x4 acc[2][2][4][2];
#pragma unroll
    for (int a = 0; a < 2; ++a)
#pragma unroll
        for (int b = 0; b < 2; ++b)
#pragma unroll
            for (int m = 0; m < 4; ++m)
#pragma unroll
                for (int n = 0; n < 2; ++n) acc[a][b][m][n] = (f32x4){0.f, 0.f, 0.f, 0.f};
    bf16x8 At[4][2], B0[2][2], B1[2][2];
    const char* cA = (const char*)g.A + (size_t)cur.pm * tstep; const char* cB = (const char*)g.Bt + (size_t)cur.pn * tstep;
    PG8_STAGE(PG8_SB(0, 0), cB, voffB); PG8_STAGE(PG8_SA(0, 0), cA, voffA); PG8_STAGE(PG8_SB(0, 1), cB + hstep, voffB); PG8_STAGE(PG8_SA(0, 1), cA + hstep, voffA);
    if (wr == 1) PG8_BAR;
    PG8_WAIT_V(4); PG8_BAR;
    PG8_STAGE(PG8_SB(1, 0), cB + kstep, voffB); PG8_STAGE(PG8_SA(1, 0), cA + kstep, voffA); PG8_STAGE(PG8_SB(1, 1), cB + hstep + kstep, voffB);
    PG8_WAIT_V(6); PG8_BAR;
    for (;;) {
        const bool has_next = S.next(ui + 1, nxt);
        const char* nA = has_next ? (const char*)g.A + (size_t)nxt.pm * tstep : cA; const char* nB = has_next ? (const char*)g.Bt + (size_t)nxt.pn * tstep : cB;
        for (int t = 0; t < nt; t += 2) {
            const bool last = (t == nt - 2);
            const char* a1 = cA + (size_t)(t + 1) * kstep;
            const char* a2 = last ? nA : cA + (size_t)(t + 2) * kstep; const char* b2 = last ? nB : cB + (size_t)(t + 2) * kstep;
            const char* a3 = a2 + kstep; const char* b3 = b2 + kstep;
            PG8_LDB(B0, 0, 0); PG8_SCHED; PG8_LDA(At, 0, 0); PG8_STAGE(PG8_SA(1, 1), a1 + hstep, voffA);
            PG8_WAIT_L(8); PG8_BAR; PG8_WAIT_L(0); PG8_MMA(0, 0, At, B0); PG8_BAR; PG8_SCHED;
            PG8_LDB(B1, 0, 1); PG8_STAGE(PG8_SB(0, 0), b2, voffB);
            PG8_BAR; PG8_WAIT_L(0); PG8_MMA(0, 1, At, B1); PG8_BAR;
            PG8_LDA(At, 0, 1); PG8_STAGE(PG8_SA(0, 0), a2, voffA);
            PG8_BAR; PG8_WAIT_L(0); PG8_MMA(1, 0, At, B0); PG8_BAR; PG8_SCHED;
            PG8_STAGE(PG8_SB(0, 1), b2 + hstep, voffB);
            PG8_WAIT_V(6); PG8_BAR; PG8_MMA(1, 1, At, B1); PG8_BAR;
            PG8_LDB(B0, 1, 0); PG8_SCHED; PG8_LDA(At, 1, 0); PG8_STAGE(PG8_SA(0, 1), a2 + hstep, voffA);
            PG8_WAIT_L(8); PG8_BAR; PG8_WAIT_L(0); PG8_MMA(0, 0, At, B0); PG8_BAR; PG8_SCHED;
            PG8_LDB(B1, 1, 1); PG8_STAGE(PG8_SB(1, 0), b3, voffB);
            PG8_BAR; PG8_WAIT_L(0); PG8_MMA(0, 1, At, B1); PG8_BAR;
            PG8_LDA(At, 1, 1); PG8_STAGE(PG8_SA(1, 0), a3, voffA);
            PG8_BAR; PG8_WAIT_L(0); PG8_MMA(1, 0, At, B0); PG8_BAR; PG8_SCHED;
            PG8_STAGE(PG8_SB(1, 1), b3 + hstep, voffB);
            PG8_WAIT_V(6); PG8_BAR; PG8_MMA(1, 1, At, B1); PG8_BAR;
        }
        E(acc, cur, wr, wc, fr, fq);
        if (!has_next) break;
#pragma unroll
        for (int a = 0; a < 2; ++a)
#pragma unroll
            for (int b = 0; b < 2; ++b)
#pragma unroll
                for (int m = 0; m < 4; ++m)
#pragma unroll
                    for (int n = 0; n < 2; ++n) acc[a][b][m][n] = (f32x4){0.f, 0.f, 0.f, 0.f};
        cur = nxt; cA = nA; cB = nB; ++ui;
    }
    PG8_WAIT_V(0);
    if (wr == 0) PG8_BAR;
    PG8_BAR;
#undef PG8_SA
#undef PG8_SB
#undef PG8_STAGE
#undef PG8_LDA
#undef PG8_LDB
#undef PG8_MMA
#undef PG8_WAIT_V
#undef PG8_WAIT_L
#undef PG8_BAR
#undef PG8_SCHED
}

template <int ACT  > struct EpiBf16 {
    static constexpr bool PERM = true;
    bf16_t* O; int ldc;
    __device__ __forceinline__ void operator()(const f32x4 (&acc)[2][2][4][2], const Unit& u, int wr, int wc, int fr, int fq) const {
        const int row0 = u.pm * BM + wr * 64 + fr, col0 = u.pn * BM + wc * 32 + 8 * fq;
#pragma unroll
        for (int ai = 0; ai < 2; ++ai)
#pragma unroll
            for (int m = 0; m < 4; ++m) { bf16_t* rowp = O + (size_t)(row0 + ai * HALF + m * 16) * ldc + col0;
#pragma unroll
                for (int bj = 0; bj < 2; ++bj) { f32x4 v0 = acc[ai][bj][m][0], v1 = acc[ai][bj][m][1];
                    if (ACT == 1) {
#pragma unroll
                        for (int j = 0; j < 4; ++j) { v0[j] = gelu_tanh(v0[j]); v1[j] = gelu_tanh(v1[j]); } }
                    u32x4 w; w.x = pk_bf16(v0[0], v0[1]); w.y = pk_bf16(v0[2], v0[3]); w.z = pk_bf16(v1[0], v1[1]); w.w = pk_bf16(v1[2], v1[3]);
                    *(u32x4*)(rowp + bj * HALF) = w; } }
    }
};
struct EpiRes {
    static constexpr bool PERM = false;
    const float* src_lat; const float* src_ctx; float* dst; const float* modL; int gate_idx;
    __device__ __forceinline__ void operator()(const f32x4 (&acc)[2][2][4][2], const Unit& u, int wr, int wc, int fr, int fq) const {
        const bool isctx = u.pm >= (TL / BM);
        const float* sb = isctx ? src_ctx + (size_t)(u.pm - TL / BM) * BM * D : src_lat + (size_t)u.pm * BM * D;
        const int mb = isctx ? NB : (u.pm >> 3);
        const float* gv = modL + (size_t)mb * 6144 + gate_idx * 1024;
        const int rl = wr * 64 + fr, col0 = u.pn * BM + wc * 32 + 4 * fq;
        f32x4 g[2][2];
#pragma unroll
        for (int bj = 0; bj < 2; ++bj)
#pragma unroll
            for (int n = 0; n < 2; ++n) g[bj][n] = *(const f32x4*)(gv + col0 + bj * HALF + n * 16);
#pragma unroll
        for (int ai = 0; ai < 2; ++ai)
#pragma unroll
            for (int m = 0; m < 4; ++m) { const int r = rl + ai * HALF + m * 16; const float* sp = sb + (size_t)r * D + col0; float* dp = dst + ((size_t)u.pm * BM + r) * D + col0;
#pragma unroll
                for (int bj = 0; bj < 2; ++bj)
#pragma unroll
                    for (int n = 0; n < 2; ++n) { const f32x4 x = *(const f32x4*)(sp + bj * HALF + n * 16); *(f32x4*)(dp + bj * HALF + n * 16) = x * DN_ALPHA + g[bj][n] * acc[ai][bj][m][n]; } }
    }
};
struct EpiGlaProj {
    static constexpr bool PERM = true;
    bf16_t* QG; bf16_t* KG; bf16_t* VG; bf16_t* RG; float* GL;
    __device__ __forceinline__ void operator()(const f32x4 (&acc)[2][2][4][2], const Unit& u, int wr, int wc, int fr, int fq) const {
        const int row0 = u.pm * BM + wr * 64 + fr, pn = u.pn;
        if (pn < 12) {
            bf16_t* base; int ld, colt; float sc = 1.f;
            if (pn < 2) { base = QG; ld = 512; colt = pn * BM; sc = 0.08838834764831845f; }
            else if (pn < 4) { base = KG; ld = 512; colt = (pn - 2) * BM; }
            else if (pn < 8) { base = VG; ld = 1024; colt = (pn - 4) * BM; }
            else { base = RG; ld = 1024; colt = (pn - 8) * BM; }
            const int col0 = colt + wc * 32 + 8 * fq;
#pragma unroll
            for (int ai = 0; ai < 2; ++ai)
#pragma unroll
                for (int m = 0; m < 4; ++m) { bf16_t* rowp = base + (size_t)(row0 + ai * HALF + m * 16) * ld + col0;
#pragma unroll
                    for (int bj = 0; bj < 2; ++bj) { const f32x4 v0 = acc[ai][bj][m][0] * sc, v1 = acc[ai][bj][m][1] * sc;
                        u32x4 w; w.x = pk_bf16(v0[0], v0[1]); w.y = pk_bf16(v0[2], v0[3]); w.z = pk_bf16(v1[0], v1[1]); w.w = pk_bf16(v1[2], v1[3]);
                        *(u32x4*)(rowp + bj * HALF) = w; } }
        } else if (wc == 0) {
#pragma unroll
            for (int ai = 0; ai < 2; ++ai)
#pragma unroll
                for (int m = 0; m < 4; ++m) { float* gp = GL + (size_t)(row0 + ai * HALF + m * 16) * 32 + 8 * fq;
                    *(f32x4*)gp = acc[ai][0][m][0]; *(f32x4*)(gp + 4) = acc[ai][0][m][1]; }
        }
    }
};
}

struct Ctx {
    const Params* p; unsigned char* ws; unsigned char* smem; int tid, lane, wave, G, bid;
};

DI void phase_prologue(const Ctx& c) {
    const Params& p = *c.p; unsigned char* ws = c.ws;
    const int tid = c.tid;
    constexpr int N_MOD = 192, N_TR = 4736, N_WS = 64, N_TAB = 2048;
    constexpr int N_ALL = N_MOD + N_TR + N_WS + N_TAB;
    for (int u = c.bid; u < N_ALL; u += c.G) {
        if (u < N_MOD) {
            const int l = u / 48, n0 = (u % 48) * 128;
            float* sc = (float*)c.smem;
            float* red = (float*)(c.smem + 17 * 1024 * 4);
            __syncthreads();
            for (int i = tid; i < 17 * 1024; i += NTHR) { const int b = i >> 10, k = i & 1023; const float v = (b < NB) ? p.in[1][b * 1024 + k] : p.in[3][k]; sc[i] = silu_f(v); }
            __syncthreads();
            const int c4 = (tid & 31) * 4, kg = tid >> 5;
            float acc[17][4];
#pragma unroll
            for (int b = 0; b < 17; ++b) { acc[b][0] = 0.f; acc[b][1] = 0.f; acc[b][2] = 0.f; acc[b][3] = 0.f; }
            const float* wp = p.in[4] + ((size_t)l * 1024 + (size_t)kg * 64) * 6144 + n0 + c4;
#pragma unroll 4
            for (int kk = 0; kk < 64; ++kk) {
                const f32x4 w = *(const f32x4*)(wp + (size_t)kk * 6144);
                const int k = kg * 64 + kk;
#pragma unroll
                for (int b = 0; b < 17; ++b) { const float s = sc[b * 1024 + k]; acc[b][0] += s * w[0]; acc[b][1] += s * w[1]; acc[b][2] += s * w[2]; acc[b][3] += s * w[3]; }
            }
#pragma unroll
            for (int b = 0; b < 17; ++b)
#pragma unroll
                for (int j = 0; j < 4; ++j) acc[b][j] += __shfl_xor(acc[b][j], 32, 64);
            if ((tid & 32) == 0) {
#pragma unroll
                for (int b = 0; b < 17; ++b)
#pragma unroll
                    for (int j = 0; j < 4; ++j) red[(c.wave * 17 + b) * 128 + c4 + j] = acc[b][j];
            }
            __syncthreads();
            for (int o = tid; o < 17 * 128; o += NTHR) { const int b = o >> 7, n = o & 127; float s = 0.f;
#pragma unroll
                for (int w = 0; w < 8; ++w) s += red[(w * 17 + b) * 128 + n];
                ((float*)(ws + WS_MOD))[((size_t)l * 17 + b) * 6144 + n0 + n] = s + p.in[5][l * 6144 + n0 + n]; }
        } else if (u < N_MOD + N_TR) {
            int v = u - N_MOD; const float* src; bf16_t* dst; int N, Npad;
            if (v < 1024) { const int j = v / 512; v %= 512; src = p.in[8] + (size_t)j * 1024 * 2048; dst = (bf16_t*)(ws + WS_WAIN) + (size_t)j * 2048 * 1024; N = 2048; Npad = 2048; }
            else if (v < 1536) { v -= 1024; const int j = v / 256; v %= 256; src = p.in[13] + (size_t)j * 1024 * 1024; dst = (bf16_t*)(ws + WS_WAOUT) + (size_t)j * 1024 * 1024; N = 1024; Npad = 1024; }
            else if (v < 3200) { v -= 1536; const int j = v / 832; v %= 832; src = p.in[14] + (size_t)j * 1024 * 3104; dst = (bf16_t*)(ws + WS_WBIN) + (size_t)j * WBIN_N * 1024; N = 3104; Npad = WBIN_N; }
            else if (v < 3712) { v -= 3200; const int j = v / 256; v %= 256; src = p.in[18] + (size_t)j * 1024 * 1024; dst = (bf16_t*)(ws + WS_WBOUT) + (size_t)j * 1024 * 1024; N = 1024; Npad = 1024; }
            else { v -= 3712; const int j = v / 256; v %= 256; src = p.in[19] + (size_t)j * 1024 * 1024; dst = (bf16_t*)(ws + WS_WQ) + (size_t)j * 1024 * 1024; N = 1024; Npad = 1024; }
            (void)Npad;
            const int ntn = v >> 4, ktile = v & 15, n0 = ntn * 64, k0 = ktile * 64;
            float* tl = (float*)c.smem;
            __syncthreads();
#pragma unroll
            for (int i = 0; i < 2; ++i) { const int kk = (tid >> 4) + 32 * i, nn = (tid & 15) * 4;
                f32x4 x = {0.f, 0.f, 0.f, 0.f};
                if (n0 + nn < N) x = *(const f32x4*)(src + (size_t)(k0 + kk) * N + n0 + nn);
                tl[kk * 65 + nn] = x[0]; tl[kk * 65 + nn + 1] = x[1]; tl[kk * 65 + nn + 2] = x[2]; tl[kk * 65 + nn + 3] = x[3]; }
            __syncthreads();
            { const int nn = tid >> 3, kk8 = (tid & 7) * 8; float x[8];
#pragma unroll
              for (int j = 0; j < 8; ++j) x[j] = tl[(kk8 + j) * 65 + nn];
              u32x4 w; w.x = pk_bf16(x[0], x[1]); w.y = pk_bf16(x[2], x[3]); w.z = pk_bf16(x[4], x[5]); w.w = pk_bf16(x[6], x[7]);
              *(u32x4*)(dst + (size_t)(n0 + nn) * 1024 + k0 + kk8) = w; }
        } else if (u < N_MOD + N_TR + N_WS) {
            const int v = u - N_MOD - N_TR; const size_t e = (size_t)v * 4096 + (size_t)tid * 8;
            const f32x4 a = *(const f32x4*)(p.in[11] + e), b = *(const f32x4*)(p.in[11] + e + 4);
            u32x4 w; w.x = pk_bf16(a[0], a[1]); w.y = pk_bf16(a[2], a[3]); w.z = pk_bf16(b[0], b[1]); w.w = pk_bf16(b[2], b[3]);
            *(u32x4*)((bf16_t*)(ws + WS_WSB) + e) = w;
        } else {
            const int v = u - N_MOD - N_TR - N_WS; const int tab = v >> 10;
            const float* src = p.in[21 + tab]; unsigned char* dst = ws + (tab ? WS_VT : WS_UT); float* sc = (float*)(ws + (tab ? WS_SV : WS_SU));
#pragma unroll 2
            for (int i = 0; i < 8; ++i) { const size_t row = (size_t)(v & 1023) * 64 + c.wave * 8 + i;
                const float* rp = src + row * 1024 + 16 * c.lane; f32x4 x[4]; float am = 0.f;
#pragma unroll
                for (int q = 0; q < 4; ++q) { x[q] = __builtin_nontemporal_load((const f32x4*)(rp + 4 * q)); am = fmaxf(am, fmaxf(fmaxf(fabsf(x[q][0]), fabsf(x[q][1])), fmaxf(fabsf(x[q][2]), fabsf(x[q][3])))); }
                am = fmaxf(wave_max(am), 1e-30f);
                const float inv = 440.0f / am; u32x4 w;
#pragma unroll
                for (int q = 0; q < 4; ++q) { int t = 0; t = __builtin_amdgcn_cvt_pk_fp8_f32(x[q][0] * inv, x[q][1] * inv, t, false); t = __builtin_amdgcn_cvt_pk_fp8_f32(x[q][2] * inv, x[q][3] * inv, t, true); w[q] = (unsigned)t; }
                *(u32x4*)(dst + row * 1024 + 16 * c.lane) = w;
                if (c.lane == 0) sc[row] = am * (1.0f / 440.0f); }
        }
    }
}

DI void phase_mod0(const Ctx& c) {
    const Params& p = *c.p; const float* MOD = (const float*)(c.ws + WS_MOD); bf16_t* H1 = (bf16_t*)(c.ws + WS_H1);
    for (int row = c.bid * NWAVE + c.wave; row < T; row += c.G * NWAVE) {
        const float* src = row < TL ? p.in[0] + (size_t)row * D : p.in[2] + (size_t)(row - TL) * D;
        const float* m = MOD + (size_t)mod_batch(row) * 6144;
#pragma unroll
        for (int j = 0; j < 4; ++j) { const int col = 4 * c.lane + 256 * j;
            const f32x4 x = *(const f32x4*)(src + col), sh = *(const f32x4*)(m + col), s = *(const f32x4*)(m + 1024 + col);
            const f32x4 h = x * (s + 1.0f) + sh; u32x2 w; w.x = pk_bf16(h[0], h[1]); w.y = pk_bf16(h[2], h[3]);
            *(u32x2*)(H1 + (size_t)row * D + col) = w; }
    }
}

DI void phase_vstats(const Ctx& c) {
    const bf16_t* UV = (const bf16_t*)(c.ws + WS_R1); float* ST = (float*)(c.ws + WS_STATS);
    for (int row = c.bid * NWAVE + c.wave; row < T; row += c.G * NWAVE) {
        const bf16_t* vp = UV + (size_t)row * 2048 + 1024;
        const u32x4 a = *(const u32x4*)(vp + 8 * c.lane), b = *(const u32x4*)(vp + 512 + 8 * c.lane);
        float x[16];
#pragma unroll
        for (int j = 0; j < 4; ++j) { x[2 * j] = bf_lo(a[j]); x[2 * j + 1] = bf_hi(a[j]); x[8 + 2 * j] = bf_lo(b[j]); x[9 + 2 * j] = bf_hi(b[j]); }
        float s = 0.f;
#pragma unroll
        for (int j = 0; j < 16; ++j) s += x[j];
        const float mean = wave_sum(s) * (1.0f / 1024.0f);
        float q = 0.f;
#pragma unroll
        for (int j = 0; j < 16; ++j) { const float d = x[j] - mean; q += d * d; }
        const float var = wave_sum(q) * (1.0f / 1024.0f);
        if (c.lane == 0) { ST[2 * row] = mean; ST[2 * row + 1] = rsqrtf(var + LN_EPS); }
    }
}

DI void phase_spatial(const Ctx& c, int j) {
    const Params& p = *c.p; unsigned char* ws = c.ws;
    const bf16_t* UV = (const bf16_t*)(ws + WS_R1); const float* ST = (const float*)(ws + WS_STATS); bf16_t* Y = (bf16_t*)(ws + WS_R2);
    const bf16_t* WSB = (const bf16_t*)(ws + WS_WSB) + (size_t)j * 8 * 128 * 128;
    const float* ng = p.in[9] + j * 1024; const float* nb = p.in[10] + j * 1024; const float* bs = p.in[12] + j * 8 * 128;
    constexpr int LD = 136;
    bf16_t* WsL = (bf16_t*)c.smem;
    bf16_t* VnT = WsL + 128 * LD;
    const int tid = c.tid, lane = c.lane, w = c.wave, g = lane >> 4, cc = lane & 15;
    for (int u = c.bid; u < (T / 128) * 8; u += c.G) {
        const int chunk = u >> 3, h = u & 7, r0 = chunk * 128;
        __syncthreads();
        { const int cg8 = tid & 15; float gg[8], bb[8];
#pragma unroll
          for (int e = 0; e < 8; ++e) { gg[e] = ng[h * 128 + cg8 * 8 + e]; bb[e] = nb[h * 128 + cg8 * 8 + e]; }
#pragma unroll
          for (int i = 0; i < 4; ++i) { const int idx = i * 512 + tid, tok = idx >> 4;
              const u32x4 v = *(const u32x4*)(UV + (size_t)(r0 + tok) * 2048 + 1024 + h * 128 + cg8 * 8);
              const float mean = ST[2 * (r0 + tok)], rstd = ST[2 * (r0 + tok) + 1];
              float x[8];
#pragma unroll
              for (int e = 0; e < 4; ++e) { x[2 * e] = bf_lo(v[e]); x[2 * e + 1] = bf_hi(v[e]); }
#pragma unroll
              for (int e = 0; e < 8; ++e) VnT[(cg8 * 8 + e) * LD + tok] = f2bf((x[e] - mean) * rstd * gg[e] + bb[e]);
              const int pp = idx >> 4;
              *(u32x4*)(WsL + pp * LD + cg8 * 8) = *(const u32x4*)(WSB + ((size_t)h * 128 + pp) * 128 + cg8 * 8); } }
        __syncthreads();
        f32x4 acc[8];
#pragma unroll
        for (int ct = 0; ct < 8; ++ct) acc[ct] = (f32x4){0.f, 0.f, 0.f, 0.f};
#pragma unroll
        for (int ks = 0; ks < 4; ++ks) {
            const bf16x8 bfr = frag_ld(WsL, LD, 16 * w, 32 * ks, lane);
#pragma unroll
            for (int ct = 0; ct < 8; ++ct) acc[ct] = mfma16(frag_ld(VnT, LD, 16 * ct, 32 * ks, lane), bfr, acc[ct]);
        }
        const int pp = 16 * w + cc; const float bsv = bs[h * 128 + pp];
        const size_t rowo = (size_t)(r0 + pp);
#pragma unroll
        for (int ct = 0; ct < 8; ++ct) { const int ch = h * 128 + 16 * ct + 4 * g;
            const u32x2 uu = *(const u32x2*)(UV + rowo * 2048 + ch);
            const float y0 = bf_lo(uu.x) * (acc[ct][0] + bsv), y1 = bf_hi(uu.x) * (acc[ct][1] + bsv), y2 = bf_lo(uu.y) * (acc[ct][2] + bsv), y3 = bf_hi(uu.y) * (acc[ct][3] + bsv);
            u32x2 o; o.x = pk_bf16(y0, y1); o.y = pk_bf16(y2, y3);
            *(u32x2*)(Y + rowo * D + ch) = o; }
    }
}

DI void phase_ln1(const Ctx& c, int L) {
    const Params& p = *c.p; float* XS = (float*)(c.ws + WS_XS); const float* MOD = (const float*)(c.ws + WS_MOD) + (size_t)L * 17 * 6144;
    bf16_t* H2 = (bf16_t*)(c.ws + WS_R2 + SZ_T1K);
    const float* lg = p.in[6] + (size_t)(L * 2 + 0) * D; const float* lb = p.in[7] + (size_t)(L * 2 + 0) * D;
    for (int row = c.bid * NWAVE + c.wave; row < T; row += c.G * NWAVE) {
        float* xp = XS + (size_t)row * D; const float* m = MOD + (size_t)mod_batch(row) * 6144;
        f32x4 x[4]; float s = 0.f;
#pragma unroll
        for (int j = 0; j < 4; ++j) { x[j] = *(const f32x4*)(xp + 4 * c.lane + 256 * j); s += (x[j][0] + x[j][1]) + (x[j][2] + x[j][3]); }
        const float mean = wave_sum(s) * (1.0f / 1024.0f);
        float q = 0.f;
#pragma unroll
        for (int j = 0; j < 4; ++j) { const f32x4 d = x[j] - mean; q += (d[0] * d[0] + d[1] * d[1]) + (d[2] * d[2] + d[3] * d[3]); }
        const float rstd = rsqrtf(wave_sum(q) * (1.0f / 1024.0f) + LN_EPS);
#pragma unroll
        for (int j = 0; j < 4; ++j) { const int col = 4 * c.lane + 256 * j;
            const f32x4 y = (x[j] - mean) * rstd * *(const f32x4*)(lg + col) + *(const f32x4*)(lb + col);
            *(f32x4*)(xp + col) = y;
            const f32x4 h = y * (*(const f32x4*)(m + 4 * 1024 + col) + 1.0f) + *(const f32x4*)(m + 3 * 1024 + col);
            u32x2 w; w.x = pk_bf16(h[0], h[1]); w.y = pk_bf16(h[2], h[3]);
            *(u32x2*)(H2 + (size_t)row * D + col) = w; }
    }
}

DI int f2key(float v) { const int i = __float_as_int(v); return i ^ ((i >> 31) & 0x7fffffff); }
DI float key2f(int k) { return __int_as_float(k ^ ((k >> 31) & 0x7fffffff)); }
DI void top16_half(const float* kh  , const bf16_t* q64, int (&t)[16]) {
    float q[64];
#pragma unroll
    for (int i = 0; i < 8; ++i) { const u32x4 v = *(const u32x4*)(q64 + 8 * i);
#pragma unroll
        for (int e = 0; e < 4; ++e) { q[8 * i + 2 * e] = bf_lo(v[e]); q[8 * i + 2 * e + 1] = bf_hi(v[e]); } }
#pragma unroll
    for (int i = 0; i < 16; ++i) t[i] = (int)0x80000000;
    for (int k = 0; k < 128; ++k) {
        const float* kr = kh + k * 64;
        float s0 = 0.f, s1 = 0.f, s2 = 0.f, s3 = 0.f;
#pragma unroll
        for (int d = 0; d < 64; d += 4) { const f32x4 kv = *(const f32x4*)(kr + d); s0 += q[d] * kv[0]; s1 += q[d + 1] * kv[1]; s2 += q[d + 2] * kv[2]; s3 += q[d + 3] * kv[3]; }
        int key = (f2key((s0 + s1) + (s2 + s3)) & ~127) | (127 - k);
#pragma unroll
        for (int i = 0; i < 16; ++i) { const int hi = max(key, t[i]); key = min(key, t[i]); t[i] = hi; }
    }
}
DI void phase_route(const Ctx& c, int L) {
    const Params& p = *c.p; unsigned char* ws = c.ws;
    float* keys = (float*)c.smem;
    unsigned* ilist = (unsigned*)(c.smem + 65536);
    __syncthreads();
    { const float* gk = p.in[20] + (size_t)L * 2 * 128 * 64;
      for (int i = c.tid; i < 2 * 128 * 64 / 4; i += NTHR) ((f32x4*)keys)[i] = ((const f32x4*)gk)[i]; }
    __syncthreads();
    const bf16_t* QP = (const bf16_t*)(ws + WS_R1); int* IDX = (int*)(ws + WS_R1 + SZ_T1K); float* WT = (float*)(ws + WS_R1 + SZ_T1K + (size_t)T * 128 * 4);
    unsigned* myl = ilist + c.tid * 8; const unsigned char* mylb = (const unsigned char*)myl;
    for (int task = c.bid * NWAVE + c.wave; task < T * 8 / 64; task += c.G * NWAVE) {
        const int item = task * 64 + c.lane, tok = item >> 3, h = item & 7;
        const bf16_t* qp = QP + (size_t)tok * D + h * 128;
        int t1[16], t2[16];
        top16_half(keys, qp, t1);
        top16_half(keys + 128 * 64, qp + 64, t2);
        float v1[16], v2[16];
#pragma unroll
        for (int i = 0; i < 16; ++i) { v1[i] = key2f(t1[i] & ~127); v2[i] = key2f(t2[i] & ~127); }
#pragma unroll
        for (int i = 0; i < 4; ++i) {
            myl[i] = (unsigned)(127 - (t1[4 * i] & 127)) | ((unsigned)(127 - (t1[4 * i + 1] & 127)) << 8) | ((unsigned)(127 - (t1[4 * i + 2] & 127)) << 16) | ((unsigned)(127 - (t1[4 * i + 3] & 127)) << 24);
            myl[4 + i] = (unsigned)(127 - (t2[4 * i] & 127)) | ((unsigned)(127 - (t2[4 * i + 1] & 127)) << 8) | ((unsigned)(127 - (t2[4 * i + 2] & 127)) << 16) | ((unsigned)(127 - (t2[4 * i + 3] & 127)) << 24); }
        int f[16];
#pragma unroll
        for (int i = 0; i < 16; ++i) f[i] = (int)0x80000000;
#pragma unroll
        for (int a = 0; a < 16; ++a)
#pragma unroll
            for (int b = 0; b < 16; ++b)
                if ((a + 1) * (b + 1) <= 16) {
                    int key = (f2key(v1[a] + v2[b]) & ~255) | (255 - (a * 16 + b));
#pragma unroll
                    for (int i = 0; i < 16; ++i) { const int hi = max(key, f[i]); key = min(key, f[i]); f[i] = hi; }
                }
        float e[16], se = 0.f; int fi[16];
        const float vmax = key2f(f[0] & ~255);
#pragma unroll
        for (int i = 0; i < 16; ++i) { const int code = 255 - (f[i] & 255); fi[i] = (int)mylb[code >> 4] * 128 + (int)mylb[16 + (code & 15)];
            e[i] = __expf(key2f(f[i] & ~255) - vmax); se += e[i]; }
        const float inv = 1.0f / se;
        int* ip = IDX + (size_t)tok * 128 + h * 16; float* wp = WT + (size_t)tok * 128 + h * 16;
#pragma unroll
        for (int i = 0; i < 16; i += 4) { *(int4*)(ip + i) = make_int4(fi[i], fi[i + 1], fi[i + 2], fi[i + 3]); *(f32x4*)(wp + i) = (f32x4){e[i] * inv, e[i + 1] * inv, e[i + 2] * inv, e[i + 3] * inv}; }
    }
}

DI void phase_experts(const Ctx& c, int L) {
    const Params& p = *c.p; unsigned char* ws = c.ws; const int lane = c.lane;
    const bf16_t* H2 = (const bf16_t*)(ws + WS_R2 + SZ_T1K);
    const int* IDX = (const int*)(ws + WS_R1 + SZ_T1K); const float* WT = (const float*)(ws + WS_R1 + SZ_T1K + (size_t)T * 128 * 4);
    const unsigned char* UT = ws + WS_UT + (size_t)L * NEXP * 1024; const unsigned char* VT = ws + WS_VT + (size_t)L * NEXP * 1024;
    const float* SU = (const float*)(ws + WS_SU) + (size_t)L * NEXP; const float* SV = (const float*)(ws + WS_SV) + (size_t)L * NEXP;
    float* XS = (float*)(ws + WS_XS); bf16_t* H1 = (bf16_t*)(ws + WS_H1);
    const float* MOD = (const float*)(ws + WS_MOD) + (size_t)L * 17 * 6144;
    const float* lg = p.in[6] + (size_t)(L * 2 + 1) * D; const float* lb = p.in[7] + (size_t)(L * 2 + 1) * D;
    const int nrows = (L == DEPTH - 1) ? TL : T;
    for (int row = c.bid * NWAVE + c.wave; row < nrows; row += c.G * NWAVE) {
        f32x2 xf[8];
        { const u32x4 xa = *(const u32x4*)(H2 + (size_t)row * D + 16 * lane), xb = *(const u32x4*)(H2 + (size_t)row * D + 16 * lane + 8);
#pragma unroll
          for (int j = 0; j < 4; ++j) { xf[j] = (f32x2){bf_lo(xa[j]), bf_hi(xa[j])}; xf[4 + j] = (f32x2){bf_lo(xb[j]), bf_hi(xb[j])}; } }
        int idv[2]; float wv[2], suv[2], svv[2], act[2];
#pragma unroll
        for (int hh = 0; hh < 2; ++hh) { idv[hh] = IDX[(size_t)row * 128 + 64 * hh + lane]; wv[hh] = WT[(size_t)row * 128 + 64 * hh + lane]; }
#pragma unroll
        for (int hh = 0; hh < 2; ++hh) { suv[hh] = SU[idv[hh]]; svv[hh] = SV[idv[hh]]; }
#pragma unroll
        for (int hh = 0; hh < 2; ++hh) {
            float zz = 0.f;
            for (int e0 = 0; e0 < 64; e0 += 16) {
                u32x4 r[16];
#pragma unroll
                for (int k = 0; k < 16; ++k) { const int ex = __builtin_amdgcn_readlane(idv[hh], e0 + k); r[k] = *(const u32x4*)(UT + (size_t)ex * 1024 + 16 * lane); }
                float pp[16];
#pragma unroll
                for (int k = 0; k < 16; ++k) { f32x2 acc = {0.f, 0.f};
#pragma unroll
                    for (int j = 0; j < 4; ++j) { acc += __builtin_amdgcn_cvt_pk_f32_fp8((int)r[k][j], false) * xf[2 * j]; acc += __builtin_amdgcn_cvt_pk_f32_fp8((int)r[k][j], true) * xf[2 * j + 1]; }
                    pp[k] = acc[0] + acc[1]; }
                const int rel = lane - e0;
#pragma unroll
                for (int g4 = 0; g4 < 4; ++g4) { const float sred = reduce4(pp[4 * g4], pp[4 * g4 + 1], pp[4 * g4 + 2], pp[4 * g4 + 3]);
#pragma unroll
                    for (int R = 0; R < 4; ++R) { const float z = __int_as_float(__builtin_amdgcn_readlane(__float_as_int(sred), 16 * R)); zz = (rel == 4 * g4 + R) ? z : zz; } }
            }
            act[hh] = gelu_tanh(zz * suv[hh]) * wv[hh] * svv[hh];
        }
        f32x2 o[8];
#pragma unroll
        for (int j = 0; j < 8; ++j) o[j] = (f32x2){0.f, 0.f};
#pragma unroll
        for (int hh = 0; hh < 2; ++hh) {
            for (int e0 = 0; e0 < 64; e0 += 16) {
                u32x4 r[16];
#pragma unroll
                for (int k = 0; k < 16; ++k) { const int ex = __builtin_amdgcn_readlane(idv[hh], e0 + k); r[k] = *(const u32x4*)(VT + (size_t)ex * 1024 + 16 * lane); }
#pragma unroll
                for (int k = 0; k < 16; ++k) { const float a = __int_as_float(__builtin_amdgcn_readlane(__float_as_int(act[hh]), e0 + k)); const f32x2 a2 = {a, a};
#pragma unroll
                    for (int j = 0; j < 4; ++j) { o[2 * j] += a2 * __builtin_amdgcn_cvt_pk_f32_fp8((int)r[k][j], false); o[2 * j + 1] += a2 * __builtin_amdgcn_cvt_pk_f32_fp8((int)r[k][j], true); } }
            }
        }
        float* xp = XS + (size_t)row * D + 16 * lane; const int mb = mod_batch(row); const float* m = MOD + (size_t)mb * 6144 + 16 * lane;
        float y[16]; float s = 0.f;
#pragma unroll
        for (int qd = 0; qd < 4; ++qd) { const f32x4 x1 = *(const f32x4*)(xp + 4 * qd), g2 = *(const f32x4*)(m + 5 * 1024 + 4 * qd);
            y[4 * qd] = DN_ALPHA * x1[0] + g2[0] * o[2 * qd][0]; y[4 * qd + 1] = DN_ALPHA * x1[1] + g2[1] * o[2 * qd][1];
            y[4 * qd + 2] = DN_ALPHA * x1[2] + g2[2] * o[2 * qd + 1][0]; y[4 * qd + 3] = DN_ALPHA * x1[3] + g2[3] * o[2 * qd + 1][1];
            s += (y[4 * qd] + y[4 * qd + 1]) + (y[4 * qd + 2] + y[4 * qd + 3]); }
        const float mean = wave_sum(s) * (1.0f / 1024.0f);
        float q = 0.f;
#pragma unroll
        for (int j = 0; j < 16; ++j) { const float d = y[j] - mean; q += d * d; }
        const float rstd = rsqrtf(wave_sum(q) * (1.0f / 1024.0f) + LN_EPS);
        const float* mn = (const float*)(ws + WS_MOD) + (size_t)(L + 1 < DEPTH ? L + 1 : L) * 17 * 6144 + (size_t)mb * 6144 + 16 * lane;
#pragma unroll
        for (int qd = 0; qd < 4; ++qd) { const int col = 16 * lane + 4 * qd;
            const f32x4 gg = *(const f32x4*)(lg + col), bb = *(const f32x4*)(lb + col); f32x4 x2;
#pragma unroll
            for (int j = 0; j < 4; ++j) x2[j] = (y[4 * qd + j] - mean) * rstd * gg[j] + bb[j];
            if (L == DEPTH - 1) { *(f32x4*)(p.out + (size_t)row * D + col) = x2; }
            else { *(f32x4*)(xp + 4 * qd) = x2;
                const f32x4 h = x2 * (*(const f32x4*)(mn + 1024 + 4 * qd) + 1.0f) + *(const f32x4*)(mn + 4 * qd);
                u32x2 w; w.x = pk_bf16(h[0], h[1]); w.y = pk_bf16(h[2], h[3]);
                *(u32x2*)(H1 + (size_t)row * D + col) = w; } }
    }
}

DI void phase_gla_prep(const Ctx& c, int j) {
    const Params& p = *c.p; unsigned char* ws = c.ws; const int tid = c.tid;
    const bf16_t* QG = (const bf16_t*)(ws + WS_R1); const bf16_t* KG = (const bf16_t*)(ws + WS_R1 + SZ_T512);
    const float* GL = (const float*)(ws + WS_GL); float* DEC = (float*)(ws + WS_DEC);
    float* gl = (float*)c.smem;
    for (int ch = c.bid; ch < T / 64; ch += c.G) {
        const int r0 = ch * 64;
        __syncthreads();
        for (int i = tid; i < 64 * 32 / 4; i += NTHR) ((f32x4*)gl)[i] = ((const f32x4*)(GL + (size_t)r0 * 32))[i];
        __syncthreads();
#pragma unroll
        for (int dir = 0; dir < 2; ++dir) {
            float wg[16];
#pragma unroll
            for (int r = 0; r < 16; ++r) wg[r] = p.in[15][((size_t)(j * 2 + dir) * 16 + r) * 512 + tid];
            const float bias = p.in[16][(size_t)(j * 2 + dir) * 512 + tid];
            float total = 0.f;
            for (int i = 0; i < 64; ++i) { float z = bias;
#pragma unroll
                for (int r = 0; r < 16; ++r) z += gl[i * 32 + dir * 16 + r] * wg[r];
                total += logsig_f(z) * (1.0f / 16.0f); }
            DEC[((size_t)dir * (T / 64) + ch) * 512 + tid] = expf(total);
            bf16_t* QIN = (bf16_t*)(ws + WS_R2) + (size_t)dir * T * 512; bf16_t* KIN = (bf16_t*)(ws + WS_R2 + SZ_T1K) + (size_t)dir * T * 512; bf16_t* KEND = (bf16_t*)(ws + WS_R2 + 2 * SZ_T1K) + (size_t)dir * T * 512;
            float cum = 0.f;
            for (int ii = 0; ii < 64; ++ii) { const int i = dir ? 63 - ii : ii; float z = bias;
#pragma unroll
                for (int r = 0; r < 16; ++r) z += gl[i * 32 + dir * 16 + r] * wg[r];
                cum += logsig_f(z) * (1.0f / 16.0f);
                const size_t o = (size_t)(r0 + i) * 512 + tid;
                const float qv = bf1(QG[o]), kv = bf1(KG[o]);
                QIN[o] = f2bf(qv * expf(cum)); KIN[o] = f2bf(kv * expf(-cum)); KEND[o] = f2bf(kv * expf(total - cum)); }
        }
    }
}

DI void phase_gla_scan(const Ctx& c) {
    unsigned char* ws = c.ws; const int tid = c.tid, lane = c.lane, w = c.wave, g = lane >> 4, cc = lane & 15;
    const bf16_t* VG = (const bf16_t*)(ws + WS_R1 + 2 * SZ_T512); const float* DEC = (const float*)(ws + WS_DEC); bf16_t* O = (bf16_t*)(ws + WS_H1);
    constexpr int LDQ = 136, LDJ = 72;
    bf16_t* Qs = (bf16_t*)c.smem;
    bf16_t* Ks = Qs + 64 * LDQ;
    bf16_t* KEt = Ks + 64 * LDQ;
    bf16_t* Vt = KEt + 128 * LDJ;
    bf16_t* At = Vt + 64 * LDJ;
    bf16_t* St = At + 64 * LDJ;
    float* dec = (float*)(St + 64 * LDQ);
    for (int u = c.bid; u < NB * 4 * 4; u += c.G) {
        const int b = u >> 4, h = (u >> 2) & 3, es = u & 3;
        for (int dir = 0; dir < 2; ++dir) {
            const bf16_t* QIN = (const bf16_t*)(ws + WS_R2) + (size_t)dir * T * 512; const bf16_t* KIN = (const bf16_t*)(ws + WS_R2 + SZ_T1K) + (size_t)dir * T * 512; const bf16_t* KEND = (const bf16_t*)(ws + WS_R2 + 2 * SZ_T1K) + (size_t)dir * T * 512;
            f32x4 accS[4];
#pragma unroll
            for (int et = 0; et < 4; ++et) accS[et] = (f32x4){0.f, 0.f, 0.f, 0.f};
            __syncthreads();
            for (int i = tid; i < 64 * LDQ / 2; i += NTHR) ((unsigned*)St)[i] = 0u;
            for (int cs = 0; cs < 36; ++cs) {
                int r0;
                if (dir == 0) r0 = (cs < 4) ? TL + b * CTXL + 64 * cs : b * SEQ + 64 * (cs - 4);
                else r0 = (cs < 4) ? TL + b * CTXL + 64 * (3 - cs) : b * SEQ + 64 * (35 - cs);
                const int chunk = r0 >> 6;
#pragma unroll
                for (int it = 0; it < 2; ++it) { const int idx = it * 512 + tid, tok = idx >> 4, d8 = (idx & 15) * 8;
                    const size_t go = (size_t)(r0 + tok) * 512 + h * 128 + d8;
                    *(u32x4*)(Qs + tok * LDQ + d8) = *(const u32x4*)(QIN + go);
                    *(u32x4*)(Ks + tok * LDQ + d8) = *(const u32x4*)(KIN + go);
                    const u32x4 ke = *(const u32x4*)(KEND + go);
#pragma unroll
                    for (int e = 0; e < 4; ++e) { KEt[(d8 + 2 * e) * LDJ + tok] = (bf16_t)(ke[e] & 0xffffu); KEt[(d8 + 2 * e + 1) * LDJ + tok] = (bf16_t)(ke[e] >> 16); } }
                { const int tok = tid >> 3, e8 = (tid & 7) * 8;
                  const u32x4 vv = *(const u32x4*)(VG + (size_t)(r0 + tok) * 1024 + h * 256 + es * 64 + e8);
#pragma unroll
                  for (int e = 0; e < 4; ++e) { Vt[(e8 + 2 * e) * LDJ + tok] = (bf16_t)(vv[e] & 0xffffu); Vt[(e8 + 2 * e + 1) * LDJ + tok] = (bf16_t)(vv[e] >> 16); } }
                if (tid < 128) dec[tid] = DEC[((size_t)dir * (T / 64) + chunk) * 512 + h * 128 + tid];
                __syncthreads();
                { const int it = w >> 1;
#pragma unroll
                  for (int jj = 0; jj < 2; ++jj) { const int jt = 2 * (w & 1) + jj; f32x4 a = {0.f, 0.f, 0.f, 0.f};
#pragma unroll
                      for (int ks = 0; ks < 4; ++ks) a = mfma16(frag_ld(Qs, LDQ, 16 * it, 32 * ks, lane), frag_ld(Ks, LDQ, 16 * jt, 32 * ks, lane), a);
                      const int jcol = 16 * jt + cc;
#pragma unroll
                      for (int r = 0; r < 4; ++r) { const int i = 16 * it + 4 * g + r; const bool keep = dir ? (jcol >= i) : (jcol <= i);
                          At[i * LDJ + jcol] = f2bf(keep ? a[r] : 0.f); } } }
                __syncthreads();
                { const int it = w >> 1;
#pragma unroll
                  for (int ee = 0; ee < 2; ++ee) { const int et = 2 * (w & 1) + ee; f32x4 a = {0.f, 0.f, 0.f, 0.f};
#pragma unroll
                      for (int ks = 0; ks < 2; ++ks) a = mfma16(frag_ld(At, LDJ, 16 * it, 32 * ks, lane), frag_ld(Vt, LDJ, 16 * et, 32 * ks, lane), a);
#pragma unroll
                      for (int ks = 0; ks < 4; ++ks) a = mfma16(frag_ld(Qs, LDQ, 16 * it, 32 * ks, lane), frag_ld(St, LDQ, 16 * et, 32 * ks, lane), a);
                      const int ecol = h * 256 + es * 64 + 16 * et + cc;
#pragma unroll
                      for (int r = 0; r < 4; ++r) { const size_t oo = (size_t)(r0 + 16 * it + 4 * g + r) * 1024 + ecol;
                          float v = a[r]; if (dir) v += bf1(O[oo]); O[oo] = f2bf(v); } } }
#pragma unroll
                for (int et = 0; et < 4; ++et) {
#pragma unroll
                    for (int r = 0; r < 4; ++r) accS[et][r] *= dec[16 * w + 4 * g + r];
#pragma unroll
                    for (int ks = 0; ks < 2; ++ks) accS[et] = mfma16(frag_ld(KEt, LDJ, 16 * w, 32 * ks, lane), frag_ld(Vt, LDJ, 16 * et, 32 * ks, lane), accS[et]);
                }
                __syncthreads();
#pragma unroll
                for (int et = 0; et < 4; ++et) { u32x2 sv; sv.x = pk_bf16(accS[et][0], accS[et][1]); sv.y = pk_bf16(accS[et][2], accS[et][3]);
                    *(u32x2*)(St + (16 * et + cc) * LDQ + 16 * w + 4 * g) = sv; }
            }
        }
    }
}

DI void phase_gla_readout(const Ctx& c, int j) {
    const Params& p = *c.p; unsigned char* ws = c.ws;
    const bf16_t* O = (const bf16_t*)(ws + WS_H1); const bf16_t* RG = (const bf16_t*)(ws + WS_R1 + 2 * SZ_T512 + SZ_T1K); bf16_t* Y = (bf16_t*)(ws + WS_R2);
    const float* gn = p.in[17] + (size_t)j * 1024;
    for (int row = c.bid * NWAVE + c.wave; row < T; row += c.G * NWAVE) {
#pragma unroll
        for (int hd = 0; hd < 4; ++hd) { const int col = 4 * c.lane + 256 * hd;
            const u32x2 ov = *(const u32x2*)(O + (size_t)row * D + col), rv = *(const u32x2*)(RG + (size_t)row * D + col);
            const float x0 = bf_lo(ov.x), x1 = bf_hi(ov.x), x2 = bf_lo(ov.y), x3 = bf_hi(ov.y);
            const float mean = wave_sum((x0 + x1) + (x2 + x3)) * (1.0f / 256.0f);
            const float d0 = x0 - mean, d1 = x1 - mean, d2 = x2 - mean, d3 = x3 - mean;
            const float rstd = rsqrtf(wave_sum((d0 * d0 + d1 * d1) + (d2 * d2 + d3 * d3)) * (1.0f / 256.0f) + LN_EPS);
            const f32x4 gg = *(const f32x4*)(gn + col);
            const float r0 = bf_lo(rv.x), r1 = bf_hi(rv.x), r2 = bf_lo(rv.y), r3 = bf_hi(rv.y);
            u32x2 o; o.x = pk_bf16(d0 * rstd * gg[0] * silu_f(r0), d1 * rstd * gg[1] * silu_f(r1)); o.y = pk_bf16(d2 * rstd * gg[2] * silu_f(r2), d3 * rstd * gg[3] * silu_f(r3));
            *(u32x2*)(Y + (size_t)row * D + col) = o; }
    }
}

constexpr int N_PHASES = 2 + 2 * 8 + 2 * 9;

__global__ void __launch_bounds__(NTHR, 2) mega_fwd(Params p) {
    extern __shared__ __attribute__((aligned(16))) unsigned char smem[];
    cg::grid_group grid = cg::this_grid();
    Ctx c; c.p = &p; c.ws = p.ws; c.smem = smem; c.tid = threadIdx.x; c.lane = c.tid & 63; c.wave = __builtin_amdgcn_readfirstlane(c.tid >> 6); c.G = gridDim.x; c.bid = blockIdx.x;
    unsigned char* ws = p.ws;
    unsigned* ctr = (unsigned*)(ws + WS_CTL);
    unsigned target = 0;
    const int lo = p.ph_lo, hi = p.ph_hi;
    int ph = 0;
#ifndef PH_ONLY
#define PH_ONLY -1
#endif
#define RUN(id, ...) do { if ((PH_ONLY < 0 || PH_ONLY == (id)) && ph >= lo && ph < hi) { { int t_ = threadIdx.x; asm volatile("" : "+v"(t_)); c.tid = t_; c.lane = t_ & 63; c.wave = __builtin_amdgcn_readfirstlane(t_ >> 6); ws = p.ws; asm volatile("" : "+s"(ws)); c.ws = ws; } __VA_ARGS__; if (ph + 1 < hi) { if (ph == 0) grid.sync(); else grid_barrier(ctr, target); } } ++ph; } while (0)
    LAS unsigned char* lds = (LAS unsigned char*)smem;
    const float* MOD = (const float*)(ws + WS_MOD);

    RUN(0, phase_prologue(c));
    RUN(1, phase_mod0(c));
    for (int L = 0; L < DEPTH; ++L) {
        const int j = L >> 1;
        if ((L & 1) == 0) {
            RUN(2, { pg8::Gemm g{(const bf16_t*)(ws + WS_H1), (const bf16_t*)(ws + WS_WAIN) + (size_t)j * 2048 * 1024, T, 2048, 1024}; pg8::StaticOrder S; S.init(T, 2048, c.G, c.bid);
                  pg8::EpiBf16<1> E{(bf16_t*)(ws + WS_R1), 2048}; pg8::gemm_phase(lds, g, S, E, c.tid); });
            RUN(3, phase_vstats(c));
            RUN(4, phase_spatial(c, j));
        } else {
            RUN(5, { pg8::Gemm g{(const bf16_t*)(ws + WS_H1), (const bf16_t*)(ws + WS_WBIN) + (size_t)j * WBIN_N * 1024, T, WBIN_N, 1024}; pg8::StaticOrder S; S.init(T, WBIN_N, c.G, c.bid);
                  pg8::EpiGlaProj E{(bf16_t*)(ws + WS_R1), (bf16_t*)(ws + WS_R1 + SZ_T512), (bf16_t*)(ws + WS_R1 + 2 * SZ_T512), (bf16_t*)(ws + WS_R1 + 2 * SZ_T512 + SZ_T1K), (float*)(ws + WS_GL)};
                  pg8::gemm_phase(lds, g, S, E, c.tid); });
            RUN(6, phase_gla_prep(c, j));
            RUN(7, phase_gla_scan(c));
            RUN(8, phase_gla_readout(c, j));
        }
        RUN(9, { const bf16_t* W = (L & 1) ? (const bf16_t*)(ws + WS_WBOUT) + (size_t)j * 1024 * 1024 : (const bf16_t*)(ws + WS_WAOUT) + (size_t)j * 1024 * 1024;
              pg8::Gemm g{(const bf16_t*)(ws + WS_R2), W, T, 1024, 1024}; pg8::StaticOrder S; S.init(T, 1024, c.G, c.bid);
              pg8::EpiRes E{L == 0 ? p.in[0] : (const float*)(ws + WS_XS), L == 0 ? p.in[2] : (const float*)(ws + WS_XS) + (size_t)TL * D, (float*)(ws + WS_XS), MOD + (size_t)L * 17 * 6144, 2};
              pg8::gemm_phase(lds, g, S, E, c.tid); });
        RUN(10, phase_ln1(c, L));
        RUN(11, { pg8::Gemm g{(const bf16_t*)(ws + WS_R2 + SZ_T1K), (const bf16_t*)(ws + WS_WQ) + (size_t)L * 1024 * 1024, T, 1024, 1024}; pg8::StaticOrder S; S.init(T, 1024, c.G, c.bid);
              pg8::EpiBf16<0> E{(bf16_t*)(ws + WS_R1), 1024}; pg8::gemm_phase(lds, g, S, E, c.tid); });
        RUN(12, phase_route(c, L));
        RUN(13, phase_experts(c, L));
    }
#undef RUN
}

extern "C" void kernel_launch(void* const* d_in, const int* in_sizes, int n_in, void* d_out, int out_size, void* d_ws, size_t ws_size, hipStream_t stream) {
    static int grid = 0;
    if (grid == 0) {
        if (n_in != 23 || out_size != TL * D || ws_size < WS_END) { fprintf(stderr, "kernel_launch: unexpected shapes: n_in %d out %d ws %zu (need %zu)\n", n_in, out_size, ws_size, (size_t)WS_END); grid = -1; return; }
        int dev = 0, cus = 0, per_cu = 0;
        if (hipGetDevice(&dev) != hipSuccess || hipDeviceGetAttribute(&cus, hipDeviceAttributeMultiprocessorCount, dev) != hipSuccess) { fprintf(stderr, "kernel_launch: device query failed\n"); grid = -1; return; }
        if (hipFuncSetAttribute((const void*)mega_fwd, hipFuncAttributeMaxDynamicSharedMemorySize, LDS_BYTES) != hipSuccess) { fprintf(stderr, "kernel_launch: hipFuncSetAttribute failed\n"); grid = -1; return; }
        if (hipOccupancyMaxActiveBlocksPerMultiprocessor(&per_cu, (const void*)mega_fwd, NTHR, LDS_BYTES) != hipSuccess || per_cu < 1) { fprintf(stderr, "kernel_launch: occupancy query says %d blocks per CU\n", per_cu); grid = -1; return; }
        grid = cus;
    }
    if (grid < 0) return;
    (void)hipMemsetAsync((char*)d_ws + WS_CTL, 0, 65536, stream);
    Params p{};
    for (int i = 0; i < 23; ++i) p.in[i] = (const float*)d_in[i];
    p.out = (float*)d_out; p.ws = (unsigned char*)d_ws; p.ph_lo = 0; p.ph_hi = N_PHASES;
    void* args[] = {&p};
    const hipError_t e = hipLaunchCooperativeKernel((const void*)mega_fwd, dim3(grid), dim3(NTHR), args, LDS_BYTES, stream);
    if (e != hipSuccess) fprintf(stderr, "kernel_launch: cooperative launch failed: %s (grid %d)\n", hipGetErrorString(e), grid);
}
```

```cpp
#include <hip/hip_runtime.h>
#include <hip/hip_cooperative_groups.h>
#include <cstdio>
#include <cstdint>
namespace cg = cooperative_groups;

#define LAS __attribute__((address_space(3)))
#define DI __device__ __forceinline__
typedef unsigned short bf16_t;
typedef short bf16x8 __attribute__((ext_vector_type(8)));
typedef float f32x4 __attribute__((ext_vector_type(4)));
typedef float f32x2 __attribute__((ext_vector_type(2)));
typedef unsigned u32x4 __attribute__((ext_vector_type(4)));
typedef unsigned u32x2 __attribute__((ext_vector_type(2)));
typedef __bf16 bf16v2 __attribute__((ext_vector_type(2)));

constexpr int D = 1024, NB = 16, SEQ = 2048, CTXL = 256, DEPTH = 4;
constexpr int TL = NB * SEQ, TC = NB * CTXL, T = TL + TC;
constexpr int NEXP = 16384;
constexpr float LN_EPS = 1e-5f;
constexpr float DN_ALPHA = 1.6817928305074290f;
constexpr int NTHR = 512, NWAVE = 8;
constexpr int LDS_BYTES = 140 * 1024;
constexpr int WBIN_N = 3328;

constexpr size_t al256(size_t x) { return (x + 255) & ~(size_t)255; }
constexpr size_t WS_CTL = 0;
constexpr size_t WS_MOD = 65536;
constexpr size_t WS_STATS = al256(WS_MOD + (size_t)4 * 17 * 6144 * 4);
constexpr size_t WS_GL = al256(WS_STATS + (size_t)T * 2 * 4);
constexpr size_t WS_DEC = al256(WS_GL + (size_t)T * 32 * 4);
constexpr size_t WS_WSB = al256(WS_DEC + (size_t)2 * 576 * 512 * 4);
constexpr size_t WS_WAIN = al256(WS_WSB + (size_t)2 * 8 * 128 * 128 * 2);
constexpr size_t WS_WAOUT = WS_WAIN + (size_t)2 * 2048 * 1024 * 2;
constexpr size_t WS_WBIN = WS_WAOUT + (size_t)2 * 1024 * 1024 * 2;
constexpr size_t WS_WBOUT = WS_WBIN + (size_t)2 * WBIN_N * 1024 * 2;
constexpr size_t WS_WQ = WS_WBOUT + (size_t)2 * 1024 * 1024 * 2;
constexpr size_t WS_UT = WS_WQ + (size_t)4 * 1024 * 1024 * 2;
constexpr size_t WS_VT = WS_UT + (size_t)4 * NEXP * 1024;
constexpr size_t WS_SU = WS_VT + (size_t)4 * NEXP * 1024;
constexpr size_t WS_SV = WS_SU + (size_t)4 * NEXP * 4;
constexpr size_t WS_XS = WS_SV + (size_t)4 * NEXP * 4;
constexpr size_t WS_R1 = WS_XS + (size_t)T * 1024 * 4;
constexpr size_t WS_R2 = WS_R1 + (size_t)T * 3072 * 2;
constexpr size_t WS_H1 = WS_R2 + (size_t)T * 3072 * 2;
constexpr size_t WS_VTT = WS_H1 + (size_t)T * 1024 * 2;
constexpr size_t WS_END = WS_VTT + (size_t)T * 1024 * 2;
constexpr size_t SZ_T1K = (size_t)T * 1024 * 2;
constexpr size_t SZ_T512 = (size_t)T * 512 * 2;

struct Params { const float* in[23]; float* out; unsigned char* ws; int ph_lo, ph_hi; };

DI unsigned pk_bf16(float lo, float hi) { f32x2 v = {lo, hi}; return __builtin_bit_cast(unsigned, __builtin_convertvector(v, bf16v2)); }
DI float bf_lo(unsigned w) { return __uint_as_float(w << 16); }
DI float bf_hi(unsigned w) { return __uint_as_float(w & 0xffff0000u); }
DI float bf1(bf16_t b) { return __uint_as_float(((unsigned)b) << 16); }
DI bf16_t f2bf(float f) { return (bf16_t)(pk_bf16(f, 0.f) & 0xffffu); }
DI float gelu_tanh(float x) { const float u = 0.7978845608028654f * (x + 0.044715f * x * x * x); return __fdividef(x, 1.0f + __expf(-2.0f * u)); }
DI float silu_f(float x) { return __fdividef(x, 1.0f + __expf(-x)); }
DI float logsig_f(float z) { return fminf(z, 0.f) - log1pf(expf(-fabsf(z))); }
DI float wave_sum(float v) {
#pragma unroll
    for (int o = 32; o > 0; o >>= 1) v += __shfl_xor(v, o, 64);
    return v;
}
DI float wave_max(float v) {
#pragma unroll
    for (int o = 32; o > 0; o >>= 1) v = fmaxf(v, __shfl_xor(v, o, 64));
    return v;
}
template <int CTRL> DI float dpp_mov(float x) { return __builtin_bit_cast(float, __builtin_amdgcn_mov_dpp(__builtin_bit_cast(int, x), CTRL, 0xf, 0xf, true)); }
DI float reduce4(float p0, float p1, float p2, float p3) {
    const auto a = __builtin_amdgcn_permlane32_swap(__float_as_uint(p0), __float_as_uint(p2), false, false); const float q0 = __uint_as_float(a[0]) + __uint_as_float(a[1]);
    const auto b = __builtin_amdgcn_permlane32_swap(__float_as_uint(p1), __float_as_uint(p3), false, false); const float q1 = __uint_as_float(b[0]) + __uint_as_float(b[1]);
    const auto c = __builtin_amdgcn_permlane16_swap(__float_as_uint(q0), __float_as_uint(q1), false, false); float s = __uint_as_float(c[0]) + __uint_as_float(c[1]);
    s += dpp_mov<0x128>(s); s += dpp_mov<0x124>(s); s += dpp_mov<0x122>(s); s += dpp_mov<0x121>(s);
    return s;
}
DI float dot2bf(unsigned a, unsigned b, float c) { return __builtin_amdgcn_fdot2_f32_bf16(__builtin_bit_cast(bf16v2, a), __builtin_bit_cast(bf16v2, b), c, false); }
DI f32x4 mfma16(bf16x8 a, bf16x8 b, f32x4 c) { return __builtin_amdgcn_mfma_f32_16x16x32_bf16(a, b, c, 0, 0, 0); }
DI bf16x8 frag_ld(const bf16_t* X, int ld, int row0, int k0, int lane) { return *(const bf16x8*)(X + (size_t)(row0 + (lane & 15)) * ld + k0 + 8 * (lane >> 4)); }
DI int mod_batch(int row) { return row < TL ? (row >> 11) : NB; }

DI void grid_barrier(unsigned* ctr, unsigned& target) {
    asm volatile("s_waitcnt vmcnt(0)" ::: "memory");
    __syncthreads();
    target += gridDim.x;
    if (threadIdx.x == 0) {
        __builtin_amdgcn_fence(__ATOMIC_RELEASE, "agent");
        asm volatile("s_waitcnt vmcnt(0)" ::: "memory");
        __hip_atomic_fetch_add(ctr, 1u, __ATOMIC_RELAXED, __HIP_MEMORY_SCOPE_AGENT);
        while (__hip_atomic_load(ctr, __ATOMIC_RELAXED, __HIP_MEMORY_SCOPE_AGENT) < target) __builtin_amdgcn_s_sleep(2);
        __builtin_amdgcn_fence(__ATOMIC_ACQUIRE, "agent");
        asm volatile("s_waitcnt vmcnt(0)" ::: "memory");
    }
    __syncthreads();
}

namespace pg8 {
constexpr int BM = 256, BK = 64, HALF = 128, HTB = HALF * BK * 2, STAGE_BYTES = 8 * HTB, NXCD = 8, WGM = 8;
__host__ __device__ __forceinline__ int lds_byte(int r, int c) { const int st = (r >> 4) * 2 + (c >> 5), rr = r & 15, cc = c & 31, ob = rr * 64 + cc * 2; return st * 1024 + (ob ^ (((ob >> 9) & 1) << 5)); }
__host__ __device__ __forceinline__ void stage_rc(int b, int& R, int& C) { const int st = b / 1024, sb = b % 1024, swz = sb ^ (((sb >> 9) & 1) << 5); R = (st >> 1) * 16 + swz / 64; C = (st & 1) * 32 + (swz % 64) / 2; }
__host__ __device__ __forceinline__ int perm32(int rho) { const int n = rho >> 4, i = rho & 15; return 8 * (i >> 2) + 4 * n + (i & 3); }
struct Unit { int pm, pn; };
struct Gemm { const bf16_t* A; const bf16_t* Bt; int M, N, K; };
struct StaticOrder {
    int nM, nN, nwg, G, c;
    __device__ void init(int M, int N, int G_, int c_) { nM = M / BM; nN = N / BM; nwg = nM * nN; G = G_; c = c_; }
    __device__ bool next(int i, Unit& u) const {
        const long L = (long)i * G + c; if (L >= nwg) return false;
        int wgid = (int)L; { const int q = nwg / NXCD, r = nwg % NXCD, xcd = wgid % NXCD, off = wgid / NXCD; wgid = (xcd < r ? xcd * (q + 1) : r * (q + 1) + (xcd - r) * q) + off; }
        const int nig = WGM * nN, gid = wgid / nig, fm = gid * WGM, gsz = (nM - fm) < WGM ? (nM - fm) : WGM;
        u.pm = fm + ((wgid % nig) % gsz); u.pn = (wgid % nig) / gsz; return true;
    }
};

template <class Epi>
__device__ __forceinline__ void gemm_phase(LAS unsigned char* lds, const Gemm g, const StaticOrder& S, const Epi& E, const int tid) {
    const int wid = __builtin_amdgcn_readfirstlane(tid >> 6), lane = tid & 63, wr = wid >> 2, wc = wid & 3, fr = lane & 15, fq = lane >> 4;
    const int K = g.K, nt = K / BK;
    unsigned voffA[2], voffB[2];
#pragma unroll
    for (int i = 0; i < 2; ++i) { int R, C; stage_rc(tid * 16 + i * 8192, R, C); const int Rb = Epi::PERM ? ((R & ~31) + perm32(R & 31)) : R;
        voffA[i] = (unsigned)(R * K + C) * 2u; voffB[i] = (unsigned)(Rb * K + C) * 2u; }
    const size_t kstep = (size_t)(BK * 2);
    const size_t hstep = (size_t)HALF * K * 2;
    const size_t tstep = 2 * hstep;
    const unsigned ldsw = (unsigned)wid * 1024u;
    const int aoff = lds_byte(wr * 64 + fr, fq * 8), boff = lds_byte(wc * 32 + fr, fq * 8);
#define PG8_SA(b, h) (((b) * 2 + (h)) * HTB)
#define PG8_SB(b, h) ((4 + (b) * 2 + (h)) * HTB)
#define PG8_STAGE(bufoff, gbase, voff) do { _Pragma("unroll") for (int _i = 0; _i < 2; ++_i) \
        __builtin_amdgcn_global_load_lds((const unsigned*)((const char*)(gbase) + (voff)[_i]), (LAS unsigned*)(lds + (bufoff) + ldsw + _i * 8192), 16, 0, 0); } while (0)
#define PG8_LDA(dst, b, h) do { _Pragma("unroll") for (int m = 0; m < 4; ++m) _Pragma("unroll") for (int k = 0; k < 2; ++k) dst[m][k] = *(const LAS bf16x8*)(lds + PG8_SA(b, h) + aoff + m * 2048 + k * 1024); } while (0)
#define PG8_LDB(dst, b, h) do { _Pragma("unroll") for (int n = 0; n < 2; ++n) _Pragma("unroll") for (int k = 0; k < 2; ++k) dst[n][k] = *(const LAS bf16x8*)(lds + PG8_SB(b, h) + boff + n * 2048 + k * 1024); } while (0)
#define PG8_MMA(ai, bj, At, Bt) do { __builtin_amdgcn_s_setprio(1); _Pragma("unroll") for (int m = 0; m < 4; ++m) _Pragma("unroll") for (int n = 0; n < 2; ++n) _Pragma("unroll") for (int k = 0; k < 2; ++k) \
        acc[ai][bj][m][n] = __builtin_amdgcn_mfma_f32_16x16x32_bf16(Bt[n][k], At[m][k], acc[ai][bj][m][n], 0, 0, 0); __builtin_amdgcn_s_setprio(0); } while (0)
#define PG8_WAIT_V(n) asm volatile("s_waitcnt vmcnt(" #n ")" ::: "memory")
#define PG8_WAIT_L(n) asm volatile("s_waitcnt lgkmcnt(" #n ")" ::: "memory")
#define PG8_BAR __builtin_amdgcn_s_barrier()
#define PG8_SCHED __builtin_amdgcn_sched_barrier(0)
    Unit cur, nxt; int ui = 0;
    if (!S.next(0, cur)) return;
    f32x4 acc[2][2][4][2];
#pragma unroll
    for (int a = 0; a < 2; ++a)
#pragma unroll
        for (int b = 0; b < 2; ++b)
#pragma unroll
            for (int m = 0; m < 4; ++m)
#pragma unroll
                for (int n = 0; n < 2; ++n) acc[a][b][m][n] = (f32x4){0.f, 0.f, 0.f, 0.f};
    bf16x8 At[4][2], B0[2][2], B1[2][2];
    const char* cA = (const char*)g.A + (size_t)cur.pm * tstep; const char* cB = (const char*)g.Bt + (size_t)cur.pn * tstep;
    PG8_STAGE(PG8_SB(0, 0), cB, voffB); PG8_STAGE(PG8_SA(0, 0), cA, voffA); PG8_STAGE(PG8_SB(0, 1), cB + hstep, voffB); PG8_STAGE(PG8_SA(0, 1), cA + hstep, voffA);
    if (wr == 1) PG8_BAR;
    PG8_WAIT_V(4); PG8_BAR;
    PG8_STAGE(PG8_SB(1, 0), cB + kstep, voffB); PG8_STAGE(PG8_SA(1, 0), cA + kstep, voffA); PG8_STAGE(PG8_SB(1, 1), cB + hstep + kstep, voffB);
    PG8_WAIT_V(6); PG8_BAR;
    for (;;) {
        const bool has_next = S.next(ui + 1, nxt);
        const char* nA = has_next ? (const char*)g.A + (size_t)nxt.pm * tstep : cA; const char* nB = has_next ? (const char*)g.Bt + (size_t)nxt.pn * tstep : cB;
        for (int t = 0; t < nt; t += 2) {
            const bool last = (t == nt - 2);
            const char* a1 = cA + (size_t)(t + 1) * kstep;
            const char* a2 = last ? nA : cA + (size_t)(t + 2) * kstep; const char* b2 = last ? nB : cB + (size_t)(t + 2) * kstep;
            const char* a3 = a2 + kstep; const char* b3 = b2 + kstep;
            PG8_LDB(B0, 0, 0); PG8_SCHED; PG8_LDA(At, 0, 0); PG8_STAGE(PG8_SA(1, 1), a1 + hstep, voffA);
            PG8_WAIT_L(8); PG8_BAR; PG8_WAIT_L(0); PG8_MMA(0, 0, At, B0); PG8_BAR; PG8_SCHED;
            PG8_LDB(B1, 0, 1); PG8_STAGE(PG8_SB(0, 0), b2, voffB);
            PG8_BAR; PG8_WAIT_L(0); PG8_MMA(0, 1, At, B1); PG8_BAR;
            PG8_LDA(At, 0, 1); PG8_STAGE(PG8_SA(0, 0), a2, voffA);
            PG8_BAR; PG8_WAIT_L(0); PG8_MMA(1, 0, At, B0); PG8_BAR; PG8_SCHED;
            PG8_STAGE(PG8_SB(0, 1), b2 + hstep, voffB);
            PG8_WAIT_V(6); PG8_BAR; PG8_MMA(1, 1, At, B1); PG8_BAR;
            PG8_LDB(B0, 1, 0); PG8_SCHED; PG8_LDA(At, 1, 0); PG8_STAGE(PG8_SA(0, 1), a2 + hstep, voffA);
            PG8_WAIT_L(8); PG8_BAR; PG8_WAIT_L(0); PG8_MMA(0, 0, At, B0); PG8_BAR; PG8_SCHED;
            PG8_LDB(B1, 1, 1); PG8_STAGE(PG8_SB(1, 0), b3, voffB);
            PG8_BAR; PG8_WAIT_L(0); PG8_MMA(0, 1, At, B1); PG8_BAR;
            PG8_LDA(At, 1, 1); PG8_STAGE(PG8_SA(1, 0), a3, voffA);
            PG8_BAR; PG8_WAIT_L(0); PG8_MMA(1, 0, At, B0); PG8_BAR; PG8_SCHED;
            PG8_STAGE(PG8_SB(1, 1), b3 + hstep, voffB);
            PG8_WAIT_V(6); PG8_BAR; PG8_MMA(1, 1, At, B1); PG8_BAR;
        }
        E(acc, cur, wr, wc, fr, fq);
        if (!has_next) break;
#pragma unroll
        for (int a = 0; a < 2; ++a)
#pragma unroll
            for (int b = 0; b < 2; ++b)
#pragma unroll
                for (int m = 0; m < 4; ++m)
#pragma unroll
                    for (int n = 0; n < 2; ++n) acc[a][b][m][n] = (f32x4){0.f, 0.f, 0.f, 0.f};
        cur = nxt; cA = nA; cB = nB; ++ui;
    }
    PG8_WAIT_V(0);
    if (wr == 0) PG8_BAR;
    PG8_BAR;
#undef PG8_SA
#undef PG8_SB
#undef PG8_STAGE
#undef PG8_LDA
#undef PG8_LDB
#undef PG8_MMA
#undef PG8_WAIT_V
#undef PG8_WAIT_L
#undef PG8_BAR
#undef PG8_SCHED
}

template <int ACT  > struct EpiBf16 {
    static constexpr bool PERM = true;
    bf16_t* O; int ldc;
    __device__ __forceinline__ void operator()(const f32x4 (&acc)[2][2][4][2], const Unit& u, int wr, int wc, int fr, int fq) const {
        const int row0 = u.pm * BM + wr * 64 + fr, col0 = u.pn * BM + wc * 32 + 8 * fq;
#pragma unroll
        for (int ai = 0; ai < 2; ++ai)
#pragma unroll
            for (int m = 0; m < 4; ++m) { bf16_t* rowp = O + (size_t)(row0 + ai * HALF + m * 16) * ldc + col0;
#pragma unroll
                for (int bj = 0; bj < 2; ++bj) { f32x4 v0 = acc[ai][bj][m][0], v1 = acc[ai][bj][m][1];
                    if (ACT == 1) {
#pragma unroll
                        for (int j = 0; j < 4; ++j) { v0[j] = gelu_tanh(v0[j]); v1[j] = gelu_tanh(v1[j]); } }
                    u32x4 w; w.x = pk_bf16(v0[0], v0[1]); w.y = pk_bf16(v0[2], v0[3]); w.z = pk_bf16(v1[0], v1[1]); w.w = pk_bf16(v1[2], v1[3]);
                    *(u32x4*)(rowp + bj * HALF) = w; } }
    }
};
struct EpiRes {
    static constexpr bool PERM = false;
    const float* src_lat; const float* src_ctx; float* dst; const float* modL; int gate_idx;
    __device__ __forceinline__ void operator()(const f32x4 (&acc)[2][2][4][2], const Unit& u, int wr, int wc, int fr, int fq) const {
        const bool isctx = u.pm >= (TL / BM);
        const float* sb = isctx ? src_ctx + (size_t)(u.pm - TL / BM) * BM * D : src_lat + (size_t)u.pm * BM * D;
        const int mb = isctx ? NB : (u.pm >> 3);
        const float* gv = modL + (size_t)mb * 6144 + gate_idx * 1024;
        const int rl = wr * 64 + fr, col0 = u.pn * BM + wc * 32 + 4 * fq;
        f32x4 g[2][2];
#pragma unroll
        for (int bj = 0; bj < 2; ++bj)
#pragma unroll
            for (int n = 0; n < 2; ++n) g[bj][n] = *(const f32x4*)(gv + col0 + bj * HALF + n * 16);
#pragma unroll
        for (int ai = 0; ai < 2; ++ai)
#pragma unroll
            for (int m = 0; m < 4; ++m) { const int r = rl + ai * HALF + m * 16; const float* sp = sb + (size_t)r * D + col0; float* dp = dst + ((size_t)u.pm * BM + r) * D + col0;
#pragma unroll
                for (int bj = 0; bj < 2; ++bj)
#pragma unroll
                    for (int n = 0; n < 2; ++n) { const f32x4 x = *(const f32x4*)(sp + bj * HALF + n * 16); *(f32x4*)(dp + bj * HALF + n * 16) = x * DN_ALPHA + g[bj][n] * acc[ai][bj][m][n]; } }
    }
};
struct EpiGlaProj {
    static constexpr bool PERM = true;
    bf16_t* QG; bf16_t* KG; bf16_t* VG; bf16_t* RG; float* GL;
    __device__ __forceinline__ void operator()(const f32x4 (&acc)[2][2][4][2], const Unit& u, int wr, int wc, int fr, int fq) const {
        const int row0 = u.pm * BM + wr * 64 + fr, pn = u.pn;
        if (pn < 12) {
            bf16_t* base; int ld, colt; float sc = 1.f;
            if (pn < 2) { base = QG; ld = 512; colt = pn * BM; sc = 0.08838834764831845f; }
            else if (pn < 4) { base = KG; ld = 512; colt = (pn - 2) * BM; }
            else if (pn < 8) { base = VG; ld = 1024; colt = (pn - 4) * BM; }
            else { base = RG; ld = 1024; colt = (pn - 8) * BM; }
            const int col0 = colt + wc * 32 + 8 * fq;
#pragma unroll
            for (int ai = 0; ai < 2; ++ai)
#pragma unroll
                for (int m = 0; m < 4; ++m) { bf16_t* rowp = base + (size_t)(row0 + ai * HALF + m * 16) * ld + col0;
#pragma unroll
                    for (int bj = 0; bj < 2; ++bj) { const f32x4 v0 = acc[ai][bj][m][0] * sc, v1 = acc[ai][bj][m][1] * sc;
                        u32x4 w; w.x = pk_bf16(v0[0], v0[1]); w.y = pk_bf16(v0[2], v0[3]); w.z = pk_bf16(v1[0], v1[1]); w.w = pk_bf16(v1[2], v1[3]);
                        *(u32x4*)(rowp + bj * HALF) = w; } }
        } else if (wc == 0) {
#pragma unroll
            for (int ai = 0; ai < 2; ++ai)
#pragma unroll
                for (int m = 0; m < 4; ++m) { float* gp = GL + (size_t)(row0 + ai * HALF + m * 16) * 32 + 8 * fq;
                    *(f32x4*)gp = acc[ai][0][m][0]; *(f32x4*)(gp + 4) = acc[ai][0][m][1]; }
        }
    }
};
}

struct Ctx {
    const Params* p; unsigned char* ws; unsigned char* smem; int tid, lane, wave, G, bid;
};

DI void phase_prologue(const Ctx& c) {
    const Params& p = *c.p; unsigned char* ws = c.ws;
    const int tid = c.tid;
    constexpr int N_MOD = 192, N_TR = 4736, N_WS = 64, N_TAB = 2048;
    constexpr int N_ALL = N_MOD + N_TR + N_WS + N_TAB;
    for (int u = c.bid; u < N_ALL; u += c.G) {
        if (u < N_MOD) {
            const int l = u / 48, n0 = (u % 48) * 128;
            float* sc = (float*)c.smem;
            float* red = (float*)(c.smem + 17 * 1024 * 4);
            __syncthreads();
            for (int i = tid; i < 17 * 1024; i += NTHR) { const int b = i >> 10, k = i & 1023; const float v = (b < NB) ? p.in[1][b * 1024 + k] : p.in[3][k]; sc[i] = silu_f(v); }
            __syncthreads();
            const int c4 = (tid & 31) * 4, kg = tid >> 5;
            float acc[17][4];
#pragma unroll
            for (int b = 0; b < 17; ++b) { acc[b][0] = 0.f; acc[b][1] = 0.f; acc[b][2] = 0.f; acc[b][3] = 0.f; }
            const float* wp = p.in[4] + ((size_t)l * 1024 + (size_t)kg * 64) * 6144 + n0 + c4;
#pragma unroll 4
            for (int kk = 0; kk < 64; ++kk) {
                const f32x4 w = *(const f32x4*)(wp + (size_t)kk * 6144);
                const int k = kg * 64 + kk;
#pragma unroll
                for (int b = 0; b < 17; ++b) { const float s = sc[b * 1024 + k]; acc[b][0] += s * w[0]; acc[b][1] += s * w[1]; acc[b][2] += s * w[2]; acc[b][3] += s * w[3]; }
            }
#pragma unroll
            for (int b = 0; b < 17; ++b)
#pragma unroll
                for (int j = 0; j < 4; ++j) acc[b][j] += __shfl_xor(acc[b][j], 32, 64);
            if ((tid & 32) == 0) {
#pragma unroll
                for (int b = 0; b < 17; ++b)
#pragma unroll
                    for (int j = 0; j < 4; ++j) red[(c.wave * 17 + b) * 128 + c4 + j] = acc[b][j];
            }
            __syncthreads();
            for (int o = tid; o < 17 * 128; o += NTHR) { const int b = o >> 7, n = o & 127; float s = 0.f;
#pragma unroll
                for (int w = 0; w < 8; ++w) s += red[(w * 17 + b) * 128 + n];
                ((float*)(ws + WS_MOD))[((size_t)l * 17 + b) * 6144 + n0 + n] = s + p.in[5][l * 6144 + n0 + n]; }
        } else if (u < N_MOD + N_TR) {
            int v = u - N_MOD; const float* src; bf16_t* dst; int N, Npad;
            if (v < 1024) { const int j = v / 512; v %= 512; src = p.in[8] + (size_t)j * 1024 * 2048; dst = (bf16_t*)(ws + WS_WAIN) + (size_t)j * 2048 * 1024; N = 2048; Npad = 2048; }
            else if (v < 1536) { v -= 1024; const int j = v / 256; v %= 256; src = p.in[13] + (size_t)j * 1024 * 1024; dst = (bf16_t*)(ws + WS_WAOUT) + (size_t)j * 1024 * 1024; N = 1024; Npad = 1024; }
            else if (v < 3200) { v -= 1536; const int j = v / 832; v %= 832; src = p.in[14] + (size_t)j * 1024 * 3104; dst = (bf16_t*)(ws + WS_WBIN) + (size_t)j * WBIN_N * 1024; N = 3104; Npad = WBIN_N; }
            else if (v < 3712) { v -= 3200; const int j = v / 256; v %= 256; src = p.in[18] + (size_t)j * 1024 * 1024; dst = (bf16_t*)(ws + WS_WBOUT) + (size_t)j * 1024 * 1024; N = 1024; Npad = 1024; }
            else { v -= 3712; const int j = v / 256; v %= 256; src = p.in[19] + (size_t)j * 1024 * 1024; dst = (bf16_t*)(ws + WS_WQ) + (size_t)j * 1024 * 1024; N = 1024; Npad = 1024; }
            (void)Npad;
            const int ntn = v >> 4, ktile = v & 15, n0 = ntn * 64, k0 = ktile * 64;
            float* tl = (float*)c.smem;
            __syncthreads();
#pragma unroll
            for (int i = 0; i < 2; ++i) { const int kk = (tid >> 4) + 32 * i, nn = (tid & 15) * 4;
                f32x4 x = {0.f, 0.f, 0.f, 0.f};
                if (n0 + nn < N) x = *(const f32x4*)(src + (size_t)(k0 + kk) * N + n0 + nn);
                tl[kk * 65 + nn] = x[0]; tl[kk * 65 + nn + 1] = x[1]; tl[kk * 65 + nn + 2] = x[2]; tl[kk * 65 + nn + 3] = x[3]; }
            __syncthreads();
            { const int nn = tid >> 3, kk8 = (tid & 7) * 8; float x[8];
#pragma unroll
              for (int j = 0; j < 8; ++j) x[j] = tl[(kk8 + j) * 65 + nn];
              u32x4 w; w.x = pk_bf16(x[0], x[1]); w.y = pk_bf16(x[2], x[3]); w.z = pk_bf16(x[4], x[5]); w.w = pk_bf16(x[6], x[7]);
              *(u32x4*)(dst + (size_t)(n0 + nn) * 1024 + k0 + kk8) = w; }
        } else if (u < N_MOD + N_TR + N_WS) {
            const int v = u - N_MOD - N_TR; const size_t e = (size_t)v * 4096 + (size_t)tid * 8;
            const f32x4 a = *(const f32x4*)(p.in[11] + e), b = *(const f32x4*)(p.in[11] + e + 4);
            u32x4 w; w.x = pk_bf16(a[0], a[1]); w.y = pk_bf16(a[2], a[3]); w.z = pk_bf16(b[0], b[1]); w.w = pk_bf16(b[2], b[3]);
            *(u32x4*)((bf16_t*)(ws + WS_WSB) + e) = w;
        } else {
            const int v = u - N_MOD - N_TR - N_WS; const int tab = v >> 10;
            const float* src = p.in[21 + tab]; unsigned char* dst = ws + (tab ? WS_VT : WS_UT); float* sc = (float*)(ws + (tab ? WS_SV : WS_SU));
#pragma unroll 2
            for (int i = 0; i < 8; ++i) { const size_t row = (size_t)(v & 1023) * 64 + c.wave * 8 + i;
                const float* rp = src + row * 1024 + 16 * c.lane; f32x4 x[4]; float am = 0.f;
#pragma unroll
                for (int q = 0; q < 4; ++q) { x[q] = __builtin_nontemporal_load((const f32x4*)(rp + 4 * q)); am = fmaxf(am, fmaxf(fmaxf(fabsf(x[q][0]), fabsf(x[q][1])), fmaxf(fabsf(x[q][2]), fabsf(x[q][3])))); }
                am = fmaxf(wave_max(am), 1e-30f);
                const float inv = 440.0f / am; u32x4 w;
#pragma unroll
                for (int q = 0; q < 4; ++q) { int t = 0; t = __builtin_amdgcn_cvt_pk_fp8_f32(x[q][0] * inv, x[q][1] * inv, t, false); t = __builtin_amdgcn_cvt_pk_fp8_f32(x[q][2] * inv, x[q][3] * inv, t, true); w[q] = (unsigned)t; }
                *(u32x4*)(dst + row * 1024 + 16 * c.lane) = w;
                if (c.lane == 0) sc[row] = am * (1.0f / 440.0f); }
        }
    }
}

DI void phase_mod0(const Ctx& c) {
    const Params& p = *c.p; const float* MOD = (const float*)(c.ws + WS_MOD); bf16_t* H1 = (bf16_t*)(c.ws + WS_H1);
    for (int row = c.bid * NWAVE + c.wave; row < T; row += c.G * NWAVE) {
        const float* src = row < TL ? p.in[0] + (size_t)row * D : p.in[2] + (size_t)(row - TL) * D;
        const float* m = MOD + (size_t)mod_batch(row) * 6144;
#pragma unroll
        for (int j = 0; j < 4; ++j) { const int col = 4 * c.lane + 256 * j;
            const f32x4 x = *(const f32x4*)(src + col), sh = *(const f32x4*)(m + col), s = *(const f32x4*)(m + 1024 + col);
            const f32x4 h = x * (s + 1.0f) + sh; u32x2 w; w.x = pk_bf16(h[0], h[1]); w.y = pk_bf16(h[2], h[3]);
            *(u32x2*)(H1 + (size_t)row * D + col) = w; }
    }
}

DI void phase_vstats(const Ctx& c) {
    const bf16_t* UV = (const bf16_t*)(c.ws + WS_R1); float* ST = (float*)(c.ws + WS_STATS);
    for (int row = c.bid * NWAVE + c.wave; row < T; row += c.G * NWAVE) {
        const bf16_t* vp = UV + (size_t)row * 2048 + 1024;
        const u32x4 a = *(const u32x4*)(vp + 8 * c.lane), b = *(const u32x4*)(vp + 512 + 8 * c.lane);
        float x[16];
#pragma unroll
        for (int j = 0; j < 4; ++j) { x[2 * j] = bf_lo(a[j]); x[2 * j + 1] = bf_hi(a[j]); x[8 + 2 * j] = bf_lo(b[j]); x[9 + 2 * j] = bf_hi(b[j]); }
        float s = 0.f;
#pragma unroll
        for (int j = 0; j < 16; ++j) s += x[j];
        const float mean = wave_sum(s) * (1.0f / 1024.0f);
        float q = 0.f;
#pragma unroll
        for (int j = 0; j < 16; ++j) { const float d = x[j] - mean; q += d * d; }
        const float var = wave_sum(q) * (1.0f / 1024.0f);
        if (c.lane == 0) { ST[2 * row] = mean; ST[2 * row + 1] = rsqrtf(var + LN_EPS); }
    }
}

DI void phase_spatial(const Ctx& c, int j) {
    const Params& p = *c.p; unsigned char* ws = c.ws;
    const bf16_t* UV = (const bf16_t*)(ws + WS_R1); const float* ST = (const float*)(ws + WS_STATS); bf16_t* Y = (bf16_t*)(ws + WS_R2);
    const bf16_t* WSB = (const bf16_t*)(ws + WS_WSB) + (size_t)j * 8 * 128 * 128;
    const float* ng = p.in[9] + j * 1024; const float* nb = p.in[10] + j * 1024; const float* bs = p.in[12] + j * 8 * 128;
    constexpr int LD = 136;
    bf16_t* WsL = (bf16_t*)c.smem;
    bf16_t* VnT = WsL + 128 * LD;
    const int tid = c.tid, lane = c.lane, w = c.wave, g = lane >> 4, cc = lane & 15;
    for (int u = c.bid; u < (T / 128) * 8; u += c.G) {
        const int chunk = u >> 3, h = u & 7, r0 = chunk * 128;
        __syncthreads();
        { const int cg8 = tid & 15; float gg[8], bb[8];
#pragma unroll
          for (int e = 0; e < 8; ++e) { gg[e] = ng[h * 128 + cg8 * 8 + e]; bb[e] = nb[h * 128 + cg8 * 8 + e]; }
#pragma unroll
          for (int i = 0; i < 4; ++i) { const int idx = i * 512 + tid, tok = idx >> 4;
              const u32x4 v = *(const u32x4*)(UV + (size_t)(r0 + tok) * 2048 + 1024 + h * 128 + cg8 * 8);
              const float mean = ST[2 * (r0 + tok)], rstd = ST[2 * (r0 + tok) + 1];
              float x[8];
#pragma unroll
              for (int e = 0; e < 4; ++e) { x[2 * e] = bf_lo(v[e]); x[2 * e + 1] = bf_hi(v[e]); }
#pragma unroll
              for (int e = 0; e < 8; ++e) VnT[(cg8 * 8 + e) * LD + tok] = f2bf((x[e] - mean) * rstd * gg[e] + bb[e]);
              const int pp = idx >> 4;
              *(u32x4*)(WsL + pp * LD + cg8 * 8) = *(const u32x4*)(WSB + ((size_t)h * 128 + pp) * 128 + cg8 * 8); } }
        __syncthreads();
        f32x4 acc[8];
#pragma unroll
        for (int ct = 0; ct < 8; ++ct) acc[ct] = (f32x4){0.f, 0.f, 0.f, 0.f};
#pragma unroll
        for (int ks = 0; ks < 4; ++ks) {
            const bf16x8 bfr = frag_ld(WsL, LD, 16 * w, 32 * ks, lane);
#pragma unroll
            for (int ct = 0; ct < 8; ++ct) acc[ct] = mfma16(frag_ld(VnT, LD, 16 * ct, 32 * ks, lane), bfr, acc[ct]);
        }
        const int pp = 16 * w + cc; const float bsv = bs[h * 128 + pp];
        const size_t rowo = (size_t)(r0 + pp);
#pragma unroll
        for (int ct = 0; ct < 8; ++ct) { const int ch = h * 128 + 16 * ct + 4 * g;
            const u32x2 uu = *(const u32x2*)(UV + rowo * 2048 + ch);
            const float y0 = bf_lo(uu.x) * (acc[ct][0] + bsv), y1 = bf_hi(uu.x) * (acc[ct][1] + bsv), y2 = bf_lo(uu.y) * (acc[ct][2] + bsv), y3 = bf_hi(uu.y) * (acc[ct][3] + bsv);
            u32x2 o; o.x = pk_bf16(y0, y1); o.y = pk_bf16(y2, y3);
            *(u32x2*)(Y + rowo * D + ch) = o; }
    }
}

DI void phase_ln1(const Ctx& c, int L) {
    const Params& p = *c.p; float* XS = (float*)(c.ws + WS_XS); const float* MOD = (const float*)(c.ws + WS_MOD) + (size_t)L * 17 * 6144;
    bf16_t* H2 = (bf16_t*)(c.ws + WS_R2 + SZ_T1K);
    const float* lg = p.in[6] + (size_t)(L * 2 + 0) * D; const float* lb = p.in[7] + (size_t)(L * 2 + 0) * D;
    for (int row = c.bid * NWAVE + c.wave; row < T; row += c.G * NWAVE) {
        float* xp = XS + (size_t)row * D; const float* m = MOD + (size_t)mod_batch(row) * 6144;
        f32x4 x[4]; float s = 0.f;
#pragma unroll
        for (int j = 0; j < 4; ++j) { x[j] = *(const f32x4*)(xp + 4 * c.lane + 256 * j); s += (x[j][0] + x[j][1]) + (x[j][2] + x[j][3]); }
        const float mean = wave_sum(s) * (1.0f / 1024.0f);
        float q = 0.f;
#pragma unroll
        for (int j = 0; j < 4; ++j) { const f32x4 d = x[j] - mean; q += (d[0] * d[0] + d[1] * d[1]) + (d[2] * d[2] + d[3] * d[3]); }
        const float rstd = rsqrtf(wave_sum(q) * (1.0f / 1024.0f) + LN_EPS);
#pragma unroll
        for (int j = 0; j < 4; ++j) { const int col = 4 * c.lane + 256 * j;
            const f32x4 y = (x[j] - mean) * rstd * *(const f32x4*)(lg + col) + *(const f32x4*)(lb + col);
            *(f32x4*)(xp + col) = y;
            const f32x4 h = y * (*(const f32x4*)(m + 4 * 1024 + col) + 1.0f) + *(const f32x4*)(m + 3 * 1024 + col);
            u32x2 w; w.x = pk_bf16(h[0], h[1]); w.y = pk_bf16(h[2], h[3]);
            *(u32x2*)(H2 + (size_t)row * D + col) = w; }
    }
}

DI int f2key(float v) { const int i = __float_as_int(v); return i ^ ((i >> 31) & 0x7fffffff); }
DI float key2f(int k) { return __int_as_float(k ^ ((k >> 31) & 0x7fffffff)); }
DI void top16_half(const float* kh  , const bf16_t* q64, int (&t)[16]) {
    float q[64];
#pragma unroll
    for (int i = 0; i < 8; ++i) { const u32x4 v = *(const u32x4*)(q64 + 8 * i);
#pragma unroll
        for (int e = 0; e < 4; ++e) { q[8 * i + 2 * e] = bf_lo(v[e]); q[8 * i + 2 * e + 1] = bf_hi(v[e]); } }
#pragma unroll
    for (int i = 0; i < 16; ++i) t[i] = (int)0x80000000;
    for (int k = 0; k < 128; ++k) {
        const float* kr = kh + k * 64;
        float s0 = 0.f, s1 = 0.f, s2 = 0.f, s3 = 0.f;
#pragma unroll
        for (int d = 0; d < 64; d += 4) { const f32x4 kv = *(const f32x4*)(kr + d); s0 += q[d] * kv[0]; s1 += q[d + 1] * kv[1]; s2 += q[d + 2] * kv[2]; s3 += q[d + 3] * kv[3]; }
        int key = (f2key((s0 + s1) + (s2 + s3)) & ~127) | (127 - k);
#pragma unroll
        for (int i = 0; i < 16; ++i) { const int hi = max(key, t[i]); key = min(key, t[i]); t[i] = hi; }
    }
}
DI void phase_route(const Ctx& c, int L) {
    const Params& p = *c.p; unsigned char* ws = c.ws;
    float* keys = (float*)c.smem;
    unsigned* ilist = (unsigned*)(c.smem + 65536);
    __syncthreads();
    { const float* gk = p.in[20] + (size_t)L * 2 * 128 * 64;
      for (int i = c.tid; i < 2 * 128 * 64 / 4; i += NTHR) ((f32x4*)keys)[i] = ((const f32x4*)gk)[i]; }
    __syncthreads();
    const bf16_t* QP = (const bf16_t*)(ws + WS_R1); int* IDX = (int*)(ws + WS_R1 + SZ_T1K); float* WT = (float*)(ws + WS_R1 + SZ_T1K + (size_t)T * 128 * 4);
    unsigned* myl = ilist + c.tid * 8; const unsigned char* mylb = (const unsigned char*)myl;
    for (int task = c.bid * NWAVE + c.wave; task < T * 8 / 64; task += c.G * NWAVE) {
        const int item = task * 64 + c.lane, tok = item >> 3, h = item & 7;
        const bf16_t* qp = QP + (size_t)tok * D + h * 128;
        int t1[16], t2[16];
        top16_half(keys, qp, t1);
        top16_half(keys + 128 * 64, qp + 64, t2);
        float v1[16], v2[16];
#pragma unroll
        for (int i = 0; i < 16; ++i) { v1[i] = key2f(t1[i] & ~127); v2[i] = key2f(t2[i] & ~127); }
#pragma unroll
        for (int i = 0; i < 4; ++i) {
            myl[i] = (unsigned)(127 - (t1[4 * i] & 127)) | ((unsigned)(127 - (t1[4 * i + 1] & 127)) << 8) | ((unsigned)(127 - (t1[4 * i + 2] & 127)) << 16) | ((unsigned)(127 - (t1[4 * i + 3] & 127)) << 24);
            myl[4 + i] = (unsigned)(127 - (t2[4 * i] & 127)) | ((unsigned)(127 - (t2[4 * i + 1] & 127)) << 8) | ((unsigned)(127 - (t2[4 * i + 2] & 127)) << 16) | ((unsigned)(127 - (t2[4 * i + 3] & 127)) << 24); }
        int f[16];
#pragma unroll
        for (int i = 0; i < 16; ++i) f[i] = (int)0x80000000;
#pragma unroll
        for (int a = 0; a < 16; ++a)
#pragma unroll
            for (int b = 0; b < 16; ++b)
                if ((a + 1) * (b + 1) <= 16) {
                    int key = (f2key(v1[a] + v2[b]) & ~255) | (255 - (a * 16 + b));
#pragma unroll
                    for (int i = 0; i < 16; ++i) { const int hi = max(key, f[i]); key = min(key, f[i]); f[i] = hi; }
                }
        float e[16], se = 0.f; int fi[16];
        const float vmax = key2f(f[0] & ~255);
#pragma unroll
        for (int i = 0; i < 16; ++i) { const int code = 255 - (f[i] & 255); fi[i] = (int)mylb[code >> 4] * 128 + (int)mylb[16 + (code & 15)];
            e[i] = __expf(key2f(f[i] & ~255) - vmax); se += e[i]; }
        const float inv = 1.0f / se;
        int* ip = IDX + (size_t)tok * 128 + h * 16; float* wp = WT + (size_t)tok * 128 + h * 16;
#pragma unroll
        for (int i = 0; i < 16; i += 4) { *(int4*)(ip + i) = make_int4(fi[i], fi[i + 1], fi[i + 2], fi[i + 3]); *(f32x4*)(wp + i) = (f32x4){e[i] * inv, e[i + 1] * inv, e[i + 2] * inv, e[i + 3] * inv}; }
    }
}

DI void phase_experts(const Ctx& c, int L) {
    const Params& p = *c.p; unsigned char* ws = c.ws; const int lane = c.lane;
    const bf16_t* H2 = (const bf16_t*)(ws + WS_R2 + SZ_T1K);
    const int* IDX = (const int*)(ws + WS_R1 + SZ_T1K); const float* WT = (const float*)(ws + WS_R1 + SZ_T1K + (size_t)T * 128 * 4);
    const unsigned char* UT = ws + WS_UT + (size_t)L * NEXP * 1024; const unsigned char* VT = ws + WS_VT + (size_t)L * NEXP * 1024;
    const float* SU = (const float*)(ws + WS_SU) + (size_t)L * NEXP; const float* SV = (const float*)(ws + WS_SV) + (size_t)L * NEXP;
    float* XS = (float*)(ws + WS_XS); bf16_t* H1 = (bf16_t*)(ws + WS_H1);
    const float* MOD = (const float*)(ws + WS_MOD) + (size_t)L * 17 * 6144;
    const float* lg = p.in[6] + (size_t)(L * 2 + 1) * D; const float* lb = p.in[7] + (size_t)(L * 2 + 1) * D;
    const int nrows = (L == DEPTH - 1) ? TL : T;
    for (int row = c.bid * NWAVE + c.wave; row < nrows; row += c.G * NWAVE) {
        f32x2 xf[8];
        { const u32x4 xa = *(const u32x4*)(H2 + (size_t)row * D + 16 * lane), xb = *(const u32x4*)(H2 + (size_t)row * D + 16 * lane + 8);
#pragma unroll
          for (int j = 0; j < 4; ++j) { xf[j] = (f32x2){bf_lo(xa[j]), bf_hi(xa[j])}; xf[4 + j] = (f32x2){bf_lo(xb[j]), bf_hi(xb[j])}; } }
        int idv[2]; float wv[2], suv[2], svv[2], act[2];
#pragma unroll
        for (int hh = 0; hh < 2; ++hh) { idv[hh] = IDX[(size_t)row * 128 + 64 * hh + lane]; wv[hh] = WT[(size_t)row * 128 + 64 * hh + lane]; }
#pragma unroll
        for (int hh = 0; hh < 2; ++hh) { suv[hh] = SU[idv[hh]]; svv[hh] = SV[idv[hh]]; }
#pragma unroll
        for (int hh = 0; hh < 2; ++hh) {
            float zz = 0.f;
            for (int e0 = 0; e0 < 64; e0 += 16) {
                u32x4 r[16];
#pragma unroll
                for (int k = 0; k < 16; ++k) { const int ex = __builtin_amdgcn_readlane(idv[hh], e0 + k); r[k] = *(const u32x4*)(UT + (size_t)ex * 1024 + 16 * lane); }
                float pp[16];
#pragma unroll
                for (int k = 0; k < 16; ++k) { f32x2 acc = {0.f, 0.f};
#pragma unroll
                    for (int j = 0; j < 4; ++j) { acc += __builtin_amdgcn_cvt_pk_f32_fp8((int)r[k][j], false) * xf[2 * j]; acc += __builtin_amdgcn_cvt_pk_f32_fp8((int)r[k][j], true) * xf[2 * j + 1]; }
                    pp[k] = acc[0] + acc[1]; }
                const int rel = lane - e0;
#pragma unroll
                for (int g4 = 0; g4 < 4; ++g4) { const float sred = reduce4(pp[4 * g4], pp[4 * g4 + 1], pp[4 * g4 + 2], pp[4 * g4 + 3]);
#pragma unroll
                    for (int R = 0; R < 4; ++R) { const float z = __int_as_float(__builtin_amdgcn_readlane(__float_as_int(sred), 16 * R)); zz = (rel == 4 * g4 + R) ? z : zz; } }
            }
            act[hh] = gelu_tanh(zz * suv[hh]) * wv[hh] * svv[hh];
        }
        f32x2 o[8];
#pragma unroll
        for (int j = 0; j < 8; ++j) o[j] = (f32x2){0.f, 0.f};
#pragma unroll
        for (int hh = 0; hh < 2; ++hh) {
            for (int e0 = 0; e0 < 64; e0 += 16) {
                u32x4 r[16];
#pragma unroll
                for (int k = 0; k < 16; ++k) { const int ex = __builtin_amdgcn_readlane(idv[hh], e0 + k); r[k] = *(const u32x4*)(VT + (size_t)ex * 1024 + 16 * lane); }
#pragma unroll
                for (int k = 0; k < 16; ++k) { const float a = __int_as_float(__builtin_amdgcn_readlane(__float_as_int(act[hh]), e0 + k)); const f32x2 a2 = {a, a};
#pragma unroll
                    for (int j = 0; j < 4; ++j) { o[2 * j] += a2 * __builtin_amdgcn_cvt_pk_f32_fp8((int)r[k][j], false); o[2 * j + 1] += a2 * __builtin_amdgcn_cvt_pk_f32_fp8((int)r[k][j], true); } }
            }
        }
        float* xp = XS + (size_t)row * D + 16 * lane; const int mb = mod_batch(row); const float* m = MOD + (size_t)mb * 6144 + 16 * lane;
        float y[16]; float s = 0.f;
#pragma unroll
        for (int qd = 0; qd < 4; ++qd) { const f32x4 x1 = *(const f32x4*)(xp + 4 * qd), g2 = *(const f32x4*)(m + 5 * 1024 + 4 * qd);
            y[4 * qd] = DN_ALPHA * x1[0] + g2[0] * o[2 * qd][0]; y[4 * qd + 1] = DN_ALPHA * x1[1] + g2[1] * o[2 * qd][1];
            y[4 * qd + 2] = DN_ALPHA * x1[2] + g2[2] * o[2 * qd + 1][0]; y[4 * qd + 3] = DN_ALPHA * x1[3] + g2[3] * o[2 * qd + 1][1];
            s += (y[4 * qd] + y[4 * qd + 1]) + (y[4 * qd + 2] + y[4 * qd + 3]); }
        const float mean = wave_sum(s) * (1.0f / 1024.0f);
        float q = 0.f;
#pragma unroll
        for (int j = 0; j < 16; ++j) { const float d = y[j] - mean; q += d * d; }
        const float rstd = rsqrtf(wave_sum(q) * (1.0f / 1024.0f) + LN_EPS);
        const float* mn = (const float*)(ws + WS_MOD) + (size_t)(L + 1 < DEPTH ? L + 1 : L) * 17 * 6144 + (size_t)mb * 6144 + 16 * lane;
#pragma unroll
        for (int qd = 0; qd < 4; ++qd) { const int col = 16 * lane + 4 * qd;
            const f32x4 gg = *(const f32x4*)(lg + col), bb = *(const f32x4*)(lb + col); f32x4 x2;
#pragma unroll
            for (int j = 0; j < 4; ++j) x2[j] = (y[4 * qd + j] - mean) * rstd * gg[j] + bb[j];
            if (L == DEPTH - 1) { *(f32x4*)(p.out + (size_t)row * D + col) = x2; }
            else { *(f32x4*)(xp + 4 * qd) = x2;
                const f32x4 h = x2 * (*(const f32x4*)(mn + 1024 + 4 * qd) + 1.0f) + *(const f32x4*)(mn + 4 * qd);
                u32x2 w; w.x = pk_bf16(h[0], h[1]); w.y = pk_bf16(h[2], h[3]);
                *(u32x2*)(H1 + (size_t)row * D + col) = w; } }
    }
}

DI float logsig_fast(float z) { return fminf(z, 0.f) - __logf(1.0f + __expf(-fabsf(z))); }
DI void phase_gla_prep(const Ctx& c, int j) {
    const Params& p = *c.p; unsigned char* ws = c.ws; const int tid = c.tid;
    const bf16_t* QG = (const bf16_t*)(ws + WS_R1); const bf16_t* KG = (const bf16_t*)(ws + WS_R1 + SZ_T512); const bf16_t* VG = (const bf16_t*)(ws + WS_R1 + 2 * SZ_T512);
    const float* GL = (const float*)(ws + WS_GL); float* DEC = (float*)(ws + WS_DEC); bf16_t* VTt = (bf16_t*)(ws + WS_VTT);
    bf16_t* Qt = (bf16_t*)c.smem;
    bf16_t* Kt = Qt + 64 * 512;
    float* gl = (float*)(c.smem + 131072);
    for (int ch = c.bid; ch < T / 64; ch += c.G) {
        const int r0 = ch * 64;
        __syncthreads();
#pragma unroll 4
        for (int it = 0; it < 8; ++it) { const int idx = it * 512 + tid, row = idx >> 6, c8 = (idx & 63) * 8;
            *(u32x4*)(Qt + row * 512 + c8) = *(const u32x4*)(QG + (size_t)(r0 + row) * 512 + c8);
            *(u32x4*)(Kt + row * 512 + c8) = *(const u32x4*)(KG + (size_t)(r0 + row) * 512 + c8); }
        ((f32x4*)gl)[tid] = ((const f32x4*)(GL + (size_t)r0 * 32))[tid];
        __syncthreads();
#pragma unroll
        for (int dir = 0; dir < 2; ++dir) {
            float wg[16];
#pragma unroll
            for (int r = 0; r < 16; ++r) wg[r] = p.in[15][((size_t)(j * 2 + dir) * 16 + r) * 512 + tid];
            const float bias = p.in[16][(size_t)(j * 2 + dir) * 512 + tid];
            float total = 0.f;
            for (int i = 0; i < 64; ++i) { float z = bias; const f32x4* gp = (const f32x4*)(gl + i * 32 + dir * 16);
#pragma unroll
                for (int r4 = 0; r4 < 4; ++r4) { const f32x4 gv = gp[r4]; z += gv[0] * wg[4 * r4] + gv[1] * wg[4 * r4 + 1] + gv[2] * wg[4 * r4 + 2] + gv[3] * wg[4 * r4 + 3]; }
                total += logsig_fast(z) * (1.0f / 16.0f); }
            DEC[((size_t)dir * (T / 64) + ch) * 512 + tid] = __expf(total);
            bf16_t* QIN = (bf16_t*)(ws + WS_R2) + (size_t)dir * T * 512; bf16_t* KIN = (bf16_t*)(ws + WS_R2 + SZ_T1K) + (size_t)dir * T * 512;
            bf16_t* KENDt = (bf16_t*)(ws + WS_R2 + 2 * SZ_T1K) + (((size_t)dir * (T / 64) + ch) * 512 + tid) * 64;
            float cum = 0.f;
            for (int blk = 0; blk < 8; ++blk) { const int jb = dir ? 56 - 8 * blk : 8 * blk; float kev[8];
#pragma unroll
                for (int e = 0; e < 8; ++e) { const int pos = dir ? 7 - e : e, i = jb + pos; float z = bias; const f32x4* gp = (const f32x4*)(gl + i * 32 + dir * 16);
#pragma unroll
                    for (int r4 = 0; r4 < 4; ++r4) { const f32x4 gv = gp[r4]; z += gv[0] * wg[4 * r4] + gv[1] * wg[4 * r4 + 1] + gv[2] * wg[4 * r4 + 2] + gv[3] * wg[4 * r4 + 3]; }
                    cum += logsig_fast(z) * (1.0f / 16.0f);
                    const float qv = bf1(Qt[i * 512 + tid]), kv = bf1(Kt[i * 512 + tid]);
                    const size_t o = (size_t)(r0 + i) * 512 + tid;
                    QIN[o] = f2bf(qv * __expf(cum)); KIN[o] = f2bf(kv * __expf(-cum)); kev[pos] = kv * __expf(total - cum); }
                u32x4 w; w.x = pk_bf16(kev[0], kev[1]); w.y = pk_bf16(kev[2], kev[3]); w.z = pk_bf16(kev[4], kev[5]); w.w = pk_bf16(kev[6], kev[7]);
                *(u32x4*)(KENDt + jb) = w; }
        }
        __syncthreads();
        bf16_t* Vl = Qt;
#pragma unroll 8
        for (int it = 0; it < 16; ++it) { const int idx = it * 512 + tid, row = idx >> 7, c8 = (idx & 127) * 8;
            *(u32x4*)(Vl + row * 1024 + c8) = *(const u32x4*)(VG + (size_t)(r0 + row) * 1024 + c8); }
        __syncthreads();
#pragma unroll
        for (int cc = 0; cc < 2; ++cc) { const int e = tid + 512 * cc; bf16_t* vp = VTt + ((size_t)ch * 1024 + e) * 64;
            for (int jb = 0; jb < 64; jb += 8) { unsigned short x[8];
#pragma unroll
                for (int t = 0; t < 8; ++t) x[t] = Vl[(jb + t) * 1024 + e];
                u32x4 w; w.x = (unsigned)x[0] | ((unsigned)x[1] << 16); w.y = (unsigned)x[2] | ((unsigned)x[3] << 16); w.z = (unsigned)x[4] | ((unsigned)x[5] << 16); w.w = (unsigned)x[6] | ((unsigned)x[7] << 16);
                *(u32x4*)(vp + jb) = w; } }
    }
}

DI void phase_gla_scan(const Ctx& c) {
    unsigned char* ws = c.ws; const int tid = c.tid, lane = c.lane, w = c.wave, g = lane >> 4, cc = lane & 15;
    const bf16_t* VTt = (const bf16_t*)(ws + WS_VTT); const float* DEC = (const float*)(ws + WS_DEC); bf16_t* O = (bf16_t*)(ws + WS_H1);
    constexpr int LDQ = 136, LDJ = 72;
    bf16_t* Qs = (bf16_t*)c.smem;
    bf16_t* Ks = Qs + 64 * LDQ;
    bf16_t* KEt = Ks + 64 * LDQ;
    bf16_t* Vt = KEt + 128 * LDJ;
    bf16_t* At = Vt + 64 * LDJ;
    bf16_t* St = At + 64 * LDJ;
    bf16_t* Ot = St + 64 * LDQ;
    float* dec = (float*)(Ot + 64 * LDJ);
    const int qtok0 = tid >> 4, qd8 = (tid & 15) * 8;
    const int ked0 = tid >> 3, kej8 = (tid & 7) * 8;
    for (int u = c.bid; u < NB * 4 * 4; u += c.G) {
        const int b = u >> 4, h = (u >> 2) & 3, es = u & 3;
        for (int dir = 0; dir < 2; ++dir) {
            const bf16_t* QIN = (const bf16_t*)(ws + WS_R2) + (size_t)dir * T * 512; const bf16_t* KIN = (const bf16_t*)(ws + WS_R2 + SZ_T1K) + (size_t)dir * T * 512;
            const bf16_t* KENDt = (const bf16_t*)(ws + WS_R2 + 2 * SZ_T1K) + (size_t)dir * (T / 64) * 512 * 64;
            f32x4 accS[4];
#pragma unroll
            for (int et = 0; et < 4; ++et) accS[et] = (f32x4){0.f, 0.f, 0.f, 0.f};
            __syncthreads();
            for (int i = tid; i < 64 * LDQ / 2; i += NTHR) ((unsigned*)St)[i] = 0u;
            u32x4 pq[2], pk[2], pke[2], pv, po; float pdec = 0.f;
            po = (u32x4){0u, 0u, 0u, 0u};
#define GLA_R0(cs_) (dir == 0 ? ((cs_) < 4 ? TL + b * CTXL + 64 * (cs_) : b * SEQ + 64 * ((cs_) - 4)) : ((cs_) < 4 ? TL + b * CTXL + 64 * (3 - (cs_)) : b * SEQ + 64 * (35 - (cs_))))
#define GLA_LOAD(cs_) do { const int r0_ = GLA_R0(cs_); const int chunk_ = r0_ >> 6; \
                _Pragma("unroll") for (int it = 0; it < 2; ++it) { const size_t go = (size_t)(r0_ + qtok0 + 32 * it) * 512 + h * 128 + qd8; pq[it] = *(const u32x4*)(QIN + go); pk[it] = *(const u32x4*)(KIN + go); \
                    pke[it] = *(const u32x4*)(KENDt + ((size_t)chunk_ * 512 + h * 128 + ked0 + 64 * it) * 64 + kej8); } \
                pv = *(const u32x4*)(VTt + ((size_t)chunk_ * 1024 + h * 256 + es * 64 + ked0) * 64 + kej8); \
                if (dir) po = *(const u32x4*)(O + (size_t)(r0_ + ked0) * 1024 + h * 256 + es * 64 + kej8); \
                if (tid < 128) pdec = DEC[((size_t)dir * (T / 64) + chunk_) * 512 + h * 128 + tid]; } while (0)
            GLA_LOAD(0);
            for (int cs = 0; cs < 36; ++cs) {
                const int r0 = GLA_R0(cs);
#pragma unroll
                for (int it = 0; it < 2; ++it) { *(u32x4*)(Qs + (qtok0 + 32 * it) * LDQ + qd8) = pq[it]; *(u32x4*)(Ks + (qtok0 + 32 * it) * LDQ + qd8) = pk[it]; *(u32x4*)(KEt + (ked0 + 64 * it) * LDJ + kej8) = pke[it]; }
                *(u32x4*)(Vt + ked0 * LDJ + kej8) = pv;
                *(u32x4*)(Ot + ked0 * LDJ + kej8) = po;
                if (tid < 128) dec[tid] = pdec;
                __syncthreads();
                if (cs + 1 < 36) GLA_LOAD(cs + 1);
                { const int it = w >> 1;
#pragma unroll
                  for (int jj = 0; jj < 2; ++jj) { const int jt = 2 * (w & 1) + jj; f32x4 a = {0.f, 0.f, 0.f, 0.f};
#pragma unroll
                      for (int ks = 0; ks < 4; ++ks) a = mfma16(frag_ld(Qs, LDQ, 16 * it, 32 * ks, lane), frag_ld(Ks, LDQ, 16 * jt, 32 * ks, lane), a);
                      const int jcol = 16 * jt + cc;
#pragma unroll
                      for (int r = 0; r < 4; ++r) { const int i = 16 * it + 4 * g + r; const bool keep = dir ? (jcol >= i) : (jcol <= i);
                          At[i * LDJ + jcol] = f2bf(keep ? a[r] : 0.f); } } }
                __syncthreads();
                { const int it = w >> 1;
#pragma unroll
                  for (int ee = 0; ee < 2; ++ee) { const int et = 2 * (w & 1) + ee; f32x4 a = {0.f, 0.f, 0.f, 0.f};
#pragma unroll
                      for (int ks = 0; ks < 2; ++ks) a = mfma16(frag_ld(At, LDJ, 16 * it, 32 * ks, lane), frag_ld(Vt, LDJ, 16 * et, 32 * ks, lane), a);
#pragma unroll
                      for (int ks = 0; ks < 4; ++ks) a = mfma16(frag_ld(Qs, LDQ, 16 * it, 32 * ks, lane), frag_ld(St, LDQ, 16 * et, 32 * ks, lane), a);
#pragma unroll
                      for (int r = 0; r < 4; ++r) { bf16_t* op = Ot + (16 * it + 4 * g + r) * LDJ + 16 * et + cc; *op = f2bf(a[r] + bf1(*op)); } } }
#pragma unroll
                for (int et = 0; et < 4; ++et) {
#pragma unroll
                    for (int r = 0; r < 4; ++r) accS[et][r] *= dec[16 * w + 4 * g + r];
#pragma unroll
                    for (int ks = 0; ks < 2; ++ks) accS[et] = mfma16(frag_ld(KEt, LDJ, 16 * w, 32 * ks, lane), frag_ld(Vt, LDJ, 16 * et, 32 * ks, lane), accS[et]);
                }
                __syncthreads();
#pragma unroll
                for (int et = 0; et < 4; ++et) { u32x2 sv; sv.x = pk_bf16(accS[et][0], accS[et][1]); sv.y = pk_bf16(accS[et][2], accS[et][3]);
                    *(u32x2*)(St + (16 * et + cc) * LDQ + 16 * w + 4 * g) = sv; }
                *(u32x4*)(O + (size_t)(r0 + ked0) * 1024 + h * 256 + es * 64 + kej8) = *(const u32x4*)(Ot + ked0 * LDJ + kej8);
            }
#undef GLA_LOAD
#undef GLA_R0
        }
    }
}

DI void phase_gla_readout(const Ctx& c, int j) {
    const Params& p = *c.p; unsigned char* ws = c.ws;
    const bf16_t* O = (const bf16_t*)(ws + WS_H1); const bf16_t* RG = (const bf16_t*)(ws + WS_R1 + 2 * SZ_T512 + SZ_T1K); bf16_t* Y = (bf16_t*)(ws + WS_R2);
    const float* gn = p.in[17] + (size_t)j * 1024;
    for (int row = c.bid * NWAVE + c.wave; row < T; row += c.G * NWAVE) {
#pragma unroll
        for (int hd = 0; hd < 4; ++hd) { const int col = 4 * c.lane + 256 * hd;
            const u32x2 ov = *(const u32x2*)(O + (size_t)row * D + col), rv = *(const u32x2*)(RG + (size_t)row * D + col);
            const float x0 = bf_lo(ov.x), x1 = bf_hi(ov.x), x2 = bf_lo(ov.y), x3 = bf_hi(ov.y);
            const float mean = wave_sum((x0 + x1) + (x2 + x3)) * (1.0f / 256.0f);
            const float d0 = x0 - mean, d1 = x1 - mean, d2 = x2 - mean, d3 = x3 - mean;
            const float rstd = rsqrtf(wave_sum((d0 * d0 + d1 * d1) + (d2 * d2 + d3 * d3)) * (1.0f / 256.0f) + LN_EPS);
            const f32x4 gg = *(const f32x4*)(gn + col);
            const float r0 = bf_lo(rv.x), r1 = bf_hi(rv.x), r2 = bf_lo(rv.y), r3 = bf_hi(rv.y);
            u32x2 o; o.x = pk_bf16(d0 * rstd * gg[0] * silu_f(r0), d1 * rstd * gg[1] * silu_f(r1)); o.y = pk_bf16(d2 * rstd * gg[2] * silu_f(r2), d3 * rstd * gg[3] * silu_f(r3));
            *(u32x2*)(Y + (size_t)row * D + col) = o; }
    }
}

constexpr int N_PHASES = 2 + 2 * 8 + 2 * 9;

__global__ void __launch_bounds__(NTHR, 2) mega_fwd(Params p) {
    extern __shared__ __attribute__((aligned(16))) unsigned char smem[];
    cg::grid_group grid = cg::this_grid();
    Ctx c; c.p = &p; c.ws = p.ws; c.smem = smem; c.tid = threadIdx.x; c.lane = c.tid & 63; c.wave = __builtin_amdgcn_readfirstlane(c.tid >> 6); c.G = gridDim.x; c.bid = blockIdx.x;
    unsigned char* ws = p.ws;
    unsigned* ctr = (unsigned*)(ws + WS_CTL);
    unsigned target = 0;
    const int lo = p.ph_lo, hi = p.ph_hi;
    int ph = 0;
#ifndef PH_ONLY
#define PH_ONLY -1
#endif
#ifndef DUP_MASK
#define DUP_MASK 0
#endif
#define RUN1(...) { { int t_ = threadIdx.x; asm volatile("" : "+v"(t_)); c.tid = t_; c.lane = t_ & 63; c.wave = __builtin_amdgcn_readfirstlane(t_ >> 6); ws = p.ws; asm volatile("" : "+s"(ws)); c.ws = ws; } __VA_ARGS__; }
#define RUN(id, ...) do { if ((PH_ONLY < 0 || PH_ONLY == (id)) && ph >= lo && ph < hi) { \
        RUN1(__VA_ARGS__) \
        if ((DUP_MASK >> (id)) & 1) { grid_barrier(ctr, target); RUN1(__VA_ARGS__) } \
        if (ph + 1 < hi) { if (ph == 0) grid.sync(); else grid_barrier(ctr, target); } } ++ph; } while (0)
    LAS unsigned char* lds = (LAS unsigned char*)smem;
    const float* MOD = (const float*)(ws + WS_MOD);

    RUN(0, phase_prologue(c));
    RUN(1, phase_mod0(c));
    for (int L = 0; L < DEPTH; ++L) {
        const int j = L >> 1;
        if ((L & 1) == 0) {
            RUN(2, { pg8::Gemm g{(const bf16_t*)(ws + WS_H1), (const bf16_t*)(ws + WS_WAIN) + (size_t)j * 2048 * 1024, T, 2048, 1024}; pg8::StaticOrder S; S.init(T, 2048, c.G, c.bid);
                  pg8::EpiBf16<1> E{(bf16_t*)(ws + WS_R1), 2048}; pg8::gemm_phase(lds, g, S, E, c.tid); });
            RUN(3, phase_vstats(c));
            RUN(4, phase_spatial(c, j));
        } else {
            RUN(5, { pg8::Gemm g{(const bf16_t*)(ws + WS_H1), (const bf16_t*)(ws + WS_WBIN) + (size_t)j * WBIN_N * 1024, T, WBIN_N, 1024}; pg8::StaticOrder S; S.init(T, WBIN_N, c.G, c.bid);
                  pg8::EpiGlaProj E{(bf16_t*)(ws + WS_R1), (bf16_t*)(ws + WS_R1 + SZ_T512), (bf16_t*)(ws + WS_R1 + 2 * SZ_T512), (bf16_t*)(ws + WS_R1 + 2 * SZ_T512 + SZ_T1K), (float*)(ws + WS_GL)};
                  pg8::gemm_phase(lds, g, S, E, c.tid); });
            RUN(6, phase_gla_prep(c, j));
            RUN(7, phase_gla_scan(c));
            RUN(8, phase_gla_readout(c, j));
        }
        RUN(9, { const bf16_t* W = (L & 1) ? (const bf16_t*)(ws + WS_WBOUT) + (size_t)j * 1024 * 1024 : (const bf16_t*)(ws + WS_WAOUT) + (size_t)j * 1024 * 1024;
              pg8::Gemm g{(const bf16_t*)(ws + WS_R2), W, T, 1024, 1024}; pg8::StaticOrder S; S.init(T, 1024, c.G, c.bid);
              pg8::EpiRes E{L == 0 ? p.in[0] : (const float*)(ws + WS_XS), L == 0 ? p.in[2] : (const float*)(ws + WS_XS) + (size_t)TL * D, (float*)(ws + WS_XS), MOD + (size_t)L * 17 * 6144, 2};
              pg8::gemm_phase(lds, g, S, E, c.tid); });
        RUN(10, phase_ln1(c, L));
        RUN(11, { pg8::Gemm g{(const bf16_t*)(ws + WS_R2 + SZ_T1K), (const bf16_t*)(ws + WS_WQ) + (size_t)L * 1024 * 1024, T, 1024, 1024}; pg8::StaticOrder S; S.init(T, 1024, c.G, c.bid);
              pg8::EpiBf16<0> E{(bf16_t*)(ws + WS_R1), 1024}; pg8::gemm_phase(lds, g, S, E, c.tid); });
        RUN(12, phase_route(c, L));
        RUN(13, phase_experts(c, L));
    }
#undef RUN
}

extern "C" void kernel_launch(void* const* d_in, const int* in_sizes, int n_in, void* d_out, int out_size, void* d_ws, size_t ws_size, hipStream_t stream) {
    static int grid = 0;
    if (grid == 0) {
        if (n_in != 23 || out_size != TL * D || ws_size < WS_END) { fprintf(stderr, "kernel_launch: unexpected shapes: n_in %d out %d ws %zu (need %zu)\n", n_in, out_size, ws_size, (size_t)WS_END); grid = -1; return; }
        int dev = 0, cus = 0, per_cu = 0;
        if (hipGetDevice(&dev) != hipSuccess || hipDeviceGetAttribute(&cus, hipDeviceAttributeMultiprocessorCount, dev) != hipSuccess) { fprintf(stderr, "kernel_launch: device query failed\n"); grid = -1; return; }
        if (hipFuncSetAttribute((const void*)mega_fwd, hipFuncAttributeMaxDynamicSharedMemorySize, LDS_BYTES) != hipSuccess) { fprintf(stderr, "kernel_launch: hipFuncSetAttribute failed\n"); grid = -1; return; }
        if (hipOccupancyMaxActiveBlocksPerMultiprocessor(&per_cu, (const void*)mega_fwd, NTHR, LDS_BYTES) != hipSuccess || per_cu < 1) { fprintf(stderr, "kernel_launch: occupancy query says %d blocks per CU\n", per_cu); grid = -1; return; }
        grid = cus;
    }
    if (grid < 0) return;
    (void)hipMemsetAsync((char*)d_ws + WS_CTL, 0, 65536, stream);
    Params p{};
    for (int i = 0; i < 23; ++i) p.in[i] = (const float*)d_in[i];
    p.out = (float*)d_out; p.ws = (unsigned char*)d_ws; p.ph_lo = 0; p.ph_hi = N_PHASES;
    void* args[] = {&p};
    const hipError_t e = hipLaunchCooperativeKernel((const void*)mega_fwd, dim3(grid), dim3(NTHR), args, LDS_BYTES, stream);
    if (e != hipSuccess) fprintf(stderr, "kernel_launch: cooperative launch failed: %s (grid %d)\n", hipGetErrorString(e), grid);
}
```

```cpp
#include <hip/hip_runtime.h>
#include <hip/hip_cooperative_groups.h>
#include <cstdio>
#include <cstdint>
namespace cg = cooperative_groups;

#define LAS __attribute__((address_space(3)))
#define DI __device__ __forceinline__
typedef unsigned short bf16_t;
typedef short bf16x8 __attribute__((ext_vector_type(8)));
typedef float f32x4 __attribute__((ext_vector_type(4)));
typedef float f32x2 __attribute__((ext_vector_type(2)));
typedef unsigned u32x4 __attribute__((ext_vector_type(4)));
typedef unsigned u32x2 __attribute__((ext_vector_type(2)));
typedef __bf16 bf16v2 __attribute__((ext_vector_type(2)));

constexpr int D = 1024, NB = 16, SEQ = 2048, CTXL = 256, DEPTH = 4;
constexpr int TL = NB * SEQ, TC = NB * CTXL, T = TL + TC;
constexpr int NEXP = 16384;
constexpr float LN_EPS = 1e-5f;
constexpr float DN_ALPHA = 1.6817928305074290f;
constexpr int NTHR = 512, NWAVE = 8;
constexpr int LDS_BYTES = 140 * 1024;
constexpr int WBIN_N = 3328;

constexpr size_t al256(size_t x) { return (x + 255) & ~(size_t)255; }
constexpr size_t WS_CTL = 0;
constexpr size_t WS_MOD = 65536;
constexpr size_t WS_STATS = al256(WS_MOD + (size_t)4 * 17 * 6144 * 4);
constexpr size_t WS_GL = al256(WS_STATS + (size_t)T * 2 * 4);
constexpr size_t WS_DEC = al256(WS_GL + (size_t)T * 32 * 4);
constexpr size_t WS_WSB = al256(WS_DEC + (size_t)2 * 576 * 512 * 4);
constexpr size_t WS_WAIN = al256(WS_WSB + (size_t)2 * 8 * 128 * 128 * 2);
constexpr size_t WS_WAOUT = WS_WAIN + (size_t)2 * 2048 * 1024 * 2;
constexpr size_t WS_WBIN = WS_WAOUT + (size_t)2 * 1024 * 1024 * 2;
constexpr size_t WS_WBOUT = WS_WBIN + (size_t)2 * WBIN_N * 1024 * 2;
constexpr size_t WS_WQ = WS_WBOUT + (size_t)2 * 1024 * 1024 * 2;
constexpr size_t WS_UT = WS_WQ + (size_t)4 * 1024 * 1024 * 2;
constexpr size_t WS_VT = WS_UT + (size_t)4 * NEXP * 1024;
constexpr size_t WS_SU = WS_VT + (size_t)4 * NEXP * 1024;
constexpr size_t WS_SV = WS_SU + (size_t)4 * NEXP * 4;
constexpr size_t WS_XS = WS_SV + (size_t)4 * NEXP * 4;
constexpr size_t WS_R1 = WS_XS + (size_t)T * 1024 * 4;
constexpr size_t WS_R2 = WS_R1 + (size_t)T * 3072 * 2;
constexpr size_t WS_H1 = WS_R2 + (size_t)T * 3072 * 2;
constexpr size_t WS_VTT = WS_H1 + (size_t)T * 1024 * 2;
constexpr size_t WS_END = WS_VTT + (size_t)T * 1024 * 2;
constexpr size_t SZ_T1K = (size_t)T * 1024 * 2;
constexpr size_t SZ_T512 = (size_t)T * 512 * 2;

struct Params { const float* in[23]; float* out; unsigned char* ws; int ph_lo, ph_hi; };

DI unsigned pk_bf16(float lo, float hi) { f32x2 v = {lo, hi}; return __builtin_bit_cast(unsigned, __builtin_convertvector(v, bf16v2)); }
DI float bf_lo(unsigned w) { return __uint_as_float(w << 16); }
DI float bf_hi(unsigned w) { return __uint_as_float(w & 0xffff0000u); }
DI float bf1(bf16_t b) { return __uint_as_float(((unsigned)b) << 16); }
DI bf16_t f2bf(float f) { return (bf16_t)(pk_bf16(f, 0.f) & 0xffffu); }
DI float gelu_tanh(float x) { const float u = 0.7978845608028654f * (x + 0.044715f * x * x * x); return __fdividef(x, 1.0f + __expf(-2.0f * u)); }
DI float silu_f(float x) { return __fdividef(x, 1.0f + __expf(-x)); }
DI float logsig_f(float z) { return fminf(z, 0.f) - log1pf(expf(-fabsf(z))); }
DI float wave_sum(float v) {
#pragma unroll
    for (int o = 32; o > 0; o >>= 1) v += __shfl_xor(v, o, 64);
    return v;
}
DI float wave_max(float v) {
#pragma unroll
    for (int o = 32; o > 0; o >>= 1) v = fmaxf(v, __shfl_xor(v, o, 64));
    return v;
}
template <int CTRL> DI float dpp_mov(float x) { return __builtin_bit_cast(float, __builtin_amdgcn_mov_dpp(__builtin_bit_cast(int, x), CTRL, 0xf, 0xf, true)); }
DI float reduce4(float p0, float p1, float p2, float p3) {
    const auto a = __builtin_amdgcn_permlane32_swap(__float_as_uint(p0), __float_as_uint(p2), false, false); const float q0 = __uint_as_float(a[0]) + __uint_as_float(a[1]);
    const auto b = __builtin_amdgcn_permlane32_swap(__float_as_uint(p1), __float_as_uint(p3), false, false); const float q1 = __uint_as_float(b[0]) + __uint_as_float(b[1]);
    const auto c = __builtin_amdgcn_permlane16_swap(__float_as_uint(q0), __float_as_uint(q1), false, false); float s = __uint_as_float(c[0]) + __uint_as_float(c[1]);
    s += dpp_mov<0x128>(s); s += dpp_mov<0x124>(s); s += dpp_mov<0x122>(s); s += dpp_mov<0x121>(s);
    return s;
}
DI float dot2bf(unsigned a, unsigned b, float c) { return __builtin_amdgcn_fdot2_f32_bf16(__builtin_bit_cast(bf16v2, a), __builtin_bit_cast(bf16v2, b), c, false); }
DI f32x4 mfma16(bf16x8 a, bf16x8 b, f32x4 c) { return __builtin_amdgcn_mfma_f32_16x16x32_bf16(a, b, c, 0, 0, 0); }
DI bf16x8 frag_ld(const bf16_t* X, int ld, int row0, int k0, int lane) { return *(const bf16x8*)(X + (size_t)(row0 + (lane & 15)) * ld + k0 + 8 * (lane >> 4)); }
DI int mod_batch(int row) { return row < TL ? (row >> 11) : NB; }

DI void grid_barrier(unsigned* ctr, unsigned& target) {
    asm volatile("s_waitcnt vmcnt(0)" ::: "memory");
    __syncthreads();
    target += gridDim.x;
    if (threadIdx.x == 0) {
        __builtin_amdgcn_fence(__ATOMIC_RELEASE, "agent");
        asm volatile("s_waitcnt vmcnt(0)" ::: "memory");
        __hip_atomic_fetch_add(ctr, 1u, __ATOMIC_RELAXED, __HIP_MEMORY_SCOPE_AGENT);
        while (__hip_atomic_load(ctr, __ATOMIC_RELAXED, __HIP_MEMORY_SCOPE_AGENT) < target) __builtin_amdgcn_s_sleep(2);
        __builtin_amdgcn_fence(__ATOMIC_ACQUIRE, "agent");
        asm volatile("s_waitcnt vmcnt(0)" ::: "memory");
    }
    __syncthreads();
}

namespace pg8 {
constexpr int BM = 256, BK = 64, HALF = 128, HTB = HALF * BK * 2, STAGE_BYTES = 8 * HTB, NXCD = 8, WGM = 8;
__host__ __device__ __forceinline__ int lds_byte(int r, int c) { const int st = (r >> 4) * 2 + (c >> 5), rr = r & 15, cc = c & 31, ob = rr * 64 + cc * 2; return st * 1024 + (ob ^ (((ob >> 9) & 1) << 5)); }
__host__ __device__ __forceinline__ void stage_rc(int b, int& R, int& C) { const int st = b / 1024, sb = b % 1024, swz = sb ^ (((sb >> 9) & 1) << 5); R = (st >> 1) * 16 + swz / 64; C = (st & 1) * 32 + (swz % 64) / 2; }
__host__ __device__ __forceinline__ int perm32(int rho) { const int n = rho >> 4, i = rho & 15; return 8 * (i >> 2) + 4 * n + (i & 3); }
struct Unit { int pm, pn; };
struct Gemm { const bf16_t* A; const bf16_t* Bt; int M, N, K; };
struct StaticOrder {
    int nM, nN, nwg, G, c;
    __device__ void init(int M, int N, int G_, int c_) { nM = M / BM; nN = N / BM; nwg = nM * nN; G = G_; c = c_; }
    __device__ bool next(int i, Unit& u) const {
        const long L = (long)i * G + c; if (L >= nwg) return false;
        int wgid = (int)L; { const int q = nwg / NXCD, r = nwg % NXCD, xcd = wgid % NXCD, off = wgid / NXCD; wgid = (xcd < r ? xcd * (q + 1) : r * (q + 1) + (xcd - r) * q) + off; }
        const int nig = WGM * nN, gid = wgid / nig, fm = gid * WGM, gsz = (nM - fm) < WGM ? (nM - fm) : WGM;
        u.pm = fm + ((wgid % nig) % gsz); u.pn = (wgid % nig) / gsz; return true;
    }
};

template <class Epi>
__device__ __forceinline__ void gemm_phase(LAS unsigned char* lds, const Gemm g, const StaticOrder& S, const Epi& E, const int tid) {
    const int wid = __builtin_amdgcn_readfirstlane(tid >> 6), lane = tid & 63, wr = wid >> 2, wc = wid & 3, fr = lane & 15, fq = lane >> 4;
    const int K = g.K, nt = K / BK;
    unsigned voffA[2], voffB[2];
#pragma unroll
    for (int i = 0; i < 2; ++i) { int R, C; stage_rc(tid * 16 + i * 8192, R, C); const int Rb = Epi::PERM ? ((R & ~31) + perm32(R & 31)) : R;
        voffA[i] = (unsigned)(R * K + C) * 2u; voffB[i] = (unsigned)(Rb * K + C) * 2u; }
    const size_t kstep = (size_t)(BK * 2);
    const size_t hstep = (size_t)HALF * K * 2;
    const size_t tstep = 2 * hstep;
    const unsigned ldsw = (unsigned)wid * 1024u;
    const int aoff = lds_byte(wr * 64 + fr, fq * 8), boff = lds_byte(wc * 32 + fr, fq * 8);
#define PG8_SA(b, h) (((b) * 2 + (h)) * HTB)
#define PG8_SB(b, h) ((4 + (b) * 2 + (h)) * HTB)
#define PG8_STAGE(bufoff, gbase, voff) do { _Pragma("unroll") for (int _i = 0; _i < 2; ++_i) \
        __builtin_amdgcn_global_load_lds((const unsigned*)((const char*)(gbase) + (voff)[_i]), (LAS unsigned*)(lds + (bufoff) + ldsw + _i * 8192), 16, 0, 0); } while (0)
#define PG8_LDA(dst, b, h) do { _Pragma("unroll") for (int m = 0; m < 4; ++m) _Pragma("unroll") for (int k = 0; k < 2; ++k) dst[m][k] = *(const LAS bf16x8*)(lds + PG8_SA(b, h) + aoff + m * 2048 + k * 1024); } while (0)
#define PG8_LDB(dst, b, h) do { _Pragma("unroll") for (int n = 0; n < 2; ++n) _Pragma("unroll") for (int k = 0; k < 2; ++k) dst[n][k] = *(const LAS bf16x8*)(lds + PG8_SB(b, h) + boff + n * 2048 + k * 1024); } while (0)
#define PG8_MMA(ai, bj, At, Bt) do { __builtin_amdgcn_s_setprio(1); _Pragma("unroll") for (int m = 0; m < 4; ++m) _Pragma("unroll") for (int n = 0; n < 2; ++n) _Pragma("unroll") for (int k = 0; k < 2; ++k) \
        acc[ai][bj][m][n] = __builtin_amdgcn_mfma_f32_16x16x32_bf16(Bt[n][k], At[m][k], acc[ai][bj][m][n], 0, 0, 0); __builtin_amdgcn_s_setprio(0); } while (0)
#define PG8_WAIT_V(n) asm volatile("s_waitcnt vmcnt(" #n ")" ::: "memory")
#define PG8_WAIT_L(n) asm volatile("s_waitcnt lgkmcnt(" #n ")" ::: "memory")
#define PG8_BAR __builtin_amdgcn_s_barrier()
#define PG8_SCHED __builtin_amdgcn_sched_barrier(0)
    Unit cur, nxt; int ui = 0;
    if (!S.next(0, cur)) return;
    f32x4 acc[2][2][4][2];
#pragma unroll
    for (int a = 0; a < 2; ++a)
#pragma unroll
        for (int b = 0; b < 2; ++b)
#pragma unroll
            for (int m = 0; m < 4; ++m)
#pragma unroll
                for (int n = 0; n < 2; ++n) acc[a][b][m][n] = (f32x4){0.f, 0.f, 0.f, 0.f};
    bf16x8 At[4][2], B0[2][2], B1[2][2];
    const char* cA = (const char*)g.A + (size_t)cur.pm * tstep; const char* cB = (const char*)g.Bt + (size_t)cur.pn * tstep;
    PG8_STAGE(PG8_SB(0, 0), cB, voffB); PG8_STAGE(PG8_SA(0, 0), cA, voffA); PG8_STAGE(PG8_SB(0, 1), cB + hstep, voffB); PG8_STAGE(PG8_SA(0, 1), cA + hstep, voffA);
    if (wr == 1) PG8_BAR;
    PG8_WAIT_V(4); PG8_BAR;
    PG8_STAGE(PG8_SB(1, 0), cB + kstep, voffB); PG8_STAGE(PG8_SA(1, 0), cA + kstep, voffA); PG8_STAGE(PG8_SB(1, 1), cB + hstep + kstep, voffB);
    PG8_WAIT_V(6); PG8_BAR;
    for (;;) {
        const bool has_next = S.next(ui + 1, nxt);
        const char* nA = has_next ? (const char*)g.A + (size_t)nxt.pm * tstep : cA; const char* nB = has_next ? (const char*)g.Bt + (size_t)nxt.pn * tstep : cB;
        for (int t = 0; t < nt; t += 2) {
            const bool last = (t == nt - 2);
            const char* a1 = cA + (size_t)(t + 1) * kstep;
            const char* a2 = last ? nA : cA + (size_t)(t + 2) * kstep; const char* b2 = last ? nB : cB + (size_t)(t + 2) * kstep;
            const char* a3 = a2 + kstep; const char* b3 = b2 + kstep;
            PG8_LDB(B0, 0, 0); PG8_SCHED; PG8_LDA(At, 0, 0); PG8_STAGE(PG8_SA(1, 1), a1 + hstep, voffA);
            PG8_WAIT_L(8); PG8_BAR; PG8_WAIT_L(0); PG8_MMA(0, 0, At, B0); PG8_BAR; PG8_SCHED;
            PG8_LDB(B1, 0, 1); PG8_STAGE(PG8_SB(0, 0), b2, voffB);
            PG8_BAR; PG8_WAIT_L(0); PG8_MMA(0, 1, At, B1); PG8_BAR;
            PG8_LDA(At, 0, 1); PG8_STAGE(PG8_SA(0, 0), a2, voffA);
            PG8_BAR; PG8_WAIT_L(0); PG8_MMA(1, 0, At, B0); PG8_BAR; PG8_SCHED;
            PG8_STAGE(PG8_SB(0, 1), b2 + hstep, voffB);
            PG8_WAIT_V(6); PG8_BAR; PG8_MMA(1, 1, At, B1); PG8_BAR;
            PG8_LDB(B0, 1, 0); PG8_SCHED; PG8_LDA(At, 1, 0); PG8_STAGE(PG8_SA(0, 1), a2 + hstep, voffA);
            PG8_WAIT_L(8); PG8_BAR; PG8_WAIT_L(0); PG8_MMA(0, 0, At, B0); PG8_BAR; PG8_SCHED;
            PG8_LDB(B1, 1, 1); PG8_STAGE(PG8_SB(1, 0), b3, voffB);
            PG8_BAR; PG8_WAIT_L(0); PG8_MMA(0, 1, At, B1); PG8_BAR;
            PG8_LDA(At, 1, 1); PG8_STAGE(PG8_SA(1, 0), a3, voffA);
            PG8_BAR; PG8_WAIT_L(0); PG8_MMA(1, 0, At, B0); PG8_BAR; PG8_SCHED;
            PG8_STAGE(PG8_SB(1, 1), b3 + hstep, voffB);
            PG8_WAIT_V(6); PG8_BAR; PG8_MMA(1, 1, At, B1); PG8_BAR;
        }
        E(acc, cur, wr, wc, fr, fq);
        if (!has_next) break;
#pragma unroll
        for (int a = 0; a < 2; ++a)
#pragma unroll
            for (int b = 0; b < 2; ++b)
#pragma unroll
                for (int m = 0; m < 4; ++m)
#pragma unroll
                    for (int n = 0; n < 2; ++n) acc[a][b][m][n] = (f32x4){0.f, 0.f, 0.f, 0.f};
        cur = nxt; cA = nA; cB = nB; ++ui;
    }
    PG8_WAIT_V(0);
    if (wr == 0) PG8_BAR;
    PG8_BAR;
#undef PG8_SA
#undef PG8_SB
#undef PG8_STAGE
#undef PG8_LDA
#undef PG8_LDB
#undef PG8_MMA
#undef PG8_WAIT_V
#undef PG8_WAIT_L
#undef PG8_BAR
#undef PG8_SCHED
}

template <int ACT  > struct EpiBf16 {
    static constexpr bool PERM = true;
    bf16_t* O; int ldc;
    __device__ __forceinline__ void operator()(const f32x4 (&acc)[2][2][4][2], const Unit& u, int wr, int wc, int fr, int fq) const {
        const int row0 = u.pm * BM + wr * 64 + fr, col0 = u.pn * BM + wc * 32 + 8 * fq;
#pragma unroll
        for (int ai = 0; ai < 2; ++ai)
#pragma unroll
            for (int m = 0; m < 4; ++m) { bf16_t* rowp = O + (size_t)(row0 + ai * HALF + m * 16) * ldc + col0;
#pragma unroll
                for (int bj = 0; bj < 2; ++bj) { f32x4 v0 = acc[ai][bj][m][0], v1 = acc[ai][bj][m][1];
                    if (ACT == 1) {
#pragma unroll
                        for (int j = 0; j < 4; ++j) { v0[j] = gelu_tanh(v0[j]); v1[j] = gelu_tanh(v1[j]); } }
                    u32x4 w; w.x = pk_bf16(v0[0], v0[1]); w.y = pk_bf16(v0[2], v0[3]); w.z = pk_bf16(v1[0], v1[1]); w.w = pk_bf16(v1[2], v1[3]);
                    *(u32x4*)(rowp + bj * HALF) = w; } }
    }
};
struct EpiRes {
    static constexpr bool PERM = false;
    const float* src_lat; const float* src_ctx; float* dst; const float* modL; int gate_idx;
    __device__ __forceinline__ void operator()(const f32x4 (&acc)[2][2][4][2], const Unit& u, int wr, int wc, int fr, int fq) const {
        const bool isctx = u.pm >= (TL / BM);
        const float* sb = isctx ? src_ctx + (size_t)(u.pm - TL / BM) * BM * D : src_lat + (size_t)u.pm * BM * D;
        const int mb = isctx ? NB : (u.pm >> 3);
        const float* gv = modL + (size_t)mb * 6144 + gate_idx * 1024;
        const int rl = wr * 64 + fr, col0 = u.pn * BM + wc * 32 + 4 * fq;
        f32x4 g[2][2];
#pragma unroll
        for (int bj = 0; bj < 2; ++bj)
#pragma unroll
            for (int n = 0; n < 2; ++n) g[bj][n] = *(const f32x4*)(gv + col0 + bj * HALF + n * 16);
#pragma unroll
        for (int ai = 0; ai < 2; ++ai)
#pragma unroll
            for (int m = 0; m < 4; ++m) { const int r = rl + ai * HALF + m * 16; const float* sp = sb + (size_t)r * D + col0; float* dp = dst + ((size_t)u.pm * BM + r) * D + col0;
#pragma unroll
                for (int bj = 0; bj < 2; ++bj)
#pragma unroll
                    for (int n = 0; n < 2; ++n) { const f32x4 x = *(const f32x4*)(sp + bj * HALF + n * 16); *(f32x4*)(dp + bj * HALF + n * 16) = x * DN_ALPHA + g[bj][n] * acc[ai][bj][m][n]; } }
    }
};
struct EpiGlaProj {
    static constexpr bool PERM = true;
    bf16_t* QG; bf16_t* KG; bf16_t* VG; bf16_t* RG; float* GL;
    __device__ __forceinline__ void operator()(const f32x4 (&acc)[2][2][4][2], const Unit& u, int wr, int wc, int fr, int fq) const {
        const int row0 = u.pm * BM + wr * 64 + fr, pn = u.pn;
        if (pn < 12) {
            bf16_t* base; int ld, colt; float sc = 1.f;
            if (pn < 2) { base = QG; ld = 512; colt = pn * BM; sc = 0.08838834764831845f; }
            else if (pn < 4) { base = KG; ld = 512; colt = (pn - 2) * BM; }
            else if (pn < 8) { base = VG; ld = 1024; colt = (pn - 4) * BM; }
            else { base = RG; ld = 1024; colt = (pn - 8) * BM; }
            const int col0 = colt + wc * 32 + 8 * fq;
#pragma unroll
            for (int ai = 0; ai < 2; ++ai)
#pragma unroll
                for (int m = 0; m < 4; ++m) { bf16_t* rowp = base + (size_t)(row0 + ai * HALF + m * 16) * ld + col0;
#pragma unroll
                    for (int bj = 0; bj < 2; ++bj) { const f32x4 v0 = acc[ai][bj][m][0] * sc, v1 = acc[ai][bj][m][1] * sc;
                        u32x4 w; w.x = pk_bf16(v0[0], v0[1]); w.y = pk_bf16(v0[2], v0[3]); w.z = pk_bf16(v1[0], v1[1]); w.w = pk_bf16(v1[2], v1[3]);
                        *(u32x4*)(rowp + bj * HALF) = w; } }
        } else if (wc == 0) {
#pragma unroll
            for (int ai = 0; ai < 2; ++ai)
#pragma unroll
                for (int m = 0; m < 4; ++m) { float* gp = GL + (size_t)(row0 + ai * HALF + m * 16) * 32 + 8 * fq;
                    *(f32x4*)gp = acc[ai][0][m][0]; *(f32x4*)(gp + 4) = acc[ai][0][m][1]; }
        }
    }
};
}

struct Ctx {
    const Params* p; unsigned char* ws; unsigned char* smem; int tid, lane, wave, G, bid;
};

DI void phase_prologue(const Ctx& c) {
    const Params& p = *c.p; unsigned char* ws = c.ws;
    const int tid = c.tid;
    constexpr int N_MOD = 192, N_TR = 4736, N_WS = 64, N_TAB = 2048;
    constexpr int N_ALL = N_MOD + N_TR + N_WS + N_TAB;
    for (int u = c.bid; u < N_ALL; u += c.G) {
        if (u < N_MOD) {
            const int l = u / 48, n0 = (u % 48) * 128;
            float* sc = (float*)c.smem;
            float* red = (float*)(c.smem + 17 * 1024 * 4);
            __syncthreads();
            for (int i = tid; i < 17 * 1024; i += NTHR) { const int b = i >> 10, k = i & 1023; const float v = (b < NB) ? p.in[1][b * 1024 + k] : p.in[3][k]; sc[i] = silu_f(v); }
            __syncthreads();
            const int c4 = (tid & 31) * 4, kg = tid >> 5;
            float acc[17][4];
#pragma unroll
            for (int b = 0; b < 17; ++b) { acc[b][0] = 0.f; acc[b][1] = 0.f; acc[b][2] = 0.f; acc[b][3] = 0.f; }
            const float* wp = p.in[4] + ((size_t)l * 1024 + (size_t)kg * 64) * 6144 + n0 + c4;
#pragma unroll 4
            for (int kk = 0; kk < 64; ++kk) {
                const f32x4 w = *(const f32x4*)(wp + (size_t)kk * 6144);
                const int k = kg * 64 + kk;
#pragma unroll
                for (int b = 0; b < 17; ++b) { const float s = sc[b * 1024 + k]; acc[b][0] += s * w[0]; acc[b][1] += s * w[1]; acc[b][2] += s * w[2]; acc[b][3] += s * w[3]; }
            }
#pragma unroll
            for (int b = 0; b < 17; ++b)
#pragma unroll
                for (int j = 0; j < 4; ++j) acc[b][j] += __shfl_xor(acc[b][j], 32, 64);
            if ((tid & 32) == 0) {
#pragma unroll
                for (int b = 0; b < 17; ++b)
#pragma unroll
                    for (int j = 0; j < 4; ++j) red[(c.wave * 17 + b) * 128 + c4 + j] = acc[b][j];
            }
            __syncthreads();
            for (int o = tid; o < 17 * 128; o += NTHR) { const int b = o >> 7, n = o & 127; float s = 0.f;
#pragma unroll
                for (int w = 0; w < 8; ++w) s += red[(w * 17 + b) * 128 + n];
                ((float*)(ws + WS_MOD))[((size_t)l * 17 + b) * 6144 + n0 + n] = s + p.in[5][l * 6144 + n0 + n]; }
        } else if (u < N_MOD + N_TR) {
            int v = u - N_MOD; const float* src; bf16_t* dst; int N, Npad;
            if (v < 1024) { const int j = v / 512; v %= 512; src = p.in[8] + (size_t)j * 1024 * 2048; dst = (bf16_t*)(ws + WS_WAIN) + (size_t)j * 2048 * 1024; N = 2048; Npad = 2048; }
            else if (v < 1536) { v -= 1024; const int j = v / 256; v %= 256; src = p.in[13] + (size_t)j * 1024 * 1024; dst = (bf16_t*)(ws + WS_WAOUT) + (size_t)j * 1024 * 1024; N = 1024; Npad = 1024; }
            else if (v < 3200) { v -= 1536; const int j = v / 832; v %= 832; src = p.in[14] + (size_t)j * 1024 * 3104; dst = (bf16_t*)(ws + WS_WBIN) + (size_t)j * WBIN_N * 1024; N = 3104; Npad = WBIN_N; }
            else if (v < 3712) { v -= 3200; const int j = v / 256; v %= 256; src = p.in[18] + (size_t)j * 1024 * 1024; dst = (bf16_t*)(ws + WS_WBOUT) + (size_t)j * 1024 * 1024; N = 1024; Npad = 1024; }
            else { v -= 3712; const int j = v / 256; v %= 256; src = p.in[19] + (size_t)j * 1024 * 1024; dst = (bf16_t*)(ws + WS_WQ) + (size_t)j * 1024 * 1024; N = 1024; Npad = 1024; }
            (void)Npad;
            const int ntn = v >> 4, ktile = v & 15, n0 = ntn * 64, k0 = ktile * 64;
            float* tl = (float*)c.smem;
            __syncthreads();
#pragma unroll
            for (int i = 0; i < 2; ++i) { const int kk = (tid >> 4) + 32 * i, nn = (tid & 15) * 4;
                f32x4 x = {0.f, 0.f, 0.f, 0.f};
                if (n0 + nn < N) x = *(const f32x4*)(src + (size_t)(k0 + kk) * N + n0 + nn);
                tl[kk * 65 + nn] = x[0]; tl[kk * 65 + nn + 1] = x[1]; tl[kk * 65 + nn + 2] = x[2]; tl[kk * 65 + nn + 3] = x[3]; }
            __syncthreads();
            { const int nn = tid >> 3, kk8 = (tid & 7) * 8; float x[8];
#pragma unroll
              for (int j = 0; j < 8; ++j) x[j] = tl[(kk8 + j) * 65 + nn];
              u32x4 w; w.x = pk_bf16(x[0], x[1]); w.y = pk_bf16(x[2], x[3]); w.z = pk_bf16(x[4], x[5]); w.w = pk_bf16(x[6], x[7]);
              *(u32x4*)(dst + (size_t)(n0 + nn) * 1024 + k0 + kk8) = w; }
        } else if (u < N_MOD + N_TR + N_WS) {
            const int v = u - N_MOD - N_TR; const size_t e = (size_t)v * 4096 + (size_t)tid * 8;
            const f32x4 a = *(const f32x4*)(p.in[11] + e), b = *(const f32x4*)(p.in[11] + e + 4);
            u32x4 w; w.x = pk_bf16(a[0], a[1]); w.y = pk_bf16(a[2], a[3]); w.z = pk_bf16(b[0], b[1]); w.w = pk_bf16(b[2], b[3]);
            *(u32x4*)((bf16_t*)(ws + WS_WSB) + e) = w;
        } else {
            const int v = u - N_MOD - N_TR - N_WS; const int tab = v >> 10;
            const float* src = p.in[21 + tab]; unsigned char* dst = ws + (tab ? WS_VT : WS_UT); float* sc = (float*)(ws + (tab ? WS_SV : WS_SU));
#pragma unroll 2
            for (int i = 0; i < 8; ++i) { const size_t row = (size_t)(v & 1023) * 64 + c.wave * 8 + i;
                const float* rp = src + row * 1024 + 16 * c.lane; f32x4 x[4]; float am = 0.f;
#pragma unroll
                for (int q = 0; q < 4; ++q) { x[q] = __builtin_nontemporal_load((const f32x4*)(rp + 4 * q)); am = fmaxf(am, fmaxf(fmaxf(fabsf(x[q][0]), fabsf(x[q][1])), fmaxf(fabsf(x[q][2]), fabsf(x[q][3])))); }
                am = fmaxf(wave_max(am), 1e-30f);
                const float inv = 440.0f / am; u32x4 w;
#pragma unroll
                for (int q = 0; q < 4; ++q) { int t = 0; t = __builtin_amdgcn_cvt_pk_fp8_f32(x[q][0] * inv, x[q][1] * inv, t, false); t = __builtin_amdgcn_cvt_pk_fp8_f32(x[q][2] * inv, x[q][3] * inv, t, true); w[q] = (unsigned)t; }
                *(u32x4*)(dst + row * 1024 + 16 * c.lane) = w;
                if (c.lane == 0) sc[row] = am * (1.0f / 440.0f); }
        }
    }
}

DI void phase_mod0(const Ctx& c) {
    const Params& p = *c.p; const float* MOD = (const float*)(c.ws + WS_MOD); bf16_t* H1 = (bf16_t*)(c.ws + WS_H1);
    for (int row = c.bid * NWAVE + c.wave; row < T; row += c.G * NWAVE) {
        const float* src = row < TL ? p.in[0] + (size_t)row * D : p.in[2] + (size_t)(row - TL) * D;
        const float* m = MOD + (size_t)mod_batch(row) * 6144;
#pragma unroll
        for (int j = 0; j < 4; ++j) { const int col = 4 * c.lane + 256 * j;
            const f32x4 x = *(const f32x4*)(src + col), sh = *(const f32x4*)(m + col), s = *(const f32x4*)(m + 1024 + col);
            const f32x4 h = x * (s + 1.0f) + sh; u32x2 w; w.x = pk_bf16(h[0], h[1]); w.y = pk_bf16(h[2], h[3]);
            *(u32x2*)(H1 + (size_t)row * D + col) = w; }
    }
}

DI void phase_vstats(const Ctx& c) {
    const bf16_t* UV = (const bf16_t*)(c.ws + WS_R1); float* ST = (float*)(c.ws + WS_STATS);
    for (int row = c.bid * NWAVE + c.wave; row < T; row += c.G * NWAVE) {
        const bf16_t* vp = UV + (size_t)row * 2048 + 1024;
        const u32x4 a = *(const u32x4*)(vp + 8 * c.lane), b = *(const u32x4*)(vp + 512 + 8 * c.lane);
        float x[16];
#pragma unroll
        for (int j = 0; j < 4; ++j) { x[2 * j] = bf_lo(a[j]); x[2 * j + 1] = bf_hi(a[j]); x[8 + 2 * j] = bf_lo(b[j]); x[9 + 2 * j] = bf_hi(b[j]); }
        float s = 0.f;
#pragma unroll
        for (int j = 0; j < 16; ++j) s += x[j];
        const float mean = wave_sum(s) * (1.0f / 1024.0f);
        float q = 0.f;
#pragma unroll
        for (int j = 0; j < 16; ++j) { const float d = x[j] - mean; q += d * d; }
        const float var = wave_sum(q) * (1.0f / 1024.0f);
        if (c.lane == 0) { ST[2 * row] = mean; ST[2 * row + 1] = rsqrtf(var + LN_EPS); }
    }
}

DI void phase_spatial(const Ctx& c, int j) {
    const Params& p = *c.p; unsigned char* ws = c.ws;
    const bf16_t* UV = (const bf16_t*)(ws + WS_R1); const float* ST = (const float*)(ws + WS_STATS); bf16_t* Y = (bf16_t*)(ws + WS_R2);
    const bf16_t* WSB = (const bf16_t*)(ws + WS_WSB) + (size_t)j * 8 * 128 * 128;
    const float* ng = p.in[9] + j * 1024; const float* nb = p.in[10] + j * 1024; const float* bs = p.in[12] + j * 8 * 128;
    constexpr int LD = 136;
    bf16_t* WsL = (bf16_t*)c.smem;
    bf16_t* VnT = WsL + 128 * LD;
    const int tid = c.tid, lane = c.lane, w = c.wave, g = lane >> 4, cc = lane & 15;
    for (int u = c.bid; u < (T / 128) * 8; u += c.G) {
        const int chunk = u >> 3, h = u & 7, r0 = chunk * 128;
        __syncthreads();
        { const int cg8 = tid & 15; float gg[8], bb[8];
#pragma unroll
          for (int e = 0; e < 8; ++e) { gg[e] = ng[h * 128 + cg8 * 8 + e]; bb[e] = nb[h * 128 + cg8 * 8 + e]; }
#pragma unroll
          for (int i = 0; i < 4; ++i) { const int idx = i * 512 + tid, tok = idx >> 4;
              const u32x4 v = *(const u32x4*)(UV + (size_t)(r0 + tok) * 2048 + 1024 + h * 128 + cg8 * 8);
              const float mean = ST[2 * (r0 + tok)], rstd = ST[2 * (r0 + tok) + 1];
              float x[8];
#pragma unroll
              for (int e = 0; e < 4; ++e) { x[2 * e] = bf_lo(v[e]); x[2 * e + 1] = bf_hi(v[e]); }
#pragma unroll
              for (int e = 0; e < 8; ++e) VnT[(cg8 * 8 + e) * LD + tok] = f2bf((x[e] - mean) * rstd * gg[e] + bb[e]);
              const int pp = idx >> 4;
              *(u32x4*)(WsL + pp * LD + cg8 * 8) = *(const u32x4*)(WSB + ((size_t)h * 128 + pp) * 128 + cg8 * 8); } }
        __syncthreads();
        f32x4 acc[8];
#pragma unroll
        for (int ct = 0; ct < 8; ++ct) acc[ct] = (f32x4){0.f, 0.f, 0.f, 0.f};
#pragma unroll
        for (int ks = 0; ks < 4; ++ks) {
            const bf16x8 bfr = frag_ld(WsL, LD, 16 * w, 32 * ks, lane);
#pragma unroll
            for (int ct = 0; ct < 8; ++ct) acc[ct] = mfma16(frag_ld(VnT, LD, 16 * ct, 32 * ks, lane), bfr, acc[ct]);
        }
        const int pp = 16 * w + cc; const float bsv = bs[h * 128 + pp];
        const size_t rowo = (size_t)(r0 + pp);
#pragma unroll
        for (int ct = 0; ct < 8; ++ct) { const int ch = h * 128 + 16 * ct + 4 * g;
            const u32x2 uu = *(const u32x2*)(UV + rowo * 2048 + ch);
            const float y0 = bf_lo(uu.x) * (acc[ct][0] + bsv), y1 = bf_hi(uu.x) * (acc[ct][1] + bsv), y2 = bf_lo(uu.y) * (acc[ct][2] + bsv), y3 = bf_hi(uu.y) * (acc[ct][3] + bsv);
            u32x2 o; o.x = pk_bf16(y0, y1); o.y = pk_bf16(y2, y3);
            *(u32x2*)(Y + rowo * D + ch) = o; }
    }
}

DI void phase_ln1(const Ctx& c, int L) {
    const Params& p = *c.p; float* XS = (float*)(c.ws + WS_XS); const float* MOD = (const float*)(c.ws + WS_MOD) + (size_t)L * 17 * 6144;
    bf16_t* H2 = (bf16_t*)(c.ws + WS_R2 + SZ_T1K);
    const float* lg = p.in[6] + (size_t)(L * 2 + 0) * D; const float* lb = p.in[7] + (size_t)(L * 2 + 0) * D;
    for (int row = c.bid * NWAVE + c.wave; row < T; row += c.G * NWAVE) {
        float* xp = XS + (size_t)row * D; const float* m = MOD + (size_t)mod_batch(row) * 6144;
        f32x4 x[4]; float s = 0.f;
#pragma unroll
        for (int j = 0; j < 4; ++j) { x[j] = *(const f32x4*)(xp + 4 * c.lane + 256 * j); s += (x[j][0] + x[j][1]) + (x[j][2] + x[j][3]); }
        const float mean = wave_sum(s) * (1.0f / 1024.0f);
        float q = 0.f;
#pragma unroll
        for (int j = 0; j < 4; ++j) { const f32x4 d = x[j] - mean; q += (d[0] * d[0] + d[1] * d[1]) + (d[2] * d[2] + d[3] * d[3]); }
        const float rstd = rsqrtf(wave_sum(q) * (1.0f / 1024.0f) + LN_EPS);
#pragma unroll
        for (int j = 0; j < 4; ++j) { const int col = 4 * c.lane + 256 * j;
            const f32x4 y = (x[j] - mean) * rstd * *(const f32x4*)(lg + col) + *(const f32x4*)(lb + col);
            *(f32x4*)(xp + col) = y;
            const f32x4 h = y * (*(const f32x4*)(m + 4 * 1024 + col) + 1.0f) + *(const f32x4*)(m + 3 * 1024 + col);
            u32x2 w; w.x = pk_bf16(h[0], h[1]); w.y = pk_bf16(h[2], h[3]);
            *(u32x2*)(H2 + (size_t)row * D + col) = w; }
    }
}

DI int f2key(float v) { const int i = __float_as_int(v); return i ^ ((i >> 31) & 0x7fffffff); }
DI float key2f(int k) { return __int_as_float(k ^ ((k >> 31) & 0x7fffffff)); }
DI void phase_route(const Ctx& c, int L) {
    const Params& p = *c.p; unsigned char* ws = c.ws; const int lane = c.lane, g = lane >> 4, cc = lane & 15;
    constexpr int LDK = 72, LDS_S = 20;
    bf16_t* keysHi = (bf16_t*)c.smem;
    bf16_t* keysLo = keysHi + 2 * 128 * LDK;
    float* sbase = (float*)(keysLo + 2 * 128 * LDK);
    unsigned* ilist = (unsigned*)(sbase + NWAVE * 64 * LDS_S);
    __syncthreads();
    { const float* gk = p.in[20] + (size_t)L * 2 * 128 * 64;
      for (int i = c.tid; i < 2 * 128 * 64; i += NTHR) { const float v = gk[i]; const bf16_t hi = f2bf(v); const int row = i >> 6, d = i & 63;
          keysHi[row * LDK + d] = hi; keysLo[row * LDK + d] = f2bf(v - bf1(hi)); } }
    __syncthreads();
    float* S = sbase + c.wave * 64 * LDS_S;
    const bf16_t* QP = (const bf16_t*)(ws + WS_R1); int* IDX = (int*)(ws + WS_R1 + SZ_T1K); float* WT = (float*)(ws + WS_R1 + SZ_T1K + (size_t)T * 128 * 4);
    unsigned* myl = ilist + c.tid * 8; const unsigned char* mylb = (const unsigned char*)myl;
    for (int task = c.bid * NWAVE + c.wave; task < (T / 64) * 8; task += c.G * NWAVE) {
        const int t0 = (task >> 3) * 64, h = task & 7, tok = t0 + lane;
        int t12[2][16];
#pragma unroll
        for (int half = 0; half < 2; ++half) {
            bf16x8 aq[4][2];
#pragma unroll
            for (int mt = 0; mt < 4; ++mt)
#pragma unroll
                for (int ks = 0; ks < 2; ++ks) aq[mt][ks] = *(const bf16x8*)(QP + (size_t)(t0 + 16 * mt + cc) * D + h * 128 + half * 64 + 32 * ks + 8 * g);
            const bf16_t* kh = keysHi + half * 128 * LDK; const bf16_t* kl = keysLo + half * 128 * LDK;
#pragma unroll
            for (int i = 0; i < 16; ++i) t12[half][i] = (int)0x80000000;
            for (int nt = 0; nt < 8; ++nt) {
                const bf16x8 bh0 = frag_ld(kh, LDK, 16 * nt, 0, lane), bh1 = frag_ld(kh, LDK, 16 * nt, 32, lane), bl0 = frag_ld(kl, LDK, 16 * nt, 0, lane), bl1 = frag_ld(kl, LDK, 16 * nt, 32, lane);
#pragma unroll
                for (int mt = 0; mt < 4; ++mt) { f32x4 a = {0.f, 0.f, 0.f, 0.f};
                    a = mfma16(aq[mt][0], bl0, a); a = mfma16(aq[mt][1], bl1, a); a = mfma16(aq[mt][0], bh0, a); a = mfma16(aq[mt][1], bh1, a);
#pragma unroll
                    for (int r = 0; r < 4; ++r) S[(16 * mt + 4 * g + r) * LDS_S + cc] = a[r]; }
                f32x4 sc[4];
#pragma unroll
                for (int q4 = 0; q4 < 4; ++q4) sc[q4] = *(const f32x4*)(S + lane * LDS_S + 4 * q4);
#pragma unroll
                for (int kk = 0; kk < 16; ++kk) { int key = (f2key(sc[kk >> 2][kk & 3]) & ~127) | (127 - (16 * nt + kk));
#pragma unroll
                    for (int i = 0; i < 16; ++i) { const int hi = max(key, t12[half][i]); key = min(key, t12[half][i]); t12[half][i] = hi; } }
            }
        }
        float v1[16], v2[16];
#pragma unroll
        for (int i = 0; i < 16; ++i) { v1[i] = key2f(t12[0][i] & ~127); v2[i] = key2f(t12[1][i] & ~127); }
#pragma unroll
        for (int i = 0; i < 4; ++i) {
            myl[i] = (unsigned)(127 - (t12[0][4 * i] & 127)) | ((unsigned)(127 - (t12[0][4 * i + 1] & 127)) << 8) | ((unsigned)(127 - (t12[0][4 * i + 2] & 127)) << 16) | ((unsigned)(127 - (t12[0][4 * i + 3] & 127)) << 24);
            myl[4 + i] = (unsigned)(127 - (t12[1][4 * i] & 127)) | ((unsigned)(127 - (t12[1][4 * i + 1] & 127)) << 8) | ((unsigned)(127 - (t12[1][4 * i + 2] & 127)) << 16) | ((unsigned)(127 - (t12[1][4 * i + 3] & 127)) << 24); }
        int f[16];
#pragma unroll
        for (int i = 0; i < 16; ++i) f[i] = (int)0x80000000;
#pragma unroll
        for (int a = 0; a < 16; ++a)
#pragma unroll
            for (int b = 0; b < 16; ++b)
                if ((a + 1) * (b + 1) <= 16) {
                    int key = (f2key(v1[a] + v2[b]) & ~255) | (255 - (a * 16 + b));
#pragma unroll
                    for (int i = 0; i < 16; ++i) { const int hi = max(key, f[i]); key = min(key, f[i]); f[i] = hi; }
                }
        float e[16], se = 0.f; int fi[16];
        const float vmax = key2f(f[0] & ~255);
#pragma unroll
        for (int i = 0; i < 16; ++i) { const int code = 255 - (f[i] & 255); fi[i] = (int)mylb[code >> 4] * 128 + (int)mylb[16 + (code & 15)];
            e[i] = __expf(key2f(f[i] & ~255) - vmax); se += e[i]; }
        const float inv = 1.0f / se;
        int* ip = IDX + (size_t)tok * 128 + h * 16; float* wp = WT + (size_t)tok * 128 + h * 16;
#pragma unroll
        for (int i = 0; i < 16; i += 4) { *(int4*)(ip + i) = make_int4(fi[i], fi[i + 1], fi[i + 2], fi[i + 3]); *(f32x4*)(wp + i) = (f32x4){e[i] * inv, e[i + 1] * inv, e[i + 2] * inv, e[i + 3] * inv}; }
    }
}

DI void phase_experts(const Ctx& c, int L) {
    const Params& p = *c.p; unsigned char* ws = c.ws; const int lane = c.lane;
    const bf16_t* H2 = (const bf16_t*)(ws + WS_R2 + SZ_T1K);
    const int* IDX = (const int*)(ws + WS_R1 + SZ_T1K); const float* WT = (const float*)(ws + WS_R1 + SZ_T1K + (size_t)T * 128 * 4);
    const unsigned char* UT = ws + WS_UT + (size_t)L * NEXP * 1024; const unsigned char* VT = ws + WS_VT + (size_t)L * NEXP * 1024;
    const float* SU = (const float*)(ws + WS_SU) + (size_t)L * NEXP; const float* SV = (const float*)(ws + WS_SV) + (size_t)L * NEXP;
    float* XS = (float*)(ws + WS_XS); bf16_t* H1 = (bf16_t*)(ws + WS_H1);
    const float* MOD = (const float*)(ws + WS_MOD) + (size_t)L * 17 * 6144;
    const float* lg = p.in[6] + (size_t)(L * 2 + 1) * D; const float* lb = p.in[7] + (size_t)(L * 2 + 1) * D;
    const int nrows = (L == DEPTH - 1) ? TL : T;
    for (int row = c.bid * NWAVE + c.wave; row < nrows; row += c.G * NWAVE) {
        f32x2 xf[8];
        { const u32x4 xa = *(const u32x4*)(H2 + (size_t)row * D + 16 * lane), xb = *(const u32x4*)(H2 + (size_t)row * D + 16 * lane + 8);
#pragma unroll
          for (int j = 0; j < 4; ++j) { xf[j] = (f32x2){bf_lo(xa[j]), bf_hi(xa[j])}; xf[4 + j] = (f32x2){bf_lo(xb[j]), bf_hi(xb[j])}; } }
        int idv[2]; float wv[2], suv[2], svv[2], act[2];
#pragma unroll
        for (int hh = 0; hh < 2; ++hh) { idv[hh] = IDX[(size_t)row * 128 + 64 * hh + lane]; wv[hh] = WT[(size_t)row * 128 + 64 * hh + lane]; }
#pragma unroll
        for (int hh = 0; hh < 2; ++hh) { suv[hh] = SU[idv[hh]]; svv[hh] = SV[idv[hh]]; }
#pragma unroll
        for (int hh = 0; hh < 2; ++hh) {
            float zz = 0.f;
            for (int e0 = 0; e0 < 64; e0 += 16) {
                u32x4 r[16];
#pragma unroll
                for (int k = 0; k < 16; ++k) { const int ex = __builtin_amdgcn_readlane(idv[hh], e0 + k); r[k] = *(const u32x4*)(UT + (size_t)ex * 1024 + 16 * lane); }
                float pp[16];
#pragma unroll
                for (int k = 0; k < 16; ++k) { f32x2 acc = {0.f, 0.f};
#pragma unroll
                    for (int j = 0; j < 4; ++j) { acc += __builtin_amdgcn_cvt_pk_f32_fp8((int)r[k][j], false) * xf[2 * j]; acc += __builtin_amdgcn_cvt_pk_f32_fp8((int)r[k][j], true) * xf[2 * j + 1]; }
                    pp[k] = acc[0] + acc[1]; }
                const int rel = lane - e0;
#pragma unroll
                for (int g4 = 0; g4 < 4; ++g4) { const float sred = reduce4(pp[4 * g4], pp[4 * g4 + 1], pp[4 * g4 + 2], pp[4 * g4 + 3]);
#pragma unroll
                    for (int R = 0; R < 4; ++R) { const float z = __int_as_float(__builtin_amdgcn_readlane(__float_as_int(sred), 16 * R)); zz = (rel == 4 * g4 + R) ? z : zz; } }
            }
            act[hh] = gelu_tanh(zz * suv[hh]) * wv[hh] * svv[hh];
        }
        f32x2 o[8];
#pragma unroll
        for (int j = 0; j < 8; ++j) o[j] = (f32x2){0.f, 0.f};
#pragma unroll
        for (int hh = 0; hh < 2; ++hh) {
            for (int e0 = 0; e0 < 64; e0 += 16) {
                u32x4 r[16];
#pragma unroll
                for (int k = 0; k < 16; ++k) { const int ex = __builtin_amdgcn_readlane(idv[hh], e0 + k); r[k] = *(const u32x4*)(VT + (size_t)ex * 1024 + 16 * lane); }
#pragma unroll
                for (int k = 0; k < 16; ++k) { const float a = __int_as_float(__builtin_amdgcn_readlane(__float_as_int(act[hh]), e0 + k)); const f32x2 a2 = {a, a};
#pragma unroll
                    for (int j = 0; j < 4; ++j) { o[2 * j] += a2 * __builtin_amdgcn_cvt_pk_f32_fp8((int)r[k][j], false); o[2 * j + 1] += a2 * __builtin_amdgcn_cvt_pk_f32_fp8((int)r[k][j], true); } }
            }
        }
        float* xp = XS + (size_t)row * D + 16 * lane; const int mb = mod_batch(row); const float* m = MOD + (size_t)mb * 6144 + 16 * lane;
        float y[16]; float s = 0.f;
#pragma unroll
        for (int qd = 0; qd < 4; ++qd) { const f32x4 x1 = *(const f32x4*)(xp + 4 * qd), g2 = *(const f32x4*)(m + 5 * 1024 + 4 * qd);
            y[4 * qd] = DN_ALPHA * x1[0] + g2[0] * o[2 * qd][0]; y[4 * qd + 1] = DN_ALPHA * x1[1] + g2[1] * o[2 * qd][1];
            y[4 * qd + 2] = DN_ALPHA * x1[2] + g2[2] * o[2 * qd + 1][0]; y[4 * qd + 3] = DN_ALPHA * x1[3] + g2[3] * o[2 * qd + 1][1];
            s += (y[4 * qd] + y[4 * qd + 1]) + (y[4 * qd + 2] + y[4 * qd + 3]); }
        const float mean = wave_sum(s) * (1.0f / 1024.0f);
        float q = 0.f;
#pragma unroll
        for (int j = 0; j < 16; ++j) { const float d = y[j] - mean; q += d * d; }
        const float rstd = rsqrtf(wave_sum(q) * (1.0f / 1024.0f) + LN_EPS);
        const float* mn = (const float*)(ws + WS_MOD) + (size_t)(L + 1 < DEPTH ? L + 1 : L) * 17 * 6144 + (size_t)mb * 6144 + 16 * lane;
#pragma unroll
        for (int qd = 0; qd < 4; ++qd) { const int col = 16 * lane + 4 * qd;
            const f32x4 gg = *(const f32x4*)(lg + col), bb = *(const f32x4*)(lb + col); f32x4 x2;
#pragma unroll
            for (int j = 0; j < 4; ++j) x2[j] = (y[4 * qd + j] - mean) * rstd * gg[j] + bb[j];
            if (L == DEPTH - 1) { *(f32x4*)(p.out + (size_t)row * D + col) = x2; }
            else { *(f32x4*)(xp + 4 * qd) = x2;
                const f32x4 h = x2 * (*(const f32x4*)(mn + 1024 + 4 * qd) + 1.0f) + *(const f32x4*)(mn + 4 * qd);
                u32x2 w; w.x = pk_bf16(h[0], h[1]); w.y = pk_bf16(h[2], h[3]);
                *(u32x2*)(H1 + (size_t)row * D + col) = w; } }
    }
}

DI float logsig_fast(float z) { return fminf(z, 0.f) - __logf(1.0f + __expf(-fabsf(z))); }
DI void phase_gla_prep(const Ctx& c, int j) {
    const Params& p = *c.p; unsigned char* ws = c.ws; const int tid = c.tid;
    const bf16_t* QG = (const bf16_t*)(ws + WS_R1); const bf16_t* KG = (const bf16_t*)(ws + WS_R1 + SZ_T512); const bf16_t* VG = (const bf16_t*)(ws + WS_R1 + 2 * SZ_T512);
    const float* GL = (const float*)(ws + WS_GL); float* DEC = (float*)(ws + WS_DEC); bf16_t* VTt = (bf16_t*)(ws + WS_VTT);
    bf16_t* Qt = (bf16_t*)c.smem;
    bf16_t* Kt = Qt + 64 * 512;
    float* gl = (float*)(c.smem + 131072);
    for (int ch = c.bid; ch < T / 64; ch += c.G) {
        const int r0 = ch * 64;
        __syncthreads();
#pragma unroll 4
        for (int it = 0; it < 8; ++it) { const int idx = it * 512 + tid, row = idx >> 6, c8 = (idx & 63) * 8;
            *(u32x4*)(Qt + row * 512 + c8) = *(const u32x4*)(QG + (size_t)(r0 + row) * 512 + c8);
            *(u32x4*)(Kt + row * 512 + c8) = *(const u32x4*)(KG + (size_t)(r0 + row) * 512 + c8); }
        ((f32x4*)gl)[tid] = ((const f32x4*)(GL + (size_t)r0 * 32))[tid];
        __syncthreads();
#pragma unroll
        for (int dir = 0; dir < 2; ++dir) {
            float wg[16];
#pragma unroll
            for (int r = 0; r < 16; ++r) wg[r] = p.in[15][((size_t)(j * 2 + dir) * 16 + r) * 512 + tid];
            const float bias = p.in[16][(size_t)(j * 2 + dir) * 512 + tid];
            bf16_t* QIN = (bf16_t*)(ws + WS_R2) + (size_t)dir * T * 512; bf16_t* KIN = (bf16_t*)(ws + WS_R2 + SZ_T1K) + (size_t)dir * T * 512;
            bf16_t* KINt = (bf16_t*)(ws + WS_R2 + 2 * SZ_T1K) + (((size_t)dir * (T / 64) + ch) * 512 + tid) * 64;
            float cum = 0.f;
            for (int blk = 0; blk < 8; ++blk) { const int jb = dir ? 56 - 8 * blk : 8 * blk; float gs[8];
#pragma unroll
                for (int e = 0; e < 8; ++e) { const int i = jb + e; float z = bias; const f32x4* gp = (const f32x4*)(gl + i * 32 + dir * 16);
#pragma unroll
                    for (int r4 = 0; r4 < 4; ++r4) { const f32x4 gv = gp[r4]; z += gv[0] * wg[4 * r4] + gv[1] * wg[4 * r4 + 1] + gv[2] * wg[4 * r4 + 2] + gv[3] * wg[4 * r4 + 3]; }
                    gs[e] = logsig_fast(z) * (1.0f / 16.0f); }
                float kiv[8];
#pragma unroll
                for (int e = 0; e < 8; ++e) { const int pos = dir ? 7 - e : e, i = jb + pos;
                    cum += gs[pos];
                    const float qv = bf1(Qt[i * 512 + tid]), kv = bf1(Kt[i * 512 + tid]);
                    const size_t o = (size_t)(r0 + i) * 512 + tid;
                    const float ki = kv * __expf(-cum);
                    QIN[o] = f2bf(qv * __expf(cum)); KIN[o] = f2bf(ki); kiv[pos] = ki; }
                u32x4 w; w.x = pk_bf16(kiv[0], kiv[1]); w.y = pk_bf16(kiv[2], kiv[3]); w.z = pk_bf16(kiv[4], kiv[5]); w.w = pk_bf16(kiv[6], kiv[7]);
                *(u32x4*)(KINt + jb) = w; }
            DEC[((size_t)dir * (T / 64) + ch) * 512 + tid] = __expf(cum);
        }
        __syncthreads();
        bf16_t* Vl = Qt;
#pragma unroll 8
        for (int it = 0; it < 16; ++it) { const int idx = it * 512 + tid, row = idx >> 7, c8 = (idx & 127) * 8;
            *(u32x4*)(Vl + row * 1024 + c8) = *(const u32x4*)(VG + (size_t)(r0 + row) * 1024 + c8); }
        __syncthreads();
#pragma unroll
        for (int cc = 0; cc < 2; ++cc) { const int e = tid + 512 * cc; bf16_t* vp = VTt + ((size_t)ch * 1024 + e) * 64;
            for (int jb = 0; jb < 64; jb += 8) { unsigned short x[8];
#pragma unroll
                for (int t = 0; t < 8; ++t) x[t] = Vl[(jb + t) * 1024 + e];
                u32x4 w; w.x = (unsigned)x[0] | ((unsigned)x[1] << 16); w.y = (unsigned)x[2] | ((unsigned)x[3] << 16); w.z = (unsigned)x[4] | ((unsigned)x[5] << 16); w.w = (unsigned)x[6] | ((unsigned)x[7] << 16);
                *(u32x4*)(vp + jb) = w; } }
    }
}

DI void phase_gla_scan(const Ctx& c) {
    unsigned char* ws = c.ws; const int tid = c.tid, lane = c.lane, w = c.wave, g = lane >> 4, cc = lane & 15;
    const bf16_t* VTt = (const bf16_t*)(ws + WS_VTT); const float* DEC = (const float*)(ws + WS_DEC); bf16_t* O = (bf16_t*)(ws + WS_H1);
    constexpr int LDQ = 136, LDJ = 72;
    bf16_t* Qs = (bf16_t*)c.smem;
    bf16_t* Ks = Qs + 64 * LDQ;
    bf16_t* KEt = Ks + 64 * LDQ;
    bf16_t* Vt = KEt + 128 * LDJ;
    bf16_t* At = Vt + 64 * LDJ;
    bf16_t* St = At + 64 * LDJ;
    bf16_t* Ot = St + 64 * LDQ;
    float* dec = (float*)(Ot + 64 * LDJ);
    const int qtok0 = tid >> 4, qd8 = (tid & 15) * 8;
    const int ked0 = tid >> 3, kej8 = (tid & 7) * 8;
    for (int u = c.bid; u < NB * 4 * 4; u += c.G) {
        const int b = u >> 4, h = (u >> 2) & 3, es = u & 3;
        for (int dir = 0; dir < 2; ++dir) {
            const bf16_t* QIN = (const bf16_t*)(ws + WS_R2) + (size_t)dir * T * 512; const bf16_t* KIN = (const bf16_t*)(ws + WS_R2 + SZ_T1K) + (size_t)dir * T * 512;
            const bf16_t* KENDt = (const bf16_t*)(ws + WS_R2 + 2 * SZ_T1K) + (size_t)dir * (T / 64) * 512 * 64;
            f32x4 accS[4];
#pragma unroll
            for (int et = 0; et < 4; ++et) accS[et] = (f32x4){0.f, 0.f, 0.f, 0.f};
            __syncthreads();
            for (int i = tid; i < 64 * LDQ / 2; i += NTHR) ((unsigned*)St)[i] = 0u;
            u32x4 pq[2], pk[2], pke[2], pv, po; float pdec = 0.f;
            po = (u32x4){0u, 0u, 0u, 0u};
#define GLA_R0(cs_) (dir == 0 ? ((cs_) < 4 ? TL + b * CTXL + 64 * (cs_) : b * SEQ + 64 * ((cs_) - 4)) : ((cs_) < 4 ? TL + b * CTXL + 64 * (3 - (cs_)) : b * SEQ + 64 * (35 - (cs_))))
#define GLA_LOAD(cs_) do { const int r0_ = GLA_R0(cs_); const int chunk_ = r0_ >> 6; \
                _Pragma("unroll") for (int it = 0; it < 2; ++it) { const size_t go = (size_t)(r0_ + qtok0 + 32 * it) * 512 + h * 128 + qd8; pq[it] = *(const u32x4*)(QIN + go); pk[it] = *(const u32x4*)(KIN + go); \
                    pke[it] = *(const u32x4*)(KENDt + ((size_t)chunk_ * 512 + h * 128 + ked0 + 64 * it) * 64 + kej8); } \
                pv = *(const u32x4*)(VTt + ((size_t)chunk_ * 1024 + h * 256 + es * 64 + ked0) * 64 + kej8); \
                if (dir) po = *(const u32x4*)(O + (size_t)(r0_ + ked0) * 1024 + h * 256 + es * 64 + kej8); \
                if (tid < 128) pdec = DEC[((size_t)dir * (T / 64) + chunk_) * 512 + h * 128 + tid]; } while (0)
            GLA_LOAD(0);
            for (int cs = 0; cs < 36; ++cs) {
                const int r0 = GLA_R0(cs);
#pragma unroll
                for (int it = 0; it < 2; ++it) { *(u32x4*)(Qs + (qtok0 + 32 * it) * LDQ + qd8) = pq[it]; *(u32x4*)(Ks + (qtok0 + 32 * it) * LDQ + qd8) = pk[it]; *(u32x4*)(KEt + (ked0 + 64 * it) * LDJ + kej8) = pke[it]; }
                *(u32x4*)(Vt + ked0 * LDJ + kej8) = pv;
                *(u32x4*)(Ot + ked0 * LDJ + kej8) = po;
                if (tid < 128) dec[tid] = pdec;
                __syncthreads();
                if (cs + 1 < 36) GLA_LOAD(cs + 1);
                { const int it = w >> 1;
#pragma unroll
                  for (int jj = 0; jj < 2; ++jj) { const int jt = 2 * (w & 1) + jj; f32x4 a = {0.f, 0.f, 0.f, 0.f};
#pragma unroll
                      for (int ks = 0; ks < 4; ++ks) a = mfma16(frag_ld(Qs, LDQ, 16 * it, 32 * ks, lane), frag_ld(Ks, LDQ, 16 * jt, 32 * ks, lane), a);
                      const int jcol = 16 * jt + cc;
#pragma unroll
                      for (int r = 0; r < 4; ++r) { const int i = 16 * it + 4 * g + r; const bool keep = dir ? (jcol >= i) : (jcol <= i);
                          At[i * LDJ + jcol] = f2bf(keep ? a[r] : 0.f); } } }
                __syncthreads();
                { const int it = w >> 1;
#pragma unroll
                  for (int ee = 0; ee < 2; ++ee) { const int et = 2 * (w & 1) + ee; f32x4 a = {0.f, 0.f, 0.f, 0.f};
#pragma unroll
                      for (int ks = 0; ks < 2; ++ks) a = mfma16(frag_ld(At, LDJ, 16 * it, 32 * ks, lane), frag_ld(Vt, LDJ, 16 * et, 32 * ks, lane), a);
#pragma unroll
                      for (int ks = 0; ks < 4; ++ks) a = mfma16(frag_ld(Qs, LDQ, 16 * it, 32 * ks, lane), frag_ld(St, LDQ, 16 * et, 32 * ks, lane), a);
#pragma unroll
                      for (int r = 0; r < 4; ++r) { bf16_t* op = Ot + (16 * it + 4 * g + r) * LDJ + 16 * et + cc; *op = f2bf(a[r] + bf1(*op)); } } }
#pragma unroll
                for (int et = 0; et < 4; ++et) {
#pragma unroll
                    for (int ks = 0; ks < 2; ++ks) accS[et] = mfma16(frag_ld(KEt, LDJ, 16 * w, 32 * ks, lane), frag_ld(Vt, LDJ, 16 * et, 32 * ks, lane), accS[et]);
#pragma unroll
                    for (int r = 0; r < 4; ++r) accS[et][r] *= dec[16 * w + 4 * g + r];
                }
                __syncthreads();
#pragma unroll
                for (int et = 0; et < 4; ++et) { u32x2 sv; sv.x = pk_bf16(accS[et][0], accS[et][1]); sv.y = pk_bf16(accS[et][2], accS[et][3]);
                    *(u32x2*)(St + (16 * et + cc) * LDQ + 16 * w + 4 * g) = sv; }
                *(u32x4*)(O + (size_t)(r0 + ked0) * 1024 + h * 256 + es * 64 + kej8) = *(const u32x4*)(Ot + ked0 * LDJ + kej8);
            }
#undef GLA_LOAD
#undef GLA_R0
        }
    }
}

DI void phase_gla_readout(const Ctx& c, int j) {
    const Params& p = *c.p; unsigned char* ws = c.ws;
    const bf16_t* O = (const bf16_t*)(ws + WS_H1); const bf16_t* RG = (const bf16_t*)(ws + WS_R1 + 2 * SZ_T512 + SZ_T1K); bf16_t* Y = (bf16_t*)(ws + WS_R2);
    const float* gn = p.in[17] + (size_t)j * 1024;
    for (int row = c.bid * NWAVE + c.wave; row < T; row += c.G * NWAVE) {
#pragma unroll
        for (int hd = 0; hd < 4; ++hd) { const int col = 4 * c.lane + 256 * hd;
            const u32x2 ov = *(const u32x2*)(O + (size_t)row * D + col), rv = *(const u32x2*)(RG + (size_t)row * D + col);
            const float x0 = bf_lo(ov.x), x1 = bf_hi(ov.x), x2 = bf_lo(ov.y), x3 = bf_hi(ov.y);
            const float mean = wave_sum((x0 + x1) + (x2 + x3)) * (1.0f / 256.0f);
            const float d0 = x0 - mean, d1 = x1 - mean, d2 = x2 - mean, d3 = x3 - mean;
            const float rstd = rsqrtf(wave_sum((d0 * d0 + d1 * d1) + (d2 * d2 + d3 * d3)) * (1.0f / 256.0f) + LN_EPS);
            const f32x4 gg = *(const f32x4*)(gn + col);
            const float r0 = bf_lo(rv.x), r1 = bf_hi(rv.x), r2 = bf_lo(rv.y), r3 = bf_hi(rv.y);
            u32x2 o; o.x = pk_bf16(d0 * rstd * gg[0] * silu_f(r0), d1 * rstd * gg[1] * silu_f(r1)); o.y = pk_bf16(d2 * rstd * gg[2] * silu_f(r2), d3 * rstd * gg[3] * silu_f(r3));
            *(u32x2*)(Y + (size_t)row * D + col) = o; }
    }
}

constexpr int N_PHASES = 2 + 2 * 8 + 2 * 9;

__global__ void __launch_bounds__(NTHR, 2) mega_fwd(Params p) {
    extern __shared__ __attribute__((aligned(16))) unsigned char smem[];
    cg::grid_group grid = cg::this_grid();
    Ctx c; c.p = &p; c.ws = p.ws; c.smem = smem; c.tid = threadIdx.x; c.lane = c.tid & 63; c.wave = __builtin_amdgcn_readfirstlane(c.tid >> 6); c.G = gridDim.x; c.bid = blockIdx.x;
    unsigned char* ws = p.ws;
    unsigned* ctr = (unsigned*)(ws + WS_CTL);
    unsigned target = 0;
    const int lo = p.ph_lo, hi = p.ph_hi;
    int ph = 0;
#ifndef PH_ONLY
#define PH_ONLY -1
#endif
#ifndef DUP_MASK
#define DUP_MASK 0
#endif
#define RUN1(...) { { int t_ = threadIdx.x; asm volatile("" : "+v"(t_)); c.tid = t_; c.lane = t_ & 63; c.wave = __builtin_amdgcn_readfirstlane(t_ >> 6); ws = p.ws; asm volatile("" : "+s"(ws)); c.ws = ws; } __VA_ARGS__; }
#define RUN(id, ...) do { if ((PH_ONLY < 0 || PH_ONLY == (id)) && ph >= lo && ph < hi) { \
        RUN1(__VA_ARGS__) \
        if ((DUP_MASK >> (id)) & 1) { grid_barrier(ctr, target); RUN1(__VA_ARGS__) } \
        if (ph + 1 < hi) { if (ph == 0) grid.sync(); else grid_barrier(ctr, target); } } ++ph; } while (0)
    LAS unsigned char* lds = (LAS unsigned char*)smem;
    const float* MOD = (const float*)(ws + WS_MOD);

    RUN(0, phase_prologue(c));
    RUN(1, phase_mod0(c));
    for (int L = 0; L < DEPTH; ++L) {
        const int j = L >> 1;
        if ((L & 1) == 0) {
            RUN(2, { pg8::Gemm g{(const bf16_t*)(ws + WS_H1), (const bf16_t*)(ws + WS_WAIN) + (size_t)j * 2048 * 1024, T, 2048, 1024}; pg8::StaticOrder S; S.init(T, 2048, c.G, c.bid);
                  pg8::EpiBf16<1> E{(bf16_t*)(ws + WS_R1), 2048}; pg8::gemm_phase(lds, g, S, E, c.tid); });
            RUN(3, phase_vstats(c));
            RUN(4, phase_spatial(c, j));
        } else {
            RUN(5, { pg8::Gemm g{(const bf16_t*)(ws + WS_H1), (const bf16_t*)(ws + WS_WBIN) + (size_t)j * WBIN_N * 1024, T, WBIN_N, 1024}; pg8::StaticOrder S; S.init(T, WBIN_N, c.G, c.bid);
                  pg8::EpiGlaProj E{(bf16_t*)(ws + WS_R1), (bf16_t*)(ws + WS_R1 + SZ_T512), (bf16_t*)(ws + WS_R1 + 2 * SZ_T512), (bf16_t*)(ws + WS_R1 + 2 * SZ_T512 + SZ_T1K), (float*)(ws + WS_GL)};
                  pg8::gemm_phase(lds, g, S, E, c.tid); });
            RUN(6, phase_gla_prep(c, j));
            RUN(7, phase_gla_scan(c));
            RUN(8, phase_gla_readout(c, j));
        }
        RUN(9, { const bf16_t* W = (L & 1) ? (const bf16_t*)(ws + WS_WBOUT) + (size_t)j * 1024 * 1024 : (const bf16_t*)(ws + WS_WAOUT) + (size_t)j * 1024 * 1024;
              pg8::Gemm g{(const bf16_t*)(ws + WS_R2), W, T, 1024, 1024}; pg8::StaticOrder S; S.init(T, 1024, c.G, c.bid);
              pg8::EpiRes E{L == 0 ? p.in[0] : (const float*)(ws + WS_XS), L == 0 ? p.in[2] : (const float*)(ws + WS_XS) + (size_t)TL * D, (float*)(ws + WS_XS), MOD + (size_t)L * 17 * 6144, 2};
              pg8::gemm_phase(lds, g, S, E, c.tid); });
        RUN(10, phase_ln1(c, L));
        RUN(11, { pg8::Gemm g{(const bf16_t*)(ws + WS_R2 + SZ_T1K), (const bf16_t*)(ws + WS_WQ) + (size_t)L * 1024 * 1024, T, 1024, 1024}; pg8::StaticOrder S; S.init(T, 1024, c.G, c.bid);
              pg8::EpiBf16<0> E{(bf16_t*)(ws + WS_R1), 1024}; pg8::gemm_phase(lds, g, S, E, c.tid); });
        RUN(12, phase_route(c, L));
        RUN(13, phase_experts(c, L));
    }
#undef RUN
}

extern "C" void kernel_launch(void* const* d_in, const int* in_sizes, int n_in, void* d_out, int out_size, void* d_ws, size_t ws_size, hipStream_t stream) {
    static int grid = 0;
    if (grid == 0) {
        if (n_in != 23 || out_size != TL * D || ws_size < WS_END) { fprintf(stderr, "kernel_launch: unexpected shapes: n_in %d out %d ws %zu (need %zu)\n", n_in, out_size, ws_size, (size_t)WS_END); grid = -1; return; }
        int dev = 0, cus = 0, per_cu = 0;
        if (hipGetDevice(&dev) != hipSuccess || hipDeviceGetAttribute(&cus, hipDeviceAttributeMultiprocessorCount, dev) != hipSuccess) { fprintf(stderr, "kernel_launch: device query failed\n"); grid = -1; return; }
        if (hipFuncSetAttribute((const void*)mega_fwd, hipFuncAttributeMaxDynamicSharedMemorySize, LDS_BYTES) != hipSuccess) { fprintf(stderr, "kernel_launch: hipFuncSetAttribute failed\n"); grid = -1; return; }
        if (hipOccupancyMaxActiveBlocksPerMultiprocessor(&per_cu, (const void*)mega_fwd, NTHR, LDS_BYTES) != hipSuccess || per_cu < 1) { fprintf(stderr, "kernel_launch: occupancy query says %d blocks per CU\n", per_cu); grid = -1; return; }
        grid = cus;
    }
    if (grid < 0) return;
    (void)hipMemsetAsync((char*)d_ws + WS_CTL, 0, 65536, stream);
    Params p{};
    for (int i = 0; i < 23; ++i) p.in[i] = (const float*)d_in[i];
    p.out = (float*)d_out; p.ws = (unsigned char*)d_ws; p.ph_lo = 0; p.ph_hi = N_PHASES;
    void* args[] = {&p};
    const hipError_t e = hipLaunchCooperativeKernel((const void*)mega_fwd, dim3(grid), dim3(NTHR), args, LDS_BYTES, stream);
    if (e != hipSuccess) fprintf(stderr, "kernel_launch: cooperative launch failed: %s (grid %d)\n", hipGetErrorString(e), grid);
}
```

```cpp
#include <hip/hip_runtime.h>
#include <hip/hip_cooperative_groups.h>
#include <cstdio>
#include <cstdint>
namespace cg = cooperative_groups;

#define LAS __attribute__((address_space(3)))
#define DI __device__ __forceinline__
typedef unsigned short bf16_t;
typedef short bf16x8 __attribute__((ext_vector_type(8)));
typedef float f32x4 __attribute__((ext_vector_type(4)));
typedef float f32x2 __attribute__((ext_vector_type(2)));
typedef unsigned u32x4 __attribute__((ext_vector_type(4)));
typedef unsigned u32x2 __attribute__((ext_vector_type(2)));
typedef __bf16 bf16v2 __attribute__((ext_vector_type(2)));

constexpr int D = 1024, NB = 16, SEQ = 2048, CTXL = 256, DEPTH = 4;
constexpr int TL = NB * SEQ, TC = NB * CTXL, T = TL + TC;
constexpr int NEXP = 16384;
constexpr float LN_EPS = 1e-5f;
constexpr float DN_ALPHA = 1.6817928305074290f;
constexpr int NTHR = 512, NWAVE = 8;
constexpr int LDS_BYTES = 140 * 1024;
constexpr int WBIN_N = 3328;

constexpr size_t al256(size_t x) { return (x + 255) & ~(size_t)255; }
constexpr size_t WS_CTL = 0;
constexpr size_t WS_MOD = 65536;
constexpr size_t WS_STATS = al256(WS_MOD + (size_t)4 * 17 * 6144 * 4);
constexpr size_t WS_GL = al256(WS_STATS + (size_t)T * 2 * 4);
constexpr size_t WS_DEC = al256(WS_GL + (size_t)T * 32 * 4);
constexpr size_t WS_WSB = al256(WS_DEC + (size_t)2 * 576 * 512 * 4);
constexpr size_t WS_WAIN = al256(WS_WSB + (size_t)2 * 8 * 128 * 128 * 2);
constexpr size_t WS_WAOUT = WS_WAIN + (size_t)2 * 2048 * 1024 * 2;
constexpr size_t WS_WBIN = WS_WAOUT + (size_t)2 * 1024 * 1024 * 2;
constexpr size_t WS_WBOUT = WS_WBIN + (size_t)2 * WBIN_N * 1024 * 2;
constexpr size_t WS_WQ = WS_WBOUT + (size_t)2 * 1024 * 1024 * 2;
constexpr size_t WS_UT = WS_WQ + (size_t)4 * 1024 * 1024 * 2;
constexpr size_t WS_VT = WS_UT + (size_t)4 * NEXP * 1024;
constexpr size_t WS_SU = WS_VT + (size_t)4 * NEXP * 1024;
constexpr size_t WS_SV = WS_SU + (size_t)4 * NEXP * 4;
constexpr size_t WS_XS = WS_SV + (size_t)4 * NEXP * 4;
constexpr size_t WS_R1 = WS_XS + (size_t)T * 1024 * 4;
constexpr size_t WS_R2 = WS_R1 + (size_t)T * 3072 * 2;
constexpr size_t WS_H1 = WS_R2 + (size_t)T * 3072 * 2;
constexpr size_t WS_VTT = WS_H1 + (size_t)T * 1024 * 2;
constexpr size_t WS_END = WS_VTT + (size_t)T * 1024 * 2;
constexpr size_t SZ_T1K = (size_t)T * 1024 * 2;
constexpr size_t SZ_T512 = (size_t)T * 512 * 2;

struct Params { const float* in[23]; float* out; unsigned char* ws; int ph_lo, ph_hi; };

DI unsigned pk_bf16(float lo, float hi) { f32x2 v = {lo, hi}; return __builtin_bit_cast(unsigned, __builtin_convertvector(v, bf16v2)); }
DI float bf_lo(unsigned w) { return __uint_as_float(w << 16); }
DI float bf_hi(unsigned w) { return __uint_as_float(w & 0xffff0000u); }
DI float bf1(bf16_t b) { return __uint_as_float(((unsigned)b) << 16); }
DI bf16_t f2bf(float f) { return (bf16_t)(pk_bf16(f, 0.f) & 0xffffu); }
DI float gelu_tanh(float x) { const float u = 0.7978845608028654f * (x + 0.044715f * x * x * x); return __fdividef(x, 1.0f + __expf(-2.0f * u)); }
DI float silu_f(float x) { return __fdividef(x, 1.0f + __expf(-x)); }
DI float logsig_f(float z) { return fminf(z, 0.f) - log1pf(expf(-fabsf(z))); }
DI float wave_sum(float v) {
#pragma unroll
    for (int o = 32; o > 0; o >>= 1) v += __shfl_xor(v, o, 64);
    return v;
}
DI float wave_max(float v) {
#pragma unroll
    for (int o = 32; o > 0; o >>= 1) v = fmaxf(v, __shfl_xor(v, o, 64));
    return v;
}
template <int CTRL> DI float dpp_mov(float x) { return __builtin_bit_cast(float, __builtin_amdgcn_mov_dpp(__builtin_bit_cast(int, x), CTRL, 0xf, 0xf, true)); }
DI float reduce4(float p0, float p1, float p2, float p3) {
    const auto a = __builtin_amdgcn_permlane32_swap(__float_as_uint(p0), __float_as_uint(p2), false, false); const float q0 = __uint_as_float(a[0]) + __uint_as_float(a[1]);
    const auto b = __builtin_amdgcn_permlane32_swap(__float_as_uint(p1), __float_as_uint(p3), false, false); const float q1 = __uint_as_float(b[0]) + __uint_as_float(b[1]);
    const auto c = __builtin_amdgcn_permlane16_swap(__float_as_uint(q0), __float_as_uint(q1), false, false); float s = __uint_as_float(c[0]) + __uint_as_float(c[1]);
    s += dpp_mov<0x128>(s); s += dpp_mov<0x124>(s); s += dpp_mov<0x122>(s); s += dpp_mov<0x121>(s);
    return s;
}
DI float dot2bf(unsigned a, unsigned b, float c) { return __builtin_amdgcn_fdot2_f32_bf16(__builtin_bit_cast(bf16v2, a), __builtin_bit_cast(bf16v2, b), c, false); }
DI f32x4 mfma16(bf16x8 a, bf16x8 b, f32x4 c) { return __builtin_amdgcn_mfma_f32_16x16x32_bf16(a, b, c, 0, 0, 0); }
DI bf16x8 frag_ld(const bf16_t* X, int ld, int row0, int k0, int lane) { return *(const bf16x8*)(X + (size_t)(row0 + (lane & 15)) * ld + k0 + 8 * (lane >> 4)); }
DI int mod_batch(int row) { return row < TL ? (row >> 11) : NB; }

DI void grid_barrier(unsigned* ctr, unsigned& target) {
    asm volatile("s_waitcnt vmcnt(0)" ::: "memory");
    __syncthreads();
    target += gridDim.x;
    if (threadIdx.x == 0) {
        __builtin_amdgcn_fence(__ATOMIC_RELEASE, "agent");
        asm volatile("s_waitcnt vmcnt(0)" ::: "memory");
        __hip_atomic_fetch_add(ctr, 1u, __ATOMIC_RELAXED, __HIP_MEMORY_SCOPE_AGENT);
        while (__hip_atomic_load(ctr, __ATOMIC_RELAXED, __HIP_MEMORY_SCOPE_AGENT) < target) __builtin_amdgcn_s_sleep(2);
        __builtin_amdgcn_fence(__ATOMIC_ACQUIRE, "agent");
        asm volatile("s_waitcnt vmcnt(0)" ::: "memory");
    }
    __syncthreads();
}

namespace pg8 {
constexpr int BM = 256, BK = 64, HALF = 128, HTB = HALF * BK * 2, STAGE_BYTES = 8 * HTB, NXCD = 8, WGM = 8;
__host__ __device__ __forceinline__ int lds_byte(int r, int c) { const int st = (r >> 4) * 2 + (c >> 5), rr = r & 15, cc = c & 31, ob = rr * 64 + cc * 2; return st * 1024 + (ob ^ (((ob >> 9) & 1) << 5)); }
__host__ __device__ __forceinline__ void stage_rc(int b, int& R, int& C) { const int st = b / 1024, sb = b % 1024, swz = sb ^ (((sb >> 9) & 1) << 5); R = (st >> 1) * 16 + swz / 64; C = (st & 1) * 32 + (swz % 64) / 2; }
__host__ __device__ __forceinline__ int perm32(int rho) { const int n = rho >> 4, i = rho & 15; return 8 * (i >> 2) + 4 * n + (i & 3); }
struct Unit { int pm, pn; };
struct Gemm { const bf16_t* A; const bf16_t* Bt; int M, N, K; };
struct StaticOrder {
    int nM, nN, nwg, G, c;
    __device__ void init(int M, int N, int G_, int c_) { nM = M / BM; nN = N / BM; nwg = nM * nN; G = G_; c = c_; }
    __device__ bool next(int i, Unit& u) const {
        const long L = (long)i * G + c; if (L >= nwg) return false;
        int wgid = (int)L; { const int q = nwg / NXCD, r = nwg % NXCD, xcd = wgid % NXCD, off = wgid / NXCD; wgid = (xcd < r ? xcd * (q + 1) : r * (q + 1) + (xcd - r) * q) + off; }
        const int nig = WGM * nN, gid = wgid / nig, fm = gid * WGM, gsz = (nM - fm) < WGM ? (nM - fm) : WGM;
        u.pm = fm + ((wgid % nig) % gsz); u.pn = (wgid % nig) / gsz; return true;
    }
};

template <class Epi>
__device__ __forceinline__ void gemm_phase(LAS unsigned char* lds, const Gemm g, const StaticOrder& S, const Epi& E, const int tid) {
    const int wid = __builtin_amdgcn_readfirstlane(tid >> 6), lane = tid & 63, wr = wid >> 2, wc = wid & 3, fr = lane & 15, fq = lane >> 4;
    const int K = g.K, nt = K / BK;
    unsigned voffA[2], voffB[2];
#pragma unroll
    for (int i = 0; i < 2; ++i) { int R, C; stage_rc(tid * 16 + i * 8192, R, C); const int Rb = Epi::PERM ? ((R & ~31) + perm32(R & 31)) : R;
        voffA[i] = (unsigned)(R * K + C) * 2u; voffB[i] = (unsigned)(Rb * K + C) * 2u; }
    const size_t kstep = (size_t)(BK * 2);
    const size_t hstep = (size_t)HALF * K * 2;
    const size_t tstep = 2 * hstep;
    const unsigned ldsw = (unsigned)wid * 1024u;
    const int aoff = lds_byte(wr * 64 + fr, fq * 8), boff = lds_byte(wc * 32 + fr, fq * 8);
#define PG8_SA(b, h) (((b) * 2 + (h)) * HTB)
#define PG8_SB(b, h) ((4 + (b) * 2 + (h)) * HTB)
#define PG8_STAGE(bufoff, gbase, voff) do { _Pragma("unroll") for (int _i = 0; _i < 2; ++_i) \
        __builtin_amdgcn_global_load_lds((const unsigned*)((const char*)(gbase) + (voff)[_i]), (LAS unsigned*)(lds + (bufoff) + ldsw + _i * 8192), 16, 0, 0); } while (0)
#define PG8_LDA(dst, b, h) do { _Pragma("unroll") for (int m = 0; m < 4; ++m) _Pragma("unroll") for (int k = 0; k < 2; ++k) dst[m][k] = *(const LAS bf16x8*)(lds + PG8_SA(b, h) + aoff + m * 2048 + k * 1024); } while (0)
#define PG8_LDB(dst, b, h) do { _Pragma("unroll") for (int n = 0; n < 2; ++n) _Pragma("unroll") for (int k = 0; k < 2; ++k) dst[n][k] = *(const LAS bf16x8*)(lds + PG8_SB(b, h) + boff + n * 2048 + k * 1024); } while (0)
#define PG8_MMA(ai, bj, At, Bt) do { __builtin_amdgcn_s_setprio(1); _Pragma("unroll") for (int m = 0; m < 4; ++m) _Pragma("unroll") for (int n = 0; n < 2; ++n) _Pragma("unroll") for (int k = 0; k < 2; ++k) \
        acc[ai][bj][m][n] = __builtin_amdgcn_mfma_f32_16x16x32_bf16(Bt[n][k], At[m][k], acc[ai][bj][m][n], 0, 0, 0); __builtin_amdgcn_s_setprio(0); } while (0)
#define PG8_WAIT_V(n) asm volatile("s_waitcnt vmcnt(" #n ")" ::: "memory")
#define PG8_WAIT_L(n) asm volatile("s_waitcnt lgkmcnt(" #n ")" ::: "memory")
#define PG8_BAR __builtin_amdgcn_s_barrier()
#define PG8_SCHED __builtin_amdgcn_sched_barrier(0)
    Unit cur, nxt; int ui = 0;
    if (!S.next(0, cur)) return;
    f32x4 acc[2][2][4][2];
#pragma unroll
    for (int a = 0; a < 2; ++a)
#pragma unroll
        for (int b = 0; b < 2; ++b)
#pragma unroll
            for (int m = 0; m < 4; ++m)
#pragma unroll
                for (int n = 0; n < 2; ++n) acc[a][b][m][n] = (f32x4){0.f, 0.f, 0.f, 0.f};
    bf16x8 At[4][2], B0[2][2], B1[2][2];
    const char* cA = (const char*)g.A + (size_t)cur.pm * tstep; const char* cB = (const char*)g.Bt + (size_t)cur.pn * tstep;
    PG8_STAGE(PG8_SB(0, 0), cB, voffB); PG8_STAGE(PG8_SA(0, 0), cA, voffA); PG8_STAGE(PG8_SB(0, 1), cB + hstep, voffB); PG8_STAGE(PG8_SA(0, 1), cA + hstep, voffA);
    if (wr == 1) PG8_BAR;
    PG8_WAIT_V(4); PG8_BAR;
    PG8_STAGE(PG8_SB(1, 0), cB + kstep, voffB); PG8_STAGE(PG8_SA(1, 0), cA + kstep, voffA); PG8_STAGE(PG8_SB(1, 1), cB + hstep + kstep, voffB);
    PG8_WAIT_V(6); PG8_BAR;
    for (;;) {
        const bool has_next = S.next(ui + 1, nxt);
        const char* nA = has_next ? (const char*)g.A + (size_t)nxt.pm * tstep : cA; const char* nB = has_next ? (const char*)g.Bt + (size_t)nxt.pn * tstep : cB;
        for (int t = 0; t < nt; t += 2) {
            const bool last = (t == nt - 2);
            const char* a1 = cA + (size_t)(t + 1) * kstep;
            const char* a2 = last ? nA : cA + (size_t)(t + 2) * kstep; const char* b2 = last ? nB : cB + (size_t)(t + 2) * kstep;
            const char* a3 = a2 + kstep; const char* b3 = b2 + kstep;
            PG8_LDB(B0, 0, 0); PG8_SCHED; PG8_LDA(At, 0, 0); PG8_STAGE(PG8_SA(1, 1), a1 + hstep, voffA);
            PG8_WAIT_L(8); PG8_BAR; PG8_WAIT_L(0); PG8_MMA(0, 0, At, B0); PG8_BAR; PG8_SCHED;
            PG8_LDB(B1, 0, 1); PG8_STAGE(PG8_SB(0, 0), b2, voffB);
            PG8_BAR; PG8_WAIT_L(0); PG8_MMA(0, 1, At, B1); PG8_BAR;
            PG8_LDA(At, 0, 1); PG8_STAGE(PG8_SA(0, 0), a2, voffA);
            PG8_BAR; PG8_WAIT_L(0); PG8_MMA(1, 0, At, B0); PG8_BAR; PG8_SCHED;
            PG8_STAGE(PG8_SB(0, 1), b2 + hstep, voffB);
            PG8_WAIT_V(6); PG8_BAR; PG8_MMA(1, 1, At, B1); PG8_BAR;
            PG8_LDB(B0, 1, 0); PG8_SCHED; PG8_LDA(At, 1, 0); PG8_STAGE(PG8_SA(0, 1), a2 + hstep, voffA);
            PG8_WAIT_L(8); PG8_BAR; PG8_WAIT_L(0); PG8_MMA(0, 0, At, B0); PG8_BAR; PG8_SCHED;
            PG8_LDB(B1, 1, 1); PG8_STAGE(PG8_SB(1, 0), b3, voffB);
            PG8_BAR; PG8_WAIT_L(0); PG8_MMA(0, 1, At, B1); PG8_BAR;
            PG8_LDA(At, 1, 1); PG8_STAGE(PG8_SA(1, 0), a3, voffA);
            PG8_BAR; PG8_WAIT_L(0); PG8_MMA(1, 0, At, B0); PG8_BAR; PG8_SCHED;
            PG8_STAGE(PG8_SB(1, 1), b3 + hstep, voffB);
            PG8_WAIT_V(6); PG8_BAR; PG8_MMA(1, 1, At, B1); PG8_BAR;
        }
        E(acc, cur, wr, wc, fr, fq);
        if (!has_next) break;
#pragma unroll
        for (int a = 0; a < 2; ++a)
#pragma unroll
            for (int b = 0; b < 2; ++b)
#pragma unroll
                for (int m = 0; m < 4; ++m)
#pragma unroll
                    for (int n = 0; n < 2; ++n) acc[a][b][m][n] = (f32x4){0.f, 0.f, 0.f, 0.f};
        cur = nxt; cA = nA; cB = nB; ++ui;
    }
    PG8_WAIT_V(0);
    if (wr == 0) PG8_BAR;
    PG8_BAR;
#undef PG8_SA
#undef PG8_SB
#undef PG8_STAGE
#undef PG8_LDA
#undef PG8_LDB
#undef PG8_MMA
#undef PG8_WAIT_V
#undef PG8_WAIT_L
#undef PG8_BAR
#undef PG8_SCHED
}

template <int ACT  > struct EpiBf16 {
    static constexpr bool PERM = true;
    bf16_t* O; int ldc;
    __device__ __forceinline__ void operator()(const f32x4 (&acc)[2][2][4][2], const Unit& u, int wr, int wc, int fr, int fq) const {
        const int row0 = u.pm * BM + wr * 64 + fr, col0 = u.pn * BM + wc * 32 + 8 * fq;
#pragma unroll
        for (int ai = 0; ai < 2; ++ai)
#pragma unroll
            for (int m = 0; m < 4; ++m) { bf16_t* rowp = O + (size_t)(row0 + ai * HALF + m * 16) * ldc + col0;
#pragma unroll
                for (int bj = 0; bj < 2; ++bj) { f32x4 v0 = acc[ai][bj][m][0], v1 = acc[ai][bj][m][1];
                    if (ACT == 1) {
#pragma unroll
                        for (int j = 0; j < 4; ++j) { v0[j] = gelu_tanh(v0[j]); v1[j] = gelu_tanh(v1[j]); } }
                    u32x4 w; w.x = pk_bf16(v0[0], v0[1]); w.y = pk_bf16(v0[2], v0[3]); w.z = pk_bf16(v1[0], v1[1]); w.w = pk_bf16(v1[2], v1[3]);
                    *(u32x4*)(rowp + bj * HALF) = w; } }
    }
};
struct EpiRes {
    static constexpr bool PERM = false;
    const float* src_lat; const float* src_ctx; float* dst; const float* modL; int gate_idx;
    __device__ __forceinline__ void operator()(const f32x4 (&acc)[2][2][4][2], const Unit& u, int wr, int wc, int fr, int fq) const {
        const bool isctx = u.pm >= (TL / BM);
        const float* sb = isctx ? src_ctx + (size_t)(u.pm - TL / BM) * BM * D : src_lat + (size_t)u.pm * BM * D;
        const int mb = isctx ? NB : (u.pm >> 3);
        const float* gv = modL + (size_t)mb * 6144 + gate_idx * 1024;
        const int rl = wr * 64 + fr, col0 = u.pn * BM + wc * 32 + 4 * fq;
        f32x4 g[2][2];
#pragma unroll
        for (int bj = 0; bj < 2; ++bj)
#pragma unroll
            for (int n = 0; n < 2; ++n) g[bj][n] = *(const f32x4*)(gv + col0 + bj * HALF + n * 16);
#pragma unroll
        for (int ai = 0; ai < 2; ++ai)
#pragma unroll
            for (int m = 0; m < 4; ++m) { const int r = rl + ai * HALF + m * 16; const float* sp = sb + (size_t)r * D + col0; float* dp = dst + ((size_t)u.pm * BM + r) * D + col0;
#pragma unroll
                for (int bj = 0; bj < 2; ++bj)
#pragma unroll
                    for (int n = 0; n < 2; ++n) { const f32x4 x = *(const f32x4*)(sp + bj * HALF + n * 16); *(f32x4*)(dp + bj * HALF + n * 16) = x * DN_ALPHA + g[bj][n] * acc[ai][bj][m][n]; } }
    }
};
struct EpiGlaProj {
    static constexpr bool PERM = true;
    bf16_t* QG; bf16_t* KG; bf16_t* VG; bf16_t* RG; float* GL;
    __device__ __forceinline__ void operator()(const f32x4 (&acc)[2][2][4][2], const Unit& u, int wr, int wc, int fr, int fq) const {
        const int row0 = u.pm * BM + wr * 64 + fr, pn = u.pn;
        if (pn < 12) {
            bf16_t* base; int ld, colt; float sc = 1.f;
            if (pn < 2) { base = QG; ld = 512; colt = pn * BM; sc = 0.08838834764831845f; }
            else if (pn < 4) { base = KG; ld = 512; colt = (pn - 2) * BM; }
            else if (pn < 8) { base = VG; ld = 1024; colt = (pn - 4) * BM; }
            else { base = RG; ld = 1024; colt = (pn - 8) * BM; }
            const int col0 = colt + wc * 32 + 8 * fq;
#pragma unroll
            for (int ai = 0; ai < 2; ++ai)
#pragma unroll
                for (int m = 0; m < 4; ++m) { bf16_t* rowp = base + (size_t)(row0 + ai * HALF + m * 16) * ld + col0;
#pragma unroll
                    for (int bj = 0; bj < 2; ++bj) { const f32x4 v0 = acc[ai][bj][m][0] * sc, v1 = acc[ai][bj][m][1] * sc;
                        u32x4 w; w.x = pk_bf16(v0[0], v0[1]); w.y = pk_bf16(v0[2], v0[3]); w.z = pk_bf16(v1[0], v1[1]); w.w = pk_bf16(v1[2], v1[3]);
                        *(u32x4*)(rowp + bj * HALF) = w; } }
        } else if (wc == 0) {
#pragma unroll
            for (int ai = 0; ai < 2; ++ai)
#pragma unroll
                for (int m = 0; m < 4; ++m) { float* gp = GL + (size_t)(row0 + ai * HALF + m * 16) * 32 + 8 * fq;
                    *(f32x4*)gp = acc[ai][0][m][0]; *(f32x4*)(gp + 4) = acc[ai][0][m][1]; }
        }
    }
};
}

struct Ctx {
    const Params* p; unsigned char* ws; unsigned char* smem; int tid, lane, wave, G, bid;
};

DI void phase_prologue(const Ctx& c) {
    const Params& p = *c.p; unsigned char* ws = c.ws;
    const int tid = c.tid;
    constexpr int N_MOD = 192, N_TR = 4736, N_WS = 64, N_TAB = 2048;
    constexpr int N_ALL = N_MOD + N_TR + N_WS + N_TAB;
    for (int u = c.bid; u < N_ALL; u += c.G) {
        if (u < N_MOD) {
            const int l = u / 48, n0 = (u % 48) * 128;
            float* sc = (float*)c.smem;
            float* red = (float*)(c.smem + 17 * 1024 * 4);
            __syncthreads();
#pragma unroll 1
            for (int hk = 0; hk < 2; ++hk) { const int k = hk * 512 + tid; float v[17];
#pragma unroll
                for (int b = 0; b < 17; ++b) v[b] = (b < NB) ? p.in[1][b * 1024 + k] : p.in[3][k];
#pragma unroll
                for (int b = 0; b < 17; ++b) sc[b * 1024 + k] = silu_f(v[b]); }
            __syncthreads();
            const int c4 = (tid & 31) * 4, kg = tid >> 5;
            float acc[17][4];
#pragma unroll
            for (int b = 0; b < 17; ++b) { acc[b][0] = 0.f; acc[b][1] = 0.f; acc[b][2] = 0.f; acc[b][3] = 0.f; }
            const float* wp = p.in[4] + ((size_t)l * 1024 + (size_t)kg * 64) * 6144 + n0 + c4;
#pragma unroll 4
            for (int kk = 0; kk < 64; ++kk) {
                const f32x4 w = *(const f32x4*)(wp + (size_t)kk * 6144);
                const int k = kg * 64 + kk;
#pragma unroll
                for (int b = 0; b < 17; ++b) { const float s = sc[b * 1024 + k]; acc[b][0] += s * w[0]; acc[b][1] += s * w[1]; acc[b][2] += s * w[2]; acc[b][3] += s * w[3]; }
            }
#pragma unroll
            for (int b = 0; b < 17; ++b)
#pragma unroll
                for (int j = 0; j < 4; ++j) acc[b][j] += __shfl_xor(acc[b][j], 32, 64);
            if ((tid & 32) == 0) {
#pragma unroll
                for (int b = 0; b < 17; ++b)
#pragma unroll
                    for (int j = 0; j < 4; ++j) red[(c.wave * 17 + b) * 128 + c4 + j] = acc[b][j];
            }
            __syncthreads();
            for (int o = tid; o < 17 * 128; o += NTHR) { const int b = o >> 7, n = o & 127; float s = 0.f;
#pragma unroll
                for (int w = 0; w < 8; ++w) s += red[(w * 17 + b) * 128 + n];
                ((float*)(ws + WS_MOD))[((size_t)l * 17 + b) * 6144 + n0 + n] = s + p.in[5][l * 6144 + n0 + n]; }
        } else if (u < N_MOD + N_TR) {
            int v = u - N_MOD; const float* src; bf16_t* dst; int N, Npad;
            if (v < 1024) { const int j = v / 512; v %= 512; src = p.in[8] + (size_t)j * 1024 * 2048; dst = (bf16_t*)(ws + WS_WAIN) + (size_t)j * 2048 * 1024; N = 2048; Npad = 2048; }
            else if (v < 1536) { v -= 1024; const int j = v / 256; v %= 256; src = p.in[13] + (size_t)j * 1024 * 1024; dst = (bf16_t*)(ws + WS_WAOUT) + (size_t)j * 1024 * 1024; N = 1024; Npad = 1024; }
            else if (v < 3200) { v -= 1536; const int j = v / 832; v %= 832; src = p.in[14] + (size_t)j * 1024 * 3104; dst = (bf16_t*)(ws + WS_WBIN) + (size_t)j * WBIN_N * 1024; N = 3104; Npad = WBIN_N; }
            else if (v < 3712) { v -= 3200; const int j = v / 256; v %= 256; src = p.in[18] + (size_t)j * 1024 * 1024; dst = (bf16_t*)(ws + WS_WBOUT) + (size_t)j * 1024 * 1024; N = 1024; Npad = 1024; }
            else { v -= 3712; const int j = v / 256; v %= 256; src = p.in[19] + (size_t)j * 1024 * 1024; dst = (bf16_t*)(ws + WS_WQ) + (size_t)j * 1024 * 1024; N = 1024; Npad = 1024; }
            (void)Npad;
            const int ntn = v >> 4, ktile = v & 15, n0 = ntn * 64, k0 = ktile * 64;
            float* tl = (float*)c.smem;
            __syncthreads();
#pragma unroll
            for (int i = 0; i < 2; ++i) { const int kk = (tid >> 4) + 32 * i, nn = (tid & 15) * 4;
                f32x4 x = {0.f, 0.f, 0.f, 0.f};
                if (n0 + nn < N) x = *(const f32x4*)(src + (size_t)(k0 + kk) * N + n0 + nn);
                tl[kk * 65 + nn] = x[0]; tl[kk * 65 + nn + 1] = x[1]; tl[kk * 65 + nn + 2] = x[2]; tl[kk * 65 + nn + 3] = x[3]; }
            __syncthreads();
            { const int nn = tid >> 3, kk8 = (tid & 7) * 8; float x[8];
#pragma unroll
              for (int j = 0; j < 8; ++j) x[j] = tl[(kk8 + j) * 65 + nn];
              u32x4 w; w.x = pk_bf16(x[0], x[1]); w.y = pk_bf16(x[2], x[3]); w.z = pk_bf16(x[4], x[5]); w.w = pk_bf16(x[6], x[7]);
              *(u32x4*)(dst + (size_t)(n0 + nn) * 1024 + k0 + kk8) = w; }
        } else if (u < N_MOD + N_TR + N_WS) {
            const int v = u - N_MOD - N_TR; const size_t e = (size_t)v * 4096 + (size_t)tid * 8;
            const f32x4 a = *(const f32x4*)(p.in[11] + e), b = *(const f32x4*)(p.in[11] + e + 4);
            u32x4 w; w.x = pk_bf16(a[0], a[1]); w.y = pk_bf16(a[2], a[3]); w.z = pk_bf16(b[0], b[1]); w.w = pk_bf16(b[2], b[3]);
            *(u32x4*)((bf16_t*)(ws + WS_WSB) + e) = w;
        } else {
            const int v = u - N_MOD - N_TR - N_WS; const int tab = v >> 10;
            const float* src = p.in[21 + tab]; unsigned char* dst = ws + (tab ? WS_VT : WS_UT); float* sc = (float*)(ws + (tab ? WS_SV : WS_SU));
#pragma unroll 2
            for (int i = 0; i < 8; ++i) { const size_t row = (size_t)(v & 1023) * 64 + c.wave * 8 + i;
                const float* rp = src + row * 1024 + 16 * c.lane; f32x4 x[4]; float am = 0.f;
#pragma unroll
                for (int q = 0; q < 4; ++q) { x[q] = __builtin_nontemporal_load((const f32x4*)(rp + 4 * q)); am = fmaxf(am, fmaxf(fmaxf(fabsf(x[q][0]), fabsf(x[q][1])), fmaxf(fabsf(x[q][2]), fabsf(x[q][3])))); }
                am = fmaxf(wave_max(am), 1e-30f);
                const float inv = 440.0f / am; u32x4 w;
#pragma unroll
                for (int q = 0; q < 4; ++q) { int t = 0; t = __builtin_amdgcn_cvt_pk_fp8_f32(x[q][0] * inv, x[q][1] * inv, t, false); t = __builtin_amdgcn_cvt_pk_fp8_f32(x[q][2] * inv, x[q][3] * inv, t, true); w[q] = (unsigned)t; }
                { const size_t Lr = row >> 14, er = row & 16383;
                  *(u32x4*)(dst + ((Lr * 8 + (c.lane >> 3)) * NEXP + er) * 128 + 16 * (c.lane & 7)) = w; }
                if (c.lane == 0) sc[row] = am * (1.0f / 440.0f); }
        }
    }
}

DI void phase_mod0(const Ctx& c) {
    const Params& p = *c.p; const float* MOD = (const float*)(c.ws + WS_MOD); bf16_t* H1 = (bf16_t*)(c.ws + WS_H1);
    for (int row = c.bid * NWAVE + c.wave; row < T; row += c.G * NWAVE) {
        const float* src = row < TL ? p.in[0] + (size_t)row * D : p.in[2] + (size_t)(row - TL) * D;
        const float* m = MOD + (size_t)mod_batch(row) * 6144;
#pragma unroll
        for (int j = 0; j < 4; ++j) { const int col = 4 * c.lane + 256 * j;
            const f32x4 x = *(const f32x4*)(src + col), sh = *(const f32x4*)(m + col), s = *(const f32x4*)(m + 1024 + col);
            const f32x4 h = x * (s + 1.0f) + sh; u32x2 w; w.x = pk_bf16(h[0], h[1]); w.y = pk_bf16(h[2], h[3]);
            *(u32x2*)(H1 + (size_t)row * D + col) = w; }
    }
}

DI void phase_vstats(const Ctx& c) {
    const bf16_t* UV = (const bf16_t*)(c.ws + WS_R1); float* ST = (float*)(c.ws + WS_STATS);
    for (int row = c.bid * NWAVE + c.wave; row < T; row += c.G * NWAVE) {
        const bf16_t* vp = UV + (size_t)row * 2048 + 1024;
        const u32x4 a = *(const u32x4*)(vp + 8 * c.lane), b = *(const u32x4*)(vp + 512 + 8 * c.lane);
        float x[16];
#pragma unroll
        for (int j = 0; j < 4; ++j) { x[2 * j] = bf_lo(a[j]); x[2 * j + 1] = bf_hi(a[j]); x[8 + 2 * j] = bf_lo(b[j]); x[9 + 2 * j] = bf_hi(b[j]); }
        float s = 0.f;
#pragma unroll
        for (int j = 0; j < 16; ++j) s += x[j];
        const float mean = wave_sum(s) * (1.0f / 1024.0f);
        float q = 0.f;
#pragma unroll
        for (int j = 0; j < 16; ++j) { const float d = x[j] - mean; q += d * d; }
        const float var = wave_sum(q) * (1.0f / 1024.0f);
        if (c.lane == 0) { ST[2 * row] = mean; ST[2 * row + 1] = rsqrtf(var + LN_EPS); }
    }
}

DI void phase_spatial(const Ctx& c, int j) {
    const Params& p = *c.p; unsigned char* ws = c.ws;
    const bf16_t* UV = (const bf16_t*)(ws + WS_R1); const float* ST = (const float*)(ws + WS_STATS); bf16_t* Y = (bf16_t*)(ws + WS_R2);
    const bf16_t* WSB = (const bf16_t*)(ws + WS_WSB) + (size_t)j * 8 * 128 * 128;
    const float* ng = p.in[9] + j * 1024; const float* nb = p.in[10] + j * 1024; const float* bs = p.in[12] + j * 8 * 128;
    constexpr int LD = 136;
    bf16_t* WsL = (bf16_t*)c.smem;
    bf16_t* VnT = WsL + 128 * LD;
    const int tid = c.tid, lane = c.lane, w = c.wave, g = lane >> 4, cc = lane & 15;
    for (int u = c.bid; u < (T / 128) * 8; u += c.G) {
        const int chunk = u >> 3, h = u & 7, r0 = chunk * 128;
        __syncthreads();
        { const int cg8 = tid & 15; float gg[8], bb[8];
#pragma unroll
          for (int e = 0; e < 8; ++e) { gg[e] = ng[h * 128 + cg8 * 8 + e]; bb[e] = nb[h * 128 + cg8 * 8 + e]; }
#pragma unroll
          for (int i = 0; i < 4; ++i) { const int idx = i * 512 + tid, tok = idx >> 4;
              const u32x4 v = *(const u32x4*)(UV + (size_t)(r0 + tok) * 2048 + 1024 + h * 128 + cg8 * 8);
              const float mean = ST[2 * (r0 + tok)], rstd = ST[2 * (r0 + tok) + 1];
              float x[8];
#pragma unroll
              for (int e = 0; e < 4; ++e) { x[2 * e] = bf_lo(v[e]); x[2 * e + 1] = bf_hi(v[e]); }
#pragma unroll
              for (int e = 0; e < 8; ++e) VnT[(cg8 * 8 + e) * LD + tok] = f2bf((x[e] - mean) * rstd * gg[e] + bb[e]);
              const int pp = idx >> 4;
              *(u32x4*)(WsL + pp * LD + cg8 * 8) = *(const u32x4*)(WSB + ((size_t)h * 128 + pp) * 128 + cg8 * 8); } }
        __syncthreads();
        f32x4 acc[8];
#pragma unroll
        for (int ct = 0; ct < 8; ++ct) acc[ct] = (f32x4){0.f, 0.f, 0.f, 0.f};
#pragma unroll
        for (int ks = 0; ks < 4; ++ks) {
            const bf16x8 bfr = frag_ld(WsL, LD, 16 * w, 32 * ks, lane);
#pragma unroll
            for (int ct = 0; ct < 8; ++ct) acc[ct] = mfma16(frag_ld(VnT, LD, 16 * ct, 32 * ks, lane), bfr, acc[ct]);
        }
        const int pp = 16 * w + cc; const float bsv = bs[h * 128 + pp];
        const size_t rowo = (size_t)(r0 + pp);
#pragma unroll
        for (int ct = 0; ct < 8; ++ct) { const int ch = h * 128 + 16 * ct + 4 * g;
            const u32x2 uu = *(const u32x2*)(UV + rowo * 2048 + ch);
            const float y0 = bf_lo(uu.x) * (acc[ct][0] + bsv), y1 = bf_hi(uu.x) * (acc[ct][1] + bsv), y2 = bf_lo(uu.y) * (acc[ct][2] + bsv), y3 = bf_hi(uu.y) * (acc[ct][3] + bsv);
            u32x2 o; o.x = pk_bf16(y0, y1); o.y = pk_bf16(y2, y3);
            *(u32x2*)(Y + rowo * D + ch) = o; }
    }
}

DI void phase_ln1(const Ctx& c, int L) {
    const Params& p = *c.p; float* XS = (float*)(c.ws + WS_XS); const float* MOD = (const float*)(c.ws + WS_MOD) + (size_t)L * 17 * 6144;
    bf16_t* H2 = (bf16_t*)(c.ws + WS_R2 + SZ_T1K);
    const float* lg = p.in[6] + (size_t)(L * 2 + 0) * D; const float* lb = p.in[7] + (size_t)(L * 2 + 0) * D;
    for (int row = c.bid * NWAVE + c.wave; row < T; row += c.G * NWAVE) {
        float* xp = XS + (size_t)row * D; const float* m = MOD + (size_t)mod_batch(row) * 6144;
        f32x4 x[4]; float s = 0.f;
#pragma unroll
        for (int j = 0; j < 4; ++j) { x[j] = *(const f32x4*)(xp + 4 * c.lane + 256 * j); s += (x[j][0] + x[j][1]) + (x[j][2] + x[j][3]); }
        const float mean = wave_sum(s) * (1.0f / 1024.0f);
        float q = 0.f;
#pragma unroll
        for (int j = 0; j < 4; ++j) { const f32x4 d = x[j] - mean; q += (d[0] * d[0] + d[1] * d[1]) + (d[2] * d[2] + d[3] * d[3]); }
        const float rstd = rsqrtf(wave_sum(q) * (1.0f / 1024.0f) + LN_EPS);
#pragma unroll
        for (int j = 0; j < 4; ++j) { const int col = 4 * c.lane + 256 * j;
            const f32x4 y = (x[j] - mean) * rstd * *(const f32x4*)(lg + col) + *(const f32x4*)(lb + col);
            *(f32x4*)(xp + col) = y;
            const f32x4 h = y * (*(const f32x4*)(m + 4 * 1024 + col) + 1.0f) + *(const f32x4*)(m + 3 * 1024 + col);
            u32x2 w; w.x = pk_bf16(h[0], h[1]); w.y = pk_bf16(h[2], h[3]);
            *(u32x2*)(H2 + (size_t)row * D + col) = w; }
    }
}

DI int f2key(float v) { const int i = __float_as_int(v); return i ^ ((i >> 31) & 0x7fffffff); }
DI float key2f(int k) { return __int_as_float(k ^ ((k >> 31) & 0x7fffffff)); }
DI void phase_route(const Ctx& c, int L) {
    const Params& p = *c.p; unsigned char* ws = c.ws; const int lane = c.lane, g = lane >> 4, cc = lane & 15;
    constexpr int LDK = 72, LDS_S = 20;
    bf16_t* keysHi = (bf16_t*)c.smem;
    bf16_t* keysLo = keysHi + 2 * 128 * LDK;
    float* sbase = (float*)(keysLo + 2 * 128 * LDK);
    unsigned* ilist = (unsigned*)(sbase + NWAVE * 64 * LDS_S);
    __syncthreads();
    { const float* gk = p.in[20] + (size_t)L * 2 * 128 * 64;
      f32x4 kv[8];
#pragma unroll
      for (int it = 0; it < 8; ++it) kv[it] = ((const f32x4*)gk)[it * NTHR + c.tid];
#pragma unroll
      for (int it = 0; it < 8; ++it) { const int i = (it * NTHR + c.tid) * 4, row = i >> 6, d = i & 63; unsigned hi[2], lo[2];
#pragma unroll
          for (int e = 0; e < 2; ++e) { const unsigned ph = pk_bf16(kv[it][2 * e], kv[it][2 * e + 1]); hi[e] = ph; lo[e] = pk_bf16(kv[it][2 * e] - bf_lo(ph), kv[it][2 * e + 1] - bf_hi(ph)); }
          *(u32x2*)(keysHi + row * LDK + d) = (u32x2){hi[0], hi[1]}; *(u32x2*)(keysLo + row * LDK + d) = (u32x2){lo[0], lo[1]}; } }
    __syncthreads();
    float* S = sbase + c.wave * 64 * LDS_S;
    const bf16_t* QP = (const bf16_t*)(ws + WS_R1); int* IDX = (int*)(ws + WS_R1 + SZ_T1K); float* WT = (float*)(ws + WS_R1 + SZ_T1K + (size_t)T * 128 * 4);
    unsigned* myl = ilist + c.tid * 8; const unsigned char* mylb = (const unsigned char*)myl;
    for (int task = c.bid * NWAVE + c.wave; task < (T / 64) * 8; task += c.G * NWAVE) {
        const int t0 = (task >> 3) * 64, h = task & 7, tok = t0 + lane;
        float t12[2][16];
#pragma unroll
        for (int half = 0; half < 2; ++half) {
            bf16x8 aq[4][2];
#pragma unroll
            for (int mt = 0; mt < 4; ++mt)
#pragma unroll
                for (int ks = 0; ks < 2; ++ks) aq[mt][ks] = *(const bf16x8*)(QP + (size_t)(t0 + 16 * mt + cc) * D + h * 128 + half * 64 + 32 * ks + 8 * g);
            const bf16_t* kh = keysHi + half * 128 * LDK; const bf16_t* kl = keysLo + half * 128 * LDK;
#pragma unroll
            for (int i = 0; i < 16; ++i) t12[half][i] = -3.0e38f;
            for (int nt = 0; nt < 8; ++nt) {
                const bf16x8 bh0 = frag_ld(kh, LDK, 16 * nt, 0, lane), bh1 = frag_ld(kh, LDK, 16 * nt, 32, lane), bl0 = frag_ld(kl, LDK, 16 * nt, 0, lane), bl1 = frag_ld(kl, LDK, 16 * nt, 32, lane);
#pragma unroll
                for (int mt = 0; mt < 4; ++mt) { f32x4 a = {0.f, 0.f, 0.f, 0.f};
                    a = mfma16(aq[mt][0], bl0, a); a = mfma16(aq[mt][1], bl1, a); a = mfma16(aq[mt][0], bh0, a); a = mfma16(aq[mt][1], bh1, a);
#pragma unroll
                    for (int r = 0; r < 4; ++r) S[(16 * mt + 4 * g + r) * LDS_S + cc] = a[r]; }
                f32x4 sc[4];
#pragma unroll
                for (int q4 = 0; q4 < 4; ++q4) sc[q4] = *(const f32x4*)(S + lane * LDS_S + 4 * q4);
#pragma unroll
                for (int kk = 0; kk < 16; ++kk) { const float key = __int_as_float((__float_as_int(sc[kk >> 2][kk & 3]) & ~127) | (127 - (16 * nt + kk)));
#pragma unroll
                    for (int i = 15; i >= 1; --i) t12[half][i] = __builtin_amdgcn_fmed3f(key, t12[half][i - 1], t12[half][i]);
                    t12[half][0] = __builtin_amdgcn_fmed3f(key, 3.0e38f, t12[half][0]); }
            }
        }
        float v1[16], v2[16];
#pragma unroll
        for (int i = 0; i < 16; ++i) { v1[i] = __int_as_float(__float_as_int(t12[0][i]) & ~127); v2[i] = __int_as_float(__float_as_int(t12[1][i]) & ~127); }
#pragma unroll
        for (int i = 0; i < 4; ++i) {
            myl[i] = (unsigned)(127 - (__float_as_int(t12[0][4 * i]) & 127)) | ((unsigned)(127 - (__float_as_int(t12[0][4 * i + 1]) & 127)) << 8) | ((unsigned)(127 - (__float_as_int(t12[0][4 * i + 2]) & 127)) << 16) | ((unsigned)(127 - (__float_as_int(t12[0][4 * i + 3]) & 127)) << 24);
            myl[4 + i] = (unsigned)(127 - (__float_as_int(t12[1][4 * i]) & 127)) | ((unsigned)(127 - (__float_as_int(t12[1][4 * i + 1]) & 127)) << 8) | ((unsigned)(127 - (__float_as_int(t12[1][4 * i + 2]) & 127)) << 16) | ((unsigned)(127 - (__float_as_int(t12[1][4 * i + 3]) & 127)) << 24); }
        float f[16];
#pragma unroll
        for (int i = 0; i < 16; ++i) f[i] = -3.0e38f;
#pragma unroll
        for (int a = 0; a < 16; ++a)
#pragma unroll
            for (int b = 0; b < 16; ++b)
                if ((a + 1) * (b + 1) <= 16) {
                    const float key = __int_as_float((__float_as_int(v1[a] + v2[b]) & ~255) | (255 - (a * 16 + b)));
#pragma unroll
                    for (int i = 15; i >= 1; --i) f[i] = __builtin_amdgcn_fmed3f(key, f[i - 1], f[i]);
                    f[0] = __builtin_amdgcn_fmed3f(key, 3.0e38f, f[0]);
                }
        float e[16], se = 0.f; int fi[16];
        const float vmax = __int_as_float(__float_as_int(f[0]) & ~255);
#pragma unroll
        for (int i = 0; i < 16; ++i) { const int code = 255 - (__float_as_int(f[i]) & 255); fi[i] = (int)mylb[code >> 4] * 128 + (int)mylb[16 + (code & 15)];
            e[i] = __expf(__int_as_float(__float_as_int(f[i]) & ~255) - vmax); se += e[i]; }
        const float inv = 1.0f / se;
        int* ip = IDX + (size_t)tok * 128 + h * 16; float* wp = WT + (size_t)tok * 128 + h * 16;
#pragma unroll
        for (int i = 0; i < 16; i += 4) { *(int4*)(ip + i) = make_int4(fi[i], fi[i + 1], fi[i + 2], fi[i + 3]); *(f32x4*)(wp + i) = (f32x4){e[i] * inv, e[i + 1] * inv, e[i + 2] * inv, e[i + 3] * inv}; }
    }
}

DI float red8(float p) { p += dpp_mov<0xB1>(p); p += dpp_mov<0x4E>(p); p += dpp_mov<0x141>(p); return p; }
DI void phase_experts(const Ctx& c, int L) {
    const Params& p = *c.p; unsigned char* ws = c.ws; const int lane = c.lane, g8 = lane >> 3, j = lane & 7;
    constexpr int MAXTOK = 18;
    const bf16_t* H2 = (const bf16_t*)(ws + WS_R2 + SZ_T1K);
    const int* IDX = (const int*)(ws + WS_R1 + SZ_T1K); const float* WT = (const float*)(ws + WS_R1 + SZ_T1K + (size_t)T * 128 * 4);
    bf16_t* FFN = (bf16_t*)(ws + WS_R1);
    const unsigned char* UT = ws + WS_UT + (size_t)L * NEXP * 1024; const unsigned char* VT = ws + WS_VT + (size_t)L * NEXP * 1024;
    const float* SU = (const float*)(ws + WS_SU) + (size_t)L * NEXP; const float* SV = (const float*)(ws + WS_SV) + (size_t)L * NEXP;
    float* XS = (float*)(ws + WS_XS); bf16_t* H1 = (bf16_t*)(ws + WS_H1);
    const float* MOD = (const float*)(ws + WS_MOD) + (size_t)L * 17 * 6144;
    const float* lg = p.in[6] + (size_t)(L * 2 + 1) * D; const float* lb = p.in[7] + (size_t)(L * 2 + 1) * D;
    const int nrows = (L == DEPTH - 1) ? TL : T;
    float* ZL = (float*)c.smem + c.wave * MAXTOK * 128;
    unsigned short* IL = (unsigned short*)(c.smem + NWAVE * MAXTOK * 128 * 4) + c.wave * MAXTOK * 128;
    const int GW = c.G * NWAVE, gw = c.bid * NWAVE + c.wave;
    const int tsrc = 8 * (lane & 7) + (lane >> 3);
    for (int base = 0; base < nrows; base += GW * MAXTOK) {
        int ntok = 0;
        for (int k = 0; k < MAXTOK; ++k) { const int tok = base + gw + GW * k; if (tok < nrows) { ntok = k + 1;
            IL[k * 128 + lane] = (unsigned short)IDX[(size_t)tok * 128 + lane]; IL[k * 128 + 64 + lane] = (unsigned short)IDX[(size_t)tok * 128 + 64 + lane]; } }
        for (int c8 = 0; c8 < 8; ++c8) {
            const unsigned char* Ub = UT + (size_t)c8 * NEXP * 128 + 16 * j;
            for (int k = 0; k < ntok; ++k) { const int tok = base + gw + GW * k;
                f32x2 xf[8];
                { const bf16_t* xp = H2 + (size_t)tok * D + 128 * c8 + 16 * j; const u32x4 xa = *(const u32x4*)xp, xb = *(const u32x4*)(xp + 8);
#pragma unroll
                  for (int q = 0; q < 4; ++q) { xf[q] = (f32x2){bf_lo(xa[q]), bf_hi(xa[q])}; xf[4 + q] = (f32x2){bf_lo(xb[q]), bf_hi(xb[q])}; } }
                u32x4 r[16];
#pragma unroll
                for (int i = 0; i < 16; ++i) { const unsigned e = IL[k * 128 + 8 * i + g8]; r[i] = *(const u32x4*)(Ub + (size_t)e * 128); }
                float ra = 0.f, rb = 0.f;
#pragma unroll
                for (int i = 0; i < 16; ++i) { f32x2 acc = {0.f, 0.f};
#pragma unroll
                    for (int q = 0; q < 4; ++q) { acc += __builtin_amdgcn_cvt_pk_f32_fp8((int)r[i][q], false) * xf[2 * q]; acc += __builtin_amdgcn_cvt_pk_f32_fp8((int)r[i][q], true) * xf[2 * q + 1]; }
                    const float pr = red8(acc[0] + acc[1]);
                    if (i < 8) ra = (j == i) ? pr : ra; else rb = (j == i - 8) ? pr : rb; }
                const float za = __shfl(ra, tsrc, 64), zb = __shfl(rb, tsrc, 64);
                if (c8 == 0) { ZL[k * 128 + lane] = za; ZL[k * 128 + 64 + lane] = zb; }
                else { ZL[k * 128 + lane] += za; ZL[k * 128 + 64 + lane] += zb; } }
        }
        for (int k = 0; k < ntok; ++k) { const int tok = base + gw + GW * k;
#pragma unroll
            for (int hh = 0; hh < 2; ++hh) { const unsigned e = IL[k * 128 + 64 * hh + lane]; const float wv = WT[(size_t)tok * 128 + 64 * hh + lane];
                ZL[k * 128 + 64 * hh + lane] = gelu_tanh(ZL[k * 128 + 64 * hh + lane] * SU[e]) * wv * SV[e]; } }
        for (int c8 = 0; c8 < 8; ++c8) {
            const unsigned char* Vb = VT + (size_t)c8 * NEXP * 128 + 16 * j;
            for (int k = 0; k < ntok; ++k) { const int tok = base + gw + GW * k;
                u32x4 r[16]; float av[16];
#pragma unroll
                for (int i = 0; i < 16; ++i) { const unsigned e = IL[k * 128 + 8 * i + g8]; r[i] = *(const u32x4*)(Vb + (size_t)e * 128); av[i] = ZL[k * 128 + 8 * i + g8]; }
                f32x2 o[8];
#pragma unroll
                for (int q = 0; q < 8; ++q) o[q] = (f32x2){0.f, 0.f};
#pragma unroll
                for (int i = 0; i < 16; ++i) { const f32x2 a2 = {av[i], av[i]};
#pragma unroll
                    for (int q = 0; q < 4; ++q) { o[2 * q] += a2 * __builtin_amdgcn_cvt_pk_f32_fp8((int)r[i][q], false); o[2 * q + 1] += a2 * __builtin_amdgcn_cvt_pk_f32_fp8((int)r[i][q], true); } }
                f32x2 q4[4];
#pragma unroll
                for (int m = 0; m < 4; ++m) {
                    const auto s0 = __builtin_amdgcn_permlane32_swap(__float_as_uint(o[m][0]), __float_as_uint(o[m + 4][0]), false, false);
                    const auto s1 = __builtin_amdgcn_permlane32_swap(__float_as_uint(o[m][1]), __float_as_uint(o[m + 4][1]), false, false);
                    q4[m] = (f32x2){__uint_as_float(s0[0]) + __uint_as_float(s0[1]), __uint_as_float(s1[0]) + __uint_as_float(s1[1])}; }
                f32x2 q2[2];
#pragma unroll
                for (int m = 0; m < 2; ++m) {
                    const auto s0 = __builtin_amdgcn_permlane16_swap(__float_as_uint(q4[m][0]), __float_as_uint(q4[m + 2][0]), false, false);
                    const auto s1 = __builtin_amdgcn_permlane16_swap(__float_as_uint(q4[m][1]), __float_as_uint(q4[m + 2][1]), false, false);
                    q2[m] = (f32x2){__uint_as_float(s0[0]) + __uint_as_float(s0[1]), __uint_as_float(s1[0]) + __uint_as_float(s1[1])}; }
                const bool hi8 = (lane & 8) != 0;
                const float k0 = hi8 ? q2[1][0] : q2[0][0], k1 = hi8 ? q2[1][1] : q2[0][1], t0 = hi8 ? q2[0][0] : q2[1][0], t1 = hi8 ? q2[0][1] : q2[1][1];
                const float f0 = k0 + dpp_mov<0x128>(t0), f1 = k1 + dpp_mov<0x128>(t1);
                *(unsigned*)(FFN + (size_t)tok * D + 128 * c8 + 16 * j + 2 * g8) = pk_bf16(f0, f1); }
        }
        asm volatile("s_waitcnt vmcnt(0)" ::: "memory");
        for (int k = 0; k < ntok; ++k) { const int row = base + gw + GW * k;
            float* xp = XS + (size_t)row * D + 16 * lane; const int mb = mod_batch(row); const float* m = MOD + (size_t)mb * 6144 + 16 * lane;
            const u32x4 fa = *(const u32x4*)(FFN + (size_t)row * D + 16 * lane), fb = *(const u32x4*)(FFN + (size_t)row * D + 16 * lane + 8);
            float o[16];
#pragma unroll
            for (int q = 0; q < 4; ++q) { o[2 * q] = bf_lo(fa[q]); o[2 * q + 1] = bf_hi(fa[q]); o[8 + 2 * q] = bf_lo(fb[q]); o[9 + 2 * q] = bf_hi(fb[q]); }
            float y[16]; float s = 0.f;
#pragma unroll
            for (int qd = 0; qd < 4; ++qd) { const f32x4 x1 = *(const f32x4*)(xp + 4 * qd), g2 = *(const f32x4*)(m + 5 * 1024 + 4 * qd);
#pragma unroll
                for (int e = 0; e < 4; ++e) { y[4 * qd + e] = DN_ALPHA * x1[e] + g2[e] * o[4 * qd + e]; s += y[4 * qd + e]; } }
            const float mean = wave_sum(s) * (1.0f / 1024.0f);
            float q = 0.f;
#pragma unroll
            for (int e = 0; e < 16; ++e) { const float d = y[e] - mean; q += d * d; }
            const float rstd = rsqrtf(wave_sum(q) * (1.0f / 1024.0f) + LN_EPS);
            const float* mn = (const float*)(ws + WS_MOD) + (size_t)(L + 1 < DEPTH ? L + 1 : L) * 17 * 6144 + (size_t)mb * 6144 + 16 * lane;
#pragma unroll
            for (int qd = 0; qd < 4; ++qd) { const int col = 16 * lane + 4 * qd;
                const f32x4 gg = *(const f32x4*)(lg + col), bb = *(const f32x4*)(lb + col); f32x4 x2;
#pragma unroll
                for (int e = 0; e < 4; ++e) x2[e] = (y[4 * qd + e] - mean) * rstd * gg[e] + bb[e];
                if (L == DEPTH - 1) { *(f32x4*)(p.out + (size_t)row * D + col) = x2; }
                else { *(f32x4*)(xp + 4 * qd) = x2;
                    const f32x4 h = x2 * (*(const f32x4*)(mn + 1024 + 4 * qd) + 1.0f) + *(const f32x4*)(mn + 4 * qd);
                    u32x2 w; w.x = pk_bf16(h[0], h[1]); w.y = pk_bf16(h[2], h[3]);
                    *(u32x2*)(H1 + (size_t)row * D + col) = w; } }
        }
    }
}

DI float logsig_fast(float z) { return fminf(z, 0.f) - __logf(1.0f + __expf(-fabsf(z))); }
DI void phase_gla_prep(const Ctx& c, int j) {
    const Params& p = *c.p; unsigned char* ws = c.ws; const int tid = c.tid;
    const bf16_t* QG = (const bf16_t*)(ws + WS_R1); const bf16_t* KG = (const bf16_t*)(ws + WS_R1 + SZ_T512); const bf16_t* VG = (const bf16_t*)(ws + WS_R1 + 2 * SZ_T512);
    const float* GL = (const float*)(ws + WS_GL); float* DEC = (float*)(ws + WS_DEC); bf16_t* VTt = (bf16_t*)(ws + WS_VTT);
    bf16_t* Qt = (bf16_t*)c.smem;
    bf16_t* Kt = Qt + 64 * 512;
    float* gl = (float*)(c.smem + 131072);
    for (int ch = c.bid; ch < T / 64; ch += c.G) {
        const int r0 = ch * 64;
        __syncthreads();
#pragma unroll 4
        for (int it = 0; it < 8; ++it) { const int idx = it * 512 + tid, row = idx >> 6, c8 = (idx & 63) * 8;
            *(u32x4*)(Qt + row * 512 + c8) = *(const u32x4*)(QG + (size_t)(r0 + row) * 512 + c8);
            *(u32x4*)(Kt + row * 512 + c8) = *(const u32x4*)(KG + (size_t)(r0 + row) * 512 + c8); }
        ((f32x4*)gl)[tid] = ((const f32x4*)(GL + (size_t)r0 * 32))[tid];
        __syncthreads();
#pragma unroll
        for (int dir = 0; dir < 2; ++dir) {
            float wg[16];
#pragma unroll
            for (int r = 0; r < 16; ++r) wg[r] = p.in[15][((size_t)(j * 2 + dir) * 16 + r) * 512 + tid];
            const float bias = p.in[16][(size_t)(j * 2 + dir) * 512 + tid];
            bf16_t* QIN = (bf16_t*)(ws + WS_R2) + (size_t)dir * T * 512; bf16_t* KIN = (bf16_t*)(ws + WS_R2 + SZ_T1K) + (size_t)dir * T * 512;
            bf16_t* KINt = (bf16_t*)(ws + WS_R2 + 2 * SZ_T1K) + (((size_t)dir * (T / 64) + ch) * 512 + tid) * 64;
            float cum = 0.f;
            for (int blk = 0; blk < 8; ++blk) { const int jb = dir ? 56 - 8 * blk : 8 * blk; float gs[8];
#pragma unroll
                for (int e = 0; e < 8; ++e) { const int i = jb + e; float z = bias; const f32x4* gp = (const f32x4*)(gl + i * 32 + dir * 16);
#pragma unroll
                    for (int r4 = 0; r4 < 4; ++r4) { const f32x4 gv = gp[r4]; z += gv[0] * wg[4 * r4] + gv[1] * wg[4 * r4 + 1] + gv[2] * wg[4 * r4 + 2] + gv[3] * wg[4 * r4 + 3]; }
                    gs[e] = logsig_fast(z) * (1.0f / 16.0f); }
                float kiv[8];
#pragma unroll
                for (int e = 0; e < 8; ++e) { const int pos = dir ? 7 - e : e, i = jb + pos;
                    cum += gs[pos];
                    const float qv = bf1(Qt[i * 512 + tid]), kv = bf1(Kt[i * 512 + tid]);
                    const size_t o = (size_t)(r0 + i) * 512 + tid;
                    const float ki = kv * __expf(-cum);
                    QIN[o] = f2bf(qv * __expf(cum)); KIN[o] = f2bf(ki); kiv[pos] = ki; }
                u32x4 w; w.x = pk_bf16(kiv[0], kiv[1]); w.y = pk_bf16(kiv[2], kiv[3]); w.z = pk_bf16(kiv[4], kiv[5]); w.w = pk_bf16(kiv[6], kiv[7]);
                *(u32x4*)(KINt + jb) = w; }
            DEC[((size_t)dir * (T / 64) + ch) * 512 + tid] = __expf(cum);
        }
        __syncthreads();
        bf16_t* Vl = Qt;
#pragma unroll 8
        for (int it = 0; it < 16; ++it) { const int idx = it * 512 + tid, row = idx >> 7, c8 = (idx & 127) * 8;
            *(u32x4*)(Vl + row * 1024 + c8) = *(const u32x4*)(VG + (size_t)(r0 + row) * 1024 + c8); }
        __syncthreads();
#pragma unroll
        for (int cc = 0; cc < 2; ++cc) { const int e = tid + 512 * cc; bf16_t* vp = VTt + ((size_t)ch * 1024 + e) * 64;
            for (int jb = 0; jb < 64; jb += 8) { unsigned short x[8];
#pragma unroll
                for (int t = 0; t < 8; ++t) x[t] = Vl[(jb + t) * 1024 + e];
                u32x4 w; w.x = (unsigned)x[0] | ((unsigned)x[1] << 16); w.y = (unsigned)x[2] | ((unsigned)x[3] << 16); w.z = (unsigned)x[4] | ((unsigned)x[5] << 16); w.w = (unsigned)x[6] | ((unsigned)x[7] << 16);
                *(u32x4*)(vp + jb) = w; } }
    }
}

DI void phase_gla_scan(const Ctx& c) {
    unsigned char* ws = c.ws; const int tid = c.tid, lane = c.lane, w = c.wave, g = lane >> 4, cc = lane & 15;
    const bf16_t* VTt = (const bf16_t*)(ws + WS_VTT); const float* DEC = (const float*)(ws + WS_DEC); bf16_t* O = (bf16_t*)(ws + WS_H1);
    constexpr int LDQ = 136, LDJ = 72;
    bf16_t* Qs = (bf16_t*)c.smem;
    bf16_t* Ks = Qs + 64 * LDQ;
    bf16_t* KEt = Ks + 64 * LDQ;
    bf16_t* Vt = KEt + 128 * LDJ;
    bf16_t* At = Vt + 64 * LDJ;
    bf16_t* St = At + 64 * LDJ;
    bf16_t* Ot = St + 64 * LDQ;
    float* dec = (float*)(Ot + 64 * LDJ);
    const int qtok0 = tid >> 4, qd8 = (tid & 15) * 8;
    const int ked0 = tid >> 3, kej8 = (tid & 7) * 8;
    for (int u = c.bid; u < NB * 4 * 4; u += c.G) {
        const int b = u >> 4, h = (u >> 2) & 3, es = u & 3;
        for (int dir = 0; dir < 2; ++dir) {
            const bf16_t* QIN = (const bf16_t*)(ws + WS_R2) + (size_t)dir * T * 512; const bf16_t* KIN = (const bf16_t*)(ws + WS_R2 + SZ_T1K) + (size_t)dir * T * 512;
            const bf16_t* KENDt = (const bf16_t*)(ws + WS_R2 + 2 * SZ_T1K) + (size_t)dir * (T / 64) * 512 * 64;
            f32x4 accS[4];
#pragma unroll
            for (int et = 0; et < 4; ++et) accS[et] = (f32x4){0.f, 0.f, 0.f, 0.f};
            __syncthreads();
            for (int i = tid; i < 64 * LDQ / 2; i += NTHR) ((unsigned*)St)[i] = 0u;
            u32x4 pq[2], pk[2], pke[2], pv, po; float pdec = 0.f;
            po = (u32x4){0u, 0u, 0u, 0u};
#define GLA_R0(cs_) (dir == 0 ? ((cs_) < 4 ? TL + b * CTXL + 64 * (cs_) : b * SEQ + 64 * ((cs_) - 4)) : ((cs_) < 4 ? TL + b * CTXL + 64 * (3 - (cs_)) : b * SEQ + 64 * (35 - (cs_))))
#define GLA_LOAD(cs_) do { const int r0_ = GLA_R0(cs_); const int chunk_ = r0_ >> 6; \
                _Pragma("unroll") for (int it = 0; it < 2; ++it) { const size_t go = (size_t)(r0_ + qtok0 + 32 * it) * 512 + h * 128 + qd8; pq[it] = *(const u32x4*)(QIN + go); pk[it] = *(const u32x4*)(KIN + go); \
                    pke[it] = *(const u32x4*)(KENDt + ((size_t)chunk_ * 512 + h * 128 + ked0 + 64 * it) * 64 + kej8); } \
                pv = *(const u32x4*)(VTt + ((size_t)chunk_ * 1024 + h * 256 + es * 64 + ked0) * 64 + kej8); \
                if (dir) po = *(const u32x4*)(O + (size_t)(r0_ + ked0) * 1024 + h * 256 + es * 64 + kej8); \
                if (tid < 128) pdec = DEC[((size_t)dir * (T / 64) + chunk_) * 512 + h * 128 + tid]; } while (0)
            GLA_LOAD(0);
            for (int cs = 0; cs < 36; ++cs) {
                const int r0 = GLA_R0(cs);
#pragma unroll
                for (int it = 0; it < 2; ++it) { *(u32x4*)(Qs + (qtok0 + 32 * it) * LDQ + qd8) = pq[it]; *(u32x4*)(Ks + (qtok0 + 32 * it) * LDQ + qd8) = pk[it]; *(u32x4*)(KEt + (ked0 + 64 * it) * LDJ + kej8) = pke[it]; }
                *(u32x4*)(Vt + ked0 * LDJ + kej8) = pv;
                *(u32x4*)(Ot + ked0 * LDJ + kej8) = po;
                if (tid < 128) dec[tid] = pdec;
                __syncthreads();
                if (cs + 1 < 36) GLA_LOAD(cs + 1);
                { const int it = w >> 1;
#pragma unroll
                  for (int jj = 0; jj < 2; ++jj) { const int jt = 2 * (w & 1) + jj; f32x4 a = {0.f, 0.f, 0.f, 0.f};
#pragma unroll
                      for (int ks = 0; ks < 4; ++ks) a = mfma16(frag_ld(Qs, LDQ, 16 * it, 32 * ks, lane), frag_ld(Ks, LDQ, 16 * jt, 32 * ks, lane), a);
                      const int jcol = 16 * jt + cc;
#pragma unroll
                      for (int r = 0; r < 4; ++r) { const int i = 16 * it + 4 * g + r; const bool keep = dir ? (jcol >= i) : (jcol <= i);
                          At[i * LDJ + jcol] = f2bf(keep ? a[r] : 0.f); } } }
                __syncthreads();
                { const int it = w >> 1;
#pragma unroll
                  for (int ee = 0; ee < 2; ++ee) { const int et = 2 * (w & 1) + ee; f32x4 a = {0.f, 0.f, 0.f, 0.f};
#pragma unroll
                      for (int ks = 0; ks < 2; ++ks) a = mfma16(frag_ld(At, LDJ, 16 * it, 32 * ks, lane), frag_ld(Vt, LDJ, 16 * et, 32 * ks, lane), a);
#pragma unroll
                      for (int ks = 0; ks < 4; ++ks) a = mfma16(frag_ld(Qs, LDQ, 16 * it, 32 * ks, lane), frag_ld(St, LDQ, 16 * et, 32 * ks, lane), a);
#pragma unroll
                      for (int r = 0; r < 4; ++r) { bf16_t* op = Ot + (16 * it + 4 * g + r) * LDJ + 16 * et + cc; *op = f2bf(a[r] + bf1(*op)); } } }
#pragma unroll
                for (int et = 0; et < 4; ++et) {
#pragma unroll
                    for (int ks = 0; ks < 2; ++ks) accS[et] = mfma16(frag_ld(KEt, LDJ, 16 * w, 32 * ks, lane), frag_ld(Vt, LDJ, 16 * et, 32 * ks, lane), accS[et]);
#pragma unroll
                    for (int r = 0; r < 4; ++r) accS[et][r] *= dec[16 * w + 4 * g + r];
                }
                __syncthreads();
#pragma unroll
                for (int et = 0; et < 4; ++et) { u32x2 sv; sv.x = pk_bf16(accS[et][0], accS[et][1]); sv.y = pk_bf16(accS[et][2], accS[et][3]);
                    *(u32x2*)(St + (16 * et + cc) * LDQ + 16 * w + 4 * g) = sv; }
                *(u32x4*)(O + (size_t)(r0 + ked0) * 1024 + h * 256 + es * 64 + kej8) = *(const u32x4*)(Ot + ked0 * LDJ + kej8);
            }
#undef GLA_LOAD
#undef GLA_R0
        }
    }
}

DI void phase_gla_readout(const Ctx& c, int j) {
    const Params& p = *c.p; unsigned char* ws = c.ws;
    const bf16_t* O = (const bf16_t*)(ws + WS_H1); const bf16_t* RG = (const bf16_t*)(ws + WS_R1 + 2 * SZ_T512 + SZ_T1K); bf16_t* Y = (bf16_t*)(ws + WS_R2);
    const float* gn = p.in[17] + (size_t)j * 1024;
    for (int row = c.bid * NWAVE + c.wave; row < T; row += c.G * NWAVE) {
#pragma unroll
        for (int hd = 0; hd < 4; ++hd) { const int col = 4 * c.lane + 256 * hd;
            const u32x2 ov = *(const u32x2*)(O + (size_t)row * D + col), rv = *(const u32x2*)(RG + (size_t)row * D + col);
            const float x0 = bf_lo(ov.x), x1 = bf_hi(ov.x), x2 = bf_lo(ov.y), x3 = bf_hi(ov.y);
            const float mean = wave_sum((x0 + x1) + (x2 + x3)) * (1.0f / 256.0f);
            const float d0 = x0 - mean, d1 = x1 - mean, d2 = x2 - mean, d3 = x3 - mean;
            const float rstd = rsqrtf(wave_sum((d0 * d0 + d1 * d1) + (d2 * d2 + d3 * d3)) * (1.0f / 256.0f) + LN_EPS);
            const f32x4 gg = *(const f32x4*)(gn + col);
            const float r0 = bf_lo(rv.x), r1 = bf_hi(rv.x), r2 = bf_lo(rv.y), r3 = bf_hi(rv.y);
            u32x2 o; o.x = pk_bf16(d0 * rstd * gg[0] * silu_f(r0), d1 * rstd * gg[1] * silu_f(r1)); o.y = pk_bf16(d2 * rstd * gg[2] * silu_f(r2), d3 * rstd * gg[3] * silu_f(r3));
            *(u32x2*)(Y + (size_t)row * D + col) = o; }
    }
}

constexpr int N_PHASES = 2 + 2 * 8 + 2 * 9;

__global__ void __launch_bounds__(NTHR, 2) mega_fwd(Params p) {
    extern __shared__ __attribute__((aligned(16))) unsigned char smem[];
    cg::grid_group grid = cg::this_grid();
    Ctx c; c.p = &p; c.ws = p.ws; c.smem = smem; c.tid = threadIdx.x; c.lane = c.tid & 63; c.wave = __builtin_amdgcn_readfirstlane(c.tid >> 6); c.G = gridDim.x; c.bid = blockIdx.x;
    unsigned char* ws = p.ws;
    unsigned* ctr = (unsigned*)(ws + WS_CTL);
    unsigned target = 0;
    const int lo = p.ph_lo, hi = p.ph_hi;
    int ph = 0;
#ifndef PH_ONLY
#define PH_ONLY -1
#endif
#ifndef DUP_MASK
#define DUP_MASK 0
#endif
#define RUN1(...) { { int t_ = threadIdx.x; asm volatile("" : "+v"(t_)); c.tid = t_; c.lane = t_ & 63; c.wave = __builtin_amdgcn_readfirstlane(t_ >> 6); ws = p.ws; asm volatile("" : "+s"(ws)); c.ws = ws; } __VA_ARGS__; }
#define RUN(id, ...) do { if ((PH_ONLY < 0 || PH_ONLY == (id)) && ph >= lo && ph < hi) { \
        RUN1(__VA_ARGS__) \
        if ((DUP_MASK >> (id)) & 1) { grid_barrier(ctr, target); RUN1(__VA_ARGS__) } \
        if (ph + 1 < hi) { if (ph == 0) grid.sync(); else grid_barrier(ctr, target); } } ++ph; } while (0)
    LAS unsigned char* lds = (LAS unsigned char*)smem;
    const float* MOD = (const float*)(ws + WS_MOD);

    RUN(0, phase_prologue(c));
    RUN(1, phase_mod0(c));
    for (int L = 0; L < DEPTH; ++L) {
        const int j = L >> 1;
        if ((L & 1) == 0) {
            RUN(2, { pg8::Gemm g{(const bf16_t*)(ws + WS_H1), (const bf16_t*)(ws + WS_WAIN) + (size_t)j * 2048 * 1024, T, 2048, 1024}; pg8::StaticOrder S; S.init(T, 2048, c.G, c.bid);
                  pg8::EpiBf16<1> E{(bf16_t*)(ws + WS_R1), 2048}; pg8::gemm_phase(lds, g, S, E, c.tid); });
            RUN(3, phase_vstats(c));
            RUN(4, phase_spatial(c, j));
        } else {
            RUN(5, { pg8::Gemm g{(const bf16_t*)(ws + WS_H1), (const bf16_t*)(ws + WS_WBIN) + (size_t)j * WBIN_N * 1024, T, WBIN_N, 1024}; pg8::StaticOrder S; S.init(T, WBIN_N, c.G, c.bid);
                  pg8::EpiGlaProj E{(bf16_t*)(ws + WS_R1), (bf16_t*)(ws + WS_R1 + SZ_T512), (bf16_t*)(ws + WS_R1 + 2 * SZ_T512), (bf16_t*)(ws + WS_R1 + 2 * SZ_T512 + SZ_T1K), (float*)(ws + WS_GL)};
                  pg8::gemm_phase(lds, g, S, E, c.tid); });
            RUN(6, phase_gla_prep(c, j));
            RUN(7, phase_gla_scan(c));
            RUN(8, phase_gla_readout(c, j));
        }
        RUN(9, { const bf16_t* W = (L & 1) ? (const bf16_t*)(ws + WS_WBOUT) + (size_t)j * 1024 * 1024 : (const bf16_t*)(ws + WS_WAOUT) + (size_t)j * 1024 * 1024;
              pg8::Gemm g{(const bf16_t*)(ws + WS_R2), W, T, 1024, 1024}; pg8::StaticOrder S; S.init(T, 1024, c.G, c.bid);
              pg8::EpiRes E{L == 0 ? p.in[0] : (const float*)(ws + WS_XS), L == 0 ? p.in[2] : (const float*)(ws + WS_XS) + (size_t)TL * D, (float*)(ws + WS_XS), MOD + (size_t)L * 17 * 6144, 2};
              pg8::gemm_phase(lds, g, S, E, c.tid); });
        RUN(10, phase_ln1(c, L));
        RUN(11, { pg8::Gemm g{(const bf16_t*)(ws + WS_R2 + SZ_T1K), (const bf16_t*)(ws + WS_WQ) + (size_t)L * 1024 * 1024, T, 1024, 1024}; pg8::StaticOrder S; S.init(T, 1024, c.G, c.bid);
              pg8::EpiBf16<0> E{(bf16_t*)(ws + WS_R1), 1024}; pg8::gemm_phase(lds, g, S, E, c.tid); });
        RUN(12, phase_route(c, L));
        RUN(13, phase_experts(c, L));
    }
#undef RUN
}

extern "C" void kernel_launch(void* const* d_in, const int* in_sizes, int n_in, void* d_out, int out_size, void* d_ws, size_t ws_size, hipStream_t stream) {
    static int grid = 0;
    if (grid == 0) {
        if (n_in != 23 || out_size != TL * D || ws_size < WS_END) { fprintf(stderr, "kernel_launch: unexpected shapes: n_in %d out %d ws %zu (need %zu)\n", n_in, out_size, ws_size, (size_t)WS_END); grid = -1; return; }
        int dev = 0, cus = 0, per_cu = 0;
        if (hipGetDevice(&dev) != hipSuccess || hipDeviceGetAttribute(&cus, hipDeviceAttributeMultiprocessorCount, dev) != hipSuccess) { fprintf(stderr, "kernel_launch: device query failed\n"); grid = -1; return; }
        if (hipFuncSetAttribute((const void*)mega_fwd, hipFuncAttributeMaxDynamicSharedMemorySize, LDS_BYTES) != hipSuccess) { fprintf(stderr, "kernel_launch: hipFuncSetAttribute failed\n"); grid = -1; return; }
        if (hipOccupancyMaxActiveBlocksPerMultiprocessor(&per_cu, (const void*)mega_fwd, NTHR, LDS_BYTES) != hipSuccess || per_cu < 1) { fprintf(stderr, "kernel_launch: occupancy query says %d blocks per CU\n", per_cu); grid = -1; return; }
        grid = cus;
    }
    if (grid < 0) return;
    (void)hipMemsetAsync((char*)d_ws + WS_CTL, 0, 65536, stream);
    Params p{};
    for (int i = 0; i < 23; ++i) p.in[i] = (const float*)d_in[i];
    p.out = (float*)d_out; p.ws = (unsigned char*)d_ws; p.ph_lo = 0; p.ph_hi = N_PHASES;
    void* args[] = {&p};
    const hipError_t e = hipLaunchCooperativeKernel((const void*)mega_fwd, dim3(grid), dim3(NTHR), args, LDS_BYTES, stream);
    if (e != hipSuccess) fprintf(stderr, "kernel_launch: cooperative launch failed: %s (grid %d)\n", hipGetErrorString(e), grid);
}
```

```cpp
#include <hip/hip_runtime.h>
#include <hip/hip_cooperative_groups.h>
#include <cstdio>
#include <cstdint>
namespace cg = cooperative_groups;

#define LAS __attribute__((address_space(3)))
#define DI __device__ __forceinline__
typedef unsigned short bf16_t;
typedef short bf16x8 __attribute__((ext_vector_type(8)));
typedef float f32x4 __attribute__((ext_vector_type(4)));
typedef float f32x2 __attribute__((ext_vector_type(2)));
typedef unsigned u32x4 __attribute__((ext_vector_type(4)));
typedef unsigned u32x2 __attribute__((ext_vector_type(2)));
typedef __bf16 bf16v2 __attribute__((ext_vector_type(2)));

constexpr int D = 1024, NB = 16, SEQ = 2048, CTXL = 256, DEPTH = 4;
constexpr int TL = NB * SEQ, TC = NB * CTXL, T = TL + TC;
constexpr int NEXP = 16384;
constexpr float LN_EPS = 1e-5f;
constexpr float DN_ALPHA = 1.6817928305074290f;
constexpr int NTHR = 512, NWAVE = 8;
constexpr int LDS_BYTES = 140 * 1024;
constexpr int WBIN_N = 3328;

constexpr size_t al256(size_t x) { return (x + 255) & ~(size_t)255; }
constexpr size_t WS_CTL = 0;
constexpr size_t WS_MOD = 65536;
constexpr size_t WS_STATS = al256(WS_MOD + (size_t)4 * 17 * 6144 * 4);
constexpr size_t WS_GL = al256(WS_STATS + (size_t)T * 2 * 4);
constexpr size_t WS_DEC = al256(WS_GL + (size_t)T * 32 * 4);
constexpr size_t WS_WSB = al256(WS_DEC + (size_t)2 * 576 * 512 * 4);
constexpr size_t WS_WAIN = al256(WS_WSB + (size_t)2 * 8 * 128 * 128 * 2);
constexpr size_t WS_WAOUT = WS_WAIN + (size_t)2 * 2048 * 1024 * 2;
constexpr size_t WS_WBIN = WS_WAOUT + (size_t)2 * 1024 * 1024 * 2;
constexpr size_t WS_WBOUT = WS_WBIN + (size_t)2 * WBIN_N * 1024 * 2;
constexpr size_t WS_WQ = WS_WBOUT + (size_t)2 * 1024 * 1024 * 2;
constexpr size_t WS_UT = WS_WQ + (size_t)4 * 1024 * 1024 * 2;
constexpr size_t WS_VT = WS_UT + (size_t)4 * NEXP * 1024;
constexpr size_t WS_SU = WS_VT + (size_t)4 * NEXP * 1024;
constexpr size_t WS_SV = WS_SU + (size_t)4 * NEXP * 4;
constexpr size_t WS_XS = WS_SV + (size_t)4 * NEXP * 4;
constexpr size_t WS_R1 = WS_XS + (size_t)T * 1024 * 4;
constexpr size_t WS_R2 = WS_R1 + (size_t)T * 3072 * 2;
constexpr size_t WS_H1 = WS_R2 + (size_t)T * 3072 * 2;
constexpr size_t WS_VTT = WS_H1 + (size_t)T * 1024 * 2;
constexpr size_t WS_END = WS_VTT + (size_t)T * 1024 * 2;
constexpr size_t SZ_T1K = (size_t)T * 1024 * 2;
constexpr size_t SZ_T512 = (size_t)T * 512 * 2;

struct Params { const float* in[23]; float* out; unsigned char* ws; int ph_lo, ph_hi; };

DI unsigned pk_bf16(float lo, float hi) { f32x2 v = {lo, hi}; return __builtin_bit_cast(unsigned, __builtin_convertvector(v, bf16v2)); }
DI float bf_lo(unsigned w) { return __uint_as_float(w << 16); }
DI float bf_hi(unsigned w) { return __uint_as_float(w & 0xffff0000u); }
DI float bf1(bf16_t b) { return __uint_as_float(((unsigned)b) << 16); }
DI bf16_t f2bf(float f) { return (bf16_t)(pk_bf16(f, 0.f) & 0xffffu); }
DI float gelu_tanh(float x) { const float u = 0.7978845608028654f * (x + 0.044715f * x * x * x); return __fdividef(x, 1.0f + __expf(-2.0f * u)); }
DI float silu_f(float x) { return __fdividef(x, 1.0f + __expf(-x)); }
DI float logsig_f(float z) { return fminf(z, 0.f) - log1pf(expf(-fabsf(z))); }
DI float wave_sum(float v) {
#pragma unroll
    for (int o = 32; o > 0; o >>= 1) v += __shfl_xor(v, o, 64);
    return v;
}
DI float wave_max(float v) {
#pragma unroll
    for (int o = 32; o > 0; o >>= 1) v = fmaxf(v, __shfl_xor(v, o, 64));
    return v;
}
template <int CTRL> DI float dpp_mov(float x) { return __builtin_bit_cast(float, __builtin_amdgcn_mov_dpp(__builtin_bit_cast(int, x), CTRL, 0xf, 0xf, true)); }
DI float reduce4(float p0, float p1, float p2, float p3) {
    const auto a = __builtin_amdgcn_permlane32_swap(__float_as_uint(p0), __float_as_uint(p2), false, false); const float q0 = __uint_as_float(a[0]) + __uint_as_float(a[1]);
    const auto b = __builtin_amdgcn_permlane32_swap(__float_as_uint(p1), __float_as_uint(p3), false, false); const float q1 = __uint_as_float(b[0]) + __uint_as_float(b[1]);
    const auto c = __builtin_amdgcn_permlane16_swap(__float_as_uint(q0), __float_as_uint(q1), false, false); float s = __uint_as_float(c[0]) + __uint_as_float(c[1]);
    s += dpp_mov<0x128>(s); s += dpp_mov<0x124>(s); s += dpp_mov<0x122>(s); s += dpp_mov<0x121>(s);
    return s;
}
DI float dot2bf(unsigned a, unsigned b, float c) { return __builtin_amdgcn_fdot2_f32_bf16(__builtin_bit_cast(bf16v2, a), __builtin_bit_cast(bf16v2, b), c, false); }
DI f32x4 mfma16(bf16x8 a, bf16x8 b, f32x4 c) { return __builtin_amdgcn_mfma_f32_16x16x32_bf16(a, b, c, 0, 0, 0); }
DI bf16x8 frag_ld(const bf16_t* X, int ld, int row0, int k0, int lane) { return *(const bf16x8*)(X + (size_t)(row0 + (lane & 15)) * ld + k0 + 8 * (lane >> 4)); }
DI int mod_batch(int row) { return row < TL ? (row >> 11) : NB; }

DI void grid_barrier(unsigned* ctr, unsigned& target) {
    asm volatile("s_waitcnt vmcnt(0)" ::: "memory");
    __syncthreads();
    target += gridDim.x;
    if (threadIdx.x == 0) {
        __builtin_amdgcn_fence(__ATOMIC_RELEASE, "agent");
        asm volatile("s_waitcnt vmcnt(0)" ::: "memory");
        __hip_atomic_fetch_add(ctr, 1u, __ATOMIC_RELAXED, __HIP_MEMORY_SCOPE_AGENT);
        while (__hip_atomic_load(ctr, __ATOMIC_RELAXED, __HIP_MEMORY_SCOPE_AGENT) < target) __builtin_amdgcn_s_sleep(2);
        __builtin_amdgcn_fence(__ATOMIC_ACQUIRE, "agent");
        asm volatile("s_waitcnt vmcnt(0)" ::: "memory");
    }
    __syncthreads();
}

namespace pg8 {
constexpr int BM = 256, BK = 64, HALF = 128, HTB = HALF * BK * 2, STAGE_BYTES = 8 * HTB, NXCD = 8, WGM = 8;
__host__ __device__ __forceinline__ int lds_byte(int r, int c) { const int st = (r >> 4) * 2 + (c >> 5), rr = r & 15, cc = c & 31, ob = rr * 64 + cc * 2; return st * 1024 + (ob ^ (((ob >> 9) & 1) << 5)); }
__host__ __device__ __forceinline__ void stage_rc(int b, int& R, int& C) { const int st = b / 1024, sb = b % 1024, swz = sb ^ (((sb >> 9) & 1) << 5); R = (st >> 1) * 16 + swz / 64; C = (st & 1) * 32 + (swz % 64) / 2; }
__host__ __device__ __forceinline__ int perm32(int rho) { const int n = rho >> 4, i = rho & 15; return 8 * (i >> 2) + 4 * n + (i & 3); }
struct Unit { int pm, pn; };
struct Gemm { const bf16_t* A; const bf16_t* Bt; int M, N, K; };
struct StaticOrder {
    int nM, nN, nwg, G, c;
    __device__ void init(int M, int N, int G_, int c_) { nM = M / BM; nN = N / BM; nwg = nM * nN; G = G_; c = c_; }
    __device__ bool next(int i, Unit& u) const {
        const long L = (long)i * G + c; if (L >= nwg) return false;
        int wgid = (int)L; { const int q = nwg / NXCD, r = nwg % NXCD, xcd = wgid % NXCD, off = wgid / NXCD; wgid = (xcd < r ? xcd * (q + 1) : r * (q + 1) + (xcd - r) * q) + off; }
        const int nig = WGM * nN, gid = wgid / nig, fm = gid * WGM, gsz = (nM - fm) < WGM ? (nM - fm) : WGM;
        u.pm = fm + ((wgid % nig) % gsz); u.pn = (wgid % nig) / gsz; return true;
    }
};

template <class Epi>
__device__ __forceinline__ void gemm_phase(LAS unsigned char* lds, const Gemm g, const StaticOrder& S, const Epi& E, const int tid) {
    const int wid = __builtin_amdgcn_readfirstlane(tid >> 6), lane = tid & 63, wr = wid >> 2, wc = wid & 3, fr = lane & 15, fq = lane >> 4;
    const int K = g.K, nt = K / BK;
    unsigned voffA[2], voffB[2];
#pragma unroll
    for (int i = 0; i < 2; ++i) { int R, C; stage_rc(tid * 16 + i * 8192, R, C); const int Rb = Epi::PERM ? ((R & ~31) + perm32(R & 31)) : R;
        voffA[i] = (unsigned)(R * K + C) * 2u; voffB[i] = (unsigned)(Rb * K + C) * 2u; }
    const size_t kstep = (size_t)(BK * 2);
    const size_t hstep = (size_t)HALF * K * 2;
    const size_t tstep = 2 * hstep;
    const unsigned ldsw = (unsigned)wid * 1024u;
    const int aoff = lds_byte(wr * 64 + fr, fq * 8), boff = lds_byte(wc * 32 + fr, fq * 8);
#define PG8_SA(b, h) (((b) * 2 + (h)) * HTB)
#define PG8_SB(b, h) ((4 + (b) * 2 + (h)) * HTB)
#define PG8_STAGE(bufoff, gbase, voff) do { _Pragma("unroll") for (int _i = 0; _i < 2; ++_i) \
        __builtin_amdgcn_global_load_lds((const unsigned*)((const char*)(gbase) + (voff)[_i]), (LAS unsigned*)(lds + (bufoff) + ldsw + _i * 8192), 16, 0, 0); } while (0)
#define PG8_LDA(dst, b, h) do { _Pragma("unroll") for (int m = 0; m < 4; ++m) _Pragma("unroll") for (int k = 0; k < 2; ++k) dst[m][k] = *(const LAS bf16x8*)(lds + PG8_SA(b, h) + aoff + m * 2048 + k * 1024); } while (0)
#define PG8_LDB(dst, b, h) do { _Pragma("unroll") for (int n = 0; n < 2; ++n) _Pragma("unroll") for (int k = 0; k < 2; ++k) dst[n][k] = *(const LAS bf16x8*)(lds + PG8_SB(b, h) + boff + n * 2048 + k * 1024); } while (0)
#define PG8_MMA(ai, bj, At, Bt) do { __builtin_amdgcn_s_setprio(1); _Pragma("unroll") for (int m = 0; m < 4; ++m) _Pragma("unroll") for (int n = 0; n < 2; ++n) _Pragma("unroll") for (int k = 0; k < 2; ++k) \
        acc[ai][bj][m][n] = __builtin_amdgcn_mfma_f32_16x16x32_bf16(Bt[n][k], At[m][k], acc[ai][bj][m][n], 0, 0, 0); __builtin_amdgcn_s_setprio(0); } while (0)
#define PG8_WAIT_V(n) asm volatile("s_waitcnt vmcnt(" #n ")" ::: "memory")
#define PG8_WAIT_L(n) asm volatile("s_waitcnt lgkmcnt(" #n ")" ::: "memory")
#define PG8_BAR __builtin_amdgcn_s_barrier()
#define PG8_SCHED __builtin_amdgcn_sched_barrier(0)
    Unit cur, nxt; int ui = 0;
    if (!S.next(0, cur)) return;
    f32x4 acc[2][2][4][2];
#pragma unroll
    for (int a = 0; a < 2; ++a)
#pragma unroll
        for (int b = 0; b < 2; ++b)
#pragma unroll
            for (int m = 0; m < 4; ++m)
#pragma unroll
                for (int n = 0; n < 2; ++n) acc[a][b][m][n] = (f32x4){0.f, 0.f, 0.f, 0.f};
    bf16x8 At[4][2], B0[2][2], B1[2][2];
    const char* cA = (const char*)g.A + (size_t)cur.pm * tstep; const char* cB = (const char*)g.Bt + (size_t)cur.pn * tstep;
    PG8_STAGE(PG8_SB(0, 0), cB, voffB); PG8_STAGE(PG8_SA(0, 0), cA, voffA); PG8_STAGE(PG8_SB(0, 1), cB + hstep, voffB); PG8_STAGE(PG8_SA(0, 1), cA + hstep, voffA);
    if (wr == 1) PG8_BAR;
    PG8_WAIT_V(4); PG8_BAR;
    PG8_STAGE(PG8_SB(1, 0), cB + kstep, voffB); PG8_STAGE(PG8_SA(1, 0), cA + kstep, voffA); PG8_STAGE(PG8_SB(1, 1), cB + hstep + kstep, voffB);
    PG8_WAIT_V(6); PG8_BAR;
    for (;;) {
        const bool has_next = S.next(ui + 1, nxt);
        const char* nA = has_next ? (const char*)g.A + (size_t)nxt.pm * tstep : cA; const char* nB = has_next ? (const char*)g.Bt + (size_t)nxt.pn * tstep : cB;
        for (int t = 0; t < nt; t += 2) {
            const bool last = (t == nt - 2);
            const char* a1 = cA + (size_t)(t + 1) * kstep;
            const char* a2 = last ? nA : cA + (size_t)(t + 2) * kstep; const char* b2 = last ? nB : cB + (size_t)(t + 2) * kstep;
            const char* a3 = a2 + kstep; const char* b3 = b2 + kstep;
            PG8_LDB(B0, 0, 0); PG8_SCHED; PG8_LDA(At, 0, 0); PG8_STAGE(PG8_SA(1, 1), a1 + hstep, voffA);
            PG8_WAIT_L(8); PG8_BAR; PG8_WAIT_L(0); PG8_MMA(0, 0, At, B0); PG8_BAR; PG8_SCHED;
            PG8_LDB(B1, 0, 1); PG8_STAGE(PG8_SB(0, 0), b2, voffB);
            PG8_BAR; PG8_WAIT_L(0); PG8_MMA(0, 1, At, B1); PG8_BAR;
            PG8_LDA(At, 0, 1); PG8_STAGE(PG8_SA(0, 0), a2, voffA);
            PG8_BAR; PG8_WAIT_L(0); PG8_MMA(1, 0, At, B0); PG8_BAR; PG8_SCHED;
            PG8_STAGE(PG8_SB(0, 1), b2 + hstep, voffB);
            PG8_WAIT_V(6); PG8_BAR; PG8_MMA(1, 1, At, B1); PG8_BAR;
            PG8_LDB(B0, 1, 0); PG8_SCHED; PG8_LDA(At, 1, 0); PG8_STAGE(PG8_SA(0, 1), a2 + hstep, voffA);
            PG8_WAIT_L(8); PG8_BAR; PG8_WAIT_L(0); PG8_MMA(0, 0, At, B0); PG8_BAR; PG8_SCHED;
            PG8_LDB(B1, 1, 1); PG8_STAGE(PG8_SB(1, 0), b3, voffB);
            PG8_BAR; PG8_WAIT_L(0); PG8_MMA(0, 1, At, B1); PG8_BAR;
            PG8_LDA(At, 1, 1); PG8_STAGE(PG8_SA(1, 0), a3, voffA);
            PG8_BAR; PG8_WAIT_L(0); PG8_MMA(1, 0, At, B0); PG8_BAR; PG8_SCHED;
            PG8_STAGE(PG8_SB(1, 1), b3 + hstep, voffB);
            PG8_WAIT_V(6); PG8_BAR; PG8_MMA(1, 1, At, B1); PG8_BAR;
        }
        E(acc, cur, wr, wc, fr, fq);
        if (!has_next) break;
#pragma unroll
        for (int a = 0; a < 2; ++a)
#pragma unroll
            for (int b = 0; b < 2; ++b)
#pragma unroll
                for (int m = 0; m < 4; ++m)
#pragma unroll
                    for (int n = 0; n < 2; ++n) acc[a][b][m][n] = (f32x4){0.f, 0.f, 0.f, 0.f};
        cur = nxt; cA = nA; cB = nB; ++ui;
    }
    PG8_WAIT_V(0);
    if (wr == 0) PG8_BAR;
    PG8_BAR;
#undef PG8_SA
#undef PG8_SB
#undef PG8_STAGE
#undef PG8_LDA
#undef PG8_LDB
#undef PG8_MMA
#undef PG8_WAIT_V
#undef PG8_WAIT_L
#undef PG8_BAR
#undef PG8_SCHED
}

template <int ACT  > struct EpiBf16 {
    static constexpr bool PERM = true;
    bf16_t* O; int ldc;
    __device__ __forceinline__ void operator()(const f32x4 (&acc)[2][2][4][2], const Unit& u, int wr, int wc, int fr, int fq) const {
        const int row0 = u.pm * BM + wr * 64 + fr, col0 = u.pn * BM + wc * 32 + 8 * fq;
#pragma unroll
        for (int ai = 0; ai < 2; ++ai)
#pragma unroll
            for (int m = 0; m < 4; ++m) { bf16_t* rowp = O + (size_t)(row0 + ai * HALF + m * 16) * ldc + col0;
#pragma unroll
                for (int bj = 0; bj < 2; ++bj) { f32x4 v0 = acc[ai][bj][m][0], v1 = acc[ai][bj][m][1];
                    if (ACT == 1) {
#pragma unroll
                        for (int j = 0; j < 4; ++j) { v0[j] = gelu_tanh(v0[j]); v1[j] = gelu_tanh(v1[j]); } }
                    u32x4 w; w.x = pk_bf16(v0[0], v0[1]); w.y = pk_bf16(v0[2], v0[3]); w.z = pk_bf16(v1[0], v1[1]); w.w = pk_bf16(v1[2], v1[3]);
                    *(u32x4*)(rowp + bj * HALF) = w; } }
    }
};
struct EpiRes {
    static constexpr bool PERM = false;
    const float* src_lat; const float* src_ctx; float* dst; const float* modL; int gate_idx;
    __device__ __forceinline__ void operator()(const f32x4 (&acc)[2][2][4][2], const Unit& u, int wr, int wc, int fr, int fq) const {
        const bool isctx = u.pm >= (TL / BM);
        const float* sb = isctx ? src_ctx + (size_t)(u.pm - TL / BM) * BM * D : src_lat + (size_t)u.pm * BM * D;
        const int mb = isctx ? NB : (u.pm >> 3);
        const float* gv = modL + (size_t)mb * 6144 + gate_idx * 1024;
        const int rl = wr * 64 + fr, col0 = u.pn * BM + wc * 32 + 4 * fq;
        f32x4 g[2][2];
#pragma unroll
        for (int bj = 0; bj < 2; ++bj)
#pragma unroll
            for (int n = 0; n < 2; ++n) g[bj][n] = *(const f32x4*)(gv + col0 + bj * HALF + n * 16);
#pragma unroll
        for (int ai = 0; ai < 2; ++ai)
#pragma unroll
            for (int m = 0; m < 4; ++m) { const int r = rl + ai * HALF + m * 16; const float* sp = sb + (size_t)r * D + col0; float* dp = dst + ((size_t)u.pm * BM + r) * D + col0;
#pragma unroll
                for (int bj = 0; bj < 2; ++bj)
#pragma unroll
                    for (int n = 0; n < 2; ++n) { const f32x4 x = *(const f32x4*)(sp + bj * HALF + n * 16); *(f32x4*)(dp + bj * HALF + n * 16) = x * DN_ALPHA + g[bj][n] * acc[ai][bj][m][n]; } }
    }
};
struct EpiGlaProj {
    static constexpr bool PERM = true;
    bf16_t* QG; bf16_t* KG; bf16_t* VG; bf16_t* RG; float* GL;
    __device__ __forceinline__ void operator()(const f32x4 (&acc)[2][2][4][2], const Unit& u, int wr, int wc, int fr, int fq) const {
        const int row0 = u.pm * BM + wr * 64 + fr, pn = u.pn;
        if (pn < 12) {
            bf16_t* base; int ld, colt; float sc = 1.f;
            if (pn < 2) { base = QG; ld = 512; colt = pn * BM; sc = 0.08838834764831845f; }
            else if (pn < 4) { base = KG; ld = 512; colt = (pn - 2) * BM; }
            else if (pn < 8) { base = VG; ld = 1024; colt = (pn - 4) * BM; }
            else { base = RG; ld = 1024; colt = (pn - 8) * BM; }
            const int col0 = colt + wc * 32 + 8 * fq;
#pragma unroll
            for (int ai = 0; ai < 2; ++ai)
#pragma unroll
                for (int m = 0; m < 4; ++m) { bf16_t* rowp = base + (size_t)(row0 + ai * HALF + m * 16) * ld + col0;
#pragma unroll
                    for (int bj = 0; bj < 2; ++bj) { const f32x4 v0 = acc[ai][bj][m][0] * sc, v1 = acc[ai][bj][m][1] * sc;
                        u32x4 w; w.x = pk_bf16(v0[0], v0[1]); w.y = pk_bf16(v0[2], v0[3]); w.z = pk_bf16(v1[0], v1[1]); w.w = pk_bf16(v1[2], v1[3]);
                        *(u32x4*)(rowp + bj * HALF) = w; } }
        } else if (wc == 0) {
#pragma unroll
            for (int ai = 0; ai < 2; ++ai)
#pragma unroll
                for (int m = 0; m < 4; ++m) { float* gp = GL + (size_t)(row0 + ai * HALF + m * 16) * 32 + 8 * fq;
                    *(f32x4*)gp = acc[ai][0][m][0]; *(f32x4*)(gp + 4) = acc[ai][0][m][1]; }
        }
    }
};
}

struct Ctx {
    const Params* p; unsigned char* ws; unsigned char* smem; int tid, lane, wave, G, bid;
};

DI void phase_prologue(const Ctx& c) {
    const Params& p = *c.p; unsigned char* ws = c.ws;
    const int tid = c.tid;
    constexpr int N_MOD = 192, N_TR = 4736, N_WS = 64, N_TAB = 2048;
    constexpr int N_ALL = N_MOD + N_TR + N_WS + N_TAB;
    for (int u = c.bid; u < N_ALL; u += c.G) {
        if (u < N_MOD) {
            const int l = u / 48, n0 = (u % 48) * 128;
            float* sc = (float*)c.smem;
            float* red = (float*)(c.smem + 17 * 1024 * 4);
            __syncthreads();
#pragma unroll 1
            for (int hk = 0; hk < 2; ++hk) { const int k = hk * 512 + tid; float v[17];
#pragma unroll
                for (int b = 0; b < 17; ++b) v[b] = (b < NB) ? p.in[1][b * 1024 + k] : p.in[3][k];
#pragma unroll
                for (int b = 0; b < 17; ++b) sc[b * 1024 + k] = silu_f(v[b]); }
            __syncthreads();
            const int c4 = (tid & 31) * 4, kg = tid >> 5;
            float acc[17][4];
#pragma unroll
            for (int b = 0; b < 17; ++b) { acc[b][0] = 0.f; acc[b][1] = 0.f; acc[b][2] = 0.f; acc[b][3] = 0.f; }
            const float* wp = p.in[4] + ((size_t)l * 1024 + (size_t)kg * 64) * 6144 + n0 + c4;
#pragma unroll 4
            for (int kk = 0; kk < 64; ++kk) {
                const f32x4 w = *(const f32x4*)(wp + (size_t)kk * 6144);
                const int k = kg * 64 + kk;
#pragma unroll
                for (int b = 0; b < 17; ++b) { const float s = sc[b * 1024 + k]; acc[b][0] += s * w[0]; acc[b][1] += s * w[1]; acc[b][2] += s * w[2]; acc[b][3] += s * w[3]; }
            }
#pragma unroll
            for (int b = 0; b < 17; ++b)
#pragma unroll
                for (int j = 0; j < 4; ++j) acc[b][j] += __shfl_xor(acc[b][j], 32, 64);
            if ((tid & 32) == 0) {
#pragma unroll
                for (int b = 0; b < 17; ++b)
#pragma unroll
                    for (int j = 0; j < 4; ++j) red[(c.wave * 17 + b) * 128 + c4 + j] = acc[b][j];
            }
            __syncthreads();
            for (int o = tid; o < 17 * 128; o += NTHR) { const int b = o >> 7, n = o & 127; float s = 0.f;
#pragma unroll
                for (int w = 0; w < 8; ++w) s += red[(w * 17 + b) * 128 + n];
                ((float*)(ws + WS_MOD))[((size_t)l * 17 + b) * 6144 + n0 + n] = s + p.in[5][l * 6144 + n0 + n]; }
        } else if (u < N_MOD + N_TR) {
            int v = u - N_MOD; const float* src; bf16_t* dst; int N, Npad;
            if (v < 1024) { const int j = v / 512; v %= 512; src = p.in[8] + (size_t)j * 1024 * 2048; dst = (bf16_t*)(ws + WS_WAIN) + (size_t)j * 2048 * 1024; N = 2048; Npad = 2048; }
            else if (v < 1536) { v -= 1024; const int j = v / 256; v %= 256; src = p.in[13] + (size_t)j * 1024 * 1024; dst = (bf16_t*)(ws + WS_WAOUT) + (size_t)j * 1024 * 1024; N = 1024; Npad = 1024; }
            else if (v < 3200) { v -= 1536; const int j = v / 832; v %= 832; src = p.in[14] + (size_t)j * 1024 * 3104; dst = (bf16_t*)(ws + WS_WBIN) + (size_t)j * WBIN_N * 1024; N = 3104; Npad = WBIN_N; }
            else if (v < 3712) { v -= 3200; const int j = v / 256; v %= 256; src = p.in[18] + (size_t)j * 1024 * 1024; dst = (bf16_t*)(ws + WS_WBOUT) + (size_t)j * 1024 * 1024; N = 1024; Npad = 1024; }
            else { v -= 3712; const int j = v / 256; v %= 256; src = p.in[19] + (size_t)j * 1024 * 1024; dst = (bf16_t*)(ws + WS_WQ) + (size_t)j * 1024 * 1024; N = 1024; Npad = 1024; }
            (void)Npad;
            const int ntn = v >> 4, ktile = v & 15, n0 = ntn * 64, k0 = ktile * 64;
            float* tl = (float*)c.smem;
            __syncthreads();
#pragma unroll
            for (int i = 0; i < 2; ++i) { const int kk = (tid >> 4) + 32 * i, nn = (tid & 15) * 4;
                f32x4 x = {0.f, 0.f, 0.f, 0.f};
                if (n0 + nn < N) x = *(const f32x4*)(src + (size_t)(k0 + kk) * N + n0 + nn);
                tl[kk * 65 + nn] = x[0]; tl[kk * 65 + nn + 1] = x[1]; tl[kk * 65 + nn + 2] = x[2]; tl[kk * 65 + nn + 3] = x[3]; }
            __syncthreads();
            { const int nn = tid >> 3, kk8 = (tid & 7) * 8; float x[8];
#pragma unroll
              for (int j = 0; j < 8; ++j) x[j] = tl[(kk8 + j) * 65 + nn];
              u32x4 w; w.x = pk_bf16(x[0], x[1]); w.y = pk_bf16(x[2], x[3]); w.z = pk_bf16(x[4], x[5]); w.w = pk_bf16(x[6], x[7]);
              *(u32x4*)(dst + (size_t)(n0 + nn) * 1024 + k0 + kk8) = w; }
        } else if (u < N_MOD + N_TR + N_WS) {
            const int v = u - N_MOD - N_TR; const size_t e = (size_t)v * 4096 + (size_t)tid * 8;
            const f32x4 a = *(const f32x4*)(p.in[11] + e), b = *(const f32x4*)(p.in[11] + e + 4);
            u32x4 w; w.x = pk_bf16(a[0], a[1]); w.y = pk_bf16(a[2], a[3]); w.z = pk_bf16(b[0], b[1]); w.w = pk_bf16(b[2], b[3]);
            *(u32x4*)((bf16_t*)(ws + WS_WSB) + e) = w;
        } else {
            const int v = u - N_MOD - N_TR - N_WS; const int tab = v >> 10;
            const float* src = p.in[21 + tab]; unsigned char* dst = ws + (tab ? WS_VT : WS_UT); float* sc = (float*)(ws + (tab ? WS_SV : WS_SU));
#pragma unroll 2
            for (int i = 0; i < 8; ++i) { const size_t row = (size_t)(v & 1023) * 64 + c.wave * 8 + i;
                const float* rp = src + row * 1024 + 16 * c.lane; f32x4 x[4]; float am = 0.f;
#pragma unroll
                for (int q = 0; q < 4; ++q) { x[q] = __builtin_nontemporal_load((const f32x4*)(rp + 4 * q)); am = fmaxf(am, fmaxf(fmaxf(fabsf(x[q][0]), fabsf(x[q][1])), fmaxf(fabsf(x[q][2]), fabsf(x[q][3])))); }
                am = fmaxf(wave_max(am), 1e-30f);
                const size_t Lr = row >> 14, er = row & 16383;
                if (tab == 0) {
                    const float inv = 440.0f / am; u32x4 w;
#pragma unroll
                    for (int q = 0; q < 4; ++q) { int t = 0; t = __builtin_amdgcn_cvt_pk_fp8_f32(x[q][0] * inv, x[q][1] * inv, t, false); t = __builtin_amdgcn_cvt_pk_fp8_f32(x[q][2] * inv, x[q][3] * inv, t, true); w[q] = (unsigned)t; }
                    *(u32x4*)(dst + ((Lr * 8 + (c.lane >> 3)) * NEXP + er) * 128 + 16 * (c.lane & 7)) = w;
                    if (c.lane == 0) sc[row] = am * (1.0f / 440.0f);
                } else {
                    const float inv = 6.0f / am; u32x2 w;
#pragma unroll
                    for (int hq = 0; hq < 2; ++hq) { unsigned t = 0;
                        t = __builtin_amdgcn_cvt_scalef32_pk_fp4_f32(t, x[2 * hq][0] * inv, x[2 * hq][1] * inv, 1.0f, 0); t = __builtin_amdgcn_cvt_scalef32_pk_fp4_f32(t, x[2 * hq][2] * inv, x[2 * hq][3] * inv, 1.0f, 1);
                        t = __builtin_amdgcn_cvt_scalef32_pk_fp4_f32(t, x[2 * hq + 1][0] * inv, x[2 * hq + 1][1] * inv, 1.0f, 2); t = __builtin_amdgcn_cvt_scalef32_pk_fp4_f32(t, x[2 * hq + 1][2] * inv, x[2 * hq + 1][3] * inv, 1.0f, 3);
                        w[hq] = t; }
                    *(u32x2*)(dst + ((Lr * 4 + (c.lane >> 4)) * NEXP + er) * 128 + 8 * (c.lane & 15)) = w;
                    if (c.lane == 0) sc[row] = am * (1.0f / 6.0f);
                } }
        }
    }
}

DI void phase_mod0(const Ctx& c) {
    const Params& p = *c.p; const float* MOD = (const float*)(c.ws + WS_MOD); bf16_t* H1 = (bf16_t*)(c.ws + WS_H1);
    for (int row = c.bid * NWAVE + c.wave; row < T; row += c.G * NWAVE) {
        const float* src = row < TL ? p.in[0] + (size_t)row * D : p.in[2] + (size_t)(row - TL) * D;
        const float* m = MOD + (size_t)mod_batch(row) * 6144;
#pragma unroll
        for (int j = 0; j < 4; ++j) { const int col = 4 * c.lane + 256 * j;
            const f32x4 x = *(const f32x4*)(src + col), sh = *(const f32x4*)(m + col), s = *(const f32x4*)(m + 1024 + col);
            const f32x4 h = x * (s + 1.0f) + sh; u32x2 w; w.x = pk_bf16(h[0], h[1]); w.y = pk_bf16(h[2], h[3]);
            *(u32x2*)(H1 + (size_t)row * D + col) = w; }
    }
}

DI void phase_vstats(const Ctx& c) {
    const bf16_t* UV = (const bf16_t*)(c.ws + WS_R1); float* ST = (float*)(c.ws + WS_STATS);
    for (int row = c.bid * NWAVE + c.wave; row < T; row += c.G * NWAVE) {
        const bf16_t* vp = UV + (size_t)row * 2048 + 1024;
        const u32x4 a = *(const u32x4*)(vp + 8 * c.lane), b = *(const u32x4*)(vp + 512 + 8 * c.lane);
        float x[16];
#pragma unroll
        for (int j = 0; j < 4; ++j) { x[2 * j] = bf_lo(a[j]); x[2 * j + 1] = bf_hi(a[j]); x[8 + 2 * j] = bf_lo(b[j]); x[9 + 2 * j] = bf_hi(b[j]); }
        float s = 0.f;
#pragma unroll
        for (int j = 0; j < 16; ++j) s += x[j];
        const float mean = wave_sum(s) * (1.0f / 1024.0f);
        float q = 0.f;
#pragma unroll
        for (int j = 0; j < 16; ++j) { const float d = x[j] - mean; q += d * d; }
        const float var = wave_sum(q) * (1.0f / 1024.0f);
        if (c.lane == 0) { ST[2 * row] = mean; ST[2 * row + 1] = rsqrtf(var + LN_EPS); }
    }
}

DI void phase_spatial(const Ctx& c, int j) {
    const Params& p = *c.p; unsigned char* ws = c.ws;
    const bf16_t* UV = (const bf16_t*)(ws + WS_R1); const float* ST = (const float*)(ws + WS_STATS); bf16_t* Y = (bf16_t*)(ws + WS_R2);
    const bf16_t* WSB = (const bf16_t*)(ws + WS_WSB) + (size_t)j * 8 * 128 * 128;
    const float* ng = p.in[9] + j * 1024; const float* nb = p.in[10] + j * 1024; const float* bs = p.in[12] + j * 8 * 128;
    constexpr int LD = 136;
    bf16_t* WsL = (bf16_t*)c.smem;
    bf16_t* VnT = WsL + 128 * LD;
    const int tid = c.tid, lane = c.lane, w = c.wave, g = lane >> 4, cc = lane & 15;
    for (int u = c.bid; u < (T / 128) * 8; u += c.G) {
        const int chunk = u >> 3, h = u & 7, r0 = chunk * 128;
        __syncthreads();
        { const int cg8 = tid & 15; float gg[8], bb[8];
#pragma unroll
          for (int e = 0; e < 8; ++e) { gg[e] = ng[h * 128 + cg8 * 8 + e]; bb[e] = nb[h * 128 + cg8 * 8 + e]; }
#pragma unroll
          for (int i = 0; i < 4; ++i) { const int idx = i * 512 + tid, tok = idx >> 4;
              const u32x4 v = *(const u32x4*)(UV + (size_t)(r0 + tok) * 2048 + 1024 + h * 128 + cg8 * 8);
              const float mean = ST[2 * (r0 + tok)], rstd = ST[2 * (r0 + tok) + 1];
              float x[8];
#pragma unroll
              for (int e = 0; e < 4; ++e) { x[2 * e] = bf_lo(v[e]); x[2 * e + 1] = bf_hi(v[e]); }
#pragma unroll
              for (int e = 0; e < 8; ++e) VnT[(cg8 * 8 + e) * LD + tok] = f2bf((x[e] - mean) * rstd * gg[e] + bb[e]);
              const int pp = idx >> 4;
              *(u32x4*)(WsL + pp * LD + cg8 * 8) = *(const u32x4*)(WSB + ((size_t)h * 128 + pp) * 128 + cg8 * 8); } }
        __syncthreads();
        f32x4 acc[8];
#pragma unroll
        for (int ct = 0; ct < 8; ++ct) acc[ct] = (f32x4){0.f, 0.f, 0.f, 0.f};
#pragma unroll
        for (int ks = 0; ks < 4; ++ks) {
            const bf16x8 bfr = frag_ld(WsL, LD, 16 * w, 32 * ks, lane);
#pragma unroll
            for (int ct = 0; ct < 8; ++ct) acc[ct] = mfma16(frag_ld(VnT, LD, 16 * ct, 32 * ks, lane), bfr, acc[ct]);
        }
        const int pp = 16 * w + cc; const float bsv = bs[h * 128 + pp];
        const size_t rowo = (size_t)(r0 + pp);
#pragma unroll
        for (int ct = 0; ct < 8; ++ct) { const int ch = h * 128 + 16 * ct + 4 * g;
            const u32x2 uu = *(const u32x2*)(UV + rowo * 2048 + ch);
            const float y0 = bf_lo(uu.x) * (acc[ct][0] + bsv), y1 = bf_hi(uu.x) * (acc[ct][1] + bsv), y2 = bf_lo(uu.y) * (acc[ct][2] + bsv), y3 = bf_hi(uu.y) * (acc[ct][3] + bsv);
            u32x2 o; o.x = pk_bf16(y0, y1); o.y = pk_bf16(y2, y3);
            *(u32x2*)(Y + rowo * D + ch) = o; }
    }
}

DI void phase_ln1(const Ctx& c, int L) {
    const Params& p = *c.p; float* XS = (float*)(c.ws + WS_XS); const float* MOD = (const float*)(c.ws + WS_MOD) + (size_t)L * 17 * 6144;
    bf16_t* H2 = (bf16_t*)(c.ws + WS_R2 + SZ_T1K);
    const float* lg = p.in[6] + (size_t)(L * 2 + 0) * D; const float* lb = p.in[7] + (size_t)(L * 2 + 0) * D;
    for (int row = c.bid * NWAVE + c.wave; row < T; row += c.G * NWAVE) {
        float* xp = XS + (size_t)row * D; const float* m = MOD + (size_t)mod_batch(row) * 6144;
        f32x4 x[4]; float s = 0.f;
#pragma unroll
        for (int j = 0; j < 4; ++j) { x[j] = *(const f32x4*)(xp + 4 * c.lane + 256 * j); s += (x[j][0] + x[j][1]) + (x[j][2] + x[j][3]); }
        const float mean = wave_sum(s) * (1.0f / 1024.0f);
        float q = 0.f;
#pragma unroll
        for (int j = 0; j < 4; ++j) { const f32x4 d = x[j] - mean; q += (d[0] * d[0] + d[1] * d[1]) + (d[2] * d[2] + d[3] * d[3]); }
        const float rstd = rsqrtf(wave_sum(q) * (1.0f / 1024.0f) + LN_EPS);
#pragma unroll
        for (int j = 0; j < 4; ++j) { const int col = 4 * c.lane + 256 * j;
            const f32x4 y = (x[j] - mean) * rstd * *(const f32x4*)(lg + col) + *(const f32x4*)(lb + col);
            *(f32x4*)(xp + col) = y;
            const f32x4 h = y * (*(const f32x4*)(m + 4 * 1024 + col) + 1.0f) + *(const f32x4*)(m + 3 * 1024 + col);
            u32x2 w; w.x = pk_bf16(h[0], h[1]); w.y = pk_bf16(h[2], h[3]);
            *(u32x2*)(H2 + (size_t)row * D + col) = w; }
    }
}

DI int f2key(float v) { const int i = __float_as_int(v); return i ^ ((i >> 31) & 0x7fffffff); }
DI float key2f(int k) { return __int_as_float(k ^ ((k >> 31) & 0x7fffffff)); }
DI void phase_route(const Ctx& c, int L) {
    const Params& p = *c.p; unsigned char* ws = c.ws; const int lane = c.lane, g = lane >> 4, cc = lane & 15;
    constexpr int LDK = 72, LDS_S = 20;
    bf16_t* keysHi = (bf16_t*)c.smem;
    bf16_t* keysLo = keysHi + 2 * 128 * LDK;
    float* sbase = (float*)(keysLo + 2 * 128 * LDK);
    unsigned* ilist = (unsigned*)(sbase + NWAVE * 64 * LDS_S);
    __syncthreads();
    { const float* gk = p.in[20] + (size_t)L * 2 * 128 * 64;
      f32x4 kv[8];
#pragma unroll
      for (int it = 0; it < 8; ++it) kv[it] = ((const f32x4*)gk)[it * NTHR + c.tid];
#pragma unroll
      for (int it = 0; it < 8; ++it) { const int i = (it * NTHR + c.tid) * 4, row = i >> 6, d = i & 63; unsigned hi[2], lo[2];
#pragma unroll
          for (int e = 0; e < 2; ++e) { const unsigned ph = pk_bf16(kv[it][2 * e], kv[it][2 * e + 1]); hi[e] = ph; lo[e] = pk_bf16(kv[it][2 * e] - bf_lo(ph), kv[it][2 * e + 1] - bf_hi(ph)); }
          *(u32x2*)(keysHi + row * LDK + d) = (u32x2){hi[0], hi[1]}; *(u32x2*)(keysLo + row * LDK + d) = (u32x2){lo[0], lo[1]}; } }
    __syncthreads();
    float* S = sbase + c.wave * 64 * LDS_S;
    const bf16_t* QP = (const bf16_t*)(ws + WS_R1); int* IDX = (int*)(ws + WS_R1 + SZ_T1K); float* WT = (float*)(ws + WS_R1 + SZ_T1K + (size_t)T * 128 * 4);
    unsigned* myl = ilist + c.tid * 8; const unsigned char* mylb = (const unsigned char*)myl;
    for (int task = c.bid * NWAVE + c.wave; task < (T / 64) * 8; task += c.G * NWAVE) {
        const int t0 = (task >> 3) * 64, h = task & 7, tok = t0 + lane;
        float t12[2][16];
#pragma unroll
        for (int half = 0; half < 2; ++half) {
            bf16x8 aq[4][2];
#pragma unroll
            for (int mt = 0; mt < 4; ++mt)
#pragma unroll
                for (int ks = 0; ks < 2; ++ks) aq[mt][ks] = *(const bf16x8*)(QP + (size_t)(t0 + 16 * mt + cc) * D + h * 128 + half * 64 + 32 * ks + 8 * g);
            const bf16_t* kh = keysHi + half * 128 * LDK; const bf16_t* kl = keysLo + half * 128 * LDK;
#pragma unroll
            for (int i = 0; i < 16; ++i) t12[half][i] = -3.0e38f;
            for (int nt = 0; nt < 8; ++nt) {
                const bf16x8 bh0 = frag_ld(kh, LDK, 16 * nt, 0, lane), bh1 = frag_ld(kh, LDK, 16 * nt, 32, lane), bl0 = frag_ld(kl, LDK, 16 * nt, 0, lane), bl1 = frag_ld(kl, LDK, 16 * nt, 32, lane);
#pragma unroll
                for (int mt = 0; mt < 4; ++mt) { f32x4 a = {0.f, 0.f, 0.f, 0.f};
                    a = mfma16(aq[mt][0], bl0, a); a = mfma16(aq[mt][1], bl1, a); a = mfma16(aq[mt][0], bh0, a); a = mfma16(aq[mt][1], bh1, a);
#pragma unroll
                    for (int r = 0; r < 4; ++r) S[(16 * mt + 4 * g + r) * LDS_S + cc] = a[r]; }
                f32x4 sc[4];
#pragma unroll
                for (int q4 = 0; q4 < 4; ++q4) sc[q4] = *(const f32x4*)(S + lane * LDS_S + 4 * q4);
#pragma unroll
                for (int kk = 0; kk < 16; ++kk) { const float key = __int_as_float((__float_as_int(sc[kk >> 2][kk & 3]) & ~127) | (127 - (16 * nt + kk)));
#pragma unroll
                    for (int i = 15; i >= 1; --i) t12[half][i] = __builtin_amdgcn_fmed3f(key, t12[half][i - 1], t12[half][i]);
                    t12[half][0] = __builtin_amdgcn_fmed3f(key, 3.0e38f, t12[half][0]); }
            }
        }
        float v1[16], v2[16];
#pragma unroll
        for (int i = 0; i < 16; ++i) { v1[i] = __int_as_float(__float_as_int(t12[0][i]) & ~127); v2[i] = __int_as_float(__float_as_int(t12[1][i]) & ~127); }
#pragma unroll
        for (int i = 0; i < 4; ++i) {
            myl[i] = (unsigned)(127 - (__float_as_int(t12[0][4 * i]) & 127)) | ((unsigned)(127 - (__float_as_int(t12[0][4 * i + 1]) & 127)) << 8) | ((unsigned)(127 - (__float_as_int(t12[0][4 * i + 2]) & 127)) << 16) | ((unsigned)(127 - (__float_as_int(t12[0][4 * i + 3]) & 127)) << 24);
            myl[4 + i] = (unsigned)(127 - (__float_as_int(t12[1][4 * i]) & 127)) | ((unsigned)(127 - (__float_as_int(t12[1][4 * i + 1]) & 127)) << 8) | ((unsigned)(127 - (__float_as_int(t12[1][4 * i + 2]) & 127)) << 16) | ((unsigned)(127 - (__float_as_int(t12[1][4 * i + 3]) & 127)) << 24); }
        float f[16];
#pragma unroll
        for (int i = 0; i < 16; ++i) f[i] = -3.0e38f;
#pragma unroll
        for (int a = 0; a < 16; ++a)
#pragma unroll
            for (int b = 0; b < 16; ++b)
                if ((a + 1) * (b + 1) <= 16) {
                    const float key = __int_as_float((__float_as_int(v1[a] + v2[b]) & ~255) | (255 - (a * 16 + b)));
#pragma unroll
                    for (int i = 15; i >= 1; --i) f[i] = __builtin_amdgcn_fmed3f(key, f[i - 1], f[i]);
                    f[0] = __builtin_amdgcn_fmed3f(key, 3.0e38f, f[0]);
                }
        float e[16], se = 0.f; int fi[16];
        const float vmax = __int_as_float(__float_as_int(f[0]) & ~255);
#pragma unroll
        for (int i = 0; i < 16; ++i) { const int code = 255 - (__float_as_int(f[i]) & 255); fi[i] = (int)mylb[code >> 4] * 128 + (int)mylb[16 + (code & 15)];
            e[i] = __expf(__int_as_float(__float_as_int(f[i]) & ~255) - vmax); se += e[i]; }
        const float inv = 1.0f / se;
        int* ip = IDX + (size_t)tok * 128 + h * 16; float* wp = WT + (size_t)tok * 128 + h * 16;
#pragma unroll
        for (int i = 0; i < 16; i += 4) { *(int4*)(ip + i) = make_int4(fi[i], fi[i + 1], fi[i + 2], fi[i + 3]); *(f32x4*)(wp + i) = (f32x4){e[i] * inv, e[i + 1] * inv, e[i + 2] * inv, e[i + 3] * inv}; }
    }
}

DI float red8(float p) { p += dpp_mov<0xB1>(p); p += dpp_mov<0x4E>(p); p += dpp_mov<0x141>(p); return p; }
DI void phase_experts(const Ctx& c, int L) {
    const Params& p = *c.p; unsigned char* ws = c.ws; const int lane = c.lane, g8 = lane >> 3, j = lane & 7;
    constexpr int MAXTOK = 18;
    const bf16_t* H2 = (const bf16_t*)(ws + WS_R2 + SZ_T1K);
    const int* IDX = (const int*)(ws + WS_R1 + SZ_T1K); const float* WT = (const float*)(ws + WS_R1 + SZ_T1K + (size_t)T * 128 * 4);
    bf16_t* FFN = (bf16_t*)(ws + WS_R1);
    const unsigned char* UT = ws + WS_UT + (size_t)L * NEXP * 1024; const unsigned char* VT = ws + WS_VT + (size_t)L * NEXP * 512;
    const float* SU = (const float*)(ws + WS_SU) + (size_t)L * NEXP; const float* SV = (const float*)(ws + WS_SV) + (size_t)L * NEXP;
    float* XS = (float*)(ws + WS_XS); bf16_t* H1 = (bf16_t*)(ws + WS_H1);
    const float* MOD = (const float*)(ws + WS_MOD) + (size_t)L * 17 * 6144;
    const float* lg = p.in[6] + (size_t)(L * 2 + 1) * D; const float* lb = p.in[7] + (size_t)(L * 2 + 1) * D;
    const int nrows = (L == DEPTH - 1) ? TL : T;
    float* ZL = (float*)c.smem + c.wave * MAXTOK * 128;
    unsigned short* IL = (unsigned short*)(c.smem + NWAVE * MAXTOK * 128 * 4) + c.wave * MAXTOK * 128;
    const int GW = c.G * NWAVE, gw = c.bid * NWAVE + c.wave;
    const int tsrc = 8 * (lane & 7) + (lane >> 3);
    for (int base = 0; base < nrows; base += GW * MAXTOK) {
        int ntok = 0;
        for (int k = 0; k < MAXTOK; ++k) { const int tok = base + gw + GW * k; if (tok < nrows) { ntok = k + 1;
            IL[k * 128 + lane] = (unsigned short)IDX[(size_t)tok * 128 + lane]; IL[k * 128 + 64 + lane] = (unsigned short)IDX[(size_t)tok * 128 + 64 + lane]; } }
        for (int c8 = 0; c8 < 8; ++c8) {
            const unsigned char* Ub = UT + (size_t)c8 * NEXP * 128 + 16 * j;
            const bf16_t* Xb = H2 + 128 * c8 + 16 * j;
            u32x4 rA[8], rB[8], xA[2], xB[2];
#define U_ISSUE(R, X, k_, hf_) do { const int tok_ = base + gw + GW * (k_); X[0] = *(const u32x4*)(Xb + (size_t)tok_ * D); X[1] = *(const u32x4*)(Xb + (size_t)tok_ * D + 8); \
                _Pragma("unroll") for (int i = 0; i < 8; ++i) { const unsigned e = IL[(k_) * 128 + 64 * (hf_) + 8 * i + g8]; R[i] = *(const u32x4*)(Ub + (size_t)e * 128); } } while (0)
#define U_COMPUTE(R, X, k_, hf_) do { f32x2 xf[8]; \
                _Pragma("unroll") for (int q = 0; q < 4; ++q) { xf[q] = (f32x2){bf_lo(X[0][q]), bf_hi(X[0][q])}; xf[4 + q] = (f32x2){bf_lo(X[1][q]), bf_hi(X[1][q])}; } \
                float ra = 0.f; \
                _Pragma("unroll") for (int i = 0; i < 8; ++i) { f32x2 acc = {0.f, 0.f}; \
                    _Pragma("unroll") for (int q = 0; q < 4; ++q) { acc += __builtin_amdgcn_cvt_pk_f32_fp8((int)R[i][q], false) * xf[2 * q]; acc += __builtin_amdgcn_cvt_pk_f32_fp8((int)R[i][q], true) * xf[2 * q + 1]; } \
                    const float pr = red8(acc[0] + acc[1]); ra = (j == i) ? pr : ra; } \
                const float za = __shfl(ra, tsrc, 64); \
                if (c8 == 0) ZL[(k_) * 128 + 64 * (hf_) + lane] = za; else ZL[(k_) * 128 + 64 * (hf_) + lane] += za; } while (0)
            if (ntok > 0) U_ISSUE(rA, xA, 0, 0);
            for (int k = 0; k < ntok; ++k) {
                const int kn = (k + 1 < ntok) ? k + 1 : k;
                U_ISSUE(rB, xB, k, 1);
                U_COMPUTE(rA, xA, k, 0);
                U_ISSUE(rA, xA, kn, 0);
                U_COMPUTE(rB, xB, k, 1);
            }
#undef U_ISSUE
#undef U_COMPUTE
        }
        for (int k = 0; k < ntok; ++k) { const int tok = base + gw + GW * k;
#pragma unroll
            for (int hh = 0; hh < 2; ++hh) { const unsigned e = IL[k * 128 + 64 * hh + lane]; const float wv = WT[(size_t)tok * 128 + 64 * hh + lane];
                ZL[k * 128 + 64 * hh + lane] = gelu_tanh(ZL[k * 128 + 64 * hh + lane] * SU[e]) * wv * SV[e]; } }
        for (int c4 = 0; c4 < 4; ++c4) {
            const unsigned char* Vb = VT + (size_t)c4 * NEXP * 128 + 16 * j;
            const bool hi8 = (lane & 8) != 0;
            u32x4 rA[8], rB[8];
            f32x2 o[16];
#define V_ISSUE(R, k_, hf_) do { _Pragma("unroll") for (int i = 0; i < 8; ++i) { const unsigned e = IL[(k_) * 128 + 64 * (hf_) + 8 * i + g8]; R[i] = *(const u32x4*)(Vb + (size_t)e * 128); } } while (0)
#define V_ACC(R, k_, hf_) do { float av[8]; \
                _Pragma("unroll") for (int i = 0; i < 8; ++i) av[i] = ZL[(k_) * 128 + 64 * (hf_) + 8 * i + g8]; \
                _Pragma("unroll") for (int i = 0; i < 8; ++i) { const f32x2 a2 = {av[i], av[i]}; \
                    _Pragma("unroll") for (int q = 0; q < 4; ++q) { \
                        o[4 * q] += a2 * __builtin_amdgcn_cvt_scalef32_pk_f32_fp4(R[i][q], 1.0f, 0); o[4 * q + 1] += a2 * __builtin_amdgcn_cvt_scalef32_pk_f32_fp4(R[i][q], 1.0f, 1); \
                        o[4 * q + 2] += a2 * __builtin_amdgcn_cvt_scalef32_pk_f32_fp4(R[i][q], 1.0f, 2); o[4 * q + 3] += a2 * __builtin_amdgcn_cvt_scalef32_pk_f32_fp4(R[i][q], 1.0f, 3); } } } while (0)
#define V_FINISH(k_) do { const int tok_ = base + gw + GW * (k_); \
                f32x2 q8[8]; \
                _Pragma("unroll") for (int m = 0; m < 8; ++m) { \
                    const auto s0 = __builtin_amdgcn_permlane32_swap(__float_as_uint(o[m][0]), __float_as_uint(o[m + 8][0]), false, false); \
                    const auto s1 = __builtin_amdgcn_permlane32_swap(__float_as_uint(o[m][1]), __float_as_uint(o[m + 8][1]), false, false); \
                    q8[m] = (f32x2){__uint_as_float(s0[0]) + __uint_as_float(s0[1]), __uint_as_float(s1[0]) + __uint_as_float(s1[1])}; } \
                f32x2 q4[4]; \
                _Pragma("unroll") for (int m = 0; m < 4; ++m) { \
                    const auto s0 = __builtin_amdgcn_permlane16_swap(__float_as_uint(q8[m][0]), __float_as_uint(q8[m + 4][0]), false, false); \
                    const auto s1 = __builtin_amdgcn_permlane16_swap(__float_as_uint(q8[m][1]), __float_as_uint(q8[m + 4][1]), false, false); \
                    q4[m] = (f32x2){__uint_as_float(s0[0]) + __uint_as_float(s0[1]), __uint_as_float(s1[0]) + __uint_as_float(s1[1])}; } \
                float fo[4]; \
                _Pragma("unroll") for (int m = 0; m < 2; ++m) { \
                    const float k0 = hi8 ? q4[m + 2][0] : q4[m][0], k1 = hi8 ? q4[m + 2][1] : q4[m][1], t0 = hi8 ? q4[m][0] : q4[m + 2][0], t1 = hi8 ? q4[m][1] : q4[m + 2][1]; \
                    fo[2 * m] = k0 + dpp_mov<0x128>(t0); fo[2 * m + 1] = k1 + dpp_mov<0x128>(t1); } \
                u32x2 w_; w_.x = pk_bf16(fo[0], fo[1]); w_.y = pk_bf16(fo[2], fo[3]); \
                *(u32x2*)(FFN + (size_t)tok_ * D + 256 * c4 + 32 * j + 4 * g8) = w_; } while (0)
            if (ntok > 0) V_ISSUE(rA, 0, 0);
            for (int k = 0; k < ntok; ++k) {
                V_ISSUE(rB, k, 1);
#pragma unroll
                for (int q = 0; q < 16; ++q) o[q] = (f32x2){0.f, 0.f};
                V_ACC(rA, k, 0);
                V_ISSUE(rA, ((k + 1 < ntok) ? k + 1 : k), 0);
                V_ACC(rB, k, 1);
                V_FINISH(k);
            }
#undef V_ISSUE
#undef V_ACC
#undef V_FINISH
        }
        asm volatile("s_waitcnt vmcnt(0)" ::: "memory");
        for (int k = 0; k < ntok; ++k) { const int row = base + gw + GW * k;
            float* xp = XS + (size_t)row * D + 16 * lane; const int mb = mod_batch(row); const float* m = MOD + (size_t)mb * 6144 + 16 * lane;
            const u32x4 fa = *(const u32x4*)(FFN + (size_t)row * D + 16 * lane), fb = *(const u32x4*)(FFN + (size_t)row * D + 16 * lane + 8);
            float o[16];
#pragma unroll
            for (int q = 0; q < 4; ++q) { o[2 * q] = bf_lo(fa[q]); o[2 * q + 1] = bf_hi(fa[q]); o[8 + 2 * q] = bf_lo(fb[q]); o[9 + 2 * q] = bf_hi(fb[q]); }
            float y[16]; float s = 0.f;
#pragma unroll
            for (int qd = 0; qd < 4; ++qd) { const f32x4 x1 = *(const f32x4*)(xp + 4 * qd), g2 = *(const f32x4*)(m + 5 * 1024 + 4 * qd);
#pragma unroll
                for (int e = 0; e < 4; ++e) { y[4 * qd + e] = DN_ALPHA * x1[e] + g2[e] * o[4 * qd + e]; s += y[4 * qd + e]; } }
            const float mean = wave_sum(s) * (1.0f / 1024.0f);
            float q = 0.f;
#pragma unroll
            for (int e = 0; e < 16; ++e) { const float d = y[e] - mean; q += d * d; }
            const float rstd = rsqrtf(wave_sum(q) * (1.0f / 1024.0f) + LN_EPS);
            const float* mn = (const float*)(ws + WS_MOD) + (size_t)(L + 1 < DEPTH ? L + 1 : L) * 17 * 6144 + (size_t)mb * 6144 + 16 * lane;
#pragma unroll
            for (int qd = 0; qd < 4; ++qd) { const int col = 16 * lane + 4 * qd;
                const f32x4 gg = *(const f32x4*)(lg + col), bb = *(const f32x4*)(lb + col); f32x4 x2;
#pragma unroll
                for (int e = 0; e < 4; ++e) x2[e] = (y[4 * qd + e] - mean) * rstd * gg[e] + bb[e];
                if (L == DEPTH - 1) { *(f32x4*)(p.out + (size_t)row * D + col) = x2; }
                else { *(f32x4*)(xp + 4 * qd) = x2;
                    const f32x4 h = x2 * (*(const f32x4*)(mn + 1024 + 4 * qd) + 1.0f) + *(const f32x4*)(mn + 4 * qd);
                    u32x2 w; w.x = pk_bf16(h[0], h[1]); w.y = pk_bf16(h[2], h[3]);
                    *(u32x2*)(H1 + (size_t)row * D + col) = w; } }
        }
    }
}

DI float logsig_fast(float z) { return fminf(z, 0.f) - __logf(1.0f + __expf(-fabsf(z))); }
DI void phase_gla_prep(const Ctx& c, int j) {
    const Params& p = *c.p; unsigned char* ws = c.ws; const int tid = c.tid;
    const bf16_t* QG = (const bf16_t*)(ws + WS_R1); const bf16_t* KG = (const bf16_t*)(ws + WS_R1 + SZ_T512); const bf16_t* VG = (const bf16_t*)(ws + WS_R1 + 2 * SZ_T512);
    const float* GL = (const float*)(ws + WS_GL); float* DEC = (float*)(ws + WS_DEC); bf16_t* VTt = (bf16_t*)(ws + WS_VTT);
    bf16_t* Qt = (bf16_t*)c.smem;
    bf16_t* Kt = Qt + 64 * 512;
    float* gl = (float*)(c.smem + 131072);
    for (int ch = c.bid; ch < T / 64; ch += c.G) {
        const int r0 = ch * 64;
        __syncthreads();
#pragma unroll 4
        for (int it = 0; it < 8; ++it) { const int idx = it * 512 + tid, row = idx >> 6, c8 = (idx & 63) * 8;
            *(u32x4*)(Qt + row * 512 + c8) = *(const u32x4*)(QG + (size_t)(r0 + row) * 512 + c8);
            *(u32x4*)(Kt + row * 512 + c8) = *(const u32x4*)(KG + (size_t)(r0 + row) * 512 + c8); }
        ((f32x4*)gl)[tid] = ((const f32x4*)(GL + (size_t)r0 * 32))[tid];
        __syncthreads();
#pragma unroll
        for (int dir = 0; dir < 2; ++dir) {
            float wg[16];
#pragma unroll
            for (int r = 0; r < 16; ++r) wg[r] = p.in[15][((size_t)(j * 2 + dir) * 16 + r) * 512 + tid];
            const float bias = p.in[16][(size_t)(j * 2 + dir) * 512 + tid];
            bf16_t* QIN = (bf16_t*)(ws + WS_R2) + (size_t)dir * T * 512; bf16_t* KIN = (bf16_t*)(ws + WS_R2 + SZ_T1K) + (size_t)dir * T * 512;
            bf16_t* KINt = (bf16_t*)(ws + WS_R2 + 2 * SZ_T1K) + (((size_t)dir * (T / 64) + ch) * 512 + tid) * 64;
            float cum = 0.f;
            for (int blk = 0; blk < 8; ++blk) { const int jb = dir ? 56 - 8 * blk : 8 * blk; float gs[8];
#pragma unroll
                for (int e = 0; e < 8; ++e) { const int i = jb + e; float z = bias; const f32x4* gp = (const f32x4*)(gl + i * 32 + dir * 16);
#pragma unroll
                    for (int r4 = 0; r4 < 4; ++r4) { const f32x4 gv = gp[r4]; z += gv[0] * wg[4 * r4] + gv[1] * wg[4 * r4 + 1] + gv[2] * wg[4 * r4 + 2] + gv[3] * wg[4 * r4 + 3]; }
                    gs[e] = logsig_fast(z) * (1.0f / 16.0f); }
                float kiv[8];
#pragma unroll
                for (int e = 0; e < 8; ++e) { const int pos = dir ? 7 - e : e, i = jb + pos;
                    cum += gs[pos];
                    const float qv = bf1(Qt[i * 512 + tid]), kv = bf1(Kt[i * 512 + tid]);
                    const size_t o = (size_t)(r0 + i) * 512 + tid;
                    const float ki = kv * __expf(-cum);
                    QIN[o] = f2bf(qv * __expf(cum)); KIN[o] = f2bf(ki); kiv[pos] = ki; }
                u32x4 w; w.x = pk_bf16(kiv[0], kiv[1]); w.y = pk_bf16(kiv[2], kiv[3]); w.z = pk_bf16(kiv[4], kiv[5]); w.w = pk_bf16(kiv[6], kiv[7]);
                *(u32x4*)(KINt + jb) = w; }
            DEC[((size_t)dir * (T / 64) + ch) * 512 + tid] = __expf(cum);
        }
        __syncthreads();
        bf16_t* Vl = Qt;
#pragma unroll 8
        for (int it = 0; it < 16; ++it) { const int idx = it * 512 + tid, row = idx >> 7, c8 = (idx & 127) * 8;
            *(u32x4*)(Vl + row * 1024 + c8) = *(const u32x4*)(VG + (size_t)(r0 + row) * 1024 + c8); }
        __syncthreads();
#pragma unroll
        for (int cc = 0; cc < 2; ++cc) { const int e = tid + 512 * cc; bf16_t* vp = VTt + ((size_t)ch * 1024 + e) * 64;
            for (int jb = 0; jb < 64; jb += 8) { unsigned short x[8];
#pragma unroll
                for (int t = 0; t < 8; ++t) x[t] = Vl[(jb + t) * 1024 + e];
                u32x4 w; w.x = (unsigned)x[0] | ((unsigned)x[1] << 16); w.y = (unsigned)x[2] | ((unsigned)x[3] << 16); w.z = (unsigned)x[4] | ((unsigned)x[5] << 16); w.w = (unsigned)x[6] | ((unsigned)x[7] << 16);
                *(u32x4*)(vp + jb) = w; } }
    }
}

DI void phase_gla_scan(const Ctx& c) {
    unsigned char* ws = c.ws; const int tid = c.tid, lane = c.lane, w = c.wave, g = lane >> 4, cc = lane & 15;
    const bf16_t* VTt = (const bf16_t*)(ws + WS_VTT); const float* DEC = (const float*)(ws + WS_DEC); bf16_t* O = (bf16_t*)(ws + WS_H1);
    constexpr int LDQ = 136, LDJ = 72;
    bf16_t* Qs = (bf16_t*)c.smem;
    bf16_t* Ks = Qs + 64 * LDQ;
    bf16_t* KEt = Ks + 64 * LDQ;
    bf16_t* Vt = KEt + 128 * LDJ;
    bf16_t* At = Vt + 64 * LDJ;
    bf16_t* St = At + 64 * LDJ;
    bf16_t* Ot = St + 64 * LDQ;
    float* dec = (float*)(Ot + 64 * LDJ);
    const int qtok0 = tid >> 4, qd8 = (tid & 15) * 8;
    const int ked0 = tid >> 3, kej8 = (tid & 7) * 8;
    for (int u = c.bid; u < NB * 4 * 4; u += c.G) {
        const int b = u >> 4, h = (u >> 2) & 3, es = u & 3;
        for (int dir = 0; dir < 2; ++dir) {
            const bf16_t* QIN = (const bf16_t*)(ws + WS_R2) + (size_t)dir * T * 512; const bf16_t* KIN = (const bf16_t*)(ws + WS_R2 + SZ_T1K) + (size_t)dir * T * 512;
            const bf16_t* KENDt = (const bf16_t*)(ws + WS_R2 + 2 * SZ_T1K) + (size_t)dir * (T / 64) * 512 * 64;
            f32x4 accS[4];
#pragma unroll
            for (int et = 0; et < 4; ++et) accS[et] = (f32x4){0.f, 0.f, 0.f, 0.f};
            __syncthreads();
            for (int i = tid; i < 64 * LDQ / 2; i += NTHR) ((unsigned*)St)[i] = 0u;
            u32x4 pq[2], pk[2], pke[2], pv, po; float pdec = 0.f;
            po = (u32x4){0u, 0u, 0u, 0u};
#define GLA_R0(cs_) (dir == 0 ? ((cs_) < 4 ? TL + b * CTXL + 64 * (cs_) : b * SEQ + 64 * ((cs_) - 4)) : ((cs_) < 4 ? TL + b * CTXL + 64 * (3 - (cs_)) : b * SEQ + 64 * (35 - (cs_))))
#define GLA_LOAD(cs_) do { const int r0_ = GLA_R0(cs_); const int chunk_ = r0_ >> 6; \
                _Pragma("unroll") for (int it = 0; it < 2; ++it) { const size_t go = (size_t)(r0_ + qtok0 + 32 * it) * 512 + h * 128 + qd8; pq[it] = *(const u32x4*)(QIN + go); pk[it] = *(const u32x4*)(KIN + go); \
                    pke[it] = *(const u32x4*)(KENDt + ((size_t)chunk_ * 512 + h * 128 + ked0 + 64 * it) * 64 + kej8); } \
                pv = *(const u32x4*)(VTt + ((size_t)chunk_ * 1024 + h * 256 + es * 64 + ked0) * 64 + kej8); \
                if (dir) po = *(const u32x4*)(O + (size_t)(r0_ + ked0) * 1024 + h * 256 + es * 64 + kej8); \
                if (tid < 128) pdec = DEC[((size_t)dir * (T / 64) + chunk_) * 512 + h * 128 + tid]; } while (0)
            GLA_LOAD(0);
            for (int cs = 0; cs < 36; ++cs) {
                const int r0 = GLA_R0(cs);
#pragma unroll
                for (int it = 0; it < 2; ++it) { *(u32x4*)(Qs + (qtok0 + 32 * it) * LDQ + qd8) = pq[it]; *(u32x4*)(Ks + (qtok0 + 32 * it) * LDQ + qd8) = pk[it]; *(u32x4*)(KEt + (ked0 + 64 * it) * LDJ + kej8) = pke[it]; }
                *(u32x4*)(Vt + ked0 * LDJ + kej8) = pv;
                *(u32x4*)(Ot + ked0 * LDJ + kej8) = po;
                if (tid < 128) dec[tid] = pdec;
                __syncthreads();
                if (cs + 1 < 36) GLA_LOAD(cs + 1);
                { const int it = w >> 1;
#pragma unroll
                  for (int jj = 0; jj < 2; ++jj) { const int jt = 2 * (w & 1) + jj; f32x4 a = {0.f, 0.f, 0.f, 0.f};
#pragma unroll
                      for (int ks = 0; ks < 4; ++ks) a = mfma16(frag_ld(Qs, LDQ, 16 * it, 32 * ks, lane), frag_ld(Ks, LDQ, 16 * jt, 32 * ks, lane), a);
                      const int jcol = 16 * jt + cc;
#pragma unroll
                      for (int r = 0; r < 4; ++r) { const int i = 16 * it + 4 * g + r; const bool keep = dir ? (jcol >= i) : (jcol <= i);
                          At[i * LDJ + jcol] = f2bf(keep ? a[r] : 0.f); } } }
                __syncthreads();
                { const int it = w >> 1;
#pragma unroll
                  for (int ee = 0; ee < 2; ++ee) { const int et = 2 * (w & 1) + ee; f32x4 a = {0.f, 0.f, 0.f, 0.f};
#pragma unroll
                      for (int ks = 0; ks < 2; ++ks) a = mfma16(frag_ld(At, LDJ, 16 * it, 32 * ks, lane), frag_ld(Vt, LDJ, 16 * et, 32 * ks, lane), a);
#pragma unroll
                      for (int ks = 0; ks < 4; ++ks) a = mfma16(frag_ld(Qs, LDQ, 16 * it, 32 * ks, lane), frag_ld(St, LDQ, 16 * et, 32 * ks, lane), a);
#pragma unroll
                      for (int r = 0; r < 4; ++r) { bf16_t* op = Ot + (16 * it + 4 * g + r) * LDJ + 16 * et + cc; *op = f2bf(a[r] + bf1(*op)); } } }
#pragma unroll
                for (int et = 0; et < 4; ++et) {
#pragma unroll
                    for (int ks = 0; ks < 2; ++ks) accS[et] = mfma16(frag_ld(KEt, LDJ, 16 * w, 32 * ks, lane), frag_ld(Vt, LDJ, 16 * et, 32 * ks, lane), accS[et]);
#pragma unroll
                    for (int r = 0; r < 4; ++r) accS[et][r] *= dec[16 * w + 4 * g + r];
                }
                __syncthreads();
#pragma unroll
                for (int et = 0; et < 4; ++et) { u32x2 sv; sv.x = pk_bf16(accS[et][0], accS[et][1]); sv.y = pk_bf16(accS[et][2], accS[et][3]);
                    *(u32x2*)(St + (16 * et + cc) * LDQ + 16 * w + 4 * g) = sv; }
                *(u32x4*)(O + (size_t)(r0 + ked0) * 1024 + h * 256 + es * 64 + kej8) = *(const u32x4*)(Ot + ked0 * LDJ + kej8);
            }
#undef GLA_LOAD
#undef GLA_R0
        }
    }
}

DI void phase_gla_readout(const Ctx& c, int j) {
    const Params& p = *c.p; unsigned char* ws = c.ws;
    const bf16_t* O = (const bf16_t*)(ws + WS_H1); const bf16_t* RG = (const bf16_t*)(ws + WS_R1 + 2 * SZ_T512 + SZ_T1K); bf16_t* Y = (bf16_t*)(ws + WS_R2);
    const float* gn = p.in[17] + (size_t)j * 1024;
    for (int row = c.bid * NWAVE + c.wave; row < T; row += c.G * NWAVE) {
#pragma unroll
        for (int hd = 0; hd < 4; ++hd) { const int col = 4 * c.lane + 256 * hd;
            const u32x2 ov = *(const u32x2*)(O + (size_t)row * D + col), rv = *(const u32x2*)(RG + (size_t)row * D + col);
            const float x0 = bf_lo(ov.x), x1 = bf_hi(ov.x), x2 = bf_lo(ov.y), x3 = bf_hi(ov.y);
            const float mean = wave_sum((x0 + x1) + (x2 + x3)) * (1.0f / 256.0f);
            const float d0 = x0 - mean, d1 = x1 - mean, d2 = x2 - mean, d3 = x3 - mean;
            const float rstd = rsqrtf(wave_sum((d0 * d0 + d1 * d1) + (d2 * d2 + d3 * d3)) * (1.0f / 256.0f) + LN_EPS);
            const f32x4 gg = *(const f32x4*)(gn + col);
            const float r0 = bf_lo(rv.x), r1 = bf_hi(rv.x), r2 = bf_lo(rv.y), r3 = bf_hi(rv.y);
            u32x2 o; o.x = pk_bf16(d0 * rstd * gg[0] * silu_f(r0), d1 * rstd * gg[1] * silu_f(r1)); o.y = pk_bf16(d2 * rstd * gg[2] * silu_f(r2), d3 * rstd * gg[3] * silu_f(r3));
            *(u32x2*)(Y + (size_t)row * D + col) = o; }
    }
}

constexpr int N_PHASES = 2 + 2 * 8 + 2 * 9;

__global__ void __launch_bounds__(NTHR, 2) mega_fwd(Params p) {
    extern __shared__ __attribute__((aligned(16))) unsigned char smem[];
    cg::grid_group grid = cg::this_grid();
    Ctx c; c.p = &p; c.ws = p.ws; c.smem = smem; c.tid = threadIdx.x; c.lane = c.tid & 63; c.wave = __builtin_amdgcn_readfirstlane(c.tid >> 6); c.G = gridDim.x; c.bid = blockIdx.x;
    unsigned char* ws = p.ws;
    unsigned* ctr = (unsigned*)(ws + WS_CTL);
    unsigned target = 0;
    const int lo = p.ph_lo, hi = p.ph_hi;
    int ph = 0;
#ifndef PH_ONLY
#define PH_ONLY -1
#endif
#ifndef DUP_MASK
#define DUP_MASK 0
#endif
#define RUN1(...) { { int t_ = threadIdx.x; asm volatile("" : "+v"(t_)); c.tid = t_; c.lane = t_ & 63; c.wave = __builtin_amdgcn_readfirstlane(t_ >> 6); { size_t z_ = 0; asm volatile("" : "+s"(z_)); ws = p.ws + z_; } c.ws = ws; } __VA_ARGS__; }
#define RUN(id, ...) do { if ((PH_ONLY < 0 || PH_ONLY == (id)) && ph >= lo && ph < hi) { \
        RUN1(__VA_ARGS__) \
        if ((DUP_MASK >> (id)) & 1) { grid_barrier(ctr, target); RUN1(__VA_ARGS__) } \
        if (ph + 1 < hi) { if (ph == 0) grid.sync(); else grid_barrier(ctr, target); } } ++ph; } while (0)
    LAS unsigned char* lds = (LAS unsigned char*)smem;
    const float* MOD = (const float*)(ws + WS_MOD);

    RUN(0, phase_prologue(c));
    RUN(1, phase_mod0(c));
    for (int L = 0; L < DEPTH; ++L) {
        const int j = L >> 1;
        if ((L & 1) == 0) {
            RUN(2, { pg8::Gemm g{(const bf16_t*)(ws + WS_H1), (const bf16_t*)(ws + WS_WAIN) + (size_t)j * 2048 * 1024, T, 2048, 1024}; pg8::StaticOrder S; S.init(T, 2048, c.G, c.bid);
                  pg8::EpiBf16<1> E{(bf16_t*)(ws + WS_R1), 2048}; pg8::gemm_phase(lds, g, S, E, c.tid); });
            RUN(3, phase_vstats(c));
            RUN(4, phase_spatial(c, j));
        } else {
            RUN(5, { pg8::Gemm g{(const bf16_t*)(ws + WS_H1), (const bf16_t*)(ws + WS_WBIN) + (size_t)j * WBIN_N * 1024, T, WBIN_N, 1024}; pg8::StaticOrder S; S.init(T, WBIN_N, c.G, c.bid);
                  pg8::EpiGlaProj E{(bf16_t*)(ws + WS_R1), (bf16_t*)(ws + WS_R1 + SZ_T512), (bf16_t*)(ws + WS_R1 + 2 * SZ_T512), (bf16_t*)(ws + WS_R1 + 2 * SZ_T512 + SZ_T1K), (float*)(ws + WS_GL)};
                  pg8::gemm_phase(lds, g, S, E, c.tid); });
            RUN(6, phase_gla_prep(c, j));
            RUN(7, phase_gla_scan(c));
            RUN(8, phase_gla_readout(c, j));
        }
        RUN(9, { const bf16_t* W = (L & 1) ? (const bf16_t*)(ws + WS_WBOUT) + (size_t)j * 1024 * 1024 : (const bf16_t*)(ws + WS_WAOUT) + (size_t)j * 1024 * 1024;
              pg8::Gemm g{(const bf16_t*)(ws + WS_R2), W, T, 1024, 1024}; pg8::StaticOrder S; S.init(T, 1024, c.G, c.bid);
              pg8::EpiRes E{L == 0 ? p.in[0] : (const float*)(ws + WS_XS), L == 0 ? p.in[2] : (const float*)(ws + WS_XS) + (size_t)TL * D, (float*)(ws + WS_XS), MOD + (size_t)L * 17 * 6144, 2};
              pg8::gemm_phase(lds, g, S, E, c.tid); });
        RUN(10, phase_ln1(c, L));
        RUN(11, { pg8::Gemm g{(const bf16_t*)(ws + WS_R2 + SZ_T1K), (const bf16_t*)(ws + WS_WQ) + (size_t)L * 1024 * 1024, T, 1024, 1024}; pg8::StaticOrder S; S.init(T, 1024, c.G, c.bid);
              pg8::EpiBf16<0> E{(bf16_t*)(ws + WS_R1), 1024}; pg8::gemm_phase(lds, g, S, E, c.tid); });
        RUN(12, phase_route(c, L));
        RUN(13, phase_experts(c, L));
    }
#undef RUN
}

extern "C" void kernel_launch(void* const* d_in, const int* in_sizes, int n_in, void* d_out, int out_size, void* d_ws, size_t ws_size, hipStream_t stream) {
    static int grid = 0;
    if (grid == 0) {
        if (n_in != 23 || out_size != TL * D || ws_size < WS_END) { fprintf(stderr, "kernel_launch: unexpected shapes: n_in %d out %d ws %zu (need %zu)\n", n_in, out_size, ws_size, (size_t)WS_END); grid = -1; return; }
        int dev = 0, cus = 0, per_cu = 0;
        if (hipGetDevice(&dev) != hipSuccess || hipDeviceGetAttribute(&cus, hipDeviceAttributeMultiprocessorCount, dev) != hipSuccess) { fprintf(stderr, "kernel_launch: device query failed\n"); grid = -1; return; }
        if (hipFuncSetAttribute((const void*)mega_fwd, hipFuncAttributeMaxDynamicSharedMemorySize, LDS_BYTES) != hipSuccess) { fprintf(stderr, "kernel_launch: hipFuncSetAttribute failed\n"); grid = -1; return; }
        if (hipOccupancyMaxActiveBlocksPerMultiprocessor(&per_cu, (const void*)mega_fwd, NTHR, LDS_BYTES) != hipSuccess || per_cu < 1) { fprintf(stderr, "kernel_launch: occupancy query says %d blocks per CU\n", per_cu); grid = -1; return; }
        grid = cus;
    }
    if (grid < 0) return;
    (void)hipMemsetAsync((char*)d_ws + WS_CTL, 0, 65536, stream);
    Params p{};
    for (int i = 0; i < 23; ++i) p.in[i] = (const float*)d_in[i];
    p.out = (float*)d_out; p.ws = (unsigned char*)d_ws; p.ph_lo = 0; p.ph_hi = N_PHASES;
    void* args[] = {&p};
    const hipError_t e = hipLaunchCooperativeKernel((const void*)mega_fwd, dim3(grid), dim3(NTHR), args, LDS_BYTES, stream);
    if (e != hipSuccess) fprintf(stderr, "kernel_launch: cooperative launch failed: %s (grid %d)\n", hipGetErrorString(e), grid);
}
```

```cpp
#include <hip/hip_runtime.h>
#include <hip/hip_cooperative_groups.h>
#include <cstdio>
#include <cstdint>
namespace cg = cooperative_groups;

#define LAS __attribute__((address_space(3)))
#define DI __device__ __forceinline__
typedef unsigned short bf16_t;
typedef short bf16x8 __attribute__((ext_vector_type(8)));
typedef float f32x4 __attribute__((ext_vector_type(4)));
typedef float f32x2 __attribute__((ext_vector_type(2)));
typedef unsigned u32x4 __attribute__((ext_vector_type(4)));
typedef unsigned u32x2 __attribute__((ext_vector_type(2)));
typedef __bf16 bf16v2 __attribute__((ext_vector_type(2)));

constexpr int D = 1024, NB = 16, SEQ = 2048, CTXL = 256, DEPTH = 4;
constexpr int TL = NB * SEQ, TC = NB * CTXL, T = TL + TC;
constexpr int NEXP = 16384;
constexpr float LN_EPS = 1e-5f;
constexpr float DN_ALPHA = 1.6817928305074290f;
constexpr int NTHR = 512, NWAVE = 8;
constexpr int LDS_BYTES = 140 * 1024;
constexpr int WBIN_N = 3328;

constexpr size_t al256(size_t x) { return (x + 255) & ~(size_t)255; }
constexpr size_t WS_CTL = 0;
constexpr size_t WS_MOD = 65536;
constexpr size_t WS_STATS = al256(WS_MOD + (size_t)4 * 17 * 6144 * 4);
constexpr size_t WS_GL = al256(WS_STATS + (size_t)T * 2 * 4);
constexpr size_t WS_DEC = al256(WS_GL + (size_t)T * 32 * 4);
constexpr size_t WS_WSB = al256(WS_DEC + (size_t)2 * 576 * 512 * 4);
constexpr size_t WS_WAIN = al256(WS_WSB + (size_t)2 * 8 * 128 * 128 * 2);
constexpr size_t WS_WAOUT = WS_WAIN + (size_t)2 * 2048 * 1024 * 2;
constexpr size_t WS_WBIN = WS_WAOUT + (size_t)2 * 1024 * 1024 * 2;
constexpr size_t WS_WBOUT = WS_WBIN + (size_t)2 * WBIN_N * 1024 * 2;
constexpr size_t WS_WQ = WS_WBOUT + (size_t)2 * 1024 * 1024 * 2;
constexpr size_t WS_UT = WS_WQ + (size_t)4 * 1024 * 1024 * 2;
constexpr size_t WS_VT = WS_UT + (size_t)4 * NEXP * 1024;
constexpr size_t WS_SU = WS_VT + (size_t)4 * NEXP * 1024;
constexpr size_t WS_SV = WS_SU + (size_t)4 * NEXP * 4;
constexpr size_t WS_XS = WS_SV + (size_t)4 * NEXP * 4;
constexpr size_t WS_R1 = WS_XS + (size_t)T * 1024 * 4;
constexpr size_t WS_R2 = WS_R1 + (size_t)T * 3072 * 2;
constexpr size_t WS_H1 = WS_R2 + (size_t)T * 3072 * 2;
constexpr size_t WS_VTT = WS_H1 + (size_t)T * 1024 * 2;
constexpr size_t WS_END = WS_VTT + (size_t)T * 1024 * 2;
constexpr size_t SZ_T1K = (size_t)T * 1024 * 2;
constexpr size_t SZ_T512 = (size_t)T * 512 * 2;

struct Params { const float* in[23]; float* out; unsigned char* ws; int ph_lo, ph_hi; };

DI unsigned pk_bf16(float lo, float hi) { f32x2 v = {lo, hi}; return __builtin_bit_cast(unsigned, __builtin_convertvector(v, bf16v2)); }
DI float bf_lo(unsigned w) { return __uint_as_float(w << 16); }
DI float bf_hi(unsigned w) { return __uint_as_float(w & 0xffff0000u); }
DI float bf1(bf16_t b) { return __uint_as_float(((unsigned)b) << 16); }
DI bf16_t f2bf(float f) { return (bf16_t)(pk_bf16(f, 0.f) & 0xffffu); }
DI float gelu_tanh(float x) { const float u = 0.7978845608028654f * (x + 0.044715f * x * x * x); return __fdividef(x, 1.0f + __expf(-2.0f * u)); }
DI float silu_f(float x) { return __fdividef(x, 1.0f + __expf(-x)); }
DI float logsig_f(float z) { return fminf(z, 0.f) - log1pf(expf(-fabsf(z))); }
DI float wave_sum(float v) {
#pragma unroll
    for (int o = 32; o > 0; o >>= 1) v += __shfl_xor(v, o, 64);
    return v;
}
DI float wave_max(float v) {
#pragma unroll
    for (int o = 32; o > 0; o >>= 1) v = fmaxf(v, __shfl_xor(v, o, 64));
    return v;
}
template <int CTRL> DI float dpp_mov(float x) { return __builtin_bit_cast(float, __builtin_amdgcn_mov_dpp(__builtin_bit_cast(int, x), CTRL, 0xf, 0xf, true)); }
DI float reduce4(float p0, float p1, float p2, float p3) {
    const auto a = __builtin_amdgcn_permlane32_swap(__float_as_uint(p0), __float_as_uint(p2), false, false); const float q0 = __uint_as_float(a[0]) + __uint_as_float(a[1]);
    const auto b = __builtin_amdgcn_permlane32_swap(__float_as_uint(p1), __float_as_uint(p3), false, false); const float q1 = __uint_as_float(b[0]) + __uint_as_float(b[1]);
    const auto c = __builtin_amdgcn_permlane16_swap(__float_as_uint(q0), __float_as_uint(q1), false, false); float s = __uint_as_float(c[0]) + __uint_as_float(c[1]);
    s += dpp_mov<0x128>(s); s += dpp_mov<0x124>(s); s += dpp_mov<0x122>(s); s += dpp_mov<0x121>(s);
    return s;
}
DI float dot2bf(unsigned a, unsigned b, float c) { return __builtin_amdgcn_fdot2_f32_bf16(__builtin_bit_cast(bf16v2, a), __builtin_bit_cast(bf16v2, b), c, false); }
DI f32x4 mfma16(bf16x8 a, bf16x8 b, f32x4 c) { return __builtin_amdgcn_mfma_f32_16x16x32_bf16(a, b, c, 0, 0, 0); }
DI bf16x8 frag_ld(const bf16_t* X, int ld, int row0, int k0, int lane) { return *(const bf16x8*)(X + (size_t)(row0 + (lane & 15)) * ld + k0 + 8 * (lane >> 4)); }
DI int mod_batch(int row) { return row < TL ? (row >> 11) : NB; }

#define XB_TMO      128
#define XB_XCNT(j)  (256  + 64 * (j))
#define XB_XSUB(j)  (1280 + 64 * (j))
#define XB_XGEN(j)  (2304 + 64 * (j))
#define XB_TOP      3328
#define XB_TOPGEN   3392
#define XCD_BAR_WORDS 3456
#define XB_SPIN_CAP (1u << 22)
DI unsigned xb_ld(unsigned* p)              { return __hip_atomic_load(p, __ATOMIC_RELAXED, __HIP_MEMORY_SCOPE_AGENT); }
DI unsigned xb_add(unsigned* p, unsigned v) { return __hip_atomic_fetch_add(p, v, __ATOMIC_RELAXED, __HIP_MEMORY_SCOPE_AGENT); }
DI unsigned xb_xcc_id() { return (unsigned)__builtin_amdgcn_s_getreg((3 << 11) | 20) & 0xFu; }
#define XB_SPIN(cond, bar) do { unsigned _sp = 0; while (cond) { __builtin_amdgcn_s_sleep(1); \
    if ((++_sp & 255u) == 0u) { if (xb_ld(&(bar)[XB_TMO])) break; if (_sp > XB_SPIN_CAP) { atomicAdd(&(bar)[XB_TMO], 1u); break; } } } } while (0)
struct XcdBarrier { unsigned* bar; unsigned x; volatile LAS unsigned* st; };
DI XcdBarrier xcd_barrier_post(unsigned* bar, volatile LAS unsigned* st) {
    XcdBarrier b; b.bar = bar; b.x = xb_xcc_id(); b.st = st;
    if (threadIdx.x == 0) (void)xb_add(&bar[XB_XCNT(b.x)], 1u);
    return b;
}
DI void xcd_barrier_complete(unsigned* bar, unsigned x, unsigned& nloc, unsigned& nx) {
    const unsigned G = gridDim.x * gridDim.y * gridDim.z;
    unsigned sum, cnt, mine, sp = 0u;
    for (;;) {
        sum = 0u; cnt = 0u; mine = 0u;
#pragma unroll
        for (unsigned j = 0; j < 16; ++j) { const unsigned c = xb_ld(&bar[XB_XCNT(j)]); sum += c; cnt += (c > 0u) ? 1u : 0u; mine = (j == x) ? c : mine; }
        if (sum == G) break;
        __builtin_amdgcn_s_sleep(1);
        if ((++sp & 255u) == 0u) { if (xb_ld(&bar[XB_TMO])) break; if (sp > XB_SPIN_CAP) { atomicAdd(&bar[XB_TMO], 1u); break; } }
    }
    nloc = mine > 0u ? mine : 1u; nx = cnt > 0u ? cnt : 1u;
}
DI void xcd_barrier(const XcdBarrier& b) {
    asm volatile("s_waitcnt vmcnt(0)" ::: "memory");
    __syncthreads();
    if (threadIdx.x == 0) {
        unsigned* bar = b.bar;
        __builtin_amdgcn_s_waitcnt(0);
        unsigned nloc = b.st[0], nx = b.st[1];
        if (nloc == 0u) { xcd_barrier_complete(bar, b.x, nloc, nx); b.st[0] = nloc; b.st[1] = nx; }
        const unsigned old = xb_add(&bar[XB_XSUB(b.x)], 1u);
        const unsigned gen = old / nloc;
        if (old + 1u == (gen + 1u) * nloc) {
            __builtin_amdgcn_fence(__ATOMIC_RELEASE, "agent");
            asm volatile("s_waitcnt vmcnt(0)" ::: "memory");
            const unsigned og = xb_add(&bar[XB_TOP], 1u);
            const unsigned tg = og / nx;
            if (og + 1u == (tg + 1u) * nx) xb_add(&bar[XB_TOPGEN], 1u);
            else XB_SPIN(xb_ld(&bar[XB_TOPGEN]) == tg, bar);
            __builtin_amdgcn_fence(__ATOMIC_ACQUIRE, "agent");
            xb_add(&bar[XB_XGEN(b.x)], 1u);
            asm volatile("s_waitcnt vmcnt(0)" ::: "memory");
        } else {
            XB_SPIN(xb_ld(&bar[XB_XGEN(b.x)]) == gen, bar);
            __builtin_amdgcn_fence(__ATOMIC_ACQUIRE, "agent");
            asm volatile("s_waitcnt vmcnt(0)" ::: "memory");
        }
    }
    __syncthreads();
}

namespace pg8 {
constexpr int BM = 256, BK = 64, HALF = 128, HTB = HALF * BK * 2, STAGE_BYTES = 8 * HTB, NXCD = 8, WGM = 8;
__host__ __device__ __forceinline__ int lds_byte(int r, int c) { const int st = (r >> 4) * 2 + (c >> 5), rr = r & 15, cc = c & 31, ob = rr * 64 + cc * 2; return st * 1024 + (ob ^ (((ob >> 9) & 1) << 5)); }
__host__ __device__ __forceinline__ void stage_rc(int b, int& R, int& C) { const int st = b / 1024, sb = b % 1024, swz = sb ^ (((sb >> 9) & 1) << 5); R = (st >> 1) * 16 + swz / 64; C = (st & 1) * 32 + (swz % 64) / 2; }
__host__ __device__ __forceinline__ int perm32(int rho) { const int n = rho >> 4, i = rho & 15; return 8 * (i >> 2) + 4 * n + (i & 3); }
struct Unit { int pm, pn; };
struct Gemm { const bf16_t* A; const bf16_t* Bt; int M, N, K; };
struct StaticOrder {
    int nM, nN, nwg, G, c;
    __device__ void init(int M, int N, int G_, int c_) { nM = M / BM; nN = N / BM; nwg = nM * nN; G = G_; c = c_; }
    __device__ bool next(int i, Unit& u) const {
        const long L = (long)i * G + c; if (L >= nwg) return false;
        int wgid = (int)L; { const int q = nwg / NXCD, r = nwg % NXCD, xcd = wgid % NXCD, off = wgid / NXCD; wgid = (xcd < r ? xcd * (q + 1) : r * (q + 1) + (xcd - r) * q) + off; }
        const int nig = WGM * nN, gid = wgid / nig, fm = gid * WGM, gsz = (nM - fm) < WGM ? (nM - fm) : WGM;
        u.pm = fm + ((wgid % nig) % gsz); u.pn = (wgid % nig) / gsz; return true;
    }
};

template <class Epi>
__device__ __forceinline__ void gemm_phase(LAS unsigned char* lds, const Gemm g, const StaticOrder& S, const Epi& E, const int tid) {
    const int wid = __builtin_amdgcn_readfirstlane(tid >> 6), lane = tid & 63, wr = wid >> 2, wc = wid & 3, fr = lane & 15, fq = lane >> 4;
    const int K = g.K, nt = K / BK;
    unsigned voffA[2], voffB[2];
#pragma unroll
    for (int i = 0; i < 2; ++i) { int R, C; stage_rc(tid * 16 + i * 8192, R, C); const int Rb = Epi::PERM ? ((R & ~31) + perm32(R & 31)) : R;
        voffA[i] = (unsigned)(R * K + C) * 2u; voffB[i] = (unsigned)(Rb * K + C) * 2u; }
    const size_t kstep = (size_t)(BK * 2);
    const size_t hstep = (size_t)HALF * K * 2;
    const size_t tstep = 2 * hstep;
    const unsigned ldsw = (unsigned)wid * 1024u;
    const int aoff = lds_byte(wr * 64 + fr, fq * 8), boff = lds_byte(wc * 32 + fr, fq * 8);
#define PG8_SA(b, h) (((b) * 2 + (h)) * HTB)
#define PG8_SB(b, h) ((4 + (b) * 2 + (h)) * HTB)
#define PG8_STAGE(bufoff, gbase, voff) do { _Pragma("unroll") for (int _i = 0; _i < 2; ++_i) \
        __builtin_amdgcn_global_load_lds((const unsigned*)((const char*)(gbase) + (voff)[_i]), (LAS unsigned*)(lds + (bufoff) + ldsw + _i * 8192), 16, 0, 0); } while (0)
#define PG8_LDA(dst, b, h) do { _Pragma("unroll") for (int m = 0; m < 4; ++m) _Pragma("unroll") for (int k = 0; k < 2; ++k) dst[m][k] = *(const LAS bf16x8*)(lds + PG8_SA(b, h) + aoff + m * 2048 + k * 1024); } while (0)
#define PG8_LDB(dst, b, h) do { _Pragma("unroll") for (int n = 0; n < 2; ++n) _Pragma("unroll") for (int k = 0; k < 2; ++k) dst[n][k] = *(const LAS bf16x8*)(lds + PG8_SB(b, h) + boff + n * 2048 + k * 1024); } while (0)
#define PG8_MMA(ai, bj, At, Bt) do { __builtin_amdgcn_s_setprio(1); _Pragma("unroll") for (int m = 0; m < 4; ++m) _Pragma("unroll") for (int n = 0; n < 2; ++n) _Pragma("unroll") for (int k = 0; k < 2; ++k) \
        acc[ai][bj][m][n] = __builtin_amdgcn_mfma_f32_16x16x32_bf16(Bt[n][k], At[m][k], acc[ai][bj][m][n], 0, 0, 0); __builtin_amdgcn_s_setprio(0); } while (0)
#define PG8_WAIT_V(n) asm volatile("s_waitcnt vmcnt(" #n ")" ::: "memory")
#define PG8_WAIT_L(n) asm volatile("s_waitcnt lgkmcnt(" #n ")" ::: "memory")
#define PG8_BAR __builtin_amdgcn_s_barrier()
#define PG8_SCHED __builtin_amdgcn_sched_barrier(0)
    Unit cur, nxt; int ui = 0;
    if (!S.next(0, cur)) return;
    f32x4 acc[2][2][4][2];
#pragma unroll
    for (int a = 0; a < 2; ++a)
#pragma unroll
        for (int b = 0; b < 2; ++b)
#pragma unroll
            for (int m = 0; m < 4; ++m)
#pragma unroll
                for (int n = 0; n < 2; ++n) acc[a][b][m][n] = (f32x4){0.f, 0.f, 0.f, 0.f};
    bf16x8 At[4][2], B0[2][2], B1[2][2];
    const char* cA = (const char*)g.A + (size_t)cur.pm * tstep; const char* cB = (const char*)g.Bt + (size_t)cur.pn * tstep;
    PG8_STAGE(PG8_SB(0, 0), cB, voffB); PG8_STAGE(PG8_SA(0, 0), cA, voffA); PG8_STAGE(PG8_SB(0, 1), cB + hstep, voffB); PG8_STAGE(PG8_SA(0, 1), cA + hstep, voffA);
    if (wr == 1) PG8_BAR;
    PG8_WAIT_V(4); PG8_BAR;
    PG8_STAGE(PG8_SB(1, 0), cB + kstep, voffB); PG8_STAGE(PG8_SA(1, 0), cA + kstep, voffA); PG8_STAGE(PG8_SB(1, 1), cB + hstep + kstep, voffB);
    PG8_WAIT_V(6); PG8_BAR;
    for (;;) {
        const bool has_next = S.next(ui + 1, nxt);
        const char* nA = has_next ? (const char*)g.A + (size_t)nxt.pm * tstep : cA; const char* nB = has_next ? (const char*)g.Bt + (size_t)nxt.pn * tstep : cB;
        for (int t = 0; t < nt; t += 2) {
            const bool last = (t == nt - 2);
            const char* a1 = cA + (size_t)(t + 1) * kstep;
            const char* a2 = last ? nA : cA + (size_t)(t + 2) * kstep; const char* b2 = last ? nB : cB + (size_t)(t + 2) * kstep;
            const char* a3 = a2 + kstep; const char* b3 = b2 + kstep;
            PG8_LDB(B0, 0, 0); PG8_SCHED; PG8_LDA(At, 0, 0); PG8_STAGE(PG8_SA(1, 1), a1 + hstep, voffA);
            PG8_WAIT_L(8); PG8_BAR; PG8_WAIT_L(0); PG8_MMA(0, 0, At, B0); PG8_BAR; PG8_SCHED;
            PG8_LDB(B1, 0, 1); PG8_STAGE(PG8_SB(0, 0), b2, voffB);
            PG8_BAR; PG8_WAIT_L(0); PG8_MMA(0, 1, At, B1); PG8_BAR;
            PG8_LDA(At, 0, 1); PG8_STAGE(PG8_SA(0, 0), a2, voffA);
            PG8_BAR; PG8_WAIT_L(0); PG8_MMA(1, 0, At, B0); PG8_BAR; PG8_SCHED;
            PG8_STAGE(PG8_SB(0, 1), b2 + hstep, voffB);
            PG8_WAIT_V(6); PG8_BAR; PG8_MMA(1, 1, At, B1); PG8_BAR;
            PG8_LDB(B0, 1, 0); PG8_SCHED; PG8_LDA(At, 1, 0); PG8_STAGE(PG8_SA(0, 1), a2 + hstep, voffA);
            PG8_WAIT_L(8); PG8_BAR; PG8_WAIT_L(0); PG8_MMA(0, 0, At, B0); PG8_BAR; PG8_SCHED;
            PG8_LDB(B1, 1, 1); PG8_STAGE(PG8_SB(1, 0), b3, voffB);
            PG8_BAR; PG8_WAIT_L(0); PG8_MMA(0, 1, At, B1); PG8_BAR;
            PG8_LDA(At, 1, 1); PG8_STAGE(PG8_SA(1, 0), a3, voffA);
            PG8_BAR; PG8_WAIT_L(0); PG8_MMA(1, 0, At, B0); PG8_BAR; PG8_SCHED;
            PG8_STAGE(PG8_SB(1, 1), b3 + hstep, voffB);
            PG8_WAIT_V(6); PG8_BAR; PG8_MMA(1, 1, At, B1); PG8_BAR;
        }
        E(acc, cur, wr, wc, fr, fq);
        if (!has_next) break;
#pragma unroll
        for (int a = 0; a < 2; ++a)
#pragma unroll
            for (int b = 0; b < 2; ++b)
#pragma unroll
                for (int m = 0; m < 4; ++m)
#pragma unroll
                    for (int n = 0; n < 2; ++n) acc[a][b][m][n] = (f32x4){0.f, 0.f, 0.f, 0.f};
        cur = nxt; cA = nA; cB = nB; ++ui;
    }
    PG8_WAIT_V(0);
    if (wr == 0) PG8_BAR;
    PG8_BAR;
#undef PG8_SA
#undef PG8_SB
#undef PG8_STAGE
#undef PG8_LDA
#undef PG8_LDB
#undef PG8_MMA
#undef PG8_WAIT_V
#undef PG8_WAIT_L
#undef PG8_BAR
#undef PG8_SCHED
}

template <int ACT  > struct EpiBf16 {
    static constexpr bool PERM = true;
    bf16_t* O; int ldc;
    __device__ __forceinline__ void operator()(const f32x4 (&acc)[2][2][4][2], const Unit& u, int wr, int wc, int fr, int fq) const {
        const int row0 = u.pm * BM + wr * 64 + fr, col0 = u.pn * BM + wc * 32 + 8 * fq;
#pragma unroll
        for (int ai = 0; ai < 2; ++ai)
#pragma unroll
            for (int m = 0; m < 4; ++m) { bf16_t* rowp = O + (size_t)(row0 + ai * HALF + m * 16) * ldc + col0;
#pragma unroll
                for (int bj = 0; bj < 2; ++bj) { f32x4 v0 = acc[ai][bj][m][0], v1 = acc[ai][bj][m][1];
                    if (ACT == 1) {
#pragma unroll
                        for (int j = 0; j < 4; ++j) { v0[j] = gelu_tanh(v0[j]); v1[j] = gelu_tanh(v1[j]); } }
                    u32x4 w; w.x = pk_bf16(v0[0], v0[1]); w.y = pk_bf16(v0[2], v0[3]); w.z = pk_bf16(v1[0], v1[1]); w.w = pk_bf16(v1[2], v1[3]);
                    *(u32x4*)(rowp + bj * HALF) = w; } }
    }
};
struct EpiRes {
    static constexpr bool PERM = false;
    const float* src_lat; const float* src_ctx; float* dst; const float* modL; int gate_idx;
    __device__ __forceinline__ void operator()(const f32x4 (&acc)[2][2][4][2], const Unit& u, int wr, int wc, int fr, int fq) const {
        const bool isctx = u.pm >= (TL / BM);
        const float* sb = isctx ? src_ctx + (size_t)(u.pm - TL / BM) * BM * D : src_lat + (size_t)u.pm * BM * D;
        const int mb = isctx ? NB : (u.pm >> 3);
        const float* gv = modL + (size_t)mb * 6144 + gate_idx * 1024;
        const int rl = wr * 64 + fr, col0 = u.pn * BM + wc * 32 + 4 * fq;
        f32x4 g[2][2];
#pragma unroll
        for (int bj = 0; bj < 2; ++bj)
#pragma unroll
            for (int n = 0; n < 2; ++n) g[bj][n] = *(const f32x4*)(gv + col0 + bj * HALF + n * 16);
#pragma unroll
        for (int ai = 0; ai < 2; ++ai)
#pragma unroll
            for (int m = 0; m < 4; ++m) { const int r = rl + ai * HALF + m * 16; const float* sp = sb + (size_t)r * D + col0; float* dp = dst + ((size_t)u.pm * BM + r) * D + col0;
#pragma unroll
                for (int bj = 0; bj < 2; ++bj)
#pragma unroll
                    for (int n = 0; n < 2; ++n) { const f32x4 x = *(const f32x4*)(sp + bj * HALF + n * 16); *(f32x4*)(dp + bj * HALF + n * 16) = x * DN_ALPHA + g[bj][n] * acc[ai][bj][m][n]; } }
    }
};
struct EpiGlaProj {
    static constexpr bool PERM = true;
    bf16_t* QG; bf16_t* KG; bf16_t* VG; bf16_t* RG; float* GL;
    __device__ __forceinline__ void operator()(const f32x4 (&acc)[2][2][4][2], const Unit& u, int wr, int wc, int fr, int fq) const {
        const int row0 = u.pm * BM + wr * 64 + fr, pn = u.pn;
        if (pn < 12) {
            bf16_t* base; int ld, colt; float sc = 1.f;
            if (pn < 2) { base = QG; ld = 512; colt = pn * BM; sc = 0.08838834764831845f; }
            else if (pn < 4) { base = KG; ld = 512; colt = (pn - 2) * BM; }
            else if (pn < 8) { base = VG; ld = 1024; colt = (pn - 4) * BM; }
            else { base = RG; ld = 1024; colt = (pn - 8) * BM; }
            const int col0 = colt + wc * 32 + 8 * fq;
#pragma unroll
            for (int ai = 0; ai < 2; ++ai)
#pragma unroll
                for (int m = 0; m < 4; ++m) { bf16_t* rowp = base + (size_t)(row0 + ai * HALF + m * 16) * ld + col0;
#pragma unroll
                    for (int bj = 0; bj < 2; ++bj) { const f32x4 v0 = acc[ai][bj][m][0] * sc, v1 = acc[ai][bj][m][1] * sc;
                        u32x4 w; w.x = pk_bf16(v0[0], v0[1]); w.y = pk_bf16(v0[2], v0[3]); w.z = pk_bf16(v1[0], v1[1]); w.w = pk_bf16(v1[2], v1[3]);
                        *(u32x4*)(rowp + bj * HALF) = w; } }
        } else if (wc == 0) {
#pragma unroll
            for (int ai = 0; ai < 2; ++ai)
#pragma unroll
                for (int m = 0; m < 4; ++m) { float* gp = GL + (size_t)(row0 + ai * HALF + m * 16) * 32 + 8 * fq;
                    *(f32x4*)gp = acc[ai][0][m][0]; *(f32x4*)(gp + 4) = acc[ai][0][m][1]; }
        }
    }
};
}

struct Ctx {
    const Params* p; unsigned char* ws; unsigned char* smem; int tid, lane, wave, G, bid;
};

DI void phase_prologue(const Ctx& c) {
    const Params& p = *c.p; unsigned char* ws = c.ws;
    const int tid = c.tid;
    constexpr int N_MOD = 192, N_TR = 4736, N_WS = 64, N_TAB = 2048;
    constexpr int N_ALL = N_MOD + N_TR + N_WS + N_TAB;
    for (int u = c.bid; u < N_ALL; u += c.G) {
        if (u < N_MOD) {
            const int l = u / 48, n0 = (u % 48) * 128;
            float* sc = (float*)c.smem;
            float* red = (float*)(c.smem + 17 * 1024 * 4);
            __syncthreads();
#pragma unroll 1
            for (int hk = 0; hk < 2; ++hk) { const int k = hk * 512 + tid; float v[17];
#pragma unroll
                for (int b = 0; b < 17; ++b) v[b] = (b < NB) ? p.in[1][b * 1024 + k] : p.in[3][k];
#pragma unroll
                for (int b = 0; b < 17; ++b) sc[b * 1024 + k] = silu_f(v[b]); }
            __syncthreads();
            const int c4 = (tid & 31) * 4, kg = tid >> 5;
            float acc[17][4];
#pragma unroll
            for (int b = 0; b < 17; ++b) { acc[b][0] = 0.f; acc[b][1] = 0.f; acc[b][2] = 0.f; acc[b][3] = 0.f; }
            const float* wp = p.in[4] + ((size_t)l * 1024 + (size_t)kg * 64) * 6144 + n0 + c4;
#pragma unroll 4
            for (int kk = 0; kk < 64; ++kk) {
                const f32x4 w = *(const f32x4*)(wp + (size_t)kk * 6144);
                const int k = kg * 64 + kk;
#pragma unroll
                for (int b = 0; b < 17; ++b) { const float s = sc[b * 1024 + k]; acc[b][0] += s * w[0]; acc[b][1] += s * w[1]; acc[b][2] += s * w[2]; acc[b][3] += s * w[3]; }
            }
#pragma unroll
            for (int b = 0; b < 17; ++b)
#pragma unroll
                for (int j = 0; j < 4; ++j) acc[b][j] += __shfl_xor(acc[b][j], 32, 64);
            if ((tid & 32) == 0) {
#pragma unroll
                for (int b = 0; b < 17; ++b)
#pragma unroll
                    for (int j = 0; j < 4; ++j) red[(c.wave * 17 + b) * 128 + c4 + j] = acc[b][j];
            }
            __syncthreads();
            for (int o = tid; o < 17 * 128; o += NTHR) { const int b = o >> 7, n = o & 127; float s = 0.f;
#pragma unroll
                for (int w = 0; w < 8; ++w) s += red[(w * 17 + b) * 128 + n];
                ((float*)(ws + WS_MOD))[((size_t)l * 17 + b) * 6144 + n0 + n] = s + p.in[5][l * 6144 + n0 + n]; }
        } else if (u < N_MOD + N_TR) {
            int v = u - N_MOD; const float* src; bf16_t* dst; int N, Npad;
            if (v < 1024) { const int j = v / 512; v %= 512; src = p.in[8] + (size_t)j * 1024 * 2048; dst = (bf16_t*)(ws + WS_WAIN) + (size_t)j * 2048 * 1024; N = 2048; Npad = 2048; }
            else if (v < 1536) { v -= 1024; const int j = v / 256; v %= 256; src = p.in[13] + (size_t)j * 1024 * 1024; dst = (bf16_t*)(ws + WS_WAOUT) + (size_t)j * 1024 * 1024; N = 1024; Npad = 1024; }
            else if (v < 3200) { v -= 1536; const int j = v / 832; v %= 832; src = p.in[14] + (size_t)j * 1024 * 3104; dst = (bf16_t*)(ws + WS_WBIN) + (size_t)j * WBIN_N * 1024; N = 3104; Npad = WBIN_N; }
            else if (v < 3712) { v -= 3200; const int j = v / 256; v %= 256; src = p.in[18] + (size_t)j * 1024 * 1024; dst = (bf16_t*)(ws + WS_WBOUT) + (size_t)j * 1024 * 1024; N = 1024; Npad = 1024; }
            else { v -= 3712; const int j = v / 256; v %= 256; src = p.in[19] + (size_t)j * 1024 * 1024; dst = (bf16_t*)(ws + WS_WQ) + (size_t)j * 1024 * 1024; N = 1024; Npad = 1024; }
            (void)Npad;
            const int ntn = v >> 4, ktile = v & 15, n0 = ntn * 64, k0 = ktile * 64;
            float* tl = (float*)c.smem;
            __syncthreads();
#pragma unroll
            for (int i = 0; i < 2; ++i) { const int kk = (tid >> 4) + 32 * i, nn = (tid & 15) * 4;
                f32x4 x = {0.f, 0.f, 0.f, 0.f};
                if (n0 + nn < N) x = *(const f32x4*)(src + (size_t)(k0 + kk) * N + n0 + nn);
                tl[kk * 65 + nn] = x[0]; tl[kk * 65 + nn + 1] = x[1]; tl[kk * 65 + nn + 2] = x[2]; tl[kk * 65 + nn + 3] = x[3]; }
            __syncthreads();
            { const int nn = tid >> 3, kk8 = (tid & 7) * 8; float x[8];
#pragma unroll
              for (int j = 0; j < 8; ++j) x[j] = tl[(kk8 + j) * 65 + nn];
              u32x4 w; w.x = pk_bf16(x[0], x[1]); w.y = pk_bf16(x[2], x[3]); w.z = pk_bf16(x[4], x[5]); w.w = pk_bf16(x[6], x[7]);
              *(u32x4*)(dst + (size_t)(n0 + nn) * 1024 + k0 + kk8) = w; }
        } else if (u < N_MOD + N_TR + N_WS) {
            const int v = u - N_MOD - N_TR; const size_t e = (size_t)v * 4096 + (size_t)tid * 8;
            const f32x4 a = *(const f32x4*)(p.in[11] + e), b = *(const f32x4*)(p.in[11] + e + 4);
            u32x4 w; w.x = pk_bf16(a[0], a[1]); w.y = pk_bf16(a[2], a[3]); w.z = pk_bf16(b[0], b[1]); w.w = pk_bf16(b[2], b[3]);
            *(u32x4*)((bf16_t*)(ws + WS_WSB) + e) = w;
        } else {
            const int v = u - N_MOD - N_TR - N_WS; const int tab = v >> 10;
            const float* src = p.in[21 + tab]; unsigned char* dst = ws + (tab ? WS_VT : WS_UT); float* sc = (float*)(ws + (tab ? WS_SV : WS_SU));
#pragma unroll 2
            for (int i = 0; i < 8; ++i) { const size_t row = (size_t)(v & 1023) * 64 + c.wave * 8 + i;
                const float* rp = src + row * 1024 + 16 * c.lane; f32x4 x[4]; float am = 0.f;
#pragma unroll
                for (int q = 0; q < 4; ++q) { x[q] = __builtin_nontemporal_load((const f32x4*)(rp + 4 * q)); am = fmaxf(am, fmaxf(fmaxf(fabsf(x[q][0]), fabsf(x[q][1])), fmaxf(fabsf(x[q][2]), fabsf(x[q][3])))); }
                am = fmaxf(wave_max(am), 1e-30f);
                const size_t Lr = row >> 14, er = row & 16383;
                if (tab == 0) {
                    const float inv = 440.0f / am; u32x4 w;
#pragma unroll
                    for (int q = 0; q < 4; ++q) { int t = 0; t = __builtin_amdgcn_cvt_pk_fp8_f32(x[q][0] * inv, x[q][1] * inv, t, false); t = __builtin_amdgcn_cvt_pk_fp8_f32(x[q][2] * inv, x[q][3] * inv, t, true); w[q] = (unsigned)t; }
                    *(u32x4*)(dst + ((Lr * 8 + (c.lane >> 3)) * NEXP + er) * 128 + 16 * (c.lane & 7)) = w;
                    if (c.lane == 0) sc[row] = am * (1.0f / 440.0f);
                } else {
                    const float inv = 6.0f / am; u32x2 w;
#pragma unroll
                    for (int hq = 0; hq < 2; ++hq) { unsigned t = 0;
                        t = __builtin_amdgcn_cvt_scalef32_pk_fp4_f32(t, x[2 * hq][0] * inv, x[2 * hq][1] * inv, 1.0f, 0); t = __builtin_amdgcn_cvt_scalef32_pk_fp4_f32(t, x[2 * hq][2] * inv, x[2 * hq][3] * inv, 1.0f, 1);
                        t = __builtin_amdgcn_cvt_scalef32_pk_fp4_f32(t, x[2 * hq + 1][0] * inv, x[2 * hq + 1][1] * inv, 1.0f, 2); t = __builtin_amdgcn_cvt_scalef32_pk_fp4_f32(t, x[2 * hq + 1][2] * inv, x[2 * hq + 1][3] * inv, 1.0f, 3);
                        w[hq] = t; }
                    *(u32x2*)(dst + ((Lr * 4 + (c.lane >> 4)) * NEXP + er) * 128 + 8 * (c.lane & 15)) = w;
                    if (c.lane == 0) sc[row] = am * (1.0f / 6.0f);
                } }
        }
    }
}

DI void phase_mod0(const Ctx& c) {
    const Params& p = *c.p; const float* MOD = (const float*)(c.ws + WS_MOD); bf16_t* H1 = (bf16_t*)(c.ws + WS_H1);
    for (int row = c.bid * NWAVE + c.wave; row < T; row += c.G * NWAVE) {
        const float* src = row < TL ? p.in[0] + (size_t)row * D : p.in[2] + (size_t)(row - TL) * D;
        const float* m = MOD + (size_t)mod_batch(row) * 6144;
#pragma unroll
        for (int j = 0; j < 4; ++j) { const int col = 4 * c.lane + 256 * j;
            const f32x4 x = *(const f32x4*)(src + col), sh = *(const f32x4*)(m + col), s = *(const f32x4*)(m + 1024 + col);
            const f32x4 h = x * (s + 1.0f) + sh; u32x2 w; w.x = pk_bf16(h[0], h[1]); w.y = pk_bf16(h[2], h[3]);
            *(u32x2*)(H1 + (size_t)row * D + col) = w; }
    }
}

DI void phase_vstats(const Ctx& c) {
    const bf16_t* UV = (const bf16_t*)(c.ws + WS_R1); float* ST = (float*)(c.ws + WS_STATS);
    for (int row = c.bid * NWAVE + c.wave; row < T; row += c.G * NWAVE) {
        const bf16_t* vp = UV + (size_t)row * 2048 + 1024;
        const u32x4 a = *(const u32x4*)(vp + 8 * c.lane), b = *(const u32x4*)(vp + 512 + 8 * c.lane);
        float x[16];
#pragma unroll
        for (int j = 0; j < 4; ++j) { x[2 * j] = bf_lo(a[j]); x[2 * j + 1] = bf_hi(a[j]); x[8 + 2 * j] = bf_lo(b[j]); x[9 + 2 * j] = bf_hi(b[j]); }
        float s = 0.f;
#pragma unroll
        for (int j = 0; j < 16; ++j) s += x[j];
        const float mean = wave_sum(s) * (1.0f / 1024.0f);
        float q = 0.f;
#pragma unroll
        for (int j = 0; j < 16; ++j) { const float d = x[j] - mean; q += d * d; }
        const float var = wave_sum(q) * (1.0f / 1024.0f);
        if (c.lane == 0) { ST[2 * row] = mean; ST[2 * row + 1] = rsqrtf(var + LN_EPS); }
    }
}

DI void phase_spatial(const Ctx& c, int j) {
    const Params& p = *c.p; unsigned char* ws = c.ws;
    const bf16_t* UV = (const bf16_t*)(ws + WS_R1); const float* ST = (const float*)(ws + WS_STATS); bf16_t* Y = (bf16_t*)(ws + WS_R2);
    const bf16_t* WSB = (const bf16_t*)(ws + WS_WSB) + (size_t)j * 8 * 128 * 128;
    const float* ng = p.in[9] + j * 1024; const float* nb = p.in[10] + j * 1024; const float* bs = p.in[12] + j * 8 * 128;
    constexpr int LD = 136;
    bf16_t* WsL = (bf16_t*)c.smem;
    bf16_t* VnT = WsL + 128 * LD;
    const int tid = c.tid, lane = c.lane, w = c.wave, g = lane >> 4, cc = lane & 15;
    for (int u = c.bid; u < (T / 128) * 8; u += c.G) {
        const int chunk = u >> 3, h = u & 7, r0 = chunk * 128;
        __syncthreads();
        { const int cg8 = tid & 15; float gg[8], bb[8];
#pragma unroll
          for (int e = 0; e < 8; ++e) { gg[e] = ng[h * 128 + cg8 * 8 + e]; bb[e] = nb[h * 128 + cg8 * 8 + e]; }
#pragma unroll
          for (int i = 0; i < 4; ++i) { const int idx = i * 512 + tid, tok = idx >> 4;
              const u32x4 v = *(const u32x4*)(UV + (size_t)(r0 + tok) * 2048 + 1024 + h * 128 + cg8 * 8);
              const float mean = ST[2 * (r0 + tok)], rstd = ST[2 * (r0 + tok) + 1];
              float x[8];
#pragma unroll
              for (int e = 0; e < 4; ++e) { x[2 * e] = bf_lo(v[e]); x[2 * e + 1] = bf_hi(v[e]); }
#pragma unroll
              for (int e = 0; e < 8; ++e) VnT[(cg8 * 8 + e) * LD + tok] = f2bf((x[e] - mean) * rstd * gg[e] + bb[e]);
              const int pp = idx >> 4;
              *(u32x4*)(WsL + pp * LD + cg8 * 8) = *(const u32x4*)(WSB + ((size_t)h * 128 + pp) * 128 + cg8 * 8); } }
        __syncthreads();
        f32x4 acc[8];
#pragma unroll
        for (int ct = 0; ct < 8; ++ct) acc[ct] = (f32x4){0.f, 0.f, 0.f, 0.f};
#pragma unroll
        for (int ks = 0; ks < 4; ++ks) {
            const bf16x8 bfr = frag_ld(WsL, LD, 16 * w, 32 * ks, lane);
#pragma unroll
            for (int ct = 0; ct < 8; ++ct) acc[ct] = mfma16(frag_ld(VnT, LD, 16 * ct, 32 * ks, lane), bfr, acc[ct]);
        }
        const int pp = 16 * w + cc; const float bsv = bs[h * 128 + pp];
        const size_t rowo = (size_t)(r0 + pp);
#pragma unroll
        for (int ct = 0; ct < 8; ++ct) { const int ch = h * 128 + 16 * ct + 4 * g;
            const u32x2 uu = *(const u32x2*)(UV + rowo * 2048 + ch);
            const float y0 = bf_lo(uu.x) * (acc[ct][0] + bsv), y1 = bf_hi(uu.x) * (acc[ct][1] + bsv), y2 = bf_lo(uu.y) * (acc[ct][2] + bsv), y3 = bf_hi(uu.y) * (acc[ct][3] + bsv);
            u32x2 o; o.x = pk_bf16(y0, y1); o.y = pk_bf16(y2, y3);
            *(u32x2*)(Y + rowo * D + ch) = o; }
    }
}

DI void phase_ln1(const Ctx& c, int L) {
    const Params& p = *c.p; float* XS = (float*)(c.ws + WS_XS); const float* MOD = (const float*)(c.ws + WS_MOD) + (size_t)L * 17 * 6144;
    bf16_t* H2 = (bf16_t*)(c.ws + WS_R2 + SZ_T1K);
    const float* lg = p.in[6] + (size_t)(L * 2 + 0) * D; const float* lb = p.in[7] + (size_t)(L * 2 + 0) * D;
    for (int row = c.bid * NWAVE + c.wave; row < T; row += c.G * NWAVE) {
        float* xp = XS + (size_t)row * D; const float* m = MOD + (size_t)mod_batch(row) * 6144;
        f32x4 x[4]; float s = 0.f;
#pragma unroll
        for (int j = 0; j < 4; ++j) { x[j] = *(const f32x4*)(xp + 4 * c.lane + 256 * j); s += (x[j][0] + x[j][1]) + (x[j][2] + x[j][3]); }
        const float mean = wave_sum(s) * (1.0f / 1024.0f);
        float q = 0.f;
#pragma unroll
        for (int j = 0; j < 4; ++j) { const f32x4 d = x[j] - mean; q += (d[0] * d[0] + d[1] * d[1]) + (d[2] * d[2] + d[3] * d[3]); }
        const float rstd = rsqrtf(wave_sum(q) * (1.0f / 1024.0f) + LN_EPS);
#pragma unroll
        for (int j = 0; j < 4; ++j) { const int col = 4 * c.lane + 256 * j;
            const f32x4 y = (x[j] - mean) * rstd * *(const f32x4*)(lg + col) + *(const f32x4*)(lb + col);
            *(f32x4*)(xp + col) = y;
            const f32x4 h = y * (*(const f32x4*)(m + 4 * 1024 + col) + 1.0f) + *(const f32x4*)(m + 3 * 1024 + col);
            u32x2 w; w.x = pk_bf16(h[0], h[1]); w.y = pk_bf16(h[2], h[3]);
            *(u32x2*)(H2 + (size_t)row * D + col) = w; }
    }
}

DI int f2key(float v) { const int i = __float_as_int(v); return i ^ ((i >> 31) & 0x7fffffff); }
DI float key2f(int k) { return __int_as_float(k ^ ((k >> 31) & 0x7fffffff)); }
DI void phase_route(const Ctx& c, int L) {
    const Params& p = *c.p; unsigned char* ws = c.ws; const int lane = c.lane, g = lane >> 4, cc = lane & 15;
    constexpr int LDK = 72, LDS_S = 20;
    bf16_t* keysHi = (bf16_t*)c.smem;
    bf16_t* keysLo = keysHi + 2 * 128 * LDK;
    float* sbase = (float*)(keysLo + 2 * 128 * LDK);
    unsigned* ilist = (unsigned*)(sbase + NWAVE * 64 * LDS_S);
    __syncthreads();
    { const float* gk = p.in[20] + (size_t)L * 2 * 128 * 64;
      f32x4 kv[8];
#pragma unroll
      for (int it = 0; it < 8; ++it) kv[it] = ((const f32x4*)gk)[it * NTHR + c.tid];
#pragma unroll
      for (int it = 0; it < 8; ++it) { const int i = (it * NTHR + c.tid) * 4, row = i >> 6, d = i & 63; unsigned hi[2], lo[2];
#pragma unroll
          for (int e = 0; e < 2; ++e) { const unsigned ph = pk_bf16(kv[it][2 * e], kv[it][2 * e + 1]); hi[e] = ph; lo[e] = pk_bf16(kv[it][2 * e] - bf_lo(ph), kv[it][2 * e + 1] - bf_hi(ph)); }
          *(u32x2*)(keysHi + row * LDK + d) = (u32x2){hi[0], hi[1]}; *(u32x2*)(keysLo + row * LDK + d) = (u32x2){lo[0], lo[1]}; } }
    __syncthreads();
    float* S = sbase + c.wave * 64 * LDS_S;
    const bf16_t* QP = (const bf16_t*)(ws + WS_R1); int* IDX = (int*)(ws + WS_R1 + SZ_T1K); float* WT = (float*)(ws + WS_R1 + SZ_T1K + (size_t)T * 128 * 4);
    unsigned* myl = ilist + c.tid * 8; const unsigned char* mylb = (const unsigned char*)myl;
    for (int task = c.bid * NWAVE + c.wave; task < (T / 64) * 8; task += c.G * NWAVE) {
        const int t0 = (task >> 3) * 64, h = task & 7, tok = t0 + lane;
        float t12[2][16];
#pragma unroll
        for (int half = 0; half < 2; ++half) {
            bf16x8 aq[4][2];
#pragma unroll
            for (int mt = 0; mt < 4; ++mt)
#pragma unroll
                for (int ks = 0; ks < 2; ++ks) aq[mt][ks] = *(const bf16x8*)(QP + (size_t)(t0 + 16 * mt + cc) * D + h * 128 + half * 64 + 32 * ks + 8 * g);
            const bf16_t* kh = keysHi + half * 128 * LDK; const bf16_t* kl = keysLo + half * 128 * LDK;
#pragma unroll
            for (int i = 0; i < 16; ++i) t12[half][i] = -3.0e38f;
            for (int nt = 0; nt < 8; ++nt) {
                const bf16x8 bh0 = frag_ld(kh, LDK, 16 * nt, 0, lane), bh1 = frag_ld(kh, LDK, 16 * nt, 32, lane), bl0 = frag_ld(kl, LDK, 16 * nt, 0, lane), bl1 = frag_ld(kl, LDK, 16 * nt, 32, lane);
#pragma unroll
                for (int mt = 0; mt < 4; ++mt) { f32x4 a = {0.f, 0.f, 0.f, 0.f};
                    a = mfma16(aq[mt][0], bl0, a); a = mfma16(aq[mt][1], bl1, a); a = mfma16(aq[mt][0], bh0, a); a = mfma16(aq[mt][1], bh1, a);
#pragma unroll
                    for (int r = 0; r < 4; ++r) S[(16 * mt + 4 * g + r) * LDS_S + cc] = a[r]; }
                f32x4 sc[4];
#pragma unroll
                for (int q4 = 0; q4 < 4; ++q4) sc[q4] = *(const f32x4*)(S + lane * LDS_S + 4 * q4);
#pragma unroll
                for (int kk = 0; kk < 16; ++kk) { const float key = __int_as_float((__float_as_int(sc[kk >> 2][kk & 3]) & ~127) | (127 - (16 * nt + kk)));
#pragma unroll
                    for (int i = 15; i >= 1; --i) t12[half][i] = __builtin_amdgcn_fmed3f(key, t12[half][i - 1], t12[half][i]);
                    t12[half][0] = __builtin_amdgcn_fmed3f(key, 3.0e38f, t12[half][0]); }
            }
        }
        float v1[16], v2[16];
#pragma unroll
        for (int i = 0; i < 16; ++i) { v1[i] = __int_as_float(__float_as_int(t12[0][i]) & ~127); v2[i] = __int_as_float(__float_as_int(t12[1][i]) & ~127); }
#pragma unroll
        for (int i = 0; i < 4; ++i) {
            myl[i] = (unsigned)(127 - (__float_as_int(t12[0][4 * i]) & 127)) | ((unsigned)(127 - (__float_as_int(t12[0][4 * i + 1]) & 127)) << 8) | ((unsigned)(127 - (__float_as_int(t12[0][4 * i + 2]) & 127)) << 16) | ((unsigned)(127 - (__float_as_int(t12[0][4 * i + 3]) & 127)) << 24);
            myl[4 + i] = (unsigned)(127 - (__float_as_int(t12[1][4 * i]) & 127)) | ((unsigned)(127 - (__float_as_int(t12[1][4 * i + 1]) & 127)) << 8) | ((unsigned)(127 - (__float_as_int(t12[1][4 * i + 2]) & 127)) << 16) | ((unsigned)(127 - (__float_as_int(t12[1][4 * i + 3]) & 127)) << 24); }
        float f[16];
#pragma unroll
        for (int i = 0; i < 16; ++i) f[i] = -3.0e38f;
#pragma unroll
        for (int a = 0; a < 16; ++a)
#pragma unroll
            for (int b = 0; b < 16; ++b)
                if ((a + 1) * (b + 1) <= 16) {
                    const float key = __int_as_float((__float_as_int(v1[a] + v2[b]) & ~255) | (255 - (a * 16 + b)));
#pragma unroll
                    for (int i = 15; i >= 1; --i) f[i] = __builtin_amdgcn_fmed3f(key, f[i - 1], f[i]);
                    f[0] = __builtin_amdgcn_fmed3f(key, 3.0e38f, f[0]);
                }
        float e[16], se = 0.f; int fi[16];
        const float vmax = __int_as_float(__float_as_int(f[0]) & ~255);
#pragma unroll
        for (int i = 0; i < 16; ++i) { const int code = 255 - (__float_as_int(f[i]) & 255); fi[i] = (int)mylb[code >> 4] * 128 + (int)mylb[16 + (code & 15)];
            e[i] = __expf(__int_as_float(__float_as_int(f[i]) & ~255) - vmax); se += e[i]; }
        const float inv = 1.0f / se;
        int* ip = IDX + (size_t)tok * 128 + h * 16; float* wp = WT + (size_t)tok * 128 + h * 16;
#pragma unroll
        for (int i = 0; i < 16; i += 4) { *(int4*)(ip + i) = make_int4(fi[i], fi[i + 1], fi[i + 2], fi[i + 3]); *(f32x4*)(wp + i) = (f32x4){e[i] * inv, e[i + 1] * inv, e[i + 2] * inv, e[i + 3] * inv}; }
    }
}

DI float red8(float p) { p += dpp_mov<0xB1>(p); p += dpp_mov<0x4E>(p); p += dpp_mov<0x141>(p); return p; }
DI void phase_experts(const Ctx& c, int L) {
    const Params& p = *c.p; unsigned char* ws = c.ws; const int lane = c.lane, g8 = lane >> 3, j = lane & 7;
    constexpr int MAXTOK = 18;
    const bf16_t* H2 = (const bf16_t*)(ws + WS_R2 + SZ_T1K);
    const int* IDX = (const int*)(ws + WS_R1 + SZ_T1K); const float* WT = (const float*)(ws + WS_R1 + SZ_T1K + (size_t)T * 128 * 4);
    bf16_t* FFN = (bf16_t*)(ws + WS_R1);
    const unsigned char* UT = ws + WS_UT + (size_t)L * NEXP * 1024; const unsigned char* VT = ws + WS_VT + (size_t)L * NEXP * 512;
    const float* SU = (const float*)(ws + WS_SU) + (size_t)L * NEXP; const float* SV = (const float*)(ws + WS_SV) + (size_t)L * NEXP;
    float* XS = (float*)(ws + WS_XS); bf16_t* H1 = (bf16_t*)(ws + WS_H1);
    const float* MOD = (const float*)(ws + WS_MOD) + (size_t)L * 17 * 6144;
    const float* lg = p.in[6] + (size_t)(L * 2 + 1) * D; const float* lb = p.in[7] + (size_t)(L * 2 + 1) * D;
    const int nrows = (L == DEPTH - 1) ? TL : T;
    float* ZL = (float*)c.smem + c.wave * MAXTOK * 128;
    unsigned short* IL = (unsigned short*)(c.smem + NWAVE * MAXTOK * 128 * 4) + c.wave * MAXTOK * 128;
    const int GW = c.G * NWAVE, gw = c.bid * NWAVE + c.wave;
    const int tsrc = 8 * (lane & 7) + (lane >> 3);
    for (int base = 0; base < nrows; base += GW * MAXTOK) {
        int ntok = 0;
        for (int k = 0; k < MAXTOK; ++k) { const int tok = base + gw + GW * k; if (tok < nrows) { ntok = k + 1;
            IL[k * 128 + lane] = (unsigned short)IDX[(size_t)tok * 128 + lane]; IL[k * 128 + 64 + lane] = (unsigned short)IDX[(size_t)tok * 128 + 64 + lane]; } }
        for (int c8 = 0; c8 < 8; ++c8) {
            const unsigned char* Ub = UT + (size_t)c8 * NEXP * 128 + 16 * j;
            const bf16_t* Xb = H2 + 128 * c8 + 16 * j;
            u32x4 rA[8], rB[8], xA[2], xB[2];
#define U_ISSUE(R, X, k_, hf_) do { const int tok_ = base + gw + GW * (k_); X[0] = *(const u32x4*)(Xb + (size_t)tok_ * D); X[1] = *(const u32x4*)(Xb + (size_t)tok_ * D + 8); \
                _Pragma("unroll") for (int i = 0; i < 8; ++i) { const unsigned e = IL[(k_) * 128 + 64 * (hf_) + 8 * i + g8]; R[i] = *(const u32x4*)(Ub + (size_t)e * 128); } } while (0)
#define U_COMPUTE(R, X, k_, hf_) do { f32x2 xf[8]; \
                _Pragma("unroll") for (int q = 0; q < 4; ++q) { xf[q] = (f32x2){bf_lo(X[0][q]), bf_hi(X[0][q])}; xf[4 + q] = (f32x2){bf_lo(X[1][q]), bf_hi(X[1][q])}; } \
                float ra = 0.f; \
                _Pragma("unroll") for (int i = 0; i < 8; ++i) { f32x2 acc = {0.f, 0.f}; \
                    _Pragma("unroll") for (int q = 0; q < 4; ++q) { acc += __builtin_amdgcn_cvt_pk_f32_fp8((int)R[i][q], false) * xf[2 * q]; acc += __builtin_amdgcn_cvt_pk_f32_fp8((int)R[i][q], true) * xf[2 * q + 1]; } \
                    const float pr = red8(acc[0] + acc[1]); ra = (j == i) ? pr : ra; } \
                const float za = __shfl(ra, tsrc, 64); \
                if (c8 == 0) ZL[(k_) * 128 + 64 * (hf_) + lane] = za; else ZL[(k_) * 128 + 64 * (hf_) + lane] += za; } while (0)
            if (ntok > 0) U_ISSUE(rA, xA, 0, 0);
            for (int k = 0; k < ntok; ++k) {
                const int kn = (k + 1 < ntok) ? k + 1 : k;
                U_ISSUE(rB, xB, k, 1);
                U_COMPUTE(rA, xA, k, 0);
                U_ISSUE(rA, xA, kn, 0);
                U_COMPUTE(rB, xB, k, 1);
            }
#undef U_ISSUE
#undef U_COMPUTE
        }
        for (int k = 0; k < ntok; ++k) { const int tok = base + gw + GW * k;
#pragma unroll
            for (int hh = 0; hh < 2; ++hh) { const unsigned e = IL[k * 128 + 64 * hh + lane]; const float wv = WT[(size_t)tok * 128 + 64 * hh + lane];
                ZL[k * 128 + 64 * hh + lane] = gelu_tanh(ZL[k * 128 + 64 * hh + lane] * SU[e]) * wv * SV[e]; } }
        for (int c4 = 0; c4 < 4; ++c4) {
            const unsigned char* Vb = VT + (size_t)c4 * NEXP * 128 + 16 * j;
            const bool hi8 = (lane & 8) != 0;
            u32x4 rA[8], rB[8];
            f32x2 o[16];
#define V_ISSUE(R, k_, hf_) do { _Pragma("unroll") for (int i = 0; i < 8; ++i) { const unsigned e = IL[(k_) * 128 + 64 * (hf_) + 8 * i + g8]; R[i] = *(const u32x4*)(Vb + (size_t)e * 128); } } while (0)
#define V_ACC(R, k_, hf_) do { float av[8]; \
                _Pragma("unroll") for (int i = 0; i < 8; ++i) av[i] = ZL[(k_) * 128 + 64 * (hf_) + 8 * i + g8]; \
                _Pragma("unroll") for (int i = 0; i < 8; ++i) { const f32x2 a2 = {av[i], av[i]}; \
                    _Pragma("unroll") for (int q = 0; q < 4; ++q) { \
                        o[4 * q] += a2 * __builtin_amdgcn_cvt_scalef32_pk_f32_fp4(R[i][q], 1.0f, 0); o[4 * q + 1] += a2 * __builtin_amdgcn_cvt_scalef32_pk_f32_fp4(R[i][q], 1.0f, 1); \
                        o[4 * q + 2] += a2 * __builtin_amdgcn_cvt_scalef32_pk_f32_fp4(R[i][q], 1.0f, 2); o[4 * q + 3] += a2 * __builtin_amdgcn_cvt_scalef32_pk_f32_fp4(R[i][q], 1.0f, 3); } } } while (0)
#define V_FINISH(k_) do { const int tok_ = base + gw + GW * (k_); \
                f32x2 q8[8]; \
                _Pragma("unroll") for (int m = 0; m < 8; ++m) { \
                    const auto s0 = __builtin_amdgcn_permlane32_swap(__float_as_uint(o[m][0]), __float_as_uint(o[m + 8][0]), false, false); \
                    const auto s1 = __builtin_amdgcn_permlane32_swap(__float_as_uint(o[m][1]), __float_as_uint(o[m + 8][1]), false, false); \
                    q8[m] = (f32x2){__uint_as_float(s0[0]) + __uint_as_float(s0[1]), __uint_as_float(s1[0]) + __uint_as_float(s1[1])}; } \
                f32x2 q4[4]; \
                _Pragma("unroll") for (int m = 0; m < 4; ++m) { \
                    const auto s0 = __builtin_amdgcn_permlane16_swap(__float_as_uint(q8[m][0]), __float_as_uint(q8[m + 4][0]), false, false); \
                    const auto s1 = __builtin_amdgcn_permlane16_swap(__float_as_uint(q8[m][1]), __float_as_uint(q8[m + 4][1]), false, false); \
                    q4[m] = (f32x2){__uint_as_float(s0[0]) + __uint_as_float(s0[1]), __uint_as_float(s1[0]) + __uint_as_float(s1[1])}; } \
                float fo[4]; \
                _Pragma("unroll") for (int m = 0; m < 2; ++m) { \
                    const float k0 = hi8 ? q4[m + 2][0] : q4[m][0], k1 = hi8 ? q4[m + 2][1] : q4[m][1], t0 = hi8 ? q4[m][0] : q4[m + 2][0], t1 = hi8 ? q4[m][1] : q4[m + 2][1]; \
                    fo[2 * m] = k0 + dpp_mov<0x128>(t0); fo[2 * m + 1] = k1 + dpp_mov<0x128>(t1); } \
                u32x2 w_; w_.x = pk_bf16(fo[0], fo[1]); w_.y = pk_bf16(fo[2], fo[3]); \
                *(u32x2*)(FFN + (size_t)tok_ * D + 256 * c4 + 32 * j + 4 * g8) = w_; } while (0)
            if (ntok > 0) V_ISSUE(rA, 0, 0);
            for (int k = 0; k < ntok; ++k) {
                V_ISSUE(rB, k, 1);
#pragma unroll
                for (int q = 0; q < 16; ++q) o[q] = (f32x2){0.f, 0.f};
                V_ACC(rA, k, 0);
                V_ISSUE(rA, ((k + 1 < ntok) ? k + 1 : k), 0);
                V_ACC(rB, k, 1);
                V_FINISH(k);
            }
#undef V_ISSUE
#undef V_ACC
#undef V_FINISH
        }
        asm volatile("s_waitcnt vmcnt(0)" ::: "memory");
        for (int k = 0; k < ntok; ++k) { const int row = base + gw + GW * k;
            float* xp = XS + (size_t)row * D + 16 * lane; const int mb = mod_batch(row); const float* m = MOD + (size_t)mb * 6144 + 16 * lane;
            const u32x4 fa = *(const u32x4*)(FFN + (size_t)row * D + 16 * lane), fb = *(const u32x4*)(FFN + (size_t)row * D + 16 * lane + 8);
            float o[16];
#pragma unroll
            for (int q = 0; q < 4; ++q) { o[2 * q] = bf_lo(fa[q]); o[2 * q + 1] = bf_hi(fa[q]); o[8 + 2 * q] = bf_lo(fb[q]); o[9 + 2 * q] = bf_hi(fb[q]); }
            float y[16]; float s = 0.f;
#pragma unroll
            for (int qd = 0; qd < 4; ++qd) { const f32x4 x1 = *(const f32x4*)(xp + 4 * qd), g2 = *(const f32x4*)(m + 5 * 1024 + 4 * qd);
#pragma unroll
                for (int e = 0; e < 4; ++e) { y[4 * qd + e] = DN_ALPHA * x1[e] + g2[e] * o[4 * qd + e]; s += y[4 * qd + e]; } }
            const float mean = wave_sum(s) * (1.0f / 1024.0f);
            float q = 0.f;
#pragma unroll
            for (int e = 0; e < 16; ++e) { const float d = y[e] - mean; q += d * d; }
            const float rstd = rsqrtf(wave_sum(q) * (1.0f / 1024.0f) + LN_EPS);
            const float* mn = (const float*)(ws + WS_MOD) + (size_t)(L + 1 < DEPTH ? L + 1 : L) * 17 * 6144 + (size_t)mb * 6144 + 16 * lane;
#pragma unroll
            for (int qd = 0; qd < 4; ++qd) { const int col = 16 * lane + 4 * qd;
                const f32x4 gg = *(const f32x4*)(lg + col), bb = *(const f32x4*)(lb + col); f32x4 x2;
#pragma unroll
                for (int e = 0; e < 4; ++e) x2[e] = (y[4 * qd + e] - mean) * rstd * gg[e] + bb[e];
                if (L == DEPTH - 1) { *(f32x4*)(p.out + (size_t)row * D + col) = x2; }
                else { *(f32x4*)(xp + 4 * qd) = x2;
                    const f32x4 h = x2 * (*(const f32x4*)(mn + 1024 + 4 * qd) + 1.0f) + *(const f32x4*)(mn + 4 * qd);
                    u32x2 w; w.x = pk_bf16(h[0], h[1]); w.y = pk_bf16(h[2], h[3]);
                    *(u32x2*)(H1 + (size_t)row * D + col) = w; } }
        }
    }
}

DI float logsig_fast(float z) { return fminf(z, 0.f) - __logf(1.0f + __expf(-fabsf(z))); }
DI void phase_gla_prep(const Ctx& c, int j) {
    const Params& p = *c.p; unsigned char* ws = c.ws; const int tid = c.tid;
    const bf16_t* QG = (const bf16_t*)(ws + WS_R1); const bf16_t* KG = (const bf16_t*)(ws + WS_R1 + SZ_T512); const bf16_t* VG = (const bf16_t*)(ws + WS_R1 + 2 * SZ_T512);
    const float* GL = (const float*)(ws + WS_GL); float* DEC = (float*)(ws + WS_DEC); bf16_t* VTt = (bf16_t*)(ws + WS_VTT);
    bf16_t* Qt = (bf16_t*)c.smem;
    bf16_t* Kt = Qt + 64 * 512;
    float* gl = (float*)(c.smem + 131072);
    for (int ch = c.bid; ch < T / 64; ch += c.G) {
        const int r0 = ch * 64;
        __syncthreads();
#pragma unroll 4
        for (int it = 0; it < 8; ++it) { const int idx = it * 512 + tid, row = idx >> 6, c8 = (idx & 63) * 8;
            *(u32x4*)(Qt + row * 512 + c8) = *(const u32x4*)(QG + (size_t)(r0 + row) * 512 + c8);
            *(u32x4*)(Kt + row * 512 + c8) = *(const u32x4*)(KG + (size_t)(r0 + row) * 512 + c8); }
        ((f32x4*)gl)[tid] = ((const f32x4*)(GL + (size_t)r0 * 32))[tid];
        __syncthreads();
#pragma unroll
        for (int dir = 0; dir < 2; ++dir) {
            float wg[16];
#pragma unroll
            for (int r = 0; r < 16; ++r) wg[r] = p.in[15][((size_t)(j * 2 + dir) * 16 + r) * 512 + tid];
            const float bias = p.in[16][(size_t)(j * 2 + dir) * 512 + tid];
            bf16_t* QIN = (bf16_t*)(ws + WS_R2) + (size_t)dir * T * 512; bf16_t* KIN = (bf16_t*)(ws + WS_R2 + SZ_T1K) + (size_t)dir * T * 512;
            bf16_t* KINt = (bf16_t*)(ws + WS_R2 + 2 * SZ_T1K) + (((size_t)dir * (T / 64) + ch) * 512 + tid) * 64;
            float cum = 0.f;
            for (int blk = 0; blk < 8; ++blk) { const int jb = dir ? 56 - 8 * blk : 8 * blk; float gs[8];
#pragma unroll
                for (int e = 0; e < 8; ++e) { const int i = jb + e; float z = bias; const f32x4* gp = (const f32x4*)(gl + i * 32 + dir * 16);
#pragma unroll
                    for (int r4 = 0; r4 < 4; ++r4) { const f32x4 gv = gp[r4]; z += gv[0] * wg[4 * r4] + gv[1] * wg[4 * r4 + 1] + gv[2] * wg[4 * r4 + 2] + gv[3] * wg[4 * r4 + 3]; }
                    gs[e] = logsig_fast(z) * (1.0f / 16.0f); }
                float kiv[8];
#pragma unroll
                for (int e = 0; e < 8; ++e) { const int pos = dir ? 7 - e : e, i = jb + pos;
                    cum += gs[pos];
                    const float qv = bf1(Qt[i * 512 + tid]), kv = bf1(Kt[i * 512 + tid]);
                    const size_t o = (size_t)(r0 + i) * 512 + tid;
                    const float ki = kv * __expf(-cum);
                    QIN[o] = f2bf(qv * __expf(cum)); KIN[o] = f2bf(ki); kiv[pos] = ki; }
                u32x4 w; w.x = pk_bf16(kiv[0], kiv[1]); w.y = pk_bf16(kiv[2], kiv[3]); w.z = pk_bf16(kiv[4], kiv[5]); w.w = pk_bf16(kiv[6], kiv[7]);
                *(u32x4*)(KINt + jb) = w; }
            DEC[((size_t)dir * (T / 64) + ch) * 512 + tid] = __expf(cum);
        }
        __syncthreads();
        bf16_t* Vl = Qt;
#pragma unroll 8
        for (int it = 0; it < 16; ++it) { const int idx = it * 512 + tid, row = idx >> 7, c8 = (idx & 127) * 8;
            *(u32x4*)(Vl + row * 1024 + c8) = *(const u32x4*)(VG + (size_t)(r0 + row) * 1024 + c8); }
        __syncthreads();
#pragma unroll
        for (int cc = 0; cc < 2; ++cc) { const int e = tid + 512 * cc; bf16_t* vp = VTt + ((size_t)ch * 1024 + e) * 64;
            for (int jb = 0; jb < 64; jb += 8) { unsigned short x[8];
#pragma unroll
                for (int t = 0; t < 8; ++t) x[t] = Vl[(jb + t) * 1024 + e];
                u32x4 w; w.x = (unsigned)x[0] | ((unsigned)x[1] << 16); w.y = (unsigned)x[2] | ((unsigned)x[3] << 16); w.z = (unsigned)x[4] | ((unsigned)x[5] << 16); w.w = (unsigned)x[6] | ((unsigned)x[7] << 16);
                *(u32x4*)(vp + jb) = w; } }
    }
}

DI void phase_gla_scan(const Ctx& c) {
    unsigned char* ws = c.ws; const int tid = c.tid, lane = c.lane, w = c.wave, g = lane >> 4, cc = lane & 15;
    const bf16_t* VTt = (const bf16_t*)(ws + WS_VTT); const float* DEC = (const float*)(ws + WS_DEC); bf16_t* O = (bf16_t*)(ws + WS_H1);
    constexpr int LDQ = 136, LDJ = 72;
    bf16_t* Qs = (bf16_t*)c.smem;
    bf16_t* Ks = Qs + 64 * LDQ;
    bf16_t* KEt = Ks + 64 * LDQ;
    bf16_t* Vt = KEt + 128 * LDJ;
    bf16_t* At = Vt + 64 * LDJ;
    bf16_t* St = At + 64 * LDJ;
    bf16_t* Ot = St + 64 * LDQ;
    float* dec = (float*)(Ot + 64 * LDJ);
    const int qtok0 = tid >> 4, qd8 = (tid & 15) * 8;
    const int ked0 = tid >> 3, kej8 = (tid & 7) * 8;
    for (int u = c.bid; u < NB * 4 * 4; u += c.G) {
        const int b = u >> 4, h = (u >> 2) & 3, es = u & 3;
        for (int dir = 0; dir < 2; ++dir) {
            const bf16_t* QIN = (const bf16_t*)(ws + WS_R2) + (size_t)dir * T * 512; const bf16_t* KIN = (const bf16_t*)(ws + WS_R2 + SZ_T1K) + (size_t)dir * T * 512;
            const bf16_t* KENDt = (const bf16_t*)(ws + WS_R2 + 2 * SZ_T1K) + (size_t)dir * (T / 64) * 512 * 64;
            f32x4 accS[4];
#pragma unroll
            for (int et = 0; et < 4; ++et) accS[et] = (f32x4){0.f, 0.f, 0.f, 0.f};
            __syncthreads();
            for (int i = tid; i < 64 * LDQ / 2; i += NTHR) ((unsigned*)St)[i] = 0u;
            u32x4 pq[2], pk[2], pke[2], pv, po; float pdec = 0.f;
            po = (u32x4){0u, 0u, 0u, 0u};
#define GLA_R0(cs_) (dir == 0 ? ((cs_) < 4 ? TL + b * CTXL + 64 * (cs_) : b * SEQ + 64 * ((cs_) - 4)) : ((cs_) < 4 ? TL + b * CTXL + 64 * (3 - (cs_)) : b * SEQ + 64 * (35 - (cs_))))
#define GLA_LOAD(cs_) do { const int r0_ = GLA_R0(cs_); const int chunk_ = r0_ >> 6; \
                _Pragma("unroll") for (int it = 0; it < 2; ++it) { const size_t go = (size_t)(r0_ + qtok0 + 32 * it) * 512 + h * 128 + qd8; pq[it] = *(const u32x4*)(QIN + go); pk[it] = *(const u32x4*)(KIN + go); \
                    pke[it] = *(const u32x4*)(KENDt + ((size_t)chunk_ * 512 + h * 128 + ked0 + 64 * it) * 64 + kej8); } \
                pv = *(const u32x4*)(VTt + ((size_t)chunk_ * 1024 + h * 256 + es * 64 + ked0) * 64 + kej8); \
                if (dir) po = *(const u32x4*)(O + (size_t)(r0_ + ked0) * 1024 + h * 256 + es * 64 + kej8); \
                if (tid < 128) pdec = DEC[((size_t)dir * (T / 64) + chunk_) * 512 + h * 128 + tid]; } while (0)
            GLA_LOAD(0);
            for (int cs = 0; cs < 36; ++cs) {
                const int r0 = GLA_R0(cs);
#pragma unroll
                for (int it = 0; it < 2; ++it) { *(u32x4*)(Qs + (qtok0 + 32 * it) * LDQ + qd8) = pq[it]; *(u32x4*)(Ks + (qtok0 + 32 * it) * LDQ + qd8) = pk[it]; *(u32x4*)(KEt + (ked0 + 64 * it) * LDJ + kej8) = pke[it]; }
                *(u32x4*)(Vt + ked0 * LDJ + kej8) = pv;
                *(u32x4*)(Ot + ked0 * LDJ + kej8) = po;
                if (tid < 128) dec[tid] = pdec;
                __syncthreads();
                if (cs + 1 < 36) GLA_LOAD(cs + 1);
                { const int it = w >> 1;
#pragma unroll
                  for (int jj = 0; jj < 2; ++jj) { const int jt = 2 * (w & 1) + jj; f32x4 a = {0.f, 0.f, 0.f, 0.f};
#pragma unroll
                      for (int ks = 0; ks < 4; ++ks) a = mfma16(frag_ld(Qs, LDQ, 16 * it, 32 * ks, lane), frag_ld(Ks, LDQ, 16 * jt, 32 * ks, lane), a);
                      const int jcol = 16 * jt + cc;
#pragma unroll
                      for (int r = 0; r < 4; ++r) { const int i = 16 * it + 4 * g + r; const bool keep = dir ? (jcol >= i) : (jcol <= i);
                          At[i * LDJ + jcol] = f2bf(keep ? a[r] : 0.f); } } }
                __syncthreads();
                { const int it = w >> 1;
#pragma unroll
                  for (int ee = 0; ee < 2; ++ee) { const int et = 2 * (w & 1) + ee; f32x4 a = {0.f, 0.f, 0.f, 0.f};
#pragma unroll
                      for (int ks = 0; ks < 2; ++ks) a = mfma16(frag_ld(At, LDJ, 16 * it, 32 * ks, lane), frag_ld(Vt, LDJ, 16 * et, 32 * ks, lane), a);
#pragma unroll
                      for (int ks = 0; ks < 4; ++ks) a = mfma16(frag_ld(Qs, LDQ, 16 * it, 32 * ks, lane), frag_ld(St, LDQ, 16 * et, 32 * ks, lane), a);
#pragma unroll
                      for (int r = 0; r < 4; ++r) { bf16_t* op = Ot + (16 * it + 4 * g + r) * LDJ + 16 * et + cc; *op = f2bf(a[r] + bf1(*op)); } } }
#pragma unroll
                for (int et = 0; et < 4; ++et) {
#pragma unroll
                    for (int ks = 0; ks < 2; ++ks) accS[et] = mfma16(frag_ld(KEt, LDJ, 16 * w, 32 * ks, lane), frag_ld(Vt, LDJ, 16 * et, 32 * ks, lane), accS[et]);
#pragma unroll
                    for (int r = 0; r < 4; ++r) accS[et][r] *= dec[16 * w + 4 * g + r];
                }
                __syncthreads();
#pragma unroll
                for (int et = 0; et < 4; ++et) { u32x2 sv; sv.x = pk_bf16(accS[et][0], accS[et][1]); sv.y = pk_bf16(accS[et][2], accS[et][3]);
                    *(u32x2*)(St + (16 * et + cc) * LDQ + 16 * w + 4 * g) = sv; }
                *(u32x4*)(O + (size_t)(r0 + ked0) * 1024 + h * 256 + es * 64 + kej8) = *(const u32x4*)(Ot + ked0 * LDJ + kej8);
            }
#undef GLA_LOAD
#undef GLA_R0
        }
    }
}

DI void phase_gla_readout(const Ctx& c, int j) {
    const Params& p = *c.p; unsigned char* ws = c.ws;
    const bf16_t* O = (const bf16_t*)(ws + WS_H1); const bf16_t* RG = (const bf16_t*)(ws + WS_R1 + 2 * SZ_T512 + SZ_T1K); bf16_t* Y = (bf16_t*)(ws + WS_R2);
    const float* gn = p.in[17] + (size_t)j * 1024;
    for (int row = c.bid * NWAVE + c.wave; row < T; row += c.G * NWAVE) {
#pragma unroll
        for (int hd = 0; hd < 4; ++hd) { const int col = 4 * c.lane + 256 * hd;
            const u32x2 ov = *(const u32x2*)(O + (size_t)row * D + col), rv = *(const u32x2*)(RG + (size_t)row * D + col);
            const float x0 = bf_lo(ov.x), x1 = bf_hi(ov.x), x2 = bf_lo(ov.y), x3 = bf_hi(ov.y);
            const float mean = wave_sum((x0 + x1) + (x2 + x3)) * (1.0f / 256.0f);
            const float d0 = x0 - mean, d1 = x1 - mean, d2 = x2 - mean, d3 = x3 - mean;
            const float rstd = rsqrtf(wave_sum((d0 * d0 + d1 * d1) + (d2 * d2 + d3 * d3)) * (1.0f / 256.0f) + LN_EPS);
            const f32x4 gg = *(const f32x4*)(gn + col);
            const float r0 = bf_lo(rv.x), r1 = bf_hi(rv.x), r2 = bf_lo(rv.y), r3 = bf_hi(rv.y);
            u32x2 o; o.x = pk_bf16(d0 * rstd * gg[0] * silu_f(r0), d1 * rstd * gg[1] * silu_f(r1)); o.y = pk_bf16(d2 * rstd * gg[2] * silu_f(r2), d3 * rstd * gg[3] * silu_f(r3));
            *(u32x2*)(Y + (size_t)row * D + col) = o; }
    }
}

constexpr int N_PHASES = 2 + 2 * 8 + 2 * 9;

__global__ void __launch_bounds__(NTHR, 2) mega_fwd(Params p) {
    extern __shared__ __attribute__((aligned(16))) unsigned char smem[];
    cg::grid_group grid = cg::this_grid();
    Ctx c; c.p = &p; c.ws = p.ws; c.smem = smem; c.tid = threadIdx.x; c.lane = c.tid & 63; c.wave = __builtin_amdgcn_readfirstlane(c.tid >> 6); c.G = gridDim.x; c.bid = blockIdx.x;
    unsigned char* ws = p.ws;
    volatile LAS unsigned* xst = (volatile LAS unsigned*)((LAS unsigned char*)smem + (LDS_BYTES - 16));
    if (threadIdx.x == 0) { xst[0] = 0u; xst[1] = 0u; }
    __syncthreads();
    const XcdBarrier xbar = xcd_barrier_post((unsigned*)(ws + WS_CTL), xst);
    const int lo = p.ph_lo, hi = p.ph_hi;
    int ph = 0;
#ifndef PH_ONLY
#define PH_ONLY -1
#endif
#ifndef DUP_MASK
#define DUP_MASK 0
#endif
#define RUN1(...) { { int t_ = threadIdx.x; asm volatile("" : "+v"(t_)); c.tid = t_; c.lane = t_ & 63; c.wave = __builtin_amdgcn_readfirstlane(t_ >> 6); { size_t z_ = 0; asm volatile("" : "+s"(z_)); ws = p.ws + z_; } c.ws = ws; } __VA_ARGS__; }
#define RUN(id, ...) do { if ((PH_ONLY < 0 || PH_ONLY == (id)) && ph >= lo && ph < hi) { \
        RUN1(__VA_ARGS__) \
        if ((DUP_MASK >> (id)) & 1) { xcd_barrier(xbar); RUN1(__VA_ARGS__) } \
        if (ph + 1 < hi) { if (ph == 0) grid.sync(); else xcd_barrier(xbar); } } ++ph; } while (0)
    LAS unsigned char* lds = (LAS unsigned char*)smem;
    const float* MOD = (const float*)(ws + WS_MOD);

    RUN(0, phase_prologue(c));
    RUN(1, phase_mod0(c));
    for (int L = 0; L < DEPTH; ++L) {
        const int j = L >> 1;
        if ((L & 1) == 0) {
            RUN(2, { pg8::Gemm g{(const bf16_t*)(ws + WS_H1), (const bf16_t*)(ws + WS_WAIN) + (size_t)j * 2048 * 1024, T, 2048, 1024}; pg8::StaticOrder S; S.init(T, 2048, c.G, c.bid);
                  pg8::EpiBf16<1> E{(bf16_t*)(ws + WS_R1), 2048}; pg8::gemm_phase(lds, g, S, E, c.tid); });
            RUN(3, phase_vstats(c));
            RUN(4, phase_spatial(c, j));
        } else {
            RUN(5, { pg8::Gemm g{(const bf16_t*)(ws + WS_H1), (const bf16_t*)(ws + WS_WBIN) + (size_t)j * WBIN_N * 1024, T, WBIN_N, 1024}; pg8::StaticOrder S; S.init(T, WBIN_N, c.G, c.bid);
                  pg8::EpiGlaProj E{(bf16_t*)(ws + WS_R1), (bf16_t*)(ws + WS_R1 + SZ_T512), (bf16_t*)(ws + WS_R1 + 2 * SZ_T512), (bf16_t*)(ws + WS_R1 + 2 * SZ_T512 + SZ_T1K), (float*)(ws + WS_GL)};
                  pg8::gemm_phase(lds, g, S, E, c.tid); });
            RUN(6, phase_gla_prep(c, j));
            RUN(7, phase_gla_scan(c));
            RUN(8, phase_gla_readout(c, j));
        }
        RUN(9, { const bf16_t* W = (L & 1) ? (const bf16_t*)(ws + WS_WBOUT) + (size_t)j * 1024 * 1024 : (const bf16_t*)(ws + WS_WAOUT) + (size_t)j * 1024 * 1024;
              pg8::Gemm g{(const bf16_t*)(ws + WS_R2), W, T, 1024, 1024}; pg8::StaticOrder S; S.init(T, 1024, c.G, c.bid);
              pg8::EpiRes E{L == 0 ? p.in[0] : (const float*)(ws + WS_XS), L == 0 ? p.in[2] : (const float*)(ws + WS_XS) + (size_t)TL * D, (float*)(ws + WS_XS), MOD + (size_t)L * 17 * 6144, 2};
              pg8::gemm_phase(lds, g, S, E, c.tid); });
        RUN(10, phase_ln1(c, L));
        RUN(11, { pg8::Gemm g{(const bf16_t*)(ws + WS_R2 + SZ_T1K), (const bf16_t*)(ws + WS_WQ) + (size_t)L * 1024 * 1024, T, 1024, 1024}; pg8::StaticOrder S; S.init(T, 1024, c.G, c.bid);
              pg8::EpiBf16<0> E{(bf16_t*)(ws + WS_R1), 1024}; pg8::gemm_phase(lds, g, S, E, c.tid); });
        RUN(12, phase_route(c, L));
        RUN(13, phase_experts(c, L));
    }
#undef RUN
}

extern "C" void kernel_launch(void* const* d_in, const int* in_sizes, int n_in, void* d_out, int out_size, void* d_ws, size_t ws_size, hipStream_t stream) {
    static int grid = 0;
    if (grid == 0) {
        if (n_in != 23 || out_size != TL * D || ws_size < WS_END) { fprintf(stderr, "kernel_launch: unexpected shapes: n_in %d out %d ws %zu (need %zu)\n", n_in, out_size, ws_size, (size_t)WS_END); grid = -1; return; }
        int dev = 0, cus = 0, per_cu = 0;
        if (hipGetDevice(&dev) != hipSuccess || hipDeviceGetAttribute(&cus, hipDeviceAttributeMultiprocessorCount, dev) != hipSuccess) { fprintf(stderr, "kernel_launch: device query failed\n"); grid = -1; return; }
        if (hipFuncSetAttribute((const void*)mega_fwd, hipFuncAttributeMaxDynamicSharedMemorySize, LDS_BYTES) != hipSuccess) { fprintf(stderr, "kernel_launch: hipFuncSetAttribute failed\n"); grid = -1; return; }
        if (hipOccupancyMaxActiveBlocksPerMultiprocessor(&per_cu, (const void*)mega_fwd, NTHR, LDS_BYTES) != hipSuccess || per_cu < 1) { fprintf(stderr, "kernel_launch: occupancy query says %d blocks per CU\n", per_cu); grid = -1; return; }
        grid = cus;
    }
    if (grid < 0) return;
    (void)hipMemsetAsync((char*)d_ws + WS_CTL, 0, 65536, stream);
    Params p{};
    for (int i = 0; i < 23; ++i) p.in[i] = (const float*)d_in[i];
    p.out = (float*)d_out; p.ws = (unsigned char*)d_ws; p.ph_lo = 0; p.ph_hi = N_PHASES;
    void* args[] = {&p};
    const hipError_t e = hipLaunchCooperativeKernel((const void*)mega_fwd, dim3(grid), dim3(NTHR), args, LDS_BYTES, stream);
    if (e != hipSuccess) fprintf(stderr, "kernel_launch: cooperative launch failed: %s (grid %d)\n", hipGetErrorString(e), grid);
}
```

```cpp
#include <hip/hip_runtime.h>
#include <hip/hip_cooperative_groups.h>
#include <cstdio>
#include <cstdint>
namespace cg = cooperative_groups;

#define LAS __attribute__((address_space(3)))
#define DI __device__ __forceinline__
typedef unsigned short bf16_t;
typedef short bf16x8 __attribute__((ext_vector_type(8)));
typedef float f32x4 __attribute__((ext_vector_type(4)));
typedef float f32x2 __attribute__((ext_vector_type(2)));
typedef unsigned u32x4 __attribute__((ext_vector_type(4)));
typedef unsigned u32x2 __attribute__((ext_vector_type(2)));
typedef __bf16 bf16v2 __attribute__((ext_vector_type(2)));

constexpr int D = 1024, NB = 16, SEQ = 2048, CTXL = 256, DEPTH = 4;
constexpr int TL = NB * SEQ, TC = NB * CTXL, T = TL + TC;
constexpr int NEXP = 16384;
constexpr float LN_EPS = 1e-5f;
constexpr float DN_ALPHA = 1.6817928305074290f;
constexpr int NTHR = 512, NWAVE = 8;
constexpr int LDS_BYTES = 140 * 1024;
constexpr int WBIN_N = 3328;

constexpr size_t al256(size_t x) { return (x + 255) & ~(size_t)255; }
constexpr size_t WS_CTL = 0;
constexpr size_t WS_MOD = 65536;
constexpr size_t WS_STATS = al256(WS_MOD + (size_t)4 * 17 * 6144 * 4);
constexpr size_t WS_GL = al256(WS_STATS + (size_t)T * 2 * 4);
constexpr size_t WS_DEC = al256(WS_GL + (size_t)T * 32 * 4);
constexpr size_t WS_WSB = al256(WS_DEC + (size_t)2 * 576 * 512 * 4);
constexpr size_t WS_WAIN = al256(WS_WSB + (size_t)2 * 8 * 128 * 128 * 2);
constexpr size_t WS_WAOUT = WS_WAIN + (size_t)2 * 2048 * 1024 * 2;
constexpr size_t WS_WBIN = WS_WAOUT + (size_t)2 * 1024 * 1024 * 2;
constexpr size_t WS_WBOUT = WS_WBIN + (size_t)2 * WBIN_N * 1024 * 2;
constexpr size_t WS_WQ = WS_WBOUT + (size_t)2 * 1024 * 1024 * 2;
constexpr size_t WS_UT = WS_WQ + (size_t)4 * 1024 * 1024 * 2;
constexpr size_t WS_VT = WS_UT + (size_t)4 * NEXP * 1024;
constexpr size_t WS_SU = WS_VT + (size_t)4 * NEXP * 1024;
constexpr size_t WS_SV = WS_SU + (size_t)4 * NEXP * 4;
constexpr size_t WS_XS = WS_SV + (size_t)4 * NEXP * 4;
constexpr size_t WS_R1 = WS_XS + (size_t)T * 1024 * 4;
constexpr size_t WS_R2 = WS_R1 + (size_t)T * 3072 * 2;
constexpr size_t WS_H1 = WS_R2 + (size_t)T * 3072 * 2;
constexpr size_t WS_VTT = WS_H1 + (size_t)T * 1024 * 2;
constexpr size_t WS_END = WS_VTT + (size_t)T * 1024 * 2;
constexpr size_t SZ_T1K = (size_t)T * 1024 * 2;
constexpr size_t SZ_T512 = (size_t)T * 512 * 2;

struct Params { const float* in[23]; float* out; unsigned char* ws; int ph_lo, ph_hi; };

DI unsigned pk_bf16(float lo, float hi) { f32x2 v = {lo, hi}; return __builtin_bit_cast(unsigned, __builtin_convertvector(v, bf16v2)); }
DI float bf_lo(unsigned w) { return __uint_as_float(w << 16); }
DI float bf_hi(unsigned w) { return __uint_as_float(w & 0xffff0000u); }
DI float bf1(bf16_t b) { return __uint_as_float(((unsigned)b) << 16); }
DI bf16_t f2bf(float f) { return (bf16_t)(pk_bf16(f, 0.f) & 0xffffu); }
DI float gelu_tanh(float x) { const float u = 0.7978845608028654f * (x + 0.044715f * x * x * x); return __fdividef(x, 1.0f + __expf(-2.0f * u)); }
DI float silu_f(float x) { return __fdividef(x, 1.0f + __expf(-x)); }
DI float logsig_f(float z) { return fminf(z, 0.f) - log1pf(expf(-fabsf(z))); }
DI float wave_sum(float v) {
#pragma unroll
    for (int o = 32; o > 0; o >>= 1) v += __shfl_xor(v, o, 64);
    return v;
}
DI float wave_max(float v) {
#pragma unroll
    for (int o = 32; o > 0; o >>= 1) v = fmaxf(v, __shfl_xor(v, o, 64));
    return v;
}
template <int CTRL> DI float dpp_mov(float x) { return __builtin_bit_cast(float, __builtin_amdgcn_mov_dpp(__builtin_bit_cast(int, x), CTRL, 0xf, 0xf, true)); }
DI float reduce4(float p0, float p1, float p2, float p3) {
    const auto a = __builtin_amdgcn_permlane32_swap(__float_as_uint(p0), __float_as_uint(p2), false, false); const float q0 = __uint_as_float(a[0]) + __uint_as_float(a[1]);
    const auto b = __builtin_amdgcn_permlane32_swap(__float_as_uint(p1), __float_as_uint(p3), false, false); const float q1 = __uint_as_float(b[0]) + __uint_as_float(b[1]);
    const auto c = __builtin_amdgcn_permlane16_swap(__float_as_uint(q0), __float_as_uint(q1), false, false); float s = __uint_as_float(c[0]) + __uint_as_float(c[1]);
    s += dpp_mov<0x128>(s); s += dpp_mov<0x124>(s); s += dpp_mov<0x122>(s); s += dpp_mov<0x121>(s);
    return s;
}
DI float dot2bf(unsigned a, unsigned b, float c) { return __builtin_amdgcn_fdot2_f32_bf16(__builtin_bit_cast(bf16v2, a), __builtin_bit_cast(bf16v2, b), c, false); }
DI f32x4 mfma16(bf16x8 a, bf16x8 b, f32x4 c) { return __builtin_amdgcn_mfma_f32_16x16x32_bf16(a, b, c, 0, 0, 0); }
DI bf16x8 frag_ld(const bf16_t* X, int ld, int row0, int k0, int lane) { return *(const bf16x8*)(X + (size_t)(row0 + (lane & 15)) * ld + k0 + 8 * (lane >> 4)); }
DI int mod_batch(int row) { return row < TL ? (row >> 11) : NB; }

#define XB_TMO      128
#define XB_XCNT(j)  (256  + 64 * (j))
#define XB_XSUB(j)  (1280 + 64 * (j))
#define XB_XGEN(j)  (2304 + 64 * (j))
#define XB_TOP      3328
#define XB_TOPGEN   3392
#define XCD_BAR_WORDS 3456
#define XB_SPIN_CAP (1u << 22)
DI unsigned xb_ld(unsigned* p)              { return __hip_atomic_load(p, __ATOMIC_RELAXED, __HIP_MEMORY_SCOPE_AGENT); }
DI unsigned xb_add(unsigned* p, unsigned v) { return __hip_atomic_fetch_add(p, v, __ATOMIC_RELAXED, __HIP_MEMORY_SCOPE_AGENT); }
DI unsigned xb_xcc_id() { return (unsigned)__builtin_amdgcn_s_getreg((3 << 11) | 20) & 0xFu; }
#define XB_SPIN(cond, bar) do { unsigned _sp = 0; while (cond) { __builtin_amdgcn_s_sleep(1); \
    if ((++_sp & 255u) == 0u) { if (xb_ld(&(bar)[XB_TMO])) break; if (_sp > XB_SPIN_CAP) { atomicAdd(&(bar)[XB_TMO], 1u); break; } } } } while (0)
struct XcdBarrier { unsigned* bar; unsigned x; volatile LAS unsigned* st; };
DI XcdBarrier xcd_barrier_post(unsigned* bar, volatile LAS unsigned* st) {
    XcdBarrier b; b.bar = bar; b.x = xb_xcc_id(); b.st = st;
    if (threadIdx.x == 0) (void)xb_add(&bar[XB_XCNT(b.x)], 1u);
    return b;
}
DI void xcd_barrier_complete(unsigned* bar, unsigned x, unsigned& nloc, unsigned& nx) {
    const unsigned G = gridDim.x * gridDim.y * gridDim.z;
    unsigned sum, cnt, mine, sp = 0u;
    for (;;) {
        sum = 0u; cnt = 0u; mine = 0u;
#pragma unroll
        for (unsigned j = 0; j < 16; ++j) { const unsigned c = xb_ld(&bar[XB_XCNT(j)]); sum += c; cnt += (c > 0u) ? 1u : 0u; mine = (j == x) ? c : mine; }
        if (sum == G) break;
        __builtin_amdgcn_s_sleep(1);
        if ((++sp & 255u) == 0u) { if (xb_ld(&bar[XB_TMO])) break; if (sp > XB_SPIN_CAP) { atomicAdd(&bar[XB_TMO], 1u); break; } }
    }
    nloc = mine > 0u ? mine : 1u; nx = cnt > 0u ? cnt : 1u;
}
DI void xcd_barrier(const XcdBarrier& b) {
    asm volatile("s_waitcnt vmcnt(0)" ::: "memory");
    __syncthreads();
    if (threadIdx.x == 0) {
        unsigned* bar = b.bar;
        __builtin_amdgcn_s_waitcnt(0);
        unsigned nloc = b.st[0], nx = b.st[1];
        if (nloc == 0u) { xcd_barrier_complete(bar, b.x, nloc, nx); b.st[0] = nloc; b.st[1] = nx; }
        const unsigned old = xb_add(&bar[XB_XSUB(b.x)], 1u);
        const unsigned gen = old / nloc;
        if (old + 1u == (gen + 1u) * nloc) {
            __builtin_amdgcn_fence(__ATOMIC_RELEASE, "agent");
            asm volatile("s_waitcnt vmcnt(0)" ::: "memory");
            const unsigned og = xb_add(&bar[XB_TOP], 1u);
            const unsigned tg = og / nx;
            if (og + 1u == (tg + 1u) * nx) xb_add(&bar[XB_TOPGEN], 1u);
            else XB_SPIN(xb_ld(&bar[XB_TOPGEN]) == tg, bar);
            __builtin_amdgcn_fence(__ATOMIC_ACQUIRE, "agent");
            xb_add(&bar[XB_XGEN(b.x)], 1u);
            asm volatile("s_waitcnt vmcnt(0)" ::: "memory");
        } else {
            XB_SPIN(xb_ld(&bar[XB_XGEN(b.x)]) == gen, bar);
            __builtin_amdgcn_fence(__ATOMIC_ACQUIRE, "agent");
            asm volatile("s_waitcnt vmcnt(0)" ::: "memory");
        }
    }
    __syncthreads();
}

namespace pg8 {
constexpr int BM = 256, BK = 64, HALF = 128, HTB = HALF * BK * 2, STAGE_BYTES = 8 * HTB, NXCD = 8, WGM = 8;
__host__ __device__ __forceinline__ int lds_byte(int r, int c) { const int st = (r >> 4) * 2 + (c >> 5), rr = r & 15, cc = c & 31, ob = rr * 64 + cc * 2; return st * 1024 + (ob ^ (((ob >> 9) & 1) << 5)); }
__host__ __device__ __forceinline__ void stage_rc(int b, int& R, int& C) { const int st = b / 1024, sb = b % 1024, swz = sb ^ (((sb >> 9) & 1) << 5); R = (st >> 1) * 16 + swz / 64; C = (st & 1) * 32 + (swz % 64) / 2; }
__host__ __device__ __forceinline__ int perm32(int rho) { const int n = rho >> 4, i = rho & 15; return 8 * (i >> 2) + 4 * n + (i & 3); }
struct Unit { int pm, pn; };
struct Gemm { const bf16_t* A; const bf16_t* Bt; int M, N, K; };
struct StaticOrder {
    int nM, nN, nwg, G, c;
    __device__ void init(int M, int N, int G_, int c_) { nM = M / BM; nN = N / BM; nwg = nM * nN; G = G_; c = c_; }
    __device__ bool next(int i, Unit& u) const {
        const long L = (long)i * G + c; if (L >= nwg) return false;
        int wgid = (int)L; { const int q = nwg / NXCD, r = nwg % NXCD, xcd = wgid % NXCD, off = wgid / NXCD; wgid = (xcd < r ? xcd * (q + 1) : r * (q + 1) + (xcd - r) * q) + off; }
        const int nig = WGM * nN, gid = wgid / nig, fm = gid * WGM, gsz = (nM - fm) < WGM ? (nM - fm) : WGM;
        u.pm = fm + ((wgid % nig) % gsz); u.pn = (wgid % nig) / gsz; return true;
    }
};

template <class Epi>
__device__ __forceinline__ void gemm_phase(LAS unsigned char* lds, const Gemm g, const StaticOrder& S, const Epi& E, const int tid) {
    const int wid = __builtin_amdgcn_readfirstlane(tid >> 6), lane = tid & 63, wr = wid >> 2, wc = wid & 3, fr = lane & 15, fq = lane >> 4;
    const int K = g.K, nt = K / BK;
    unsigned voffA[2], voffB[2];
#pragma unroll
    for (int i = 0; i < 2; ++i) { int R, C; stage_rc(tid * 16 + i * 8192, R, C); const int Rb = Epi::PERM ? ((R & ~31) + perm32(R & 31)) : R;
        voffA[i] = (unsigned)(R * K + C) * 2u; voffB[i] = (unsigned)(Rb * K + C) * 2u; }
    const size_t kstep = (size_t)(BK * 2);
    const size_t hstep = (size_t)HALF * K * 2;
    const size_t tstep = 2 * hstep;
    const unsigned ldsw = (unsigned)wid * 1024u;
    const int aoff = lds_byte(wr * 64 + fr, fq * 8), boff = lds_byte(wc * 32 + fr, fq * 8);
#define PG8_SA(b, h) (((b) * 2 + (h)) * HTB)
#define PG8_SB(b, h) ((4 + (b) * 2 + (h)) * HTB)
#define PG8_STAGE(bufoff, gbase, voff) do { _Pragma("unroll") for (int _i = 0; _i < 2; ++_i) \
        __builtin_amdgcn_global_load_lds((const unsigned*)((const char*)(gbase) + (voff)[_i]), (LAS unsigned*)(lds + (bufoff) + ldsw + _i * 8192), 16, 0, 0); } while (0)
#define PG8_LDA(dst, b, h) do { _Pragma("unroll") for (int m = 0; m < 4; ++m) _Pragma("unroll") for (int k = 0; k < 2; ++k) dst[m][k] = *(const LAS bf16x8*)(lds + PG8_SA(b, h) + aoff + m * 2048 + k * 1024); } while (0)
#define PG8_LDB(dst, b, h) do { _Pragma("unroll") for (int n = 0; n < 2; ++n) _Pragma("unroll") for (int k = 0; k < 2; ++k) dst[n][k] = *(const LAS bf16x8*)(lds + PG8_SB(b, h) + boff + n * 2048 + k * 1024); } while (0)
#define PG8_MMA(ai, bj, At, Bt) do { __builtin_amdgcn_s_setprio(1); _Pragma("unroll") for (int m = 0; m < 4; ++m) _Pragma("unroll") for (int n = 0; n < 2; ++n) _Pragma("unroll") for (int k = 0; k < 2; ++k) \
        acc[ai][bj][m][n] = __builtin_amdgcn_mfma_f32_16x16x32_bf16(Bt[n][k], At[m][k], acc[ai][bj][m][n], 0, 0, 0); __builtin_amdgcn_s_setprio(0); } while (0)
#define PG8_WAIT_V(n) asm volatile("s_waitcnt vmcnt(" #n ")" ::: "memory")
#define PG8_WAIT_L(n) asm volatile("s_waitcnt lgkmcnt(" #n ")" ::: "memory")
#define PG8_BAR __builtin_amdgcn_s_barrier()
#define PG8_SCHED __builtin_amdgcn_sched_barrier(0)
    Unit cur, nxt; int ui = 0;
    if (!S.next(0, cur)) return;
    f32x4 acc[2][2][4][2];
#pragma unroll
    for (int a = 0; a < 2; ++a)
#pragma unroll
        for (int b = 0; b < 2; ++b)
#pragma unroll
            for (int m = 0; m < 4; ++m)
#pragma unroll
                for (int n = 0; n < 2; ++n) acc[a][b][m][n] = (f32x4){0.f, 0.f, 0.f, 0.f};
    bf16x8 At[4][2], B0[2][2], B1[2][2];
    const char* cA = (const char*)g.A + (size_t)cur.pm * tstep; const char* cB = (const char*)g.Bt + (size_t)cur.pn * tstep;
    PG8_STAGE(PG8_SB(0, 0), cB, voffB); PG8_STAGE(PG8_SA(0, 0), cA, voffA); PG8_STAGE(PG8_SB(0, 1), cB + hstep, voffB); PG8_STAGE(PG8_SA(0, 1), cA + hstep, voffA);
    if (wr == 1) PG8_BAR;
    PG8_WAIT_V(4); PG8_BAR;
    PG8_STAGE(PG8_SB(1, 0), cB + kstep, voffB); PG8_STAGE(PG8_SA(1, 0), cA + kstep, voffA); PG8_STAGE(PG8_SB(1, 1), cB + hstep + kstep, voffB);
    PG8_WAIT_V(6); PG8_BAR;
    for (;;) {
        const bool has_next = S.next(ui + 1, nxt);
        const char* nA = has_next ? (const char*)g.A + (size_t)nxt.pm * tstep : cA; const char* nB = has_next ? (const char*)g.Bt + (size_t)nxt.pn * tstep : cB;
        for (int t = 0; t < nt; t += 2) {
            const bool last = (t == nt - 2);
            const char* a1 = cA + (size_t)(t + 1) * kstep;
            const char* a2 = last ? nA : cA + (size_t)(t + 2) * kstep; const char* b2 = last ? nB : cB + (size_t)(t + 2) * kstep;
            const char* a3 = a2 + kstep; const char* b3 = b2 + kstep;
            PG8_LDB(B0, 0, 0); PG8_SCHED; PG8_LDA(At, 0, 0); PG8_STAGE(PG8_SA(1, 1), a1 + hstep, voffA);
            PG8_WAIT_L(8); PG8_BAR; PG8_WAIT_L(0); PG8_MMA(0, 0, At, B0); PG8_BAR; PG8_SCHED;
            PG8_LDB(B1, 0, 1); PG8_STAGE(PG8_SB(0, 0), b2, voffB);
            PG8_BAR; PG8_WAIT_L(0); PG8_MMA(0, 1, At, B1); PG8_BAR;
            PG8_LDA(At, 0, 1); PG8_STAGE(PG8_SA(0, 0), a2, voffA);
            PG8_BAR; PG8_WAIT_L(0); PG8_MMA(1, 0, At, B0); PG8_BAR; PG8_SCHED;
            PG8_STAGE(PG8_SB(0, 1), b2 + hstep, voffB);
            PG8_WAIT_V(6); PG8_BAR; PG8_MMA(1, 1, At, B1); PG8_BAR;
            PG8_LDB(B0, 1, 0); PG8_SCHED; PG8_LDA(At, 1, 0); PG8_STAGE(PG8_SA(0, 1), a2 + hstep, voffA);
            PG8_WAIT_L(8); PG8_BAR; PG8_WAIT_L(0); PG8_MMA(0, 0, At, B0); PG8_BAR; PG8_SCHED;
            PG8_LDB(B1, 1, 1); PG8_STAGE(PG8_SB(1, 0), b3, voffB);
            PG8_BAR; PG8_WAIT_L(0); PG8_MMA(0, 1, At, B1); PG8_BAR;
            PG8_LDA(At, 1, 1); PG8_STAGE(PG8_SA(1, 0), a3, voffA);
            PG8_BAR; PG8_WAIT_L(0); PG8_MMA(1, 0, At, B0); PG8_BAR; PG8_SCHED;
            PG8_STAGE(PG8_SB(1, 1), b3 + hstep, voffB);
            PG8_WAIT_V(6); PG8_BAR; PG8_MMA(1, 1, At, B1); PG8_BAR;
        }
        E(acc, cur, wr, wc, fr, fq);
        if (!has_next) break;
#pragma unroll
        for (int a = 0; a < 2; ++a)
#pragma unroll
            for (int b = 0; b < 2; ++b)
#pragma unroll
                for (int m = 0; m < 4; ++m)
#pragma unroll
                    for (int n = 0; n < 2; ++n) acc[a][b][m][n] = (f32x4){0.f, 0.f, 0.f, 0.f};
        cur = nxt; cA = nA; cB = nB; ++ui;
    }
    PG8_WAIT_V(0);
    if (wr == 0) PG8_BAR;
    PG8_BAR;
#undef PG8_SA
#undef PG8_SB
#undef PG8_STAGE
#undef PG8_LDA
#undef PG8_LDB
#undef PG8_MMA
#undef PG8_WAIT_V
#undef PG8_WAIT_L
#undef PG8_BAR
#undef PG8_SCHED
}

template <int ACT  > struct EpiBf16 {
    static constexpr bool PERM = true;
    bf16_t* O; int ldc;
    __device__ __forceinline__ void operator()(const f32x4 (&acc)[2][2][4][2], const Unit& u, int wr, int wc, int fr, int fq) const {
        const int row0 = u.pm * BM + wr * 64 + fr, col0 = u.pn * BM + wc * 32 + 8 * fq;
#pragma unroll
        for (int ai = 0; ai < 2; ++ai)
#pragma unroll
            for (int m = 0; m < 4; ++m) { bf16_t* rowp = O + (size_t)(row0 + ai * HALF + m * 16) * ldc + col0;
#pragma unroll
                for (int bj = 0; bj < 2; ++bj) { f32x4 v0 = acc[ai][bj][m][0], v1 = acc[ai][bj][m][1];
                    if (ACT == 1) {
#pragma unroll
                        for (int j = 0; j < 4; ++j) { v0[j] = gelu_tanh(v0[j]); v1[j] = gelu_tanh(v1[j]); } }
                    u32x4 w; w.x = pk_bf16(v0[0], v0[1]); w.y = pk_bf16(v0[2], v0[3]); w.z = pk_bf16(v1[0], v1[1]); w.w = pk_bf16(v1[2], v1[3]);
                    *(u32x4*)(rowp + bj * HALF) = w; } }
    }
};
struct EpiRes {
    static constexpr bool PERM = true;
    const float* src_lat; const float* src_ctx; bf16_t* xs; const float* modL; int gate_idx; int src_f32;
    __device__ __forceinline__ void operator()(const f32x4 (&acc)[2][2][4][2], const Unit& u, int wr, int wc, int fr, int fq) const {
        const bool isctx = u.pm >= (TL / BM);
        const float* sb = isctx ? src_ctx + (size_t)(u.pm - TL / BM) * BM * D : src_lat + (size_t)u.pm * BM * D;
        const int mb = isctx ? NB : (u.pm >> 3);
        const float* gv = modL + (size_t)mb * 6144 + gate_idx * 1024;
        const int rl = wr * 64 + fr, col0 = u.pn * BM + wc * 32 + 8 * fq;
        f32x4 g[2][2];
#pragma unroll
        for (int bj = 0; bj < 2; ++bj)
#pragma unroll
            for (int n = 0; n < 2; ++n) g[bj][n] = *(const f32x4*)(gv + col0 + bj * HALF + n * 4);
#pragma unroll
        for (int ai = 0; ai < 2; ++ai)
#pragma unroll
            for (int m = 0; m < 4; ++m) { const int r = rl + ai * HALF + m * 16; bf16_t* dp = xs + ((size_t)u.pm * BM + r) * D + col0;
#pragma unroll
                for (int bj = 0; bj < 2; ++bj) { f32x4 x0, x1;
                    if (src_f32) { const float* sp = sb + (size_t)r * D + col0 + bj * HALF; x0 = *(const f32x4*)sp; x1 = *(const f32x4*)(sp + 4); }
                    else { const u32x4 xv = *(const u32x4*)(dp + bj * HALF); x0 = (f32x4){bf_lo(xv.x), bf_hi(xv.x), bf_lo(xv.y), bf_hi(xv.y)}; x1 = (f32x4){bf_lo(xv.z), bf_hi(xv.z), bf_lo(xv.w), bf_hi(xv.w)}; }
                    const f32x4 y0 = x0 * DN_ALPHA + g[bj][0] * acc[ai][bj][m][0], y1 = x1 * DN_ALPHA + g[bj][1] * acc[ai][bj][m][1];
                    u32x4 w; w.x = pk_bf16(y0[0], y0[1]); w.y = pk_bf16(y0[2], y0[3]); w.z = pk_bf16(y1[0], y1[1]); w.w = pk_bf16(y1[2], y1[3]);
                    *(u32x4*)(dp + bj * HALF) = w; } }
    }
};
struct EpiGlaProj {
    static constexpr bool PERM = true;
    bf16_t* QG; bf16_t* KG; bf16_t* VG; bf16_t* RG; float* GL;
    __device__ __forceinline__ void operator()(const f32x4 (&acc)[2][2][4][2], const Unit& u, int wr, int wc, int fr, int fq) const {
        const int row0 = u.pm * BM + wr * 64 + fr, pn = u.pn;
        if (pn < 12) {
            bf16_t* base; int ld, colt; float sc = 1.f;
            if (pn < 2) { base = QG; ld = 512; colt = pn * BM; sc = 0.08838834764831845f; }
            else if (pn < 4) { base = KG; ld = 512; colt = (pn - 2) * BM; }
            else if (pn < 8) { base = VG; ld = 1024; colt = (pn - 4) * BM; }
            else { base = RG; ld = 1024; colt = (pn - 8) * BM; }
            const int col0 = colt + wc * 32 + 8 * fq;
#pragma unroll
            for (int ai = 0; ai < 2; ++ai)
#pragma unroll
                for (int m = 0; m < 4; ++m) { bf16_t* rowp = base + (size_t)(row0 + ai * HALF + m * 16) * ld + col0;
#pragma unroll
                    for (int bj = 0; bj < 2; ++bj) { const f32x4 v0 = acc[ai][bj][m][0] * sc, v1 = acc[ai][bj][m][1] * sc;
                        u32x4 w; w.x = pk_bf16(v0[0], v0[1]); w.y = pk_bf16(v0[2], v0[3]); w.z = pk_bf16(v1[0], v1[1]); w.w = pk_bf16(v1[2], v1[3]);
                        *(u32x4*)(rowp + bj * HALF) = w; } }
        } else if (wc == 0) {
#pragma unroll
            for (int ai = 0; ai < 2; ++ai)
#pragma unroll
                for (int m = 0; m < 4; ++m) { float* gp = GL + (size_t)(row0 + ai * HALF + m * 16) * 32 + 8 * fq;
                    *(f32x4*)gp = acc[ai][0][m][0]; *(f32x4*)(gp + 4) = acc[ai][0][m][1]; }
        }
    }
};
}

struct Ctx {
    const Params* p; unsigned char* ws; unsigned char* smem; int tid, lane, wave, G, bid;
};

DI void phase_prologue(const Ctx& c) {
    const Params& p = *c.p; unsigned char* ws = c.ws;
    const int tid = c.tid;
    constexpr int N_MOD = 192, N_TR = 4736, N_WS = 64, N_TAB = 2048;
    constexpr int N_ALL = N_MOD + N_TR + N_WS + N_TAB;
    for (int u = c.bid; u < N_ALL; u += c.G) {
        if (u < N_MOD) {
            const int l = u / 48, n0 = (u % 48) * 128;
            float* sc = (float*)c.smem;
            float* red = (float*)(c.smem + 17 * 1024 * 4);
            __syncthreads();
#pragma unroll 1
            for (int hk = 0; hk < 2; ++hk) { const int k = hk * 512 + tid; float v[17];
#pragma unroll
                for (int b = 0; b < 17; ++b) v[b] = (b < NB) ? p.in[1][b * 1024 + k] : p.in[3][k];
#pragma unroll
                for (int b = 0; b < 17; ++b) sc[b * 1024 + k] = silu_f(v[b]); }
            __syncthreads();
            const int c4 = (tid & 31) * 4, kg = tid >> 5;
            float acc[17][4];
#pragma unroll
            for (int b = 0; b < 17; ++b) { acc[b][0] = 0.f; acc[b][1] = 0.f; acc[b][2] = 0.f; acc[b][3] = 0.f; }
            const float* wp = p.in[4] + ((size_t)l * 1024 + (size_t)kg * 64) * 6144 + n0 + c4;
#pragma unroll 4
            for (int kk = 0; kk < 64; ++kk) {
                const f32x4 w = *(const f32x4*)(wp + (size_t)kk * 6144);
                const int k = kg * 64 + kk;
#pragma unroll
                for (int b = 0; b < 17; ++b) { const float s = sc[b * 1024 + k]; acc[b][0] += s * w[0]; acc[b][1] += s * w[1]; acc[b][2] += s * w[2]; acc[b][3] += s * w[3]; }
            }
#pragma unroll
            for (int b = 0; b < 17; ++b)
#pragma unroll
                for (int j = 0; j < 4; ++j) acc[b][j] += __shfl_xor(acc[b][j], 32, 64);
            if ((tid & 32) == 0) {
#pragma unroll
                for (int b = 0; b < 17; ++b)
#pragma unroll
                    for (int j = 0; j < 4; ++j) red[(c.wave * 17 + b) * 128 + c4 + j] = acc[b][j];
            }
            __syncthreads();
            for (int o = tid; o < 17 * 128; o += NTHR) { const int b = o >> 7, n = o & 127; float s = 0.f;
#pragma unroll
                for (int w = 0; w < 8; ++w) s += red[(w * 17 + b) * 128 + n];
                ((float*)(ws + WS_MOD))[((size_t)l * 17 + b) * 6144 + n0 + n] = s + p.in[5][l * 6144 + n0 + n]; }
        } else if (u < N_MOD + N_TR) {
            int v = u - N_MOD; const float* src; bf16_t* dst; int N, Npad;
            if (v < 1024) { const int j = v / 512; v %= 512; src = p.in[8] + (size_t)j * 1024 * 2048; dst = (bf16_t*)(ws + WS_WAIN) + (size_t)j * 2048 * 1024; N = 2048; Npad = 2048; }
            else if (v < 1536) { v -= 1024; const int j = v / 256; v %= 256; src = p.in[13] + (size_t)j * 1024 * 1024; dst = (bf16_t*)(ws + WS_WAOUT) + (size_t)j * 1024 * 1024; N = 1024; Npad = 1024; }
            else if (v < 3200) { v -= 1536; const int j = v / 832; v %= 832; src = p.in[14] + (size_t)j * 1024 * 3104; dst = (bf16_t*)(ws + WS_WBIN) + (size_t)j * WBIN_N * 1024; N = 3104; Npad = WBIN_N; }
            else if (v < 3712) { v -= 3200; const int j = v / 256; v %= 256; src = p.in[18] + (size_t)j * 1024 * 1024; dst = (bf16_t*)(ws + WS_WBOUT) + (size_t)j * 1024 * 1024; N = 1024; Npad = 1024; }
            else { v -= 3712; const int j = v / 256; v %= 256; src = p.in[19] + (size_t)j * 1024 * 1024; dst = (bf16_t*)(ws + WS_WQ) + (size_t)j * 1024 * 1024; N = 1024; Npad = 1024; }
            (void)Npad;
            const int ntn = v >> 4, ktile = v & 15, n0 = ntn * 64, k0 = ktile * 64;
            float* tl = (float*)c.smem;
            __syncthreads();
#pragma unroll
            for (int i = 0; i < 2; ++i) { const int kk = (tid >> 4) + 32 * i, nn = (tid & 15) * 4;
                f32x4 x = {0.f, 0.f, 0.f, 0.f};
                if (n0 + nn < N) x = *(const f32x4*)(src + (size_t)(k0 + kk) * N + n0 + nn);
                tl[kk * 65 + nn] = x[0]; tl[kk * 65 + nn + 1] = x[1]; tl[kk * 65 + nn + 2] = x[2]; tl[kk * 65 + nn + 3] = x[3]; }
            __syncthreads();
            { const int nn = tid >> 3, kk8 = (tid & 7) * 8; float x[8];
#pragma unroll
              for (int j = 0; j < 8; ++j) x[j] = tl[(kk8 + j) * 65 + nn];
              u32x4 w; w.x = pk_bf16(x[0], x[1]); w.y = pk_bf16(x[2], x[3]); w.z = pk_bf16(x[4], x[5]); w.w = pk_bf16(x[6], x[7]);
              *(u32x4*)(dst + (size_t)(n0 + nn) * 1024 + k0 + kk8) = w; }
        } else if (u < N_MOD + N_TR + N_WS) {
            const int v = u - N_MOD - N_TR; const size_t e = (size_t)v * 4096 + (size_t)tid * 8;
            const f32x4 a = *(const f32x4*)(p.in[11] + e), b = *(const f32x4*)(p.in[11] + e + 4);
            u32x4 w; w.x = pk_bf16(a[0], a[1]); w.y = pk_bf16(a[2], a[3]); w.z = pk_bf16(b[0], b[1]); w.w = pk_bf16(b[2], b[3]);
            *(u32x4*)((bf16_t*)(ws + WS_WSB) + e) = w;
        } else {
            const int v = u - N_MOD - N_TR - N_WS; const int tab = v >> 10;
            const float* src = p.in[21 + tab]; unsigned char* dst = ws + (tab ? WS_VT : WS_UT); float* sc = (float*)(ws + (tab ? WS_SV : WS_SU));
#pragma unroll 2
            for (int i = 0; i < 8; ++i) { const size_t row = (size_t)(v & 1023) * 64 + c.wave * 8 + i;
                const float* rp = src + row * 1024 + 16 * c.lane; f32x4 x[4]; float am = 0.f;
#pragma unroll
                for (int q = 0; q < 4; ++q) { x[q] = __builtin_nontemporal_load((const f32x4*)(rp + 4 * q)); am = fmaxf(am, fmaxf(fmaxf(fabsf(x[q][0]), fabsf(x[q][1])), fmaxf(fabsf(x[q][2]), fabsf(x[q][3])))); }
                am = fmaxf(wave_max(am), 1e-30f);
                const size_t Lr = row >> 14, er = row & 16383;
                if (tab == 0) {
                    const float inv = 440.0f / am; u32x4 w;
#pragma unroll
                    for (int q = 0; q < 4; ++q) { int t = 0; t = __builtin_amdgcn_cvt_pk_fp8_f32(x[q][0] * inv, x[q][1] * inv, t, false); t = __builtin_amdgcn_cvt_pk_fp8_f32(x[q][2] * inv, x[q][3] * inv, t, true); w[q] = (unsigned)t; }
                    *(u32x4*)(dst + ((Lr * 8 + (c.lane >> 3)) * NEXP + er) * 128 + 16 * (c.lane & 7)) = w;
                    if (c.lane == 0) sc[row] = am * (1.0f / 440.0f);
                } else {
                    const float inv = 6.0f / am; u32x2 w;
#pragma unroll
                    for (int hq = 0; hq < 2; ++hq) { unsigned t = 0;
                        t = __builtin_amdgcn_cvt_scalef32_pk_fp4_f32(t, x[2 * hq][0] * inv, x[2 * hq][1] * inv, 1.0f, 0); t = __builtin_amdgcn_cvt_scalef32_pk_fp4_f32(t, x[2 * hq][2] * inv, x[2 * hq][3] * inv, 1.0f, 1);
                        t = __builtin_amdgcn_cvt_scalef32_pk_fp4_f32(t, x[2 * hq + 1][0] * inv, x[2 * hq + 1][1] * inv, 1.0f, 2); t = __builtin_amdgcn_cvt_scalef32_pk_fp4_f32(t, x[2 * hq + 1][2] * inv, x[2 * hq + 1][3] * inv, 1.0f, 3);
                        w[hq] = t; }
                    *(u32x2*)(dst + ((Lr * 4 + (c.lane >> 4)) * NEXP + er) * 128 + 8 * (c.lane & 15)) = w;
                    if (c.lane == 0) sc[row] = am * (1.0f / 6.0f);
                } }
        }
    }
}

DI void phase_mod0(const Ctx& c) {
    const Params& p = *c.p; const float* MOD = (const float*)(c.ws + WS_MOD); bf16_t* H1 = (bf16_t*)(c.ws + WS_H1);
    for (int row = c.bid * NWAVE + c.wave; row < T; row += c.G * NWAVE) {
        const float* src = row < TL ? p.in[0] + (size_t)row * D : p.in[2] + (size_t)(row - TL) * D;
        const float* m = MOD + (size_t)mod_batch(row) * 6144;
#pragma unroll
        for (int j = 0; j < 4; ++j) { const int col = 4 * c.lane + 256 * j;
            const f32x4 x = *(const f32x4*)(src + col), sh = *(const f32x4*)(m + col), s = *(const f32x4*)(m + 1024 + col);
            const f32x4 h = x * (s + 1.0f) + sh; u32x2 w; w.x = pk_bf16(h[0], h[1]); w.y = pk_bf16(h[2], h[3]);
            *(u32x2*)(H1 + (size_t)row * D + col) = w; }
    }
}

DI void phase_vstats(const Ctx& c) {
    const bf16_t* UV = (const bf16_t*)(c.ws + WS_R1); float* ST = (float*)(c.ws + WS_STATS);
    for (int row = c.bid * NWAVE + c.wave; row < T; row += c.G * NWAVE) {
        const bf16_t* vp = UV + (size_t)row * 2048 + 1024;
        const u32x4 a = *(const u32x4*)(vp + 8 * c.lane), b = *(const u32x4*)(vp + 512 + 8 * c.lane);
        float x[16];
#pragma unroll
        for (int j = 0; j < 4; ++j) { x[2 * j] = bf_lo(a[j]); x[2 * j + 1] = bf_hi(a[j]); x[8 + 2 * j] = bf_lo(b[j]); x[9 + 2 * j] = bf_hi(b[j]); }
        float s = 0.f;
#pragma unroll
        for (int j = 0; j < 16; ++j) s += x[j];
        const float mean = wave_sum(s) * (1.0f / 1024.0f);
        float q = 0.f;
#pragma unroll
        for (int j = 0; j < 16; ++j) { const float d = x[j] - mean; q += d * d; }
        const float var = wave_sum(q) * (1.0f / 1024.0f);
        if (c.lane == 0) { ST[2 * row] = mean; ST[2 * row + 1] = rsqrtf(var + LN_EPS); }
    }
}

DI void phase_spatial(const Ctx& c, int j) {
    const Params& p = *c.p; unsigned char* ws = c.ws;
    const bf16_t* UV = (const bf16_t*)(ws + WS_R1); const float* ST = (const float*)(ws + WS_STATS); bf16_t* Y = (bf16_t*)(ws + WS_R2);
    const bf16_t* WSB = (const bf16_t*)(ws + WS_WSB) + (size_t)j * 8 * 128 * 128;
    const float* ng = p.in[9] + j * 1024; const float* nb = p.in[10] + j * 1024; const float* bs = p.in[12] + j * 8 * 128;
    constexpr int LD = 136;
    bf16_t* WsL = (bf16_t*)c.smem;
    bf16_t* VnT = WsL + 128 * LD;
    const int tid = c.tid, lane = c.lane, w = c.wave, g = lane >> 4, cc = lane & 15;
    for (int u = c.bid; u < (T / 128) * 8; u += c.G) {
        const int chunk = u >> 3, h = u & 7, r0 = chunk * 128;
        __syncthreads();
        { const int cg8 = tid & 15; float gg[8], bb[8];
#pragma unroll
          for (int e = 0; e < 8; ++e) { gg[e] = ng[h * 128 + cg8 * 8 + e]; bb[e] = nb[h * 128 + cg8 * 8 + e]; }
#pragma unroll
          for (int i = 0; i < 4; ++i) { const int idx = i * 512 + tid, tok = idx >> 4;
              const u32x4 v = *(const u32x4*)(UV + (size_t)(r0 + tok) * 2048 + 1024 + h * 128 + cg8 * 8);
              const float mean = ST[2 * (r0 + tok)], rstd = ST[2 * (r0 + tok) + 1];
              float x[8];
#pragma unroll
              for (int e = 0; e < 4; ++e) { x[2 * e] = bf_lo(v[e]); x[2 * e + 1] = bf_hi(v[e]); }
#pragma unroll
              for (int e = 0; e < 8; ++e) VnT[(cg8 * 8 + e) * LD + tok] = f2bf((x[e] - mean) * rstd * gg[e] + bb[e]);
              const int pp = idx >> 4;
              *(u32x4*)(WsL + pp * LD + cg8 * 8) = *(const u32x4*)(WSB + ((size_t)h * 128 + pp) * 128 + cg8 * 8); } }
        __syncthreads();
        f32x4 acc[8];
#pragma unroll
        for (int ct = 0; ct < 8; ++ct) acc[ct] = (f32x4){0.f, 0.f, 0.f, 0.f};
#pragma unroll
        for (int ks = 0; ks < 4; ++ks) {
            const bf16x8 bfr = frag_ld(WsL, LD, 16 * w, 32 * ks, lane);
#pragma unroll
            for (int ct = 0; ct < 8; ++ct) acc[ct] = mfma16(frag_ld(VnT, LD, 16 * ct, 32 * ks, lane), bfr, acc[ct]);
        }
        const int pp = 16 * w + cc; const float bsv = bs[h * 128 + pp];
        const size_t rowo = (size_t)(r0 + pp);
#pragma unroll
        for (int ct = 0; ct < 8; ++ct) { const int ch = h * 128 + 16 * ct + 4 * g;
            const u32x2 uu = *(const u32x2*)(UV + rowo * 2048 + ch);
            const float y0 = bf_lo(uu.x) * (acc[ct][0] + bsv), y1 = bf_hi(uu.x) * (acc[ct][1] + bsv), y2 = bf_lo(uu.y) * (acc[ct][2] + bsv), y3 = bf_hi(uu.y) * (acc[ct][3] + bsv);
            u32x2 o; o.x = pk_bf16(y0, y1); o.y = pk_bf16(y2, y3);
            *(u32x2*)(Y + rowo * D + ch) = o; }
    }
}

DI void phase_ln1(const Ctx& c, int L) {
    const Params& p = *c.p; bf16_t* XS = (bf16_t*)(c.ws + WS_XS); const float* MOD = (const float*)(c.ws + WS_MOD) + (size_t)L * 17 * 6144;
    bf16_t* H2 = (bf16_t*)(c.ws + WS_R2 + SZ_T1K);
    const float* lg = p.in[6] + (size_t)(L * 2 + 0) * D; const float* lb = p.in[7] + (size_t)(L * 2 + 0) * D;
    const int nrows = (L == DEPTH - 1) ? TL : T;
    for (int row = c.bid * NWAVE + c.wave; row < nrows; row += c.G * NWAVE) {
        bf16_t* xp = XS + (size_t)row * D; const float* m = MOD + (size_t)mod_batch(row) * 6144;
        f32x4 x[4]; float s = 0.f;
#pragma unroll
        for (int j = 0; j < 4; ++j) { const u32x2 v = *(const u32x2*)(xp + 4 * c.lane + 256 * j); x[j] = (f32x4){bf_lo(v.x), bf_hi(v.x), bf_lo(v.y), bf_hi(v.y)}; s += (x[j][0] + x[j][1]) + (x[j][2] + x[j][3]); }
        const float mean = wave_sum(s) * (1.0f / 1024.0f);
        float q = 0.f;
#pragma unroll
        for (int j = 0; j < 4; ++j) { const f32x4 d = x[j] - mean; q += (d[0] * d[0] + d[1] * d[1]) + (d[2] * d[2] + d[3] * d[3]); }
        const float rstd = rsqrtf(wave_sum(q) * (1.0f / 1024.0f) + LN_EPS);
#pragma unroll
        for (int j = 0; j < 4; ++j) { const int col = 4 * c.lane + 256 * j;
            const f32x4 y = (x[j] - mean) * rstd * *(const f32x4*)(lg + col) + *(const f32x4*)(lb + col);
            u32x2 xw; xw.x = pk_bf16(y[0], y[1]); xw.y = pk_bf16(y[2], y[3]);
            *(u32x2*)(xp + col) = xw;
            const f32x4 h = y * (*(const f32x4*)(m + 4 * 1024 + col) + 1.0f) + *(const f32x4*)(m + 3 * 1024 + col);
            u32x2 w; w.x = pk_bf16(h[0], h[1]); w.y = pk_bf16(h[2], h[3]);
            *(u32x2*)(H2 + (size_t)row * D + col) = w; }
    }
}

DI int f2key(float v) { const int i = __float_as_int(v); return i ^ ((i >> 31) & 0x7fffffff); }
DI float key2f(int k) { return __int_as_float(k ^ ((k >> 31) & 0x7fffffff)); }
DI void phase_route(const Ctx& c, int L) {
    const Params& p = *c.p; unsigned char* ws = c.ws; const int lane = c.lane, g = lane >> 4, cc = lane & 15;
    constexpr int LDK = 72, LDS_S = 20;
    bf16_t* keysHi = (bf16_t*)c.smem;
    bf16_t* keysLo = keysHi + 2 * 128 * LDK;
    float* sbase = (float*)(keysLo + 2 * 128 * LDK);
    unsigned* ilist = (unsigned*)(sbase + NWAVE * 64 * LDS_S);
    __syncthreads();
    { const float* gk = p.in[20] + (size_t)L * 2 * 128 * 64;
      f32x4 kv[8];
#pragma unroll
      for (int it = 0; it < 8; ++it) kv[it] = ((const f32x4*)gk)[it * NTHR + c.tid];
#pragma unroll
      for (int it = 0; it < 8; ++it) { const int i = (it * NTHR + c.tid) * 4, row = i >> 6, d = i & 63; unsigned hi[2], lo[2];
#pragma unroll
          for (int e = 0; e < 2; ++e) { const unsigned ph = pk_bf16(kv[it][2 * e], kv[it][2 * e + 1]); hi[e] = ph; lo[e] = pk_bf16(kv[it][2 * e] - bf_lo(ph), kv[it][2 * e + 1] - bf_hi(ph)); }
          *(u32x2*)(keysHi + row * LDK + d) = (u32x2){hi[0], hi[1]}; *(u32x2*)(keysLo + row * LDK + d) = (u32x2){lo[0], lo[1]}; } }
    __syncthreads();
    float* S = sbase + c.wave * 64 * LDS_S;
    const bf16_t* QP = (const bf16_t*)(ws + WS_R1); int* IDX = (int*)(ws + WS_R1 + SZ_T1K); float* WT = (float*)(ws + WS_R1 + SZ_T1K + (size_t)T * 128 * 4);
    unsigned* myl = ilist + c.tid * 8; const unsigned char* mylb = (const unsigned char*)myl;
    const int ntask = (((L == DEPTH - 1) ? TL : T) / 64) * 8;
    for (int task = c.bid * NWAVE + c.wave; task < ntask; task += c.G * NWAVE) {
        const int t0 = (task >> 3) * 64, h = task & 7, tok = t0 + lane;
        float t12[2][16];
#pragma unroll
        for (int half = 0; half < 2; ++half) {
            bf16x8 aq[4][2];
#pragma unroll
            for (int mt = 0; mt < 4; ++mt)
#pragma unroll
                for (int ks = 0; ks < 2; ++ks) aq[mt][ks] = *(const bf16x8*)(QP + (size_t)(t0 + 16 * mt + cc) * D + h * 128 + half * 64 + 32 * ks + 8 * g);
            const bf16_t* kh = keysHi + half * 128 * LDK; const bf16_t* kl = keysLo + half * 128 * LDK;
#pragma unroll
            for (int i = 0; i < 16; ++i) t12[half][i] = -3.0e38f;
            for (int nt = 0; nt < 8; ++nt) {
                const bf16x8 bh0 = frag_ld(kh, LDK, 16 * nt, 0, lane), bh1 = frag_ld(kh, LDK, 16 * nt, 32, lane), bl0 = frag_ld(kl, LDK, 16 * nt, 0, lane), bl1 = frag_ld(kl, LDK, 16 * nt, 32, lane);
#pragma unroll
                for (int mt = 0; mt < 4; ++mt) { f32x4 a = {0.f, 0.f, 0.f, 0.f};
                    a = mfma16(aq[mt][0], bl0, a); a = mfma16(aq[mt][1], bl1, a); a = mfma16(aq[mt][0], bh0, a); a = mfma16(aq[mt][1], bh1, a);
#pragma unroll
                    for (int r = 0; r < 4; ++r) S[(16 * mt + 4 * g + r) * LDS_S + cc] = a[r]; }
                f32x4 sc[4];
#pragma unroll
                for (int q4 = 0; q4 < 4; ++q4) sc[q4] = *(const f32x4*)(S + lane * LDS_S + 4 * q4);
#pragma unroll
                for (int kk = 0; kk < 16; ++kk) { const float key = __int_as_float((__float_as_int(sc[kk >> 2][kk & 3]) & ~127) | (127 - (16 * nt + kk)));
#pragma unroll
                    for (int i = 15; i >= 1; --i) t12[half][i] = __builtin_amdgcn_fmed3f(key, t12[half][i - 1], t12[half][i]);
                    t12[half][0] = __builtin_amdgcn_fmed3f(key, 3.0e38f, t12[half][0]); }
            }
        }
        float v1[16], v2[16];
#pragma unroll
        for (int i = 0; i < 16; ++i) { v1[i] = __int_as_float(__float_as_int(t12[0][i]) & ~127); v2[i] = __int_as_float(__float_as_int(t12[1][i]) & ~127); }
#pragma unroll
        for (int i = 0; i < 4; ++i) {
            myl[i] = (unsigned)(127 - (__float_as_int(t12[0][4 * i]) & 127)) | ((unsigned)(127 - (__float_as_int(t12[0][4 * i + 1]) & 127)) << 8) | ((unsigned)(127 - (__float_as_int(t12[0][4 * i + 2]) & 127)) << 16) | ((unsigned)(127 - (__float_as_int(t12[0][4 * i + 3]) & 127)) << 24);
            myl[4 + i] = (unsigned)(127 - (__float_as_int(t12[1][4 * i]) & 127)) | ((unsigned)(127 - (__float_as_int(t12[1][4 * i + 1]) & 127)) << 8) | ((unsigned)(127 - (__float_as_int(t12[1][4 * i + 2]) & 127)) << 16) | ((unsigned)(127 - (__float_as_int(t12[1][4 * i + 3]) & 127)) << 24); }
        float f[16];
#pragma unroll
        for (int i = 0; i < 16; ++i) f[i] = -3.0e38f;
#pragma unroll
        for (int a = 0; a < 16; ++a)
#pragma unroll
            for (int b = 0; b < 16; ++b)
                if ((a + 1) * (b + 1) <= 16) {
                    const float key = __int_as_float((__float_as_int(v1[a] + v2[b]) & ~255) | (255 - (a * 16 + b)));
#pragma unroll
                    for (int i = 15; i >= 1; --i) f[i] = __builtin_amdgcn_fmed3f(key, f[i - 1], f[i]);
                    f[0] = __builtin_amdgcn_fmed3f(key, 3.0e38f, f[0]);
                }
        float e[16], se = 0.f; int fi[16];
        const float vmax = __int_as_float(__float_as_int(f[0]) & ~255);
#pragma unroll
        for (int i = 0; i < 16; ++i) { const int code = 255 - (__float_as_int(f[i]) & 255); fi[i] = (int)mylb[code >> 4] * 128 + (int)mylb[16 + (code & 15)];
            e[i] = __expf(__int_as_float(__float_as_int(f[i]) & ~255) - vmax); se += e[i]; }
        const float inv = 1.0f / se;
        int* ip = IDX + (size_t)tok * 128 + h * 16; float* wp = WT + (size_t)tok * 128 + h * 16;
#pragma unroll
        for (int i = 0; i < 16; i += 4) { *(int4*)(ip + i) = make_int4(fi[i], fi[i + 1], fi[i + 2], fi[i + 3]); *(f32x4*)(wp + i) = (f32x4){e[i] * inv, e[i + 1] * inv, e[i + 2] * inv, e[i + 3] * inv}; }
    }
}

DI float red8(float p) { p += dpp_mov<0xB1>(p); p += dpp_mov<0x4E>(p); p += dpp_mov<0x141>(p); return p; }
DI void phase_experts(const Ctx& c, int L) {
    const Params& p = *c.p; unsigned char* ws = c.ws; const int lane = c.lane, g8 = lane >> 3, j = lane & 7;
    constexpr int MAXTOK = 18;
    const bf16_t* H2 = (const bf16_t*)(ws + WS_R2 + SZ_T1K);
    const int* IDX = (const int*)(ws + WS_R1 + SZ_T1K); const float* WT = (const float*)(ws + WS_R1 + SZ_T1K + (size_t)T * 128 * 4);
    bf16_t* FFN = (bf16_t*)(ws + WS_R1);
    const unsigned char* UT = ws + WS_UT + (size_t)L * NEXP * 1024; const unsigned char* VT = ws + WS_VT + (size_t)L * NEXP * 512;
    const float* SU = (const float*)(ws + WS_SU) + (size_t)L * NEXP; const float* SV = (const float*)(ws + WS_SV) + (size_t)L * NEXP;
    bf16_t* XS = (bf16_t*)(ws + WS_XS); bf16_t* H1 = (bf16_t*)(ws + WS_H1);
    const float* MOD = (const float*)(ws + WS_MOD) + (size_t)L * 17 * 6144;
    const float* lg = p.in[6] + (size_t)(L * 2 + 1) * D; const float* lb = p.in[7] + (size_t)(L * 2 + 1) * D;
    const int nrows = (L == DEPTH - 1) ? TL : T;
    float* ZL = (float*)c.smem + c.wave * MAXTOK * 128;
    unsigned short* IL = (unsigned short*)(c.smem + NWAVE * MAXTOK * 128 * 4) + c.wave * MAXTOK * 128;
    const int GW = c.G * NWAVE, gw = c.bid * NWAVE + c.wave;
    const int tsrc = 8 * (lane & 7) + (lane >> 3);
    for (int base = 0; base < nrows; base += GW * MAXTOK) {
        int ntok = 0;
        for (int k = 0; k < MAXTOK; ++k) { const int tok = base + gw + GW * k; if (tok < nrows) { ntok = k + 1;
            IL[k * 128 + lane] = (unsigned short)IDX[(size_t)tok * 128 + lane]; IL[k * 128 + 64 + lane] = (unsigned short)IDX[(size_t)tok * 128 + 64 + lane]; } }
        for (int c8 = 0; c8 < 8; ++c8) {
            const unsigned char* Ub = UT + (size_t)c8 * NEXP * 128 + 16 * j;
            const bf16_t* Xb = H2 + 128 * c8 + 16 * j;
            u32x4 rA[8], rB[8], xA[2], xB[2];
#define U_ISSUE(R, X, k_, hf_) do { const int tok_ = base + gw + GW * (k_); X[0] = *(const u32x4*)(Xb + (size_t)tok_ * D); X[1] = *(const u32x4*)(Xb + (size_t)tok_ * D + 8); \
                _Pragma("unroll") for (int i = 0; i < 8; ++i) { const unsigned e = IL[(k_) * 128 + 64 * (hf_) + 8 * i + g8]; R[i] = *(const u32x4*)(Ub + (size_t)e * 128); } } while (0)
#define U_COMPUTE(R, X, k_, hf_) do { f32x2 xf[8]; \
                _Pragma("unroll") for (int q = 0; q < 4; ++q) { xf[q] = (f32x2){bf_lo(X[0][q]), bf_hi(X[0][q])}; xf[4 + q] = (f32x2){bf_lo(X[1][q]), bf_hi(X[1][q])}; } \
                float ra = 0.f; \
                _Pragma("unroll") for (int i = 0; i < 8; ++i) { f32x2 acc = {0.f, 0.f}; \
                    _Pragma("unroll") for (int q = 0; q < 4; ++q) { acc += __builtin_amdgcn_cvt_pk_f32_fp8((int)R[i][q], false) * xf[2 * q]; acc += __builtin_amdgcn_cvt_pk_f32_fp8((int)R[i][q], true) * xf[2 * q + 1]; } \
                    const float pr = red8(acc[0] + acc[1]); ra = (j == i) ? pr : ra; } \
                const float za = __shfl(ra, tsrc, 64); \
                if (c8 == 0) ZL[(k_) * 128 + 64 * (hf_) + lane] = za; else ZL[(k_) * 128 + 64 * (hf_) + lane] += za; } while (0)
            if (ntok > 0) U_ISSUE(rA, xA, 0, 0);
            for (int k = 0; k < ntok; ++k) {
                const int kn = (k + 1 < ntok) ? k + 1 : k;
                U_ISSUE(rB, xB, k, 1);
                U_COMPUTE(rA, xA, k, 0);
                U_ISSUE(rA, xA, kn, 0);
                U_COMPUTE(rB, xB, k, 1);
            }
#undef U_ISSUE
#undef U_COMPUTE
        }
        for (int k = 0; k < ntok; ++k) { const int tok = base + gw + GW * k;
#pragma unroll
            for (int hh = 0; hh < 2; ++hh) { const unsigned e = IL[k * 128 + 64 * hh + lane]; const float wv = WT[(size_t)tok * 128 + 64 * hh + lane];
                ZL[k * 128 + 64 * hh + lane] = gelu_tanh(ZL[k * 128 + 64 * hh + lane] * SU[e]) * wv * SV[e]; } }
        for (int c4 = 0; c4 < 4; ++c4) {
            const unsigned char* Vb = VT + (size_t)c4 * NEXP * 128 + 16 * j;
            const bool hi8 = (lane & 8) != 0;
            u32x4 rA[8], rB[8];
            f32x2 o[16];
#define V_ISSUE(R, k_, hf_) do { _Pragma("unroll") for (int i = 0; i < 8; ++i) { const unsigned e = IL[(k_) * 128 + 64 * (hf_) + 8 * i + g8]; R[i] = *(const u32x4*)(Vb + (size_t)e * 128); } } while (0)
#define V_ACC(R, k_, hf_) do { float av[8]; \
                _Pragma("unroll") for (int i = 0; i < 8; ++i) av[i] = ZL[(k_) * 128 + 64 * (hf_) + 8 * i + g8]; \
                _Pragma("unroll") for (int i = 0; i < 8; ++i) { const f32x2 a2 = {av[i], av[i]}; \
                    _Pragma("unroll") for (int q = 0; q < 4; ++q) { \
                        o[4 * q] += a2 * __builtin_amdgcn_cvt_scalef32_pk_f32_fp4(R[i][q], 1.0f, 0); o[4 * q + 1] += a2 * __builtin_amdgcn_cvt_scalef32_pk_f32_fp4(R[i][q], 1.0f, 1); \
                        o[4 * q + 2] += a2 * __builtin_amdgcn_cvt_scalef32_pk_f32_fp4(R[i][q], 1.0f, 2); o[4 * q + 3] += a2 * __builtin_amdgcn_cvt_scalef32_pk_f32_fp4(R[i][q], 1.0f, 3); } } } while (0)
#define V_FINISH(k_) do { const int tok_ = base + gw + GW * (k_); \
                f32x2 q8[8]; \
                _Pragma("unroll") for (int m = 0; m < 8; ++m) { \
                    const auto s0 = __builtin_amdgcn_permlane32_swap(__float_as_uint(o[m][0]), __float_as_uint(o[m + 8][0]), false, false); \
                    const auto s1 = __builtin_amdgcn_permlane32_swap(__float_as_uint(o[m][1]), __float_as_uint(o[m + 8][1]), false, false); \
                    q8[m] = (f32x2){__uint_as_float(s0[0]) + __uint_as_float(s0[1]), __uint_as_float(s1[0]) + __uint_as_float(s1[1])}; } \
                f32x2 q4[4]; \
                _Pragma("unroll") for (int m = 0; m < 4; ++m) { \
                    const auto s0 = __builtin_amdgcn_permlane16_swap(__float_as_uint(q8[m][0]), __float_as_uint(q8[m + 4][0]), false, false); \
                    const auto s1 = __builtin_amdgcn_permlane16_swap(__float_as_uint(q8[m][1]), __float_as_uint(q8[m + 4][1]), false, false); \
                    q4[m] = (f32x2){__uint_as_float(s0[0]) + __uint_as_float(s0[1]), __uint_as_float(s1[0]) + __uint_as_float(s1[1])}; } \
                float fo[4]; \
                _Pragma("unroll") for (int m = 0; m < 2; ++m) { \
                    const float k0 = hi8 ? q4[m + 2][0] : q4[m][0], k1 = hi8 ? q4[m + 2][1] : q4[m][1], t0 = hi8 ? q4[m][0] : q4[m + 2][0], t1 = hi8 ? q4[m][1] : q4[m + 2][1]; \
                    fo[2 * m] = k0 + dpp_mov<0x128>(t0); fo[2 * m + 1] = k1 + dpp_mov<0x128>(t1); } \
                u32x2 w_; w_.x = pk_bf16(fo[0], fo[1]); w_.y = pk_bf16(fo[2], fo[3]); \
                *(u32x2*)(FFN + (size_t)tok_ * D + 256 * c4 + 32 * j + 4 * g8) = w_; } while (0)
            if (ntok > 0) V_ISSUE(rA, 0, 0);
            for (int k = 0; k < ntok; ++k) {
                V_ISSUE(rB, k, 1);
#pragma unroll
                for (int q = 0; q < 16; ++q) o[q] = (f32x2){0.f, 0.f};
                V_ACC(rA, k, 0);
                V_ISSUE(rA, ((k + 1 < ntok) ? k + 1 : k), 0);
                V_ACC(rB, k, 1);
                V_FINISH(k);
            }
#undef V_ISSUE
#undef V_ACC
#undef V_FINISH
        }
        asm volatile("s_waitcnt vmcnt(0)" ::: "memory");
        for (int k = 0; k < ntok; ++k) { const int row = base + gw + GW * k;
            bf16_t* xp = XS + (size_t)row * D + 16 * lane; const int mb = mod_batch(row); const float* m = MOD + (size_t)mb * 6144 + 16 * lane;
            const u32x4 fa = *(const u32x4*)(FFN + (size_t)row * D + 16 * lane), fb = *(const u32x4*)(FFN + (size_t)row * D + 16 * lane + 8);
            const u32x4 xa = *(const u32x4*)xp, xb = *(const u32x4*)(xp + 8);
            float o[16], x1[16];
#pragma unroll
            for (int q = 0; q < 4; ++q) { o[2 * q] = bf_lo(fa[q]); o[2 * q + 1] = bf_hi(fa[q]); o[8 + 2 * q] = bf_lo(fb[q]); o[9 + 2 * q] = bf_hi(fb[q]);
                x1[2 * q] = bf_lo(xa[q]); x1[2 * q + 1] = bf_hi(xa[q]); x1[8 + 2 * q] = bf_lo(xb[q]); x1[9 + 2 * q] = bf_hi(xb[q]); }
            float y[16]; float s = 0.f;
#pragma unroll
            for (int qd = 0; qd < 4; ++qd) { const f32x4 g2 = *(const f32x4*)(m + 5 * 1024 + 4 * qd);
#pragma unroll
                for (int e = 0; e < 4; ++e) { y[4 * qd + e] = DN_ALPHA * x1[4 * qd + e] + g2[e] * o[4 * qd + e]; s += y[4 * qd + e]; } }
            const float mean = wave_sum(s) * (1.0f / 1024.0f);
            float q = 0.f;
#pragma unroll
            for (int e = 0; e < 16; ++e) { const float d = y[e] - mean; q += d * d; }
            const float rstd = rsqrtf(wave_sum(q) * (1.0f / 1024.0f) + LN_EPS);
            const float* mn = (const float*)(ws + WS_MOD) + (size_t)(L + 1 < DEPTH ? L + 1 : L) * 17 * 6144 + (size_t)mb * 6144 + 16 * lane;
            float x2[16];
#pragma unroll
            for (int qd = 0; qd < 4; ++qd) { const int col = 16 * lane + 4 * qd;
                const f32x4 gg = *(const f32x4*)(lg + col), bb = *(const f32x4*)(lb + col);
#pragma unroll
                for (int e = 0; e < 4; ++e) x2[4 * qd + e] = (y[4 * qd + e] - mean) * rstd * gg[e] + bb[e]; }
            if (L == DEPTH - 1) {
#pragma unroll
                for (int qd = 0; qd < 4; ++qd) *(f32x4*)(p.out + (size_t)row * D + 16 * lane + 4 * qd) = (f32x4){x2[4 * qd], x2[4 * qd + 1], x2[4 * qd + 2], x2[4 * qd + 3]};
            } else {
                float hh[16];
#pragma unroll
                for (int qd = 0; qd < 4; ++qd) { const f32x4 s1 = *(const f32x4*)(mn + 1024 + 4 * qd), sh = *(const f32x4*)(mn + 4 * qd);
#pragma unroll
                    for (int e = 0; e < 4; ++e) hh[4 * qd + e] = x2[4 * qd + e] * (s1[e] + 1.0f) + sh[e]; }
#pragma unroll
                for (int hf = 0; hf < 2; ++hf) { u32x4 wx, wh;
#pragma unroll
                    for (int q2 = 0; q2 < 4; ++q2) { wx[q2] = pk_bf16(x2[8 * hf + 2 * q2], x2[8 * hf + 2 * q2 + 1]); wh[q2] = pk_bf16(hh[8 * hf + 2 * q2], hh[8 * hf + 2 * q2 + 1]); }
                    *(u32x4*)(xp + 8 * hf) = wx; *(u32x4*)(H1 + (size_t)row * D + 16 * lane + 8 * hf) = wh; }
            }
        }
    }
}

DI float logsig_fast(float z) { return fminf(z, 0.f) - __logf(1.0f + __expf(-fabsf(z))); }
template <int DIR>
DI float gla_prep_gates(const bf16_t* Qt, const bf16_t* Kt, bf16_t* OUT, const float* gl, const float (&wg)[16], float bias, int cl, unsigned (&kpk)[32]) {
    constexpr int dir = DIR;
    { int z_ = 0; asm volatile("" : "+v"(z_)); gl += z_; }
    float cum = 0.f;
#pragma unroll
        for (int blk = 0; blk < 8; ++blk) {
            float gs[8];
#pragma unroll
            for (int e = 0; e < 8; ++e) { const int i = (dir ? 56 - 8 * blk : 8 * blk) + e; float z = bias; const f32x4* gp = (const f32x4*)(gl + i * 32 + dir * 16);
#pragma unroll
                for (int r4 = 0; r4 < 4; ++r4) { const f32x4 gv = gp[r4]; z += gv[0] * wg[4 * r4] + gv[1] * wg[4 * r4 + 1] + gv[2] * wg[4 * r4 + 2] + gv[3] * wg[4 * r4 + 3]; }
                gs[e] = logsig_fast(z) * (1.0f / 16.0f); }
            float kiv[8];
#pragma unroll
            for (int e = 0; e < 8; ++e) { const int pos = dir ? 7 - e : e, i = (dir ? 56 - 8 * blk : 8 * blk) + pos;
                cum += gs[pos];
                const float qv = bf1(Qt[i * 256 + cl]), kv = bf1(Kt[i * 256 + cl]);
                OUT[(dir * 64 + i) * 256 + cl] = f2bf(qv * __expf(cum)); kiv[pos] = kv * __expf(-cum); }
            u32x4 w; w.x = pk_bf16(kiv[0], kiv[1]); w.y = pk_bf16(kiv[2], kiv[3]); w.z = pk_bf16(kiv[4], kiv[5]); w.w = pk_bf16(kiv[6], kiv[7]);
            if (dir) { kpk[4 * (7 - blk)] = w.x; kpk[4 * (7 - blk) + 1] = w.y; kpk[4 * (7 - blk) + 2] = w.z; kpk[4 * (7 - blk) + 3] = w.w; }
            else { kpk[4 * blk] = w.x; kpk[4 * blk + 1] = w.y; kpk[4 * blk + 2] = w.z; kpk[4 * blk + 3] = w.w; }
            __builtin_amdgcn_sched_barrier(0);
        }
    return cum;
}
DI void phase_gla_prep(const Ctx& c, int j) {
    const Params& p = *c.p; unsigned char* ws = c.ws; const int tid = c.tid;
    const bf16_t* QG = (const bf16_t*)(ws + WS_R1); const bf16_t* KG = (const bf16_t*)(ws + WS_R1 + SZ_T512); const bf16_t* VG = (const bf16_t*)(ws + WS_R1 + 2 * SZ_T512);
    const float* GL = (const float*)(ws + WS_GL); float* DEC = (float*)(ws + WS_DEC); bf16_t* VTt = (bf16_t*)(ws + WS_VTT);
    bf16_t* Qt = (bf16_t*)c.smem;
    bf16_t* Kt = Qt + 64 * 256;
    bf16_t* OUT = Kt + 64 * 256;
    float* gl = (float*)(c.smem + 131072);
    const int dir = __builtin_amdgcn_readfirstlane(tid >> 8), cl = tid & 255;
    for (int u = c.bid; u < (T / 64) * 2; u += c.G) {
        const int ch = u >> 1, hc = u & 1, r0 = ch * 64, cg = 256 * hc + cl;
        __syncthreads();
#pragma unroll
        for (int it = 0; it < 4; ++it) { const int idx = it * 512 + tid, row = idx >> 5, c8 = (idx & 31) * 8;
            *(u32x4*)(Qt + row * 256 + c8) = *(const u32x4*)(QG + (size_t)(r0 + row) * 512 + 256 * hc + c8);
            *(u32x4*)(Kt + row * 256 + c8) = *(const u32x4*)(KG + (size_t)(r0 + row) * 512 + 256 * hc + c8); }
        ((f32x4*)gl)[tid] = ((const f32x4*)(GL + (size_t)r0 * 32))[tid];
        float wg[16];
#pragma unroll
        for (int r = 0; r < 16; ++r) wg[r] = p.in[15][((size_t)(j * 2 + dir) * 16 + r) * 512 + cg];
        const float bias = p.in[16][(size_t)(j * 2 + dir) * 512 + cg];
        __syncthreads();
        unsigned kpk[32];
        const float cum = dir ? gla_prep_gates<1>(Qt, Kt, OUT, gl, wg, bias, cl, kpk) : gla_prep_gates<0>(Qt, Kt, OUT, gl, wg, bias, cl, kpk);
        DEC[((size_t)dir * (T / 64) + ch) * 512 + cg] = __expf(cum);
        __syncthreads();
#pragma unroll 2
        for (int it = 0; it < 8; ++it) { const int idx = it * 512 + tid, d2 = idx >> 11, row = (idx >> 5) & 63, c8 = (idx & 31) * 8;
            *(u32x4*)((bf16_t*)(ws + WS_R2) + (size_t)d2 * T * 512 + (size_t)(r0 + row) * 512 + 256 * hc + c8) = *(const u32x4*)(OUT + (d2 * 64 + row) * 256 + c8); }
        bf16_t* KT = Qt;
#pragma unroll
        for (int cb = 0; cb < 8; ++cb) *(u32x4*)(KT + (dir * 256 + cl) * 64 + ((cb ^ (cl & 7)) * 8)) = (u32x4){kpk[4 * cb], kpk[4 * cb + 1], kpk[4 * cb + 2], kpk[4 * cb + 3]};
        __syncthreads();
#pragma unroll 2
        for (int it = 0; it < 8; ++it) { const int idx = it * 512 + tid, d2 = idx >> 11, clr = (idx >> 3) & 255, cb = idx & 7;
            *(u32x4*)((bf16_t*)(ws + WS_R2 + 2 * SZ_T1K) + (((size_t)d2 * (T / 64) + ch) * 512 + 256 * hc + clr) * 64 + cb * 8) = *(const u32x4*)(KT + (d2 * 256 + clr) * 64 + ((cb ^ (clr & 7)) * 8)); }
#pragma unroll
        for (int i2 = 0; i2 < 32; ++i2) { OUT[(dir * 64 + 2 * i2) * 256 + cl] = (bf16_t)(kpk[i2] & 0xffffu); OUT[(dir * 64 + 2 * i2 + 1) * 256 + cl] = (bf16_t)(kpk[i2] >> 16); }
        __syncthreads();
#pragma unroll 2
        for (int it = 0; it < 8; ++it) { const int idx = it * 512 + tid, d2 = idx >> 11, row = (idx >> 5) & 63, c8 = (idx & 31) * 8;
            *(u32x4*)((bf16_t*)(ws + WS_R2 + SZ_T1K) + (size_t)d2 * T * 512 + (size_t)(r0 + row) * 512 + 256 * hc + c8) = *(const u32x4*)(OUT + (d2 * 64 + row) * 256 + c8); }
        bf16_t* Vl = Qt;
#pragma unroll 2
        for (int it = 0; it < 8; ++it) { const int idx = it * 512 + tid, row = idx >> 6, c8 = (idx & 63) * 8;
            *(u32x4*)(Vl + row * 512 + c8) = *(const u32x4*)(VG + (size_t)(r0 + row) * 1024 + 512 * hc + c8); }
        __syncthreads();
        bf16_t* VTl = OUT;
#pragma unroll 2
        for (int cb = 0; cb < 8; ++cb) { unsigned short x[8];
#pragma unroll
            for (int t = 0; t < 8; ++t) x[t] = Vl[(8 * cb + t) * 512 + tid];
            u32x4 w; w.x = (unsigned)x[0] | ((unsigned)x[1] << 16); w.y = (unsigned)x[2] | ((unsigned)x[3] << 16); w.z = (unsigned)x[4] | ((unsigned)x[5] << 16); w.w = (unsigned)x[6] | ((unsigned)x[7] << 16);
            *(u32x4*)(VTl + tid * 64 + ((cb ^ (tid & 7)) * 8)) = w; }
        __syncthreads();
#pragma unroll 2
        for (int it = 0; it < 8; ++it) { const int idx = it * 512 + tid, er = idx >> 3, cb = idx & 7;
            *(u32x4*)(VTt + ((size_t)ch * 1024 + 512 * hc + er) * 64 + cb * 8) = *(const u32x4*)(VTl + er * 64 + ((cb ^ (er & 7)) * 8)); }
    }
}

DI void phase_gla_scan(const Ctx& c) {
    unsigned char* ws = c.ws; const int tid = c.tid, lane = c.lane, w = c.wave, g = lane >> 4, cc = lane & 15;
    const bf16_t* VTt = (const bf16_t*)(ws + WS_VTT); const float* DEC = (const float*)(ws + WS_DEC); bf16_t* O = (bf16_t*)(ws + WS_H1);
    constexpr int LDQ = 136, LDJ = 72;
    bf16_t* Qs = (bf16_t*)c.smem;
    bf16_t* Ks = Qs + 64 * LDQ;
    bf16_t* KEt = Ks + 64 * LDQ;
    bf16_t* Vt = KEt + 128 * LDJ;
    bf16_t* At = Vt + 64 * LDJ;
    bf16_t* St = At + 64 * LDJ;
    bf16_t* Ot = St + 64 * LDQ;
    float* dec = (float*)(Ot + 64 * LDJ);
    const int qtok0 = tid >> 4, qd8 = (tid & 15) * 8;
    const int ked0 = tid >> 3, kej8 = (tid & 7) * 8;
    for (int u = c.bid; u < NB * 4 * 4; u += c.G) {
        const int b = u >> 4, h = (u >> 2) & 3, es = u & 3;
        for (int dir = 0; dir < 2; ++dir) {
            const bf16_t* QIN = (const bf16_t*)(ws + WS_R2) + (size_t)dir * T * 512; const bf16_t* KIN = (const bf16_t*)(ws + WS_R2 + SZ_T1K) + (size_t)dir * T * 512;
            const bf16_t* KENDt = (const bf16_t*)(ws + WS_R2 + 2 * SZ_T1K) + (size_t)dir * (T / 64) * 512 * 64;
            f32x4 accS[4];
#pragma unroll
            for (int et = 0; et < 4; ++et) accS[et] = (f32x4){0.f, 0.f, 0.f, 0.f};
            __syncthreads();
            for (int i = tid; i < 64 * LDQ / 2; i += NTHR) ((unsigned*)St)[i] = 0u;
            u32x4 pq[2], pk[2], pke[2], pv, po; float pdec = 0.f;
            po = (u32x4){0u, 0u, 0u, 0u};
#define GLA_R0(cs_) (dir == 0 ? ((cs_) < 4 ? TL + b * CTXL + 64 * (cs_) : b * SEQ + 64 * ((cs_) - 4)) : ((cs_) < 4 ? TL + b * CTXL + 64 * (3 - (cs_)) : b * SEQ + 64 * (35 - (cs_))))
#define GLA_LOAD(cs_) do { const int r0_ = GLA_R0(cs_); const int chunk_ = r0_ >> 6; \
                _Pragma("unroll") for (int it = 0; it < 2; ++it) { const size_t go = (size_t)(r0_ + qtok0 + 32 * it) * 512 + h * 128 + qd8; pq[it] = *(const u32x4*)(QIN + go); pk[it] = *(const u32x4*)(KIN + go); \
                    pke[it] = *(const u32x4*)(KENDt + ((size_t)chunk_ * 512 + h * 128 + ked0 + 64 * it) * 64 + kej8); } \
                pv = *(const u32x4*)(VTt + ((size_t)chunk_ * 1024 + h * 256 + es * 64 + ked0) * 64 + kej8); \
                if (dir) po = *(const u32x4*)(O + (size_t)(r0_ + ked0) * 1024 + h * 256 + es * 64 + kej8); \
                if (tid < 128) pdec = DEC[((size_t)dir * (T / 64) + chunk_) * 512 + h * 128 + tid]; } while (0)
            GLA_LOAD(0);
            for (int cs = 0; cs < 36; ++cs) {
                const int r0 = GLA_R0(cs);
#pragma unroll
                for (int it = 0; it < 2; ++it) { *(u32x4*)(Qs + (qtok0 + 32 * it) * LDQ + qd8) = pq[it]; *(u32x4*)(Ks + (qtok0 + 32 * it) * LDQ + qd8) = pk[it]; *(u32x4*)(KEt + (ked0 + 64 * it) * LDJ + kej8) = pke[it]; }
                *(u32x4*)(Vt + ked0 * LDJ + kej8) = pv;
                *(u32x4*)(Ot + ked0 * LDJ + kej8) = po;
                if (tid < 128) dec[tid] = pdec;
                __syncthreads();
                if (cs + 1 < 36) GLA_LOAD(cs + 1);
                { const int it = w >> 1;
#pragma unroll
                  for (int jj = 0; jj < 2; ++jj) { const int jt = 2 * (w & 1) + jj; f32x4 a = {0.f, 0.f, 0.f, 0.f};
#pragma unroll
                      for (int ks = 0; ks < 4; ++ks) a = mfma16(frag_ld(Qs, LDQ, 16 * it, 32 * ks, lane), frag_ld(Ks, LDQ, 16 * jt, 32 * ks, lane), a);
                      const int jcol = 16 * jt + cc;
#pragma unroll
                      for (int r = 0; r < 4; ++r) { const int i = 16 * it + 4 * g + r; const bool keep = dir ? (jcol >= i) : (jcol <= i);
                          At[i * LDJ + jcol] = f2bf(keep ? a[r] : 0.f); } } }
                __syncthreads();
                { const int it = w >> 1;
#pragma unroll
                  for (int ee = 0; ee < 2; ++ee) { const int et = 2 * (w & 1) + ee; f32x4 a = {0.f, 0.f, 0.f, 0.f};
#pragma unroll
                      for (int ks = 0; ks < 2; ++ks) a = mfma16(frag_ld(At, LDJ, 16 * it, 32 * ks, lane), frag_ld(Vt, LDJ, 16 * et, 32 * ks, lane), a);
#pragma unroll
                      for (int ks = 0; ks < 4; ++ks) a = mfma16(frag_ld(Qs, LDQ, 16 * it, 32 * ks, lane), frag_ld(St, LDQ, 16 * et, 32 * ks, lane), a);
#pragma unroll
                      for (int r = 0; r < 4; ++r) { bf16_t* op = Ot + (16 * it + 4 * g + r) * LDJ + 16 * et + cc; *op = f2bf(a[r] + bf1(*op)); } } }
#pragma unroll
                for (int et = 0; et < 4; ++et) {
#pragma unroll
                    for (int ks = 0; ks < 2; ++ks) accS[et] = mfma16(frag_ld(KEt, LDJ, 16 * w, 32 * ks, lane), frag_ld(Vt, LDJ, 16 * et, 32 * ks, lane), accS[et]);
#pragma unroll
                    for (int r = 0; r < 4; ++r) accS[et][r] *= dec[16 * w + 4 * g + r];
                }
                __syncthreads();
#pragma unroll
                for (int et = 0; et < 4; ++et) { u32x2 sv; sv.x = pk_bf16(accS[et][0], accS[et][1]); sv.y = pk_bf16(accS[et][2], accS[et][3]);
                    *(u32x2*)(St + (16 * et + cc) * LDQ + 16 * w + 4 * g) = sv; }
                *(u32x4*)(O + (size_t)(r0 + ked0) * 1024 + h * 256 + es * 64 + kej8) = *(const u32x4*)(Ot + ked0 * LDJ + kej8);
            }
#undef GLA_LOAD
#undef GLA_R0
        }
    }
}

DI void phase_gla_readout(const Ctx& c, int j) {
    const Params& p = *c.p; unsigned char* ws = c.ws;
    const bf16_t* O = (const bf16_t*)(ws + WS_H1); const bf16_t* RG = (const bf16_t*)(ws + WS_R1 + 2 * SZ_T512 + SZ_T1K); bf16_t* Y = (bf16_t*)(ws + WS_R2);
    const float* gn = p.in[17] + (size_t)j * 1024;
    for (int row = c.bid * NWAVE + c.wave; row < T; row += c.G * NWAVE) {
#pragma unroll
        for (int hd = 0; hd < 4; ++hd) { const int col = 4 * c.lane + 256 * hd;
            const u32x2 ov = *(const u32x2*)(O + (size_t)row * D + col), rv = *(const u32x2*)(RG + (size_t)row * D + col);
            const float x0 = bf_lo(ov.x), x1 = bf_hi(ov.x), x2 = bf_lo(ov.y), x3 = bf_hi(ov.y);
            const float mean = wave_sum((x0 + x1) + (x2 + x3)) * (1.0f / 256.0f);
            const float d0 = x0 - mean, d1 = x1 - mean, d2 = x2 - mean, d3 = x3 - mean;
            const float rstd = rsqrtf(wave_sum((d0 * d0 + d1 * d1) + (d2 * d2 + d3 * d3)) * (1.0f / 256.0f) + LN_EPS);
            const f32x4 gg = *(const f32x4*)(gn + col);
            const float r0 = bf_lo(rv.x), r1 = bf_hi(rv.x), r2 = bf_lo(rv.y), r3 = bf_hi(rv.y);
            u32x2 o; o.x = pk_bf16(d0 * rstd * gg[0] * silu_f(r0), d1 * rstd * gg[1] * silu_f(r1)); o.y = pk_bf16(d2 * rstd * gg[2] * silu_f(r2), d3 * rstd * gg[3] * silu_f(r3));
            *(u32x2*)(Y + (size_t)row * D + col) = o; }
    }
}

constexpr int N_PHASES = 2 + 2 * 8 + 2 * 9;

__global__ void __launch_bounds__(NTHR, 2) mega_fwd(Params p) {
    extern __shared__ __attribute__((aligned(16))) unsigned char smem[];
    cg::grid_group grid = cg::this_grid();
    Ctx c; c.p = &p; c.ws = p.ws; c.smem = smem; c.tid = threadIdx.x; c.lane = c.tid & 63; c.wave = __builtin_amdgcn_readfirstlane(c.tid >> 6); c.G = gridDim.x; c.bid = blockIdx.x;
    unsigned char* ws = p.ws;
    volatile LAS unsigned* xst = (volatile LAS unsigned*)((LAS unsigned char*)smem + (LDS_BYTES - 16));
    if (threadIdx.x == 0) { xst[0] = 0u; xst[1] = 0u; }
    __syncthreads();
    const XcdBarrier xbar = xcd_barrier_post((unsigned*)(ws + WS_CTL), xst);
    const int lo = p.ph_lo, hi = p.ph_hi;
    int ph = 0;
#ifndef PH_ONLY
#define PH_ONLY -1
#endif
#ifndef DUP_MASK
#define DUP_MASK 0
#endif
#define RUN1(...) { { int t_ = threadIdx.x; asm volatile("" : "+v"(t_)); c.tid = t_; c.lane = t_ & 63; c.wave = __builtin_amdgcn_readfirstlane(t_ >> 6); { size_t z_ = 0; asm volatile("" : "+s"(z_)); ws = p.ws + z_; } c.ws = ws; } __VA_ARGS__; }
#define RUN(id, ...) do { if ((PH_ONLY < 0 || PH_ONLY == (id)) && ph >= lo && ph < hi) { \
        RUN1(__VA_ARGS__) \
        if ((DUP_MASK >> (id)) & 1) { xcd_barrier(xbar); RUN1(__VA_ARGS__) } \
        if (ph + 1 < hi) { if (ph == 0) grid.sync(); else xcd_barrier(xbar); } } ++ph; } while (0)
    LAS unsigned char* lds = (LAS unsigned char*)smem;
    const float* MOD = (const float*)(ws + WS_MOD);

    RUN(0, phase_prologue(c));
    RUN(1, phase_mod0(c));
    for (int L = 0; L < DEPTH; ++L) {
        const int j = L >> 1;
        if ((L & 1) == 0) {
            RUN(2, { pg8::Gemm g{(const bf16_t*)(ws + WS_H1), (const bf16_t*)(ws + WS_WAIN) + (size_t)j * 2048 * 1024, T, 2048, 1024}; pg8::StaticOrder S; S.init(T, 2048, c.G, c.bid);
                  pg8::EpiBf16<1> E{(bf16_t*)(ws + WS_R1), 2048}; pg8::gemm_phase(lds, g, S, E, c.tid); });
            RUN(3, phase_vstats(c));
            RUN(4, phase_spatial(c, j));
        } else {
            RUN(5, { pg8::Gemm g{(const bf16_t*)(ws + WS_H1), (const bf16_t*)(ws + WS_WBIN) + (size_t)j * WBIN_N * 1024, T, WBIN_N, 1024}; pg8::StaticOrder S; S.init(T, WBIN_N, c.G, c.bid);
                  pg8::EpiGlaProj E{(bf16_t*)(ws + WS_R1), (bf16_t*)(ws + WS_R1 + SZ_T512), (bf16_t*)(ws + WS_R1 + 2 * SZ_T512), (bf16_t*)(ws + WS_R1 + 2 * SZ_T512 + SZ_T1K), (float*)(ws + WS_GL)};
                  pg8::gemm_phase(lds, g, S, E, c.tid); });
            RUN(6, phase_gla_prep(c, j));
            RUN(7, phase_gla_scan(c));
            RUN(8, phase_gla_readout(c, j));
        }
        const int Mrows = (L == DEPTH - 1) ? TL : T;
        RUN(9, { const bf16_t* W = (L & 1) ? (const bf16_t*)(ws + WS_WBOUT) + (size_t)j * 1024 * 1024 : (const bf16_t*)(ws + WS_WAOUT) + (size_t)j * 1024 * 1024;
              pg8::Gemm g{(const bf16_t*)(ws + WS_R2), W, Mrows, 1024, 1024}; pg8::StaticOrder S; S.init(Mrows, 1024, c.G, c.bid);
              pg8::EpiRes E{p.in[0], p.in[2], (bf16_t*)(ws + WS_XS), MOD + (size_t)L * 17 * 6144, 2, L == 0 ? 1 : 0};
              pg8::gemm_phase(lds, g, S, E, c.tid); });
        RUN(10, phase_ln1(c, L));
        RUN(11, { pg8::Gemm g{(const bf16_t*)(ws + WS_R2 + SZ_T1K), (const bf16_t*)(ws + WS_WQ) + (size_t)L * 1024 * 1024, Mrows, 1024, 1024}; pg8::StaticOrder S; S.init(Mrows, 1024, c.G, c.bid);
              pg8::EpiBf16<0> E{(bf16_t*)(ws + WS_R1), 1024}; pg8::gemm_phase(lds, g, S, E, c.tid); });
        RUN(12, phase_route(c, L));
        RUN(13, phase_experts(c, L));
    }
#undef RUN
}

extern "C" void kernel_launch(void* const* d_in, const int* in_sizes, int n_in, void* d_out, int out_size, void* d_ws, size_t ws_size, hipStream_t stream) {
    static int grid = 0;
    if (grid == 0) {
        if (n_in != 23 || out_size != TL * D || ws_size < WS_END) { fprintf(stderr, "kernel_launch: unexpected shapes: n_in %d out %d ws %zu (need %zu)\n", n_in, out_size, ws_size, (size_t)WS_END); grid = -1; return; }
        int dev = 0, cus = 0, per_cu = 0;
        if (hipGetDevice(&dev) != hipSuccess || hipDeviceGetAttribute(&cus, hipDeviceAttributeMultiprocessorCount, dev) != hipSuccess) { fprintf(stderr, "kernel_launch: device query failed\n"); grid = -1; return; }
        if (hipFuncSetAttribute((const void*)mega_fwd, hipFuncAttributeMaxDynamicSharedMemorySize, LDS_BYTES) != hipSuccess) { fprintf(stderr, "kernel_launch: hipFuncSetAttribute failed\n"); grid = -1; return; }
        if (hipOccupancyMaxActiveBlocksPerMultiprocessor(&per_cu, (const void*)mega_fwd, NTHR, LDS_BYTES) != hipSuccess || per_cu < 1) { fprintf(stderr, "kernel_launch: occupancy query says %d blocks per CU\n", per_cu); grid = -1; return; }
        grid = cus;
    }
    if (grid < 0) return;
    (void)hipMemsetAsync((char*)d_ws + WS_CTL, 0, 65536, stream);
    Params p{};
    for (int i = 0; i < 23; ++i) p.in[i] = (const float*)d_in[i];
    p.out = (float*)d_out; p.ws = (unsigned char*)d_ws; p.ph_lo = 0; p.ph_hi = N_PHASES;
    void* args[] = {&p};
    const hipError_t e = hipLaunchCooperativeKernel((const void*)mega_fwd, dim3(grid), dim3(NTHR), args, LDS_BYTES, stream);
    if (e != hipSuccess) fprintf(stderr, "kernel_launch: cooperative launch failed: %s (grid %d)\n", hipGetErrorString(e), grid);
}
```

```cpp
#include <hip/hip_runtime.h>
#include <hip/hip_cooperative_groups.h>
#include <cstdio>
#include <cstdint>
namespace cg = cooperative_groups;

#define LAS __attribute__((address_space(3)))
#define DI __device__ __forceinline__
typedef unsigned short bf16_t;
typedef short bf16x8 __attribute__((ext_vector_type(8)));
typedef float f32x4 __attribute__((ext_vector_type(4)));
typedef float f32x2 __attribute__((ext_vector_type(2)));
typedef unsigned u32x4 __attribute__((ext_vector_type(4)));
typedef unsigned u32x2 __attribute__((ext_vector_type(2)));
typedef __bf16 bf16v2 __attribute__((ext_vector_type(2)));

constexpr int D = 1024, NB = 16, SEQ = 2048, CTXL = 256, DEPTH = 4;
constexpr int TL = NB * SEQ, TC = NB * CTXL, T = TL + TC;
constexpr int NEXP = 16384;
constexpr float LN_EPS = 1e-5f;
constexpr float DN_ALPHA = 1.6817928305074290f;
constexpr int NTHR = 512, NWAVE = 8;
constexpr int LDS_BYTES = 140 * 1024;
constexpr int WBIN_N = 3328;

constexpr size_t al256(size_t x) { return (x + 255) & ~(size_t)255; }
constexpr size_t WS_CTL = 0;
constexpr size_t WS_MOD = 65536;
constexpr size_t WS_STATS = al256(WS_MOD + (size_t)4 * 17 * 6144 * 4);
constexpr size_t WS_GL = al256(WS_STATS + (size_t)T * 2 * 4);
constexpr size_t WS_DEC = al256(WS_GL + (size_t)T * 32 * 4);
constexpr size_t WS_WSB = al256(WS_DEC + (size_t)2 * 576 * 512 * 4);
constexpr size_t WS_WAIN = al256(WS_WSB + (size_t)2 * 8 * 128 * 128 * 2);
constexpr size_t WS_WAOUT = WS_WAIN + (size_t)2 * 2048 * 1024 * 2;
constexpr size_t WS_WBIN = WS_WAOUT + (size_t)2 * 1024 * 1024 * 2;
constexpr size_t WS_WBOUT = WS_WBIN + (size_t)2 * WBIN_N * 1024 * 2;
constexpr size_t WS_WQ = WS_WBOUT + (size_t)2 * 1024 * 1024 * 2;
constexpr size_t WS_UT = WS_WQ + (size_t)4 * 1024 * 1024 * 2;
constexpr size_t WS_VT = WS_UT + (size_t)4 * NEXP * 1024;
constexpr size_t WS_SU = WS_VT + (size_t)4 * NEXP * 1024;
constexpr size_t WS_SV = WS_SU + (size_t)4 * NEXP * 4;
constexpr size_t WS_XS = WS_SV + (size_t)4 * NEXP * 4;
constexpr size_t WS_R1 = WS_XS + (size_t)T * 1024 * 4;
constexpr size_t WS_R2 = WS_R1 + (size_t)T * 3072 * 2;
constexpr size_t WS_H1 = WS_R2 + (size_t)T * 3072 * 2;
constexpr size_t WS_VTT = WS_H1 + (size_t)T * 1024 * 2;
constexpr size_t WS_OB = WS_VTT + (size_t)T * 1024 * 2;
constexpr size_t WS_END = WS_OB + (size_t)T * 1024 * 2;
constexpr size_t SZ_T1K = (size_t)T * 1024 * 2;
constexpr size_t SZ_T512 = (size_t)T * 512 * 2;

struct Params { const float* in[23]; float* out; unsigned char* ws; int ph_lo, ph_hi; };

DI unsigned pk_bf16(float lo, float hi) { f32x2 v = {lo, hi}; return __builtin_bit_cast(unsigned, __builtin_convertvector(v, bf16v2)); }
DI float bf_lo(unsigned w) { return __uint_as_float(w << 16); }
DI float bf_hi(unsigned w) { return __uint_as_float(w & 0xffff0000u); }
DI float bf1(bf16_t b) { return __uint_as_float(((unsigned)b) << 16); }
DI bf16_t f2bf(float f) { return (bf16_t)(pk_bf16(f, 0.f) & 0xffffu); }
DI float gelu_tanh(float x) { const float u = 0.7978845608028654f * (x + 0.044715f * x * x * x); return __fdividef(x, 1.0f + __expf(-2.0f * u)); }
DI float silu_f(float x) { return __fdividef(x, 1.0f + __expf(-x)); }
DI float logsig_f(float z) { return fminf(z, 0.f) - log1pf(expf(-fabsf(z))); }
DI float wave_sum(float v) {
#pragma unroll
    for (int o = 32; o > 0; o >>= 1) v += __shfl_xor(v, o, 64);
    return v;
}
DI float wave_max(float v) {
#pragma unroll
    for (int o = 32; o > 0; o >>= 1) v = fmaxf(v, __shfl_xor(v, o, 64));
    return v;
}
template <int CTRL> DI float dpp_mov(float x) { return __builtin_bit_cast(float, __builtin_amdgcn_mov_dpp(__builtin_bit_cast(int, x), CTRL, 0xf, 0xf, true)); }
DI float reduce4(float p0, float p1, float p2, float p3) {
    const auto a = __builtin_amdgcn_permlane32_swap(__float_as_uint(p0), __float_as_uint(p2), false, false); const float q0 = __uint_as_float(a[0]) + __uint_as_float(a[1]);
    const auto b = __builtin_amdgcn_permlane32_swap(__float_as_uint(p1), __float_as_uint(p3), false, false); const float q1 = __uint_as_float(b[0]) + __uint_as_float(b[1]);
    const auto c = __builtin_amdgcn_permlane16_swap(__float_as_uint(q0), __float_as_uint(q1), false, false); float s = __uint_as_float(c[0]) + __uint_as_float(c[1]);
    s += dpp_mov<0x128>(s); s += dpp_mov<0x124>(s); s += dpp_mov<0x122>(s); s += dpp_mov<0x121>(s);
    return s;
}
DI float dot2bf(unsigned a, unsigned b, float c) { return __builtin_amdgcn_fdot2_f32_bf16(__builtin_bit_cast(bf16v2, a), __builtin_bit_cast(bf16v2, b), c, false); }
DI f32x4 mfma16(bf16x8 a, bf16x8 b, f32x4 c) { return __builtin_amdgcn_mfma_f32_16x16x32_bf16(a, b, c, 0, 0, 0); }
DI bf16x8 frag_ld(const bf16_t* X, int ld, int row0, int k0, int lane) { return *(const bf16x8*)(X + (size_t)(row0 + (lane & 15)) * ld + k0 + 8 * (lane >> 4)); }
DI int mod_batch(int row) { return row < TL ? (row >> 11) : NB; }

#define XB_TMO      128
#define XB_XCNT(j)  (256  + 64 * (j))
#define XB_XSUB(j)  (1280 + 64 * (j))
#define XB_XGEN(j)  (2304 + 64 * (j))
#define XB_TOP      3328
#define XB_TOPGEN   3392
#define XCD_BAR_WORDS 3456
#define XB_SPIN_CAP (1u << 22)
DI unsigned xb_ld(unsigned* p)              { return __hip_atomic_load(p, __ATOMIC_RELAXED, __HIP_MEMORY_SCOPE_AGENT); }
DI unsigned xb_add(unsigned* p, unsigned v) { return __hip_atomic_fetch_add(p, v, __ATOMIC_RELAXED, __HIP_MEMORY_SCOPE_AGENT); }
DI unsigned xb_xcc_id() { return (unsigned)__builtin_amdgcn_s_getreg((3 << 11) | 20) & 0xFu; }
#define XB_SPIN(cond, bar) do { unsigned _sp = 0; while (cond) { __builtin_amdgcn_s_sleep(1); \
    if ((++_sp & 255u) == 0u) { if (xb_ld(&(bar)[XB_TMO])) break; if (_sp > XB_SPIN_CAP) { atomicAdd(&(bar)[XB_TMO], 1u); break; } } } } while (0)
struct XcdBarrier { unsigned* bar; unsigned x; volatile LAS unsigned* st; };
DI XcdBarrier xcd_barrier_post(unsigned* bar, volatile LAS unsigned* st) {
    XcdBarrier b; b.bar = bar; b.x = xb_xcc_id(); b.st = st;
    if (threadIdx.x == 0) (void)xb_add(&bar[XB_XCNT(b.x)], 1u);
    return b;
}
DI void xcd_barrier_complete(unsigned* bar, unsigned x, unsigned& nloc, unsigned& nx) {
    const unsigned G = gridDim.x * gridDim.y * gridDim.z;
    unsigned sum, cnt, mine, sp = 0u;
    for (;;) {
        sum = 0u; cnt = 0u; mine = 0u;
#pragma unroll
        for (unsigned j = 0; j < 16; ++j) { const unsigned c = xb_ld(&bar[XB_XCNT(j)]); sum += c; cnt += (c > 0u) ? 1u : 0u; mine = (j == x) ? c : mine; }
        if (sum == G) break;
        __builtin_amdgcn_s_sleep(1);
        if ((++sp & 255u) == 0u) { if (xb_ld(&bar[XB_TMO])) break; if (sp > XB_SPIN_CAP) { atomicAdd(&bar[XB_TMO], 1u); break; } }
    }
    nloc = mine > 0u ? mine : 1u; nx = cnt > 0u ? cnt : 1u;
}
DI void xcd_barrier(const XcdBarrier& b) {
    asm volatile("s_waitcnt vmcnt(0)" ::: "memory");
    __syncthreads();
    if (threadIdx.x == 0) {
        unsigned* bar = b.bar;
        __builtin_amdgcn_s_waitcnt(0);
        unsigned nloc = b.st[0], nx = b.st[1];
        if (nloc == 0u) { xcd_barrier_complete(bar, b.x, nloc, nx); b.st[0] = nloc; b.st[1] = nx; }
        const unsigned old = xb_add(&bar[XB_XSUB(b.x)], 1u);
        const unsigned gen = old / nloc;
        if (old + 1u == (gen + 1u) * nloc) {
            __builtin_amdgcn_fence(__ATOMIC_RELEASE, "agent");
            asm volatile("s_waitcnt vmcnt(0)" ::: "memory");
            const unsigned og = xb_add(&bar[XB_TOP], 1u);
            const unsigned tg = og / nx;
            if (og + 1u == (tg + 1u) * nx) xb_add(&bar[XB_TOPGEN], 1u);
            else XB_SPIN(xb_ld(&bar[XB_TOPGEN]) == tg, bar);
            __builtin_amdgcn_fence(__ATOMIC_ACQUIRE, "agent");
            xb_add(&bar[XB_XGEN(b.x)], 1u);
            asm volatile("s_waitcnt vmcnt(0)" ::: "memory");
        } else {
            XB_SPIN(xb_ld(&bar[XB_XGEN(b.x)]) == gen, bar);
            __builtin_amdgcn_fence(__ATOMIC_ACQUIRE, "agent");
            asm volatile("s_waitcnt vmcnt(0)" ::: "memory");
        }
    }
    __syncthreads();
}

namespace pg8 {
constexpr int BM = 256, BK = 64, HALF = 128, HTB = HALF * BK * 2, STAGE_BYTES = 8 * HTB, NXCD = 8, WGM = 8;
__host__ __device__ __forceinline__ int lds_byte(int r, int c) { const int st = (r >> 4) * 2 + (c >> 5), rr = r & 15, cc = c & 31, ob = rr * 64 + cc * 2; return st * 1024 + (ob ^ (((ob >> 9) & 1) << 5)); }
__host__ __device__ __forceinline__ void stage_rc(int b, int& R, int& C) { const int st = b / 1024, sb = b % 1024, swz = sb ^ (((sb >> 9) & 1) << 5); R = (st >> 1) * 16 + swz / 64; C = (st & 1) * 32 + (swz % 64) / 2; }
__host__ __device__ __forceinline__ int perm32(int rho) { const int n = rho >> 4, i = rho & 15; return 8 * (i >> 2) + 4 * n + (i & 3); }
struct Unit { int pm, pn; };
struct Gemm { const bf16_t* A; const bf16_t* Bt; int M, N, K; };
struct StaticOrder {
    int nM, nN, nwg, G, c;
    __device__ void init(int M, int N, int G_, int c_) { nM = M / BM; nN = N / BM; nwg = nM * nN; G = G_; c = c_; }
    __device__ bool next(int i, Unit& u) const {
        const long L = (long)i * G + c; if (L >= nwg) return false;
        int wgid = (int)L; { const int q = nwg / NXCD, r = nwg % NXCD, xcd = wgid % NXCD, off = wgid / NXCD; wgid = (xcd < r ? xcd * (q + 1) : r * (q + 1) + (xcd - r) * q) + off; }
        const int nig = WGM * nN, gid = wgid / nig, fm = gid * WGM, gsz = (nM - fm) < WGM ? (nM - fm) : WGM;
        u.pm = fm + ((wgid % nig) % gsz); u.pn = (wgid % nig) / gsz; return true;
    }
};

template <class Epi>
__device__ __forceinline__ void gemm_phase(LAS unsigned char* lds, const Gemm g, const StaticOrder& S, const Epi& E, const int tid) {
    const int wid = __builtin_amdgcn_readfirstlane(tid >> 6), lane = tid & 63, wr = wid >> 2, wc = wid & 3, fr = lane & 15, fq = lane >> 4;
    const int K = g.K, nt = K / BK;
    unsigned voffA[2], voffB[2];
#pragma unroll
    for (int i = 0; i < 2; ++i) { int R, C; stage_rc(tid * 16 + i * 8192, R, C); const int Rb = Epi::PERM ? ((R & ~31) + perm32(R & 31)) : R;
        voffA[i] = (unsigned)(R * K + C) * 2u; voffB[i] = (unsigned)(Rb * K + C) * 2u; }
    const size_t kstep = (size_t)(BK * 2);
    const size_t hstep = (size_t)HALF * K * 2;
    const size_t tstep = 2 * hstep;
    const unsigned ldsw = (unsigned)wid * 1024u;
    const int aoff = lds_byte(wr * 64 + fr, fq * 8), boff = lds_byte(wc * 32 + fr, fq * 8);
#define PG8_SA(b, h) (((b) * 2 + (h)) * HTB)
#define PG8_SB(b, h) ((4 + (b) * 2 + (h)) * HTB)
#define PG8_STAGE(bufoff, gbase, voff) do { _Pragma("unroll") for (int _i = 0; _i < 2; ++_i) \
        __builtin_amdgcn_global_load_lds((const unsigned*)((const char*)(gbase) + (voff)[_i]), (LAS unsigned*)(lds + (bufoff) + ldsw + _i * 8192), 16, 0, 0); } while (0)
#define PG8_LDA(dst, b, h) do { _Pragma("unroll") for (int m = 0; m < 4; ++m) _Pragma("unroll") for (int k = 0; k < 2; ++k) dst[m][k] = *(const LAS bf16x8*)(lds + PG8_SA(b, h) + aoff + m * 2048 + k * 1024); } while (0)
#define PG8_LDB(dst, b, h) do { _Pragma("unroll") for (int n = 0; n < 2; ++n) _Pragma("unroll") for (int k = 0; k < 2; ++k) dst[n][k] = *(const LAS bf16x8*)(lds + PG8_SB(b, h) + boff + n * 2048 + k * 1024); } while (0)
#define PG8_MMA(ai, bj, At, Bt) do { __builtin_amdgcn_s_setprio(1); _Pragma("unroll") for (int m = 0; m < 4; ++m) _Pragma("unroll") for (int n = 0; n < 2; ++n) _Pragma("unroll") for (int k = 0; k < 2; ++k) \
        acc[ai][bj][m][n] = __builtin_amdgcn_mfma_f32_16x16x32_bf16(Bt[n][k], At[m][k], acc[ai][bj][m][n], 0, 0, 0); __builtin_amdgcn_s_setprio(0); } while (0)
#define PG8_WAIT_V(n) asm volatile("s_waitcnt vmcnt(" #n ")" ::: "memory")
#define PG8_WAIT_L(n) asm volatile("s_waitcnt lgkmcnt(" #n ")" ::: "memory")
#define PG8_BAR __builtin_amdgcn_s_barrier()
#define PG8_SCHED __builtin_amdgcn_sched_barrier(0)
    Unit cur, nxt; int ui = 0;
    if (!S.next(0, cur)) return;
    f32x4 acc[2][2][4][2];
#pragma unroll
    for (int a = 0; a < 2; ++a)
#pragma unroll
        for (int b = 0; b < 2; ++b)
#pragma unroll
            for (int m = 0; m < 4; ++m)
#pragma unroll
                for (int n = 0; n < 2; ++n) acc[a][b][m][n] = (f32x4){0.f, 0.f, 0.f, 0.f};
    bf16x8 At[4][2], B0[2][2], B1[2][2];
    const char* cA = (const char*)g.A + (size_t)cur.pm * tstep; const char* cB = (const char*)g.Bt + (size_t)cur.pn * tstep;
    PG8_STAGE(PG8_SB(0, 0), cB, voffB); PG8_STAGE(PG8_SA(0, 0), cA, voffA); PG8_STAGE(PG8_SB(0, 1), cB + hstep, voffB); PG8_STAGE(PG8_SA(0, 1), cA + hstep, voffA);
    if (wr == 1) PG8_BAR;
    PG8_WAIT_V(4); PG8_BAR;
    PG8_STAGE(PG8_SB(1, 0), cB + kstep, voffB); PG8_STAGE(PG8_SA(1, 0), cA + kstep, voffA); PG8_STAGE(PG8_SB(1, 1), cB + hstep + kstep, voffB);
    PG8_WAIT_V(6); PG8_BAR;
    for (;;) {
        const bool has_next = S.next(ui + 1, nxt);
        const char* nA = has_next ? (const char*)g.A + (size_t)nxt.pm * tstep : cA; const char* nB = has_next ? (const char*)g.Bt + (size_t)nxt.pn * tstep : cB;
        for (int t = 0; t < nt; t += 2) {
            const bool last = (t == nt - 2);
            const char* a1 = cA + (size_t)(t + 1) * kstep;
            const char* a2 = last ? nA : cA + (size_t)(t + 2) * kstep; const char* b2 = last ? nB : cB + (size_t)(t + 2) * kstep;
            const char* a3 = a2 + kstep; const char* b3 = b2 + kstep;
            PG8_LDB(B0, 0, 0); PG8_SCHED; PG8_LDA(At, 0, 0); PG8_STAGE(PG8_SA(1, 1), a1 + hstep, voffA);
            PG8_WAIT_L(8); PG8_BAR; PG8_WAIT_L(0); PG8_MMA(0, 0, At, B0); PG8_BAR; PG8_SCHED;
            PG8_LDB(B1, 0, 1); PG8_STAGE(PG8_SB(0, 0), b2, voffB);
            PG8_BAR; PG8_WAIT_L(0); PG8_MMA(0, 1, At, B1); PG8_BAR;
            PG8_LDA(At, 0, 1); PG8_STAGE(PG8_SA(0, 0), a2, voffA);
            PG8_BAR; PG8_WAIT_L(0); PG8_MMA(1, 0, At, B0); PG8_BAR; PG8_SCHED;
            PG8_STAGE(PG8_SB(0, 1), b2 + hstep, voffB);
            PG8_WAIT_V(6); PG8_BAR; PG8_MMA(1, 1, At, B1); PG8_BAR;
            PG8_LDB(B0, 1, 0); PG8_SCHED; PG8_LDA(At, 1, 0); PG8_STAGE(PG8_SA(0, 1), a2 + hstep, voffA);
            PG8_WAIT_L(8); PG8_BAR; PG8_WAIT_L(0); PG8_MMA(0, 0, At, B0); PG8_BAR; PG8_SCHED;
            PG8_LDB(B1, 1, 1); PG8_STAGE(PG8_SB(1, 0), b3, voffB);
            PG8_BAR; PG8_WAIT_L(0); PG8_MMA(0, 1, At, B1); PG8_BAR;
            PG8_LDA(At, 1, 1); PG8_STAGE(PG8_SA(1, 0), a3, voffA);
            PG8_BAR; PG8_WAIT_L(0); PG8_MMA(1, 0, At, B0); PG8_BAR; PG8_SCHED;
            PG8_STAGE(PG8_SB(1, 1), b3 + hstep, voffB);
            PG8_WAIT_V(6); PG8_BAR; PG8_MMA(1, 1, At, B1); PG8_BAR;
        }
        E(acc, cur, wr, wc, fr, fq);
        if (!has_next) break;
#pragma unroll
        for (int a = 0; a < 2; ++a)
#pragma unroll
            for (int b = 0; b < 2; ++b)
#pragma unroll
                for (int m = 0; m < 4; ++m)
#pragma unroll
                    for (int n = 0; n < 2; ++n) acc[a][b][m][n] = (f32x4){0.f, 0.f, 0.f, 0.f};
        cur = nxt; cA = nA; cB = nB; ++ui;
    }
    PG8_WAIT_V(0);
    if (wr == 0) PG8_BAR;
    PG8_BAR;
#undef PG8_SA
#undef PG8_SB
#undef PG8_STAGE
#undef PG8_LDA
#undef PG8_LDB
#undef PG8_MMA
#undef PG8_WAIT_V
#undef PG8_WAIT_L
#undef PG8_BAR
#undef PG8_SCHED
}

template <int ACT  > struct EpiBf16 {
    static constexpr bool PERM = true;
    bf16_t* O; int ldc;
    __device__ __forceinline__ void operator()(const f32x4 (&acc)[2][2][4][2], const Unit& u, int wr, int wc, int fr, int fq) const {
        const int row0 = u.pm * BM + wr * 64 + fr, col0 = u.pn * BM + wc * 32 + 8 * fq;
#pragma unroll
        for (int ai = 0; ai < 2; ++ai)
#pragma unroll
            for (int m = 0; m < 4; ++m) { bf16_t* rowp = O + (size_t)(row0 + ai * HALF + m * 16) * ldc + col0;
#pragma unroll
                for (int bj = 0; bj < 2; ++bj) { f32x4 v0 = acc[ai][bj][m][0], v1 = acc[ai][bj][m][1];
                    if (ACT == 1) {
#pragma unroll
                        for (int j = 0; j < 4; ++j) { v0[j] = gelu_tanh(v0[j]); v1[j] = gelu_tanh(v1[j]); } }
                    u32x4 w; w.x = pk_bf16(v0[0], v0[1]); w.y = pk_bf16(v0[2], v0[3]); w.z = pk_bf16(v1[0], v1[1]); w.w = pk_bf16(v1[2], v1[3]);
                    *(u32x4*)(rowp + bj * HALF) = w; } }
    }
};
struct EpiRes {
    static constexpr bool PERM = true;
    const float* src_lat; const float* src_ctx; bf16_t* xs; const float* modL; int gate_idx; int src_f32;
    __device__ __forceinline__ void operator()(const f32x4 (&acc)[2][2][4][2], const Unit& u, int wr, int wc, int fr, int fq) const {
        const bool isctx = u.pm >= (TL / BM);
        const float* sb = isctx ? src_ctx + (size_t)(u.pm - TL / BM) * BM * D : src_lat + (size_t)u.pm * BM * D;
        const int mb = isctx ? NB : (u.pm >> 3);
        const float* gv = modL + (size_t)mb * 6144 + gate_idx * 1024;
        const int rl = wr * 64 + fr, col0 = u.pn * BM + wc * 32 + 8 * fq;
        f32x4 g[2][2];
#pragma unroll
        for (int bj = 0; bj < 2; ++bj)
#pragma unroll
            for (int n = 0; n < 2; ++n) g[bj][n] = *(const f32x4*)(gv + col0 + bj * HALF + n * 4);
#pragma unroll
        for (int ai = 0; ai < 2; ++ai)
#pragma unroll
            for (int m = 0; m < 4; ++m) { const int r = rl + ai * HALF + m * 16; bf16_t* dp = xs + ((size_t)u.pm * BM + r) * D + col0;
#pragma unroll
                for (int bj = 0; bj < 2; ++bj) { f32x4 x0, x1;
                    if (src_f32) { const float* sp = sb + (size_t)r * D + col0 + bj * HALF; x0 = *(const f32x4*)sp; x1 = *(const f32x4*)(sp + 4); }
                    else { const u32x4 xv = *(const u32x4*)(dp + bj * HALF); x0 = (f32x4){bf_lo(xv.x), bf_hi(xv.x), bf_lo(xv.y), bf_hi(xv.y)}; x1 = (f32x4){bf_lo(xv.z), bf_hi(xv.z), bf_lo(xv.w), bf_hi(xv.w)}; }
                    const f32x4 y0 = x0 * DN_ALPHA + g[bj][0] * acc[ai][bj][m][0], y1 = x1 * DN_ALPHA + g[bj][1] * acc[ai][bj][m][1];
                    u32x4 w; w.x = pk_bf16(y0[0], y0[1]); w.y = pk_bf16(y0[2], y0[3]); w.z = pk_bf16(y1[0], y1[1]); w.w = pk_bf16(y1[2], y1[3]);
                    *(u32x4*)(dp + bj * HALF) = w; } }
    }
};
struct EpiGlaProj {
    static constexpr bool PERM = true;
    bf16_t* QG; bf16_t* KG; bf16_t* VG; bf16_t* RG; float* GL;
    __device__ __forceinline__ void operator()(const f32x4 (&acc)[2][2][4][2], const Unit& u, int wr, int wc, int fr, int fq) const {
        const int row0 = u.pm * BM + wr * 64 + fr, pn = u.pn;
        if (pn < 12) {
            bf16_t* base; int ld, colt; float sc = 1.f;
            if (pn < 2) { base = QG; ld = 512; colt = pn * BM; sc = 0.08838834764831845f; }
            else if (pn < 4) { base = KG; ld = 512; colt = (pn - 2) * BM; }
            else if (pn < 8) { base = VG; ld = 1024; colt = (pn - 4) * BM; }
            else { base = RG; ld = 1024; colt = (pn - 8) * BM; }
            const int col0 = colt + wc * 32 + 8 * fq;
#pragma unroll
            for (int ai = 0; ai < 2; ++ai)
#pragma unroll
                for (int m = 0; m < 4; ++m) { bf16_t* rowp = base + (size_t)(row0 + ai * HALF + m * 16) * ld + col0;
#pragma unroll
                    for (int bj = 0; bj < 2; ++bj) { const f32x4 v0 = acc[ai][bj][m][0] * sc, v1 = acc[ai][bj][m][1] * sc;
                        u32x4 w; w.x = pk_bf16(v0[0], v0[1]); w.y = pk_bf16(v0[2], v0[3]); w.z = pk_bf16(v1[0], v1[1]); w.w = pk_bf16(v1[2], v1[3]);
                        *(u32x4*)(rowp + bj * HALF) = w; } }
        } else if (wc == 0) {
#pragma unroll
            for (int ai = 0; ai < 2; ++ai)
#pragma unroll
                for (int m = 0; m < 4; ++m) { float* gp = GL + (size_t)(row0 + ai * HALF + m * 16) * 32 + 8 * fq;
                    *(f32x4*)gp = acc[ai][0][m][0]; *(f32x4*)(gp + 4) = acc[ai][0][m][1]; }
        }
    }
};
}

struct Ctx {
    const Params* p; unsigned char* ws; unsigned char* smem; int tid, lane, wave, G, bid;
};

DI void phase_prologue(const Ctx& c) {
    const Params& p = *c.p; unsigned char* ws = c.ws;
    const int tid = c.tid;
    constexpr int N_MOD = 192, N_TR = 4736, N_WS = 64, N_TAB = 2048;
    constexpr int N_ALL = N_MOD + N_TR + N_WS + N_TAB;
    for (int u = c.bid; u < N_ALL; u += c.G) {
        if (u < N_MOD) {
            const int l = u / 48, n0 = (u % 48) * 128;
            float* sc = (float*)c.smem;
            float* red = (float*)(c.smem + 17 * 1024 * 4);
            __syncthreads();
#pragma unroll 1
            for (int hk = 0; hk < 2; ++hk) { const int k = hk * 512 + tid; float v[17];
#pragma unroll
                for (int b = 0; b < 17; ++b) v[b] = (b < NB) ? p.in[1][b * 1024 + k] : p.in[3][k];
#pragma unroll
                for (int b = 0; b < 17; ++b) sc[b * 1024 + k] = silu_f(v[b]); }
            __syncthreads();
            const int c4 = (tid & 31) * 4, kg = tid >> 5;
            float acc[17][4];
#pragma unroll
            for (int b = 0; b < 17; ++b) { acc[b][0] = 0.f; acc[b][1] = 0.f; acc[b][2] = 0.f; acc[b][3] = 0.f; }
            const float* wp = p.in[4] + ((size_t)l * 1024 + (size_t)kg * 64) * 6144 + n0 + c4;
#pragma unroll 4
            for (int kk = 0; kk < 64; ++kk) {
                const f32x4 w = *(const f32x4*)(wp + (size_t)kk * 6144);
                const int k = kg * 64 + kk;
#pragma unroll
                for (int b = 0; b < 17; ++b) { const float s = sc[b * 1024 + k]; acc[b][0] += s * w[0]; acc[b][1] += s * w[1]; acc[b][2] += s * w[2]; acc[b][3] += s * w[3]; }
            }
#pragma unroll
            for (int b = 0; b < 17; ++b)
#pragma unroll
                for (int j = 0; j < 4; ++j) acc[b][j] += __shfl_xor(acc[b][j], 32, 64);
            if ((tid & 32) == 0) {
#pragma unroll
                for (int b = 0; b < 17; ++b)
#pragma unroll
                    for (int j = 0; j < 4; ++j) red[(c.wave * 17 + b) * 128 + c4 + j] = acc[b][j];
            }
            __syncthreads();
            for (int o = tid; o < 17 * 128; o += NTHR) { const int b = o >> 7, n = o & 127; float s = 0.f;
#pragma unroll
                for (int w = 0; w < 8; ++w) s += red[(w * 17 + b) * 128 + n];
                ((float*)(ws + WS_MOD))[((size_t)l * 17 + b) * 6144 + n0 + n] = s + p.in[5][l * 6144 + n0 + n]; }
        } else if (u < N_MOD + N_TR) {
            int v = u - N_MOD; const float* src; bf16_t* dst; int N, Npad;
            if (v < 1024) { const int j = v / 512; v %= 512; src = p.in[8] + (size_t)j * 1024 * 2048; dst = (bf16_t*)(ws + WS_WAIN) + (size_t)j * 2048 * 1024; N = 2048; Npad = 2048; }
            else if (v < 1536) { v -= 1024; const int j = v / 256; v %= 256; src = p.in[13] + (size_t)j * 1024 * 1024; dst = (bf16_t*)(ws + WS_WAOUT) + (size_t)j * 1024 * 1024; N = 1024; Npad = 1024; }
            else if (v < 3200) { v -= 1536; const int j = v / 832; v %= 832; src = p.in[14] + (size_t)j * 1024 * 3104; dst = (bf16_t*)(ws + WS_WBIN) + (size_t)j * WBIN_N * 1024; N = 3104; Npad = WBIN_N; }
            else if (v < 3712) { v -= 3200; const int j = v / 256; v %= 256; src = p.in[18] + (size_t)j * 1024 * 1024; dst = (bf16_t*)(ws + WS_WBOUT) + (size_t)j * 1024 * 1024; N = 1024; Npad = 1024; }
            else { v -= 3712; const int j = v / 256; v %= 256; src = p.in[19] + (size_t)j * 1024 * 1024; dst = (bf16_t*)(ws + WS_WQ) + (size_t)j * 1024 * 1024; N = 1024; Npad = 1024; }
            (void)Npad;
            const int ntn = v >> 4, ktile = v & 15, n0 = ntn * 64, k0 = ktile * 64;
            float* tl = (float*)c.smem;
            __syncthreads();
#pragma unroll
            for (int i = 0; i < 2; ++i) { const int kk = (tid >> 4) + 32 * i, nn = (tid & 15) * 4;
                f32x4 x = {0.f, 0.f, 0.f, 0.f};
                if (n0 + nn < N) x = *(const f32x4*)(src + (size_t)(k0 + kk) * N + n0 + nn);
                tl[kk * 65 + nn] = x[0]; tl[kk * 65 + nn + 1] = x[1]; tl[kk * 65 + nn + 2] = x[2]; tl[kk * 65 + nn + 3] = x[3]; }
            __syncthreads();
            { const int nn = tid >> 3, kk8 = (tid & 7) * 8; float x[8];
#pragma unroll
              for (int j = 0; j < 8; ++j) x[j] = tl[(kk8 + j) * 65 + nn];
              u32x4 w; w.x = pk_bf16(x[0], x[1]); w.y = pk_bf16(x[2], x[3]); w.z = pk_bf16(x[4], x[5]); w.w = pk_bf16(x[6], x[7]);
              *(u32x4*)(dst + (size_t)(n0 + nn) * 1024 + k0 + kk8) = w; }
        } else if (u < N_MOD + N_TR + N_WS) {
            const int v = u - N_MOD - N_TR; const size_t e = (size_t)v * 4096 + (size_t)tid * 8;
            const f32x4 a = *(const f32x4*)(p.in[11] + e), b = *(const f32x4*)(p.in[11] + e + 4);
            u32x4 w; w.x = pk_bf16(a[0], a[1]); w.y = pk_bf16(a[2], a[3]); w.z = pk_bf16(b[0], b[1]); w.w = pk_bf16(b[2], b[3]);
            *(u32x4*)((bf16_t*)(ws + WS_WSB) + e) = w;
        } else {
            const int v = u - N_MOD - N_TR - N_WS; const int tab = v >> 10;
            const float* src = p.in[21 + tab]; unsigned char* dst = ws + (tab ? WS_VT : WS_UT); float* sc = (float*)(ws + (tab ? WS_SV : WS_SU));
#pragma unroll 2
            for (int i = 0; i < 8; ++i) { const size_t row = (size_t)(v & 1023) * 64 + c.wave * 8 + i;
                const float* rp = src + row * 1024 + 16 * c.lane; f32x4 x[4]; float am = 0.f;
#pragma unroll
                for (int q = 0; q < 4; ++q) { x[q] = __builtin_nontemporal_load((const f32x4*)(rp + 4 * q)); am = fmaxf(am, fmaxf(fmaxf(fabsf(x[q][0]), fabsf(x[q][1])), fmaxf(fabsf(x[q][2]), fabsf(x[q][3])))); }
                am = fmaxf(wave_max(am), 1e-30f);
                const size_t Lr = row >> 14, er = row & 16383;
                {
                    const float inv = 6.0f / am; u32x2 w;
#pragma unroll
                    for (int hq = 0; hq < 2; ++hq) { unsigned t = 0;
                        t = __builtin_amdgcn_cvt_scalef32_pk_fp4_f32(t, x[2 * hq][0] * inv, x[2 * hq][1] * inv, 1.0f, 0); t = __builtin_amdgcn_cvt_scalef32_pk_fp4_f32(t, x[2 * hq][2] * inv, x[2 * hq][3] * inv, 1.0f, 1);
                        t = __builtin_amdgcn_cvt_scalef32_pk_fp4_f32(t, x[2 * hq + 1][0] * inv, x[2 * hq + 1][1] * inv, 1.0f, 2); t = __builtin_amdgcn_cvt_scalef32_pk_fp4_f32(t, x[2 * hq + 1][2] * inv, x[2 * hq + 1][3] * inv, 1.0f, 3);
                        w[hq] = t; }
                    *(u32x2*)(dst + ((Lr * 4 + (c.lane >> 4)) * NEXP + er) * 128 + 8 * (c.lane & 15)) = w;
                    if (c.lane == 0) sc[row] = am * (1.0f / 6.0f);
                } }
        }
    }
}

DI void phase_mod0(const Ctx& c) {
    const Params& p = *c.p; const float* MOD = (const float*)(c.ws + WS_MOD); bf16_t* H1 = (bf16_t*)(c.ws + WS_H1);
    for (int row = c.bid * NWAVE + c.wave; row < T; row += c.G * NWAVE) {
        const float* src = row < TL ? p.in[0] + (size_t)row * D : p.in[2] + (size_t)(row - TL) * D;
        const float* m = MOD + (size_t)mod_batch(row) * 6144;
#pragma unroll
        for (int j = 0; j < 4; ++j) { const int col = 4 * c.lane + 256 * j;
            const f32x4 x = *(const f32x4*)(src + col), sh = *(const f32x4*)(m + col), s = *(const f32x4*)(m + 1024 + col);
            const f32x4 h = x * (s + 1.0f) + sh; u32x2 w; w.x = pk_bf16(h[0], h[1]); w.y = pk_bf16(h[2], h[3]);
            *(u32x2*)(H1 + (size_t)row * D + col) = w; }
    }
}

DI void phase_vstats(const Ctx& c) {
    const bf16_t* UV = (const bf16_t*)(c.ws + WS_R1); float* ST = (float*)(c.ws + WS_STATS);
    for (int row = c.bid * NWAVE + c.wave; row < T; row += c.G * NWAVE) {
        const bf16_t* vp = UV + (size_t)row * 2048 + 1024;
        const u32x4 a = *(const u32x4*)(vp + 8 * c.lane), b = *(const u32x4*)(vp + 512 + 8 * c.lane);
        float x[16];
#pragma unroll
        for (int j = 0; j < 4; ++j) { x[2 * j] = bf_lo(a[j]); x[2 * j + 1] = bf_hi(a[j]); x[8 + 2 * j] = bf_lo(b[j]); x[9 + 2 * j] = bf_hi(b[j]); }
        float s = 0.f;
#pragma unroll
        for (int j = 0; j < 16; ++j) s += x[j];
        const float mean = wave_sum(s) * (1.0f / 1024.0f);
        float q = 0.f;
#pragma unroll
        for (int j = 0; j < 16; ++j) { const float d = x[j] - mean; q += d * d; }
        const float var = wave_sum(q) * (1.0f / 1024.0f);
        if (c.lane == 0) { ST[2 * row] = mean; ST[2 * row + 1] = rsqrtf(var + LN_EPS); }
    }
}

DI void phase_spatial(const Ctx& c, int j) {
    const Params& p = *c.p; unsigned char* ws = c.ws;
    const bf16_t* UV = (const bf16_t*)(ws + WS_R1); const float* ST = (const float*)(ws + WS_STATS); bf16_t* Y = (bf16_t*)(ws + WS_R2);
    const bf16_t* WSB = (const bf16_t*)(ws + WS_WSB) + (size_t)j * 8 * 128 * 128;
    const float* ng = p.in[9] + j * 1024; const float* nb = p.in[10] + j * 1024; const float* bs = p.in[12] + j * 8 * 128;
    constexpr int LD = 136;
    bf16_t* WsL = (bf16_t*)c.smem;
    bf16_t* VnT = WsL + 128 * LD;
    const int tid = c.tid, lane = c.lane, w = c.wave, g = lane >> 4, cc = lane & 15;
    for (int u = c.bid; u < (T / 128) * 8; u += c.G) {
        const int chunk = u >> 3, h = u & 7, r0 = chunk * 128;
        __syncthreads();
        { const int cg8 = tid & 15; float gg[8], bb[8];
#pragma unroll
          for (int e = 0; e < 8; ++e) { gg[e] = ng[h * 128 + cg8 * 8 + e]; bb[e] = nb[h * 128 + cg8 * 8 + e]; }
#pragma unroll
          for (int i = 0; i < 4; ++i) { const int idx = i * 512 + tid, tok = idx >> 4;
              const u32x4 v = *(const u32x4*)(UV + (size_t)(r0 + tok) * 2048 + 1024 + h * 128 + cg8 * 8);
              const float mean = ST[2 * (r0 + tok)], rstd = ST[2 * (r0 + tok) + 1];
              float x[8];
#pragma unroll
              for (int e = 0; e < 4; ++e) { x[2 * e] = bf_lo(v[e]); x[2 * e + 1] = bf_hi(v[e]); }
#pragma unroll
              for (int e = 0; e < 8; ++e) VnT[(cg8 * 8 + e) * LD + tok] = f2bf((x[e] - mean) * rstd * gg[e] + bb[e]);
              const int pp = idx >> 4;
              *(u32x4*)(WsL + pp * LD + cg8 * 8) = *(const u32x4*)(WSB + ((size_t)h * 128 + pp) * 128 + cg8 * 8); } }
        __syncthreads();
        f32x4 acc[8];
#pragma unroll
        for (int ct = 0; ct < 8; ++ct) acc[ct] = (f32x4){0.f, 0.f, 0.f, 0.f};
#pragma unroll
        for (int ks = 0; ks < 4; ++ks) {
            const bf16x8 bfr = frag_ld(WsL, LD, 16 * w, 32 * ks, lane);
#pragma unroll
            for (int ct = 0; ct < 8; ++ct) acc[ct] = mfma16(frag_ld(VnT, LD, 16 * ct, 32 * ks, lane), bfr, acc[ct]);
        }
        const int pp = 16 * w + cc; const float bsv = bs[h * 128 + pp];
        const size_t rowo = (size_t)(r0 + pp);
#pragma unroll
        for (int ct = 0; ct < 8; ++ct) { const int ch = h * 128 + 16 * ct + 4 * g;
            const u32x2 uu = *(const u32x2*)(UV + rowo * 2048 + ch);
            const float y0 = bf_lo(uu.x) * (acc[ct][0] + bsv), y1 = bf_hi(uu.x) * (acc[ct][1] + bsv), y2 = bf_lo(uu.y) * (acc[ct][2] + bsv), y3 = bf_hi(uu.y) * (acc[ct][3] + bsv);
            u32x2 o; o.x = pk_bf16(y0, y1); o.y = pk_bf16(y2, y3);
            *(u32x2*)(Y + rowo * D + ch) = o; }
    }
}

DI void phase_ln1(const Ctx& c, int L) {
    const Params& p = *c.p; bf16_t* XS = (bf16_t*)(c.ws + WS_XS); const float* MOD = (const float*)(c.ws + WS_MOD) + (size_t)L * 17 * 6144;
    bf16_t* H2 = (bf16_t*)(c.ws + WS_R2 + SZ_T1K);
    const float* lg = p.in[6] + (size_t)(L * 2 + 0) * D; const float* lb = p.in[7] + (size_t)(L * 2 + 0) * D;
    const int nrows = (L == DEPTH - 1) ? TL : T;
    for (int row = c.bid * NWAVE + c.wave; row < nrows; row += c.G * NWAVE) {
        bf16_t* xp = XS + (size_t)row * D; const float* m = MOD + (size_t)mod_batch(row) * 6144;
        f32x4 x[4]; float s = 0.f;
#pragma unroll
        for (int j = 0; j < 4; ++j) { const u32x2 v = *(const u32x2*)(xp + 4 * c.lane + 256 * j); x[j] = (f32x4){bf_lo(v.x), bf_hi(v.x), bf_lo(v.y), bf_hi(v.y)}; s += (x[j][0] + x[j][1]) + (x[j][2] + x[j][3]); }
        const float mean = wave_sum(s) * (1.0f / 1024.0f);
        float q = 0.f;
#pragma unroll
        for (int j = 0; j < 4; ++j) { const f32x4 d = x[j] - mean; q += (d[0] * d[0] + d[1] * d[1]) + (d[2] * d[2] + d[3] * d[3]); }
        const float rstd = rsqrtf(wave_sum(q) * (1.0f / 1024.0f) + LN_EPS);
#pragma unroll
        for (int j = 0; j < 4; ++j) { const int col = 4 * c.lane + 256 * j;
            const f32x4 y = (x[j] - mean) * rstd * *(const f32x4*)(lg + col) + *(const f32x4*)(lb + col);
            u32x2 xw; xw.x = pk_bf16(y[0], y[1]); xw.y = pk_bf16(y[2], y[3]);
            *(u32x2*)(xp + col) = xw;
            const f32x4 h = y * (*(const f32x4*)(m + 4 * 1024 + col) + 1.0f) + *(const f32x4*)(m + 3 * 1024 + col);
            u32x2 w; w.x = pk_bf16(h[0], h[1]); w.y = pk_bf16(h[2], h[3]);
            *(u32x2*)(H2 + (size_t)row * D + col) = w; }
    }
}

DI int f2key(float v) { const int i = __float_as_int(v); return i ^ ((i >> 31) & 0x7fffffff); }
DI float key2f(int k) { return __int_as_float(k ^ ((k >> 31) & 0x7fffffff)); }
DI void phase_route(const Ctx& c, int L) {
    const Params& p = *c.p; unsigned char* ws = c.ws; const int lane = c.lane, g = lane >> 4, cc = lane & 15;
    constexpr int LDK = 72, LDS_S = 20;
    bf16_t* keysHi = (bf16_t*)c.smem;
    bf16_t* keysLo = keysHi + 2 * 128 * LDK;
    float* sbase = (float*)(keysLo + 2 * 128 * LDK);
    unsigned* ilist = (unsigned*)(sbase + NWAVE * 64 * LDS_S);
    __syncthreads();
    { const float* gk = p.in[20] + (size_t)L * 2 * 128 * 64;
      f32x4 kv[8];
#pragma unroll
      for (int it = 0; it < 8; ++it) kv[it] = ((const f32x4*)gk)[it * NTHR + c.tid];
#pragma unroll
      for (int it = 0; it < 8; ++it) { const int i = (it * NTHR + c.tid) * 4, row = i >> 6, d = i & 63; unsigned hi[2], lo[2];
#pragma unroll
          for (int e = 0; e < 2; ++e) { const unsigned ph = pk_bf16(kv[it][2 * e], kv[it][2 * e + 1]); hi[e] = ph; lo[e] = pk_bf16(kv[it][2 * e] - bf_lo(ph), kv[it][2 * e + 1] - bf_hi(ph)); }
          *(u32x2*)(keysHi + row * LDK + d) = (u32x2){hi[0], hi[1]}; *(u32x2*)(keysLo + row * LDK + d) = (u32x2){lo[0], lo[1]}; } }
    __syncthreads();
    float* S = sbase + c.wave * 64 * LDS_S;
    const bf16_t* QP = (const bf16_t*)(ws + WS_R1); int* IDX = (int*)(ws + WS_R1 + SZ_T1K); float* WT = (float*)(ws + WS_R1 + SZ_T1K + (size_t)T * 128 * 4);
    unsigned* myl = ilist + c.tid * 8; const unsigned char* mylb = (const unsigned char*)myl;
    const int ntask = (((L == DEPTH - 1) ? TL : T) / 64) * 8;
    for (int task = c.bid * NWAVE + c.wave; task < ntask; task += c.G * NWAVE) {
        const int t0 = (task >> 3) * 64, h = task & 7, tok = t0 + lane;
        float t12[2][16];
#pragma unroll
        for (int half = 0; half < 2; ++half) {
            bf16x8 aq[4][2];
#pragma unroll
            for (int mt = 0; mt < 4; ++mt)
#pragma unroll
                for (int ks = 0; ks < 2; ++ks) aq[mt][ks] = *(const bf16x8*)(QP + (size_t)(t0 + 16 * mt + cc) * D + h * 128 + half * 64 + 32 * ks + 8 * g);
            const bf16_t* kh = keysHi + half * 128 * LDK; const bf16_t* kl = keysLo + half * 128 * LDK;
#pragma unroll
            for (int i = 0; i < 16; ++i) t12[half][i] = -3.0e38f;
            for (int nt = 0; nt < 8; ++nt) {
                const bf16x8 bh0 = frag_ld(kh, LDK, 16 * nt, 0, lane), bh1 = frag_ld(kh, LDK, 16 * nt, 32, lane), bl0 = frag_ld(kl, LDK, 16 * nt, 0, lane), bl1 = frag_ld(kl, LDK, 16 * nt, 32, lane);
#pragma unroll
                for (int mt = 0; mt < 4; ++mt) { f32x4 a = {0.f, 0.f, 0.f, 0.f};
                    a = mfma16(aq[mt][0], bl0, a); a = mfma16(aq[mt][1], bl1, a); a = mfma16(aq[mt][0], bh0, a); a = mfma16(aq[mt][1], bh1, a);
#pragma unroll
                    for (int r = 0; r < 4; ++r) S[(16 * mt + 4 * g + r) * LDS_S + cc] = a[r]; }
                f32x4 sc[4];
#pragma unroll
                for (int q4 = 0; q4 < 4; ++q4) sc[q4] = *(const f32x4*)(S + lane * LDS_S + 4 * q4);
#pragma unroll
                for (int kk = 0; kk < 16; ++kk) { const float key = __int_as_float((__float_as_int(sc[kk >> 2][kk & 3]) & ~127) | (127 - (16 * nt + kk)));
#pragma unroll
                    for (int i = 15; i >= 1; --i) t12[half][i] = __builtin_amdgcn_fmed3f(key, t12[half][i - 1], t12[half][i]);
                    t12[half][0] = __builtin_amdgcn_fmed3f(key, 3.0e38f, t12[half][0]); }
            }
        }
        float v1[16], v2[16];
#pragma unroll
        for (int i = 0; i < 16; ++i) { v1[i] = __int_as_float(__float_as_int(t12[0][i]) & ~127); v2[i] = __int_as_float(__float_as_int(t12[1][i]) & ~127); }
#pragma unroll
        for (int i = 0; i < 4; ++i) {
            myl[i] = (unsigned)(127 - (__float_as_int(t12[0][4 * i]) & 127)) | ((unsigned)(127 - (__float_as_int(t12[0][4 * i + 1]) & 127)) << 8) | ((unsigned)(127 - (__float_as_int(t12[0][4 * i + 2]) & 127)) << 16) | ((unsigned)(127 - (__float_as_int(t12[0][4 * i + 3]) & 127)) << 24);
            myl[4 + i] = (unsigned)(127 - (__float_as_int(t12[1][4 * i]) & 127)) | ((unsigned)(127 - (__float_as_int(t12[1][4 * i + 1]) & 127)) << 8) | ((unsigned)(127 - (__float_as_int(t12[1][4 * i + 2]) & 127)) << 16) | ((unsigned)(127 - (__float_as_int(t12[1][4 * i + 3]) & 127)) << 24); }
        float f[16];
#pragma unroll
        for (int i = 0; i < 16; ++i) f[i] = -3.0e38f;
#pragma unroll
        for (int a = 0; a < 16; ++a)
#pragma unroll
            for (int b = 0; b < 16; ++b)
                if ((a + 1) * (b + 1) <= 16) {
                    const float key = __int_as_float((__float_as_int(v1[a] + v2[b]) & ~255) | (255 - (a * 16 + b)));
#pragma unroll
                    for (int i = 15; i >= 1; --i) f[i] = __builtin_amdgcn_fmed3f(key, f[i - 1], f[i]);
                    f[0] = __builtin_amdgcn_fmed3f(key, 3.0e38f, f[0]);
                }
        float e[16], se = 0.f; int fi[16];
        const float vmax = __int_as_float(__float_as_int(f[0]) & ~255);
#pragma unroll
        for (int i = 0; i < 16; ++i) { const int code = 255 - (__float_as_int(f[i]) & 255); fi[i] = (int)mylb[code >> 4] * 128 + (int)mylb[16 + (code & 15)];
            e[i] = __expf(__int_as_float(__float_as_int(f[i]) & ~255) - vmax); se += e[i]; }
        const float inv = 1.0f / se;
        int* ip = IDX + (size_t)tok * 128 + h * 16; float* wp = WT + (size_t)tok * 128 + h * 16;
#pragma unroll
        for (int i = 0; i < 16; i += 4) { *(int4*)(ip + i) = make_int4(fi[i], fi[i + 1], fi[i + 2], fi[i + 3]); *(f32x4*)(wp + i) = (f32x4){e[i] * inv, e[i + 1] * inv, e[i + 2] * inv, e[i + 3] * inv}; }
    }
}

DI float red8(float p) { p += dpp_mov<0xB1>(p); p += dpp_mov<0x4E>(p); p += dpp_mov<0x141>(p); return p; }
DI void phase_experts(const Ctx& c, int L) {
    const Params& p = *c.p; unsigned char* ws = c.ws; const int lane = c.lane, g8 = lane >> 3, j = lane & 7;
    constexpr int MAXTOK = 18;
    const bf16_t* H2 = (const bf16_t*)(ws + WS_R2 + SZ_T1K);
    const int* IDX = (const int*)(ws + WS_R1 + SZ_T1K); const float* WT = (const float*)(ws + WS_R1 + SZ_T1K + (size_t)T * 128 * 4);
    bf16_t* FFN = (bf16_t*)(ws + WS_R1);
    const unsigned char* UT = ws + WS_UT + (size_t)L * NEXP * 512; const unsigned char* VT = ws + WS_VT + (size_t)L * NEXP * 512;
    const float* SU = (const float*)(ws + WS_SU) + (size_t)L * NEXP; const float* SV = (const float*)(ws + WS_SV) + (size_t)L * NEXP;
    bf16_t* XS = (bf16_t*)(ws + WS_XS); bf16_t* H1 = (bf16_t*)(ws + WS_H1);
    const float* MOD = (const float*)(ws + WS_MOD) + (size_t)L * 17 * 6144;
    const float* lg = p.in[6] + (size_t)(L * 2 + 1) * D; const float* lb = p.in[7] + (size_t)(L * 2 + 1) * D;
    const int nrows = (L == DEPTH - 1) ? TL : T;
    float* ZL = (float*)c.smem + c.wave * MAXTOK * 128;
    unsigned short* IL = (unsigned short*)(c.smem + NWAVE * MAXTOK * 128 * 4) + c.wave * MAXTOK * 128;
    const int GW = c.G * NWAVE, gw = c.bid * NWAVE + c.wave;
    const int tsrc = 8 * (lane & 7) + (lane >> 3);
    for (int base = 0; base < nrows; base += GW * MAXTOK) {
        int ntok = 0;
        for (int k = 0; k < MAXTOK; ++k) { const int tok = base + gw + GW * k; if (tok < nrows) { ntok = k + 1;
            IL[k * 128 + lane] = (unsigned short)IDX[(size_t)tok * 128 + lane]; IL[k * 128 + 64 + lane] = (unsigned short)IDX[(size_t)tok * 128 + 64 + lane]; } }
        for (int c4 = 0; c4 < 4; ++c4) {
            const unsigned char* Ub = UT + (size_t)c4 * NEXP * 128 + 16 * j;
            const bf16_t* Xb = H2 + 256 * c4 + 32 * j;
            u32x4 rA[8], rB[8];
            f32x2 xf[16];
            u32x4 xr[4];
#define U_LOADX(k_) do { const bf16_t* xp_ = Xb + (size_t)(base + gw + GW * (k_)) * D; \
                _Pragma("unroll") for (int t = 0; t < 4; ++t) xr[t] = *(const u32x4*)(xp_ + 8 * t); } while (0)
#define U_UNPACKX() do { _Pragma("unroll") for (int t = 0; t < 4; ++t) { \
                    _Pragma("unroll") for (int q = 0; q < 4; ++q) xf[4 * t + q] = (f32x2){bf_lo(xr[t][q]), bf_hi(xr[t][q])}; } } while (0)
#define U_ISSUE(R, k_, hf_) do { _Pragma("unroll") for (int i = 0; i < 8; ++i) { const unsigned e = IL[(k_) * 128 + 64 * (hf_) + 8 * i + g8]; R[i] = *(const u32x4*)(Ub + (size_t)e * 128); } } while (0)
#define U_COMPUTE(R, k_, hf_) do { float ra = 0.f; \
                _Pragma("unroll") for (int i = 0; i < 8; ++i) { f32x2 acc = {0.f, 0.f}; \
                    _Pragma("unroll") for (int q = 0; q < 4; ++q) { \
                        acc += __builtin_amdgcn_cvt_scalef32_pk_f32_fp4(R[i][q], 1.0f, 0) * xf[4 * q]; acc += __builtin_amdgcn_cvt_scalef32_pk_f32_fp4(R[i][q], 1.0f, 1) * xf[4 * q + 1]; \
                        acc += __builtin_amdgcn_cvt_scalef32_pk_f32_fp4(R[i][q], 1.0f, 2) * xf[4 * q + 2]; acc += __builtin_amdgcn_cvt_scalef32_pk_f32_fp4(R[i][q], 1.0f, 3) * xf[4 * q + 3]; } \
                    const float pr = red8(acc[0] + acc[1]); ra = (j == i) ? pr : ra; } \
                const float za = __shfl(ra, tsrc, 64); \
                if (c4 == 0) ZL[(k_) * 128 + 64 * (hf_) + lane] = za; else ZL[(k_) * 128 + 64 * (hf_) + lane] += za; } while (0)
            if (ntok > 0) { U_LOADX(0); U_ISSUE(rA, 0, 0); }
            for (int k = 0; k < ntok; ++k) {
                const int kn = (k + 1 < ntok) ? k + 1 : k;
                U_ISSUE(rB, k, 1);
                U_UNPACKX();
                U_COMPUTE(rA, k, 0);
                U_LOADX(kn); U_ISSUE(rA, kn, 0);
                U_COMPUTE(rB, k, 1);
            }
#undef U_LOADX
#undef U_UNPACKX
#undef U_ISSUE
#undef U_COMPUTE
        }
        for (int k = 0; k < ntok; ++k) { const int tok = base + gw + GW * k;
#pragma unroll
            for (int hh = 0; hh < 2; ++hh) { const unsigned e = IL[k * 128 + 64 * hh + lane]; const float wv = WT[(size_t)tok * 128 + 64 * hh + lane];
                ZL[k * 128 + 64 * hh + lane] = gelu_tanh(ZL[k * 128 + 64 * hh + lane] * SU[e]) * wv * SV[e]; } }
        for (int c4 = 0; c4 < 4; ++c4) {
            const unsigned char* Vb = VT + (size_t)c4 * NEXP * 128 + 16 * j;
            const bool hi8 = (lane & 8) != 0;
            u32x4 rA[8], rB[8];
            f32x2 o[16];
#define V_ISSUE(R, k_, hf_) do { _Pragma("unroll") for (int i = 0; i < 8; ++i) { const unsigned e = IL[(k_) * 128 + 64 * (hf_) + 8 * i + g8]; R[i] = *(const u32x4*)(Vb + (size_t)e * 128); } } while (0)
#define V_ACC(R, k_, hf_) do { float av[8]; \
                _Pragma("unroll") for (int i = 0; i < 8; ++i) av[i] = ZL[(k_) * 128 + 64 * (hf_) + 8 * i + g8]; \
                _Pragma("unroll") for (int i = 0; i < 8; ++i) { const f32x2 a2 = {av[i], av[i]}; \
                    _Pragma("unroll") for (int q = 0; q < 4; ++q) { \
                        o[4 * q] += a2 * __builtin_amdgcn_cvt_scalef32_pk_f32_fp4(R[i][q], 1.0f, 0); o[4 * q + 1] += a2 * __builtin_amdgcn_cvt_scalef32_pk_f32_fp4(R[i][q], 1.0f, 1); \
                        o[4 * q + 2] += a2 * __builtin_amdgcn_cvt_scalef32_pk_f32_fp4(R[i][q], 1.0f, 2); o[4 * q + 3] += a2 * __builtin_amdgcn_cvt_scalef32_pk_f32_fp4(R[i][q], 1.0f, 3); } } } while (0)
#define V_FINISH(k_) do { const int tok_ = base + gw + GW * (k_); \
                f32x2 q8[8]; \
                _Pragma("unroll") for (int m = 0; m < 8; ++m) { \
                    const auto s0 = __builtin_amdgcn_permlane32_swap(__float_as_uint(o[m][0]), __float_as_uint(o[m + 8][0]), false, false); \
                    const auto s1 = __builtin_amdgcn_permlane32_swap(__float_as_uint(o[m][1]), __float_as_uint(o[m + 8][1]), false, false); \
                    q8[m] = (f32x2){__uint_as_float(s0[0]) + __uint_as_float(s0[1]), __uint_as_float(s1[0]) + __uint_as_float(s1[1])}; } \
                f32x2 q4[4]; \
                _Pragma("unroll") for (int m = 0; m < 4; ++m) { \
                    const auto s0 = __builtin_amdgcn_permlane16_swap(__float_as_uint(q8[m][0]), __float_as_uint(q8[m + 4][0]), false, false); \
                    const auto s1 = __builtin_amdgcn_permlane16_swap(__float_as_uint(q8[m][1]), __float_as_uint(q8[m + 4][1]), false, false); \
                    q4[m] = (f32x2){__uint_as_float(s0[0]) + __uint_as_float(s0[1]), __uint_as_float(s1[0]) + __uint_as_float(s1[1])}; } \
                float fo[4]; \
                _Pragma("unroll") for (int m = 0; m < 2; ++m) { \
                    const float k0 = hi8 ? q4[m + 2][0] : q4[m][0], k1 = hi8 ? q4[m + 2][1] : q4[m][1], t0 = hi8 ? q4[m][0] : q4[m + 2][0], t1 = hi8 ? q4[m][1] : q4[m + 2][1]; \
                    fo[2 * m] = k0 + dpp_mov<0x128>(t0); fo[2 * m + 1] = k1 + dpp_mov<0x128>(t1); } \
                u32x2 w_; w_.x = pk_bf16(fo[0], fo[1]); w_.y = pk_bf16(fo[2], fo[3]); \
                *(u32x2*)(FFN + (size_t)tok_ * D + 256 * c4 + 32 * j + 4 * g8) = w_; } while (0)
            if (ntok > 0) V_ISSUE(rA, 0, 0);
            for (int k = 0; k < ntok; ++k) {
                V_ISSUE(rB, k, 1);
#pragma unroll
                for (int q = 0; q < 16; ++q) o[q] = (f32x2){0.f, 0.f};
                V_ACC(rA, k, 0);
                V_ISSUE(rA, ((k + 1 < ntok) ? k + 1 : k), 0);
                V_ACC(rB, k, 1);
                V_FINISH(k);
            }
#undef V_ISSUE
#undef V_ACC
#undef V_FINISH
        }
        asm volatile("s_waitcnt vmcnt(0)" ::: "memory");
        for (int k = 0; k < ntok; ++k) { const int row = base + gw + GW * k;
            bf16_t* xp = XS + (size_t)row * D + 16 * lane; const int mb = mod_batch(row); const float* m = MOD + (size_t)mb * 6144 + 16 * lane;
            const u32x4 fa = *(const u32x4*)(FFN + (size_t)row * D + 16 * lane), fb = *(const u32x4*)(FFN + (size_t)row * D + 16 * lane + 8);
            const u32x4 xa = *(const u32x4*)xp, xb = *(const u32x4*)(xp + 8);
            float o[16], x1[16];
#pragma unroll
            for (int q = 0; q < 4; ++q) { o[2 * q] = bf_lo(fa[q]); o[2 * q + 1] = bf_hi(fa[q]); o[8 + 2 * q] = bf_lo(fb[q]); o[9 + 2 * q] = bf_hi(fb[q]);
                x1[2 * q] = bf_lo(xa[q]); x1[2 * q + 1] = bf_hi(xa[q]); x1[8 + 2 * q] = bf_lo(xb[q]); x1[9 + 2 * q] = bf_hi(xb[q]); }
            float y[16]; float s = 0.f;
#pragma unroll
            for (int qd = 0; qd < 4; ++qd) { const f32x4 g2 = *(const f32x4*)(m + 5 * 1024 + 4 * qd);
#pragma unroll
                for (int e = 0; e < 4; ++e) { y[4 * qd + e] = DN_ALPHA * x1[4 * qd + e] + g2[e] * o[4 * qd + e]; s += y[4 * qd + e]; } }
            const float mean = wave_sum(s) * (1.0f / 1024.0f);
            float q = 0.f;
#pragma unroll
            for (int e = 0; e < 16; ++e) { const float d = y[e] - mean; q += d * d; }
            const float rstd = rsqrtf(wave_sum(q) * (1.0f / 1024.0f) + LN_EPS);
            const float* mn = (const float*)(ws + WS_MOD) + (size_t)(L + 1 < DEPTH ? L + 1 : L) * 17 * 6144 + (size_t)mb * 6144 + 16 * lane;
            float x2[16];
#pragma unroll
            for (int qd = 0; qd < 4; ++qd) { const int col = 16 * lane + 4 * qd;
                const f32x4 gg = *(const f32x4*)(lg + col), bb = *(const f32x4*)(lb + col);
#pragma unroll
                for (int e = 0; e < 4; ++e) x2[4 * qd + e] = (y[4 * qd + e] - mean) * rstd * gg[e] + bb[e]; }
            if (L == DEPTH - 1) {
#pragma unroll
                for (int qd = 0; qd < 4; ++qd) *(f32x4*)(p.out + (size_t)row * D + 16 * lane + 4 * qd) = (f32x4){x2[4 * qd], x2[4 * qd + 1], x2[4 * qd + 2], x2[4 * qd + 3]};
            } else {
                float hh[16];
#pragma unroll
                for (int qd = 0; qd < 4; ++qd) { const f32x4 s1 = *(const f32x4*)(mn + 1024 + 4 * qd), sh = *(const f32x4*)(mn + 4 * qd);
#pragma unroll
                    for (int e = 0; e < 4; ++e) hh[4 * qd + e] = x2[4 * qd + e] * (s1[e] + 1.0f) + sh[e]; }
#pragma unroll
                for (int hf = 0; hf < 2; ++hf) { u32x4 wx, wh;
#pragma unroll
                    for (int q2 = 0; q2 < 4; ++q2) { wx[q2] = pk_bf16(x2[8 * hf + 2 * q2], x2[8 * hf + 2 * q2 + 1]); wh[q2] = pk_bf16(hh[8 * hf + 2 * q2], hh[8 * hf + 2 * q2 + 1]); }
                    *(u32x4*)(xp + 8 * hf) = wx; *(u32x4*)(H1 + (size_t)row * D + 16 * lane + 8 * hf) = wh; }
            }
        }
    }
}

DI float logsig_fast(float z) { return fminf(z, 0.f) - __logf(1.0f + __expf(-fabsf(z))); }
template <int DIR>
DI float gla_prep_gates(const bf16_t* Qt, const bf16_t* Kt, bf16_t* OUT, const float* gl, const float (&wg)[16], float bias, int cl, unsigned (&kpk)[32]) {
    constexpr int dir = DIR;
    { int z_ = 0; asm volatile("" : "+v"(z_)); gl += z_; }
    float cum = 0.f;
#pragma unroll
        for (int blk = 0; blk < 8; ++blk) {
            float gs[8];
#pragma unroll
            for (int e = 0; e < 8; ++e) { const int i = (dir ? 56 - 8 * blk : 8 * blk) + e; float z = bias; const f32x4* gp = (const f32x4*)(gl + i * 32 + dir * 16);
#pragma unroll
                for (int r4 = 0; r4 < 4; ++r4) { const f32x4 gv = gp[r4]; z += gv[0] * wg[4 * r4] + gv[1] * wg[4 * r4 + 1] + gv[2] * wg[4 * r4 + 2] + gv[3] * wg[4 * r4 + 3]; }
                gs[e] = logsig_fast(z) * (1.0f / 16.0f); }
            float kiv[8];
#pragma unroll
            for (int e = 0; e < 8; ++e) { const int pos = dir ? 7 - e : e, i = (dir ? 56 - 8 * blk : 8 * blk) + pos;
                cum += gs[pos];
                const float qv = bf1(Qt[i * 256 + cl]), kv = bf1(Kt[i * 256 + cl]);
                OUT[(dir * 64 + i) * 256 + cl] = f2bf(qv * __expf(cum)); kiv[pos] = kv * __expf(-cum); }
            u32x4 w; w.x = pk_bf16(kiv[0], kiv[1]); w.y = pk_bf16(kiv[2], kiv[3]); w.z = pk_bf16(kiv[4], kiv[5]); w.w = pk_bf16(kiv[6], kiv[7]);
            if (dir) { kpk[4 * (7 - blk)] = w.x; kpk[4 * (7 - blk) + 1] = w.y; kpk[4 * (7 - blk) + 2] = w.z; kpk[4 * (7 - blk) + 3] = w.w; }
            else { kpk[4 * blk] = w.x; kpk[4 * blk + 1] = w.y; kpk[4 * blk + 2] = w.z; kpk[4 * blk + 3] = w.w; }
            __builtin_amdgcn_sched_barrier(0);
        }
    return cum;
}
DI void phase_gla_prep(const Ctx& c, int j) {
    const Params& p = *c.p; unsigned char* ws = c.ws; const int tid = c.tid;
    const bf16_t* QG = (const bf16_t*)(ws + WS_R1); const bf16_t* KG = (const bf16_t*)(ws + WS_R1 + SZ_T512); const bf16_t* VG = (const bf16_t*)(ws + WS_R1 + 2 * SZ_T512);
    const float* GL = (const float*)(ws + WS_GL); float* DEC = (float*)(ws + WS_DEC); bf16_t* VTt = (bf16_t*)(ws + WS_VTT);
    bf16_t* Qt = (bf16_t*)c.smem;
    bf16_t* Kt = Qt + 64 * 256;
    bf16_t* OUT = Kt + 64 * 256;
    float* gl = (float*)(c.smem + 131072);
    const int dir = __builtin_amdgcn_readfirstlane(tid >> 8), cl = tid & 255;
    for (int u = c.bid; u < (T / 64) * 2; u += c.G) {
        const int ch = u >> 1, hc = u & 1, r0 = ch * 64, cg = 256 * hc + cl;
        __syncthreads();
#pragma unroll
        for (int it = 0; it < 4; ++it) { const int idx = it * 512 + tid, row = idx >> 5, c8 = (idx & 31) * 8;
            *(u32x4*)(Qt + row * 256 + c8) = *(const u32x4*)(QG + (size_t)(r0 + row) * 512 + 256 * hc + c8);
            *(u32x4*)(Kt + row * 256 + c8) = *(const u32x4*)(KG + (size_t)(r0 + row) * 512 + 256 * hc + c8); }
        ((f32x4*)gl)[tid] = ((const f32x4*)(GL + (size_t)r0 * 32))[tid];
        float wg[16];
#pragma unroll
        for (int r = 0; r < 16; ++r) wg[r] = p.in[15][((size_t)(j * 2 + dir) * 16 + r) * 512 + cg];
        const float bias = p.in[16][(size_t)(j * 2 + dir) * 512 + cg];
        __syncthreads();
        unsigned kpk[32];
        const float cum = dir ? gla_prep_gates<1>(Qt, Kt, OUT, gl, wg, bias, cl, kpk) : gla_prep_gates<0>(Qt, Kt, OUT, gl, wg, bias, cl, kpk);
        DEC[((size_t)dir * (T / 64) + ch) * 512 + cg] = __expf(cum);
        __syncthreads();
#pragma unroll 2
        for (int it = 0; it < 8; ++it) { const int idx = it * 512 + tid, d2 = idx >> 11, row = (idx >> 5) & 63, c8 = (idx & 31) * 8;
            *(u32x4*)((bf16_t*)(ws + WS_R2) + (size_t)d2 * T * 512 + (size_t)(r0 + row) * 512 + 256 * hc + c8) = *(const u32x4*)(OUT + (d2 * 64 + row) * 256 + c8); }
        bf16_t* KT = Qt;
#pragma unroll
        for (int cb = 0; cb < 8; ++cb) *(u32x4*)(KT + (dir * 256 + cl) * 64 + ((cb ^ (cl & 7)) * 8)) = (u32x4){kpk[4 * cb], kpk[4 * cb + 1], kpk[4 * cb + 2], kpk[4 * cb + 3]};
        __syncthreads();
#pragma unroll 2
        for (int it = 0; it < 8; ++it) { const int idx = it * 512 + tid, d2 = idx >> 11, clr = (idx >> 3) & 255, cb = idx & 7;
            *(u32x4*)((bf16_t*)(ws + WS_R2 + 2 * SZ_T1K) + (((size_t)d2 * (T / 64) + ch) * 512 + 256 * hc + clr) * 64 + cb * 8) = *(const u32x4*)(KT + (d2 * 256 + clr) * 64 + ((cb ^ (clr & 7)) * 8)); }
#pragma unroll
        for (int i2 = 0; i2 < 32; ++i2) { OUT[(dir * 64 + 2 * i2) * 256 + cl] = (bf16_t)(kpk[i2] & 0xffffu); OUT[(dir * 64 + 2 * i2 + 1) * 256 + cl] = (bf16_t)(kpk[i2] >> 16); }
        __syncthreads();
#pragma unroll 2
        for (int it = 0; it < 8; ++it) { const int idx = it * 512 + tid, d2 = idx >> 11, row = (idx >> 5) & 63, c8 = (idx & 31) * 8;
            *(u32x4*)((bf16_t*)(ws + WS_R2 + SZ_T1K) + (size_t)d2 * T * 512 + (size_t)(r0 + row) * 512 + 256 * hc + c8) = *(const u32x4*)(OUT + (d2 * 64 + row) * 256 + c8); }
        bf16_t* Vl = Qt;
#pragma unroll 2
        for (int it = 0; it < 8; ++it) { const int idx = it * 512 + tid, row = idx >> 6, c8 = (idx & 63) * 8;
            *(u32x4*)(Vl + row * 512 + c8) = *(const u32x4*)(VG + (size_t)(r0 + row) * 1024 + 512 * hc + c8); }
        __syncthreads();
        bf16_t* VTl = OUT;
#pragma unroll 2
        for (int cb = 0; cb < 8; ++cb) { unsigned short x[8];
#pragma unroll
            for (int t = 0; t < 8; ++t) x[t] = Vl[(8 * cb + t) * 512 + tid];
            u32x4 w; w.x = (unsigned)x[0] | ((unsigned)x[1] << 16); w.y = (unsigned)x[2] | ((unsigned)x[3] << 16); w.z = (unsigned)x[4] | ((unsigned)x[5] << 16); w.w = (unsigned)x[6] | ((unsigned)x[7] << 16);
            *(u32x4*)(VTl + tid * 64 + ((cb ^ (tid & 7)) * 8)) = w; }
        __syncthreads();
#pragma unroll 2
        for (int it = 0; it < 8; ++it) { const int idx = it * 512 + tid, er = idx >> 3, cb = idx & 7;
            *(u32x4*)(VTt + ((size_t)ch * 1024 + 512 * hc + er) * 64 + cb * 8) = *(const u32x4*)(VTl + er * 64 + ((cb ^ (er & 7)) * 8)); }
    }
}

DI void phase_gla_scan(const Ctx& c) {
    unsigned char* ws = c.ws; const int tid = c.tid, lane = c.lane, w = c.wave, g = lane >> 4, cc = lane & 15;
    const bf16_t* VTt = (const bf16_t*)(ws + WS_VTT); const float* DEC = (const float*)(ws + WS_DEC);
    constexpr int LDQ = 136, LDJ = 72;
    bf16_t* Qs = (bf16_t*)c.smem;
    bf16_t* Ks = Qs + 64 * LDQ;
    bf16_t* KEt = Ks + 64 * LDQ;
    bf16_t* Vt = KEt + 128 * LDJ;
    bf16_t* At = Vt + 128 * LDJ;
    bf16_t* St = At + 64 * LDJ;
    bf16_t* Ot = St + 128 * LDQ;
    float* dec = (float*)(Ot + 64 * LDQ);
    const int qtok0 = tid >> 4, qd8 = (tid & 15) * 8;
    const int ked0 = tid >> 3, kej8 = (tid & 7) * 8;
    for (int u = c.bid; u < NB * 4 * 2 * 2; u += c.G) {
        const int b = u >> 4, h = (u >> 2) & 3, es = (u >> 1) & 1, dir = u & 1;
        bf16_t* O = (bf16_t*)(ws + (dir ? WS_OB : WS_H1));
        const bf16_t* QIN = (const bf16_t*)(ws + WS_R2) + (size_t)dir * T * 512; const bf16_t* KIN = (const bf16_t*)(ws + WS_R2 + SZ_T1K) + (size_t)dir * T * 512;
        const bf16_t* KINt = (const bf16_t*)(ws + WS_R2 + 2 * SZ_T1K) + (size_t)dir * (T / 64) * 512 * 64;
        f32x4 accS[8];
#pragma unroll
        for (int et = 0; et < 8; ++et) accS[et] = (f32x4){0.f, 0.f, 0.f, 0.f};
        __syncthreads();
        for (int i = tid; i < 128 * LDQ / 2; i += NTHR) ((unsigned*)St)[i] = 0u;
        u32x4 pq[2], pk[2], pke[2], pv[2]; float pdec = 0.f;
#define GLA_R0(cs_) (dir == 0 ? ((cs_) < 4 ? TL + b * CTXL + 64 * (cs_) : b * SEQ + 64 * ((cs_) - 4)) : ((cs_) < 4 ? TL + b * CTXL + 64 * (3 - (cs_)) : b * SEQ + 64 * (35 - (cs_))))
#define GLA_LOAD(cs_) do { const int r0_ = GLA_R0(cs_); const int chunk_ = r0_ >> 6; \
            _Pragma("unroll") for (int it = 0; it < 2; ++it) { const size_t go = (size_t)(r0_ + qtok0 + 32 * it) * 512 + h * 128 + qd8; pq[it] = *(const u32x4*)(QIN + go); pk[it] = *(const u32x4*)(KIN + go); \
                pke[it] = *(const u32x4*)(KINt + ((size_t)chunk_ * 512 + h * 128 + ked0 + 64 * it) * 64 + kej8); \
                pv[it] = *(const u32x4*)(VTt + ((size_t)chunk_ * 1024 + h * 256 + es * 128 + ked0 + 64 * it) * 64 + kej8); } \
            if (tid < 128) pdec = DEC[((size_t)dir * (T / 64) + chunk_) * 512 + h * 128 + tid]; } while (0)
        GLA_LOAD(0);
        for (int cs = 0; cs < 36; ++cs) {
            const int r0 = GLA_R0(cs);
#pragma unroll
            for (int it = 0; it < 2; ++it) { *(u32x4*)(Qs + (qtok0 + 32 * it) * LDQ + qd8) = pq[it]; *(u32x4*)(Ks + (qtok0 + 32 * it) * LDQ + qd8) = pk[it];
                *(u32x4*)(KEt + (ked0 + 64 * it) * LDJ + kej8) = pke[it]; *(u32x4*)(Vt + (ked0 + 64 * it) * LDJ + kej8) = pv[it]; }
            if (tid < 128) dec[tid] = pdec;
            __syncthreads();
            GLA_LOAD(cs + 1 < 36 ? cs + 1 : cs);
            { const int it = w >> 1;
#pragma unroll
              for (int jj = 0; jj < 2; ++jj) { const int jt = 2 * (w & 1) + jj; f32x4 a = {0.f, 0.f, 0.f, 0.f};
#pragma unroll
                  for (int ks = 0; ks < 4; ++ks) a = mfma16(frag_ld(Qs, LDQ, 16 * it, 32 * ks, lane), frag_ld(Ks, LDQ, 16 * jt, 32 * ks, lane), a);
                  const int jcol = 16 * jt + cc;
#pragma unroll
                  for (int r = 0; r < 4; ++r) { const int i = 16 * it + 4 * g + r; const bool keep = dir ? (jcol >= i) : (jcol <= i);
                      At[i * LDJ + jcol] = f2bf(keep ? a[r] : 0.f); } } }
            __syncthreads();
            { const int it = w >> 1;
#pragma unroll
              for (int ee = 0; ee < 4; ++ee) { const int et = 4 * (w & 1) + ee; f32x4 a = {0.f, 0.f, 0.f, 0.f};
#pragma unroll
                  for (int ks = 0; ks < 2; ++ks) a = mfma16(frag_ld(At, LDJ, 16 * it, 32 * ks, lane), frag_ld(Vt, LDJ, 16 * et, 32 * ks, lane), a);
#pragma unroll
                  for (int ks = 0; ks < 4; ++ks) a = mfma16(frag_ld(Qs, LDQ, 16 * it, 32 * ks, lane), frag_ld(St, LDQ, 16 * et, 32 * ks, lane), a);
#pragma unroll
                  for (int r = 0; r < 4; ++r) Ot[(16 * it + 4 * g + r) * LDQ + 16 * et + cc] = f2bf(a[r]); } }
#pragma unroll
            for (int et = 0; et < 8; ++et) {
#pragma unroll
                for (int ks = 0; ks < 2; ++ks) accS[et] = mfma16(frag_ld(KEt, LDJ, 16 * w, 32 * ks, lane), frag_ld(Vt, LDJ, 16 * et, 32 * ks, lane), accS[et]);
#pragma unroll
                for (int r = 0; r < 4; ++r) accS[et][r] *= dec[16 * w + 4 * g + r];
            }
            __syncthreads();
#pragma unroll
            for (int et = 0; et < 8; ++et) { u32x2 sv; sv.x = pk_bf16(accS[et][0], accS[et][1]); sv.y = pk_bf16(accS[et][2], accS[et][3]);
                *(u32x2*)(St + (16 * et + cc) * LDQ + 16 * w + 4 * g) = sv; }
#pragma unroll
            for (int it = 0; it < 2; ++it) *(u32x4*)(O + (size_t)(r0 + qtok0 + 32 * it) * 1024 + h * 256 + es * 128 + qd8) = *(const u32x4*)(Ot + (qtok0 + 32 * it) * LDQ + qd8);
        }
#undef GLA_LOAD
#undef GLA_R0
    }
}

DI void phase_gla_readout(const Ctx& c, int j) {
    const Params& p = *c.p; unsigned char* ws = c.ws;
    const bf16_t* O = (const bf16_t*)(ws + WS_H1); const bf16_t* OB = (const bf16_t*)(ws + WS_OB); const bf16_t* RG = (const bf16_t*)(ws + WS_R1 + 2 * SZ_T512 + SZ_T1K); bf16_t* Y = (bf16_t*)(ws + WS_R2);
    const float* gn = p.in[17] + (size_t)j * 1024;
    for (int row = c.bid * NWAVE + c.wave; row < T; row += c.G * NWAVE) {
#pragma unroll
        for (int hd = 0; hd < 4; ++hd) { const int col = 4 * c.lane + 256 * hd;
            const u32x2 ov = *(const u32x2*)(O + (size_t)row * D + col), ow = *(const u32x2*)(OB + (size_t)row * D + col), rv = *(const u32x2*)(RG + (size_t)row * D + col);
            const float x0 = bf_lo(ov.x) + bf_lo(ow.x), x1 = bf_hi(ov.x) + bf_hi(ow.x), x2 = bf_lo(ov.y) + bf_lo(ow.y), x3 = bf_hi(ov.y) + bf_hi(ow.y);
            const float mean = wave_sum((x0 + x1) + (x2 + x3)) * (1.0f / 256.0f);
            const float d0 = x0 - mean, d1 = x1 - mean, d2 = x2 - mean, d3 = x3 - mean;
            const float rstd = rsqrtf(wave_sum((d0 * d0 + d1 * d1) + (d2 * d2 + d3 * d3)) * (1.0f / 256.0f) + LN_EPS);
            const f32x4 gg = *(const f32x4*)(gn + col);
            const float r0 = bf_lo(rv.x), r1 = bf_hi(rv.x), r2 = bf_lo(rv.y), r3 = bf_hi(rv.y);
            u32x2 o; o.x = pk_bf16(d0 * rstd * gg[0] * silu_f(r0), d1 * rstd * gg[1] * silu_f(r1)); o.y = pk_bf16(d2 * rstd * gg[2] * silu_f(r2), d3 * rstd * gg[3] * silu_f(r3));
            *(u32x2*)(Y + (size_t)row * D + col) = o; }
    }
}

constexpr int N_PHASES = 2 + 2 * 8 + 2 * 9;

__global__ void __launch_bounds__(NTHR, 2) mega_fwd(Params p) {
    extern __shared__ __attribute__((aligned(16))) unsigned char smem[];
    cg::grid_group grid = cg::this_grid();
    Ctx c; c.p = &p; c.ws = p.ws; c.smem = smem; c.tid = threadIdx.x; c.lane = c.tid & 63; c.wave = __builtin_amdgcn_readfirstlane(c.tid >> 6); c.G = gridDim.x; c.bid = blockIdx.x;
    unsigned char* ws = p.ws;
    volatile LAS unsigned* xst = (volatile LAS unsigned*)((LAS unsigned char*)smem + (LDS_BYTES - 16));
    if (threadIdx.x == 0) { xst[0] = 0u; xst[1] = 0u; }
    __syncthreads();
    const XcdBarrier xbar = xcd_barrier_post((unsigned*)(ws + WS_CTL), xst);
    const int lo = p.ph_lo, hi = p.ph_hi;
    int ph = 0;
#ifndef PH_ONLY
#define PH_ONLY -1
#endif
#ifndef DUP_MASK
#define DUP_MASK 0
#endif
#define RUN1(...) { { int t_ = threadIdx.x; asm volatile("" : "+v"(t_)); c.tid = t_; c.lane = t_ & 63; c.wave = __builtin_amdgcn_readfirstlane(t_ >> 6); { size_t z_ = 0; asm volatile("" : "+s"(z_)); ws = p.ws + z_; } c.ws = ws; } __VA_ARGS__; }
#define RUN(id, ...) do { if ((PH_ONLY < 0 || PH_ONLY == (id)) && ph >= lo && ph < hi) { \
        RUN1(__VA_ARGS__) \
        if ((DUP_MASK >> (id)) & 1) { xcd_barrier(xbar); RUN1(__VA_ARGS__) } \
        if (ph + 1 < hi) { if (ph == 0) grid.sync(); else xcd_barrier(xbar); } } ++ph; } while (0)
    LAS unsigned char* lds = (LAS unsigned char*)smem;
    const float* MOD = (const float*)(ws + WS_MOD);

    RUN(0, phase_prologue(c));
    RUN(1, phase_mod0(c));
    for (int L = 0; L < DEPTH; ++L) {
        const int j = L >> 1;
        if ((L & 1) == 0) {
            RUN(2, { pg8::Gemm g{(const bf16_t*)(ws + WS_H1), (const bf16_t*)(ws + WS_WAIN) + (size_t)j * 2048 * 1024, T, 2048, 1024}; pg8::StaticOrder S; S.init(T, 2048, c.G, c.bid);
                  pg8::EpiBf16<1> E{(bf16_t*)(ws + WS_R1), 2048}; pg8::gemm_phase(lds, g, S, E, c.tid); });
            RUN(3, phase_vstats(c));
            RUN(4, phase_spatial(c, j));
        } else {
            RUN(5, { pg8::Gemm g{(const bf16_t*)(ws + WS_H1), (const bf16_t*)(ws + WS_WBIN) + (size_t)j * WBIN_N * 1024, T, WBIN_N, 1024}; pg8::StaticOrder S; S.init(T, WBIN_N, c.G, c.bid);
                  pg8::EpiGlaProj E{(bf16_t*)(ws + WS_R1), (bf16_t*)(ws + WS_R1 + SZ_T512), (bf16_t*)(ws + WS_R1 + 2 * SZ_T512), (bf16_t*)(ws + WS_R1 + 2 * SZ_T512 + SZ_T1K), (float*)(ws + WS_GL)};
                  pg8::gemm_phase(lds, g, S, E, c.tid); });
            RUN(6, phase_gla_prep(c, j));
            RUN(7, phase_gla_scan(c));
            RUN(8, phase_gla_readout(c, j));
        }
        const int Mrows = (L == DEPTH - 1) ? TL : T;
        RUN(9, { const bf16_t* W = (L & 1) ? (const bf16_t*)(ws + WS_WBOUT) + (size_t)j * 1024 * 1024 : (const bf16_t*)(ws + WS_WAOUT) + (size_t)j * 1024 * 1024;
              pg8::Gemm g{(const bf16_t*)(ws + WS_R2), W, Mrows, 1024, 1024}; pg8::StaticOrder S; S.init(Mrows, 1024, c.G, c.bid);
              pg8::EpiRes E{p.in[0], p.in[2], (bf16_t*)(ws + WS_XS), MOD + (size_t)L * 17 * 6144, 2, L == 0 ? 1 : 0};
              pg8::gemm_phase(lds, g, S, E, c.tid); });
        RUN(10, phase_ln1(c, L));
        RUN(11, { pg8::Gemm g{(const bf16_t*)(ws + WS_R2 + SZ_T1K), (const bf16_t*)(ws + WS_WQ) + (size_t)L * 1024 * 1024, Mrows, 1024, 1024}; pg8::StaticOrder S; S.init(Mrows, 1024, c.G, c.bid);
              pg8::EpiBf16<0> E{(bf16_t*)(ws + WS_R1), 1024}; pg8::gemm_phase(lds, g, S, E, c.tid); });
        RUN(12, phase_route(c, L));
        RUN(13, phase_experts(c, L));
    }
#undef RUN
}

extern "C" void kernel_launch(void* const* d_in, const int* in_sizes, int n_in, void* d_out, int out_size, void* d_ws, size_t ws_size, hipStream_t stream) {
    static int grid = 0;
    if (grid == 0) {
        if (n_in != 23 || out_size != TL * D || ws_size < WS_END) { fprintf(stderr, "kernel_launch: unexpected shapes: n_in %d out %d ws %zu (need %zu)\n", n_in, out_size, ws_size, (size_t)WS_END); grid = -1; return; }
        int dev = 0, cus = 0, per_cu = 0;
        if (hipGetDevice(&dev) != hipSuccess || hipDeviceGetAttribute(&cus, hipDeviceAttributeMultiprocessorCount, dev) != hipSuccess) { fprintf(stderr, "kernel_launch: device query failed\n"); grid = -1; return; }
        if (hipFuncSetAttribute((const void*)mega_fwd, hipFuncAttributeMaxDynamicSharedMemorySize, LDS_BYTES) != hipSuccess) { fprintf(stderr, "kernel_launch: hipFuncSetAttribute failed\n"); grid = -1; return; }
        if (hipOccupancyMaxActiveBlocksPerMultiprocessor(&per_cu, (const void*)mega_fwd, NTHR, LDS_BYTES) != hipSuccess || per_cu < 1) { fprintf(stderr, "kernel_launch: occupancy query says %d blocks per CU\n", per_cu); grid = -1; return; }
        grid = cus;
    }
    if (grid < 0) return;
    (void)hipMemsetAsync((char*)d_ws + WS_CTL, 0, 65536, stream);
    Params p{};
    for (int i = 0; i < 23; ++i) p.in[i] = (const float*)d_in[i];
    p.out = (float*)d_out; p.ws = (unsigned char*)d_ws; p.ph_lo = 0; p.ph_hi = N_PHASES;
    void* args[] = {&p};
    const hipError_t e = hipLaunchCooperativeKernel((const void*)mega_fwd, dim3(grid), dim3(NTHR), args, LDS_BYTES, stream);
    if (e != hipSuccess) fprintf(stderr, "kernel_launch: cooperative launch failed: %s (grid %d)\n", hipGetErrorString(e), grid);
}
```

```cpp
#include <hip/hip_runtime.h>
#include <hip/hip_cooperative_groups.h>
#include <cstdio>
#include <cstdint>
namespace cg = cooperative_groups;

#define LAS __attribute__((address_space(3)))
#define DI __device__ __forceinline__
typedef unsigned short bf16_t;
typedef short bf16x8 __attribute__((ext_vector_type(8)));
typedef float f32x4 __attribute__((ext_vector_type(4)));
typedef float f32x2 __attribute__((ext_vector_type(2)));
typedef unsigned u32x4 __attribute__((ext_vector_type(4)));
typedef unsigned u32x2 __attribute__((ext_vector_type(2)));
typedef __bf16 bf16v2 __attribute__((ext_vector_type(2)));

constexpr int D = 1024, NB = 16, SEQ = 2048, CTXL = 256, DEPTH = 4;
constexpr int TL = NB * SEQ, TC = NB * CTXL, T = TL + TC;
constexpr int NEXP = 16384;
constexpr float LN_EPS = 1e-5f;
constexpr float DN_ALPHA = 1.6817928305074290f;
constexpr int NTHR = 512, NWAVE = 8;
constexpr int LDS_BYTES = 140 * 1024;
constexpr int WBIN_N = 3328;

constexpr size_t al256(size_t x) { return (x + 255) & ~(size_t)255; }
constexpr size_t WS_CTL = 0;
constexpr size_t WS_MOD = 65536;
constexpr size_t WS_STATS = al256(WS_MOD + (size_t)4 * 17 * 6144 * 4);
constexpr size_t WS_GL = al256(WS_STATS + (size_t)T * 2 * 4);
constexpr size_t WS_DEC = al256(WS_GL + (size_t)T * 32 * 4);
constexpr size_t WS_WSB = al256(WS_DEC + (size_t)2 * 576 * 512 * 4);
constexpr size_t WS_WAIN = al256(WS_WSB + (size_t)2 * 8 * 128 * 128 * 2);
constexpr size_t WS_WAOUT = WS_WAIN + (size_t)2 * 2048 * 1024 * 2;
constexpr size_t WS_WBIN = WS_WAOUT + (size_t)2 * 1024 * 1024 * 2;
constexpr size_t WS_WBOUT = WS_WBIN + (size_t)2 * WBIN_N * 1024 * 2;
constexpr size_t WS_WQ = WS_WBOUT + (size_t)2 * 1024 * 1024 * 2;
constexpr size_t WS_UT = WS_WQ + (size_t)4 * 1024 * 1024 * 2;
constexpr size_t WS_VT = WS_UT + (size_t)4 * NEXP * 1024;
constexpr size_t WS_SU = WS_VT + (size_t)4 * NEXP * 1024;
constexpr size_t WS_SV = WS_SU + (size_t)4 * NEXP * 4;
constexpr size_t WS_XS = WS_SV + (size_t)4 * NEXP * 4;
constexpr size_t WS_R1 = WS_XS + (size_t)T * 1024 * 4;
constexpr size_t WS_R2 = WS_R1 + (size_t)T * 3072 * 2;
constexpr size_t WS_H1 = WS_R2 + (size_t)T * 3072 * 2;
constexpr size_t WS_VTT = WS_H1 + (size_t)T * 1024 * 2;
constexpr size_t WS_OB = WS_VTT + (size_t)T * 1024 * 2;
constexpr size_t WS_END = WS_OB + (size_t)T * 1024 * 2;
constexpr size_t SZ_T1K = (size_t)T * 1024 * 2;
constexpr size_t SZ_T512 = (size_t)T * 512 * 2;

struct Params { const float* in[23]; float* out; unsigned char* ws; int ph_lo, ph_hi; };

DI unsigned pk_bf16(float lo, float hi) { f32x2 v = {lo, hi}; return __builtin_bit_cast(unsigned, __builtin_convertvector(v, bf16v2)); }
DI float bf_lo(unsigned w) { return __uint_as_float(w << 16); }
DI float bf_hi(unsigned w) { return __uint_as_float(w & 0xffff0000u); }
DI float bf1(bf16_t b) { return __uint_as_float(((unsigned)b) << 16); }
DI bf16_t f2bf(float f) { return (bf16_t)(pk_bf16(f, 0.f) & 0xffffu); }
DI float gelu_tanh(float x) { const float u = 0.7978845608028654f * (x + 0.044715f * x * x * x); return __fdividef(x, 1.0f + __expf(-2.0f * u)); }
DI float silu_f(float x) { return __fdividef(x, 1.0f + __expf(-x)); }
DI float logsig_f(float z) { return fminf(z, 0.f) - log1pf(expf(-fabsf(z))); }
template <int CTRL> DI float dpp_mov(float x) { return __builtin_bit_cast(float, __builtin_amdgcn_mov_dpp(__builtin_bit_cast(int, x), CTRL, 0xf, 0xf, true)); }
DI float wave_sum(float v) {
    const auto a = __builtin_amdgcn_permlane32_swap(__float_as_uint(v), __float_as_uint(v), false, false); v = __uint_as_float(a[0]) + __uint_as_float(a[1]);
    const auto b = __builtin_amdgcn_permlane16_swap(__float_as_uint(v), __float_as_uint(v), false, false); v = __uint_as_float(b[0]) + __uint_as_float(b[1]);
    v += dpp_mov<0x128>(v); v += dpp_mov<0x124>(v); v += dpp_mov<0x122>(v); v += dpp_mov<0x121>(v);
    return v;
}
DI float wave_max(float v) {
#pragma unroll
    for (int o = 32; o > 0; o >>= 1) v = fmaxf(v, __shfl_xor(v, o, 64));
    return v;
}
DI float reduce4(float p0, float p1, float p2, float p3) {
    const auto a = __builtin_amdgcn_permlane32_swap(__float_as_uint(p0), __float_as_uint(p2), false, false); const float q0 = __uint_as_float(a[0]) + __uint_as_float(a[1]);
    const auto b = __builtin_amdgcn_permlane32_swap(__float_as_uint(p1), __float_as_uint(p3), false, false); const float q1 = __uint_as_float(b[0]) + __uint_as_float(b[1]);
    const auto c = __builtin_amdgcn_permlane16_swap(__float_as_uint(q0), __float_as_uint(q1), false, false); float s = __uint_as_float(c[0]) + __uint_as_float(c[1]);
    s += dpp_mov<0x128>(s); s += dpp_mov<0x124>(s); s += dpp_mov<0x122>(s); s += dpp_mov<0x121>(s);
    return s;
}
DI float dot2bf(unsigned a, unsigned b, float c) { return __builtin_amdgcn_fdot2_f32_bf16(__builtin_bit_cast(bf16v2, a), __builtin_bit_cast(bf16v2, b), c, false); }
DI f32x4 mfma16(bf16x8 a, bf16x8 b, f32x4 c) { return __builtin_amdgcn_mfma_f32_16x16x32_bf16(a, b, c, 0, 0, 0); }
DI bf16x8 frag_ld(const bf16_t* X, int ld, int row0, int k0, int lane) { return *(const bf16x8*)(X + (size_t)(row0 + (lane & 15)) * ld + k0 + 8 * (lane >> 4)); }
DI int mod_batch(int row) { return row < TL ? (row >> 11) : NB; }

#define XB_TMO      128
#define XB_XCNT(j)  (256  + 64 * (j))
#define XB_XSUB(j)  (1280 + 64 * (j))
#define XB_XGEN(j)  (2304 + 64 * (j))
#define XB_TOP      3328
#define XB_TOPGEN   3392
#define XCD_BAR_WORDS 3456
#define XB_SPIN_CAP (1u << 22)
DI unsigned xb_ld(unsigned* p)              { return __hip_atomic_load(p, __ATOMIC_RELAXED, __HIP_MEMORY_SCOPE_AGENT); }
DI unsigned xb_add(unsigned* p, unsigned v) { return __hip_atomic_fetch_add(p, v, __ATOMIC_RELAXED, __HIP_MEMORY_SCOPE_AGENT); }
DI unsigned xb_xcc_id() { return (unsigned)__builtin_amdgcn_s_getreg((3 << 11) | 20) & 0xFu; }
#define XB_SPIN(cond, bar) do { unsigned _sp = 0; while (cond) { __builtin_amdgcn_s_sleep(1); \
    if ((++_sp & 255u) == 0u) { if (xb_ld(&(bar)[XB_TMO])) break; if (_sp > XB_SPIN_CAP) { atomicAdd(&(bar)[XB_TMO], 1u); break; } } } } while (0)
struct XcdBarrier { unsigned* bar; unsigned x; volatile LAS unsigned* st; };
DI XcdBarrier xcd_barrier_post(unsigned* bar, volatile LAS unsigned* st) {
    XcdBarrier b; b.bar = bar; b.x = xb_xcc_id(); b.st = st;
    if (threadIdx.x == 0) (void)xb_add(&bar[XB_XCNT(b.x)], 1u);
    return b;
}
DI void xcd_barrier_complete(unsigned* bar, unsigned x, unsigned& nloc, unsigned& nx) {
    const unsigned G = gridDim.x * gridDim.y * gridDim.z;
    unsigned sum, cnt, mine, sp = 0u;
    for (;;) {
        sum = 0u; cnt = 0u; mine = 0u;
#pragma unroll
        for (unsigned j = 0; j < 16; ++j) { const unsigned c = xb_ld(&bar[XB_XCNT(j)]); sum += c; cnt += (c > 0u) ? 1u : 0u; mine = (j == x) ? c : mine; }
        if (sum == G) break;
        __builtin_amdgcn_s_sleep(1);
        if ((++sp & 255u) == 0u) { if (xb_ld(&bar[XB_TMO])) break; if (sp > XB_SPIN_CAP) { atomicAdd(&bar[XB_TMO], 1u); break; } }
    }
    nloc = mine > 0u ? mine : 1u; nx = cnt > 0u ? cnt : 1u;
}
DI void xcd_barrier(const XcdBarrier& b) {
    asm volatile("s_waitcnt vmcnt(0)" ::: "memory");
    __syncthreads();
    if (threadIdx.x == 0) {
        unsigned* bar = b.bar;
        __builtin_amdgcn_s_waitcnt(0);
        unsigned nloc = b.st[0], nx = b.st[1];
        if (nloc == 0u) { xcd_barrier_complete(bar, b.x, nloc, nx); b.st[0] = nloc; b.st[1] = nx; }
        const unsigned old = xb_add(&bar[XB_XSUB(b.x)], 1u);
        const unsigned gen = old / nloc;
        if (old + 1u == (gen + 1u) * nloc) {
            __builtin_amdgcn_fence(__ATOMIC_RELEASE, "agent");
            asm volatile("s_waitcnt vmcnt(0)" ::: "memory");
            const unsigned og = xb_add(&bar[XB_TOP], 1u);
            const unsigned tg = og / nx;
            if (og + 1u == (tg + 1u) * nx) xb_add(&bar[XB_TOPGEN], 1u);
            else XB_SPIN(xb_ld(&bar[XB_TOPGEN]) == tg, bar);
            __builtin_amdgcn_fence(__ATOMIC_ACQUIRE, "agent");
            xb_add(&bar[XB_XGEN(b.x)], 1u);
            asm volatile("s_waitcnt vmcnt(0)" ::: "memory");
        } else {
            XB_SPIN(xb_ld(&bar[XB_XGEN(b.x)]) == gen, bar);
            __builtin_amdgcn_fence(__ATOMIC_ACQUIRE, "agent");
            asm volatile("s_waitcnt vmcnt(0)" ::: "memory");
        }
    }
    __syncthreads();
}

namespace pg8 {
constexpr int BM = 256, BK = 64, HALF = 128, HTB = HALF * BK * 2, STAGE_BYTES = 8 * HTB, NXCD = 8, WGM = 8;
__host__ __device__ __forceinline__ int lds_byte(int r, int c) { const int st = (r >> 4) * 2 + (c >> 5), rr = r & 15, cc = c & 31, ob = rr * 64 + cc * 2; return st * 1024 + (ob ^ (((ob >> 9) & 1) << 5)); }
__host__ __device__ __forceinline__ void stage_rc(int b, int& R, int& C) { const int st = b / 1024, sb = b % 1024, swz = sb ^ (((sb >> 9) & 1) << 5); R = (st >> 1) * 16 + swz / 64; C = (st & 1) * 32 + (swz % 64) / 2; }
__host__ __device__ __forceinline__ int perm32(int rho) { const int n = rho >> 4, i = rho & 15; return 8 * (i >> 2) + 4 * n + (i & 3); }
struct Unit { int pm, pn; };
struct Gemm { const bf16_t* A; const bf16_t* Bt; int M, N, K; };
struct StaticOrder {
    int nM, nN, nwg, G, c;
    __device__ void init(int M, int N, int G_, int c_) { nM = M / BM; nN = N / BM; nwg = nM * nN; G = G_; c = c_; }
    __device__ bool next(int i, Unit& u) const {
        const long L = (long)i * G + c; if (L >= nwg) return false;
        int wgid = (int)L; { const int q = nwg / NXCD, r = nwg % NXCD, xcd = wgid % NXCD, off = wgid / NXCD; wgid = (xcd < r ? xcd * (q + 1) : r * (q + 1) + (xcd - r) * q) + off; }
        const int nig = WGM * nN, gid = wgid / nig, fm = gid * WGM, gsz = (nM - fm) < WGM ? (nM - fm) : WGM;
        u.pm = fm + ((wgid % nig) % gsz); u.pn = (wgid % nig) / gsz; return true;
    }
};

template <class Epi>
__device__ __forceinline__ void gemm_phase(LAS unsigned char* lds, const Gemm g, const StaticOrder& S, const Epi& E, const int tid) {
    const int wid = __builtin_amdgcn_readfirstlane(tid >> 6), lane = tid & 63, wr = wid >> 2, wc = wid & 3, fr = lane & 15, fq = lane >> 4;
    const int K = g.K, nt = K / BK;
    unsigned voffA[2], voffB[2];
#pragma unroll
    for (int i = 0; i < 2; ++i) { int R, C; stage_rc(tid * 16 + i * 8192, R, C); const int Rb = Epi::PERM ? ((R & ~31) + perm32(R & 31)) : R;
        voffA[i] = (unsigned)(R * K + C) * 2u; voffB[i] = (unsigned)(Rb * K + C) * 2u; }
    const size_t kstep = (size_t)(BK * 2);
    const size_t hstep = (size_t)HALF * K * 2;
    const size_t tstep = 2 * hstep;
    const unsigned ldsw = (unsigned)wid * 1024u;
    const int aoff = lds_byte(wr * 64 + fr, fq * 8), boff = lds_byte(wc * 32 + fr, fq * 8);
#define PG8_SA(b, h) (((b) * 2 + (h)) * HTB)
#define PG8_SB(b, h) ((4 + (b) * 2 + (h)) * HTB)
#define PG8_STAGE(bufoff, gbase, voff) do { _Pragma("unroll") for (int _i = 0; _i < 2; ++_i) \
        __builtin_amdgcn_global_load_lds((const unsigned*)((const char*)(gbase) + (voff)[_i]), (LAS unsigned*)(lds + (bufoff) + ldsw + _i * 8192), 16, 0, 0); } while (0)
#define PG8_LDA(dst, b, h) do { _Pragma("unroll") for (int m = 0; m < 4; ++m) _Pragma("unroll") for (int k = 0; k < 2; ++k) dst[m][k] = *(const LAS bf16x8*)(lds + PG8_SA(b, h) + aoff + m * 2048 + k * 1024); } while (0)
#define PG8_LDB(dst, b, h) do { _Pragma("unroll") for (int n = 0; n < 2; ++n) _Pragma("unroll") for (int k = 0; k < 2; ++k) dst[n][k] = *(const LAS bf16x8*)(lds + PG8_SB(b, h) + boff + n * 2048 + k * 1024); } while (0)
#define PG8_MMA(ai, bj, At, Bt) do { __builtin_amdgcn_s_setprio(1); _Pragma("unroll") for (int m = 0; m < 4; ++m) _Pragma("unroll") for (int n = 0; n < 2; ++n) _Pragma("unroll") for (int k = 0; k < 2; ++k) \
        acc[ai][bj][m][n] = __builtin_amdgcn_mfma_f32_16x16x32_bf16(Bt[n][k], At[m][k], acc[ai][bj][m][n], 0, 0, 0); __builtin_amdgcn_s_setprio(0); } while (0)
#define PG8_WAIT_V(n) asm volatile("s_waitcnt vmcnt(" #n ")" ::: "memory")
#define PG8_WAIT_L(n) asm volatile("s_waitcnt lgkmcnt(" #n ")" ::: "memory")
#define PG8_BAR __builtin_amdgcn_s_barrier()
#define PG8_SCHED __builtin_amdgcn_sched_barrier(0)
    Unit cur, nxt; int ui = 0;
    if (!S.next(0, cur)) return;
    f32x4 acc[2][2][4][2];
#pragma unroll
    for (int a = 0; a < 2; ++a)
#pragma unroll
        for (int b = 0; b < 2; ++b)
#pragma unroll
            for (int m = 0; m < 4; ++m)
#pragma unroll
                for (int n = 0; n < 2; ++n) acc[a][b][m][n] = (f32x4){0.f, 0.f, 0.f, 0.f};
    bf16x8 At[4][2], B0[2][2], B1[2][2];
    const char* cA = (const char*)g.A + (size_t)cur.pm * tstep; const char* cB = (const char*)g.Bt + (size_t)cur.pn * tstep;
    PG8_STAGE(PG8_SB(0, 0), cB, voffB); PG8_STAGE(PG8_SA(0, 0), cA, voffA); PG8_STAGE(PG8_SB(0, 1), cB + hstep, voffB); PG8_STAGE(PG8_SA(0, 1), cA + hstep, voffA);
    if (wr == 1) PG8_BAR;
    PG8_WAIT_V(4); PG8_BAR;
    PG8_STAGE(PG8_SB(1, 0), cB + kstep, voffB); PG8_STAGE(PG8_SA(1, 0), cA + kstep, voffA); PG8_STAGE(PG8_SB(1, 1), cB + hstep + kstep, voffB);
    PG8_WAIT_V(6); PG8_BAR;
    for (;;) {
        const bool has_next = S.next(ui + 1, nxt);
        const char* nA = has_next ? (const char*)g.A + (size_t)nxt.pm * tstep : cA; const char* nB = has_next ? (const char*)g.Bt + (size_t)nxt.pn * tstep : cB;
        for (int t = 0; t < nt; t += 2) {
            const bool last = (t == nt - 2);
            const char* a1 = cA + (size_t)(t + 1) * kstep;
            const char* a2 = last ? nA : cA + (size_t)(t + 2) * kstep; const char* b2 = last ? nB : cB + (size_t)(t + 2) * kstep;
            const char* a3 = a2 + kstep; const char* b3 = b2 + kstep;
            PG8_LDB(B0, 0, 0); PG8_SCHED; PG8_LDA(At, 0, 0); PG8_STAGE(PG8_SA(1, 1), a1 + hstep, voffA);
            PG8_WAIT_L(8); PG8_BAR; PG8_WAIT_L(0); PG8_MMA(0, 0, At, B0); PG8_BAR; PG8_SCHED;
            PG8_LDB(B1, 0, 1); PG8_STAGE(PG8_SB(0, 0), b2, voffB);
            PG8_BAR; PG8_WAIT_L(0); PG8_MMA(0, 1, At, B1); PG8_BAR;
            PG8_LDA(At, 0, 1); PG8_STAGE(PG8_SA(0, 0), a2, voffA);
            PG8_BAR; PG8_WAIT_L(0); PG8_MMA(1, 0, At, B0); PG8_BAR; PG8_SCHED;
            PG8_STAGE(PG8_SB(0, 1), b2 + hstep, voffB);
            PG8_WAIT_V(6); PG8_BAR; PG8_MMA(1, 1, At, B1); PG8_BAR;
            PG8_LDB(B0, 1, 0); PG8_SCHED; PG8_LDA(At, 1, 0); PG8_STAGE(PG8_SA(0, 1), a2 + hstep, voffA);
            PG8_WAIT_L(8); PG8_BAR; PG8_WAIT_L(0); PG8_MMA(0, 0, At, B0); PG8_BAR; PG8_SCHED;
            PG8_LDB(B1, 1, 1); PG8_STAGE(PG8_SB(1, 0), b3, voffB);
            PG8_BAR; PG8_WAIT_L(0); PG8_MMA(0, 1, At, B1); PG8_BAR;
            PG8_LDA(At, 1, 1); PG8_STAGE(PG8_SA(1, 0), a3, voffA);
            PG8_BAR; PG8_WAIT_L(0); PG8_MMA(1, 0, At, B0); PG8_BAR; PG8_SCHED;
            PG8_STAGE(PG8_SB(1, 1), b3 + hstep, voffB);
            PG8_WAIT_V(6); PG8_BAR; PG8_MMA(1, 1, At, B1); PG8_BAR;
        }
        E(acc, cur, wr, wc, fr, fq);
        if (!has_next) break;
#pragma unroll
        for (int a = 0; a < 2; ++a)
#pragma unroll
            for (int b = 0; b < 2; ++b)
#pragma unroll
                for (int m = 0; m < 4; ++m)
#pragma unroll
                    for (int n = 0; n < 2; ++n) acc[a][b][m][n] = (f32x4){0.f, 0.f, 0.f, 0.f};
        cur = nxt; cA = nA; cB = nB; ++ui;
    }
    PG8_WAIT_V(0);
    if (wr == 0) PG8_BAR;
    PG8_BAR;
#undef PG8_SA
#undef PG8_SB
#undef PG8_STAGE
#undef PG8_LDA
#undef PG8_LDB
#undef PG8_MMA
#undef PG8_WAIT_V
#undef PG8_WAIT_L
#undef PG8_BAR
#undef PG8_SCHED
}

template <int ACT  > struct EpiBf16 {
    static constexpr bool PERM = true;
    bf16_t* O; int ldc;
    __device__ __forceinline__ void operator()(const f32x4 (&acc)[2][2][4][2], const Unit& u, int wr, int wc, int fr, int fq) const {
        const int row0 = u.pm * BM + wr * 64 + fr, col0 = u.pn * BM + wc * 32 + 8 * fq;
#pragma unroll
        for (int ai = 0; ai < 2; ++ai)
#pragma unroll
            for (int m = 0; m < 4; ++m) { bf16_t* rowp = O + (size_t)(row0 + ai * HALF + m * 16) * ldc + col0;
#pragma unroll
                for (int bj = 0; bj < 2; ++bj) { f32x4 v0 = acc[ai][bj][m][0], v1 = acc[ai][bj][m][1];
                    if (ACT == 1) {
#pragma unroll
                        for (int j = 0; j < 4; ++j) { v0[j] = gelu_tanh(v0[j]); v1[j] = gelu_tanh(v1[j]); } }
                    u32x4 w; w.x = pk_bf16(v0[0], v0[1]); w.y = pk_bf16(v0[2], v0[3]); w.z = pk_bf16(v1[0], v1[1]); w.w = pk_bf16(v1[2], v1[3]);
                    *(u32x4*)(rowp + bj * HALF) = w; } }
    }
};
struct EpiRes {
    static constexpr bool PERM = true;
    const float* src_lat; const float* src_ctx; bf16_t* xs; const float* modL; int gate_idx; int src_f32;
    __device__ __forceinline__ void operator()(const f32x4 (&acc)[2][2][4][2], const Unit& u, int wr, int wc, int fr, int fq) const {
        const bool isctx = u.pm >= (TL / BM);
        const float* sb = isctx ? src_ctx + (size_t)(u.pm - TL / BM) * BM * D : src_lat + (size_t)u.pm * BM * D;
        const int mb = isctx ? NB : (u.pm >> 3);
        const float* gv = modL + (size_t)mb * 6144 + gate_idx * 1024;
        const int rl = wr * 64 + fr, col0 = u.pn * BM + wc * 32 + 8 * fq;
        f32x4 g[2][2];
#pragma unroll
        for (int bj = 0; bj < 2; ++bj)
#pragma unroll
            for (int n = 0; n < 2; ++n) g[bj][n] = *(const f32x4*)(gv + col0 + bj * HALF + n * 4);
#pragma unroll
        for (int ai = 0; ai < 2; ++ai)
#pragma unroll
            for (int m = 0; m < 4; ++m) { const int r = rl + ai * HALF + m * 16; bf16_t* dp = xs + ((size_t)u.pm * BM + r) * D + col0;
#pragma unroll
                for (int bj = 0; bj < 2; ++bj) { f32x4 x0, x1;
                    if (src_f32) { const float* sp = sb + (size_t)r * D + col0 + bj * HALF; x0 = *(const f32x4*)sp; x1 = *(const f32x4*)(sp + 4); }
                    else { const u32x4 xv = *(const u32x4*)(dp + bj * HALF); x0 = (f32x4){bf_lo(xv.x), bf_hi(xv.x), bf_lo(xv.y), bf_hi(xv.y)}; x1 = (f32x4){bf_lo(xv.z), bf_hi(xv.z), bf_lo(xv.w), bf_hi(xv.w)}; }
                    const f32x4 y0 = x0 * DN_ALPHA + g[bj][0] * acc[ai][bj][m][0], y1 = x1 * DN_ALPHA + g[bj][1] * acc[ai][bj][m][1];
                    u32x4 w; w.x = pk_bf16(y0[0], y0[1]); w.y = pk_bf16(y0[2], y0[3]); w.z = pk_bf16(y1[0], y1[1]); w.w = pk_bf16(y1[2], y1[3]);
                    *(u32x4*)(dp + bj * HALF) = w; } }
    }
};
struct EpiGlaProj {
    static constexpr bool PERM = true;
    bf16_t* QG; bf16_t* KG; bf16_t* VG; bf16_t* RG; float* GL;
    __device__ __forceinline__ void operator()(const f32x4 (&acc)[2][2][4][2], const Unit& u, int wr, int wc, int fr, int fq) const {
        const int row0 = u.pm * BM + wr * 64 + fr, pn = u.pn;
        if (pn < 12) {
            bf16_t* base; int ld, colt; float sc = 1.f;
            if (pn < 2) { base = QG; ld = 512; colt = pn * BM; sc = 0.08838834764831845f; }
            else if (pn < 4) { base = KG; ld = 512; colt = (pn - 2) * BM; }
            else if (pn < 8) { base = VG; ld = 1024; colt = (pn - 4) * BM; }
            else { base = RG; ld = 1024; colt = (pn - 8) * BM; }
            const int col0 = colt + wc * 32 + 8 * fq;
#pragma unroll
            for (int ai = 0; ai < 2; ++ai)
#pragma unroll
                for (int m = 0; m < 4; ++m) { bf16_t* rowp = base + (size_t)(row0 + ai * HALF + m * 16) * ld + col0;
#pragma unroll
                    for (int bj = 0; bj < 2; ++bj) { const f32x4 v0 = acc[ai][bj][m][0] * sc, v1 = acc[ai][bj][m][1] * sc;
                        u32x4 w; w.x = pk_bf16(v0[0], v0[1]); w.y = pk_bf16(v0[2], v0[3]); w.z = pk_bf16(v1[0], v1[1]); w.w = pk_bf16(v1[2], v1[3]);
                        *(u32x4*)(rowp + bj * HALF) = w; } }
        } else if (wc == 0) {
#pragma unroll
            for (int ai = 0; ai < 2; ++ai)
#pragma unroll
                for (int m = 0; m < 4; ++m) { float* gp = GL + (size_t)(row0 + ai * HALF + m * 16) * 32 + 8 * fq;
                    *(f32x4*)gp = acc[ai][0][m][0]; *(f32x4*)(gp + 4) = acc[ai][0][m][1]; }
        }
    }
};
}

struct Ctx {
    const Params* p; unsigned char* ws; unsigned char* smem; int tid, lane, wave, G, bid;
};

DI void phase_prologue(const Ctx& c) {
    const Params& p = *c.p; unsigned char* ws = c.ws;
    const int tid = c.tid;
    constexpr int N_MOD = 192, N_TR = 4736, N_WS = 64, N_TAB = 2048;
    constexpr int N_ALL = N_MOD + N_TR + N_WS + N_TAB;
    for (int u = c.bid; u < N_ALL; u += c.G) {
        if (u < N_MOD) {
            const int l = u / 48, n0 = (u % 48) * 128;
            float* sc = (float*)c.smem;
            float* red = (float*)(c.smem + 17 * 1024 * 4);
            __syncthreads();
#pragma unroll 1
            for (int hk = 0; hk < 2; ++hk) { const int k = hk * 512 + tid; float v[17];
#pragma unroll
                for (int b = 0; b < 17; ++b) v[b] = (b < NB) ? p.in[1][b * 1024 + k] : p.in[3][k];
#pragma unroll
                for (int b = 0; b < 17; ++b) sc[b * 1024 + k] = silu_f(v[b]); }
            __syncthreads();
            const int c4 = (tid & 31) * 4, kg = tid >> 5;
            float acc[17][4];
#pragma unroll
            for (int b = 0; b < 17; ++b) { acc[b][0] = 0.f; acc[b][1] = 0.f; acc[b][2] = 0.f; acc[b][3] = 0.f; }
            const float* wp = p.in[4] + ((size_t)l * 1024 + (size_t)kg * 64) * 6144 + n0 + c4;
#pragma unroll 4
            for (int kk = 0; kk < 64; ++kk) {
                const f32x4 w = *(const f32x4*)(wp + (size_t)kk * 6144);
                const int k = kg * 64 + kk;
#pragma unroll
                for (int b = 0; b < 17; ++b) { const float s = sc[b * 1024 + k]; acc[b][0] += s * w[0]; acc[b][1] += s * w[1]; acc[b][2] += s * w[2]; acc[b][3] += s * w[3]; }
            }
#pragma unroll
            for (int b = 0; b < 17; ++b)
#pragma unroll
                for (int j = 0; j < 4; ++j) acc[b][j] += __shfl_xor(acc[b][j], 32, 64);
            if ((tid & 32) == 0) {
#pragma unroll
                for (int b = 0; b < 17; ++b)
#pragma unroll
                    for (int j = 0; j < 4; ++j) red[(c.wave * 17 + b) * 128 + c4 + j] = acc[b][j];
            }
            __syncthreads();
            for (int o = tid; o < 17 * 128; o += NTHR) { const int b = o >> 7, n = o & 127; float s = 0.f;
#pragma unroll
                for (int w = 0; w < 8; ++w) s += red[(w * 17 + b) * 128 + n];
                ((float*)(ws + WS_MOD))[((size_t)l * 17 + b) * 6144 + n0 + n] = s + p.in[5][l * 6144 + n0 + n]; }
        } else if (u < N_MOD + N_TR) {
            int v = u - N_MOD; const float* src; bf16_t* dst; int N, Npad;
            if (v < 1024) { const int j = v / 512; v %= 512; src = p.in[8] + (size_t)j * 1024 * 2048; dst = (bf16_t*)(ws + WS_WAIN) + (size_t)j * 2048 * 1024; N = 2048; Npad = 2048; }
            else if (v < 1536) { v -= 1024; const int j = v / 256; v %= 256; src = p.in[13] + (size_t)j * 1024 * 1024; dst = (bf16_t*)(ws + WS_WAOUT) + (size_t)j * 1024 * 1024; N = 1024; Npad = 1024; }
            else if (v < 3200) { v -= 1536; const int j = v / 832; v %= 832; src = p.in[14] + (size_t)j * 1024 * 3104; dst = (bf16_t*)(ws + WS_WBIN) + (size_t)j * WBIN_N * 1024; N = 3104; Npad = WBIN_N; }
            else if (v < 3712) { v -= 3200; const int j = v / 256; v %= 256; src = p.in[18] + (size_t)j * 1024 * 1024; dst = (bf16_t*)(ws + WS_WBOUT) + (size_t)j * 1024 * 1024; N = 1024; Npad = 1024; }
            else { v -= 3712; const int j = v / 256; v %= 256; src = p.in[19] + (size_t)j * 1024 * 1024; dst = (bf16_t*)(ws + WS_WQ) + (size_t)j * 1024 * 1024; N = 1024; Npad = 1024; }
            (void)Npad;
            const int ntn = v >> 4, ktile = v & 15, n0 = ntn * 64, k0 = ktile * 64;
            float* tl = (float*)c.smem;
            __syncthreads();
#pragma unroll
            for (int i = 0; i < 2; ++i) { const int kk = (tid >> 4) + 32 * i, nn = (tid & 15) * 4;
                f32x4 x = {0.f, 0.f, 0.f, 0.f};
                if (n0 + nn < N) x = *(const f32x4*)(src + (size_t)(k0 + kk) * N + n0 + nn);
                tl[kk * 65 + nn] = x[0]; tl[kk * 65 + nn + 1] = x[1]; tl[kk * 65 + nn + 2] = x[2]; tl[kk * 65 + nn + 3] = x[3]; }
            __syncthreads();
            { const int nn = tid >> 3, kk8 = (tid & 7) * 8; float x[8];
#pragma unroll
              for (int j = 0; j < 8; ++j) x[j] = tl[(kk8 + j) * 65 + nn];
              u32x4 w; w.x = pk_bf16(x[0], x[1]); w.y = pk_bf16(x[2], x[3]); w.z = pk_bf16(x[4], x[5]); w.w = pk_bf16(x[6], x[7]);
              *(u32x4*)(dst + (size_t)(n0 + nn) * 1024 + k0 + kk8) = w; }
        } else if (u < N_MOD + N_TR + N_WS) {
            const int v = u - N_MOD - N_TR; const size_t e = (size_t)v * 4096 + (size_t)tid * 8;
            const f32x4 a = *(const f32x4*)(p.in[11] + e), b = *(const f32x4*)(p.in[11] + e + 4);
            u32x4 w; w.x = pk_bf16(a[0], a[1]); w.y = pk_bf16(a[2], a[3]); w.z = pk_bf16(b[0], b[1]); w.w = pk_bf16(b[2], b[3]);
            *(u32x4*)((bf16_t*)(ws + WS_WSB) + e) = w;
        } else {
            const int v = u - N_MOD - N_TR - N_WS; const int tab = v >> 10;
            const float* src = p.in[21 + tab]; unsigned char* dst = ws + (tab ? WS_VT : WS_UT); float* sc = (float*)(ws + (tab ? WS_SV : WS_SU));
#pragma unroll 2
            for (int i = 0; i < 8; ++i) { const size_t row = (size_t)(v & 1023) * 64 + c.wave * 8 + i;
                const float* rp = src + row * 1024 + 16 * c.lane; f32x4 x[4]; float am = 0.f;
#pragma unroll
                for (int q = 0; q < 4; ++q) { x[q] = __builtin_nontemporal_load((const f32x4*)(rp + 4 * q)); am = fmaxf(am, fmaxf(fmaxf(fabsf(x[q][0]), fabsf(x[q][1])), fmaxf(fabsf(x[q][2]), fabsf(x[q][3])))); }
                am = fmaxf(wave_max(am), 1e-30f);
                const size_t Lr = row >> 14, er = row & 16383;
                {
                    const float inv = 6.0f / am; u32x2 w;
#pragma unroll
                    for (int hq = 0; hq < 2; ++hq) { unsigned t = 0;
                        t = __builtin_amdgcn_cvt_scalef32_pk_fp4_f32(t, x[2 * hq][0] * inv, x[2 * hq][1] * inv, 1.0f, 0); t = __builtin_amdgcn_cvt_scalef32_pk_fp4_f32(t, x[2 * hq][2] * inv, x[2 * hq][3] * inv, 1.0f, 1);
                        t = __builtin_amdgcn_cvt_scalef32_pk_fp4_f32(t, x[2 * hq + 1][0] * inv, x[2 * hq + 1][1] * inv, 1.0f, 2); t = __builtin_amdgcn_cvt_scalef32_pk_fp4_f32(t, x[2 * hq + 1][2] * inv, x[2 * hq + 1][3] * inv, 1.0f, 3);
                        w[hq] = t; }
                    *(u32x2*)(dst + ((Lr * 4 + (c.lane >> 4)) * NEXP + er) * 128 + 8 * (c.lane & 15)) = w;
                    if (c.lane == 0) sc[row] = am * (1.0f / 6.0f);
                } }
        }
    }
}

DI void phase_mod0(const Ctx& c) {
    const Params& p = *c.p; const float* MOD = (const float*)(c.ws + WS_MOD); bf16_t* H1 = (bf16_t*)(c.ws + WS_H1);
    for (int row = c.bid * NWAVE + c.wave; row < T; row += c.G * NWAVE) {
        const float* src = row < TL ? p.in[0] + (size_t)row * D : p.in[2] + (size_t)(row - TL) * D;
        const float* m = MOD + (size_t)mod_batch(row) * 6144;
#pragma unroll
        for (int j = 0; j < 4; ++j) { const int col = 4 * c.lane + 256 * j;
            const f32x4 x = *(const f32x4*)(src + col), sh = *(const f32x4*)(m + col), s = *(const f32x4*)(m + 1024 + col);
            const f32x4 h = x * (s + 1.0f) + sh; u32x2 w; w.x = pk_bf16(h[0], h[1]); w.y = pk_bf16(h[2], h[3]);
            *(u32x2*)(H1 + (size_t)row * D + col) = w; }
    }
}

DI void phase_vstats(const Ctx& c) {
    const bf16_t* UV = (const bf16_t*)(c.ws + WS_R1); float* ST = (float*)(c.ws + WS_STATS);
    for (int row = c.bid * NWAVE + c.wave; row < T; row += c.G * NWAVE) {
        const bf16_t* vp = UV + (size_t)row * 2048 + 1024;
        const u32x4 a = *(const u32x4*)(vp + 8 * c.lane), b = *(const u32x4*)(vp + 512 + 8 * c.lane);
        float x[16];
#pragma unroll
        for (int j = 0; j < 4; ++j) { x[2 * j] = bf_lo(a[j]); x[2 * j + 1] = bf_hi(a[j]); x[8 + 2 * j] = bf_lo(b[j]); x[9 + 2 * j] = bf_hi(b[j]); }
        float s = 0.f;
#pragma unroll
        for (int j = 0; j < 16; ++j) s += x[j];
        const float mean = wave_sum(s) * (1.0f / 1024.0f);
        float q = 0.f;
#pragma unroll
        for (int j = 0; j < 16; ++j) { const float d = x[j] - mean; q += d * d; }
        const float var = wave_sum(q) * (1.0f / 1024.0f);
        if (c.lane == 0) { ST[2 * row] = mean; ST[2 * row + 1] = rsqrtf(var + LN_EPS); }
    }
}

DI void phase_spatial(const Ctx& c, int j) {
    const Params& p = *c.p; unsigned char* ws = c.ws;
    const bf16_t* UV = (const bf16_t*)(ws + WS_R1); const float* ST = (const float*)(ws + WS_STATS); bf16_t* Y = (bf16_t*)(ws + WS_R2);
    const bf16_t* WSB = (const bf16_t*)(ws + WS_WSB) + (size_t)j * 8 * 128 * 128;
    const float* ng = p.in[9] + j * 1024; const float* nb = p.in[10] + j * 1024; const float* bs = p.in[12] + j * 8 * 128;
    constexpr int LD = 136;
    bf16_t* WsL = (bf16_t*)c.smem;
    bf16_t* VnT = WsL + 128 * LD;
    const int tid = c.tid, lane = c.lane, w = c.wave, g = lane >> 4, cc = lane & 15;
    for (int u = c.bid; u < (T / 128) * 8; u += c.G) {
        const int chunk = u >> 3, h = u & 7, r0 = chunk * 128;
        __syncthreads();
        { const int cg8 = tid & 15; float gg[8], bb[8];
#pragma unroll
          for (int e = 0; e < 8; ++e) { gg[e] = ng[h * 128 + cg8 * 8 + e]; bb[e] = nb[h * 128 + cg8 * 8 + e]; }
#pragma unroll
          for (int i = 0; i < 4; ++i) { const int idx = i * 512 + tid, tok = idx >> 4;
              const u32x4 v = *(const u32x4*)(UV + (size_t)(r0 + tok) * 2048 + 1024 + h * 128 + cg8 * 8);
              const float mean = ST[2 * (r0 + tok)], rstd = ST[2 * (r0 + tok) + 1];
              float x[8];
#pragma unroll
              for (int e = 0; e < 4; ++e) { x[2 * e] = bf_lo(v[e]); x[2 * e + 1] = bf_hi(v[e]); }
#pragma unroll
              for (int e = 0; e < 8; ++e) VnT[(cg8 * 8 + e) * LD + tok] = f2bf((x[e] - mean) * rstd * gg[e] + bb[e]);
              const int pp = idx >> 4;
              *(u32x4*)(WsL + pp * LD + cg8 * 8) = *(const u32x4*)(WSB + ((size_t)h * 128 + pp) * 128 + cg8 * 8); } }
        __syncthreads();
        f32x4 acc[8];
#pragma unroll
        for (int ct = 0; ct < 8; ++ct) acc[ct] = (f32x4){0.f, 0.f, 0.f, 0.f};
#pragma unroll
        for (int ks = 0; ks < 4; ++ks) {
            const bf16x8 bfr = frag_ld(WsL, LD, 16 * w, 32 * ks, lane);
#pragma unroll
            for (int ct = 0; ct < 8; ++ct) acc[ct] = mfma16(frag_ld(VnT, LD, 16 * ct, 32 * ks, lane), bfr, acc[ct]);
        }
        const int pp = 16 * w + cc; const float bsv = bs[h * 128 + pp];
        const size_t rowo = (size_t)(r0 + pp);
#pragma unroll
        for (int ct = 0; ct < 8; ++ct) { const int ch = h * 128 + 16 * ct + 4 * g;
            const u32x2 uu = *(const u32x2*)(UV + rowo * 2048 + ch);
            const float y0 = bf_lo(uu.x) * (acc[ct][0] + bsv), y1 = bf_hi(uu.x) * (acc[ct][1] + bsv), y2 = bf_lo(uu.y) * (acc[ct][2] + bsv), y3 = bf_hi(uu.y) * (acc[ct][3] + bsv);
            u32x2 o; o.x = pk_bf16(y0, y1); o.y = pk_bf16(y2, y3);
            *(u32x2*)(Y + rowo * D + ch) = o; }
    }
}

DI void phase_ln1(const Ctx& c, int L) {
    const Params& p = *c.p; bf16_t* XS = (bf16_t*)(c.ws + WS_XS); const float* MOD = (const float*)(c.ws + WS_MOD) + (size_t)L * 17 * 6144;
    bf16_t* H2 = (bf16_t*)(c.ws + WS_R2 + SZ_T1K);
    const float* lg = p.in[6] + (size_t)(L * 2 + 0) * D; const float* lb = p.in[7] + (size_t)(L * 2 + 0) * D;
    const int nrows = (L == DEPTH - 1) ? TL : T, stride = c.G * NWAVE;
    for (int row0 = c.bid * NWAVE + c.wave; row0 < nrows; row0 += 2 * stride) {
        const bool has2 = row0 + stride < nrows; const int rows[2] = {row0, has2 ? row0 + stride : row0};
        u32x2 v[2][4];
#pragma unroll
        for (int rr = 0; rr < 2; ++rr)
#pragma unroll
            for (int j = 0; j < 4; ++j) v[rr][j] = *(const u32x2*)(XS + (size_t)rows[rr] * D + 4 * c.lane + 256 * j);
#pragma unroll
        for (int rr = 0; rr < 2; ++rr) {
            if (rr == 1 && !has2) break;
            const int row = rows[rr]; bf16_t* xp = XS + (size_t)row * D; const float* m = MOD + (size_t)mod_batch(row) * 6144;
            f32x4 x[4]; float s = 0.f;
#pragma unroll
            for (int j = 0; j < 4; ++j) { x[j] = (f32x4){bf_lo(v[rr][j].x), bf_hi(v[rr][j].x), bf_lo(v[rr][j].y), bf_hi(v[rr][j].y)}; s += (x[j][0] + x[j][1]) + (x[j][2] + x[j][3]); }
            const float mean = wave_sum(s) * (1.0f / 1024.0f);
            float q = 0.f;
#pragma unroll
            for (int j = 0; j < 4; ++j) { const f32x4 d = x[j] - mean; q += (d[0] * d[0] + d[1] * d[1]) + (d[2] * d[2] + d[3] * d[3]); }
            const float rstd = rsqrtf(wave_sum(q) * (1.0f / 1024.0f) + LN_EPS);
#pragma unroll
            for (int j = 0; j < 4; ++j) { const int col = 4 * c.lane + 256 * j;
                const f32x4 y = (x[j] - mean) * rstd * *(const f32x4*)(lg + col) + *(const f32x4*)(lb + col);
                u32x2 xw; xw.x = pk_bf16(y[0], y[1]); xw.y = pk_bf16(y[2], y[3]);
                *(u32x2*)(xp + col) = xw;
                const f32x4 h = y * (*(const f32x4*)(m + 4 * 1024 + col) + 1.0f) + *(const f32x4*)(m + 3 * 1024 + col);
                u32x2 w; w.x = pk_bf16(h[0], h[1]); w.y = pk_bf16(h[2], h[3]);
                *(u32x2*)(H2 + (size_t)row * D + col) = w; }
        }
    }
}

DI int f2key(float v) { const int i = __float_as_int(v); return i ^ ((i >> 31) & 0x7fffffff); }
DI float key2f(int k) { return __int_as_float(k ^ ((k >> 31) & 0x7fffffff)); }
DI void phase_route(const Ctx& c, int L) {
    const Params& p = *c.p; unsigned char* ws = c.ws; const int lane = c.lane, g = lane >> 4, cc = lane & 15;
    constexpr int LDK = 72, LDS_S = 20;
    bf16_t* keysHi = (bf16_t*)c.smem;
    bf16_t* keysLo = keysHi + 2 * 128 * LDK;
    float* sbase = (float*)(keysLo + 2 * 128 * LDK);
    unsigned* ilist = (unsigned*)(sbase + NWAVE * 64 * LDS_S);
    __syncthreads();
    { const float* gk = p.in[20] + (size_t)L * 2 * 128 * 64;
      f32x4 kv[8];
#pragma unroll
      for (int it = 0; it < 8; ++it) kv[it] = ((const f32x4*)gk)[it * NTHR + c.tid];
#pragma unroll
      for (int it = 0; it < 8; ++it) { const int i = (it * NTHR + c.tid) * 4, row = i >> 6, d = i & 63; unsigned hi[2], lo[2];
#pragma unroll
          for (int e = 0; e < 2; ++e) { const unsigned ph = pk_bf16(kv[it][2 * e], kv[it][2 * e + 1]); hi[e] = ph; lo[e] = pk_bf16(kv[it][2 * e] - bf_lo(ph), kv[it][2 * e + 1] - bf_hi(ph)); }
          *(u32x2*)(keysHi + row * LDK + d) = (u32x2){hi[0], hi[1]}; *(u32x2*)(keysLo + row * LDK + d) = (u32x2){lo[0], lo[1]}; } }
    __syncthreads();
    float* S = sbase + c.wave * 64 * LDS_S;
    const bf16_t* QP = (const bf16_t*)(ws + WS_R1); int* IDX = (int*)(ws + WS_R1 + SZ_T1K); float* WT = (float*)(ws + WS_R1 + SZ_T1K + (size_t)T * 128 * 4);
    unsigned* myl = ilist + c.tid * 8; const unsigned char* mylb = (const unsigned char*)myl;
    const int ntask = (((L == DEPTH - 1) ? TL : T) / 64) * 8;
    for (int task = c.bid * NWAVE + c.wave; task < ntask; task += c.G * NWAVE) {
        const int t0 = (task >> 3) * 64, h = task & 7, tok = t0 + lane;
        float t12[2][16];
#pragma unroll
        for (int half = 0; half < 2; ++half) {
            bf16x8 aq[4][2];
#pragma unroll
            for (int mt = 0; mt < 4; ++mt)
#pragma unroll
                for (int ks = 0; ks < 2; ++ks) aq[mt][ks] = *(const bf16x8*)(QP + (size_t)(t0 + 16 * mt + cc) * D + h * 128 + half * 64 + 32 * ks + 8 * g);
            const bf16_t* kh = keysHi + half * 128 * LDK; const bf16_t* kl = keysLo + half * 128 * LDK;
#pragma unroll
            for (int i = 0; i < 16; ++i) t12[half][i] = -3.0e38f;
            for (int nt = 0; nt < 8; ++nt) {
                const bf16x8 bh0 = frag_ld(kh, LDK, 16 * nt, 0, lane), bh1 = frag_ld(kh, LDK, 16 * nt, 32, lane), bl0 = frag_ld(kl, LDK, 16 * nt, 0, lane), bl1 = frag_ld(kl, LDK, 16 * nt, 32, lane);
#pragma unroll
                for (int mt = 0; mt < 4; ++mt) { f32x4 a = {0.f, 0.f, 0.f, 0.f};
                    a = mfma16(aq[mt][0], bl0, a); a = mfma16(aq[mt][1], bl1, a); a = mfma16(aq[mt][0], bh0, a); a = mfma16(aq[mt][1], bh1, a);
#pragma unroll
                    for (int r = 0; r < 4; ++r) S[(16 * mt + 4 * g + r) * LDS_S + cc] = a[r]; }
                f32x4 sc[4];
#pragma unroll
                for (int q4 = 0; q4 < 4; ++q4) sc[q4] = *(const f32x4*)(S + lane * LDS_S + 4 * q4);
#pragma unroll
                for (int kk = 0; kk < 16; ++kk) { const float key = __int_as_float((__float_as_int(sc[kk >> 2][kk & 3]) & ~127) | (127 - (16 * nt + kk)));
#pragma unroll
                    for (int i = 15; i >= 1; --i) t12[half][i] = __builtin_amdgcn_fmed3f(key, t12[half][i - 1], t12[half][i]);
                    t12[half][0] = __builtin_amdgcn_fmed3f(key, 3.0e38f, t12[half][0]); }
            }
        }
        float v1[16], v2[16];
#pragma unroll
        for (int i = 0; i < 16; ++i) { v1[i] = __int_as_float(__float_as_int(t12[0][i]) & ~127); v2[i] = __int_as_float(__float_as_int(t12[1][i]) & ~127); }
#pragma unroll
        for (int i = 0; i < 4; ++i) {
            myl[i] = (unsigned)(127 - (__float_as_int(t12[0][4 * i]) & 127)) | ((unsigned)(127 - (__float_as_int(t12[0][4 * i + 1]) & 127)) << 8) | ((unsigned)(127 - (__float_as_int(t12[0][4 * i + 2]) & 127)) << 16) | ((unsigned)(127 - (__float_as_int(t12[0][4 * i + 3]) & 127)) << 24);
            myl[4 + i] = (unsigned)(127 - (__float_as_int(t12[1][4 * i]) & 127)) | ((unsigned)(127 - (__float_as_int(t12[1][4 * i + 1]) & 127)) << 8) | ((unsigned)(127 - (__float_as_int(t12[1][4 * i + 2]) & 127)) << 16) | ((unsigned)(127 - (__float_as_int(t12[1][4 * i + 3]) & 127)) << 24); }
        float f[16];
#pragma unroll
        for (int i = 0; i < 16; ++i) f[i] = -3.0e38f;
#pragma unroll
        for (int a = 0; a < 16; ++a)
#pragma unroll
            for (int b = 0; b < 16; ++b)
                if ((a + 1) * (b + 1) <= 16) {
                    const float key = __int_as_float((__float_as_int(v1[a] + v2[b]) & ~255) | (255 - (a * 16 + b)));
#pragma unroll
                    for (int i = 15; i >= 1; --i) f[i] = __builtin_amdgcn_fmed3f(key, f[i - 1], f[i]);
                    f[0] = __builtin_amdgcn_fmed3f(key, 3.0e38f, f[0]);
                }
        float e[16], se = 0.f; int fi[16];
        const float vmax = __int_as_float(__float_as_int(f[0]) & ~255);
#pragma unroll
        for (int i = 0; i < 16; ++i) { const int code = 255 - (__float_as_int(f[i]) & 255); fi[i] = (int)mylb[code >> 4] * 128 + (int)mylb[16 + (code & 15)];
            e[i] = __expf(__int_as_float(__float_as_int(f[i]) & ~255) - vmax); se += e[i]; }
        const float inv = 1.0f / se;
        int* ip = IDX + (size_t)tok * 128 + h * 16; float* wp = WT + (size_t)tok * 128 + h * 16;
#pragma unroll
        for (int i = 0; i < 16; i += 4) { *(int4*)(ip + i) = make_int4(fi[i], fi[i + 1], fi[i + 2], fi[i + 3]); *(f32x4*)(wp + i) = (f32x4){e[i] * inv, e[i + 1] * inv, e[i + 2] * inv, e[i + 3] * inv}; }
    }
}

DI float red8(float p) { p += dpp_mov<0xB1>(p); p += dpp_mov<0x4E>(p); p += dpp_mov<0x141>(p); return p; }
DI void phase_experts(const Ctx& c, int L) {
    const Params& p = *c.p; unsigned char* ws = c.ws; const int lane = c.lane, g8 = lane >> 3, j = lane & 7;
    constexpr int MAXTOK = 18;
    const bf16_t* H2 = (const bf16_t*)(ws + WS_R2 + SZ_T1K);
    const int* IDX = (const int*)(ws + WS_R1 + SZ_T1K); const float* WT = (const float*)(ws + WS_R1 + SZ_T1K + (size_t)T * 128 * 4);
    bf16_t* FFN = (bf16_t*)(ws + WS_R1);
    const unsigned char* UT = ws + WS_UT + (size_t)L * NEXP * 512; const unsigned char* VT = ws + WS_VT + (size_t)L * NEXP * 512;
    const float* SU = (const float*)(ws + WS_SU) + (size_t)L * NEXP; const float* SV = (const float*)(ws + WS_SV) + (size_t)L * NEXP;
    bf16_t* XS = (bf16_t*)(ws + WS_XS); bf16_t* H1 = (bf16_t*)(ws + WS_H1);
    const float* MOD = (const float*)(ws + WS_MOD) + (size_t)L * 17 * 6144;
    const float* lg = p.in[6] + (size_t)(L * 2 + 1) * D; const float* lb = p.in[7] + (size_t)(L * 2 + 1) * D;
    const int nrows = (L == DEPTH - 1) ? TL : T;
    float* ZL = (float*)c.smem + c.wave * MAXTOK * 128;
    unsigned short* IL = (unsigned short*)(c.smem + NWAVE * MAXTOK * 128 * 4) + c.wave * MAXTOK * 128;
    const int GW = c.G * NWAVE, gw = c.bid * NWAVE + c.wave;
    const int tsrc = 8 * (lane & 7) + (lane >> 3);
    for (int base = 0; base < nrows; base += GW * MAXTOK) {
        int ntok = (nrows - base - gw + GW - 1) / GW; ntok = ntok < 0 ? 0 : (ntok > MAXTOK ? MAXTOK : ntok);
        const int klast = ntok > 0 ? ntok - 1 : 0;
        if (ntok > 0) {
            for (int k0 = 0; k0 < MAXTOK; k0 += 6) { int iv[6][2];
#pragma unroll
                for (int kk = 0; kk < 6; ++kk) { const int kc = (k0 + kk < ntok) ? k0 + kk : klast; const size_t tb = (size_t)(base + gw + GW * kc) * 128; iv[kk][0] = IDX[tb + lane]; iv[kk][1] = IDX[tb + 64 + lane]; }
#pragma unroll
                for (int kk = 0; kk < 6; ++kk) { IL[(k0 + kk) * 128 + lane] = (unsigned short)iv[kk][0]; IL[(k0 + kk) * 128 + 64 + lane] = (unsigned short)iv[kk][1]; } }
        }
        for (int c4 = 0; c4 < 4; ++c4) {
            const unsigned char* Ub = UT + (size_t)c4 * NEXP * 128 + 16 * j;
            const bf16_t* Xb = H2 + 256 * c4 + 32 * j;
            u32x4 rA[8], rB[8];
            f32x2 xf[16];
            u32x4 xr[4];
#define U_LOADX(k_) do { const bf16_t* xp_ = Xb + (size_t)(base + gw + GW * (k_)) * D; \
                _Pragma("unroll") for (int t = 0; t < 4; ++t) xr[t] = *(const u32x4*)(xp_ + 8 * t); } while (0)
#define U_UNPACKX() do { _Pragma("unroll") for (int t = 0; t < 4; ++t) { \
                    _Pragma("unroll") for (int q = 0; q < 4; ++q) xf[4 * t + q] = (f32x2){bf_lo(xr[t][q]), bf_hi(xr[t][q])}; } } while (0)
#define U_ISSUE(R, k_, hf_) do { _Pragma("unroll") for (int i = 0; i < 8; ++i) { const unsigned e = IL[(k_) * 128 + 64 * (hf_) + 8 * i + g8]; R[i] = *(const u32x4*)(Ub + (size_t)e * 128); } } while (0)
#define U_COMPUTE(R, k_, hf_) do { float ra = 0.f; \
                _Pragma("unroll") for (int i = 0; i < 8; ++i) { f32x2 acc = {0.f, 0.f}; \
                    _Pragma("unroll") for (int q = 0; q < 4; ++q) { \
                        acc += __builtin_amdgcn_cvt_scalef32_pk_f32_fp4(R[i][q], 1.0f, 0) * xf[4 * q]; acc += __builtin_amdgcn_cvt_scalef32_pk_f32_fp4(R[i][q], 1.0f, 1) * xf[4 * q + 1]; \
                        acc += __builtin_amdgcn_cvt_scalef32_pk_f32_fp4(R[i][q], 1.0f, 2) * xf[4 * q + 2]; acc += __builtin_amdgcn_cvt_scalef32_pk_f32_fp4(R[i][q], 1.0f, 3) * xf[4 * q + 3]; } \
                    const float pr = red8(acc[0] + acc[1]); ra = (j == i) ? pr : ra; } \
                const float za = __shfl(ra, tsrc, 64); \
                if (c4 == 0) ZL[(k_) * 128 + 64 * (hf_) + lane] = za; else ZL[(k_) * 128 + 64 * (hf_) + lane] += za; } while (0)
            if (ntok > 0) { U_LOADX(0); U_ISSUE(rA, 0, 0); }
            for (int k = 0; k < ntok; ++k) {
                const int kn = (k + 1 < ntok) ? k + 1 : k;
                U_ISSUE(rB, k, 1);
                U_UNPACKX();
                U_COMPUTE(rA, k, 0);
                U_LOADX(kn); U_ISSUE(rA, kn, 0);
                U_COMPUTE(rB, k, 1);
            }
#undef U_LOADX
#undef U_UNPACKX
#undef U_ISSUE
#undef U_COMPUTE
        }
        if (ntok > 0) {
            for (int k0 = 0; k0 < MAXTOK; k0 += 6) { float wv[6][2], su[6][2], sv[6][2];
#pragma unroll
                for (int kk = 0; kk < 6; ++kk) { const int kc = (k0 + kk < ntok) ? k0 + kk : klast; const size_t tb = (size_t)(base + gw + GW * kc) * 128;
#pragma unroll
                    for (int hh = 0; hh < 2; ++hh) { const unsigned e = IL[kc * 128 + 64 * hh + lane]; wv[kk][hh] = WT[tb + 64 * hh + lane]; su[kk][hh] = SU[e]; sv[kk][hh] = SV[e]; } }
#pragma unroll
                for (int kk = 0; kk < 6; ++kk) { const int kc = (k0 + kk < ntok) ? k0 + kk : klast;
                    if (k0 + kk < ntok) {
#pragma unroll
                        for (int hh = 0; hh < 2; ++hh) ZL[kc * 128 + 64 * hh + lane] = gelu_tanh(ZL[kc * 128 + 64 * hh + lane] * su[kk][hh]) * wv[kk][hh] * sv[kk][hh]; } } }
        }
        for (int c4 = 0; c4 < 4; ++c4) {
            const unsigned char* Vb = VT + (size_t)c4 * NEXP * 128 + 16 * j;
            const bool hi8 = (lane & 8) != 0;
            u32x4 rA[8], rB[8];
            f32x2 o[16];
#define V_ISSUE(R, k_, hf_) do { _Pragma("unroll") for (int i = 0; i < 8; ++i) { const unsigned e = IL[(k_) * 128 + 64 * (hf_) + 8 * i + g8]; R[i] = *(const u32x4*)(Vb + (size_t)e * 128); } } while (0)
#define V_ACC(R, k_, hf_) do { float av[8]; \
                _Pragma("unroll") for (int i = 0; i < 8; ++i) av[i] = ZL[(k_) * 128 + 64 * (hf_) + 8 * i + g8]; \
                _Pragma("unroll") for (int i = 0; i < 8; ++i) { const f32x2 a2 = {av[i], av[i]}; \
                    _Pragma("unroll") for (int q = 0; q < 4; ++q) { \
                        o[4 * q] += a2 * __builtin_amdgcn_cvt_scalef32_pk_f32_fp4(R[i][q], 1.0f, 0); o[4 * q + 1] += a2 * __builtin_amdgcn_cvt_scalef32_pk_f32_fp4(R[i][q], 1.0f, 1); \
                        o[4 * q + 2] += a2 * __builtin_amdgcn_cvt_scalef32_pk_f32_fp4(R[i][q], 1.0f, 2); o[4 * q + 3] += a2 * __builtin_amdgcn_cvt_scalef32_pk_f32_fp4(R[i][q], 1.0f, 3); } } } while (0)
#define V_FINISH(k_) do { const int tok_ = base + gw + GW * (k_); \
                f32x2 q8[8]; \
                _Pragma("unroll") for (int m = 0; m < 8; ++m) { \
                    const auto s0 = __builtin_amdgcn_permlane32_swap(__float_as_uint(o[m][0]), __float_as_uint(o[m + 8][0]), false, false); \
                    const auto s1 = __builtin_amdgcn_permlane32_swap(__float_as_uint(o[m][1]), __float_as_uint(o[m + 8][1]), false, false); \
                    q8[m] = (f32x2){__uint_as_float(s0[0]) + __uint_as_float(s0[1]), __uint_as_float(s1[0]) + __uint_as_float(s1[1])}; } \
                f32x2 q4[4]; \
                _Pragma("unroll") for (int m = 0; m < 4; ++m) { \
                    const auto s0 = __builtin_amdgcn_permlane16_swap(__float_as_uint(q8[m][0]), __float_as_uint(q8[m + 4][0]), false, false); \
                    const auto s1 = __builtin_amdgcn_permlane16_swap(__float_as_uint(q8[m][1]), __float_as_uint(q8[m + 4][1]), false, false); \
                    q4[m] = (f32x2){__uint_as_float(s0[0]) + __uint_as_float(s0[1]), __uint_as_float(s1[0]) + __uint_as_float(s1[1])}; } \
                float fo[4]; \
                _Pragma("unroll") for (int m = 0; m < 2; ++m) { \
                    const float k0 = hi8 ? q4[m + 2][0] : q4[m][0], k1 = hi8 ? q4[m + 2][1] : q4[m][1], t0 = hi8 ? q4[m][0] : q4[m + 2][0], t1 = hi8 ? q4[m][1] : q4[m + 2][1]; \
                    fo[2 * m] = k0 + dpp_mov<0x128>(t0); fo[2 * m + 1] = k1 + dpp_mov<0x128>(t1); } \
                u32x2 w_; w_.x = pk_bf16(fo[0], fo[1]); w_.y = pk_bf16(fo[2], fo[3]); \
                *(u32x2*)(FFN + (size_t)tok_ * D + 256 * c4 + 32 * j + 4 * g8) = w_; } while (0)
            if (ntok > 0) V_ISSUE(rA, 0, 0);
            for (int k = 0; k < ntok; ++k) {
                V_ISSUE(rB, k, 1);
#pragma unroll
                for (int q = 0; q < 16; ++q) o[q] = (f32x2){0.f, 0.f};
                V_ACC(rA, k, 0);
                V_ISSUE(rA, ((k + 1 < ntok) ? k + 1 : k), 0);
                V_ACC(rB, k, 1);
                V_FINISH(k);
            }
#undef V_ISSUE
#undef V_ACC
#undef V_FINISH
        }
        asm volatile("s_waitcnt vmcnt(0)" ::: "memory");
        u32x4 nfa, nfb, nxa, nxb;
        { const int row0 = base + gw + GW * 0 < nrows ? base + gw : 0; nfa = *(const u32x4*)(FFN + (size_t)row0 * D + 16 * lane); nfb = *(const u32x4*)(FFN + (size_t)row0 * D + 16 * lane + 8);
          nxa = *(const u32x4*)(XS + (size_t)row0 * D + 16 * lane); nxb = *(const u32x4*)(XS + (size_t)row0 * D + 16 * lane + 8); }
        for (int k = 0; k < ntok; ++k) { const int row = base + gw + GW * k;
            bf16_t* xp = XS + (size_t)row * D + 16 * lane; const int mb = mod_batch(row); const float* m = MOD + (size_t)mb * 6144 + 16 * lane;
            const u32x4 fa = nfa, fb = nfb, xa = nxa, xb = nxb;
            { const int rn = base + gw + GW * ((k + 1 < ntok) ? k + 1 : k);
              nfa = *(const u32x4*)(FFN + (size_t)rn * D + 16 * lane); nfb = *(const u32x4*)(FFN + (size_t)rn * D + 16 * lane + 8);
              nxa = *(const u32x4*)(XS + (size_t)rn * D + 16 * lane); nxb = *(const u32x4*)(XS + (size_t)rn * D + 16 * lane + 8); }
            float o[16], x1[16];
#pragma unroll
            for (int q = 0; q < 4; ++q) { o[2 * q] = bf_lo(fa[q]); o[2 * q + 1] = bf_hi(fa[q]); o[8 + 2 * q] = bf_lo(fb[q]); o[9 + 2 * q] = bf_hi(fb[q]);
                x1[2 * q] = bf_lo(xa[q]); x1[2 * q + 1] = bf_hi(xa[q]); x1[8 + 2 * q] = bf_lo(xb[q]); x1[9 + 2 * q] = bf_hi(xb[q]); }
            float y[16]; float s = 0.f;
#pragma unroll
            for (int qd = 0; qd < 4; ++qd) { const f32x4 g2 = *(const f32x4*)(m + 5 * 1024 + 4 * qd);
#pragma unroll
                for (int e = 0; e < 4; ++e) { y[4 * qd + e] = DN_ALPHA * x1[4 * qd + e] + g2[e] * o[4 * qd + e]; s += y[4 * qd + e]; } }
            const float mean = wave_sum(s) * (1.0f / 1024.0f);
            float q = 0.f;
#pragma unroll
            for (int e = 0; e < 16; ++e) { const float d = y[e] - mean; q += d * d; }
            const float rstd = rsqrtf(wave_sum(q) * (1.0f / 1024.0f) + LN_EPS);
            const float* mn = (const float*)(ws + WS_MOD) + (size_t)(L + 1 < DEPTH ? L + 1 : L) * 17 * 6144 + (size_t)mb * 6144 + 16 * lane;
            float x2[16];
#pragma unroll
            for (int qd = 0; qd < 4; ++qd) { const int col = 16 * lane + 4 * qd;
                const f32x4 gg = *(const f32x4*)(lg + col), bb = *(const f32x4*)(lb + col);
#pragma unroll
                for (int e = 0; e < 4; ++e) x2[4 * qd + e] = (y[4 * qd + e] - mean) * rstd * gg[e] + bb[e]; }
            if (L == DEPTH - 1) {
#pragma unroll
                for (int qd = 0; qd < 4; ++qd) *(f32x4*)(p.out + (size_t)row * D + 16 * lane + 4 * qd) = (f32x4){x2[4 * qd], x2[4 * qd + 1], x2[4 * qd + 2], x2[4 * qd + 3]};
            } else {
                float hh[16];
#pragma unroll
                for (int qd = 0; qd < 4; ++qd) { const f32x4 s1 = *(const f32x4*)(mn + 1024 + 4 * qd), sh = *(const f32x4*)(mn + 4 * qd);
#pragma unroll
                    for (int e = 0; e < 4; ++e) hh[4 * qd + e] = x2[4 * qd + e] * (s1[e] + 1.0f) + sh[e]; }
#pragma unroll
                for (int hf = 0; hf < 2; ++hf) { u32x4 wx, wh;
#pragma unroll
                    for (int q2 = 0; q2 < 4; ++q2) { wx[q2] = pk_bf16(x2[8 * hf + 2 * q2], x2[8 * hf + 2 * q2 + 1]); wh[q2] = pk_bf16(hh[8 * hf + 2 * q2], hh[8 * hf + 2 * q2 + 1]); }
                    *(u32x4*)(xp + 8 * hf) = wx; *(u32x4*)(H1 + (size_t)row * D + 16 * lane + 8 * hf) = wh; }
            }
        }
    }
}

DI float logsig2_16(float z) { const float zl = z * 1.4426950408889634f; return (fminf(zl, 0.f) - __builtin_amdgcn_logf(1.0f + __builtin_amdgcn_exp2f(-fabsf(zl)))) * (1.0f / 16.0f); }
template <int DIR>
DI float gla_prep_gates(const bf16_t* Qt, const bf16_t* Kt, bf16_t* OUT, const float* gl, const float (&wg)[16], float bias, int cl, unsigned (&kpk)[32]) {
    constexpr int dir = DIR;
    { int z_ = 0; asm volatile("" : "+v"(z_)); gl += z_; }
    float cum = 0.f;
#pragma unroll
        for (int blk = 0; blk < 8; ++blk) {
            float gs[8];
#pragma unroll
            for (int e = 0; e < 8; ++e) { const int i = (dir ? 56 - 8 * blk : 8 * blk) + e; float z = bias; const f32x4* gp = (const f32x4*)(gl + i * 32 + dir * 16);
#pragma unroll
                for (int r4 = 0; r4 < 4; ++r4) { const f32x4 gv = gp[r4]; z += gv[0] * wg[4 * r4] + gv[1] * wg[4 * r4 + 1] + gv[2] * wg[4 * r4 + 2] + gv[3] * wg[4 * r4 + 3]; }
                gs[e] = logsig2_16(z); }
            float kiv[8];
#pragma unroll
            for (int e = 0; e < 8; ++e) { const int pos = dir ? 7 - e : e, i = (dir ? 56 - 8 * blk : 8 * blk) + pos;
                cum += gs[pos];
                const float qv = bf1(Qt[i * 256 + cl]), kv = bf1(Kt[i * 256 + cl]);
                OUT[(dir * 64 + i) * 256 + cl] = f2bf(qv * __builtin_amdgcn_exp2f(cum)); kiv[pos] = kv * __builtin_amdgcn_exp2f(-cum); }
            u32x4 w; w.x = pk_bf16(kiv[0], kiv[1]); w.y = pk_bf16(kiv[2], kiv[3]); w.z = pk_bf16(kiv[4], kiv[5]); w.w = pk_bf16(kiv[6], kiv[7]);
            if (dir) { kpk[4 * (7 - blk)] = w.x; kpk[4 * (7 - blk) + 1] = w.y; kpk[4 * (7 - blk) + 2] = w.z; kpk[4 * (7 - blk) + 3] = w.w; }
            else { kpk[4 * blk] = w.x; kpk[4 * blk + 1] = w.y; kpk[4 * blk + 2] = w.z; kpk[4 * blk + 3] = w.w; }
            __builtin_amdgcn_sched_barrier(0);
        }
    return cum;
}
DI void phase_gla_prep(const Ctx& c, int j) {
    const Params& p = *c.p; unsigned char* ws = c.ws; const int tid = c.tid;
    const bf16_t* QG = (const bf16_t*)(ws + WS_R1); const bf16_t* KG = (const bf16_t*)(ws + WS_R1 + SZ_T512); const bf16_t* VG = (const bf16_t*)(ws + WS_R1 + 2 * SZ_T512);
    const float* GL = (const float*)(ws + WS_GL); float* DEC = (float*)(ws + WS_DEC); bf16_t* VTt = (bf16_t*)(ws + WS_VTT);
    bf16_t* Qt = (bf16_t*)c.smem;
    bf16_t* Kt = Qt + 64 * 256;
    bf16_t* OUT = Kt + 64 * 256;
    float* gl = (float*)(c.smem + 131072);
    const int dir = __builtin_amdgcn_readfirstlane(tid >> 8), cl = tid & 255;
    for (int u = c.bid; u < (T / 64) * 2; u += c.G) {
        const int ch = u >> 1, hc = u & 1, r0 = ch * 64, cg = 256 * hc + cl;
        __syncthreads();
#pragma unroll
        for (int it = 0; it < 4; ++it) { const int idx = it * 512 + tid, row = idx >> 5, c8 = (idx & 31) * 8;
            *(u32x4*)(Qt + row * 256 + c8) = *(const u32x4*)(QG + (size_t)(r0 + row) * 512 + 256 * hc + c8);
            *(u32x4*)(Kt + row * 256 + c8) = *(const u32x4*)(KG + (size_t)(r0 + row) * 512 + 256 * hc + c8); }
        ((f32x4*)gl)[tid] = ((const f32x4*)(GL + (size_t)r0 * 32))[tid];
        float wg[16];
#pragma unroll
        for (int r = 0; r < 16; ++r) wg[r] = p.in[15][((size_t)(j * 2 + dir) * 16 + r) * 512 + cg];
        const float bias = p.in[16][(size_t)(j * 2 + dir) * 512 + cg];
        __syncthreads();
        unsigned kpk[32];
        const float cum = dir ? gla_prep_gates<1>(Qt, Kt, OUT, gl, wg, bias, cl, kpk) : gla_prep_gates<0>(Qt, Kt, OUT, gl, wg, bias, cl, kpk);
        DEC[((size_t)dir * (T / 64) + ch) * 512 + cg] = __builtin_amdgcn_exp2f(cum);
        __syncthreads();
#pragma unroll 2
        for (int it = 0; it < 8; ++it) { const int idx = it * 512 + tid, d2 = idx >> 11, row = (idx >> 5) & 63, c8 = (idx & 31) * 8;
            *(u32x4*)((bf16_t*)(ws + WS_R2) + (size_t)d2 * T * 512 + (size_t)(r0 + row) * 512 + 256 * hc + c8) = *(const u32x4*)(OUT + (d2 * 64 + row) * 256 + c8); }
        bf16_t* KT = Qt;
#pragma unroll
        for (int cb = 0; cb < 8; ++cb) *(u32x4*)(KT + (dir * 256 + cl) * 64 + ((cb ^ (cl & 7)) * 8)) = (u32x4){kpk[4 * cb], kpk[4 * cb + 1], kpk[4 * cb + 2], kpk[4 * cb + 3]};
        __syncthreads();
#pragma unroll 2
        for (int it = 0; it < 8; ++it) { const int idx = it * 512 + tid, d2 = idx >> 11, clr = (idx >> 3) & 255, cb = idx & 7;
            *(u32x4*)((bf16_t*)(ws + WS_R2 + 2 * SZ_T1K) + (((size_t)d2 * (T / 64) + ch) * 512 + 256 * hc + clr) * 64 + cb * 8) = *(const u32x4*)(KT + (d2 * 256 + clr) * 64 + ((cb ^ (clr & 7)) * 8)); }
#pragma unroll
        for (int i2 = 0; i2 < 32; ++i2) { OUT[(dir * 64 + 2 * i2) * 256 + cl] = (bf16_t)(kpk[i2] & 0xffffu); OUT[(dir * 64 + 2 * i2 + 1) * 256 + cl] = (bf16_t)(kpk[i2] >> 16); }
        __syncthreads();
#pragma unroll 2
        for (int it = 0; it < 8; ++it) { const int idx = it * 512 + tid, d2 = idx >> 11, row = (idx >> 5) & 63, c8 = (idx & 31) * 8;
            *(u32x4*)((bf16_t*)(ws + WS_R2 + SZ_T1K) + (size_t)d2 * T * 512 + (size_t)(r0 + row) * 512 + 256 * hc + c8) = *(const u32x4*)(OUT + (d2 * 64 + row) * 256 + c8); }
        bf16_t* Vl = Qt;
#pragma unroll 2
        for (int it = 0; it < 8; ++it) { const int idx = it * 512 + tid, row = idx >> 6, c8 = (idx & 63) * 8;
            *(u32x4*)(Vl + row * 512 + c8) = *(const u32x4*)(VG + (size_t)(r0 + row) * 1024 + 512 * hc + c8); }
        __syncthreads();
        bf16_t* VTl = OUT;
#pragma unroll 2
        for (int cb = 0; cb < 8; ++cb) { unsigned short x[8];
#pragma unroll
            for (int t = 0; t < 8; ++t) x[t] = Vl[(8 * cb + t) * 512 + tid];
            u32x4 w; w.x = (unsigned)x[0] | ((unsigned)x[1] << 16); w.y = (unsigned)x[2] | ((unsigned)x[3] << 16); w.z = (unsigned)x[4] | ((unsigned)x[5] << 16); w.w = (unsigned)x[6] | ((unsigned)x[7] << 16);
            *(u32x4*)(VTl + tid * 64 + ((cb ^ (tid & 7)) * 8)) = w; }
        __syncthreads();
#pragma unroll 2
        for (int it = 0; it < 8; ++it) { const int idx = it * 512 + tid, er = idx >> 3, cb = idx & 7;
            *(u32x4*)(VTt + ((size_t)ch * 1024 + 512 * hc + er) * 64 + cb * 8) = *(const u32x4*)(VTl + er * 64 + ((cb ^ (er & 7)) * 8)); }
    }
}

DI void phase_gla_scan(const Ctx& c) {
    unsigned char* ws = c.ws; const int tid = c.tid, lane = c.lane, w = c.wave, g = lane >> 4, cc = lane & 15;
    const bf16_t* VTt = (const bf16_t*)(ws + WS_VTT); const float* DEC = (const float*)(ws + WS_DEC);
    constexpr int LDQ = 136, LDJ = 72;
    bf16_t* Qs = (bf16_t*)c.smem;
    bf16_t* Ks = Qs + 64 * LDQ;
    bf16_t* KEt = Ks + 64 * LDQ;
    bf16_t* Vt = KEt + 128 * LDJ;
    bf16_t* At = Vt + 128 * LDJ;
    bf16_t* St = At + 64 * LDJ;
    bf16_t* Ot = St + 128 * LDQ;
    float* dec = (float*)(Ot + 64 * LDQ);
    const int qtok0 = tid >> 4, qd8 = (tid & 15) * 8;
    const int ked0 = tid >> 3, kej8 = (tid & 7) * 8;
    for (int u = c.bid; u < NB * 4 * 2 * 2; u += c.G) {
        const int b = u >> 4, h = (u >> 2) & 3, es = (u >> 1) & 1, dir = u & 1;
        bf16_t* O = (bf16_t*)(ws + (dir ? WS_OB : WS_H1));
        const bf16_t* QIN = (const bf16_t*)(ws + WS_R2) + (size_t)dir * T * 512; const bf16_t* KIN = (const bf16_t*)(ws + WS_R2 + SZ_T1K) + (size_t)dir * T * 512;
        const bf16_t* KINt = (const bf16_t*)(ws + WS_R2 + 2 * SZ_T1K) + (size_t)dir * (T / 64) * 512 * 64;
        f32x4 accS[8];
#pragma unroll
        for (int et = 0; et < 8; ++et) accS[et] = (f32x4){0.f, 0.f, 0.f, 0.f};
        __syncthreads();
        for (int i = tid; i < 128 * LDQ / 2; i += NTHR) ((unsigned*)St)[i] = 0u;
        u32x4 pq[2], pk[2], pke[2], pv[2]; float pdec = 0.f;
#define GLA_R0(cs_) (dir == 0 ? ((cs_) < 4 ? TL + b * CTXL + 64 * (cs_) : b * SEQ + 64 * ((cs_) - 4)) : ((cs_) < 4 ? TL + b * CTXL + 64 * (3 - (cs_)) : b * SEQ + 64 * (35 - (cs_))))
#define GLA_LOAD(cs_) do { const int r0_ = GLA_R0(cs_); const int chunk_ = r0_ >> 6; \
            _Pragma("unroll") for (int it = 0; it < 2; ++it) { const size_t go = (size_t)(r0_ + qtok0 + 32 * it) * 512 + h * 128 + qd8; pq[it] = *(const u32x4*)(QIN + go); pk[it] = *(const u32x4*)(KIN + go); \
                pke[it] = *(const u32x4*)(KINt + ((size_t)chunk_ * 512 + h * 128 + ked0 + 64 * it) * 64 + kej8); \
                pv[it] = *(const u32x4*)(VTt + ((size_t)chunk_ * 1024 + h * 256 + es * 128 + ked0 + 64 * it) * 64 + kej8); } \
            if (tid < 128) pdec = DEC[((size_t)dir * (T / 64) + chunk_) * 512 + h * 128 + tid]; } while (0)
        GLA_LOAD(0);
        for (int cs = 0; cs < 36; ++cs) {
            const int r0 = GLA_R0(cs);
#pragma unroll
            for (int it = 0; it < 2; ++it) { *(u32x4*)(Qs + (qtok0 + 32 * it) * LDQ + qd8) = pq[it]; *(u32x4*)(Ks + (qtok0 + 32 * it) * LDQ + qd8) = pk[it];
                *(u32x4*)(KEt + (ked0 + 64 * it) * LDJ + kej8) = pke[it]; *(u32x4*)(Vt + (ked0 + 64 * it) * LDJ + kej8) = pv[it]; }
            if (tid < 128) dec[tid] = pdec;
            __syncthreads();
            GLA_LOAD(cs + 1 < 36 ? cs + 1 : cs);
            { const int it = w >> 1;
#pragma unroll
              for (int jj = 0; jj < 2; ++jj) { const int jt = 2 * (w & 1) + jj; f32x4 a = {0.f, 0.f, 0.f, 0.f};
#pragma unroll
                  for (int ks = 0; ks < 4; ++ks) a = mfma16(frag_ld(Qs, LDQ, 16 * it, 32 * ks, lane), frag_ld(Ks, LDQ, 16 * jt, 32 * ks, lane), a);
                  const int jcol = 16 * jt + cc;
#pragma unroll
                  for (int r = 0; r < 4; ++r) { const int i = 16 * it + 4 * g + r; const bool keep = dir ? (jcol >= i) : (jcol <= i);
                      At[i * LDJ + jcol] = f2bf(keep ? a[r] : 0.f); } } }
            __syncthreads();
            { const int it = w >> 1;
#pragma unroll
              for (int ee = 0; ee < 4; ++ee) { const int et = 4 * (w & 1) + ee; f32x4 a = {0.f, 0.f, 0.f, 0.f};
#pragma unroll
                  for (int ks = 0; ks < 2; ++ks) a = mfma16(frag_ld(At, LDJ, 16 * it, 32 * ks, lane), frag_ld(Vt, LDJ, 16 * et, 32 * ks, lane), a);
#pragma unroll
                  for (int ks = 0; ks < 4; ++ks) a = mfma16(frag_ld(Qs, LDQ, 16 * it, 32 * ks, lane), frag_ld(St, LDQ, 16 * et, 32 * ks, lane), a);
#pragma unroll
                  for (int r = 0; r < 4; ++r) Ot[(16 * it + 4 * g + r) * LDQ + 16 * et + cc] = f2bf(a[r]); } }
#pragma unroll
            for (int et = 0; et < 8; ++et) {
#pragma unroll
                for (int ks = 0; ks < 2; ++ks) accS[et] = mfma16(frag_ld(KEt, LDJ, 16 * w, 32 * ks, lane), frag_ld(Vt, LDJ, 16 * et, 32 * ks, lane), accS[et]);
#pragma unroll
                for (int r = 0; r < 4; ++r) accS[et][r] *= dec[16 * w + 4 * g + r];
            }
            __syncthreads();
#pragma unroll
            for (int et = 0; et < 8; ++et) { u32x2 sv; sv.x = pk_bf16(accS[et][0], accS[et][1]); sv.y = pk_bf16(accS[et][2], accS[et][3]);
                *(u32x2*)(St + (16 * et + cc) * LDQ + 16 * w + 4 * g) = sv; }
#pragma unroll
            for (int it = 0; it < 2; ++it) *(u32x4*)(O + (size_t)(r0 + qtok0 + 32 * it) * 1024 + h * 256 + es * 128 + qd8) = *(const u32x4*)(Ot + (qtok0 + 32 * it) * LDQ + qd8);
        }
#undef GLA_LOAD
#undef GLA_R0
    }
}

DI void phase_gla_readout(const Ctx& c, int j) {
    const Params& p = *c.p; unsigned char* ws = c.ws;
    const bf16_t* O = (const bf16_t*)(ws + WS_H1); const bf16_t* OB = (const bf16_t*)(ws + WS_OB); const bf16_t* RG = (const bf16_t*)(ws + WS_R1 + 2 * SZ_T512 + SZ_T1K); bf16_t* Y = (bf16_t*)(ws + WS_R2);
    const float* gn = p.in[17] + (size_t)j * 1024; const int stride = c.G * NWAVE;
    for (int row0 = c.bid * NWAVE + c.wave; row0 < T; row0 += 2 * stride) {
        const bool has2 = row0 + stride < T; const int rows[2] = {row0, has2 ? row0 + stride : row0};
        u32x2 ov[2][4], ow[2][4], rv[2][4];
#pragma unroll
        for (int rr = 0; rr < 2; ++rr)
#pragma unroll
            for (int hd = 0; hd < 4; ++hd) { const size_t o = (size_t)rows[rr] * D + 4 * c.lane + 256 * hd; ov[rr][hd] = *(const u32x2*)(O + o); ow[rr][hd] = *(const u32x2*)(OB + o); rv[rr][hd] = *(const u32x2*)(RG + o); }
#pragma unroll
        for (int rr = 0; rr < 2; ++rr) {
            if (rr == 1 && !has2) break;
#pragma unroll
            for (int hd = 0; hd < 4; ++hd) { const int col = 4 * c.lane + 256 * hd;
                const float x0 = bf_lo(ov[rr][hd].x) + bf_lo(ow[rr][hd].x), x1 = bf_hi(ov[rr][hd].x) + bf_hi(ow[rr][hd].x), x2 = bf_lo(ov[rr][hd].y) + bf_lo(ow[rr][hd].y), x3 = bf_hi(ov[rr][hd].y) + bf_hi(ow[rr][hd].y);
                const float mean = wave_sum((x0 + x1) + (x2 + x3)) * (1.0f / 256.0f);
                const float d0 = x0 - mean, d1 = x1 - mean, d2 = x2 - mean, d3 = x3 - mean;
                const float rstd = rsqrtf(wave_sum((d0 * d0 + d1 * d1) + (d2 * d2 + d3 * d3)) * (1.0f / 256.0f) + LN_EPS);
                const f32x4 gg = *(const f32x4*)(gn + col);
                const float r0 = bf_lo(rv[rr][hd].x), r1 = bf_hi(rv[rr][hd].x), r2 = bf_lo(rv[rr][hd].y), r3 = bf_hi(rv[rr][hd].y);
                u32x2 o; o.x = pk_bf16(d0 * rstd * gg[0] * silu_f(r0), d1 * rstd * gg[1] * silu_f(r1)); o.y = pk_bf16(d2 * rstd * gg[2] * silu_f(r2), d3 * rstd * gg[3] * silu_f(r3));
                *(u32x2*)(Y + (size_t)rows[rr] * D + col) = o; }
        }
    }
}

constexpr int N_PHASES = 2 + 2 * 8 + 2 * 9;

__global__ void __launch_bounds__(NTHR, 2) mega_fwd(Params p) {
    extern __shared__ __attribute__((aligned(16))) unsigned char smem[];
    cg::grid_group grid = cg::this_grid();
    Ctx c; c.p = &p; c.ws = p.ws; c.smem = smem; c.tid = threadIdx.x; c.lane = c.tid & 63; c.wave = __builtin_amdgcn_readfirstlane(c.tid >> 6); c.G = gridDim.x; c.bid = blockIdx.x;
    unsigned char* ws = p.ws;
    volatile LAS unsigned* xst = (volatile LAS unsigned*)((LAS unsigned char*)smem + (LDS_BYTES - 16));
    if (threadIdx.x == 0) { xst[0] = 0u; xst[1] = 0u; }
    __syncthreads();
    const XcdBarrier xbar = xcd_barrier_post((unsigned*)(ws + WS_CTL), xst);
    const int lo = p.ph_lo, hi = p.ph_hi;
    int ph = 0;
#ifndef PH_ONLY
#define PH_ONLY -1
#endif
#ifndef DUP_MASK
#define DUP_MASK 0
#endif
#define RUN1(...) { { int t_ = threadIdx.x; asm volatile("" : "+v"(t_)); c.tid = t_; c.lane = t_ & 63; c.wave = __builtin_amdgcn_readfirstlane(t_ >> 6); { size_t z_ = 0; asm volatile("" : "+s"(z_)); ws = p.ws + z_; } c.ws = ws; } __VA_ARGS__; }
#define RUN(id, ...) do { if ((PH_ONLY < 0 || PH_ONLY == (id)) && ph >= lo && ph < hi) { \
        RUN1(__VA_ARGS__) \
        if ((DUP_MASK >> (id)) & 1) { xcd_barrier(xbar); RUN1(__VA_ARGS__) } \
        if (ph + 1 < hi) { if (ph == 0) grid.sync(); else xcd_barrier(xbar); } } ++ph; } while (0)
    LAS unsigned char* lds = (LAS unsigned char*)smem;
    const float* MOD = (const float*)(ws + WS_MOD);

    RUN(0, phase_prologue(c));
    RUN(1, phase_mod0(c));
    for (int L = 0; L < DEPTH; ++L) {
        const int j = L >> 1;
        if ((L & 1) == 0) {
            RUN(2, { pg8::Gemm g{(const bf16_t*)(ws + WS_H1), (const bf16_t*)(ws + WS_WAIN) + (size_t)j * 2048 * 1024, T, 2048, 1024}; pg8::StaticOrder S; S.init(T, 2048, c.G, c.bid);
                  pg8::EpiBf16<1> E{(bf16_t*)(ws + WS_R1), 2048}; pg8::gemm_phase(lds, g, S, E, c.tid); });
            RUN(3, phase_vstats(c));
            RUN(4, phase_spatial(c, j));
        } else {
            RUN(5, { pg8::Gemm g{(const bf16_t*)(ws + WS_H1), (const bf16_t*)(ws + WS_WBIN) + (size_t)j * WBIN_N * 1024, T, WBIN_N, 1024}; pg8::StaticOrder S; S.init(T, WBIN_N, c.G, c.bid);
                  pg8::EpiGlaProj E{(bf16_t*)(ws + WS_R1), (bf16_t*)(ws + WS_R1 + SZ_T512), (bf16_t*)(ws + WS_R1 + 2 * SZ_T512), (bf16_t*)(ws + WS_R1 + 2 * SZ_T512 + SZ_T1K), (float*)(ws + WS_GL)};
                  pg8::gemm_phase(lds, g, S, E, c.tid); });
            RUN(6, phase_gla_prep(c, j));
            RUN(7, phase_gla_scan(c));
            RUN(8, phase_gla_readout(c, j));
        }
        const int Mrows = (L == DEPTH - 1) ? TL : T;
        RUN(9, { const bf16_t* W = (L & 1) ? (const bf16_t*)(ws + WS_WBOUT) + (size_t)j * 1024 * 1024 : (const bf16_t*)(ws + WS_WAOUT) + (size_t)j * 1024 * 1024;
              pg8::Gemm g{(const bf16_t*)(ws + WS_R2), W, Mrows, 1024, 1024}; pg8::StaticOrder S; S.init(Mrows, 1024, c.G, c.bid);
              pg8::EpiRes E{p.in[0], p.in[2], (bf16_t*)(ws + WS_XS), MOD + (size_t)L * 17 * 6144, 2, L == 0 ? 1 : 0};
              pg8::gemm_phase(lds, g, S, E, c.tid); });
        RUN(10, phase_ln1(c, L));
        RUN(11, { pg8::Gemm g{(const bf16_t*)(ws + WS_R2 + SZ_T1K), (const bf16_t*)(ws + WS_WQ) + (size_t)L * 1024 * 1024, Mrows, 1024, 1024}; pg8::StaticOrder S; S.init(Mrows, 1024, c.G, c.bid);
              pg8::EpiBf16<0> E{(bf16_t*)(ws + WS_R1), 1024}; pg8::gemm_phase(lds, g, S, E, c.tid); });
        RUN(12, phase_route(c, L));
        RUN(13, phase_experts(c, L));
    }
#undef RUN
}

extern "C" void kernel_launch(void* const* d_in, const int* in_sizes, int n_in, void* d_out, int out_size, void* d_ws, size_t ws_size, hipStream_t stream) {
    static int grid = 0;
    if (grid == 0) {
        if (n_in != 23 || out_size != TL * D || ws_size < WS_END) { fprintf(stderr, "kernel_launch: unexpected shapes: n_in %d out %d ws %zu (need %zu)\n", n_in, out_size, ws_size, (size_t)WS_END); grid = -1; return; }
        int dev = 0, cus = 0, per_cu = 0;
        if (hipGetDevice(&dev) != hipSuccess || hipDeviceGetAttribute(&cus, hipDeviceAttributeMultiprocessorCount, dev) != hipSuccess) { fprintf(stderr, "kernel_launch: device query failed\n"); grid = -1; return; }
        if (hipFuncSetAttribute((const void*)mega_fwd, hipFuncAttributeMaxDynamicSharedMemorySize, LDS_BYTES) != hipSuccess) { fprintf(stderr, "kernel_launch: hipFuncSetAttribute failed\n"); grid = -1; return; }
        if (hipOccupancyMaxActiveBlocksPerMultiprocessor(&per_cu, (const void*)mega_fwd, NTHR, LDS_BYTES) != hipSuccess || per_cu < 1) { fprintf(stderr, "kernel_launch: occupancy query says %d blocks per CU\n", per_cu); grid = -1; return; }
        grid = cus;
    }
    if (grid < 0) return;
    (void)hipMemsetAsync((char*)d_ws + WS_CTL, 0, 65536, stream);
    Params p{};
    for (int i = 0; i < 23; ++i) p.in[i] = (const float*)d_in[i];
    p.out = (float*)d_out; p.ws = (unsigned char*)d_ws; p.ph_lo = 0; p.ph_hi = N_PHASES;
    void* args[] = {&p};
    const hipError_t e = hipLaunchCooperativeKernel((const void*)mega_fwd, dim3(grid), dim3(NTHR), args, LDS_BYTES, stream);
    if (e != hipSuccess) fprintf(stderr, "kernel_launch: cooperative launch failed: %s (grid %d)\n", hipGetErrorString(e), grid);
}
```

```cpp
#include <hip/hip_runtime.h>
#include <hip/hip_cooperative_groups.h>
#include <cstdio>
#include <cstdint>
namespace cg = cooperative_groups;

#define LAS __attribute__((address_space(3)))
#define DI __device__ __forceinline__
typedef unsigned short bf16_t;
typedef short bf16x8 __attribute__((ext_vector_type(8)));
typedef float f32x4 __attribute__((ext_vector_type(4)));
typedef float f32x2 __attribute__((ext_vector_type(2)));
typedef unsigned u32x4 __attribute__((ext_vector_type(4)));
typedef unsigned u32x2 __attribute__((ext_vector_type(2)));
typedef __bf16 bf16v2 __attribute__((ext_vector_type(2)));

constexpr int D = 1024, NB = 16, SEQ = 2048, CTXL = 256, DEPTH = 4;
constexpr int TL = NB * SEQ, TC = NB * CTXL, T = TL + TC;
constexpr int NEXP = 16384;
constexpr float LN_EPS = 1e-5f;
constexpr float DN_ALPHA = 1.6817928305074290f;
constexpr int NTHR = 512, NWAVE = 8;
constexpr int LDS_BYTES = 140 * 1024;
constexpr int WBIN_N = 3328;

constexpr size_t al256(size_t x) { return (x + 255) & ~(size_t)255; }
constexpr size_t WS_CTL = 0;
constexpr size_t WS_MOD = 65536;
constexpr size_t WS_STATS = al256(WS_MOD + (size_t)4 * 17 * 6144 * 4);
constexpr size_t WS_GL = al256(WS_STATS + (size_t)T * 2 * 4);
constexpr size_t WS_DEC = al256(WS_GL + (size_t)T * 32 * 4);
constexpr size_t WS_WSB = al256(WS_DEC + (size_t)2 * 576 * 512 * 4);
constexpr size_t WS_WAIN = al256(WS_WSB + (size_t)2 * 8 * 128 * 128 * 2);
constexpr size_t WS_WAOUT = WS_WAIN + (size_t)2 * 2048 * 1024 * 2;
constexpr size_t WS_WBIN = WS_WAOUT + (size_t)2 * 1024 * 1024 * 2;
constexpr size_t WS_WBOUT = WS_WBIN + (size_t)2 * WBIN_N * 1024 * 2;
constexpr size_t WS_WQ = WS_WBOUT + (size_t)2 * 1024 * 1024 * 2;
constexpr size_t WS_UT = WS_WQ + (size_t)4 * 1024 * 1024 * 2;
constexpr size_t WS_VT = WS_UT + (size_t)4 * NEXP * 1024;
constexpr size_t WS_SU = WS_VT + (size_t)4 * NEXP * 1024;
constexpr size_t WS_SV = WS_SU + (size_t)4 * NEXP * 4;
constexpr size_t WS_XS = WS_SV + (size_t)4 * NEXP * 4;
constexpr size_t WS_R1 = WS_XS + (size_t)T * 1024 * 4;
constexpr size_t WS_R2 = WS_R1 + (size_t)T * 3072 * 2;
constexpr size_t WS_H1 = WS_R2 + (size_t)T * 3072 * 2;
constexpr size_t WS_VTT = WS_H1 + (size_t)T * 1024 * 2;
constexpr size_t WS_OB = WS_VTT + (size_t)T * 1024 * 2;
constexpr size_t WS_XH = WS_OB + (size_t)T * 1024 * 2;
constexpr size_t WS_XL = WS_XH + (size_t)T * 512;
constexpr size_t WS_SX = WS_XL + (size_t)T * 512;
constexpr size_t WS_END = al256(WS_SX + (size_t)T * 4);
constexpr size_t SZ_T1K = (size_t)T * 1024 * 2;
constexpr size_t SZ_T512 = (size_t)T * 512 * 2;

struct Params { const float* in[23]; float* out; unsigned char* ws; int ph_lo, ph_hi; };

DI unsigned pk_bf16(float lo, float hi) { f32x2 v = {lo, hi}; return __builtin_bit_cast(unsigned, __builtin_convertvector(v, bf16v2)); }
DI float bf_lo(unsigned w) { return __uint_as_float(w << 16); }
DI float bf_hi(unsigned w) { return __uint_as_float(w & 0xffff0000u); }
DI float bf1(bf16_t b) { return __uint_as_float(((unsigned)b) << 16); }
DI bf16_t f2bf(float f) { return (bf16_t)(pk_bf16(f, 0.f) & 0xffffu); }
DI float gelu_tanh(float x) { const float u = 0.7978845608028654f * (x + 0.044715f * x * x * x); return __fdividef(x, 1.0f + __expf(-2.0f * u)); }
DI float silu_f(float x) { return __fdividef(x, 1.0f + __expf(-x)); }
DI float logsig_f(float z) { return fminf(z, 0.f) - log1pf(expf(-fabsf(z))); }
template <int CTRL> DI float dpp_mov(float x) { return __builtin_bit_cast(float, __builtin_amdgcn_mov_dpp(__builtin_bit_cast(int, x), CTRL, 0xf, 0xf, true)); }
DI float wave_sum(float v) {
    const auto a = __builtin_amdgcn_permlane32_swap(__float_as_uint(v), __float_as_uint(v), false, false); v = __uint_as_float(a[0]) + __uint_as_float(a[1]);
    const auto b = __builtin_amdgcn_permlane16_swap(__float_as_uint(v), __float_as_uint(v), false, false); v = __uint_as_float(b[0]) + __uint_as_float(b[1]);
    v += dpp_mov<0x128>(v); v += dpp_mov<0x124>(v); v += dpp_mov<0x122>(v); v += dpp_mov<0x121>(v);
    return v;
}
DI float wave_max(float v) {
#pragma unroll
    for (int o = 32; o > 0; o >>= 1) v = fmaxf(v, __shfl_xor(v, o, 64));
    return v;
}
DI float reduce4(float p0, float p1, float p2, float p3) {
    const auto a = __builtin_amdgcn_permlane32_swap(__float_as_uint(p0), __float_as_uint(p2), false, false); const float q0 = __uint_as_float(a[0]) + __uint_as_float(a[1]);
    const auto b = __builtin_amdgcn_permlane32_swap(__float_as_uint(p1), __float_as_uint(p3), false, false); const float q1 = __uint_as_float(b[0]) + __uint_as_float(b[1]);
    const auto c = __builtin_amdgcn_permlane16_swap(__float_as_uint(q0), __float_as_uint(q1), false, false); float s = __uint_as_float(c[0]) + __uint_as_float(c[1]);
    s += dpp_mov<0x128>(s); s += dpp_mov<0x124>(s); s += dpp_mov<0x122>(s); s += dpp_mov<0x121>(s);
    return s;
}
DI float dot2bf(unsigned a, unsigned b, float c) { return __builtin_amdgcn_fdot2_f32_bf16(__builtin_bit_cast(bf16v2, a), __builtin_bit_cast(bf16v2, b), c, false); }
DI f32x4 mfma16(bf16x8 a, bf16x8 b, f32x4 c) { return __builtin_amdgcn_mfma_f32_16x16x32_bf16(a, b, c, 0, 0, 0); }
DI bf16x8 frag_ld(const bf16_t* X, int ld, int row0, int k0, int lane) { return *(const bf16x8*)(X + (size_t)(row0 + (lane & 15)) * ld + k0 + 8 * (lane >> 4)); }
DI int mod_batch(int row) { return row < TL ? (row >> 11) : NB; }

#define XB_TMO      128
#define XB_XCNT(j)  (256  + 64 * (j))
#define XB_XSUB(j)  (1280 + 64 * (j))
#define XB_XGEN(j)  (2304 + 64 * (j))
#define XB_TOP      3328
#define XB_TOPGEN   3392
#define XCD_BAR_WORDS 3456
#define XB_SPIN_CAP (1u << 22)
DI unsigned xb_ld(unsigned* p)              { return __hip_atomic_load(p, __ATOMIC_RELAXED, __HIP_MEMORY_SCOPE_AGENT); }
DI unsigned xb_add(unsigned* p, unsigned v) { return __hip_atomic_fetch_add(p, v, __ATOMIC_RELAXED, __HIP_MEMORY_SCOPE_AGENT); }
DI unsigned xb_xcc_id() { return (unsigned)__builtin_amdgcn_s_getreg((3 << 11) | 20) & 0xFu; }
#define XB_SPIN(cond, bar) do { unsigned _sp = 0; while (cond) { __builtin_amdgcn_s_sleep(1); \
    if ((++_sp & 255u) == 0u) { if (xb_ld(&(bar)[XB_TMO])) break; if (_sp > XB_SPIN_CAP) { atomicAdd(&(bar)[XB_TMO], 1u); break; } } } } while (0)
struct XcdBarrier { unsigned* bar; unsigned x; volatile LAS unsigned* st; };
DI XcdBarrier xcd_barrier_post(unsigned* bar, volatile LAS unsigned* st) {
    XcdBarrier b; b.bar = bar; b.x = xb_xcc_id(); b.st = st;
    if (threadIdx.x == 0) (void)xb_add(&bar[XB_XCNT(b.x)], 1u);
    return b;
}
DI void xcd_barrier_complete(unsigned* bar, unsigned x, unsigned& nloc, unsigned& nx) {
    const unsigned G = gridDim.x * gridDim.y * gridDim.z;
    unsigned sum, cnt, mine, sp = 0u;
    for (;;) {
        sum = 0u; cnt = 0u; mine = 0u;
#pragma unroll
        for (unsigned j = 0; j < 16; ++j) { const unsigned c = xb_ld(&bar[XB_XCNT(j)]); sum += c; cnt += (c > 0u) ? 1u : 0u; mine = (j == x) ? c : mine; }
        if (sum == G) break;
        __builtin_amdgcn_s_sleep(1);
        if ((++sp & 255u) == 0u) { if (xb_ld(&bar[XB_TMO])) break; if (sp > XB_SPIN_CAP) { atomicAdd(&bar[XB_TMO], 1u); break; } }
    }
    nloc = mine > 0u ? mine : 1u; nx = cnt > 0u ? cnt : 1u;
}
DI void xcd_barrier(const XcdBarrier& b) {
    asm volatile("s_waitcnt vmcnt(0)" ::: "memory");
    __syncthreads();
    if (threadIdx.x == 0) {
        unsigned* bar = b.bar;
        __builtin_amdgcn_s_waitcnt(0);
        unsigned nloc = b.st[0], nx = b.st[1];
        if (nloc == 0u) { xcd_barrier_complete(bar, b.x, nloc, nx); b.st[0] = nloc; b.st[1] = nx; }
        const unsigned old = xb_add(&bar[XB_XSUB(b.x)], 1u);
        const unsigned gen = old / nloc;
        if (old + 1u == (gen + 1u) * nloc) {
            __builtin_amdgcn_fence(__ATOMIC_RELEASE, "agent");
            asm volatile("s_waitcnt vmcnt(0)" ::: "memory");
            const unsigned og = xb_add(&bar[XB_TOP], 1u);
            const unsigned tg = og / nx;
            if (og + 1u == (tg + 1u) * nx) xb_add(&bar[XB_TOPGEN], 1u);
            else XB_SPIN(xb_ld(&bar[XB_TOPGEN]) == tg, bar);
            __builtin_amdgcn_fence(__ATOMIC_ACQUIRE, "agent");
            xb_add(&bar[XB_XGEN(b.x)], 1u);
            asm volatile("s_waitcnt vmcnt(0)" ::: "memory");
        } else {
            XB_SPIN(xb_ld(&bar[XB_XGEN(b.x)]) == gen, bar);
            __builtin_amdgcn_fence(__ATOMIC_ACQUIRE, "agent");
            asm volatile("s_waitcnt vmcnt(0)" ::: "memory");
        }
    }
    __syncthreads();
}

namespace pg8 {
constexpr int BM = 256, BK = 64, HALF = 128, HTB = HALF * BK * 2, STAGE_BYTES = 8 * HTB, NXCD = 8, WGM = 8;
__host__ __device__ __forceinline__ int lds_byte(int r, int c) { const int st = (r >> 4) * 2 + (c >> 5), rr = r & 15, cc = c & 31, ob = rr * 64 + cc * 2; return st * 1024 + (ob ^ (((ob >> 9) & 1) << 5)); }
__host__ __device__ __forceinline__ void stage_rc(int b, int& R, int& C) { const int st = b / 1024, sb = b % 1024, swz = sb ^ (((sb >> 9) & 1) << 5); R = (st >> 1) * 16 + swz / 64; C = (st & 1) * 32 + (swz % 64) / 2; }
__host__ __device__ __forceinline__ int perm32(int rho) { const int n = rho >> 4, i = rho & 15; return 8 * (i >> 2) + 4 * n + (i & 3); }
struct Unit { int pm, pn; };
struct Gemm { const bf16_t* A; const bf16_t* Bt; int M, N, K; };
struct StaticOrder {
    int nM, nN, nwg, G, c;
    __device__ void init(int M, int N, int G_, int c_) { nM = M / BM; nN = N / BM; nwg = nM * nN; G = G_; c = c_; }
    __device__ bool next(int i, Unit& u) const {
        const long L = (long)i * G + c; if (L >= nwg) return false;
        int wgid = (int)L; { const int q = nwg / NXCD, r = nwg % NXCD, xcd = wgid % NXCD, off = wgid / NXCD; wgid = (xcd < r ? xcd * (q + 1) : r * (q + 1) + (xcd - r) * q) + off; }
        const int nig = WGM * nN, gid = wgid / nig, fm = gid * WGM, gsz = (nM - fm) < WGM ? (nM - fm) : WGM;
        u.pm = fm + ((wgid % nig) % gsz); u.pn = (wgid % nig) / gsz; return true;
    }
};

template <class Epi>
__device__ __forceinline__ void gemm_phase(LAS unsigned char* lds, const Gemm g, const StaticOrder& S, const Epi& E, const int tid) {
    const int wid = __builtin_amdgcn_readfirstlane(tid >> 6), lane = tid & 63, wr = wid >> 2, wc = wid & 3, fr = lane & 15, fq = lane >> 4;
    const int K = g.K, nt = K / BK;
    unsigned voffA[2], voffB[2];
#pragma unroll
    for (int i = 0; i < 2; ++i) { int R, C; stage_rc(tid * 16 + i * 8192, R, C); const int Rb = Epi::PERM ? ((R & ~31) + perm32(R & 31)) : R;
        voffA[i] = (unsigned)(R * K + C) * 2u; voffB[i] = (unsigned)(Rb * K + C) * 2u; }
    const size_t kstep = (size_t)(BK * 2);
    const size_t hstep = (size_t)HALF * K * 2;
    const size_t tstep = 2 * hstep;
    const unsigned ldsw = (unsigned)wid * 1024u;
    const int aoff = lds_byte(wr * 64 + fr, fq * 8), boff = lds_byte(wc * 32 + fr, fq * 8);
#define PG8_SA(b, h) (((b) * 2 + (h)) * HTB)
#define PG8_SB(b, h) ((4 + (b) * 2 + (h)) * HTB)
#define PG8_STAGE(bufoff, gbase, voff) do { _Pragma("unroll") for (int _i = 0; _i < 2; ++_i) \
        __builtin_amdgcn_global_load_lds((const unsigned*)((const char*)(gbase) + (voff)[_i]), (LAS unsigned*)(lds + (bufoff) + ldsw + _i * 8192), 16, 0, 0); } while (0)
#define PG8_LDA(dst, b, h) do { _Pragma("unroll") for (int m = 0; m < 4; ++m) _Pragma("unroll") for (int k = 0; k < 2; ++k) dst[m][k] = *(const LAS bf16x8*)(lds + PG8_SA(b, h) + aoff + m * 2048 + k * 1024); } while (0)
#define PG8_LDB(dst, b, h) do { _Pragma("unroll") for (int n = 0; n < 2; ++n) _Pragma("unroll") for (int k = 0; k < 2; ++k) dst[n][k] = *(const LAS bf16x8*)(lds + PG8_SB(b, h) + boff + n * 2048 + k * 1024); } while (0)
#define PG8_MMA(ai, bj, At, Bt) do { __builtin_amdgcn_s_setprio(1); _Pragma("unroll") for (int m = 0; m < 4; ++m) _Pragma("unroll") for (int n = 0; n < 2; ++n) _Pragma("unroll") for (int k = 0; k < 2; ++k) \
        acc[ai][bj][m][n] = __builtin_amdgcn_mfma_f32_16x16x32_bf16(Bt[n][k], At[m][k], acc[ai][bj][m][n], 0, 0, 0); __builtin_amdgcn_s_setprio(0); } while (0)
#define PG8_WAIT_V(n) asm volatile("s_waitcnt vmcnt(" #n ")" ::: "memory")
#define PG8_WAIT_L(n) asm volatile("s_waitcnt lgkmcnt(" #n ")" ::: "memory")
#define PG8_BAR __builtin_amdgcn_s_barrier()
#define PG8_SCHED __builtin_amdgcn_sched_barrier(0)
    Unit cur, nxt; int ui = 0;
    if (!S.next(0, cur)) return;
    f32x4 acc[2][2][4][2];
#pragma unroll
    for (int a = 0; a < 2; ++a)
#pragma unroll
        for (int b = 0; b < 2; ++b)
#pragma unroll
            for (int m = 0; m < 4; ++m)
#pragma unroll
                for (int n = 0; n < 2; ++n) acc[a][b][m][n] = (f32x4){0.f, 0.f, 0.f, 0.f};
    bf16x8 At[4][2], B0[2][2], B1[2][2];
    const char* cA = (const char*)g.A + (size_t)cur.pm * tstep; const char* cB = (const char*)g.Bt + (size_t)cur.pn * tstep;
    PG8_STAGE(PG8_SB(0, 0), cB, voffB); PG8_STAGE(PG8_SA(0, 0), cA, voffA); PG8_STAGE(PG8_SB(0, 1), cB + hstep, voffB); PG8_STAGE(PG8_SA(0, 1), cA + hstep, voffA);
    if (wr == 1) PG8_BAR;
    PG8_WAIT_V(4); PG8_BAR;
    PG8_STAGE(PG8_SB(1, 0), cB + kstep, voffB); PG8_STAGE(PG8_SA(1, 0), cA + kstep, voffA); PG8_STAGE(PG8_SB(1, 1), cB + hstep + kstep, voffB);
    PG8_WAIT_V(6); PG8_BAR;
    for (;;) {
        const bool has_next = S.next(ui + 1, nxt);
        const char* nA = has_next ? (const char*)g.A + (size_t)nxt.pm * tstep : cA; const char* nB = has_next ? (const char*)g.Bt + (size_t)nxt.pn * tstep : cB;
        for (int t = 0; t < nt; t += 2) {
            const bool last = (t == nt - 2);
            const char* a1 = cA + (size_t)(t + 1) * kstep;
            const char* a2 = last ? nA : cA + (size_t)(t + 2) * kstep; const char* b2 = last ? nB : cB + (size_t)(t + 2) * kstep;
            const char* a3 = a2 + kstep; const char* b3 = b2 + kstep;
            PG8_LDB(B0, 0, 0); PG8_SCHED; PG8_LDA(At, 0, 0); PG8_STAGE(PG8_SA(1, 1), a1 + hstep, voffA);
            PG8_WAIT_L(8); PG8_BAR; PG8_WAIT_L(0); PG8_MMA(0, 0, At, B0); PG8_BAR; PG8_SCHED;
            PG8_LDB(B1, 0, 1); PG8_STAGE(PG8_SB(0, 0), b2, voffB);
            PG8_BAR; PG8_WAIT_L(0); PG8_MMA(0, 1, At, B1); PG8_BAR;
            PG8_LDA(At, 0, 1); PG8_STAGE(PG8_SA(0, 0), a2, voffA);
            PG8_BAR; PG8_WAIT_L(0); PG8_MMA(1, 0, At, B0); PG8_BAR; PG8_SCHED;
            PG8_STAGE(PG8_SB(0, 1), b2 + hstep, voffB);
            PG8_WAIT_V(6); PG8_BAR; PG8_MMA(1, 1, At, B1); PG8_BAR;
            PG8_LDB(B0, 1, 0); PG8_SCHED; PG8_LDA(At, 1, 0); PG8_STAGE(PG8_SA(0, 1), a2 + hstep, voffA);
            PG8_WAIT_L(8); PG8_BAR; PG8_WAIT_L(0); PG8_MMA(0, 0, At, B0); PG8_BAR; PG8_SCHED;
            PG8_LDB(B1, 1, 1); PG8_STAGE(PG8_SB(1, 0), b3, voffB);
            PG8_BAR; PG8_WAIT_L(0); PG8_MMA(0, 1, At, B1); PG8_BAR;
            PG8_LDA(At, 1, 1); PG8_STAGE(PG8_SA(1, 0), a3, voffA);
            PG8_BAR; PG8_WAIT_L(0); PG8_MMA(1, 0, At, B0); PG8_BAR; PG8_SCHED;
            PG8_STAGE(PG8_SB(1, 1), b3 + hstep, voffB);
            PG8_WAIT_V(6); PG8_BAR; PG8_MMA(1, 1, At, B1); PG8_BAR;
        }
        E(acc, cur, wr, wc, fr, fq);
        if (!has_next) break;
#pragma unroll
        for (int a = 0; a < 2; ++a)
#pragma unroll
            for (int b = 0; b < 2; ++b)
#pragma unroll
                for (int m = 0; m < 4; ++m)
#pragma unroll
                    for (int n = 0; n < 2; ++n) acc[a][b][m][n] = (f32x4){0.f, 0.f, 0.f, 0.f};
        cur = nxt; cA = nA; cB = nB; ++ui;
    }
    PG8_WAIT_V(0);
    if (wr == 0) PG8_BAR;
    PG8_BAR;
#undef PG8_SA
#undef PG8_SB
#undef PG8_STAGE
#undef PG8_LDA
#undef PG8_LDB
#undef PG8_MMA
#undef PG8_WAIT_V
#undef PG8_WAIT_L
#undef PG8_BAR
#undef PG8_SCHED
}

template <int ACT  > struct EpiBf16 {
    static constexpr bool PERM = true;
    bf16_t* O; int ldc;
    __device__ __forceinline__ void operator()(const f32x4 (&acc)[2][2][4][2], const Unit& u, int wr, int wc, int fr, int fq) const {
        const int row0 = u.pm * BM + wr * 64 + fr, col0 = u.pn * BM + wc * 32 + 8 * fq;
#pragma unroll
        for (int ai = 0; ai < 2; ++ai)
#pragma unroll
            for (int m = 0; m < 4; ++m) { bf16_t* rowp = O + (size_t)(row0 + ai * HALF + m * 16) * ldc + col0;
#pragma unroll
                for (int bj = 0; bj < 2; ++bj) { f32x4 v0 = acc[ai][bj][m][0], v1 = acc[ai][bj][m][1];
                    if (ACT == 1) {
#pragma unroll
                        for (int j = 0; j < 4; ++j) { v0[j] = gelu_tanh(v0[j]); v1[j] = gelu_tanh(v1[j]); } }
                    u32x4 w; w.x = pk_bf16(v0[0], v0[1]); w.y = pk_bf16(v0[2], v0[3]); w.z = pk_bf16(v1[0], v1[1]); w.w = pk_bf16(v1[2], v1[3]);
                    *(u32x4*)(rowp + bj * HALF) = w; } }
    }
};
struct EpiRes {
    static constexpr bool PERM = true;
    const float* src_lat; const float* src_ctx; bf16_t* xs; const float* modL; int gate_idx; int src_f32;
    __device__ __forceinline__ void operator()(const f32x4 (&acc)[2][2][4][2], const Unit& u, int wr, int wc, int fr, int fq) const {
        const bool isctx = u.pm >= (TL / BM);
        const float* sb = isctx ? src_ctx + (size_t)(u.pm - TL / BM) * BM * D : src_lat + (size_t)u.pm * BM * D;
        const int mb = isctx ? NB : (u.pm >> 3);
        const float* gv = modL + (size_t)mb * 6144 + gate_idx * 1024;
        const int rl = wr * 64 + fr, col0 = u.pn * BM + wc * 32 + 8 * fq;
        f32x4 g[2][2];
#pragma unroll
        for (int bj = 0; bj < 2; ++bj)
#pragma unroll
            for (int n = 0; n < 2; ++n) g[bj][n] = *(const f32x4*)(gv + col0 + bj * HALF + n * 4);
#pragma unroll
        for (int ai = 0; ai < 2; ++ai)
#pragma unroll
            for (int m = 0; m < 4; ++m) { const int r = rl + ai * HALF + m * 16; bf16_t* dp = xs + ((size_t)u.pm * BM + r) * D + col0;
#pragma unroll
                for (int bj = 0; bj < 2; ++bj) { f32x4 x0, x1;
                    if (src_f32) { const float* sp = sb + (size_t)r * D + col0 + bj * HALF; x0 = *(const f32x4*)sp; x1 = *(const f32x4*)(sp + 4); }
                    else { const u32x4 xv = *(const u32x4*)(dp + bj * HALF); x0 = (f32x4){bf_lo(xv.x), bf_hi(xv.x), bf_lo(xv.y), bf_hi(xv.y)}; x1 = (f32x4){bf_lo(xv.z), bf_hi(xv.z), bf_lo(xv.w), bf_hi(xv.w)}; }
                    const f32x4 y0 = x0 * DN_ALPHA + g[bj][0] * acc[ai][bj][m][0], y1 = x1 * DN_ALPHA + g[bj][1] * acc[ai][bj][m][1];
                    u32x4 w; w.x = pk_bf16(y0[0], y0[1]); w.y = pk_bf16(y0[2], y0[3]); w.z = pk_bf16(y1[0], y1[1]); w.w = pk_bf16(y1[2], y1[3]);
                    *(u32x4*)(dp + bj * HALF) = w; } }
    }
};
struct EpiGlaProj {
    static constexpr bool PERM = true;
    bf16_t* QG; bf16_t* KG; bf16_t* VG; bf16_t* RG; float* GL;
    __device__ __forceinline__ void operator()(const f32x4 (&acc)[2][2][4][2], const Unit& u, int wr, int wc, int fr, int fq) const {
        const int row0 = u.pm * BM + wr * 64 + fr, pn = u.pn;
        if (pn < 12) {
            bf16_t* base; int ld, colt; float sc = 1.f;
            if (pn < 2) { base = QG; ld = 512; colt = pn * BM; sc = 0.08838834764831845f; }
            else if (pn < 4) { base = KG; ld = 512; colt = (pn - 2) * BM; }
            else if (pn < 8) { base = VG; ld = 1024; colt = (pn - 4) * BM; }
            else { base = RG; ld = 1024; colt = (pn - 8) * BM; }
            const int col0 = colt + wc * 32 + 8 * fq;
#pragma unroll
            for (int ai = 0; ai < 2; ++ai)
#pragma unroll
                for (int m = 0; m < 4; ++m) { bf16_t* rowp = base + (size_t)(row0 + ai * HALF + m * 16) * ld + col0;
#pragma unroll
                    for (int bj = 0; bj < 2; ++bj) { const f32x4 v0 = acc[ai][bj][m][0] * sc, v1 = acc[ai][bj][m][1] * sc;
                        u32x4 w; w.x = pk_bf16(v0[0], v0[1]); w.y = pk_bf16(v0[2], v0[3]); w.z = pk_bf16(v1[0], v1[1]); w.w = pk_bf16(v1[2], v1[3]);
                        *(u32x4*)(rowp + bj * HALF) = w; } }
        } else if (wc == 0) {
#pragma unroll
            for (int ai = 0; ai < 2; ++ai)
#pragma unroll
                for (int m = 0; m < 4; ++m) { float* gp = GL + (size_t)(row0 + ai * HALF + m * 16) * 32 + 8 * fq;
                    *(f32x4*)gp = acc[ai][0][m][0]; *(f32x4*)(gp + 4) = acc[ai][0][m][1]; }
        }
    }
};
}

struct Ctx {
    const Params* p; unsigned char* ws; unsigned char* smem; int tid, lane, wave, G, bid;
};

DI void phase_prologue(const Ctx& c) {
    const Params& p = *c.p; unsigned char* ws = c.ws;
    const int tid = c.tid;
    constexpr int N_MOD = 192, N_TR = 4736, N_WS = 64, N_TAB = 2048;
    constexpr int N_ALL = N_MOD + N_TR + N_WS + N_TAB;
    for (int u = c.bid; u < N_ALL; u += c.G) {
        if (u < N_MOD) {
            const int l = u / 48, n0 = (u % 48) * 128;
            float* sc = (float*)c.smem;
            float* red = (float*)(c.smem + 17 * 1024 * 4);
            __syncthreads();
#pragma unroll 1
            for (int hk = 0; hk < 2; ++hk) { const int k = hk * 512 + tid; float v[17];
#pragma unroll
                for (int b = 0; b < 17; ++b) v[b] = (b < NB) ? p.in[1][b * 1024 + k] : p.in[3][k];
#pragma unroll
                for (int b = 0; b < 17; ++b) sc[b * 1024 + k] = silu_f(v[b]); }
            __syncthreads();
            const int c4 = (tid & 31) * 4, kg = tid >> 5;
            float acc[17][4];
#pragma unroll
            for (int b = 0; b < 17; ++b) { acc[b][0] = 0.f; acc[b][1] = 0.f; acc[b][2] = 0.f; acc[b][3] = 0.f; }
            const float* wp = p.in[4] + ((size_t)l * 1024 + (size_t)kg * 64) * 6144 + n0 + c4;
#pragma unroll 4
            for (int kk = 0; kk < 64; ++kk) {
                const f32x4 w = *(const f32x4*)(wp + (size_t)kk * 6144);
                const int k = kg * 64 + kk;
#pragma unroll
                for (int b = 0; b < 17; ++b) { const float s = sc[b * 1024 + k]; acc[b][0] += s * w[0]; acc[b][1] += s * w[1]; acc[b][2] += s * w[2]; acc[b][3] += s * w[3]; }
            }
#pragma unroll
            for (int b = 0; b < 17; ++b)
#pragma unroll
                for (int j = 0; j < 4; ++j) acc[b][j] += __shfl_xor(acc[b][j], 32, 64);
            if ((tid & 32) == 0) {
#pragma unroll
                for (int b = 0; b < 17; ++b)
#pragma unroll
                    for (int j = 0; j < 4; ++j) red[(c.wave * 17 + b) * 128 + c4 + j] = acc[b][j];
            }
            __syncthreads();
            for (int o = tid; o < 17 * 128; o += NTHR) { const int b = o >> 7, n = o & 127; float s = 0.f;
#pragma unroll
                for (int w = 0; w < 8; ++w) s += red[(w * 17 + b) * 128 + n];
                ((float*)(ws + WS_MOD))[((size_t)l * 17 + b) * 6144 + n0 + n] = s + p.in[5][l * 6144 + n0 + n]; }
        } else if (u < N_MOD + N_TR) {
            int v = u - N_MOD; const float* src; bf16_t* dst; int N, Npad;
            if (v < 1024) { const int j = v / 512; v %= 512; src = p.in[8] + (size_t)j * 1024 * 2048; dst = (bf16_t*)(ws + WS_WAIN) + (size_t)j * 2048 * 1024; N = 2048; Npad = 2048; }
            else if (v < 1536) { v -= 1024; const int j = v / 256; v %= 256; src = p.in[13] + (size_t)j * 1024 * 1024; dst = (bf16_t*)(ws + WS_WAOUT) + (size_t)j * 1024 * 1024; N = 1024; Npad = 1024; }
            else if (v < 3200) { v -= 1536; const int j = v / 832; v %= 832; src = p.in[14] + (size_t)j * 1024 * 3104; dst = (bf16_t*)(ws + WS_WBIN) + (size_t)j * WBIN_N * 1024; N = 3104; Npad = WBIN_N; }
            else if (v < 3712) { v -= 3200; const int j = v / 256; v %= 256; src = p.in[18] + (size_t)j * 1024 * 1024; dst = (bf16_t*)(ws + WS_WBOUT) + (size_t)j * 1024 * 1024; N = 1024; Npad = 1024; }
            else { v -= 3712; const int j = v / 256; v %= 256; src = p.in[19] + (size_t)j * 1024 * 1024; dst = (bf16_t*)(ws + WS_WQ) + (size_t)j * 1024 * 1024; N = 1024; Npad = 1024; }
            (void)Npad;
            const int ntn = v >> 4, ktile = v & 15, n0 = ntn * 64, k0 = ktile * 64;
            float* tl = (float*)c.smem;
            __syncthreads();
#pragma unroll
            for (int i = 0; i < 2; ++i) { const int kk = (tid >> 4) + 32 * i, nn = (tid & 15) * 4;
                f32x4 x = {0.f, 0.f, 0.f, 0.f};
                if (n0 + nn < N) x = *(const f32x4*)(src + (size_t)(k0 + kk) * N + n0 + nn);
                tl[kk * 65 + nn] = x[0]; tl[kk * 65 + nn + 1] = x[1]; tl[kk * 65 + nn + 2] = x[2]; tl[kk * 65 + nn + 3] = x[3]; }
            __syncthreads();
            { const int nn = tid >> 3, kk8 = (tid & 7) * 8; float x[8];
#pragma unroll
              for (int j = 0; j < 8; ++j) x[j] = tl[(kk8 + j) * 65 + nn];
              u32x4 w; w.x = pk_bf16(x[0], x[1]); w.y = pk_bf16(x[2], x[3]); w.z = pk_bf16(x[4], x[5]); w.w = pk_bf16(x[6], x[7]);
              *(u32x4*)(dst + (size_t)(n0 + nn) * 1024 + k0 + kk8) = w; }
        } else if (u < N_MOD + N_TR + N_WS) {
            const int v = u - N_MOD - N_TR; const size_t e = (size_t)v * 4096 + (size_t)tid * 8;
            const f32x4 a = *(const f32x4*)(p.in[11] + e), b = *(const f32x4*)(p.in[11] + e + 4);
            u32x4 w; w.x = pk_bf16(a[0], a[1]); w.y = pk_bf16(a[2], a[3]); w.z = pk_bf16(b[0], b[1]); w.w = pk_bf16(b[2], b[3]);
            *(u32x4*)((bf16_t*)(ws + WS_WSB) + e) = w;
        } else {
            const int v = u - N_MOD - N_TR - N_WS; const int tab = v >> 10;
            const float* src = p.in[21 + tab]; unsigned char* dst = ws + (tab ? WS_VT : WS_UT); float* sc = (float*)(ws + (tab ? WS_SV : WS_SU));
#pragma unroll 2
            for (int i = 0; i < 8; ++i) { const size_t row = (size_t)(v & 1023) * 64 + c.wave * 8 + i;
                const float* rp = src + row * 1024 + 16 * c.lane; f32x4 x[4]; float am = 0.f;
#pragma unroll
                for (int q = 0; q < 4; ++q) { x[q] = __builtin_nontemporal_load((const f32x4*)(rp + 4 * q)); am = fmaxf(am, fmaxf(fmaxf(fabsf(x[q][0]), fabsf(x[q][1])), fmaxf(fabsf(x[q][2]), fabsf(x[q][3])))); }
                am = fmaxf(wave_max(am), 1e-30f);
                const size_t Lr = row >> 14, er = row & 16383;
                if (tab == 0) {
                    float ss = 0.f;
#pragma unroll
                    for (int q = 0; q < 4; ++q) ss += (x[q][0] * x[q][0] + x[q][1] * x[q][1]) + (x[q][2] * x[q][2] + x[q][3] * x[q][3]);
                    const float rms = sqrtf(wave_sum(ss) * (1.0f / 1024.0f)); const float stp = fmaxf(rms * (2.4f / 7.0f), 1e-30f), inv = 1.0f / stp; u32x2 w;
#pragma unroll
                    for (int hq = 0; hq < 2; ++hq) { unsigned t = 0;
#pragma unroll
                        for (int e = 0; e < 8; ++e) { const float v = x[2 * hq + (e >> 2)][e & 3] * inv; const int qi = (int)fminf(fmaxf(rintf(v), -8.0f), 7.0f); t |= ((unsigned)qi & 15u) << (4 * e); }
                        w[hq] = t; }
                    *(u32x2*)(dst + ((Lr * 4 + (c.lane >> 4)) * NEXP + er) * 128 + 8 * (c.lane & 15)) = w;
                    if (c.lane == 0) sc[row] = stp;
                } else {
                    const float inv = 6.0f / am; u32x2 w;
#pragma unroll
                    for (int hq = 0; hq < 2; ++hq) { unsigned t = 0;
                        t = __builtin_amdgcn_cvt_scalef32_pk_fp4_f32(t, x[2 * hq][0] * inv, x[2 * hq][1] * inv, 1.0f, 0); t = __builtin_amdgcn_cvt_scalef32_pk_fp4_f32(t, x[2 * hq][2] * inv, x[2 * hq][3] * inv, 1.0f, 1);
                        t = __builtin_amdgcn_cvt_scalef32_pk_fp4_f32(t, x[2 * hq + 1][0] * inv, x[2 * hq + 1][1] * inv, 1.0f, 2); t = __builtin_amdgcn_cvt_scalef32_pk_fp4_f32(t, x[2 * hq + 1][2] * inv, x[2 * hq + 1][3] * inv, 1.0f, 3);
                        w[hq] = t; }
                    *(u32x2*)(dst + ((Lr * 4 + (c.lane >> 4)) * NEXP + er) * 128 + 8 * (c.lane & 15)) = w;
                    if (c.lane == 0) sc[row] = am * (1.0f / 6.0f);
                } }
        }
    }
}

DI void phase_mod0(const Ctx& c) {
    const Params& p = *c.p; const float* MOD = (const float*)(c.ws + WS_MOD); bf16_t* H1 = (bf16_t*)(c.ws + WS_H1);
    for (int row = c.bid * NWAVE + c.wave; row < T; row += c.G * NWAVE) {
        const float* src = row < TL ? p.in[0] + (size_t)row * D : p.in[2] + (size_t)(row - TL) * D;
        const float* m = MOD + (size_t)mod_batch(row) * 6144;
#pragma unroll
        for (int j = 0; j < 4; ++j) { const int col = 4 * c.lane + 256 * j;
            const f32x4 x = *(const f32x4*)(src + col), sh = *(const f32x4*)(m + col), s = *(const f32x4*)(m + 1024 + col);
            const f32x4 h = x * (s + 1.0f) + sh; u32x2 w; w.x = pk_bf16(h[0], h[1]); w.y = pk_bf16(h[2], h[3]);
            *(u32x2*)(H1 + (size_t)row * D + col) = w; }
    }
}

DI void phase_vstats(const Ctx& c) {
    const bf16_t* UV = (const bf16_t*)(c.ws + WS_R1); float* ST = (float*)(c.ws + WS_STATS);
    for (int row = c.bid * NWAVE + c.wave; row < T; row += c.G * NWAVE) {
        const bf16_t* vp = UV + (size_t)row * 2048 + 1024;
        const u32x4 a = *(const u32x4*)(vp + 8 * c.lane), b = *(const u32x4*)(vp + 512 + 8 * c.lane);
        float x[16];
#pragma unroll
        for (int j = 0; j < 4; ++j) { x[2 * j] = bf_lo(a[j]); x[2 * j + 1] = bf_hi(a[j]); x[8 + 2 * j] = bf_lo(b[j]); x[9 + 2 * j] = bf_hi(b[j]); }
        float s = 0.f;
#pragma unroll
        for (int j = 0; j < 16; ++j) s += x[j];
        const float mean = wave_sum(s) * (1.0f / 1024.0f);
        float q = 0.f;
#pragma unroll
        for (int j = 0; j < 16; ++j) { const float d = x[j] - mean; q += d * d; }
        const float var = wave_sum(q) * (1.0f / 1024.0f);
        if (c.lane == 0) { ST[2 * row] = mean; ST[2 * row + 1] = rsqrtf(var + LN_EPS); }
    }
}

DI void phase_spatial(const Ctx& c, int j) {
    const Params& p = *c.p; unsigned char* ws = c.ws;
    const bf16_t* UV = (const bf16_t*)(ws + WS_R1); const float* ST = (const float*)(ws + WS_STATS); bf16_t* Y = (bf16_t*)(ws + WS_R2);
    const bf16_t* WSB = (const bf16_t*)(ws + WS_WSB) + (size_t)j * 8 * 128 * 128;
    const float* ng = p.in[9] + j * 1024; const float* nb = p.in[10] + j * 1024; const float* bs = p.in[12] + j * 8 * 128;
    constexpr int LD = 136;
    bf16_t* WsL = (bf16_t*)c.smem;
    bf16_t* VnT = WsL + 128 * LD;
    const int tid = c.tid, lane = c.lane, w = c.wave, g = lane >> 4, cc = lane & 15;
    for (int u = c.bid; u < (T / 128) * 8; u += c.G) {
        const int chunk = u >> 3, h = u & 7, r0 = chunk * 128;
        __syncthreads();
        { const int cg8 = tid & 15; float gg[8], bb[8];
#pragma unroll
          for (int e = 0; e < 8; ++e) { gg[e] = ng[h * 128 + cg8 * 8 + e]; bb[e] = nb[h * 128 + cg8 * 8 + e]; }
#pragma unroll
          for (int i = 0; i < 4; ++i) { const int idx = i * 512 + tid, tok = idx >> 4;
              const u32x4 v = *(const u32x4*)(UV + (size_t)(r0 + tok) * 2048 + 1024 + h * 128 + cg8 * 8);
              const float mean = ST[2 * (r0 + tok)], rstd = ST[2 * (r0 + tok) + 1];
              float x[8];
#pragma unroll
              for (int e = 0; e < 4; ++e) { x[2 * e] = bf_lo(v[e]); x[2 * e + 1] = bf_hi(v[e]); }
#pragma unroll
              for (int e = 0; e < 8; ++e) VnT[(cg8 * 8 + e) * LD + tok] = f2bf((x[e] - mean) * rstd * gg[e] + bb[e]);
              const int pp = idx >> 4;
              *(u32x4*)(WsL + pp * LD + cg8 * 8) = *(const u32x4*)(WSB + ((size_t)h * 128 + pp) * 128 + cg8 * 8); } }
        __syncthreads();
        f32x4 acc[8];
#pragma unroll
        for (int ct = 0; ct < 8; ++ct) acc[ct] = (f32x4){0.f, 0.f, 0.f, 0.f};
#pragma unroll
        for (int ks = 0; ks < 4; ++ks) {
            const bf16x8 bfr = frag_ld(WsL, LD, 16 * w, 32 * ks, lane);
#pragma unroll
            for (int ct = 0; ct < 8; ++ct) acc[ct] = mfma16(frag_ld(VnT, LD, 16 * ct, 32 * ks, lane), bfr, acc[ct]);
        }
        const int pp = 16 * w + cc; const float bsv = bs[h * 128 + pp];
        const size_t rowo = (size_t)(r0 + pp);
#pragma unroll
        for (int ct = 0; ct < 8; ++ct) { const int ch = h * 128 + 16 * ct + 4 * g;
            const u32x2 uu = *(const u32x2*)(UV + rowo * 2048 + ch);
            const float y0 = bf_lo(uu.x) * (acc[ct][0] + bsv), y1 = bf_hi(uu.x) * (acc[ct][1] + bsv), y2 = bf_lo(uu.y) * (acc[ct][2] + bsv), y3 = bf_hi(uu.y) * (acc[ct][3] + bsv);
            u32x2 o; o.x = pk_bf16(y0, y1); o.y = pk_bf16(y2, y3);
            *(u32x2*)(Y + rowo * D + ch) = o; }
    }
}

DI void phase_ln1(const Ctx& c, int L) {
    const Params& p = *c.p; bf16_t* XS = (bf16_t*)(c.ws + WS_XS); const float* MOD = (const float*)(c.ws + WS_MOD) + (size_t)L * 17 * 6144;
    bf16_t* H2 = (bf16_t*)(c.ws + WS_R2 + SZ_T1K);
    const float* lg = p.in[6] + (size_t)(L * 2 + 0) * D; const float* lb = p.in[7] + (size_t)(L * 2 + 0) * D;
    const int nrows = (L == DEPTH - 1) ? TL : T, stride = c.G * NWAVE;
    for (int row0 = c.bid * NWAVE + c.wave; row0 < nrows; row0 += 2 * stride) {
        const bool has2 = row0 + stride < nrows; const int rows[2] = {row0, has2 ? row0 + stride : row0};
        u32x2 v[2][4];
#pragma unroll
        for (int rr = 0; rr < 2; ++rr)
#pragma unroll
            for (int j = 0; j < 4; ++j) v[rr][j] = *(const u32x2*)(XS + (size_t)rows[rr] * D + 4 * c.lane + 256 * j);
#pragma unroll
        for (int rr = 0; rr < 2; ++rr) {
            if (rr == 1 && !has2) break;
            const int row = rows[rr]; bf16_t* xp = XS + (size_t)row * D; const float* m = MOD + (size_t)mod_batch(row) * 6144;
            f32x4 x[4]; float s = 0.f;
#pragma unroll
            for (int j = 0; j < 4; ++j) { x[j] = (f32x4){bf_lo(v[rr][j].x), bf_hi(v[rr][j].x), bf_lo(v[rr][j].y), bf_hi(v[rr][j].y)}; s += (x[j][0] + x[j][1]) + (x[j][2] + x[j][3]); }
            const float mean = wave_sum(s) * (1.0f / 1024.0f);
            float q = 0.f;
#pragma unroll
            for (int j = 0; j < 4; ++j) { const f32x4 d = x[j] - mean; q += (d[0] * d[0] + d[1] * d[1]) + (d[2] * d[2] + d[3] * d[3]); }
            const float rstd = rsqrtf(wave_sum(q) * (1.0f / 1024.0f) + LN_EPS);
            f32x4 hv[4];
#pragma unroll
            for (int j = 0; j < 4; ++j) { const int col = 4 * c.lane + 256 * j;
                const f32x4 y = (x[j] - mean) * rstd * *(const f32x4*)(lg + col) + *(const f32x4*)(lb + col);
                u32x2 xw; xw.x = pk_bf16(y[0], y[1]); xw.y = pk_bf16(y[2], y[3]);
                *(u32x2*)(xp + col) = xw;
                const f32x4 h = y * (*(const f32x4*)(m + 4 * 1024 + col) + 1.0f) + *(const f32x4*)(m + 3 * 1024 + col);
                u32x2 w; w.x = pk_bf16(h[0], h[1]); w.y = pk_bf16(h[2], h[3]);
                *(u32x2*)(H2 + (size_t)row * D + col) = w; hv[j] = h; }
            float am = 0.f;
#pragma unroll
            for (int j = 0; j < 4; ++j) am = fmaxf(am, fmaxf(fmaxf(fabsf(hv[j][0]), fabsf(hv[j][1])), fmaxf(fabsf(hv[j][2]), fabsf(hv[j][3]))));
            am = fmaxf(wave_max(am), 1e-30f); const float sx = am * (1.0f / 119.0f), isx = 119.0f / am;
#pragma unroll
            for (int j = 0; j < 4; ++j) { unsigned th = 0, tl = 0;
#pragma unroll
                for (int e = 0; e < 4; ++e) { const int x8 = (int)rintf(hv[j][e] * isx); const int xl = ((x8 + 8) & 15) - 8, xh = (x8 - xl) >> 4; th |= ((unsigned)xh & 15u) << (4 * e); tl |= ((unsigned)xl & 15u) << (4 * e); }
                const size_t bo = (size_t)row * 512 + (256 * j + 4 * c.lane) / 2;
                *(unsigned short*)(c.ws + WS_XH + bo) = (unsigned short)th; *(unsigned short*)(c.ws + WS_XL + bo) = (unsigned short)tl; }
            if (c.lane == 0) ((float*)(c.ws + WS_SX))[row] = sx;
        }
    }
}

DI int f2key(float v) { const int i = __float_as_int(v); return i ^ ((i >> 31) & 0x7fffffff); }
DI float key2f(int k) { return __int_as_float(k ^ ((k >> 31) & 0x7fffffff)); }
DI void phase_route(const Ctx& c, int L) {
    const Params& p = *c.p; unsigned char* ws = c.ws; const int lane = c.lane, g = lane >> 4, cc = lane & 15;
    constexpr int LDK = 72, LDS_S = 20;
    bf16_t* keysHi = (bf16_t*)c.smem;
    bf16_t* keysLo = keysHi + 2 * 128 * LDK;
    float* sbase = (float*)(keysLo + 2 * 128 * LDK);
    unsigned* ilist = (unsigned*)(sbase + NWAVE * 64 * LDS_S);
    __syncthreads();
    { const float* gk = p.in[20] + (size_t)L * 2 * 128 * 64;
      f32x4 kv[8];
#pragma unroll
      for (int it = 0; it < 8; ++it) kv[it] = ((const f32x4*)gk)[it * NTHR + c.tid];
#pragma unroll
      for (int it = 0; it < 8; ++it) { const int i = (it * NTHR + c.tid) * 4, row = i >> 6, d = i & 63; unsigned hi[2], lo[2];
#pragma unroll
          for (int e = 0; e < 2; ++e) { const unsigned ph = pk_bf16(kv[it][2 * e], kv[it][2 * e + 1]); hi[e] = ph; lo[e] = pk_bf16(kv[it][2 * e] - bf_lo(ph), kv[it][2 * e + 1] - bf_hi(ph)); }
          *(u32x2*)(keysHi + row * LDK + d) = (u32x2){hi[0], hi[1]}; *(u32x2*)(keysLo + row * LDK + d) = (u32x2){lo[0], lo[1]}; } }
    __syncthreads();
    float* S = sbase + c.wave * 64 * LDS_S;
    const bf16_t* QP = (const bf16_t*)(ws + WS_R1); int* IDX = (int*)(ws + WS_R1 + SZ_T1K); float* WT = (float*)(ws + WS_R1 + SZ_T1K + (size_t)T * 128 * 4);
    unsigned* myl = ilist + c.tid * 8; const unsigned char* mylb = (const unsigned char*)myl;
    const int ntask = (((L == DEPTH - 1) ? TL : T) / 64) * 8;
    for (int task = c.bid * NWAVE + c.wave; task < ntask; task += c.G * NWAVE) {
        const int t0 = (task >> 3) * 64, h = task & 7, tok = t0 + lane;
        float t12[2][16];
#pragma unroll
        for (int half = 0; half < 2; ++half) {
            bf16x8 aq[4][2];
#pragma unroll
            for (int mt = 0; mt < 4; ++mt)
#pragma unroll
                for (int ks = 0; ks < 2; ++ks) aq[mt][ks] = *(const bf16x8*)(QP + (size_t)(t0 + 16 * mt + cc) * D + h * 128 + half * 64 + 32 * ks + 8 * g);
            const bf16_t* kh = keysHi + half * 128 * LDK; const bf16_t* kl = keysLo + half * 128 * LDK;
#pragma unroll
            for (int i = 0; i < 16; ++i) t12[half][i] = -3.0e38f;
            for (int nt = 0; nt < 8; ++nt) {
                const bf16x8 bh0 = frag_ld(kh, LDK, 16 * nt, 0, lane), bh1 = frag_ld(kh, LDK, 16 * nt, 32, lane), bl0 = frag_ld(kl, LDK, 16 * nt, 0, lane), bl1 = frag_ld(kl, LDK, 16 * nt, 32, lane);
#pragma unroll
                for (int mt = 0; mt < 4; ++mt) { f32x4 a = {0.f, 0.f, 0.f, 0.f};
                    a = mfma16(aq[mt][0], bl0, a); a = mfma16(aq[mt][1], bl1, a); a = mfma16(aq[mt][0], bh0, a); a = mfma16(aq[mt][1], bh1, a);
#pragma unroll
                    for (int r = 0; r < 4; ++r) S[(16 * mt + 4 * g + r) * LDS_S + cc] = a[r]; }
                f32x4 sc[4];
#pragma unroll
                for (int q4 = 0; q4 < 4; ++q4) sc[q4] = *(const f32x4*)(S + lane * LDS_S + 4 * q4);
#pragma unroll
                for (int kk = 0; kk < 16; ++kk) { const float key = __int_as_float((__float_as_int(sc[kk >> 2][kk & 3]) & ~127) | (127 - (16 * nt + kk)));
#pragma unroll
                    for (int i = 15; i >= 1; --i) t12[half][i] = __builtin_amdgcn_fmed3f(key, t12[half][i - 1], t12[half][i]);
                    t12[half][0] = __builtin_amdgcn_fmed3f(key, 3.0e38f, t12[half][0]); }
            }
        }
        float v1[16], v2[16];
#pragma unroll
        for (int i = 0; i < 16; ++i) { v1[i] = __int_as_float(__float_as_int(t12[0][i]) & ~127); v2[i] = __int_as_float(__float_as_int(t12[1][i]) & ~127); }
#pragma unroll
        for (int i = 0; i < 4; ++i) {
            myl[i] = (unsigned)(127 - (__float_as_int(t12[0][4 * i]) & 127)) | ((unsigned)(127 - (__float_as_int(t12[0][4 * i + 1]) & 127)) << 8) | ((unsigned)(127 - (__float_as_int(t12[0][4 * i + 2]) & 127)) << 16) | ((unsigned)(127 - (__float_as_int(t12[0][4 * i + 3]) & 127)) << 24);
            myl[4 + i] = (unsigned)(127 - (__float_as_int(t12[1][4 * i]) & 127)) | ((unsigned)(127 - (__float_as_int(t12[1][4 * i + 1]) & 127)) << 8) | ((unsigned)(127 - (__float_as_int(t12[1][4 * i + 2]) & 127)) << 16) | ((unsigned)(127 - (__float_as_int(t12[1][4 * i + 3]) & 127)) << 24); }
        float f[16];
#pragma unroll
        for (int i = 0; i < 16; ++i) f[i] = -3.0e38f;
#pragma unroll
        for (int a = 0; a < 16; ++a)
#pragma unroll
            for (int b = 0; b < 16; ++b)
                if ((a + 1) * (b + 1) <= 16) {
                    const float key = __int_as_float((__float_as_int(v1[a] + v2[b]) & ~255) | (255 - (a * 16 + b)));
#pragma unroll
                    for (int i = 15; i >= 1; --i) f[i] = __builtin_amdgcn_fmed3f(key, f[i - 1], f[i]);
                    f[0] = __builtin_amdgcn_fmed3f(key, 3.0e38f, f[0]);
                }
        float e[16], se = 0.f; int fi[16];
        const float vmax = __int_as_float(__float_as_int(f[0]) & ~255);
#pragma unroll
        for (int i = 0; i < 16; ++i) { const int code = 255 - (__float_as_int(f[i]) & 255); fi[i] = (int)mylb[code >> 4] * 128 + (int)mylb[16 + (code & 15)];
            e[i] = __expf(__int_as_float(__float_as_int(f[i]) & ~255) - vmax); se += e[i]; }
        const float inv = 1.0f / se;
        int* ip = IDX + (size_t)tok * 128 + h * 16; float* wp = WT + (size_t)tok * 128 + h * 16;
#pragma unroll
        for (int i = 0; i < 16; i += 4) { *(int4*)(ip + i) = make_int4(fi[i], fi[i + 1], fi[i + 2], fi[i + 3]); *(f32x4*)(wp + i) = (f32x4){e[i] * inv, e[i + 1] * inv, e[i + 2] * inv, e[i + 3] * inv}; }
    }
}

DI float red8(float p) { p += dpp_mov<0xB1>(p); p += dpp_mov<0x4E>(p); p += dpp_mov<0x141>(p); return p; }
DI void phase_experts(const Ctx& c, int L) {
    const Params& p = *c.p; unsigned char* ws = c.ws; const int lane = c.lane, g8 = lane >> 3, j = lane & 7;
    constexpr int MAXTOK = 18;
    const bf16_t* H2 = (const bf16_t*)(ws + WS_R2 + SZ_T1K);
    const int* IDX = (const int*)(ws + WS_R1 + SZ_T1K); const float* WT = (const float*)(ws + WS_R1 + SZ_T1K + (size_t)T * 128 * 4);
    bf16_t* FFN = (bf16_t*)(ws + WS_R1);
    const unsigned char* UT = ws + WS_UT + (size_t)L * NEXP * 512; const unsigned char* VT = ws + WS_VT + (size_t)L * NEXP * 512;
    const float* SU = (const float*)(ws + WS_SU) + (size_t)L * NEXP; const float* SV = (const float*)(ws + WS_SV) + (size_t)L * NEXP;
    bf16_t* XS = (bf16_t*)(ws + WS_XS); bf16_t* H1 = (bf16_t*)(ws + WS_H1);
    const float* MOD = (const float*)(ws + WS_MOD) + (size_t)L * 17 * 6144;
    const float* lg = p.in[6] + (size_t)(L * 2 + 1) * D; const float* lb = p.in[7] + (size_t)(L * 2 + 1) * D;
    const int nrows = (L == DEPTH - 1) ? TL : T;
    float* ZL = (float*)c.smem + c.wave * MAXTOK * 128;
    unsigned short* IL = (unsigned short*)(c.smem + NWAVE * MAXTOK * 128 * 4) + c.wave * MAXTOK * 128;
    const int GW = c.G * NWAVE, gw = c.bid * NWAVE + c.wave;
    const int tsrc = 8 * (lane & 7) + (lane >> 3);
    for (int base = 0; base < nrows; base += GW * MAXTOK) {
        int ntok = (nrows - base - gw + GW - 1) / GW; ntok = ntok < 0 ? 0 : (ntok > MAXTOK ? MAXTOK : ntok);
        const int klast = ntok > 0 ? ntok - 1 : 0;
        if (ntok > 0) {
            for (int k0 = 0; k0 < MAXTOK; k0 += 6) { int iv[6][2];
#pragma unroll
                for (int kk = 0; kk < 6; ++kk) { const int kc = (k0 + kk < ntok) ? k0 + kk : klast; const size_t tb = (size_t)(base + gw + GW * kc) * 128; iv[kk][0] = IDX[tb + lane]; iv[kk][1] = IDX[tb + 64 + lane]; }
#pragma unroll
                for (int kk = 0; kk < 6; ++kk) { IL[(k0 + kk) * 128 + lane] = (unsigned short)iv[kk][0]; IL[(k0 + kk) * 128 + 64 + lane] = (unsigned short)iv[kk][1]; } }
        }
        for (int c4 = 0; c4 < 4; ++c4) {
            const unsigned char* Ub = UT + (size_t)c4 * NEXP * 128 + 16 * j;
            const unsigned char* XHb = ws + WS_XH + 128 * c4 + 16 * j; const unsigned char* XLb = ws + WS_XL + 128 * c4 + 16 * j;
            u32x4 rA[8], rB[8], xh, xl, nxh, nxl;
#define U_LOADX(k_) do { const size_t to_ = (size_t)(base + gw + GW * (k_)) * 512; nxh = *(const u32x4*)(XHb + to_); nxl = *(const u32x4*)(XLb + to_); } while (0)
#define U_ISSUE(R, k_, hf_) do { _Pragma("unroll") for (int i = 0; i < 8; ++i) { const unsigned e = IL[(k_) * 128 + 64 * (hf_) + 8 * i + g8]; R[i] = *(const u32x4*)(Ub + (size_t)e * 128); } } while (0)
#define U_COMPUTE(R, k_, hf_) do { int ra = 0; \
                _Pragma("unroll") for (int i = 0; i < 8; ++i) { int ah = 0, al = 0; \
                    _Pragma("unroll") for (int q = 0; q < 4; ++q) { ah = __builtin_amdgcn_sdot8((int)R[i][q], (int)xh[q], ah, false); al = __builtin_amdgcn_sdot8((int)R[i][q], (int)xl[q], al, false); } \
                    int zi = ah * 16 + al; \
                    zi += __builtin_amdgcn_mov_dpp(zi, 0xB1, 0xf, 0xf, true); zi += __builtin_amdgcn_mov_dpp(zi, 0x4E, 0xf, 0xf, true); zi += __builtin_amdgcn_mov_dpp(zi, 0x141, 0xf, 0xf, true); \
                    ra = (j == i) ? zi : ra; } \
                const float za = (float)__shfl(ra, tsrc, 64); \
                if (c4 == 0) ZL[(k_) * 128 + 64 * (hf_) + lane] = za; else ZL[(k_) * 128 + 64 * (hf_) + lane] += za; } while (0)
            if (ntok > 0) { U_LOADX(0); U_ISSUE(rA, 0, 0); }
            for (int k = 0; k < ntok; ++k) {
                const int kn = (k + 1 < ntok) ? k + 1 : k;
                U_ISSUE(rB, k, 1);
                xh = nxh; xl = nxl;
                U_COMPUTE(rA, k, 0);
                U_LOADX(kn); U_ISSUE(rA, kn, 0);
                U_COMPUTE(rB, k, 1);
            }
#undef U_LOADX
#undef U_ISSUE
#undef U_COMPUTE
        }
        if (ntok > 0) {
            for (int k0 = 0; k0 < MAXTOK; k0 += 6) { float wv[6][2], su[6][2], sv[6][2], sxv[6];
#pragma unroll
                for (int kk = 0; kk < 6; ++kk) { const int kc = (k0 + kk < ntok) ? k0 + kk : klast; const size_t tb = (size_t)(base + gw + GW * kc) * 128; sxv[kk] = ((const float*)(ws + WS_SX))[base + gw + GW * kc];
#pragma unroll
                    for (int hh = 0; hh < 2; ++hh) { const unsigned e = IL[kc * 128 + 64 * hh + lane]; wv[kk][hh] = WT[tb + 64 * hh + lane]; su[kk][hh] = SU[e]; sv[kk][hh] = SV[e]; } }
#pragma unroll
                for (int kk = 0; kk < 6; ++kk) { const int kc = (k0 + kk < ntok) ? k0 + kk : klast;
                    if (k0 + kk < ntok) {
#pragma unroll
                        for (int hh = 0; hh < 2; ++hh) ZL[kc * 128 + 64 * hh + lane] = gelu_tanh(ZL[kc * 128 + 64 * hh + lane] * (su[kk][hh] * sxv[kk])) * wv[kk][hh] * sv[kk][hh]; } } }
        }
        for (int c4 = 0; c4 < 4; ++c4) {
            const unsigned char* Vb = VT + (size_t)c4 * NEXP * 128 + 16 * j;
            const bool hi8 = (lane & 8) != 0;
            u32x4 rA[8], rB[8];
            f32x2 o[16];
#define V_ISSUE(R, k_, hf_) do { _Pragma("unroll") for (int i = 0; i < 8; ++i) { const unsigned e = IL[(k_) * 128 + 64 * (hf_) + 8 * i + g8]; R[i] = *(const u32x4*)(Vb + (size_t)e * 128); } } while (0)
#define V_ACC(R, k_, hf_) do { float av[8]; \
                _Pragma("unroll") for (int i = 0; i < 8; ++i) av[i] = ZL[(k_) * 128 + 64 * (hf_) + 8 * i + g8]; \
                _Pragma("unroll") for (int i = 0; i < 8; ++i) { const f32x2 a2 = {av[i], av[i]}; \
                    _Pragma("unroll") for (int q = 0; q < 4; ++q) { \
                        o[4 * q] += a2 * __builtin_amdgcn_cvt_scalef32_pk_f32_fp4(R[i][q], 1.0f, 0); o[4 * q + 1] += a2 * __builtin_amdgcn_cvt_scalef32_pk_f32_fp4(R[i][q], 1.0f, 1); \
                        o[4 * q + 2] += a2 * __builtin_amdgcn_cvt_scalef32_pk_f32_fp4(R[i][q], 1.0f, 2); o[4 * q + 3] += a2 * __builtin_amdgcn_cvt_scalef32_pk_f32_fp4(R[i][q], 1.0f, 3); } } } while (0)
#define V_FINISH(k_) do { const int tok_ = base + gw + GW * (k_); \
                f32x2 q8[8]; \
                _Pragma("unroll") for (int m = 0; m < 8; ++m) { \
                    const auto s0 = __builtin_amdgcn_permlane32_swap(__float_as_uint(o[m][0]), __float_as_uint(o[m + 8][0]), false, false); \
                    const auto s1 = __builtin_amdgcn_permlane32_swap(__float_as_uint(o[m][1]), __float_as_uint(o[m + 8][1]), false, false); \
                    q8[m] = (f32x2){__uint_as_float(s0[0]) + __uint_as_float(s0[1]), __uint_as_float(s1[0]) + __uint_as_float(s1[1])}; } \
                f32x2 q4[4]; \
                _Pragma("unroll") for (int m = 0; m < 4; ++m) { \
                    const auto s0 = __builtin_amdgcn_permlane16_swap(__float_as_uint(q8[m][0]), __float_as_uint(q8[m + 4][0]), false, false); \
                    const auto s1 = __builtin_amdgcn_permlane16_swap(__float_as_uint(q8[m][1]), __float_as_uint(q8[m + 4][1]), false, false); \
                    q4[m] = (f32x2){__uint_as_float(s0[0]) + __uint_as_float(s0[1]), __uint_as_float(s1[0]) + __uint_as_float(s1[1])}; } \
                float fo[4]; \
                _Pragma("unroll") for (int m = 0; m < 2; ++m) { \
                    const float k0 = hi8 ? q4[m + 2][0] : q4[m][0], k1 = hi8 ? q4[m + 2][1] : q4[m][1], t0 = hi8 ? q4[m][0] : q4[m + 2][0], t1 = hi8 ? q4[m][1] : q4[m + 2][1]; \
                    fo[2 * m] = k0 + dpp_mov<0x128>(t0); fo[2 * m + 1] = k1 + dpp_mov<0x128>(t1); } \
                u32x2 w_; w_.x = pk_bf16(fo[0], fo[1]); w_.y = pk_bf16(fo[2], fo[3]); \
                *(u32x2*)(FFN + (size_t)tok_ * D + 256 * c4 + 32 * j + 4 * g8) = w_; } while (0)
            if (ntok > 0) V_ISSUE(rA, 0, 0);
            for (int k = 0; k < ntok; ++k) {
                V_ISSUE(rB, k, 1);
#pragma unroll
                for (int q = 0; q < 16; ++q) o[q] = (f32x2){0.f, 0.f};
                V_ACC(rA, k, 0);
                V_ISSUE(rA, ((k + 1 < ntok) ? k + 1 : k), 0);
                V_ACC(rB, k, 1);
                V_FINISH(k);
            }
#undef V_ISSUE
#undef V_ACC
#undef V_FINISH
        }
        asm volatile("s_waitcnt vmcnt(0)" ::: "memory");
        u32x4 nfa, nfb, nxa, nxb;
        { const int row0 = base + gw + GW * 0 < nrows ? base + gw : 0; nfa = *(const u32x4*)(FFN + (size_t)row0 * D + 16 * lane); nfb = *(const u32x4*)(FFN + (size_t)row0 * D + 16 * lane + 8);
          nxa = *(const u32x4*)(XS + (size_t)row0 * D + 16 * lane); nxb = *(const u32x4*)(XS + (size_t)row0 * D + 16 * lane + 8); }
        for (int k = 0; k < ntok; ++k) { const int row = base + gw + GW * k;
            bf16_t* xp = XS + (size_t)row * D + 16 * lane; const int mb = mod_batch(row); const float* m = MOD + (size_t)mb * 6144 + 16 * lane;
            const u32x4 fa = nfa, fb = nfb, xa = nxa, xb = nxb;
            { const int rn = base + gw + GW * ((k + 1 < ntok) ? k + 1 : k);
              nfa = *(const u32x4*)(FFN + (size_t)rn * D + 16 * lane); nfb = *(const u32x4*)(FFN + (size_t)rn * D + 16 * lane + 8);
              nxa = *(const u32x4*)(XS + (size_t)rn * D + 16 * lane); nxb = *(const u32x4*)(XS + (size_t)rn * D + 16 * lane + 8); }
            float o[16], x1[16];
#pragma unroll
            for (int q = 0; q < 4; ++q) { o[2 * q] = bf_lo(fa[q]); o[2 * q + 1] = bf_hi(fa[q]); o[8 + 2 * q] = bf_lo(fb[q]); o[9 + 2 * q] = bf_hi(fb[q]);
                x1[2 * q] = bf_lo(xa[q]); x1[2 * q + 1] = bf_hi(xa[q]); x1[8 + 2 * q] = bf_lo(xb[q]); x1[9 + 2 * q] = bf_hi(xb[q]); }
            float y[16]; float s = 0.f;
#pragma unroll
            for (int qd = 0; qd < 4; ++qd) { const f32x4 g2 = *(const f32x4*)(m + 5 * 1024 + 4 * qd);
#pragma unroll
                for (int e = 0; e < 4; ++e) { y[4 * qd + e] = DN_ALPHA * x1[4 * qd + e] + g2[e] * o[4 * qd + e]; s += y[4 * qd + e]; } }
            const float mean = wave_sum(s) * (1.0f / 1024.0f);
            float q = 0.f;
#pragma unroll
            for (int e = 0; e < 16; ++e) { const float d = y[e] - mean; q += d * d; }
            const float rstd = rsqrtf(wave_sum(q) * (1.0f / 1024.0f) + LN_EPS);
            const float* mn = (const float*)(ws + WS_MOD) + (size_t)(L + 1 < DEPTH ? L + 1 : L) * 17 * 6144 + (size_t)mb * 6144 + 16 * lane;
            float x2[16];
#pragma unroll
            for (int qd = 0; qd < 4; ++qd) { const int col = 16 * lane + 4 * qd;
                const f32x4 gg = *(const f32x4*)(lg + col), bb = *(const f32x4*)(lb + col);
#pragma unroll
                for (int e = 0; e < 4; ++e) x2[4 * qd + e] = (y[4 * qd + e] - mean) * rstd * gg[e] + bb[e]; }
            if (L == DEPTH - 1) {
#pragma unroll
                for (int qd = 0; qd < 4; ++qd) *(f32x4*)(p.out + (size_t)row * D + 16 * lane + 4 * qd) = (f32x4){x2[4 * qd], x2[4 * qd + 1], x2[4 * qd + 2], x2[4 * qd + 3]};
            } else {
                float hh[16];
#pragma unroll
                for (int qd = 0; qd < 4; ++qd) { const f32x4 s1 = *(const f32x4*)(mn + 1024 + 4 * qd), sh = *(const f32x4*)(mn + 4 * qd);
#pragma unroll
                    for (int e = 0; e < 4; ++e) hh[4 * qd + e] = x2[4 * qd + e] * (s1[e] + 1.0f) + sh[e]; }
#pragma unroll
                for (int hf = 0; hf < 2; ++hf) { u32x4 wx, wh;
#pragma unroll
                    for (int q2 = 0; q2 < 4; ++q2) { wx[q2] = pk_bf16(x2[8 * hf + 2 * q2], x2[8 * hf + 2 * q2 + 1]); wh[q2] = pk_bf16(hh[8 * hf + 2 * q2], hh[8 * hf + 2 * q2 + 1]); }
                    *(u32x4*)(xp + 8 * hf) = wx; *(u32x4*)(H1 + (size_t)row * D + 16 * lane + 8 * hf) = wh; }
            }
        }
    }
}

DI float logsig2_16(float z) { const float zl = z * 1.4426950408889634f; return (fminf(zl, 0.f) - __builtin_amdgcn_logf(1.0f + __builtin_amdgcn_exp2f(-fabsf(zl)))) * (1.0f / 16.0f); }
template <int DIR>
DI float gla_prep_gates(const bf16_t* Qt, const bf16_t* Kt, bf16_t* OUT, const float* gl, const float (&wg)[16], float bias, int cl, unsigned (&kpk)[32]) {
    constexpr int dir = DIR;
    { int z_ = 0; asm volatile("" : "+v"(z_)); gl += z_; }
    float cum = 0.f;
#pragma unroll
        for (int blk = 0; blk < 8; ++blk) {
            float gs[8];
#pragma unroll
            for (int e = 0; e < 8; ++e) { const int i = (dir ? 56 - 8 * blk : 8 * blk) + e; float z = bias; const f32x4* gp = (const f32x4*)(gl + i * 32 + dir * 16);
#pragma unroll
                for (int r4 = 0; r4 < 4; ++r4) { const f32x4 gv = gp[r4]; z += gv[0] * wg[4 * r4] + gv[1] * wg[4 * r4 + 1] + gv[2] * wg[4 * r4 + 2] + gv[3] * wg[4 * r4 + 3]; }
                gs[e] = logsig2_16(z); }
            float kiv[8];
#pragma unroll
            for (int e = 0; e < 8; ++e) { const int pos = dir ? 7 - e : e, i = (dir ? 56 - 8 * blk : 8 * blk) + pos;
                cum += gs[pos];
                const float qv = bf1(Qt[i * 256 + cl]), kv = bf1(Kt[i * 256 + cl]);
                OUT[(dir * 64 + i) * 256 + cl] = f2bf(qv * __builtin_amdgcn_exp2f(cum)); kiv[pos] = kv * __builtin_amdgcn_exp2f(-cum); }
            u32x4 w; w.x = pk_bf16(kiv[0], kiv[1]); w.y = pk_bf16(kiv[2], kiv[3]); w.z = pk_bf16(kiv[4], kiv[5]); w.w = pk_bf16(kiv[6], kiv[7]);
            if (dir) { kpk[4 * (7 - blk)] = w.x; kpk[4 * (7 - blk) + 1] = w.y; kpk[4 * (7 - blk) + 2] = w.z; kpk[4 * (7 - blk) + 3] = w.w; }
            else { kpk[4 * blk] = w.x; kpk[4 * blk + 1] = w.y; kpk[4 * blk + 2] = w.z; kpk[4 * blk + 3] = w.w; }
            __builtin_amdgcn_sched_barrier(0);
        }
    return cum;
}
DI void phase_gla_prep(const Ctx& c, int j) {
    const Params& p = *c.p; unsigned char* ws = c.ws; const int tid = c.tid;
    const bf16_t* QG = (const bf16_t*)(ws + WS_R1); const bf16_t* KG = (const bf16_t*)(ws + WS_R1 + SZ_T512); const bf16_t* VG = (const bf16_t*)(ws + WS_R1 + 2 * SZ_T512);
    const float* GL = (const float*)(ws + WS_GL); float* DEC = (float*)(ws + WS_DEC); bf16_t* VTt = (bf16_t*)(ws + WS_VTT);
    bf16_t* Qt = (bf16_t*)c.smem;
    bf16_t* Kt = Qt + 64 * 256;
    bf16_t* OUT = Kt + 64 * 256;
    float* gl = (float*)(c.smem + 131072);
    const int dir = __builtin_amdgcn_readfirstlane(tid >> 8), cl = tid & 255;
    for (int u = c.bid; u < (T / 64) * 2; u += c.G) {
        const int ch = u >> 1, hc = u & 1, r0 = ch * 64, cg = 256 * hc + cl;
        __syncthreads();
#pragma unroll
        for (int it = 0; it < 4; ++it) { const int idx = it * 512 + tid, row = idx >> 5, c8 = (idx & 31) * 8;
            *(u32x4*)(Qt + row * 256 + c8) = *(const u32x4*)(QG + (size_t)(r0 + row) * 512 + 256 * hc + c8);
            *(u32x4*)(Kt + row * 256 + c8) = *(const u32x4*)(KG + (size_t)(r0 + row) * 512 + 256 * hc + c8); }
        ((f32x4*)gl)[tid] = ((const f32x4*)(GL + (size_t)r0 * 32))[tid];
        float wg[16];
#pragma unroll
        for (int r = 0; r < 16; ++r) wg[r] = p.in[15][((size_t)(j * 2 + dir) * 16 + r) * 512 + cg];
        const float bias = p.in[16][(size_t)(j * 2 + dir) * 512 + cg];
        __syncthreads();
        unsigned kpk[32];
        const float cum = dir ? gla_prep_gates<1>(Qt, Kt, OUT, gl, wg, bias, cl, kpk) : gla_prep_gates<0>(Qt, Kt, OUT, gl, wg, bias, cl, kpk);
        DEC[((size_t)dir * (T / 64) + ch) * 512 + cg] = __builtin_amdgcn_exp2f(cum);
        __syncthreads();
#pragma unroll 2
        for (int it = 0; it < 8; ++it) { const int idx = it * 512 + tid, d2 = idx >> 11, row = (idx >> 5) & 63, c8 = (idx & 31) * 8;
            *(u32x4*)((bf16_t*)(ws + WS_R2) + (size_t)d2 * T * 512 + (size_t)(r0 + row) * 512 + 256 * hc + c8) = *(const u32x4*)(OUT + (d2 * 64 + row) * 256 + c8); }
        bf16_t* KT = Qt;
#pragma unroll
        for (int cb = 0; cb < 8; ++cb) *(u32x4*)(KT + (dir * 256 + cl) * 64 + ((cb ^ (cl & 7)) * 8)) = (u32x4){kpk[4 * cb], kpk[4 * cb + 1], kpk[4 * cb + 2], kpk[4 * cb + 3]};
        __syncthreads();
#pragma unroll 2
        for (int it = 0; it < 8; ++it) { const int idx = it * 512 + tid, d2 = idx >> 11, clr = (idx >> 3) & 255, cb = idx & 7;
            *(u32x4*)((bf16_t*)(ws + WS_R2 + 2 * SZ_T1K) + (((size_t)d2 * (T / 64) + ch) * 512 + 256 * hc + clr) * 64 + cb * 8) = *(const u32x4*)(KT + (d2 * 256 + clr) * 64 + ((cb ^ (clr & 7)) * 8)); }
#pragma unroll
        for (int i2 = 0; i2 < 32; ++i2) { OUT[(dir * 64 + 2 * i2) * 256 + cl] = (bf16_t)(kpk[i2] & 0xffffu); OUT[(dir * 64 + 2 * i2 + 1) * 256 + cl] = (bf16_t)(kpk[i2] >> 16); }
        __syncthreads();
#pragma unroll 2
        for (int it = 0; it < 8; ++it) { const int idx = it * 512 + tid, d2 = idx >> 11, row = (idx >> 5) & 63, c8 = (idx & 31) * 8;
            *(u32x4*)((bf16_t*)(ws + WS_R2 + SZ_T1K) + (size_t)d2 * T * 512 + (size_t)(r0 + row) * 512 + 256 * hc + c8) = *(const u32x4*)(OUT + (d2 * 64 + row) * 256 + c8); }
        bf16_t* Vl = Qt;
#pragma unroll 2
        for (int it = 0; it < 8; ++it) { const int idx = it * 512 + tid, row = idx >> 6, c8 = (idx & 63) * 8;
            *(u32x4*)(Vl + row * 512 + c8) = *(const u32x4*)(VG + (size_t)(r0 + row) * 1024 + 512 * hc + c8); }
        __syncthreads();
        bf16_t* VTl = OUT;
#pragma unroll 2
        for (int cb = 0; cb < 8; ++cb) { unsigned short x[8];
#pragma unroll
            for (int t = 0; t < 8; ++t) x[t] = Vl[(8 * cb + t) * 512 + tid];
            u32x4 w; w.x = (unsigned)x[0] | ((unsigned)x[1] << 16); w.y = (unsigned)x[2] | ((unsigned)x[3] << 16); w.z = (unsigned)x[4] | ((unsigned)x[5] << 16); w.w = (unsigned)x[6] | ((unsigned)x[7] << 16);
            *(u32x4*)(VTl + tid * 64 + ((cb ^ (tid & 7)) * 8)) = w; }
        __syncthreads();
#pragma unroll 2
        for (int it = 0; it < 8; ++it) { const int idx = it * 512 + tid, er = idx >> 3, cb = idx & 7;
            *(u32x4*)(VTt + ((size_t)ch * 1024 + 512 * hc + er) * 64 + cb * 8) = *(const u32x4*)(VTl + er * 64 + ((cb ^ (er & 7)) * 8)); }
    }
}

DI void phase_gla_scan(const Ctx& c) {
    unsigned char* ws = c.ws; const int tid = c.tid, lane = c.lane, w = c.wave, g = lane >> 4, cc = lane & 15;
    const bf16_t* VTt = (const bf16_t*)(ws + WS_VTT); const float* DEC = (const float*)(ws + WS_DEC);
    constexpr int LDQ = 136, LDJ = 72;
    bf16_t* Qs = (bf16_t*)c.smem;
    bf16_t* Ks = Qs + 64 * LDQ;
    bf16_t* KEt = Ks + 64 * LDQ;
    bf16_t* Vt = KEt + 128 * LDJ;
    bf16_t* At = Vt + 128 * LDJ;
    bf16_t* St = At + 64 * LDJ;
    bf16_t* Ot = St + 128 * LDQ;
    float* dec = (float*)(Ot + 64 * LDQ);
    const int qtok0 = tid >> 4, qd8 = (tid & 15) * 8;
    const int ked0 = tid >> 3, kej8 = (tid & 7) * 8;
    for (int u = c.bid; u < NB * 4 * 2 * 2; u += c.G) {
        const int b = u >> 4, h = (u >> 2) & 3, es = (u >> 1) & 1, dir = u & 1;
        bf16_t* O = (bf16_t*)(ws + (dir ? WS_OB : WS_H1));
        const bf16_t* QIN = (const bf16_t*)(ws + WS_R2) + (size_t)dir * T * 512; const bf16_t* KIN = (const bf16_t*)(ws + WS_R2 + SZ_T1K) + (size_t)dir * T * 512;
        const bf16_t* KINt = (const bf16_t*)(ws + WS_R2 + 2 * SZ_T1K) + (size_t)dir * (T / 64) * 512 * 64;
        f32x4 accS[8];
#pragma unroll
        for (int et = 0; et < 8; ++et) accS[et] = (f32x4){0.f, 0.f, 0.f, 0.f};
        __syncthreads();
        for (int i = tid; i < 128 * LDQ / 2; i += NTHR) ((unsigned*)St)[i] = 0u;
        u32x4 pq[2], pk[2], pke[2], pv[2]; float pdec = 0.f;
#define GLA_R0(cs_) (dir == 0 ? ((cs_) < 4 ? TL + b * CTXL + 64 * (cs_) : b * SEQ + 64 * ((cs_) - 4)) : ((cs_) < 4 ? TL + b * CTXL + 64 * (3 - (cs_)) : b * SEQ + 64 * (35 - (cs_))))
#define GLA_LOAD(cs_) do { const int r0_ = GLA_R0(cs_); const int chunk_ = r0_ >> 6; \
            _Pragma("unroll") for (int it = 0; it < 2; ++it) { const size_t go = (size_t)(r0_ + qtok0 + 32 * it) * 512 + h * 128 + qd8; pq[it] = *(const u32x4*)(QIN + go); pk[it] = *(const u32x4*)(KIN + go); \
                pke[it] = *(const u32x4*)(KINt + ((size_t)chunk_ * 512 + h * 128 + ked0 + 64 * it) * 64 + kej8); \
                pv[it] = *(const u32x4*)(VTt + ((size_t)chunk_ * 1024 + h * 256 + es * 128 + ked0 + 64 * it) * 64 + kej8); } \
            if (tid < 128) pdec = DEC[((size_t)dir * (T / 64) + chunk_) * 512 + h * 128 + tid]; } while (0)
        GLA_LOAD(0);
        for (int cs = 0; cs < 36; ++cs) {
            const int r0 = GLA_R0(cs);
#pragma unroll
            for (int it = 0; it < 2; ++it) { *(u32x4*)(Qs + (qtok0 + 32 * it) * LDQ + qd8) = pq[it]; *(u32x4*)(Ks + (qtok0 + 32 * it) * LDQ + qd8) = pk[it];
                *(u32x4*)(KEt + (ked0 + 64 * it) * LDJ + kej8) = pke[it]; *(u32x4*)(Vt + (ked0 + 64 * it) * LDJ + kej8) = pv[it]; }
            if (tid < 128) dec[tid] = pdec;
            __syncthreads();
            GLA_LOAD(cs + 1 < 36 ? cs + 1 : cs);
            { const int it = w >> 1;
#pragma unroll
              for (int jj = 0; jj < 2; ++jj) { const int jt = 2 * (w & 1) + jj; f32x4 a = {0.f, 0.f, 0.f, 0.f};
#pragma unroll
                  for (int ks = 0; ks < 4; ++ks) a = mfma16(frag_ld(Qs, LDQ, 16 * it, 32 * ks, lane), frag_ld(Ks, LDQ, 16 * jt, 32 * ks, lane), a);
                  const int jcol = 16 * jt + cc;
#pragma unroll
                  for (int r = 0; r < 4; ++r) { const int i = 16 * it + 4 * g + r; const bool keep = dir ? (jcol >= i) : (jcol <= i);
                      At[i * LDJ + jcol] = f2bf(keep ? a[r] : 0.f); } } }
            __syncthreads();
            { const int it = w >> 1;
#pragma unroll
              for (int ee = 0; ee < 4; ++ee) { const int et = 4 * (w & 1) + ee; f32x4 a = {0.f, 0.f, 0.f, 0.f};
#pragma unroll
                  for (int ks = 0; ks < 2; ++ks) a = mfma16(frag_ld(At, LDJ, 16 * it, 32 * ks, lane), frag_ld(Vt, LDJ, 16 * et, 32 * ks, lane), a);
#pragma unroll
                  for (int ks = 0; ks < 4; ++ks) a = mfma16(frag_ld(Qs, LDQ, 16 * it, 32 * ks, lane), frag_ld(St, LDQ, 16 * et, 32 * ks, lane), a);
#pragma unroll
                  for (int r = 0; r < 4; ++r) Ot[(16 * it + 4 * g + r) * LDQ + 16 * et + cc] = f2bf(a[r]); } }
#pragma unroll
            for (int et = 0; et < 8; ++et) {
#pragma unroll
                for (int ks = 0; ks < 2; ++ks) accS[et] = mfma16(frag_ld(KEt, LDJ, 16 * w, 32 * ks, lane), frag_ld(Vt, LDJ, 16 * et, 32 * ks, lane), accS[et]);
#pragma unroll
                for (int r = 0; r < 4; ++r) accS[et][r] *= dec[16 * w + 4 * g + r];
            }
            __syncthreads();
#pragma unroll
            for (int et = 0; et < 8; ++et) { u32x2 sv; sv.x = pk_bf16(accS[et][0], accS[et][1]); sv.y = pk_bf16(accS[et][2], accS[et][3]);
                *(u32x2*)(St + (16 * et + cc) * LDQ + 16 * w + 4 * g) = sv; }
#pragma unroll
            for (int it = 0; it < 2; ++it) *(u32x4*)(O + (size_t)(r0 + qtok0 + 32 * it) * 1024 + h * 256 + es * 128 + qd8) = *(const u32x4*)(Ot + (qtok0 + 32 * it) * LDQ + qd8);
        }
#undef GLA_LOAD
#undef GLA_R0
    }
}

DI void phase_gla_readout(const Ctx& c, int j) {
    const Params& p = *c.p; unsigned char* ws = c.ws;
    const bf16_t* O = (const bf16_t*)(ws + WS_H1); const bf16_t* OB = (const bf16_t*)(ws + WS_OB); const bf16_t* RG = (const bf16_t*)(ws + WS_R1 + 2 * SZ_T512 + SZ_T1K); bf16_t* Y = (bf16_t*)(ws + WS_R2);
    const float* gn = p.in[17] + (size_t)j * 1024; const int stride = c.G * NWAVE;
    for (int row0 = c.bid * NWAVE + c.wave; row0 < T; row0 += 2 * stride) {
        const bool has2 = row0 + stride < T; const int rows[2] = {row0, has2 ? row0 + stride : row0};
        u32x2 ov[2][4], ow[2][4], rv[2][4];
#pragma unroll
        for (int rr = 0; rr < 2; ++rr)
#pragma unroll
            for (int hd = 0; hd < 4; ++hd) { const size_t o = (size_t)rows[rr] * D + 4 * c.lane + 256 * hd; ov[rr][hd] = *(const u32x2*)(O + o); ow[rr][hd] = *(const u32x2*)(OB + o); rv[rr][hd] = *(const u32x2*)(RG + o); }
#pragma unroll
        for (int rr = 0; rr < 2; ++rr) {
            if (rr == 1 && !has2) break;
#pragma unroll
            for (int hd = 0; hd < 4; ++hd) { const int col = 4 * c.lane + 256 * hd;
                const float x0 = bf_lo(ov[rr][hd].x) + bf_lo(ow[rr][hd].x), x1 = bf_hi(ov[rr][hd].x) + bf_hi(ow[rr][hd].x), x2 = bf_lo(ov[rr][hd].y) + bf_lo(ow[rr][hd].y), x3 = bf_hi(ov[rr][hd].y) + bf_hi(ow[rr][hd].y);
                const float mean = wave_sum((x0 + x1) + (x2 + x3)) * (1.0f / 256.0f);
                const float d0 = x0 - mean, d1 = x1 - mean, d2 = x2 - mean, d3 = x3 - mean;
                const float rstd = rsqrtf(wave_sum((d0 * d0 + d1 * d1) + (d2 * d2 + d3 * d3)) * (1.0f / 256.0f) + LN_EPS);
                const f32x4 gg = *(const f32x4*)(gn + col);
                const float r0 = bf_lo(rv[rr][hd].x), r1 = bf_hi(rv[rr][hd].x), r2 = bf_lo(rv[rr][hd].y), r3 = bf_hi(rv[rr][hd].y);
                u32x2 o; o.x = pk_bf16(d0 * rstd * gg[0] * silu_f(r0), d1 * rstd * gg[1] * silu_f(r1)); o.y = pk_bf16(d2 * rstd * gg[2] * silu_f(r2), d3 * rstd * gg[3] * silu_f(r3));
                *(u32x2*)(Y + (size_t)rows[rr] * D + col) = o; }
        }
    }
}

constexpr int N_PHASES = 2 + 2 * 8 + 2 * 9;

__global__ void __launch_bounds__(NTHR, 2) mega_fwd(Params p) {
    extern __shared__ __attribute__((aligned(16))) unsigned char smem[];
    cg::grid_group grid = cg::this_grid();
    Ctx c; c.p = &p; c.ws = p.ws; c.smem = smem; c.tid = threadIdx.x; c.lane = c.tid & 63; c.wave = __builtin_amdgcn_readfirstlane(c.tid >> 6); c.G = gridDim.x; c.bid = blockIdx.x;
    unsigned char* ws = p.ws;
    volatile LAS unsigned* xst = (volatile LAS unsigned*)((LAS unsigned char*)smem + (LDS_BYTES - 16));
    if (threadIdx.x == 0) { xst[0] = 0u; xst[1] = 0u; }
    __syncthreads();
    const XcdBarrier xbar = xcd_barrier_post((unsigned*)(ws + WS_CTL), xst);
    const int lo = p.ph_lo, hi = p.ph_hi;
    int ph = 0;
#ifndef PH_ONLY
#define PH_ONLY -1
#endif
#ifndef DUP_MASK
#define DUP_MASK 0
#endif
#define RUN1(...) { { int t_ = threadIdx.x; asm volatile("" : "+v"(t_)); c.tid = t_; c.lane = t_ & 63; c.wave = __builtin_amdgcn_readfirstlane(t_ >> 6); { size_t z_ = 0; asm volatile("" : "+s"(z_)); ws = p.ws + z_; } c.ws = ws; } __VA_ARGS__; }
#define RUN(id, ...) do { if ((PH_ONLY < 0 || PH_ONLY == (id)) && ph >= lo && ph < hi) { \
        RUN1(__VA_ARGS__) \
        if ((DUP_MASK >> (id)) & 1) { xcd_barrier(xbar); RUN1(__VA_ARGS__) } \
        if (ph + 1 < hi) { if (ph == 0) grid.sync(); else xcd_barrier(xbar); } } ++ph; } while (0)
    LAS unsigned char* lds = (LAS unsigned char*)smem;
    const float* MOD = (const float*)(ws + WS_MOD);

    RUN(0, phase_prologue(c));
    RUN(1, phase_mod0(c));
    for (int L = 0; L < DEPTH; ++L) {
        const int j = L >> 1;
        if ((L & 1) == 0) {
            RUN(2, { pg8::Gemm g{(const bf16_t*)(ws + WS_H1), (const bf16_t*)(ws + WS_WAIN) + (size_t)j * 2048 * 1024, T, 2048, 1024}; pg8::StaticOrder S; S.init(T, 2048, c.G, c.bid);
                  pg8::EpiBf16<1> E{(bf16_t*)(ws + WS_R1), 2048}; pg8::gemm_phase(lds, g, S, E, c.tid); });
            RUN(3, phase_vstats(c));
            RUN(4, phase_spatial(c, j));
        } else {
            RUN(5, { pg8::Gemm g{(const bf16_t*)(ws + WS_H1), (const bf16_t*)(ws + WS_WBIN) + (size_t)j * WBIN_N * 1024, T, WBIN_N, 1024}; pg8::StaticOrder S; S.init(T, WBIN_N, c.G, c.bid);
                  pg8::EpiGlaProj E{(bf16_t*)(ws + WS_R1), (bf16_t*)(ws + WS_R1 + SZ_T512), (bf16_t*)(ws + WS_R1 + 2 * SZ_T512), (bf16_t*)(ws + WS_R1 + 2 * SZ_T512 + SZ_T1K), (float*)(ws + WS_GL)};
                  pg8::gemm_phase(lds, g, S, E, c.tid); });
            RUN(6, phase_gla_prep(c, j));
            RUN(7, phase_gla_scan(c));
            RUN(8, phase_gla_readout(c, j));
        }
        const int Mrows = (L == DEPTH - 1) ? TL : T;
        RUN(9, { const bf16_t* W = (L & 1) ? (const bf16_t*)(ws + WS_WBOUT) + (size_t)j * 1024 * 1024 : (const bf16_t*)(ws + WS_WAOUT) + (size_t)j * 1024 * 1024;
              pg8::Gemm g{(const bf16_t*)(ws + WS_R2), W, Mrows, 1024, 1024}; pg8::StaticOrder S; S.init(Mrows, 1024, c.G, c.bid);
              pg8::EpiRes E{p.in[0], p.in[2], (bf16_t*)(ws + WS_XS), MOD + (size_t)L * 17 * 6144, 2, L == 0 ? 1 : 0};
              pg8::gemm_phase(lds, g, S, E, c.tid); });
        RUN(10, phase_ln1(c, L));
        RUN(11, { pg8::Gemm g{(const bf16_t*)(ws + WS_R2 + SZ_T1K), (const bf16_t*)(ws + WS_WQ) + (size_t)L * 1024 * 1024, Mrows, 1024, 1024}; pg8::StaticOrder S; S.init(Mrows, 1024, c.G, c.bid);
              pg8::EpiBf16<0> E{(bf16_t*)(ws + WS_R1), 1024}; pg8::gemm_phase(lds, g, S, E, c.tid); });
        RUN(12, phase_route(c, L));
        RUN(13, phase_experts(c, L));
    }
#undef RUN
}

extern "C" void kernel_launch(void* const* d_in, const int* in_sizes, int n_in, void* d_out, int out_size, void* d_ws, size_t ws_size, hipStream_t stream) {
    static int grid = 0;
    if (grid == 0) {
        if (n_in != 23 || out_size != TL * D || ws_size < WS_END) { fprintf(stderr, "kernel_launch: unexpected shapes: n_in %d out %d ws %zu (need %zu)\n", n_in, out_size, ws_size, (size_t)WS_END); grid = -1; return; }
        int dev = 0, cus = 0, per_cu = 0;
        if (hipGetDevice(&dev) != hipSuccess || hipDeviceGetAttribute(&cus, hipDeviceAttributeMultiprocessorCount, dev) != hipSuccess) { fprintf(stderr, "kernel_launch: device query failed\n"); grid = -1; return; }
        if (hipFuncSetAttribute((const void*)mega_fwd, hipFuncAttributeMaxDynamicSharedMemorySize, LDS_BYTES) != hipSuccess) { fprintf(stderr, "kernel_launch: hipFuncSetAttribute failed\n"); grid = -1; return; }
        if (hipOccupancyMaxActiveBlocksPerMultiprocessor(&per_cu, (const void*)mega_fwd, NTHR, LDS_BYTES) != hipSuccess || per_cu < 1) { fprintf(stderr, "kernel_launch: occupancy query says %d blocks per CU\n", per_cu); grid = -1; return; }
        grid = cus;
    }
    if (grid < 0) return;
    (void)hipMemsetAsync((char*)d_ws + WS_CTL, 0, 65536, stream);
    Params p{};
    for (int i = 0; i < 23; ++i) p.in[i] = (const float*)d_in[i];
    p.out = (float*)d_out; p.ws = (unsigned char*)d_ws; p.ph_lo = 0; p.ph_hi = N_PHASES;
    void* args[] = {&p};
    const hipError_t e = hipLaunchCooperativeKernel((const void*)mega_fwd, dim3(grid), dim3(NTHR), args, LDS_BYTES, stream);
    if (e != hipSuccess) fprintf(stderr, "kernel_launch: cooperative launch failed: %s (grid %d)\n", hipGetErrorString(e), grid);
}
```

```cpp
#include <hip/hip_runtime.h>
#include <hip/hip_cooperative_groups.h>
#include <cstdio>
#include <cstdint>
namespace cg = cooperative_groups;

#define LAS __attribute__((address_space(3)))
#define DI __device__ __forceinline__
typedef unsigned short bf16_t;
typedef short bf16x8 __attribute__((ext_vector_type(8)));
typedef float f32x4 __attribute__((ext_vector_type(4)));
typedef float f32x2 __attribute__((ext_vector_type(2)));
typedef unsigned u32x4 __attribute__((ext_vector_type(4)));
typedef unsigned u32x2 __attribute__((ext_vector_type(2)));
typedef __bf16 bf16v2 __attribute__((ext_vector_type(2)));

constexpr int D = 1024, NB = 16, SEQ = 2048, CTXL = 256, DEPTH = 4;
constexpr int TL = NB * SEQ, TC = NB * CTXL, T = TL + TC;
constexpr int NEXP = 16384;
constexpr float LN_EPS = 1e-5f;
constexpr float DN_ALPHA = 1.6817928305074290f;
constexpr int NTHR = 512, NWAVE = 8;
constexpr int LDS_BYTES = 140 * 1024;
constexpr int WBIN_N = 3328;

constexpr size_t al256(size_t x) { return (x + 255) & ~(size_t)255; }
constexpr size_t WS_CTL = 0;
constexpr size_t WS_MOD = 65536;
constexpr size_t WS_STATS = al256(WS_MOD + (size_t)4 * 17 * 6144 * 4);
constexpr size_t WS_GL = al256(WS_STATS + (size_t)T * 2 * 4);
constexpr size_t WS_DEC = al256(WS_GL + (size_t)T * 32 * 4);
constexpr size_t WS_WSB = al256(WS_DEC + (size_t)2 * 576 * 512 * 4);
constexpr size_t WS_WAIN = al256(WS_WSB + (size_t)2 * 8 * 128 * 128 * 2);
constexpr size_t WS_WAOUT = WS_WAIN + (size_t)2 * 2048 * 1024 * 2;
constexpr size_t WS_WBIN = WS_WAOUT + (size_t)2 * 1024 * 1024 * 2;
constexpr size_t WS_WBOUT = WS_WBIN + (size_t)2 * WBIN_N * 1024 * 2;
constexpr size_t WS_WQ = WS_WBOUT + (size_t)2 * 1024 * 1024 * 2;
constexpr size_t WS_UT = WS_WQ + (size_t)4 * 1024 * 1024 * 2;
constexpr size_t WS_VT = WS_UT + (size_t)4 * NEXP * 1024;
constexpr size_t WS_SU = WS_VT + (size_t)4 * NEXP * 1024;
constexpr size_t WS_SV = WS_SU + (size_t)4 * NEXP * 4;
constexpr size_t WS_XS = WS_SV + (size_t)4 * NEXP * 4;
constexpr size_t WS_R1 = WS_XS + (size_t)T * 1024 * 4;
constexpr size_t WS_R2 = WS_R1 + (size_t)T * 3072 * 2;
constexpr size_t WS_H1 = WS_R2 + (size_t)T * 3072 * 2;
constexpr size_t WS_VTT = WS_H1 + (size_t)T * 1024 * 2;
constexpr size_t WS_OB = WS_VTT + (size_t)T * 1024 * 2;
constexpr size_t WS_XH = WS_OB + (size_t)T * 1024 * 2;
constexpr size_t WS_XL = WS_XH + (size_t)T * 512;
constexpr size_t WS_SX = WS_XL + (size_t)T * 512;
constexpr size_t WS_END = al256(WS_SX + (size_t)T * 4);
constexpr size_t SZ_T1K = (size_t)T * 1024 * 2;
constexpr size_t SZ_T512 = (size_t)T * 512 * 2;

struct Params { const float* in[23]; float* out; unsigned char* ws; int ph_lo, ph_hi; };

DI unsigned pk_bf16(float lo, float hi) { f32x2 v = {lo, hi}; return __builtin_bit_cast(unsigned, __builtin_convertvector(v, bf16v2)); }
DI float bf_lo(unsigned w) { return __uint_as_float(w << 16); }
DI float bf_hi(unsigned w) { return __uint_as_float(w & 0xffff0000u); }
DI float bf1(bf16_t b) { return __uint_as_float(((unsigned)b) << 16); }
DI bf16_t f2bf(float f) { return (bf16_t)(pk_bf16(f, 0.f) & 0xffffu); }
DI float gelu_tanh(float x) { const float t = x * x; const float w = x * (t * (-2.0f * 1.4426950408889634f * 0.7978845608028654f * 0.044715f) + (-2.0f * 1.4426950408889634f * 0.7978845608028654f)); return x * __builtin_amdgcn_rcpf(1.0f + __builtin_amdgcn_exp2f(w)); }
DI float silu_f(float x) { return x * __builtin_amdgcn_rcpf(1.0f + __builtin_amdgcn_exp2f(-1.4426950408889634f * x)); }
DI float logsig_f(float z) { return fminf(z, 0.f) - log1pf(expf(-fabsf(z))); }
template <int CTRL> DI float dpp_mov(float x) { return __builtin_bit_cast(float, __builtin_amdgcn_mov_dpp(__builtin_bit_cast(int, x), CTRL, 0xf, 0xf, true)); }
DI float wave_sum(float v) {
    const auto a = __builtin_amdgcn_permlane32_swap(__float_as_uint(v), __float_as_uint(v), false, false); v = __uint_as_float(a[0]) + __uint_as_float(a[1]);
    const auto b = __builtin_amdgcn_permlane16_swap(__float_as_uint(v), __float_as_uint(v), false, false); v = __uint_as_float(b[0]) + __uint_as_float(b[1]);
    v += dpp_mov<0x128>(v); v += dpp_mov<0x124>(v); v += dpp_mov<0x122>(v); v += dpp_mov<0x121>(v);
    return v;
}
DI float wave_max(float v) {
#pragma unroll
    for (int o = 32; o > 0; o >>= 1) v = fmaxf(v, __shfl_xor(v, o, 64));
    return v;
}
DI float reduce4(float p0, float p1, float p2, float p3) {
    const auto a = __builtin_amdgcn_permlane32_swap(__float_as_uint(p0), __float_as_uint(p2), false, false); const float q0 = __uint_as_float(a[0]) + __uint_as_float(a[1]);
    const auto b = __builtin_amdgcn_permlane32_swap(__float_as_uint(p1), __float_as_uint(p3), false, false); const float q1 = __uint_as_float(b[0]) + __uint_as_float(b[1]);
    const auto c = __builtin_amdgcn_permlane16_swap(__float_as_uint(q0), __float_as_uint(q1), false, false); float s = __uint_as_float(c[0]) + __uint_as_float(c[1]);
    s += dpp_mov<0x128>(s); s += dpp_mov<0x124>(s); s += dpp_mov<0x122>(s); s += dpp_mov<0x121>(s);
    return s;
}
DI float dot2bf(unsigned a, unsigned b, float c) { return __builtin_amdgcn_fdot2_f32_bf16(__builtin_bit_cast(bf16v2, a), __builtin_bit_cast(bf16v2, b), c, false); }
DI f32x4 mfma16(bf16x8 a, bf16x8 b, f32x4 c) { return __builtin_amdgcn_mfma_f32_16x16x32_bf16(a, b, c, 0, 0, 0); }
DI bf16x8 frag_ld(const bf16_t* X, int ld, int row0, int k0, int lane) { return *(const bf16x8*)(X + (size_t)(row0 + (lane & 15)) * ld + k0 + 8 * (lane >> 4)); }
DI int mod_batch(int row) { return row < TL ? (row >> 11) : NB; }

#define XB_TMO      128
#define XB_XCNT(j)  (256  + 64 * (j))
#define XB_XSUB(j)  (1280 + 64 * (j))
#define XB_XGEN(j)  (2304 + 64 * (j))
#define XB_TOP      3328
#define XB_TOPGEN   3392
#define XCD_BAR_WORDS 3456
#define XB_SPIN_CAP (1u << 22)
DI unsigned xb_ld(unsigned* p)              { return __hip_atomic_load(p, __ATOMIC_RELAXED, __HIP_MEMORY_SCOPE_AGENT); }
DI unsigned xb_add(unsigned* p, unsigned v) { return __hip_atomic_fetch_add(p, v, __ATOMIC_RELAXED, __HIP_MEMORY_SCOPE_AGENT); }
DI unsigned xb_xcc_id() { return (unsigned)__builtin_amdgcn_s_getreg((3 << 11) | 20) & 0xFu; }
#define XB_SPIN(cond, bar) do { unsigned _sp = 0; while (cond) { __builtin_amdgcn_s_sleep(1); \
    if ((++_sp & 255u) == 0u) { if (xb_ld(&(bar)[XB_TMO])) break; if (_sp > XB_SPIN_CAP) { atomicAdd(&(bar)[XB_TMO], 1u); break; } } } } while (0)
struct XcdBarrier { unsigned* bar; unsigned x; volatile LAS unsigned* st; };
DI XcdBarrier xcd_barrier_post(unsigned* bar, volatile LAS unsigned* st) {
    XcdBarrier b; b.bar = bar; b.x = xb_xcc_id(); b.st = st;
    if (threadIdx.x == 0) (void)xb_add(&bar[XB_XCNT(b.x)], 1u);
    return b;
}
DI void xcd_barrier_complete(unsigned* bar, unsigned x, unsigned& nloc, unsigned& nx) {
    const unsigned G = gridDim.x * gridDim.y * gridDim.z;
    unsigned sum, cnt, mine, sp = 0u;
    for (;;) {
        sum = 0u; cnt = 0u; mine = 0u;
#pragma unroll
        for (unsigned j = 0; j < 16; ++j) { const unsigned c = xb_ld(&bar[XB_XCNT(j)]); sum += c; cnt += (c > 0u) ? 1u : 0u; mine = (j == x) ? c : mine; }
        if (sum == G) break;
        __builtin_amdgcn_s_sleep(1);
        if ((++sp & 255u) == 0u) { if (xb_ld(&bar[XB_TMO])) break; if (sp > XB_SPIN_CAP) { atomicAdd(&bar[XB_TMO], 1u); break; } }
    }
    nloc = mine > 0u ? mine : 1u; nx = cnt > 0u ? cnt : 1u;
}
DI void xcd_barrier(const XcdBarrier& b) {
    asm volatile("s_waitcnt vmcnt(0)" ::: "memory");
    __syncthreads();
    if (threadIdx.x == 0) {
        unsigned* bar = b.bar;
        __builtin_amdgcn_s_waitcnt(0);
        unsigned nloc = b.st[0], nx = b.st[1];
        if (nloc == 0u) { xcd_barrier_complete(bar, b.x, nloc, nx); b.st[0] = nloc; b.st[1] = nx; }
        const unsigned old = xb_add(&bar[XB_XSUB(b.x)], 1u);
        const unsigned gen = old / nloc;
        if (old + 1u == (gen + 1u) * nloc) {
            __builtin_amdgcn_fence(__ATOMIC_RELEASE, "agent");
            asm volatile("s_waitcnt vmcnt(0)" ::: "memory");
            const unsigned og = xb_add(&bar[XB_TOP], 1u);
            const unsigned tg = og / nx;
            if (og + 1u == (tg + 1u) * nx) xb_add(&bar[XB_TOPGEN], 1u);
            else XB_SPIN(xb_ld(&bar[XB_TOPGEN]) == tg, bar);
            __builtin_amdgcn_fence(__ATOMIC_ACQUIRE, "agent");
            xb_add(&bar[XB_XGEN(b.x)], 1u);
            asm volatile("s_waitcnt vmcnt(0)" ::: "memory");
        } else {
            XB_SPIN(xb_ld(&bar[XB_XGEN(b.x)]) == gen, bar);
            __builtin_amdgcn_fence(__ATOMIC_ACQUIRE, "agent");
            asm volatile("s_waitcnt vmcnt(0)" ::: "memory");
        }
    }
    __syncthreads();
}

namespace pg8 {
constexpr int BM = 256, BK = 64, HALF = 128, HTB = HALF * BK * 2, STAGE_BYTES = 8 * HTB, NXCD = 8, WGM = 8;
__host__ __device__ __forceinline__ int lds_byte(int r, int c) { const int st = (r >> 4) * 2 + (c >> 5), rr = r & 15, cc = c & 31, ob = rr * 64 + cc * 2; return st * 1024 + (ob ^ (((ob >> 9) & 1) << 5)); }
__host__ __device__ __forceinline__ void stage_rc(int b, int& R, int& C) { const int st = b / 1024, sb = b % 1024, swz = sb ^ (((sb >> 9) & 1) << 5); R = (st >> 1) * 16 + swz / 64; C = (st & 1) * 32 + (swz % 64) / 2; }
__host__ __device__ __forceinline__ int perm32(int rho) { const int n = rho >> 4, i = rho & 15; return 8 * (i >> 2) + 4 * n + (i & 3); }
struct Unit { int pm, pn; };
struct Gemm { const bf16_t* A; const bf16_t* Bt; int M, N, K; };
struct StaticOrder {
    int nM, nN, nwg, G, c;
    __device__ void init(int M, int N, int G_, int c_) { nM = M / BM; nN = N / BM; nwg = nM * nN; G = G_; c = c_; }
    __device__ bool next(int i, Unit& u) const {
        const long L = (long)i * G + c; if (L >= nwg) return false;
        int wgid = (int)L; { const int q = nwg / NXCD, r = nwg % NXCD, xcd = wgid % NXCD, off = wgid / NXCD; wgid = (xcd < r ? xcd * (q + 1) : r * (q + 1) + (xcd - r) * q) + off; }
        const int nig = WGM * nN, gid = wgid / nig, fm = gid * WGM, gsz = (nM - fm) < WGM ? (nM - fm) : WGM;
        u.pm = fm + ((wgid % nig) % gsz); u.pn = (wgid % nig) / gsz; return true;
    }
};

template <class Epi>
__device__ __forceinline__ void gemm_phase(LAS unsigned char* lds, const Gemm g, const StaticOrder& S, const Epi& E, const int tid) {
    const int wid = __builtin_amdgcn_readfirstlane(tid >> 6), lane = tid & 63, wr = wid >> 2, wc = wid & 3, fr = lane & 15, fq = lane >> 4;
    const int K = g.K, nt = K / BK;
    unsigned voffA[2], voffB[2];
#pragma unroll
    for (int i = 0; i < 2; ++i) { int R, C; stage_rc(tid * 16 + i * 8192, R, C); const int Rb = Epi::PERM ? ((R & ~31) + perm32(R & 31)) : R;
        voffA[i] = (unsigned)(R * K + C) * 2u; voffB[i] = (unsigned)(Rb * K + C) * 2u; }
    const size_t kstep = (size_t)(BK * 2);
    const size_t hstep = (size_t)HALF * K * 2;
    const size_t tstep = 2 * hstep;
    const unsigned ldsw = (unsigned)wid * 1024u;
    const int aoff = lds_byte(wr * 64 + fr, fq * 8), boff = lds_byte(wc * 32 + fr, fq * 8);
#define PG8_SA(b, h) (((b) * 2 + (h)) * HTB)
#define PG8_SB(b, h) ((4 + (b) * 2 + (h)) * HTB)
#define PG8_STAGE(bufoff, gbase, voff) do { _Pragma("unroll") for (int _i = 0; _i < 2; ++_i) \
        __builtin_amdgcn_global_load_lds((const unsigned*)((const char*)(gbase) + (voff)[_i]), (LAS unsigned*)(lds + (bufoff) + ldsw + _i * 8192), 16, 0, 0); } while (0)
#define PG8_LDA(dst, b, h) do { _Pragma("unroll") for (int m = 0; m < 4; ++m) _Pragma("unroll") for (int k = 0; k < 2; ++k) dst[m][k] = *(const LAS bf16x8*)(lds + PG8_SA(b, h) + aoff + m * 2048 + k * 1024); } while (0)
#define PG8_LDB(dst, b, h) do { _Pragma("unroll") for (int n = 0; n < 2; ++n) _Pragma("unroll") for (int k = 0; k < 2; ++k) dst[n][k] = *(const LAS bf16x8*)(lds + PG8_SB(b, h) + boff + n * 2048 + k * 1024); } while (0)
#define PG8_MMA(ai, bj, At, Bt) do { __builtin_amdgcn_s_setprio(1); _Pragma("unroll") for (int m = 0; m < 4; ++m) _Pragma("unroll") for (int n = 0; n < 2; ++n) _Pragma("unroll") for (int k = 0; k < 2; ++k) \
        acc[ai][bj][m][n] = __builtin_amdgcn_mfma_f32_16x16x32_bf16(Bt[n][k], At[m][k], acc[ai][bj][m][n], 0, 0, 0); __builtin_amdgcn_s_setprio(0); } while (0)
#define PG8_WAIT_V(n) asm volatile("s_waitcnt vmcnt(" #n ")" ::: "memory")
#define PG8_WAIT_L(n) asm volatile("s_waitcnt lgkmcnt(" #n ")" ::: "memory")
#define PG8_BAR __builtin_amdgcn_s_barrier()
#define PG8_SCHED __builtin_amdgcn_sched_barrier(0)
    Unit cur, nxt; int ui = 0;
    if (!S.next(0, cur)) return;
    f32x4 acc[2][2][4][2];
#pragma unroll
    for (int a = 0; a < 2; ++a)
#pragma unroll
        for (int b = 0; b < 2; ++b)
#pragma unroll
            for (int m = 0; m < 4; ++m)
#pragma unroll
                for (int n = 0; n < 2; ++n) acc[a][b][m][n] = (f32x4){0.f, 0.f, 0.f, 0.f};
    bf16x8 At[4][2], B0[2][2], B1[2][2];
    const char* cA = (const char*)g.A + (size_t)cur.pm * tstep; const char* cB = (const char*)g.Bt + (size_t)cur.pn * tstep;
    PG8_STAGE(PG8_SB(0, 0), cB, voffB); PG8_STAGE(PG8_SA(0, 0), cA, voffA); PG8_STAGE(PG8_SB(0, 1), cB + hstep, voffB); PG8_STAGE(PG8_SA(0, 1), cA + hstep, voffA);
    if (wr == 1) PG8_BAR;
    PG8_WAIT_V(4); PG8_BAR;
    PG8_STAGE(PG8_SB(1, 0), cB + kstep, voffB); PG8_STAGE(PG8_SA(1, 0), cA + kstep, voffA); PG8_STAGE(PG8_SB(1, 1), cB + hstep + kstep, voffB);
    PG8_WAIT_V(6); PG8_BAR;
    for (;;) {
        const bool has_next = S.next(ui + 1, nxt);
        const char* nA = has_next ? (const char*)g.A + (size_t)nxt.pm * tstep : cA; const char* nB = has_next ? (const char*)g.Bt + (size_t)nxt.pn * tstep : cB;
        for (int t = 0; t < nt; t += 2) {
            const bool last = (t == nt - 2);
            const char* a1 = cA + (size_t)(t + 1) * kstep;
            const char* a2 = last ? nA : cA + (size_t)(t + 2) * kstep; const char* b2 = last ? nB : cB + (size_t)(t + 2) * kstep;
            const char* a3 = a2 + kstep; const char* b3 = b2 + kstep;
            PG8_LDB(B0, 0, 0); PG8_SCHED; PG8_LDA(At, 0, 0); PG8_STAGE(PG8_SA(1, 1), a1 + hstep, voffA);
            PG8_WAIT_L(8); PG8_BAR; PG8_WAIT_L(0); PG8_MMA(0, 0, At, B0); PG8_BAR; PG8_SCHED;
            PG8_LDB(B1, 0, 1); PG8_STAGE(PG8_SB(0, 0), b2, voffB);
            PG8_BAR; PG8_WAIT_L(0); PG8_MMA(0, 1, At, B1); PG8_BAR;
            PG8_LDA(At, 0, 1); PG8_STAGE(PG8_SA(0, 0), a2, voffA);
            PG8_BAR; PG8_WAIT_L(0); PG8_MMA(1, 0, At, B0); PG8_BAR; PG8_SCHED;
            PG8_STAGE(PG8_SB(0, 1), b2 + hstep, voffB);
            PG8_WAIT_V(6); PG8_BAR; PG8_MMA(1, 1, At, B1); PG8_BAR;
            PG8_LDB(B0, 1, 0); PG8_SCHED; PG8_LDA(At, 1, 0); PG8_STAGE(PG8_SA(0, 1), a2 + hstep, voffA);
            PG8_WAIT_L(8); PG8_BAR; PG8_WAIT_L(0); PG8_MMA(0, 0, At, B0); PG8_BAR; PG8_SCHED;
            PG8_LDB(B1, 1, 1); PG8_STAGE(PG8_SB(1, 0), b3, voffB);
            PG8_BAR; PG8_WAIT_L(0); PG8_MMA(0, 1, At, B1); PG8_BAR;
            PG8_LDA(At, 1, 1); PG8_STAGE(PG8_SA(1, 0), a3, voffA);
            PG8_BAR; PG8_WAIT_L(0); PG8_MMA(1, 0, At, B0); PG8_BAR; PG8_SCHED;
            PG8_STAGE(PG8_SB(1, 1), b3 + hstep, voffB);
            PG8_WAIT_V(6); PG8_BAR; PG8_MMA(1, 1, At, B1); PG8_BAR;
        }
        E(acc, cur, wr, wc, fr, fq);
        if (!has_next) break;
#pragma unroll
        for (int a = 0; a < 2; ++a)
#pragma unroll
            for (int b = 0; b < 2; ++b)
#pragma unroll
                for (int m = 0; m < 4; ++m)
#pragma unroll
                    for (int n = 0; n < 2; ++n) acc[a][b][m][n] = (f32x4){0.f, 0.f, 0.f, 0.f};
        cur = nxt; cA = nA; cB = nB; ++ui;
    }
    PG8_WAIT_V(0);
    if (wr == 0) PG8_BAR;
    PG8_BAR;
#undef PG8_SA
#undef PG8_SB
#undef PG8_STAGE
#undef PG8_LDA
#undef PG8_LDB
#undef PG8_MMA
#undef PG8_WAIT_V
#undef PG8_WAIT_L
#undef PG8_BAR
#undef PG8_SCHED
}

template <int ACT  > struct EpiBf16 {
    static constexpr bool PERM = true;
    bf16_t* O; int ldc;
    __device__ __forceinline__ void operator()(const f32x4 (&acc)[2][2][4][2], const Unit& u, int wr, int wc, int fr, int fq) const {
        const int row0 = u.pm * BM + wr * 64 + fr, col0 = u.pn * BM + wc * 32 + 8 * fq;
#pragma unroll
        for (int ai = 0; ai < 2; ++ai)
#pragma unroll
            for (int m = 0; m < 4; ++m) { bf16_t* rowp = O + (size_t)(row0 + ai * HALF + m * 16) * ldc + col0;
#pragma unroll
                for (int bj = 0; bj < 2; ++bj) { f32x4 v0 = acc[ai][bj][m][0], v1 = acc[ai][bj][m][1];
                    if (ACT == 1) {
#pragma unroll
                        for (int j = 0; j < 4; ++j) { v0[j] = gelu_tanh(v0[j]); v1[j] = gelu_tanh(v1[j]); } }
                    u32x4 w; w.x = pk_bf16(v0[0], v0[1]); w.y = pk_bf16(v0[2], v0[3]); w.z = pk_bf16(v1[0], v1[1]); w.w = pk_bf16(v1[2], v1[3]);
                    *(u32x4*)(rowp + bj * HALF) = w; } }
    }
};
struct EpiRes {
    static constexpr bool PERM = true;
    const float* src_lat; const float* src_ctx; bf16_t* xs; const float* modL; int gate_idx; int src_f32;
    __device__ __forceinline__ void operator()(const f32x4 (&acc)[2][2][4][2], const Unit& u, int wr, int wc, int fr, int fq) const {
        const bool isctx = u.pm >= (TL / BM);
        const float* sb = isctx ? src_ctx + (size_t)(u.pm - TL / BM) * BM * D : src_lat + (size_t)u.pm * BM * D;
        const int mb = isctx ? NB : (u.pm >> 3);
        const float* gv = modL + (size_t)mb * 6144 + gate_idx * 1024;
        const int rl = wr * 64 + fr, col0 = u.pn * BM + wc * 32 + 8 * fq;
        f32x4 g[2][2];
#pragma unroll
        for (int bj = 0; bj < 2; ++bj)
#pragma unroll
            for (int n = 0; n < 2; ++n) g[bj][n] = *(const f32x4*)(gv + col0 + bj * HALF + n * 4);
#pragma unroll
        for (int ai = 0; ai < 2; ++ai)
#pragma unroll
            for (int m = 0; m < 4; ++m) { const int r = rl + ai * HALF + m * 16; bf16_t* dp = xs + ((size_t)u.pm * BM + r) * D + col0;
#pragma unroll
                for (int bj = 0; bj < 2; ++bj) { f32x4 x0, x1;
                    if (src_f32) { const float* sp = sb + (size_t)r * D + col0 + bj * HALF; x0 = *(const f32x4*)sp; x1 = *(const f32x4*)(sp + 4); }
                    else { const u32x4 xv = *(const u32x4*)(dp + bj * HALF); x0 = (f32x4){bf_lo(xv.x), bf_hi(xv.x), bf_lo(xv.y), bf_hi(xv.y)}; x1 = (f32x4){bf_lo(xv.z), bf_hi(xv.z), bf_lo(xv.w), bf_hi(xv.w)}; }
                    const f32x4 y0 = x0 * DN_ALPHA + g[bj][0] * acc[ai][bj][m][0], y1 = x1 * DN_ALPHA + g[bj][1] * acc[ai][bj][m][1];
                    u32x4 w; w.x = pk_bf16(y0[0], y0[1]); w.y = pk_bf16(y0[2], y0[3]); w.z = pk_bf16(y1[0], y1[1]); w.w = pk_bf16(y1[2], y1[3]);
                    *(u32x4*)(dp + bj * HALF) = w; } }
    }
};
struct EpiGlaProj {
    static constexpr bool PERM = true;
    bf16_t* QG; bf16_t* KG; bf16_t* VG; bf16_t* RG; float* GL;
    __device__ __forceinline__ void operator()(const f32x4 (&acc)[2][2][4][2], const Unit& u, int wr, int wc, int fr, int fq) const {
        const int row0 = u.pm * BM + wr * 64 + fr, pn = u.pn;
        if (pn < 12) {
            bf16_t* base; int ld, colt; float sc = 1.f;
            if (pn < 2) { base = QG; ld = 512; colt = pn * BM; sc = 0.08838834764831845f; }
            else if (pn < 4) { base = KG; ld = 512; colt = (pn - 2) * BM; }
            else if (pn < 8) { base = VG; ld = 1024; colt = (pn - 4) * BM; }
            else { base = RG; ld = 1024; colt = (pn - 8) * BM; }
            const int col0 = colt + wc * 32 + 8 * fq;
#pragma unroll
            for (int ai = 0; ai < 2; ++ai)
#pragma unroll
                for (int m = 0; m < 4; ++m) { bf16_t* rowp = base + (size_t)(row0 + ai * HALF + m * 16) * ld + col0;
#pragma unroll
                    for (int bj = 0; bj < 2; ++bj) { const f32x4 v0 = acc[ai][bj][m][0] * sc, v1 = acc[ai][bj][m][1] * sc;
                        u32x4 w; w.x = pk_bf16(v0[0], v0[1]); w.y = pk_bf16(v0[2], v0[3]); w.z = pk_bf16(v1[0], v1[1]); w.w = pk_bf16(v1[2], v1[3]);
                        *(u32x4*)(rowp + bj * HALF) = w; } }
        } else if (wc == 0) {
#pragma unroll
            for (int ai = 0; ai < 2; ++ai)
#pragma unroll
                for (int m = 0; m < 4; ++m) { float* gp = GL + (size_t)(row0 + ai * HALF + m * 16) * 32 + 8 * fq;
                    *(f32x4*)gp = acc[ai][0][m][0]; *(f32x4*)(gp + 4) = acc[ai][0][m][1]; }
        }
    }
};
}

struct Ctx {
    const Params* p; unsigned char* ws; unsigned char* smem; int tid, lane, wave, G, bid;
};

DI void phase_prologue(const Ctx& c) {
    const Params& p = *c.p; unsigned char* ws = c.ws;
    const int tid = c.tid;
    constexpr int N_MOD = 192, N_TR = 4736, N_WS = 64, N_TAB = 2048;
    constexpr int N_ALL = N_MOD + N_TR + N_WS + N_TAB;
    for (int u = c.bid; u < N_ALL; u += c.G) {
        if (u < N_MOD) {
            const int l = u / 48, n0 = (u % 48) * 128;
            float* sc = (float*)c.smem;
            float* red = (float*)(c.smem + 17 * 1024 * 4);
            __syncthreads();
#pragma unroll 1
            for (int hk = 0; hk < 2; ++hk) { const int k = hk * 512 + tid; float v[17];
#pragma unroll
                for (int b = 0; b < 17; ++b) v[b] = (b < NB) ? p.in[1][b * 1024 + k] : p.in[3][k];
#pragma unroll
                for (int b = 0; b < 17; ++b) sc[b * 1024 + k] = silu_f(v[b]); }
            __syncthreads();
            const int c4 = (tid & 31) * 4, kg = tid >> 5;
            float acc[17][4];
#pragma unroll
            for (int b = 0; b < 17; ++b) { acc[b][0] = 0.f; acc[b][1] = 0.f; acc[b][2] = 0.f; acc[b][3] = 0.f; }
            const float* wp = p.in[4] + ((size_t)l * 1024 + (size_t)kg * 64) * 6144 + n0 + c4;
#pragma unroll 4
            for (int kk = 0; kk < 64; ++kk) {
                const f32x4 w = *(const f32x4*)(wp + (size_t)kk * 6144);
                const int k = kg * 64 + kk;
#pragma unroll
                for (int b = 0; b < 17; ++b) { const float s = sc[b * 1024 + k]; acc[b][0] += s * w[0]; acc[b][1] += s * w[1]; acc[b][2] += s * w[2]; acc[b][3] += s * w[3]; }
            }
#pragma unroll
            for (int b = 0; b < 17; ++b)
#pragma unroll
                for (int j = 0; j < 4; ++j) acc[b][j] += __shfl_xor(acc[b][j], 32, 64);
            if ((tid & 32) == 0) {
#pragma unroll
                for (int b = 0; b < 17; ++b)
#pragma unroll
                    for (int j = 0; j < 4; ++j) red[(c.wave * 17 + b) * 128 + c4 + j] = acc[b][j];
            }
            __syncthreads();
            for (int o = tid; o < 17 * 128; o += NTHR) { const int b = o >> 7, n = o & 127; float s = 0.f;
#pragma unroll
                for (int w = 0; w < 8; ++w) s += red[(w * 17 + b) * 128 + n];
                ((float*)(ws + WS_MOD))[((size_t)l * 17 + b) * 6144 + n0 + n] = s + p.in[5][l * 6144 + n0 + n]; }
        } else if (u < N_MOD + N_TR) {
            int v = u - N_MOD; const float* src; bf16_t* dst; int N, Npad;
            if (v < 1024) { const int j = v / 512; v %= 512; src = p.in[8] + (size_t)j * 1024 * 2048; dst = (bf16_t*)(ws + WS_WAIN) + (size_t)j * 2048 * 1024; N = 2048; Npad = 2048; }
            else if (v < 1536) { v -= 1024; const int j = v / 256; v %= 256; src = p.in[13] + (size_t)j * 1024 * 1024; dst = (bf16_t*)(ws + WS_WAOUT) + (size_t)j * 1024 * 1024; N = 1024; Npad = 1024; }
            else if (v < 3200) { v -= 1536; const int j = v / 832; v %= 832; src = p.in[14] + (size_t)j * 1024 * 3104; dst = (bf16_t*)(ws + WS_WBIN) + (size_t)j * WBIN_N * 1024; N = 3104; Npad = WBIN_N; }
            else if (v < 3712) { v -= 3200; const int j = v / 256; v %= 256; src = p.in[18] + (size_t)j * 1024 * 1024; dst = (bf16_t*)(ws + WS_WBOUT) + (size_t)j * 1024 * 1024; N = 1024; Npad = 1024; }
            else { v -= 3712; const int j = v / 256; v %= 256; src = p.in[19] + (size_t)j * 1024 * 1024; dst = (bf16_t*)(ws + WS_WQ) + (size_t)j * 1024 * 1024; N = 1024; Npad = 1024; }
            (void)Npad;
            const int ntn = v >> 4, ktile = v & 15, n0 = ntn * 64, k0 = ktile * 64;
            float* tl = (float*)c.smem;
            __syncthreads();
#pragma unroll
            for (int i = 0; i < 2; ++i) { const int kk = (tid >> 4) + 32 * i, nn = (tid & 15) * 4;
                f32x4 x = {0.f, 0.f, 0.f, 0.f};
                if (n0 + nn < N) x = *(const f32x4*)(src + (size_t)(k0 + kk) * N + n0 + nn);
                tl[kk * 65 + nn] = x[0]; tl[kk * 65 + nn + 1] = x[1]; tl[kk * 65 + nn + 2] = x[2]; tl[kk * 65 + nn + 3] = x[3]; }
            __syncthreads();
            { const int nn = tid >> 3, kk8 = (tid & 7) * 8; float x[8];
#pragma unroll
              for (int j = 0; j < 8; ++j) x[j] = tl[(kk8 + j) * 65 + nn];
              u32x4 w; w.x = pk_bf16(x[0], x[1]); w.y = pk_bf16(x[2], x[3]); w.z = pk_bf16(x[4], x[5]); w.w = pk_bf16(x[6], x[7]);
              *(u32x4*)(dst + (size_t)(n0 + nn) * 1024 + k0 + kk8) = w; }
        } else if (u < N_MOD + N_TR + N_WS) {
            const int v = u - N_MOD - N_TR; const size_t e = (size_t)v * 4096 + (size_t)tid * 8;
            const f32x4 a = *(const f32x4*)(p.in[11] + e), b = *(const f32x4*)(p.in[11] + e + 4);
            u32x4 w; w.x = pk_bf16(a[0], a[1]); w.y = pk_bf16(a[2], a[3]); w.z = pk_bf16(b[0], b[1]); w.w = pk_bf16(b[2], b[3]);
            *(u32x4*)((bf16_t*)(ws + WS_WSB) + e) = w;
        } else {
            const int v = u - N_MOD - N_TR - N_WS; const int tab = v >> 10;
            const float* src = p.in[21 + tab]; unsigned char* dst = ws + (tab ? WS_VT : WS_UT); float* sc = (float*)(ws + (tab ? WS_SV : WS_SU));
#pragma unroll 2
            for (int i = 0; i < 8; ++i) { const size_t row = (size_t)(v & 1023) * 64 + c.wave * 8 + i;
                const float* rp = src + row * 1024 + 16 * c.lane; f32x4 x[4]; float am = 0.f;
#pragma unroll
                for (int q = 0; q < 4; ++q) { x[q] = __builtin_nontemporal_load((const f32x4*)(rp + 4 * q)); am = fmaxf(am, fmaxf(fmaxf(fabsf(x[q][0]), fabsf(x[q][1])), fmaxf(fabsf(x[q][2]), fabsf(x[q][3])))); }
                am = fmaxf(wave_max(am), 1e-30f);
                const size_t Lr = row >> 14, er = row & 16383;
                if (tab == 0) {
                    float ss = 0.f;
#pragma unroll
                    for (int q = 0; q < 4; ++q) ss += (x[q][0] * x[q][0] + x[q][1] * x[q][1]) + (x[q][2] * x[q][2] + x[q][3] * x[q][3]);
                    const float rms = sqrtf(wave_sum(ss) * (1.0f / 1024.0f)); const float stp = fmaxf(rms * (2.4f / 7.0f), 1e-30f), inv = 1.0f / stp; u32x2 w;
#pragma unroll
                    for (int hq = 0; hq < 2; ++hq) { unsigned t = 0;
#pragma unroll
                        for (int e = 0; e < 8; ++e) { const float v = x[2 * hq + (e >> 2)][e & 3] * inv; const int qi = (int)fminf(fmaxf(rintf(v), -8.0f), 7.0f); t |= ((unsigned)qi & 15u) << (4 * e); }
                        w[hq] = t; }
                    *(u32x2*)(dst + ((Lr * 4 + (c.lane >> 4)) * NEXP + er) * 128 + 8 * (c.lane & 15)) = w;
                    if (c.lane == 0) sc[row] = stp;
                } else {
                    const float inv = 6.0f / am; u32x2 w;
#pragma unroll
                    for (int hq = 0; hq < 2; ++hq) { unsigned t = 0;
                        t = __builtin_amdgcn_cvt_scalef32_pk_fp4_f32(t, x[2 * hq][0] * inv, x[2 * hq][1] * inv, 1.0f, 0); t = __builtin_amdgcn_cvt_scalef32_pk_fp4_f32(t, x[2 * hq][2] * inv, x[2 * hq][3] * inv, 1.0f, 1);
                        t = __builtin_amdgcn_cvt_scalef32_pk_fp4_f32(t, x[2 * hq + 1][0] * inv, x[2 * hq + 1][1] * inv, 1.0f, 2); t = __builtin_amdgcn_cvt_scalef32_pk_fp4_f32(t, x[2 * hq + 1][2] * inv, x[2 * hq + 1][3] * inv, 1.0f, 3);
                        w[hq] = t; }
                    *(u32x2*)(dst + ((Lr * 4 + (c.lane >> 4)) * NEXP + er) * 128 + 8 * (c.lane & 15)) = w;
                    if (c.lane == 0) sc[row] = am * (1.0f / 6.0f);
                } }
        }
    }
}

DI void phase_mod0(const Ctx& c) {
    const Params& p = *c.p; const float* MOD = (const float*)(c.ws + WS_MOD); bf16_t* H1 = (bf16_t*)(c.ws + WS_H1);
    for (int row = c.bid * NWAVE + c.wave; row < T; row += c.G * NWAVE) {
        const float* src = row < TL ? p.in[0] + (size_t)row * D : p.in[2] + (size_t)(row - TL) * D;
        const float* m = MOD + (size_t)mod_batch(row) * 6144;
#pragma unroll
        for (int j = 0; j < 4; ++j) { const int col = 4 * c.lane + 256 * j;
            const f32x4 x = *(const f32x4*)(src + col), sh = *(const f32x4*)(m + col), s = *(const f32x4*)(m + 1024 + col);
            const f32x4 h = x * (s + 1.0f) + sh; u32x2 w; w.x = pk_bf16(h[0], h[1]); w.y = pk_bf16(h[2], h[3]);
            *(u32x2*)(H1 + (size_t)row * D + col) = w; }
    }
}

DI void phase_vstats(const Ctx& c) {
    const bf16_t* UV = (const bf16_t*)(c.ws + WS_R1); float* ST = (float*)(c.ws + WS_STATS);
    for (int row = c.bid * NWAVE + c.wave; row < T; row += c.G * NWAVE) {
        const bf16_t* vp = UV + (size_t)row * 2048 + 1024;
        const u32x4 a = *(const u32x4*)(vp + 8 * c.lane), b = *(const u32x4*)(vp + 512 + 8 * c.lane);
        float x[16];
#pragma unroll
        for (int j = 0; j < 4; ++j) { x[2 * j] = bf_lo(a[j]); x[2 * j + 1] = bf_hi(a[j]); x[8 + 2 * j] = bf_lo(b[j]); x[9 + 2 * j] = bf_hi(b[j]); }
        float s = 0.f;
#pragma unroll
        for (int j = 0; j < 16; ++j) s += x[j];
        const float mean = wave_sum(s) * (1.0f / 1024.0f);
        float q = 0.f;
#pragma unroll
        for (int j = 0; j < 16; ++j) { const float d = x[j] - mean; q += d * d; }
        const float var = wave_sum(q) * (1.0f / 1024.0f);
        if (c.lane == 0) { ST[2 * row] = mean; ST[2 * row + 1] = rsqrtf(var + LN_EPS); }
    }
}

DI void phase_spatial(const Ctx& c, int j) {
    const Params& p = *c.p; unsigned char* ws = c.ws;
    const bf16_t* UV = (const bf16_t*)(ws + WS_R1); const float* ST = (const float*)(ws + WS_STATS); bf16_t* Y = (bf16_t*)(ws + WS_R2);
    const bf16_t* WSB = (const bf16_t*)(ws + WS_WSB) + (size_t)j * 8 * 128 * 128;
    const float* ng = p.in[9] + j * 1024; const float* nb = p.in[10] + j * 1024; const float* bs = p.in[12] + j * 8 * 128;
    constexpr int LD = 136;
    bf16_t* WsL = (bf16_t*)c.smem;
    bf16_t* VnT = WsL + 128 * LD;
    const int tid = c.tid, lane = c.lane, w = c.wave, g = lane >> 4, cc = lane & 15;
    for (int u = c.bid; u < (T / 128) * 8; u += c.G) {
        const int chunk = u >> 3, h = u & 7, r0 = chunk * 128;
        __syncthreads();
        { const int cg8 = tid & 15; float gg[8], bb[8];
#pragma unroll
          for (int e = 0; e < 8; ++e) { gg[e] = ng[h * 128 + cg8 * 8 + e]; bb[e] = nb[h * 128 + cg8 * 8 + e]; }
#pragma unroll
          for (int i = 0; i < 4; ++i) { const int idx = i * 512 + tid, tok = idx >> 4;
              const u32x4 v = *(const u32x4*)(UV + (size_t)(r0 + tok) * 2048 + 1024 + h * 128 + cg8 * 8);
              const float mean = ST[2 * (r0 + tok)], rstd = ST[2 * (r0 + tok) + 1];
              float x[8];
#pragma unroll
              for (int e = 0; e < 4; ++e) { x[2 * e] = bf_lo(v[e]); x[2 * e + 1] = bf_hi(v[e]); }
#pragma unroll
              for (int e = 0; e < 8; ++e) VnT[(cg8 * 8 + e) * LD + tok] = f2bf((x[e] - mean) * rstd * gg[e] + bb[e]);
              const int pp = idx >> 4;
              *(u32x4*)(WsL + pp * LD + cg8 * 8) = *(const u32x4*)(WSB + ((size_t)h * 128 + pp) * 128 + cg8 * 8); } }
        __syncthreads();
        f32x4 acc[8];
#pragma unroll
        for (int ct = 0; ct < 8; ++ct) acc[ct] = (f32x4){0.f, 0.f, 0.f, 0.f};
#pragma unroll
        for (int ks = 0; ks < 4; ++ks) {
            const bf16x8 bfr = frag_ld(WsL, LD, 16 * w, 32 * ks, lane);
#pragma unroll
            for (int ct = 0; ct < 8; ++ct) acc[ct] = mfma16(frag_ld(VnT, LD, 16 * ct, 32 * ks, lane), bfr, acc[ct]);
        }
        const int pp = 16 * w + cc; const float bsv = bs[h * 128 + pp];
        const size_t rowo = (size_t)(r0 + pp);
#pragma unroll
        for (int ct = 0; ct < 8; ++ct) { const int ch = h * 128 + 16 * ct + 4 * g;
            const u32x2 uu = *(const u32x2*)(UV + rowo * 2048 + ch);
            const float y0 = bf_lo(uu.x) * (acc[ct][0] + bsv), y1 = bf_hi(uu.x) * (acc[ct][1] + bsv), y2 = bf_lo(uu.y) * (acc[ct][2] + bsv), y3 = bf_hi(uu.y) * (acc[ct][3] + bsv);
            u32x2 o; o.x = pk_bf16(y0, y1); o.y = pk_bf16(y2, y3);
            *(u32x2*)(Y + rowo * D + ch) = o; }
    }
}

DI void phase_ln1(const Ctx& c, int L) {
    const Params& p = *c.p; bf16_t* XS = (bf16_t*)(c.ws + WS_XS); const float* MOD = (const float*)(c.ws + WS_MOD) + (size_t)L * 17 * 6144;
    bf16_t* H2 = (bf16_t*)(c.ws + WS_R2 + SZ_T1K);
    const float* lg = p.in[6] + (size_t)(L * 2 + 0) * D; const float* lb = p.in[7] + (size_t)(L * 2 + 0) * D;
    const int nrows = (L == DEPTH - 1) ? TL : T, stride = c.G * NWAVE;
    for (int row0 = c.bid * NWAVE + c.wave; row0 < nrows; row0 += 2 * stride) {
        const bool has2 = row0 + stride < nrows; const int rows[2] = {row0, has2 ? row0 + stride : row0};
        u32x2 v[2][4];
#pragma unroll
        for (int rr = 0; rr < 2; ++rr)
#pragma unroll
            for (int j = 0; j < 4; ++j) v[rr][j] = *(const u32x2*)(XS + (size_t)rows[rr] * D + 4 * c.lane + 256 * j);
#pragma unroll
        for (int rr = 0; rr < 2; ++rr) {
            if (rr == 1 && !has2) break;
            const int row = rows[rr]; bf16_t* xp = XS + (size_t)row * D; const float* m = MOD + (size_t)mod_batch(row) * 6144;
            f32x4 x[4]; float s = 0.f;
#pragma unroll
            for (int j = 0; j < 4; ++j) { x[j] = (f32x4){bf_lo(v[rr][j].x), bf_hi(v[rr][j].x), bf_lo(v[rr][j].y), bf_hi(v[rr][j].y)}; s += (x[j][0] + x[j][1]) + (x[j][2] + x[j][3]); }
            const float mean = wave_sum(s) * (1.0f / 1024.0f);
            float q = 0.f;
#pragma unroll
            for (int j = 0; j < 4; ++j) { const f32x4 d = x[j] - mean; q += (d[0] * d[0] + d[1] * d[1]) + (d[2] * d[2] + d[3] * d[3]); }
            const float rstd = rsqrtf(wave_sum(q) * (1.0f / 1024.0f) + LN_EPS);
            f32x4 hv[4];
#pragma unroll
            for (int j = 0; j < 4; ++j) { const int col = 4 * c.lane + 256 * j;
                const f32x4 y = (x[j] - mean) * rstd * *(const f32x4*)(lg + col) + *(const f32x4*)(lb + col);
                u32x2 xw; xw.x = pk_bf16(y[0], y[1]); xw.y = pk_bf16(y[2], y[3]);
                *(u32x2*)(xp + col) = xw;
                const f32x4 h = y * (*(const f32x4*)(m + 4 * 1024 + col) + 1.0f) + *(const f32x4*)(m + 3 * 1024 + col);
                u32x2 w; w.x = pk_bf16(h[0], h[1]); w.y = pk_bf16(h[2], h[3]);
                *(u32x2*)(H2 + (size_t)row * D + col) = w; hv[j] = h; }
            float am = 0.f;
#pragma unroll
            for (int j = 0; j < 4; ++j) am = fmaxf(am, fmaxf(fmaxf(fabsf(hv[j][0]), fabsf(hv[j][1])), fmaxf(fabsf(hv[j][2]), fabsf(hv[j][3]))));
            am = fmaxf(wave_max(am), 1e-30f); const float sx = am * (1.0f / 119.0f), isx = 119.0f / am;
#pragma unroll
            for (int j = 0; j < 4; ++j) { unsigned th = 0, tl = 0;
#pragma unroll
                for (int e = 0; e < 4; ++e) { const int x8 = (int)rintf(hv[j][e] * isx); const int xl = ((x8 + 8) & 15) - 8, xh = (x8 - xl) >> 4; th |= ((unsigned)xh & 15u) << (4 * e); tl |= ((unsigned)xl & 15u) << (4 * e); }
                const size_t bo = (size_t)row * 512 + (256 * j + 4 * c.lane) / 2;
                *(unsigned short*)(c.ws + WS_XH + bo) = (unsigned short)th; *(unsigned short*)(c.ws + WS_XL + bo) = (unsigned short)tl; }
            if (c.lane == 0) ((float*)(c.ws + WS_SX))[row] = sx;
        }
    }
}

DI int f2key(float v) { const int i = __float_as_int(v); return i ^ ((i >> 31) & 0x7fffffff); }
DI float key2f(int k) { return __int_as_float(k ^ ((k >> 31) & 0x7fffffff)); }
DI void phase_route(const Ctx& c, int L) {
    const Params& p = *c.p; unsigned char* ws = c.ws; const int lane = c.lane, g = lane >> 4, cc = lane & 15;
    constexpr int LDK = 72, LDS_S = 20;
    bf16_t* keysHi = (bf16_t*)c.smem;
    bf16_t* keysLo = keysHi + 2 * 128 * LDK;
    float* sbase = (float*)(keysLo + 2 * 128 * LDK);
    unsigned* ilist = (unsigned*)(sbase + NWAVE * 64 * LDS_S);
    __syncthreads();
    { const float* gk = p.in[20] + (size_t)L * 2 * 128 * 64;
      f32x4 kv[8];
#pragma unroll
      for (int it = 0; it < 8; ++it) kv[it] = ((const f32x4*)gk)[it * NTHR + c.tid];
#pragma unroll
      for (int it = 0; it < 8; ++it) { const int i = (it * NTHR + c.tid) * 4, row = i >> 6, d = i & 63; unsigned hi[2], lo[2];
#pragma unroll
          for (int e = 0; e < 2; ++e) { const unsigned ph = pk_bf16(kv[it][2 * e], kv[it][2 * e + 1]); hi[e] = ph; lo[e] = pk_bf16(kv[it][2 * e] - bf_lo(ph), kv[it][2 * e + 1] - bf_hi(ph)); }
          *(u32x2*)(keysHi + row * LDK + d) = (u32x2){hi[0], hi[1]}; *(u32x2*)(keysLo + row * LDK + d) = (u32x2){lo[0], lo[1]}; } }
    __syncthreads();
    float* S = sbase + c.wave * 64 * LDS_S;
    const bf16_t* QP = (const bf16_t*)(ws + WS_R1); int* IDX = (int*)(ws + WS_R1 + SZ_T1K); float* WT = (float*)(ws + WS_R1 + SZ_T1K + (size_t)T * 128 * 4);
    unsigned* myl = ilist + c.tid * 8; const unsigned char* mylb = (const unsigned char*)myl;
    const int ntask = (((L == DEPTH - 1) ? TL : T) / 64) * 8;
    for (int task = c.bid * NWAVE + c.wave; task < ntask; task += c.G * NWAVE) {
        const int t0 = (task >> 3) * 64, h = task & 7, tok = t0 + lane;
        float t12[2][16];
#pragma unroll
        for (int half = 0; half < 2; ++half) {
            bf16x8 aq[4][2];
#pragma unroll
            for (int mt = 0; mt < 4; ++mt)
#pragma unroll
                for (int ks = 0; ks < 2; ++ks) aq[mt][ks] = *(const bf16x8*)(QP + (size_t)(t0 + 16 * mt + cc) * D + h * 128 + half * 64 + 32 * ks + 8 * g);
            const bf16_t* kh = keysHi + half * 128 * LDK; const bf16_t* kl = keysLo + half * 128 * LDK;
#pragma unroll
            for (int i = 0; i < 16; ++i) t12[half][i] = -3.0e38f;
            for (int nt = 0; nt < 8; ++nt) {
                const bf16x8 bh0 = frag_ld(kh, LDK, 16 * nt, 0, lane), bh1 = frag_ld(kh, LDK, 16 * nt, 32, lane), bl0 = frag_ld(kl, LDK, 16 * nt, 0, lane), bl1 = frag_ld(kl, LDK, 16 * nt, 32, lane);
#pragma unroll
                for (int mt = 0; mt < 4; ++mt) { f32x4 a = {0.f, 0.f, 0.f, 0.f};
                    a = mfma16(aq[mt][0], bl0, a); a = mfma16(aq[mt][1], bl1, a); a = mfma16(aq[mt][0], bh0, a); a = mfma16(aq[mt][1], bh1, a);
#pragma unroll
                    for (int r = 0; r < 4; ++r) S[(16 * mt + 4 * g + r) * LDS_S + cc] = a[r]; }
                f32x4 sc[4];
#pragma unroll
                for (int q4 = 0; q4 < 4; ++q4) sc[q4] = *(const f32x4*)(S + lane * LDS_S + 4 * q4);
#pragma unroll
                for (int kk = 0; kk < 16; ++kk) { const float key = __int_as_float((__float_as_int(sc[kk >> 2][kk & 3]) & ~127) | (127 - (16 * nt + kk)));
#pragma unroll
                    for (int i = 15; i >= 1; --i) t12[half][i] = __builtin_amdgcn_fmed3f(key, t12[half][i - 1], t12[half][i]);
                    t12[half][0] = __builtin_amdgcn_fmed3f(key, 3.0e38f, t12[half][0]); }
            }
        }
        float v1[16], v2[16];
#pragma unroll
        for (int i = 0; i < 16; ++i) { v1[i] = __int_as_float(__float_as_int(t12[0][i]) & ~127); v2[i] = __int_as_float(__float_as_int(t12[1][i]) & ~127); }
#pragma unroll
        for (int i = 0; i < 4; ++i) {
            myl[i] = (unsigned)(127 - (__float_as_int(t12[0][4 * i]) & 127)) | ((unsigned)(127 - (__float_as_int(t12[0][4 * i + 1]) & 127)) << 8) | ((unsigned)(127 - (__float_as_int(t12[0][4 * i + 2]) & 127)) << 16) | ((unsigned)(127 - (__float_as_int(t12[0][4 * i + 3]) & 127)) << 24);
            myl[4 + i] = (unsigned)(127 - (__float_as_int(t12[1][4 * i]) & 127)) | ((unsigned)(127 - (__float_as_int(t12[1][4 * i + 1]) & 127)) << 8) | ((unsigned)(127 - (__float_as_int(t12[1][4 * i + 2]) & 127)) << 16) | ((unsigned)(127 - (__float_as_int(t12[1][4 * i + 3]) & 127)) << 24); }
        float f[16];
#pragma unroll
        for (int i = 0; i < 16; ++i) f[i] = -3.0e38f;
#pragma unroll
        for (int a = 0; a < 16; ++a)
#pragma unroll
            for (int b = 0; b < 16; ++b)
                if ((a + 1) * (b + 1) <= 16) {
                    const float key = __int_as_float((__float_as_int(v1[a] + v2[b]) & ~255) | (255 - (a * 16 + b)));
#pragma unroll
                    for (int i = 15; i >= 1; --i) f[i] = __builtin_amdgcn_fmed3f(key, f[i - 1], f[i]);
                    f[0] = __builtin_amdgcn_fmed3f(key, 3.0e38f, f[0]);
                }
        float e[16], se = 0.f; int fi[16];
        const float vmax = __int_as_float(__float_as_int(f[0]) & ~255);
#pragma unroll
        for (int i = 0; i < 16; ++i) { const int code = 255 - (__float_as_int(f[i]) & 255); fi[i] = (int)mylb[code >> 4] * 128 + (int)mylb[16 + (code & 15)];
            e[i] = __expf(__int_as_float(__float_as_int(f[i]) & ~255) - vmax); se += e[i]; }
        const float inv = 1.0f / se;
        int* ip = IDX + (size_t)tok * 128 + h * 16; float* wp = WT + (size_t)tok * 128 + h * 16;
#pragma unroll
        for (int i = 0; i < 16; i += 4) { *(int4*)(ip + i) = make_int4(fi[i], fi[i + 1], fi[i + 2], fi[i + 3]); *(f32x4*)(wp + i) = (f32x4){e[i] * inv, e[i + 1] * inv, e[i + 2] * inv, e[i + 3] * inv}; }
    }
}

DI float red8(float p) { p += dpp_mov<0xB1>(p); p += dpp_mov<0x4E>(p); p += dpp_mov<0x141>(p); return p; }
DI void phase_experts(const Ctx& c, int L) {
    const Params& p = *c.p; unsigned char* ws = c.ws; const int lane = c.lane, g8 = lane >> 3, j = lane & 7;
    constexpr int MAXTOK = 18;
    const bf16_t* H2 = (const bf16_t*)(ws + WS_R2 + SZ_T1K);
    const int* IDX = (const int*)(ws + WS_R1 + SZ_T1K); const float* WT = (const float*)(ws + WS_R1 + SZ_T1K + (size_t)T * 128 * 4);
    bf16_t* FFN = (bf16_t*)(ws + WS_R1);
    const unsigned char* UT = ws + WS_UT + (size_t)L * NEXP * 512; const unsigned char* VT = ws + WS_VT + (size_t)L * NEXP * 512;
    const float* SU = (const float*)(ws + WS_SU) + (size_t)L * NEXP; const float* SV = (const float*)(ws + WS_SV) + (size_t)L * NEXP;
    bf16_t* XS = (bf16_t*)(ws + WS_XS); bf16_t* H1 = (bf16_t*)(ws + WS_H1);
    const float* MOD = (const float*)(ws + WS_MOD) + (size_t)L * 17 * 6144;
    const float* lg = p.in[6] + (size_t)(L * 2 + 1) * D; const float* lb = p.in[7] + (size_t)(L * 2 + 1) * D;
    const int nrows = (L == DEPTH - 1) ? TL : T;
    float* ZL = (float*)c.smem + c.wave * MAXTOK * 128;
    unsigned short* IL = (unsigned short*)(c.smem + NWAVE * MAXTOK * 128 * 4) + c.wave * MAXTOK * 128;
    const int GW = c.G * NWAVE, gw = c.bid * NWAVE + c.wave;
    const int tsrc = 8 * (lane & 7) + (lane >> 3);
    for (int base = 0; base < nrows; base += GW * MAXTOK) {
        int ntok = (nrows - base - gw + GW - 1) / GW; ntok = ntok < 0 ? 0 : (ntok > MAXTOK ? MAXTOK : ntok);
        const int klast = ntok > 0 ? ntok - 1 : 0;
        if (ntok > 0) {
            for (int k0 = 0; k0 < MAXTOK; k0 += 6) { int iv[6][2];
#pragma unroll
                for (int kk = 0; kk < 6; ++kk) { const int kc = (k0 + kk < ntok) ? k0 + kk : klast; const size_t tb = (size_t)(base + gw + GW * kc) * 128; iv[kk][0] = IDX[tb + lane]; iv[kk][1] = IDX[tb + 64 + lane]; }
#pragma unroll
                for (int kk = 0; kk < 6; ++kk) { IL[(k0 + kk) * 128 + lane] = (unsigned short)iv[kk][0]; IL[(k0 + kk) * 128 + 64 + lane] = (unsigned short)iv[kk][1]; } }
        }
        for (int c4 = 0; c4 < 4; ++c4) {
            const unsigned char* Ub = UT + (size_t)c4 * NEXP * 128 + 16 * j;
            const unsigned char* XHb = ws + WS_XH + 128 * c4 + 16 * j; const unsigned char* XLb = ws + WS_XL + 128 * c4 + 16 * j;
            u32x4 rA[8], rB[8], xh, xl, nxh, nxl;
#define U_LOADX(k_) do { const size_t to_ = (size_t)(base + gw + GW * (k_)) * 512; nxh = *(const u32x4*)(XHb + to_); nxl = *(const u32x4*)(XLb + to_); } while (0)
#define U_ISSUE(R, k_, hf_) do { _Pragma("unroll") for (int i = 0; i < 8; ++i) { const unsigned e = IL[(k_) * 128 + 64 * (hf_) + 8 * i + g8]; R[i] = *(const u32x4*)(Ub + (size_t)e * 128); } } while (0)
#define U_COMPUTE(R, k_, hf_) do { int ra = 0; \
                _Pragma("unroll") for (int i = 0; i < 8; ++i) { int ah = 0, al = 0; \
                    _Pragma("unroll") for (int q = 0; q < 4; ++q) { ah = __builtin_amdgcn_sdot8((int)R[i][q], (int)xh[q], ah, false); al = __builtin_amdgcn_sdot8((int)R[i][q], (int)xl[q], al, false); } \
                    int zi = ah * 16 + al; \
                    zi += __builtin_amdgcn_mov_dpp(zi, 0xB1, 0xf, 0xf, true); zi += __builtin_amdgcn_mov_dpp(zi, 0x4E, 0xf, 0xf, true); zi += __builtin_amdgcn_mov_dpp(zi, 0x141, 0xf, 0xf, true); \
                    ra = (j == i) ? zi : ra; } \
                const float za = (float)__shfl(ra, tsrc, 64); \
                if (c4 == 0) ZL[(k_) * 128 + 64 * (hf_) + lane] = za; else ZL[(k_) * 128 + 64 * (hf_) + lane] += za; } while (0)
            if (ntok > 0) { U_LOADX(0); U_ISSUE(rA, 0, 0); }
            for (int k = 0; k < ntok; ++k) {
                const int kn = (k + 1 < ntok) ? k + 1 : k;
                U_ISSUE(rB, k, 1);
                xh = nxh; xl = nxl;
                U_COMPUTE(rA, k, 0);
                U_LOADX(kn); U_ISSUE(rA, kn, 0);
                U_COMPUTE(rB, k, 1);
            }
#undef U_LOADX
#undef U_ISSUE
#undef U_COMPUTE
        }
        if (ntok > 0) {
            for (int k0 = 0; k0 < MAXTOK; k0 += 6) { float wv[6][2], su[6][2], sv[6][2], sxv[6];
#pragma unroll
                for (int kk = 0; kk < 6; ++kk) { const int kc = (k0 + kk < ntok) ? k0 + kk : klast; const size_t tb = (size_t)(base + gw + GW * kc) * 128; sxv[kk] = ((const float*)(ws + WS_SX))[base + gw + GW * kc];
#pragma unroll
                    for (int hh = 0; hh < 2; ++hh) { const unsigned e = IL[kc * 128 + 64 * hh + lane]; wv[kk][hh] = WT[tb + 64 * hh + lane]; su[kk][hh] = SU[e]; sv[kk][hh] = SV[e]; } }
#pragma unroll
                for (int kk = 0; kk < 6; ++kk) { const int kc = (k0 + kk < ntok) ? k0 + kk : klast;
                    if (k0 + kk < ntok) {
#pragma unroll
                        for (int hh = 0; hh < 2; ++hh) ZL[kc * 128 + 64 * hh + lane] = gelu_tanh(ZL[kc * 128 + 64 * hh + lane] * (su[kk][hh] * sxv[kk])) * wv[kk][hh] * sv[kk][hh]; } } }
        }
        for (int c4 = 0; c4 < 4; ++c4) {
            const unsigned char* Vb = VT + (size_t)c4 * NEXP * 128 + 16 * j;
            const bool hi8 = (lane & 8) != 0;
            u32x4 rA[8], rB[8];
            f32x2 o[16];
#define V_ISSUE(R, k_, hf_) do { _Pragma("unroll") for (int i = 0; i < 8; ++i) { const unsigned e = IL[(k_) * 128 + 64 * (hf_) + 8 * i + g8]; R[i] = *(const u32x4*)(Vb + (size_t)e * 128); } } while (0)
#define V_ACC(R, k_, hf_) do { float av[8]; \
                _Pragma("unroll") for (int i = 0; i < 8; ++i) av[i] = ZL[(k_) * 128 + 64 * (hf_) + 8 * i + g8]; \
                _Pragma("unroll") for (int i = 0; i < 8; ++i) { const f32x2 a2 = {av[i], av[i]}; \
                    _Pragma("unroll") for (int q = 0; q < 4; ++q) { \
                        o[4 * q] += a2 * __builtin_amdgcn_cvt_scalef32_pk_f32_fp4(R[i][q], 1.0f, 0); o[4 * q + 1] += a2 * __builtin_amdgcn_cvt_scalef32_pk_f32_fp4(R[i][q], 1.0f, 1); \
                        o[4 * q + 2] += a2 * __builtin_amdgcn_cvt_scalef32_pk_f32_fp4(R[i][q], 1.0f, 2); o[4 * q + 3] += a2 * __builtin_amdgcn_cvt_scalef32_pk_f32_fp4(R[i][q], 1.0f, 3); } } } while (0)
#define V_FINISH(k_) do { const int tok_ = base + gw + GW * (k_); \
                f32x2 q8[8]; \
                _Pragma("unroll") for (int m = 0; m < 8; ++m) { \
                    const auto s0 = __builtin_amdgcn_permlane32_swap(__float_as_uint(o[m][0]), __float_as_uint(o[m + 8][0]), false, false); \
                    const auto s1 = __builtin_amdgcn_permlane32_swap(__float_as_uint(o[m][1]), __float_as_uint(o[m + 8][1]), false, false); \
                    q8[m] = (f32x2){__uint_as_float(s0[0]) + __uint_as_float(s0[1]), __uint_as_float(s1[0]) + __uint_as_float(s1[1])}; } \
                f32x2 q4[4]; \
                _Pragma("unroll") for (int m = 0; m < 4; ++m) { \
                    const auto s0 = __builtin_amdgcn_permlane16_swap(__float_as_uint(q8[m][0]), __float_as_uint(q8[m + 4][0]), false, false); \
                    const auto s1 = __builtin_amdgcn_permlane16_swap(__float_as_uint(q8[m][1]), __float_as_uint(q8[m + 4][1]), false, false); \
                    q4[m] = (f32x2){__uint_as_float(s0[0]) + __uint_as_float(s0[1]), __uint_as_float(s1[0]) + __uint_as_float(s1[1])}; } \
                float fo[4]; \
                _Pragma("unroll") for (int m = 0; m < 2; ++m) { \
                    const float k0 = hi8 ? q4[m + 2][0] : q4[m][0], k1 = hi8 ? q4[m + 2][1] : q4[m][1], t0 = hi8 ? q4[m][0] : q4[m + 2][0], t1 = hi8 ? q4[m][1] : q4[m + 2][1]; \
                    fo[2 * m] = k0 + dpp_mov<0x128>(t0); fo[2 * m + 1] = k1 + dpp_mov<0x128>(t1); } \
                u32x2 w_; w_.x = pk_bf16(fo[0], fo[1]); w_.y = pk_bf16(fo[2], fo[3]); \
                *(u32x2*)(FFN + (size_t)tok_ * D + 256 * c4 + 32 * j + 4 * g8) = w_; } while (0)
            if (ntok > 0) V_ISSUE(rA, 0, 0);
            for (int k = 0; k < ntok; ++k) {
                V_ISSUE(rB, k, 1);
#pragma unroll
                for (int q = 0; q < 16; ++q) o[q] = (f32x2){0.f, 0.f};
                V_ACC(rA, k, 0);
                V_ISSUE(rA, ((k + 1 < ntok) ? k + 1 : k), 0);
                V_ACC(rB, k, 1);
                V_FINISH(k);
            }
#undef V_ISSUE
#undef V_ACC
#undef V_FINISH
        }
        asm volatile("s_waitcnt vmcnt(0)" ::: "memory");
        u32x4 nfa, nfb, nxa, nxb;
        { const int row0 = base + gw + GW * 0 < nrows ? base + gw : 0; nfa = *(const u32x4*)(FFN + (size_t)row0 * D + 16 * lane); nfb = *(const u32x4*)(FFN + (size_t)row0 * D + 16 * lane + 8);
          nxa = *(const u32x4*)(XS + (size_t)row0 * D + 16 * lane); nxb = *(const u32x4*)(XS + (size_t)row0 * D + 16 * lane + 8); }
        for (int k = 0; k < ntok; ++k) { const int row = base + gw + GW * k;
            bf16_t* xp = XS + (size_t)row * D + 16 * lane; const int mb = mod_batch(row); const float* m = MOD + (size_t)mb * 6144 + 16 * lane;
            const u32x4 fa = nfa, fb = nfb, xa = nxa, xb = nxb;
            { const int rn = base + gw + GW * ((k + 1 < ntok) ? k + 1 : k);
              nfa = *(const u32x4*)(FFN + (size_t)rn * D + 16 * lane); nfb = *(const u32x4*)(FFN + (size_t)rn * D + 16 * lane + 8);
              nxa = *(const u32x4*)(XS + (size_t)rn * D + 16 * lane); nxb = *(const u32x4*)(XS + (size_t)rn * D + 16 * lane + 8); }
            float o[16], x1[16];
#pragma unroll
            for (int q = 0; q < 4; ++q) { o[2 * q] = bf_lo(fa[q]); o[2 * q + 1] = bf_hi(fa[q]); o[8 + 2 * q] = bf_lo(fb[q]); o[9 + 2 * q] = bf_hi(fb[q]);
                x1[2 * q] = bf_lo(xa[q]); x1[2 * q + 1] = bf_hi(xa[q]); x1[8 + 2 * q] = bf_lo(xb[q]); x1[9 + 2 * q] = bf_hi(xb[q]); }
            float y[16]; float s = 0.f;
#pragma unroll
            for (int qd = 0; qd < 4; ++qd) { const f32x4 g2 = *(const f32x4*)(m + 5 * 1024 + 4 * qd);
#pragma unroll
                for (int e = 0; e < 4; ++e) { y[4 * qd + e] = DN_ALPHA * x1[4 * qd + e] + g2[e] * o[4 * qd + e]; s += y[4 * qd + e]; } }
            const float mean = wave_sum(s) * (1.0f / 1024.0f);
            float q = 0.f;
#pragma unroll
            for (int e = 0; e < 16; ++e) { const float d = y[e] - mean; q += d * d; }
            const float rstd = rsqrtf(wave_sum(q) * (1.0f / 1024.0f) + LN_EPS);
            const float* mn = (const float*)(ws + WS_MOD) + (size_t)(L + 1 < DEPTH ? L + 1 : L) * 17 * 6144 + (size_t)mb * 6144 + 16 * lane;
            float x2[16];
#pragma unroll
            for (int qd = 0; qd < 4; ++qd) { const int col = 16 * lane + 4 * qd;
                const f32x4 gg = *(const f32x4*)(lg + col), bb = *(const f32x4*)(lb + col);
#pragma unroll
                for (int e = 0; e < 4; ++e) x2[4 * qd + e] = (y[4 * qd + e] - mean) * rstd * gg[e] + bb[e]; }
            if (L == DEPTH - 1) {
#pragma unroll
                for (int qd = 0; qd < 4; ++qd) *(f32x4*)(p.out + (size_t)row * D + 16 * lane + 4 * qd) = (f32x4){x2[4 * qd], x2[4 * qd + 1], x2[4 * qd + 2], x2[4 * qd + 3]};
            } else {
                float hh[16];
#pragma unroll
                for (int qd = 0; qd < 4; ++qd) { const f32x4 s1 = *(const f32x4*)(mn + 1024 + 4 * qd), sh = *(const f32x4*)(mn + 4 * qd);
#pragma unroll
                    for (int e = 0; e < 4; ++e) hh[4 * qd + e] = x2[4 * qd + e] * (s1[e] + 1.0f) + sh[e]; }
#pragma unroll
                for (int hf = 0; hf < 2; ++hf) { u32x4 wx, wh;
#pragma unroll
                    for (int q2 = 0; q2 < 4; ++q2) { wx[q2] = pk_bf16(x2[8 * hf + 2 * q2], x2[8 * hf + 2 * q2 + 1]); wh[q2] = pk_bf16(hh[8 * hf + 2 * q2], hh[8 * hf + 2 * q2 + 1]); }
                    *(u32x4*)(xp + 8 * hf) = wx; *(u32x4*)(H1 + (size_t)row * D + 16 * lane + 8 * hf) = wh; }
            }
        }
    }
}

DI float logsig2_16(float z) { const float zl = z * 1.4426950408889634f; return (fminf(zl, 0.f) - __builtin_amdgcn_logf(1.0f + __builtin_amdgcn_exp2f(-fabsf(zl)))) * (1.0f / 16.0f); }
template <int DIR>
DI float gla_prep_gates(const bf16_t* Qt, const bf16_t* Kt, bf16_t* OUT, const float* gl, const float (&wg)[16], float bias, int cl, unsigned (&kpk)[32]) {
    constexpr int dir = DIR;
    { int z_ = 0; asm volatile("" : "+v"(z_)); gl += z_; }
    float cum = 0.f;
#pragma unroll
        for (int blk = 0; blk < 8; ++blk) {
            float gs[8];
#pragma unroll
            for (int e = 0; e < 8; ++e) { const int i = (dir ? 56 - 8 * blk : 8 * blk) + e; float z = bias; const f32x4* gp = (const f32x4*)(gl + i * 32 + dir * 16);
#pragma unroll
                for (int r4 = 0; r4 < 4; ++r4) { const f32x4 gv = gp[r4]; z += gv[0] * wg[4 * r4] + gv[1] * wg[4 * r4 + 1] + gv[2] * wg[4 * r4 + 2] + gv[3] * wg[4 * r4 + 3]; }
                gs[e] = logsig2_16(z); }
            float kiv[8];
#pragma unroll
            for (int e = 0; e < 8; ++e) { const int pos = dir ? 7 - e : e, i = (dir ? 56 - 8 * blk : 8 * blk) + pos;
                cum += gs[pos];
                const float qv = bf1(Qt[i * 256 + cl]), kv = bf1(Kt[i * 256 + cl]);
                OUT[(dir * 64 + i) * 256 + cl] = f2bf(qv * __builtin_amdgcn_exp2f(cum)); kiv[pos] = kv * __builtin_amdgcn_exp2f(-cum); }
            u32x4 w; w.x = pk_bf16(kiv[0], kiv[1]); w.y = pk_bf16(kiv[2], kiv[3]); w.z = pk_bf16(kiv[4], kiv[5]); w.w = pk_bf16(kiv[6], kiv[7]);
            if (dir) { kpk[4 * (7 - blk)] = w.x; kpk[4 * (7 - blk) + 1] = w.y; kpk[4 * (7 - blk) + 2] = w.z; kpk[4 * (7 - blk) + 3] = w.w; }
            else { kpk[4 * blk] = w.x; kpk[4 * blk + 1] = w.y; kpk[4 * blk + 2] = w.z; kpk[4 * blk + 3] = w.w; }
            __builtin_amdgcn_sched_barrier(0);
        }
    return cum;
}
DI void phase_gla_prep(const Ctx& c, int j) {
    const Params& p = *c.p; unsigned char* ws = c.ws; const int tid = c.tid;
    const bf16_t* QG = (const bf16_t*)(ws + WS_R1); const bf16_t* KG = (const bf16_t*)(ws + WS_R1 + SZ_T512); const bf16_t* VG = (const bf16_t*)(ws + WS_R1 + 2 * SZ_T512);
    const float* GL = (const float*)(ws + WS_GL); float* DEC = (float*)(ws + WS_DEC); bf16_t* VTt = (bf16_t*)(ws + WS_VTT);
    bf16_t* Qt = (bf16_t*)c.smem;
    bf16_t* Kt = Qt + 64 * 256;
    bf16_t* OUT = Kt + 64 * 256;
    float* gl = (float*)(c.smem + 131072);
    const int dir = __builtin_amdgcn_readfirstlane(tid >> 8), cl = tid & 255;
    for (int u = c.bid; u < (T / 64) * 2; u += c.G) {
        const int ch = u >> 1, hc = u & 1, r0 = ch * 64, cg = 256 * hc + cl;
        __syncthreads();
#pragma unroll
        for (int it = 0; it < 4; ++it) { const int idx = it * 512 + tid, row = idx >> 5, c8 = (idx & 31) * 8;
            *(u32x4*)(Qt + row * 256 + c8) = *(const u32x4*)(QG + (size_t)(r0 + row) * 512 + 256 * hc + c8);
            *(u32x4*)(Kt + row * 256 + c8) = *(const u32x4*)(KG + (size_t)(r0 + row) * 512 + 256 * hc + c8); }
        ((f32x4*)gl)[tid] = ((const f32x4*)(GL + (size_t)r0 * 32))[tid];
        float wg[16];
#pragma unroll
        for (int r = 0; r < 16; ++r) wg[r] = p.in[15][((size_t)(j * 2 + dir) * 16 + r) * 512 + cg];
        const float bias = p.in[16][(size_t)(j * 2 + dir) * 512 + cg];
        __syncthreads();
        unsigned kpk[32];
        const float cum = dir ? gla_prep_gates<1>(Qt, Kt, OUT, gl, wg, bias, cl, kpk) : gla_prep_gates<0>(Qt, Kt, OUT, gl, wg, bias, cl, kpk);
        DEC[((size_t)dir * (T / 64) + ch) * 512 + cg] = __builtin_amdgcn_exp2f(cum);
        __syncthreads();
#pragma unroll 2
        for (int it = 0; it < 8; ++it) { const int idx = it * 512 + tid, d2 = idx >> 11, row = (idx >> 5) & 63, c8 = (idx & 31) * 8;
            *(u32x4*)((bf16_t*)(ws + WS_R2) + (size_t)d2 * T * 512 + (size_t)(r0 + row) * 512 + 256 * hc + c8) = *(const u32x4*)(OUT + (d2 * 64 + row) * 256 + c8); }
        bf16_t* KT = Qt;
#pragma unroll
        for (int cb = 0; cb < 8; ++cb) *(u32x4*)(KT + (dir * 256 + cl) * 64 + ((cb ^ (cl & 7)) * 8)) = (u32x4){kpk[4 * cb], kpk[4 * cb + 1], kpk[4 * cb + 2], kpk[4 * cb + 3]};
        __syncthreads();
#pragma unroll 2
        for (int it = 0; it < 8; ++it) { const int idx = it * 512 + tid, d2 = idx >> 11, clr = (idx >> 3) & 255, cb = idx & 7;
            *(u32x4*)((bf16_t*)(ws + WS_R2 + 2 * SZ_T1K) + (((size_t)d2 * (T / 64) + ch) * 512 + 256 * hc + clr) * 64 + cb * 8) = *(const u32x4*)(KT + (d2 * 256 + clr) * 64 + ((cb ^ (clr & 7)) * 8)); }
#pragma unroll
        for (int i2 = 0; i2 < 32; ++i2) { OUT[(dir * 64 + 2 * i2) * 256 + cl] = (bf16_t)(kpk[i2] & 0xffffu); OUT[(dir * 64 + 2 * i2 + 1) * 256 + cl] = (bf16_t)(kpk[i2] >> 16); }
        __syncthreads();
#pragma unroll 2
        for (int it = 0; it < 8; ++it) { const int idx = it * 512 + tid, d2 = idx >> 11, row = (idx >> 5) & 63, c8 = (idx & 31) * 8;
            *(u32x4*)((bf16_t*)(ws + WS_R2 + SZ_T1K) + (size_t)d2 * T * 512 + (size_t)(r0 + row) * 512 + 256 * hc + c8) = *(const u32x4*)(OUT + (d2 * 64 + row) * 256 + c8); }
        bf16_t* Vl = Qt;
#pragma unroll 2
        for (int it = 0; it < 8; ++it) { const int idx = it * 512 + tid, row = idx >> 6, c8 = (idx & 63) * 8;
            *(u32x4*)(Vl + row * 512 + c8) = *(const u32x4*)(VG + (size_t)(r0 + row) * 1024 + 512 * hc + c8); }
        __syncthreads();
        bf16_t* VTl = OUT;
#pragma unroll 2
        for (int cb = 0; cb < 8; ++cb) { unsigned short x[8];
#pragma unroll
            for (int t = 0; t < 8; ++t) x[t] = Vl[(8 * cb + t) * 512 + tid];
            u32x4 w; w.x = (unsigned)x[0] | ((unsigned)x[1] << 16); w.y = (unsigned)x[2] | ((unsigned)x[3] << 16); w.z = (unsigned)x[4] | ((unsigned)x[5] << 16); w.w = (unsigned)x[6] | ((unsigned)x[7] << 16);
            *(u32x4*)(VTl + tid * 64 + ((cb ^ (tid & 7)) * 8)) = w; }
        __syncthreads();
#pragma unroll 2
        for (int it = 0; it < 8; ++it) { const int idx = it * 512 + tid, er = idx >> 3, cb = idx & 7;
            *(u32x4*)(VTt + ((size_t)ch * 1024 + 512 * hc + er) * 64 + cb * 8) = *(const u32x4*)(VTl + er * 64 + ((cb ^ (er & 7)) * 8)); }
    }
}

DI void phase_gla_scan(const Ctx& c) {
    unsigned char* ws = c.ws; const int tid = c.tid, lane = c.lane, w = c.wave, g = lane >> 4, cc = lane & 15;
    const bf16_t* VTt = (const bf16_t*)(ws + WS_VTT); const float* DEC = (const float*)(ws + WS_DEC);
    constexpr int LDQ = 136, LDJ = 72;
    bf16_t* Qs = (bf16_t*)c.smem;
    bf16_t* Ks = Qs + 64 * LDQ;
    bf16_t* KEt = Ks + 64 * LDQ;
    bf16_t* Vt = KEt + 128 * LDJ;
    bf16_t* At = Vt + 128 * LDJ;
    bf16_t* St = At + 64 * LDJ;
    bf16_t* Ot = St + 128 * LDQ;
    float* dec = (float*)(Ot + 64 * LDQ);
    const int qtok0 = tid >> 4, qd8 = (tid & 15) * 8;
    const int ked0 = tid >> 3, kej8 = (tid & 7) * 8;
    for (int u = c.bid; u < NB * 4 * 2 * 2; u += c.G) {
        const int b = u >> 4, h = (u >> 2) & 3, es = (u >> 1) & 1, dir = u & 1;
        bf16_t* O = (bf16_t*)(ws + (dir ? WS_OB : WS_H1));
        const bf16_t* QIN = (const bf16_t*)(ws + WS_R2) + (size_t)dir * T * 512; const bf16_t* KIN = (const bf16_t*)(ws + WS_R2 + SZ_T1K) + (size_t)dir * T * 512;
        const bf16_t* KINt = (const bf16_t*)(ws + WS_R2 + 2 * SZ_T1K) + (size_t)dir * (T / 64) * 512 * 64;
        f32x4 accS[8];
#pragma unroll
        for (int et = 0; et < 8; ++et) accS[et] = (f32x4){0.f, 0.f, 0.f, 0.f};
        __syncthreads();
        for (int i = tid; i < 128 * LDQ / 2; i += NTHR) ((unsigned*)St)[i] = 0u;
        u32x4 pq[2], pk[2], pke[2], pv[2]; float pdec = 0.f;
#define GLA_R0(cs_) (dir == 0 ? ((cs_) < 4 ? TL + b * CTXL + 64 * (cs_) : b * SEQ + 64 * ((cs_) - 4)) : ((cs_) < 4 ? TL + b * CTXL + 64 * (3 - (cs_)) : b * SEQ + 64 * (35 - (cs_))))
#define GLA_LOAD(cs_) do { const int r0_ = GLA_R0(cs_); const int chunk_ = r0_ >> 6; \
            _Pragma("unroll") for (int it = 0; it < 2; ++it) { const size_t go = (size_t)(r0_ + qtok0 + 32 * it) * 512 + h * 128 + qd8; pq[it] = *(const u32x4*)(QIN + go); pk[it] = *(const u32x4*)(KIN + go); \
                pke[it] = *(const u32x4*)(KINt + ((size_t)chunk_ * 512 + h * 128 + ked0 + 64 * it) * 64 + kej8); \
                pv[it] = *(const u32x4*)(VTt + ((size_t)chunk_ * 1024 + h * 256 + es * 128 + ked0 + 64 * it) * 64 + kej8); } \
            if (tid < 128) pdec = DEC[((size_t)dir * (T / 64) + chunk_) * 512 + h * 128 + tid]; } while (0)
        GLA_LOAD(0);
        for (int cs = 0; cs < 36; ++cs) {
            const int r0 = GLA_R0(cs);
#pragma unroll
            for (int it = 0; it < 2; ++it) { *(u32x4*)(Qs + (qtok0 + 32 * it) * LDQ + qd8) = pq[it]; *(u32x4*)(Ks + (qtok0 + 32 * it) * LDQ + qd8) = pk[it];
                *(u32x4*)(KEt + (ked0 + 64 * it) * LDJ + kej8) = pke[it]; *(u32x4*)(Vt + (ked0 + 64 * it) * LDJ + kej8) = pv[it]; }
            if (tid < 128) dec[tid] = pdec;
            __syncthreads();
            GLA_LOAD(cs + 1 < 36 ? cs + 1 : cs);
            { const int it = w >> 1;
#pragma unroll
              for (int jj = 0; jj < 2; ++jj) { const int jt = 2 * (w & 1) + jj; f32x4 a = {0.f, 0.f, 0.f, 0.f};
#pragma unroll
                  for (int ks = 0; ks < 4; ++ks) a = mfma16(frag_ld(Qs, LDQ, 16 * it, 32 * ks, lane), frag_ld(Ks, LDQ, 16 * jt, 32 * ks, lane), a);
                  const int jcol = 16 * jt + cc;
#pragma unroll
                  for (int r = 0; r < 4; ++r) { const int i = 16 * it + 4 * g + r; const bool keep = dir ? (jcol >= i) : (jcol <= i);
                      At[i * LDJ + jcol] = f2bf(keep ? a[r] : 0.f); } } }
            __syncthreads();
            { const int it = w >> 1;
#pragma unroll
              for (int ee = 0; ee < 4; ++ee) { const int et = 4 * (w & 1) + ee; f32x4 a = {0.f, 0.f, 0.f, 0.f};
#pragma unroll
                  for (int ks = 0; ks < 2; ++ks) a = mfma16(frag_ld(At, LDJ, 16 * it, 32 * ks, lane), frag_ld(Vt, LDJ, 16 * et, 32 * ks, lane), a);
#pragma unroll
                  for (int ks = 0; ks < 4; ++ks) a = mfma16(frag_ld(Qs, LDQ, 16 * it, 32 * ks, lane), frag_ld(St, LDQ, 16 * et, 32 * ks, lane), a);
#pragma unroll
                  for (int r = 0; r < 4; ++r) Ot[(16 * it + 4 * g + r) * LDQ + 16 * et + cc] = f2bf(a[r]); } }
#pragma unroll
            for (int et = 0; et < 8; ++et) {
#pragma unroll
                for (int ks = 0; ks < 2; ++ks) accS[et] = mfma16(frag_ld(KEt, LDJ, 16 * w, 32 * ks, lane), frag_ld(Vt, LDJ, 16 * et, 32 * ks, lane), accS[et]);
#pragma unroll
                for (int r = 0; r < 4; ++r) accS[et][r] *= dec[16 * w + 4 * g + r];
            }
            __syncthreads();
#pragma unroll
            for (int et = 0; et < 8; ++et) { u32x2 sv; sv.x = pk_bf16(accS[et][0], accS[et][1]); sv.y = pk_bf16(accS[et][2], accS[et][3]);
                *(u32x2*)(St + (16 * et + cc) * LDQ + 16 * w + 4 * g) = sv; }
#pragma unroll
            for (int it = 0; it < 2; ++it) *(u32x4*)(O + (size_t)(r0 + qtok0 + 32 * it) * 1024 + h * 256 + es * 128 + qd8) = *(const u32x4*)(Ot + (qtok0 + 32 * it) * LDQ + qd8);
        }
#undef GLA_LOAD
#undef GLA_R0
    }
}

DI void phase_gla_readout(const Ctx& c, int j) {
    const Params& p = *c.p; unsigned char* ws = c.ws;
    const bf16_t* O = (const bf16_t*)(ws + WS_H1); const bf16_t* OB = (const bf16_t*)(ws + WS_OB); const bf16_t* RG = (const bf16_t*)(ws + WS_R1 + 2 * SZ_T512 + SZ_T1K); bf16_t* Y = (bf16_t*)(ws + WS_R2);
    const float* gn = p.in[17] + (size_t)j * 1024; const int stride = c.G * NWAVE;
    for (int row0 = c.bid * NWAVE + c.wave; row0 < T; row0 += 2 * stride) {
        const bool has2 = row0 + stride < T; const int rows[2] = {row0, has2 ? row0 + stride : row0};
        u32x2 ov[2][4], ow[2][4], rv[2][4];
#pragma unroll
        for (int rr = 0; rr < 2; ++rr)
#pragma unroll
            for (int hd = 0; hd < 4; ++hd) { const size_t o = (size_t)rows[rr] * D + 4 * c.lane + 256 * hd; ov[rr][hd] = *(const u32x2*)(O + o); ow[rr][hd] = *(const u32x2*)(OB + o); rv[rr][hd] = *(const u32x2*)(RG + o); }
#pragma unroll
        for (int rr = 0; rr < 2; ++rr) {
            if (rr == 1 && !has2) break;
#pragma unroll
            for (int hd = 0; hd < 4; ++hd) { const int col = 4 * c.lane + 256 * hd;
                const float x0 = bf_lo(ov[rr][hd].x) + bf_lo(ow[rr][hd].x), x1 = bf_hi(ov[rr][hd].x) + bf_hi(ow[rr][hd].x), x2 = bf_lo(ov[rr][hd].y) + bf_lo(ow[rr][hd].y), x3 = bf_hi(ov[rr][hd].y) + bf_hi(ow[rr][hd].y);
                const float mean = wave_sum((x0 + x1) + (x2 + x3)) * (1.0f / 256.0f);
                const float d0 = x0 - mean, d1 = x1 - mean, d2 = x2 - mean, d3 = x3 - mean;
                const float rstd = rsqrtf(wave_sum((d0 * d0 + d1 * d1) + (d2 * d2 + d3 * d3)) * (1.0f / 256.0f) + LN_EPS);
                const f32x4 gg = *(const f32x4*)(gn + col);
                const float r0 = bf_lo(rv[rr][hd].x), r1 = bf_hi(rv[rr][hd].x), r2 = bf_lo(rv[rr][hd].y), r3 = bf_hi(rv[rr][hd].y);
                u32x2 o; o.x = pk_bf16(d0 * rstd * gg[0] * silu_f(r0), d1 * rstd * gg[1] * silu_f(r1)); o.y = pk_bf16(d2 * rstd * gg[2] * silu_f(r2), d3 * rstd * gg[3] * silu_f(r3));
                *(u32x2*)(Y + (size_t)rows[rr] * D + col) = o; }
        }
    }
}

constexpr int N_PHASES = 2 + 2 * 8 + 2 * 9;

__global__ void __launch_bounds__(NTHR, 2) mega_fwd(Params p) {
    extern __shared__ __attribute__((aligned(16))) unsigned char smem[];
    cg::grid_group grid = cg::this_grid();
    Ctx c; c.p = &p; c.ws = p.ws; c.smem = smem; c.tid = threadIdx.x; c.lane = c.tid & 63; c.wave = __builtin_amdgcn_readfirstlane(c.tid >> 6); c.G = gridDim.x; c.bid = blockIdx.x;
    unsigned char* ws = p.ws;
    volatile LAS unsigned* xst = (volatile LAS unsigned*)((LAS unsigned char*)smem + (LDS_BYTES - 16));
    if (threadIdx.x == 0) { xst[0] = 0u; xst[1] = 0u; }
    __syncthreads();
    const XcdBarrier xbar = xcd_barrier_post((unsigned*)(ws + WS_CTL), xst);
    const int lo = p.ph_lo, hi = p.ph_hi;
    int ph = 0;
#ifndef PH_ONLY
#define PH_ONLY -1
#endif
#ifndef DUP_MASK
#define DUP_MASK 0
#endif
#define RUN1(...) { { int t_ = threadIdx.x; asm volatile("" : "+v"(t_)); c.tid = t_; c.lane = t_ & 63; c.wave = __builtin_amdgcn_readfirstlane(t_ >> 6); { size_t z_ = 0; asm volatile("" : "+s"(z_)); ws = p.ws + z_; } c.ws = ws; } __VA_ARGS__; }
#define RUN(id, ...) do { if ((PH_ONLY < 0 || PH_ONLY == (id)) && ph >= lo && ph < hi) { \
        RUN1(__VA_ARGS__) \
        if ((DUP_MASK >> (id)) & 1) { xcd_barrier(xbar); RUN1(__VA_ARGS__) } \
        if (ph + 1 < hi) { if (ph == 0) grid.sync(); else xcd_barrier(xbar); } } ++ph; } while (0)
    LAS unsigned char* lds = (LAS unsigned char*)smem;
    const float* MOD = (const float*)(ws + WS_MOD);

    RUN(0, phase_prologue(c));
    RUN(1, phase_mod0(c));
    for (int L = 0; L < DEPTH; ++L) {
        const int j = L >> 1;
        if ((L & 1) == 0) {
            RUN(2, { pg8::Gemm g{(const bf16_t*)(ws + WS_H1), (const bf16_t*)(ws + WS_WAIN) + (size_t)j * 2048 * 1024, T, 2048, 1024}; pg8::StaticOrder S; S.init(T, 2048, c.G, c.bid);
                  pg8::EpiBf16<1> E{(bf16_t*)(ws + WS_R1), 2048}; pg8::gemm_phase(lds, g, S, E, c.tid); });
            RUN(3, phase_vstats(c));
            RUN(4, phase_spatial(c, j));
        } else {
            RUN(5, { pg8::Gemm g{(const bf16_t*)(ws + WS_H1), (const bf16_t*)(ws + WS_WBIN) + (size_t)j * WBIN_N * 1024, T, WBIN_N, 1024}; pg8::StaticOrder S; S.init(T, WBIN_N, c.G, c.bid);
                  pg8::EpiGlaProj E{(bf16_t*)(ws + WS_R1), (bf16_t*)(ws + WS_R1 + SZ_T512), (bf16_t*)(ws + WS_R1 + 2 * SZ_T512), (bf16_t*)(ws + WS_R1 + 2 * SZ_T512 + SZ_T1K), (float*)(ws + WS_GL)};
                  pg8::gemm_phase(lds, g, S, E, c.tid); });
            RUN(6, phase_gla_prep(c, j));
            RUN(7, phase_gla_scan(c));
            RUN(8, phase_gla_readout(c, j));
        }
        const int Mrows = (L == DEPTH - 1) ? TL : T;
        RUN(9, { const bf16_t* W = (L & 1) ? (const bf16_t*)(ws + WS_WBOUT) + (size_t)j * 1024 * 1024 : (const bf16_t*)(ws + WS_WAOUT) + (size_t)j * 1024 * 1024;
              pg8::Gemm g{(const bf16_t*)(ws + WS_R2), W, Mrows, 1024, 1024}; pg8::StaticOrder S; S.init(Mrows, 1024, c.G, c.bid);
              pg8::EpiRes E{p.in[0], p.in[2], (bf16_t*)(ws + WS_XS), MOD + (size_t)L * 17 * 6144, 2, L == 0 ? 1 : 0};
              pg8::gemm_phase(lds, g, S, E, c.tid); });
        RUN(10, phase_ln1(c, L));
        RUN(11, { pg8::Gemm g{(const bf16_t*)(ws + WS_R2 + SZ_T1K), (const bf16_t*)(ws + WS_WQ) + (size_t)L * 1024 * 1024, Mrows, 1024, 1024}; pg8::StaticOrder S; S.init(Mrows, 1024, c.G, c.bid);
              pg8::EpiBf16<0> E{(bf16_t*)(ws + WS_R1), 1024}; pg8::gemm_phase(lds, g, S, E, c.tid); });
        RUN(12, phase_route(c, L));
        RUN(13, phase_experts(c, L));
    }
#undef RUN
}

extern "C" void kernel_launch(void* const* d_in, const int* in_sizes, int n_in, void* d_out, int out_size, void* d_ws, size_t ws_size, hipStream_t stream) {
    static int grid = 0;
    if (grid == 0) {
        if (n_in != 23 || out_size != TL * D || ws_size < WS_END) { fprintf(stderr, "kernel_launch: unexpected shapes: n_in %d out %d ws %zu (need %zu)\n", n_in, out_size, ws_size, (size_t)WS_END); grid = -1; return; }
        int dev = 0, cus = 0, per_cu = 0;
        if (hipGetDevice(&dev) != hipSuccess || hipDeviceGetAttribute(&cus, hipDeviceAttributeMultiprocessorCount, dev) != hipSuccess) { fprintf(stderr, "kernel_launch: device query failed\n"); grid = -1; return; }
        if (hipFuncSetAttribute((const void*)mega_fwd, hipFuncAttributeMaxDynamicSharedMemorySize, LDS_BYTES) != hipSuccess) { fprintf(stderr, "kernel_launch: hipFuncSetAttribute failed\n"); grid = -1; return; }
        if (hipOccupancyMaxActiveBlocksPerMultiprocessor(&per_cu, (const void*)mega_fwd, NTHR, LDS_BYTES) != hipSuccess || per_cu < 1) { fprintf(stderr, "kernel_launch: occupancy query says %d blocks per CU\n", per_cu); grid = -1; return; }
        grid = cus;
    }
    if (grid < 0) return;
    (void)hipMemsetAsync((char*)d_ws + WS_CTL, 0, 65536, stream);
    Params p{};
    for (int i = 0; i < 23; ++i) p.in[i] = (const float*)d_in[i];
    p.out = (float*)d_out; p.ws = (unsigned char*)d_ws; p.ph_lo = 0; p.ph_hi = N_PHASES;
    void* args[] = {&p};
    const hipError_t e = hipLaunchCooperativeKernel((const void*)mega_fwd, dim3(grid), dim3(NTHR), args, LDS_BYTES, stream);
    if (e != hipSuccess) fprintf(stderr, "kernel_launch: cooperative launch failed: %s (grid %d)\n", hipGetErrorString(e), grid);
}
```

```cpp
#include <hip/hip_runtime.h>
#include <hip/hip_cooperative_groups.h>
#include <cstdio>
#include <cstdint>
namespace cg = cooperative_groups;

#define LAS __attribute__((address_space(3)))
#define DI __device__ __forceinline__
typedef unsigned short bf16_t;
typedef short bf16x8 __attribute__((ext_vector_type(8)));
typedef float f32x4 __attribute__((ext_vector_type(4)));
typedef float f32x2 __attribute__((ext_vector_type(2)));
typedef unsigned u32x4 __attribute__((ext_vector_type(4)));
typedef unsigned u32x2 __attribute__((ext_vector_type(2)));
typedef __bf16 bf16v2 __attribute__((ext_vector_type(2)));

constexpr int D = 1024, NB = 16, SEQ = 2048, CTXL = 256, DEPTH = 4;
constexpr int TL = NB * SEQ, TC = NB * CTXL, T = TL + TC;
constexpr int NEXP = 16384;
constexpr float LN_EPS = 1e-5f;
constexpr float DN_ALPHA = 1.6817928305074290f;
constexpr int NTHR = 512, NWAVE = 8;
constexpr int LDS_BYTES = 140 * 1024;
constexpr int WBIN_N = 3328;

constexpr size_t al256(size_t x) { return (x + 255) & ~(size_t)255; }
constexpr size_t WS_CTL = 0;
constexpr size_t WS_MOD = 65536;
constexpr size_t WS_STATS = al256(WS_MOD + (size_t)4 * 17 * 6144 * 4);
constexpr size_t WS_GL = al256(WS_STATS + (size_t)T * 2 * 4);
constexpr size_t WS_DEC = al256(WS_GL + (size_t)T * 32 * 4);
constexpr size_t WS_WSB = al256(WS_DEC + (size_t)2 * 576 * 512 * 4);
constexpr size_t WS_WAIN = al256(WS_WSB + (size_t)2 * 8 * 128 * 128 * 2);
constexpr size_t WS_WAOUT = WS_WAIN + (size_t)2 * 2048 * 1024 * 2;
constexpr size_t WS_WBIN = WS_WAOUT + (size_t)2 * 1024 * 1024 * 2;
constexpr size_t WS_WBOUT = WS_WBIN + (size_t)2 * WBIN_N * 1024 * 2;
constexpr size_t WS_WQ = WS_WBOUT + (size_t)2 * 1024 * 1024 * 2;
constexpr size_t WS_UT = WS_WQ + (size_t)4 * 1024 * 1024 * 2;
constexpr size_t WS_VT = WS_UT + (size_t)4 * NEXP * 1024;
constexpr size_t WS_SU = WS_VT + (size_t)4 * NEXP * 1024;
constexpr size_t WS_SV = WS_SU + (size_t)4 * NEXP * 4;
constexpr size_t WS_XS = WS_SV + (size_t)4 * NEXP * 4;
constexpr size_t WS_R1 = WS_XS + (size_t)T * 1024 * 4;
constexpr size_t WS_R2 = WS_R1 + (size_t)T * 3072 * 2;
constexpr size_t WS_H1 = WS_R2 + (size_t)T * 3072 * 2;
constexpr size_t WS_VTT = WS_H1 + (size_t)T * 1024 * 2;
constexpr size_t WS_OB = WS_VTT + (size_t)T * 1024 * 2;
constexpr size_t WS_XH = WS_OB + (size_t)T * 1024 * 2;
constexpr size_t WS_XL = WS_XH + (size_t)T * 512;
constexpr size_t WS_SX = WS_XL + (size_t)T * 512;
constexpr size_t WS_END = al256(WS_SX + (size_t)T * 4);
constexpr size_t SZ_T1K = (size_t)T * 1024 * 2;
constexpr size_t SZ_T512 = (size_t)T * 512 * 2;

struct Params { const float* in[23]; float* out; unsigned char* ws; int ph_lo, ph_hi; };

DI unsigned pk_bf16(float lo, float hi) { f32x2 v = {lo, hi}; return __builtin_bit_cast(unsigned, __builtin_convertvector(v, bf16v2)); }
DI float bf_lo(unsigned w) { return __uint_as_float(w << 16); }
DI float bf_hi(unsigned w) { return __uint_as_float(w & 0xffff0000u); }
DI float bf1(bf16_t b) { return __uint_as_float(((unsigned)b) << 16); }
DI bf16_t f2bf(float f) { return (bf16_t)(pk_bf16(f, 0.f) & 0xffffu); }
DI float gelu_tanh(float x) { const float t = x * x; const float w = x * (t * (-2.0f * 1.4426950408889634f * 0.7978845608028654f * 0.044715f) + (-2.0f * 1.4426950408889634f * 0.7978845608028654f)); return x * __builtin_amdgcn_rcpf(1.0f + __builtin_amdgcn_exp2f(w)); }
DI float silu_f(float x) { return x * __builtin_amdgcn_rcpf(1.0f + __builtin_amdgcn_exp2f(-1.4426950408889634f * x)); }
DI float logsig_f(float z) { return fminf(z, 0.f) - log1pf(expf(-fabsf(z))); }
template <int CTRL> DI float dpp_mov(float x) { return __builtin_bit_cast(float, __builtin_amdgcn_mov_dpp(__builtin_bit_cast(int, x), CTRL, 0xf, 0xf, true)); }
DI float wave_sum(float v) {
    const auto a = __builtin_amdgcn_permlane32_swap(__float_as_uint(v), __float_as_uint(v), false, false); v = __uint_as_float(a[0]) + __uint_as_float(a[1]);
    const auto b = __builtin_amdgcn_permlane16_swap(__float_as_uint(v), __float_as_uint(v), false, false); v = __uint_as_float(b[0]) + __uint_as_float(b[1]);
    v += dpp_mov<0x128>(v); v += dpp_mov<0x124>(v); v += dpp_mov<0x122>(v); v += dpp_mov<0x121>(v);
    return v;
}
DI float wave_max(float v) {
#pragma unroll
    for (int o = 32; o > 0; o >>= 1) v = fmaxf(v, __shfl_xor(v, o, 64));
    return v;
}
DI float reduce4(float p0, float p1, float p2, float p3) {
    const auto a = __builtin_amdgcn_permlane32_swap(__float_as_uint(p0), __float_as_uint(p2), false, false); const float q0 = __uint_as_float(a[0]) + __uint_as_float(a[1]);
    const auto b = __builtin_amdgcn_permlane32_swap(__float_as_uint(p1), __float_as_uint(p3), false, false); const float q1 = __uint_as_float(b[0]) + __uint_as_float(b[1]);
    const auto c = __builtin_amdgcn_permlane16_swap(__float_as_uint(q0), __float_as_uint(q1), false, false); float s = __uint_as_float(c[0]) + __uint_as_float(c[1]);
    s += dpp_mov<0x128>(s); s += dpp_mov<0x124>(s); s += dpp_mov<0x122>(s); s += dpp_mov<0x121>(s);
    return s;
}
DI float dot2bf(unsigned a, unsigned b, float c) { return __builtin_amdgcn_fdot2_f32_bf16(__builtin_bit_cast(bf16v2, a), __builtin_bit_cast(bf16v2, b), c, false); }
DI f32x4 mfma16(bf16x8 a, bf16x8 b, f32x4 c) { return __builtin_amdgcn_mfma_f32_16x16x32_bf16(a, b, c, 0, 0, 0); }
DI bf16x8 frag_ld(const bf16_t* X, int ld, int row0, int k0, int lane) { return *(const bf16x8*)(X + (size_t)(row0 + (lane & 15)) * ld + k0 + 8 * (lane >> 4)); }
DI int mod_batch(int row) { return row < TL ? (row >> 11) : NB; }

#define XB_TMO      128
#define XB_XCNT(j)  (256  + 64 * (j))
#define XB_XSUB(j)  (1280 + 64 * (j))
#define XB_XGEN(j)  (2304 + 64 * (j))
#define XB_TOP      3328
#define XB_TOPGEN   3392
#define XCD_BAR_WORDS 3456
#define XB_SPIN_CAP (1u << 22)
DI unsigned xb_ld(unsigned* p)              { return __hip_atomic_load(p, __ATOMIC_RELAXED, __HIP_MEMORY_SCOPE_AGENT); }
DI unsigned xb_add(unsigned* p, unsigned v) { return __hip_atomic_fetch_add(p, v, __ATOMIC_RELAXED, __HIP_MEMORY_SCOPE_AGENT); }
DI unsigned xb_xcc_id() { return (unsigned)__builtin_amdgcn_s_getreg((3 << 11) | 20) & 0xFu; }
#define XB_SPIN(cond, bar) do { unsigned _sp = 0; while (cond) { __builtin_amdgcn_s_sleep(1); \
    if ((++_sp & 255u) == 0u) { if (xb_ld(&(bar)[XB_TMO])) break; if (_sp > XB_SPIN_CAP) { atomicAdd(&(bar)[XB_TMO], 1u); break; } } } } while (0)
struct XcdBarrier { unsigned* bar; unsigned x; volatile LAS unsigned* st; };
DI XcdBarrier xcd_barrier_post(unsigned* bar, volatile LAS unsigned* st) {
    XcdBarrier b; b.bar = bar; b.x = xb_xcc_id(); b.st = st;
    if (threadIdx.x == 0) (void)xb_add(&bar[XB_XCNT(b.x)], 1u);
    return b;
}
DI void xcd_barrier_complete(unsigned* bar, unsigned x, unsigned& nloc, unsigned& nx) {
    const unsigned G = gridDim.x * gridDim.y * gridDim.z;
    unsigned sum, cnt, mine, sp = 0u;
    for (;;) {
        sum = 0u; cnt = 0u; mine = 0u;
#pragma unroll
        for (unsigned j = 0; j < 16; ++j) { const unsigned c = xb_ld(&bar[XB_XCNT(j)]); sum += c; cnt += (c > 0u) ? 1u : 0u; mine = (j == x) ? c : mine; }
        if (sum == G) break;
        __builtin_amdgcn_s_sleep(1);
        if ((++sp & 255u) == 0u) { if (xb_ld(&bar[XB_TMO])) break; if (sp > XB_SPIN_CAP) { atomicAdd(&bar[XB_TMO], 1u); break; } }
    }
    nloc = mine > 0u ? mine : 1u; nx = cnt > 0u ? cnt : 1u;
}
DI void xcd_barrier(const XcdBarrier& b) {
    asm volatile("s_waitcnt vmcnt(0)" ::: "memory");
    __syncthreads();
    if (threadIdx.x == 0) {
        unsigned* bar = b.bar;
        __builtin_amdgcn_s_waitcnt(0);
        unsigned nloc = b.st[0], nx = b.st[1];
        if (nloc == 0u) { xcd_barrier_complete(bar, b.x, nloc, nx); b.st[0] = nloc; b.st[1] = nx; }
        const unsigned old = xb_add(&bar[XB_XSUB(b.x)], 1u);
        const unsigned gen = old / nloc;
        if (old + 1u == (gen + 1u) * nloc) {
            __builtin_amdgcn_fence(__ATOMIC_RELEASE, "agent");
            asm volatile("s_waitcnt vmcnt(0)" ::: "memory");
            const unsigned og = xb_add(&bar[XB_TOP], 1u);
            const unsigned tg = og / nx;
            if (og + 1u == (tg + 1u) * nx) xb_add(&bar[XB_TOPGEN], 1u);
            else XB_SPIN(xb_ld(&bar[XB_TOPGEN]) == tg, bar);
            __builtin_amdgcn_fence(__ATOMIC_ACQUIRE, "agent");
            xb_add(&bar[XB_XGEN(b.x)], 1u);
            asm volatile("s_waitcnt vmcnt(0)" ::: "memory");
        } else {
            XB_SPIN(xb_ld(&bar[XB_XGEN(b.x)]) == gen, bar);
            __builtin_amdgcn_fence(__ATOMIC_ACQUIRE, "agent");
            asm volatile("s_waitcnt vmcnt(0)" ::: "memory");
        }
    }
    __syncthreads();
}

namespace pg8 {
constexpr int BM = 256, BK = 64, HALF = 128, HTB = HALF * BK * 2, STAGE_BYTES = 8 * HTB, NXCD = 8, WGM = 8;
__host__ __device__ __forceinline__ int lds_byte(int r, int c) { const int st = (r >> 4) * 2 + (c >> 5), rr = r & 15, cc = c & 31, ob = rr * 64 + cc * 2; return st * 1024 + (ob ^ (((ob >> 9) & 1) << 5)); }
__host__ __device__ __forceinline__ void stage_rc(int b, int& R, int& C) { const int st = b / 1024, sb = b % 1024, swz = sb ^ (((sb >> 9) & 1) << 5); R = (st >> 1) * 16 + swz / 64; C = (st & 1) * 32 + (swz % 64) / 2; }
__host__ __device__ __forceinline__ int perm32(int rho) { const int n = rho >> 4, i = rho & 15; return 8 * (i >> 2) + 4 * n + (i & 3); }
struct Unit { int pm, pn; };
struct Gemm { const bf16_t* A; const bf16_t* Bt; int M, N, K; };
struct StaticOrder {
    int nM, nN, nwg, G, c;
    __device__ void init(int M, int N, int G_, int c_) { nM = M / BM; nN = N / BM; nwg = nM * nN; G = G_; c = c_; }
    __device__ bool next(int i, Unit& u) const {
        const long L = (long)i * G + c; if (L >= nwg) return false;
        int wgid = (int)L; { const int q = nwg / NXCD, r = nwg % NXCD, xcd = wgid % NXCD, off = wgid / NXCD; wgid = (xcd < r ? xcd * (q + 1) : r * (q + 1) + (xcd - r) * q) + off; }
        const int nig = WGM * nN, gid = wgid / nig, fm = gid * WGM, gsz = (nM - fm) < WGM ? (nM - fm) : WGM;
        u.pm = fm + ((wgid % nig) % gsz); u.pn = (wgid % nig) / gsz; return true;
    }
};

template <class Epi>
__device__ __forceinline__ void gemm_phase(LAS unsigned char* lds, const Gemm g, const StaticOrder& S, const Epi& E, const int tid) {
    const int wid = __builtin_amdgcn_readfirstlane(tid >> 6), lane = tid & 63, wr = wid >> 2, wc = wid & 3, fr = lane & 15, fq = lane >> 4;
    const int K = g.K, nt = K / BK;
    unsigned voffA[2], voffB[2];
#pragma unroll
    for (int i = 0; i < 2; ++i) { int R, C; stage_rc(tid * 16 + i * 8192, R, C); const int Rb = Epi::PERM ? ((R & ~31) + perm32(R & 31)) : R;
        voffA[i] = (unsigned)(R * K + C) * 2u; voffB[i] = (unsigned)(Rb * K + C) * 2u; }
    const size_t kstep = (size_t)(BK * 2);
    const size_t hstep = (size_t)HALF * K * 2;
    const size_t tstep = 2 * hstep;
    const unsigned ldsw = (unsigned)wid * 1024u;
    const int aoff = lds_byte(wr * 64 + fr, fq * 8), boff = lds_byte(wc * 32 + fr, fq * 8);
#define PG8_SA(b, h) (((b) * 2 + (h)) * HTB)
#define PG8_SB(b, h) ((4 + (b) * 2 + (h)) * HTB)
#define PG8_STAGE(bufoff, gbase, voff) do { _Pragma("unroll") for (int _i = 0; _i < 2; ++_i) \
        __builtin_amdgcn_global_load_lds((const unsigned*)((const char*)(gbase) + (voff)[_i]), (LAS unsigned*)(lds + (bufoff) + ldsw + _i * 8192), 16, 0, 0); } while (0)
#define PG8_LDA(dst, b, h) do { _Pragma("unroll") for (int m = 0; m < 4; ++m) _Pragma("unroll") for (int k = 0; k < 2; ++k) dst[m][k] = *(const LAS bf16x8*)(lds + PG8_SA(b, h) + aoff + m * 2048 + k * 1024); } while (0)
#define PG8_LDB(dst, b, h) do { _Pragma("unroll") for (int n = 0; n < 2; ++n) _Pragma("unroll") for (int k = 0; k < 2; ++k) dst[n][k] = *(const LAS bf16x8*)(lds + PG8_SB(b, h) + boff + n * 2048 + k * 1024); } while (0)
#define PG8_MMA(ai, bj, At, Bt) do { __builtin_amdgcn_s_setprio(1); _Pragma("unroll") for (int m = 0; m < 4; ++m) _Pragma("unroll") for (int n = 0; n < 2; ++n) _Pragma("unroll") for (int k = 0; k < 2; ++k) \
        acc[ai][bj][m][n] = __builtin_amdgcn_mfma_f32_16x16x32_bf16(Bt[n][k], At[m][k], acc[ai][bj][m][n], 0, 0, 0); __builtin_amdgcn_s_setprio(0); } while (0)
#define PG8_WAIT_V(n) asm volatile("s_waitcnt vmcnt(" #n ")" ::: "memory")
#define PG8_WAIT_L(n) asm volatile("s_waitcnt lgkmcnt(" #n ")" ::: "memory")
#define PG8_BAR __builtin_amdgcn_s_barrier()
#define PG8_SCHED __builtin_amdgcn_sched_barrier(0)
    Unit cur, nxt; int ui = 0;
    if (!S.next(0, cur)) return;
    f32x4 acc[2][2][4][2];
#pragma unroll
    for (int a = 0; a < 2; ++a)
#pragma unroll
        for (int b = 0; b < 2; ++b)
#pragma unroll
            for (int m = 0; m < 4; ++m)
#pragma unroll
                for (int n = 0; n < 2; ++n) acc[a][b][m][n] = (f32x4){0.f, 0.f, 0.f, 0.f};
    bf16x8 At[4][2], B0[2][2], B1[2][2];
    const char* cA = (const char*)g.A + (size_t)cur.pm * tstep; const char* cB = (const char*)g.Bt + (size_t)cur.pn * tstep;
    PG8_STAGE(PG8_SB(0, 0), cB, voffB); PG8_STAGE(PG8_SB(0, 1), cB + hstep, voffB); PG8_STAGE(PG8_SA(0, 0), cA, voffA); PG8_STAGE(PG8_SA(0, 1), cA + hstep, voffA);
    if (wr == 1) PG8_BAR;
    PG8_WAIT_V(2); PG8_BAR;
    PG8_STAGE(PG8_SB(1, 0), cB + kstep, voffB); PG8_STAGE(PG8_SA(1, 0), cA + kstep, voffA); PG8_STAGE(PG8_SB(1, 1), cB + hstep + kstep, voffB);
    PG8_WAIT_V(6); PG8_BAR;
    for (;;) {
        const bool has_next = S.next(ui + 1, nxt);
        const char* nA = has_next ? (const char*)g.A + (size_t)nxt.pm * tstep : cA; const char* nB = has_next ? (const char*)g.Bt + (size_t)nxt.pn * tstep : cB;
        for (int t = 0; t < nt; t += 2) {
            const bool last = (t == nt - 2);
            const char* a1 = cA + (size_t)(t + 1) * kstep;
            const char* a2 = last ? nA : cA + (size_t)(t + 2) * kstep; const char* b2 = last ? nB : cB + (size_t)(t + 2) * kstep;
            const char* a3 = a2 + kstep; const char* b3 = b2 + kstep;
            PG8_LDB(B0, 0, 0); PG8_LDB(B1, 0, 1); PG8_SCHED; PG8_LDA(At, 0, 0); PG8_STAGE(PG8_SA(1, 1), a1 + hstep, voffA);
            PG8_WAIT_V(8); PG8_WAIT_L(0); PG8_BAR; PG8_MMA(0, 0, At, B0); PG8_MMA(0, 1, At, B1); PG8_BAR; PG8_SCHED;
            PG8_LDA(At, 0, 1); PG8_STAGE(PG8_SB(0, 0), b2, voffB); PG8_STAGE(PG8_SB(0, 1), b2 + hstep, voffB); PG8_STAGE(PG8_SA(0, 0), a2, voffA);
            PG8_WAIT_V(8); PG8_WAIT_L(0); PG8_BAR; PG8_MMA(1, 0, At, B0); PG8_MMA(1, 1, At, B1); PG8_BAR; PG8_SCHED;
            PG8_LDB(B0, 1, 0); PG8_LDB(B1, 1, 1); PG8_SCHED; PG8_LDA(At, 1, 0); PG8_STAGE(PG8_SA(0, 1), a2 + hstep, voffA);
            PG8_WAIT_V(8); PG8_WAIT_L(0); PG8_BAR; PG8_MMA(0, 0, At, B0); PG8_MMA(0, 1, At, B1); PG8_BAR; PG8_SCHED;
            PG8_LDA(At, 1, 1); PG8_STAGE(PG8_SB(1, 0), b3, voffB); PG8_STAGE(PG8_SB(1, 1), b3 + hstep, voffB); PG8_STAGE(PG8_SA(1, 0), a3, voffA);
            PG8_WAIT_V(8); PG8_WAIT_L(0); PG8_BAR; PG8_MMA(1, 0, At, B0); PG8_MMA(1, 1, At, B1); PG8_BAR; PG8_SCHED;
        }
        if (wr == 0) PG8_BAR;
        E(acc, cur, wr, wc, fr, fq);
        if (!has_next) break;
#pragma unroll
        for (int a = 0; a < 2; ++a)
#pragma unroll
            for (int b = 0; b < 2; ++b)
#pragma unroll
                for (int m = 0; m < 4; ++m)
#pragma unroll
                    for (int n = 0; n < 2; ++n) acc[a][b][m][n] = (f32x4){0.f, 0.f, 0.f, 0.f};
        cur = nxt; cA = nA; cB = nB; ++ui;
        if (wr == 1) PG8_BAR;
    }
    PG8_WAIT_V(0);
    PG8_BAR;
#undef PG8_SA
#undef PG8_SB
#undef PG8_STAGE
#undef PG8_LDA
#undef PG8_LDB
#undef PG8_MMA
#undef PG8_WAIT_V
#undef PG8_WAIT_L
#undef PG8_BAR
#undef PG8_SCHED
}

template <int ACT  > struct EpiBf16 {
    static constexpr bool PERM = true;
    bf16_t* O; int ldc;
    __device__ __forceinline__ void operator()(const f32x4 (&acc)[2][2][4][2], const Unit& u, int wr, int wc, int fr, int fq) const {
        const int row0 = u.pm * BM + wr * 64 + fr, col0 = u.pn * BM + wc * 32 + 8 * fq;
#pragma unroll
        for (int ai = 0; ai < 2; ++ai)
#pragma unroll
            for (int m = 0; m < 4; ++m) { bf16_t* rowp = O + (size_t)(row0 + ai * HALF + m * 16) * ldc + col0;
#pragma unroll
                for (int bj = 0; bj < 2; ++bj) { f32x4 v0 = acc[ai][bj][m][0], v1 = acc[ai][bj][m][1];
                    if (ACT == 1) {
#pragma unroll
                        for (int j = 0; j < 4; ++j) { v0[j] = gelu_tanh(v0[j]); v1[j] = gelu_tanh(v1[j]); } }
                    u32x4 w; w.x = pk_bf16(v0[0], v0[1]); w.y = pk_bf16(v0[2], v0[3]); w.z = pk_bf16(v1[0], v1[1]); w.w = pk_bf16(v1[2], v1[3]);
                    *(u32x4*)(rowp + bj * HALF) = w; } }
    }
};
struct EpiRes {
    static constexpr bool PERM = true;
    const float* src_lat; const float* src_ctx; bf16_t* xs; const float* modL; int gate_idx; int src_f32;
    __device__ __forceinline__ void operator()(const f32x4 (&acc)[2][2][4][2], const Unit& u, int wr, int wc, int fr, int fq) const {
        asm volatile("" : "+v"(fr), "+v"(fq));
        const bool isctx = u.pm >= (TL / BM);
        const float* sb = isctx ? src_ctx + (size_t)(u.pm - TL / BM) * BM * D : src_lat + (size_t)u.pm * BM * D;
        const int mb = isctx ? NB : (u.pm >> 3);
        const float* gv = modL + (size_t)mb * 6144 + gate_idx * 1024;
        const int rl = wr * 64 + fr, col0 = u.pn * BM + wc * 32 + 8 * fq;
#pragma unroll
        for (int bj = 0; bj < 2; ++bj) {
            const f32x4 g0 = *(const f32x4*)(gv + col0 + bj * HALF), g1 = *(const f32x4*)(gv + col0 + bj * HALF + 4);
#pragma unroll
            for (int ai = 0; ai < 2; ++ai)
#pragma unroll
                for (int m = 0; m < 4; ++m) { const int r = rl + ai * HALF + m * 16; bf16_t* dp = xs + ((size_t)u.pm * BM + r) * D + col0 + bj * HALF; f32x4 x0, x1;
                    if (src_f32) { const float* sp = sb + (size_t)r * D + col0 + bj * HALF; x0 = *(const f32x4*)sp; x1 = *(const f32x4*)(sp + 4); }
                    else { const u32x4 xv = *(const u32x4*)dp; x0 = (f32x4){bf_lo(xv.x), bf_hi(xv.x), bf_lo(xv.y), bf_hi(xv.y)}; x1 = (f32x4){bf_lo(xv.z), bf_hi(xv.z), bf_lo(xv.w), bf_hi(xv.w)}; }
                    const f32x4 y0 = x0 * DN_ALPHA + g0 * acc[ai][bj][m][0], y1 = x1 * DN_ALPHA + g1 * acc[ai][bj][m][1];
                    u32x4 w; w.x = pk_bf16(y0[0], y0[1]); w.y = pk_bf16(y0[2], y0[3]); w.z = pk_bf16(y1[0], y1[1]); w.w = pk_bf16(y1[2], y1[3]);
                    *(u32x4*)dp = w; }
        }
    }
};
struct EpiGlaProj {
    static constexpr bool PERM = true;
    bf16_t* QG; bf16_t* KG; bf16_t* VG; bf16_t* RG; float* GL;
    __device__ __forceinline__ void operator()(const f32x4 (&acc)[2][2][4][2], const Unit& u, int wr, int wc, int fr, int fq) const {
        const int row0 = u.pm * BM + wr * 64 + fr, pn = u.pn;
        if (pn < 12) {
            bf16_t* base; int ld, colt; float sc = 1.f;
            if (pn < 2) { base = QG; ld = 512; colt = pn * BM; sc = 0.08838834764831845f; }
            else if (pn < 4) { base = KG; ld = 512; colt = (pn - 2) * BM; }
            else if (pn < 8) { base = VG; ld = 1024; colt = (pn - 4) * BM; }
            else { base = RG; ld = 1024; colt = (pn - 8) * BM; }
            const int col0 = colt + wc * 32 + 8 * fq;
#pragma unroll
            for (int ai = 0; ai < 2; ++ai)
#pragma unroll
                for (int m = 0; m < 4; ++m) { bf16_t* rowp = base + (size_t)(row0 + ai * HALF + m * 16) * ld + col0;
#pragma unroll
                    for (int bj = 0; bj < 2; ++bj) { const f32x4 v0 = acc[ai][bj][m][0] * sc, v1 = acc[ai][bj][m][1] * sc;
                        u32x4 w; w.x = pk_bf16(v0[0], v0[1]); w.y = pk_bf16(v0[2], v0[3]); w.z = pk_bf16(v1[0], v1[1]); w.w = pk_bf16(v1[2], v1[3]);
                        *(u32x4*)(rowp + bj * HALF) = w; } }
        } else if (wc == 0) {
#pragma unroll
            for (int ai = 0; ai < 2; ++ai)
#pragma unroll
                for (int m = 0; m < 4; ++m) { float* gp = GL + (size_t)(row0 + ai * HALF + m * 16) * 32 + 8 * fq;
                    *(f32x4*)gp = acc[ai][0][m][0]; *(f32x4*)(gp + 4) = acc[ai][0][m][1]; }
        }
    }
};
}

struct Ctx {
    const Params* p; unsigned char* ws; unsigned char* smem; int tid, lane, wave, G, bid;
};

DI void phase_prologue(const Ctx& c) {
    const Params& p = *c.p; unsigned char* ws = c.ws;
    const int tid = c.tid;
    constexpr int N_MOD = 192, N_TR = 4736, N_WS = 64, N_TAB = 2048;
    constexpr int N_ALL = N_MOD + N_TR + N_WS + N_TAB;
    for (int u = c.bid; u < N_ALL; u += c.G) {
        if (u < N_MOD) {
            const int l = u / 48, n0 = (u % 48) * 128;
            float* sc = (float*)c.smem;
            float* red = (float*)(c.smem + 17 * 1024 * 4);
            __syncthreads();
#pragma unroll 1
            for (int hk = 0; hk < 2; ++hk) { const int k = hk * 512 + tid; float v[17];
#pragma unroll
                for (int b = 0; b < 17; ++b) v[b] = (b < NB) ? p.in[1][b * 1024 + k] : p.in[3][k];
#pragma unroll
                for (int b = 0; b < 17; ++b) sc[b * 1024 + k] = silu_f(v[b]); }
            __syncthreads();
            const int c4 = (tid & 31) * 4, kg = tid >> 5;
            float acc[17][4];
#pragma unroll
            for (int b = 0; b < 17; ++b) { acc[b][0] = 0.f; acc[b][1] = 0.f; acc[b][2] = 0.f; acc[b][3] = 0.f; }
            const float* wp = p.in[4] + ((size_t)l * 1024 + (size_t)kg * 64) * 6144 + n0 + c4;
#pragma unroll 4
            for (int kk = 0; kk < 64; ++kk) {
                const f32x4 w = *(const f32x4*)(wp + (size_t)kk * 6144);
                const int k = kg * 64 + kk;
#pragma unroll
                for (int b = 0; b < 17; ++b) { const float s = sc[b * 1024 + k]; acc[b][0] += s * w[0]; acc[b][1] += s * w[1]; acc[b][2] += s * w[2]; acc[b][3] += s * w[3]; }
            }
#pragma unroll
            for (int b = 0; b < 17; ++b)
#pragma unroll
                for (int j = 0; j < 4; ++j) acc[b][j] += __shfl_xor(acc[b][j], 32, 64);
            if ((tid & 32) == 0) {
#pragma unroll
                for (int b = 0; b < 17; ++b)
#pragma unroll
                    for (int j = 0; j < 4; ++j) red[(c.wave * 17 + b) * 128 + c4 + j] = acc[b][j];
            }
            __syncthreads();
            for (int o = tid; o < 17 * 128; o += NTHR) { const int b = o >> 7, n = o & 127; float s = 0.f;
#pragma unroll
                for (int w = 0; w < 8; ++w) s += red[(w * 17 + b) * 128 + n];
                ((float*)(ws + WS_MOD))[((size_t)l * 17 + b) * 6144 + n0 + n] = s + p.in[5][l * 6144 + n0 + n]; }
        } else if (u < N_MOD + N_TR) {
            int v = u - N_MOD; const float* src; bf16_t* dst; int N, Npad;
            if (v < 1024) { const int j = v / 512; v %= 512; src = p.in[8] + (size_t)j * 1024 * 2048; dst = (bf16_t*)(ws + WS_WAIN) + (size_t)j * 2048 * 1024; N = 2048; Npad = 2048; }
            else if (v < 1536) { v -= 1024; const int j = v / 256; v %= 256; src = p.in[13] + (size_t)j * 1024 * 1024; dst = (bf16_t*)(ws + WS_WAOUT) + (size_t)j * 1024 * 1024; N = 1024; Npad = 1024; }
            else if (v < 3200) { v -= 1536; const int j = v / 832; v %= 832; src = p.in[14] + (size_t)j * 1024 * 3104; dst = (bf16_t*)(ws + WS_WBIN) + (size_t)j * WBIN_N * 1024; N = 3104; Npad = WBIN_N; }
            else if (v < 3712) { v -= 3200; const int j = v / 256; v %= 256; src = p.in[18] + (size_t)j * 1024 * 1024; dst = (bf16_t*)(ws + WS_WBOUT) + (size_t)j * 1024 * 1024; N = 1024; Npad = 1024; }
            else { v -= 3712; const int j = v / 256; v %= 256; src = p.in[19] + (size_t)j * 1024 * 1024; dst = (bf16_t*)(ws + WS_WQ) + (size_t)j * 1024 * 1024; N = 1024; Npad = 1024; }
            (void)Npad;
            const int ntn = v >> 4, ktile = v & 15, n0 = ntn * 64, k0 = ktile * 64;
            float* tl = (float*)c.smem;
            __syncthreads();
#pragma unroll
            for (int i = 0; i < 2; ++i) { const int kk = (tid >> 4) + 32 * i, nn = (tid & 15) * 4;
                f32x4 x = {0.f, 0.f, 0.f, 0.f};
                if (n0 + nn < N) x = *(const f32x4*)(src + (size_t)(k0 + kk) * N + n0 + nn);
                tl[kk * 65 + nn] = x[0]; tl[kk * 65 + nn + 1] = x[1]; tl[kk * 65 + nn + 2] = x[2]; tl[kk * 65 + nn + 3] = x[3]; }
            __syncthreads();
            { const int nn = tid >> 3, kk8 = (tid & 7) * 8; float x[8];
#pragma unroll
              for (int j = 0; j < 8; ++j) x[j] = tl[(kk8 + j) * 65 + nn];
              u32x4 w; w.x = pk_bf16(x[0], x[1]); w.y = pk_bf16(x[2], x[3]); w.z = pk_bf16(x[4], x[5]); w.w = pk_bf16(x[6], x[7]);
              *(u32x4*)(dst + (size_t)(n0 + nn) * 1024 + k0 + kk8) = w; }
        } else if (u < N_MOD + N_TR + N_WS) {
            const int v = u - N_MOD - N_TR; const size_t e = (size_t)v * 4096 + (size_t)tid * 8;
            const f32x4 a = *(const f32x4*)(p.in[11] + e), b = *(const f32x4*)(p.in[11] + e + 4);
            u32x4 w; w.x = pk_bf16(a[0], a[1]); w.y = pk_bf16(a[2], a[3]); w.z = pk_bf16(b[0], b[1]); w.w = pk_bf16(b[2], b[3]);
            *(u32x4*)((bf16_t*)(ws + WS_WSB) + e) = w;
        } else {
            const int v = u - N_MOD - N_TR - N_WS; const int tab = v >> 10;
            const float* src = p.in[21 + tab]; unsigned char* dst = ws + (tab ? WS_VT : WS_UT); float* sc = (float*)(ws + (tab ? WS_SV : WS_SU));
#pragma unroll 2
            for (int i = 0; i < 8; ++i) { const size_t row = (size_t)(v & 1023) * 64 + c.wave * 8 + i;
                const float* rp = src + row * 1024 + 16 * c.lane; f32x4 x[4]; float am = 0.f;
#pragma unroll
                for (int q = 0; q < 4; ++q) { x[q] = __builtin_nontemporal_load((const f32x4*)(rp + 4 * q)); am = fmaxf(am, fmaxf(fmaxf(fabsf(x[q][0]), fabsf(x[q][1])), fmaxf(fabsf(x[q][2]), fabsf(x[q][3])))); }
                am = fmaxf(wave_max(am), 1e-30f);
                const size_t Lr = row >> 14, er = row & 16383;
                if (tab == 0) {
                    float ss = 0.f;
#pragma unroll
                    for (int q = 0; q < 4; ++q) ss += (x[q][0] * x[q][0] + x[q][1] * x[q][1]) + (x[q][2] * x[q][2] + x[q][3] * x[q][3]);
                    const float rms = sqrtf(wave_sum(ss) * (1.0f / 1024.0f)); const float stp = fmaxf(rms * (2.4f / 7.0f), 1e-30f), inv = 1.0f / stp; u32x2 w;
#pragma unroll
                    for (int hq = 0; hq < 2; ++hq) { unsigned t = 0;
#pragma unroll
                        for (int e = 0; e < 8; ++e) { const float v = x[2 * hq + (e >> 2)][e & 3] * inv; const int qi = (int)fminf(fmaxf(rintf(v), -8.0f), 7.0f); t |= ((unsigned)qi & 15u) << (4 * e); }
                        w[hq] = t; }
                    *(u32x2*)(dst + ((Lr * 4 + (c.lane >> 4)) * NEXP + er) * 128 + 8 * (c.lane & 15)) = w;
                    if (c.lane == 0) sc[row] = stp;
                } else {
                    const float inv = 6.0f / am; u32x2 w;
#pragma unroll
                    for (int hq = 0; hq < 2; ++hq) { unsigned t = 0;
                        t = __builtin_amdgcn_cvt_scalef32_pk_fp4_f32(t, x[2 * hq][0] * inv, x[2 * hq][1] * inv, 1.0f, 0); t = __builtin_amdgcn_cvt_scalef32_pk_fp4_f32(t, x[2 * hq][2] * inv, x[2 * hq][3] * inv, 1.0f, 1);
                        t = __builtin_amdgcn_cvt_scalef32_pk_fp4_f32(t, x[2 * hq + 1][0] * inv, x[2 * hq + 1][1] * inv, 1.0f, 2); t = __builtin_amdgcn_cvt_scalef32_pk_fp4_f32(t, x[2 * hq + 1][2] * inv, x[2 * hq + 1][3] * inv, 1.0f, 3);
                        w[hq] = t; }
                    *(u32x2*)(dst + ((Lr * 4 + (c.lane >> 4)) * NEXP + er) * 128 + 8 * (c.lane & 15)) = w;
                    if (c.lane == 0) sc[row] = am * (1.0f / 6.0f);
                } }
        }
    }
}

DI void phase_mod0(const Ctx& c) {
    const Params& p = *c.p; const float* MOD = (const float*)(c.ws + WS_MOD); bf16_t* H1 = (bf16_t*)(c.ws + WS_H1);
    for (int row = c.bid * NWAVE + c.wave; row < T; row += c.G * NWAVE) {
        const float* src = row < TL ? p.in[0] + (size_t)row * D : p.in[2] + (size_t)(row - TL) * D;
        const float* m = MOD + (size_t)mod_batch(row) * 6144;
#pragma unroll
        for (int j = 0; j < 4; ++j) { const int col = 4 * c.lane + 256 * j;
            const f32x4 x = *(const f32x4*)(src + col), sh = *(const f32x4*)(m + col), s = *(const f32x4*)(m + 1024 + col);
            const f32x4 h = x * (s + 1.0f) + sh; u32x2 w; w.x = pk_bf16(h[0], h[1]); w.y = pk_bf16(h[2], h[3]);
            *(u32x2*)(H1 + (size_t)row * D + col) = w; }
    }
}

DI void phase_vstats(const Ctx& c) {
    const bf16_t* UV = (const bf16_t*)(c.ws + WS_R1); float* ST = (float*)(c.ws + WS_STATS);
    for (int row = c.bid * NWAVE + c.wave; row < T; row += c.G * NWAVE) {
        const bf16_t* vp = UV + (size_t)row * 2048 + 1024;
        const u32x4 a = *(const u32x4*)(vp + 8 * c.lane), b = *(const u32x4*)(vp + 512 + 8 * c.lane);
        float x[16];
#pragma unroll
        for (int j = 0; j < 4; ++j) { x[2 * j] = bf_lo(a[j]); x[2 * j + 1] = bf_hi(a[j]); x[8 + 2 * j] = bf_lo(b[j]); x[9 + 2 * j] = bf_hi(b[j]); }
        float s = 0.f;
#pragma unroll
        for (int j = 0; j < 16; ++j) s += x[j];
        const float mean = wave_sum(s) * (1.0f / 1024.0f);
        float q = 0.f;
#pragma unroll
        for (int j = 0; j < 16; ++j) { const float d = x[j] - mean; q += d * d; }
        const float var = wave_sum(q) * (1.0f / 1024.0f);
        if (c.lane == 0) { ST[2 * row] = mean; ST[2 * row + 1] = rsqrtf(var + LN_EPS); }
    }
}

DI void phase_spatial(const Ctx& c, int j) {
    const Params& p = *c.p; unsigned char* ws = c.ws;
    const bf16_t* UV = (const bf16_t*)(ws + WS_R1); const float* ST = (const float*)(ws + WS_STATS); bf16_t* Y = (bf16_t*)(ws + WS_R2);
    const bf16_t* WSB = (const bf16_t*)(ws + WS_WSB) + (size_t)j * 8 * 128 * 128;
    const float* ng = p.in[9] + j * 1024; const float* nb = p.in[10] + j * 1024; const float* bs = p.in[12] + j * 8 * 128;
    constexpr int LD = 136;
    bf16_t* WsL = (bf16_t*)c.smem;
    bf16_t* VnT = WsL + 128 * LD;
    const int tid = c.tid, lane = c.lane, w = c.wave, g = lane >> 4, cc = lane & 15;
    for (int u = c.bid; u < (T / 128) * 8; u += c.G) {
        const int chunk = u >> 3, h = u & 7, r0 = chunk * 128;
        __syncthreads();
        { const int cg8 = tid & 15; float gg[8], bb[8];
#pragma unroll
          for (int e = 0; e < 8; ++e) { gg[e] = ng[h * 128 + cg8 * 8 + e]; bb[e] = nb[h * 128 + cg8 * 8 + e]; }
#pragma unroll
          for (int i = 0; i < 4; ++i) { const int idx = i * 512 + tid, tok = idx >> 4;
              const u32x4 v = *(const u32x4*)(UV + (size_t)(r0 + tok) * 2048 + 1024 + h * 128 + cg8 * 8);
              const float mean = ST[2 * (r0 + tok)], rstd = ST[2 * (r0 + tok) + 1];
              float x[8];
#pragma unroll
              for (int e = 0; e < 4; ++e) { x[2 * e] = bf_lo(v[e]); x[2 * e + 1] = bf_hi(v[e]); }
#pragma unroll
              for (int e = 0; e < 8; ++e) VnT[(cg8 * 8 + e) * LD + tok] = f2bf((x[e] - mean) * rstd * gg[e] + bb[e]);
              const int pp = idx >> 4;
              *(u32x4*)(WsL + pp * LD + cg8 * 8) = *(const u32x4*)(WSB + ((size_t)h * 128 + pp) * 128 + cg8 * 8); } }
        __syncthreads();
        f32x4 acc[8];
#pragma unroll
        for (int ct = 0; ct < 8; ++ct) acc[ct] = (f32x4){0.f, 0.f, 0.f, 0.f};
#pragma unroll
        for (int ks = 0; ks < 4; ++ks) {
            const bf16x8 bfr = frag_ld(WsL, LD, 16 * w, 32 * ks, lane);
#pragma unroll
            for (int ct = 0; ct < 8; ++ct) acc[ct] = mfma16(frag_ld(VnT, LD, 16 * ct, 32 * ks, lane), bfr, acc[ct]);
        }
        const int pp = 16 * w + cc; const float bsv = bs[h * 128 + pp];
        const size_t rowo = (size_t)(r0 + pp);
#pragma unroll
        for (int ct = 0; ct < 8; ++ct) { const int ch = h * 128 + 16 * ct + 4 * g;
            const u32x2 uu = *(const u32x2*)(UV + rowo * 2048 + ch);
            const float y0 = bf_lo(uu.x) * (acc[ct][0] + bsv), y1 = bf_hi(uu.x) * (acc[ct][1] + bsv), y2 = bf_lo(uu.y) * (acc[ct][2] + bsv), y3 = bf_hi(uu.y) * (acc[ct][3] + bsv);
            u32x2 o; o.x = pk_bf16(y0, y1); o.y = pk_bf16(y2, y3);
            *(u32x2*)(Y + rowo * D + ch) = o; }
    }
}

DI void phase_ln1(const Ctx& c, int L) {
    const Params& p = *c.p; bf16_t* XS = (bf16_t*)(c.ws + WS_XS); const float* MOD = (const float*)(c.ws + WS_MOD) + (size_t)L * 17 * 6144;
    bf16_t* H2 = (bf16_t*)(c.ws + WS_R2 + SZ_T1K);
    const float* lg = p.in[6] + (size_t)(L * 2 + 0) * D; const float* lb = p.in[7] + (size_t)(L * 2 + 0) * D;
    const int nrows = (L == DEPTH - 1) ? TL : T, stride = c.G * NWAVE;
    for (int row0 = c.bid * NWAVE + c.wave; row0 < nrows; row0 += 2 * stride) {
        const bool has2 = row0 + stride < nrows; const int rows[2] = {row0, has2 ? row0 + stride : row0};
        u32x2 v[2][4];
#pragma unroll
        for (int rr = 0; rr < 2; ++rr)
#pragma unroll
            for (int j = 0; j < 4; ++j) v[rr][j] = *(const u32x2*)(XS + (size_t)rows[rr] * D + 4 * c.lane + 256 * j);
#pragma unroll
        for (int rr = 0; rr < 2; ++rr) {
            if (rr == 1 && !has2) break;
            const int row = rows[rr]; bf16_t* xp = XS + (size_t)row * D; const float* m = MOD + (size_t)mod_batch(row) * 6144;
            f32x4 x[4]; float s = 0.f;
#pragma unroll
            for (int j = 0; j < 4; ++j) { x[j] = (f32x4){bf_lo(v[rr][j].x), bf_hi(v[rr][j].x), bf_lo(v[rr][j].y), bf_hi(v[rr][j].y)}; s += (x[j][0] + x[j][1]) + (x[j][2] + x[j][3]); }
            const float mean = wave_sum(s) * (1.0f / 1024.0f);
            float q = 0.f;
#pragma unroll
            for (int j = 0; j < 4; ++j) { const f32x4 d = x[j] - mean; q += (d[0] * d[0] + d[1] * d[1]) + (d[2] * d[2] + d[3] * d[3]); }
            const float rstd = rsqrtf(wave_sum(q) * (1.0f / 1024.0f) + LN_EPS);
            f32x4 hv[4];
#pragma unroll
            for (int j = 0; j < 4; ++j) { const int col = 4 * c.lane + 256 * j;
                const f32x4 y = (x[j] - mean) * rstd * *(const f32x4*)(lg + col) + *(const f32x4*)(lb + col);
                u32x2 xw; xw.x = pk_bf16(y[0], y[1]); xw.y = pk_bf16(y[2], y[3]);
                *(u32x2*)(xp + col) = xw;
                const f32x4 h = y * (*(const f32x4*)(m + 4 * 1024 + col) + 1.0f) + *(const f32x4*)(m + 3 * 1024 + col);
                u32x2 w; w.x = pk_bf16(h[0], h[1]); w.y = pk_bf16(h[2], h[3]);
                *(u32x2*)(H2 + (size_t)row * D + col) = w; hv[j] = h; }
            float am = 0.f;
#pragma unroll
            for (int j = 0; j < 4; ++j) am = fmaxf(am, fmaxf(fmaxf(fabsf(hv[j][0]), fabsf(hv[j][1])), fmaxf(fabsf(hv[j][2]), fabsf(hv[j][3]))));
            am = fmaxf(wave_max(am), 1e-30f); const float sx = am * (1.0f / 119.0f), isx = 119.0f / am;
#pragma unroll
            for (int j = 0; j < 4; ++j) { unsigned th = 0, tl = 0;
#pragma unroll
                for (int e = 0; e < 4; ++e) { const int x8 = (int)rintf(hv[j][e] * isx); const int xl = ((x8 + 8) & 15) - 8, xh = (x8 - xl) >> 4; th |= ((unsigned)xh & 15u) << (4 * e); tl |= ((unsigned)xl & 15u) << (4 * e); }
                const size_t bo = (size_t)row * 512 + (256 * j + 4 * c.lane) / 2;
                *(unsigned short*)(c.ws + WS_XH + bo) = (unsigned short)th; *(unsigned short*)(c.ws + WS_XL + bo) = (unsigned short)tl; }
            if (c.lane == 0) ((float*)(c.ws + WS_SX))[row] = sx;
        }
    }
}

DI int f2key(float v) { const int i = __float_as_int(v); return i ^ ((i >> 31) & 0x7fffffff); }
DI float key2f(int k) { return __int_as_float(k ^ ((k >> 31) & 0x7fffffff)); }
DI void phase_route(const Ctx& c, int L) {
    const Params& p = *c.p; unsigned char* ws = c.ws; const int lane = c.lane, g = lane >> 4, cc = lane & 15;
    constexpr int LDK = 72, LDS_S = 20;
    bf16_t* keysHi = (bf16_t*)c.smem;
    bf16_t* keysLo = keysHi + 2 * 128 * LDK;
    float* sbase = (float*)(keysLo + 2 * 128 * LDK);
    unsigned* ilist = (unsigned*)(sbase + NWAVE * 64 * LDS_S);
    __syncthreads();
    { const float* gk = p.in[20] + (size_t)L * 2 * 128 * 64;
      f32x4 kv[8];
#pragma unroll
      for (int it = 0; it < 8; ++it) kv[it] = ((const f32x4*)gk)[it * NTHR + c.tid];
#pragma unroll
      for (int it = 0; it < 8; ++it) { const int i = (it * NTHR + c.tid) * 4, row = i >> 6, d = i & 63; unsigned hi[2], lo[2];
#pragma unroll
          for (int e = 0; e < 2; ++e) { const unsigned ph = pk_bf16(kv[it][2 * e], kv[it][2 * e + 1]); hi[e] = ph; lo[e] = pk_bf16(kv[it][2 * e] - bf_lo(ph), kv[it][2 * e + 1] - bf_hi(ph)); }
          *(u32x2*)(keysHi + row * LDK + d) = (u32x2){hi[0], hi[1]}; *(u32x2*)(keysLo + row * LDK + d) = (u32x2){lo[0], lo[1]}; } }
    __syncthreads();
    float* S = sbase + c.wave * 64 * LDS_S;
    const bf16_t* QP = (const bf16_t*)(ws + WS_R1); int* IDX = (int*)(ws + WS_R1 + SZ_T1K); float* WT = (float*)(ws + WS_R1 + SZ_T1K + (size_t)T * 128 * 4);
    unsigned* myl = ilist + c.tid * 8; const unsigned char* mylb = (const unsigned char*)myl;
    const int ntask = (((L == DEPTH - 1) ? TL : T) / 64) * 8;
    for (int task = c.bid * NWAVE + c.wave; task < ntask; task += c.G * NWAVE) {
        const int t0 = (task >> 3) * 64, h = task & 7, tok = t0 + lane;
        float t12[2][16];
#pragma unroll
        for (int half = 0; half < 2; ++half) {
            bf16x8 aq[4][2];
#pragma unroll
            for (int mt = 0; mt < 4; ++mt)
#pragma unroll
                for (int ks = 0; ks < 2; ++ks) aq[mt][ks] = *(const bf16x8*)(QP + (size_t)(t0 + 16 * mt + cc) * D + h * 128 + half * 64 + 32 * ks + 8 * g);
            const bf16_t* kh = keysHi + half * 128 * LDK; const bf16_t* kl = keysLo + half * 128 * LDK;
#pragma unroll
            for (int i = 0; i < 16; ++i) t12[half][i] = -3.0e38f;
            for (int nt = 0; nt < 8; ++nt) {
                const bf16x8 bh0 = frag_ld(kh, LDK, 16 * nt, 0, lane), bh1 = frag_ld(kh, LDK, 16 * nt, 32, lane), bl0 = frag_ld(kl, LDK, 16 * nt, 0, lane), bl1 = frag_ld(kl, LDK, 16 * nt, 32, lane);
#pragma unroll
                for (int mt = 0; mt < 4; ++mt) { f32x4 a = {0.f, 0.f, 0.f, 0.f};
                    a = mfma16(aq[mt][0], bl0, a); a = mfma16(aq[mt][1], bl1, a); a = mfma16(aq[mt][0], bh0, a); a = mfma16(aq[mt][1], bh1, a);
#pragma unroll
                    for (int r = 0; r < 4; ++r) S[(16 * mt + 4 * g + r) * LDS_S + cc] = a[r]; }
                f32x4 sc[4];
#pragma unroll
                for (int q4 = 0; q4 < 4; ++q4) sc[q4] = *(const f32x4*)(S + lane * LDS_S + 4 * q4);
#pragma unroll
                for (int kk = 0; kk < 16; ++kk) { const float key = __int_as_float((__float_as_int(sc[kk >> 2][kk & 3]) & ~127) | (127 - (16 * nt + kk)));
#pragma unroll
                    for (int i = 15; i >= 1; --i) t12[half][i] = __builtin_amdgcn_fmed3f(key, t12[half][i - 1], t12[half][i]);
                    t12[half][0] = __builtin_amdgcn_fmed3f(key, 3.0e38f, t12[half][0]); }
            }
        }
        float v1[16], v2[16];
#pragma unroll
        for (int i = 0; i < 16; ++i) { v1[i] = __int_as_float(__float_as_int(t12[0][i]) & ~127); v2[i] = __int_as_float(__float_as_int(t12[1][i]) & ~127); }
#pragma unroll
        for (int i = 0; i < 4; ++i) {
            myl[i] = (unsigned)(127 - (__float_as_int(t12[0][4 * i]) & 127)) | ((unsigned)(127 - (__float_as_int(t12[0][4 * i + 1]) & 127)) << 8) | ((unsigned)(127 - (__float_as_int(t12[0][4 * i + 2]) & 127)) << 16) | ((unsigned)(127 - (__float_as_int(t12[0][4 * i + 3]) & 127)) << 24);
            myl[4 + i] = (unsigned)(127 - (__float_as_int(t12[1][4 * i]) & 127)) | ((unsigned)(127 - (__float_as_int(t12[1][4 * i + 1]) & 127)) << 8) | ((unsigned)(127 - (__float_as_int(t12[1][4 * i + 2]) & 127)) << 16) | ((unsigned)(127 - (__float_as_int(t12[1][4 * i + 3]) & 127)) << 24); }
        float f[16];
#pragma unroll
        for (int i = 0; i < 16; ++i) f[i] = -3.0e38f;
#pragma unroll
        for (int a = 0; a < 16; ++a)
#pragma unroll
            for (int b = 0; b < 16; ++b)
                if ((a + 1) * (b + 1) <= 16) {
                    const float key = __int_as_float((__float_as_int(v1[a] + v2[b]) & ~255) | (255 - (a * 16 + b)));
#pragma unroll
                    for (int i = 15; i >= 1; --i) f[i] = __builtin_amdgcn_fmed3f(key, f[i - 1], f[i]);
                    f[0] = __builtin_amdgcn_fmed3f(key, 3.0e38f, f[0]);
                }
        float e[16], se = 0.f; int fi[16];
        const float vmax = __int_as_float(__float_as_int(f[0]) & ~255);
#pragma unroll
        for (int i = 0; i < 16; ++i) { const int code = 255 - (__float_as_int(f[i]) & 255); fi[i] = (int)mylb[code >> 4] * 128 + (int)mylb[16 + (code & 15)];
            e[i] = __expf(__int_as_float(__float_as_int(f[i]) & ~255) - vmax); se += e[i]; }
        const float inv = 1.0f / se;
        int* ip = IDX + (size_t)tok * 128 + h * 16; float* wp = WT + (size_t)tok * 128 + h * 16;
#pragma unroll
        for (int i = 0; i < 16; i += 4) { *(int4*)(ip + i) = make_int4(fi[i], fi[i + 1], fi[i + 2], fi[i + 3]); *(f32x4*)(wp + i) = (f32x4){e[i] * inv, e[i + 1] * inv, e[i + 2] * inv, e[i + 3] * inv}; }
    }
}

DI float red8(float p) { p += dpp_mov<0xB1>(p); p += dpp_mov<0x4E>(p); p += dpp_mov<0x141>(p); return p; }
DI void phase_experts(const Ctx& c, int L) {
    const Params& p = *c.p; unsigned char* ws = c.ws; const int lane = c.lane, g8 = lane >> 3, j = lane & 7;
    constexpr int MAXTOK = 18;
    const bf16_t* H2 = (const bf16_t*)(ws + WS_R2 + SZ_T1K);
    const int* IDX = (const int*)(ws + WS_R1 + SZ_T1K); const float* WT = (const float*)(ws + WS_R1 + SZ_T1K + (size_t)T * 128 * 4);
    bf16_t* FFN = (bf16_t*)(ws + WS_R1);
    const unsigned char* UT = ws + WS_UT + (size_t)L * NEXP * 512; const unsigned char* VT = ws + WS_VT + (size_t)L * NEXP * 512;
    const float* SU = (const float*)(ws + WS_SU) + (size_t)L * NEXP; const float* SV = (const float*)(ws + WS_SV) + (size_t)L * NEXP;
    bf16_t* XS = (bf16_t*)(ws + WS_XS); bf16_t* H1 = (bf16_t*)(ws + WS_H1);
    const float* MOD = (const float*)(ws + WS_MOD) + (size_t)L * 17 * 6144;
    const float* lg = p.in[6] + (size_t)(L * 2 + 1) * D; const float* lb = p.in[7] + (size_t)(L * 2 + 1) * D;
    const int nrows = (L == DEPTH - 1) ? TL : T;
    float* ZL = (float*)c.smem + c.wave * MAXTOK * 128;
    unsigned short* IL = (unsigned short*)(c.smem + NWAVE * MAXTOK * 128 * 4) + c.wave * MAXTOK * 128;
    const int GW = c.G * NWAVE, gw = c.bid * NWAVE + c.wave;
    const int tsrc = 8 * (lane & 7) + (lane >> 3);
    for (int base = 0; base < nrows; base += GW * MAXTOK) {
        int ntok = (nrows - base - gw + GW - 1) / GW; ntok = ntok < 0 ? 0 : (ntok > MAXTOK ? MAXTOK : ntok);
        const int klast = ntok > 0 ? ntok - 1 : 0;
        if (ntok > 0) {
            for (int k0 = 0; k0 < MAXTOK; k0 += 6) { int iv[6][2];
#pragma unroll
                for (int kk = 0; kk < 6; ++kk) { const int kc = (k0 + kk < ntok) ? k0 + kk : klast; const size_t tb = (size_t)(base + gw + GW * kc) * 128; iv[kk][0] = IDX[tb + lane]; iv[kk][1] = IDX[tb + 64 + lane]; }
#pragma unroll
                for (int kk = 0; kk < 6; ++kk) { IL[(k0 + kk) * 128 + lane] = (unsigned short)iv[kk][0]; IL[(k0 + kk) * 128 + 64 + lane] = (unsigned short)iv[kk][1]; } }
        }
        for (int c4 = 0; c4 < 4; ++c4) {
            const unsigned char* Ub = UT + (size_t)c4 * NEXP * 128 + 16 * j;
            const unsigned char* XHb = ws + WS_XH + 128 * c4 + 16 * j; const unsigned char* XLb = ws + WS_XL + 128 * c4 + 16 * j;
            u32x4 rA[8], rB[8], xh, xl, nxh, nxl;
#define U_LOADX(k_) do { const size_t to_ = (size_t)(base + gw + GW * (k_)) * 512; nxh = *(const u32x4*)(XHb + to_); nxl = *(const u32x4*)(XLb + to_); } while (0)
#define U_ISSUE(R, k_, hf_) do { _Pragma("unroll") for (int i = 0; i < 8; ++i) { const unsigned e = IL[(k_) * 128 + 64 * (hf_) + 8 * i + g8]; R[i] = *(const u32x4*)(Ub + (size_t)e * 128); } } while (0)
#define U_COMPUTE(R, k_, hf_) do { int ra = 0; \
                _Pragma("unroll") for (int i = 0; i < 8; ++i) { int ah = 0, al = 0; \
                    _Pragma("unroll") for (int q = 0; q < 4; ++q) { ah = __builtin_amdgcn_sdot8((int)R[i][q], (int)xh[q], ah, false); al = __builtin_amdgcn_sdot8((int)R[i][q], (int)xl[q], al, false); } \
                    int zi = ah * 16 + al; \
                    zi += __builtin_amdgcn_mov_dpp(zi, 0xB1, 0xf, 0xf, true); zi += __builtin_amdgcn_mov_dpp(zi, 0x4E, 0xf, 0xf, true); zi += __builtin_amdgcn_mov_dpp(zi, 0x141, 0xf, 0xf, true); \
                    ra = (j == i) ? zi : ra; } \
                const float za = (float)__shfl(ra, tsrc, 64); \
                if (c4 == 0) ZL[(k_) * 128 + 64 * (hf_) + lane] = za; else ZL[(k_) * 128 + 64 * (hf_) + lane] += za; } while (0)
            if (ntok > 0) { U_LOADX(0); U_ISSUE(rA, 0, 0); }
            for (int k = 0; k < ntok; ++k) {
                const int kn = (k + 1 < ntok) ? k + 1 : k;
                U_ISSUE(rB, k, 1);
                xh = nxh; xl = nxl;
                U_COMPUTE(rA, k, 0);
                U_LOADX(kn); U_ISSUE(rA, kn, 0);
                U_COMPUTE(rB, k, 1);
            }
#undef U_LOADX
#undef U_ISSUE
#undef U_COMPUTE
        }
        if (ntok > 0) {
            for (int k0 = 0; k0 < MAXTOK; k0 += 6) { float wv[6][2], su[6][2], sv[6][2], sxv[6];
#pragma unroll
                for (int kk = 0; kk < 6; ++kk) { const int kc = (k0 + kk < ntok) ? k0 + kk : klast; const size_t tb = (size_t)(base + gw + GW * kc) * 128; sxv[kk] = ((const float*)(ws + WS_SX))[base + gw + GW * kc];
#pragma unroll
                    for (int hh = 0; hh < 2; ++hh) { const unsigned e = IL[kc * 128 + 64 * hh + lane]; wv[kk][hh] = WT[tb + 64 * hh + lane]; su[kk][hh] = SU[e]; sv[kk][hh] = SV[e]; } }
#pragma unroll
                for (int kk = 0; kk < 6; ++kk) { const int kc = (k0 + kk < ntok) ? k0 + kk : klast;
                    if (k0 + kk < ntok) {
#pragma unroll
                        for (int hh = 0; hh < 2; ++hh) ZL[kc * 128 + 64 * hh + lane] = gelu_tanh(ZL[kc * 128 + 64 * hh + lane] * (su[kk][hh] * sxv[kk])) * wv[kk][hh] * sv[kk][hh]; } } }
        }
        for (int c4 = 0; c4 < 4; ++c4) {
            const unsigned char* Vb = VT + (size_t)c4 * NEXP * 128 + 16 * j;
            const bool hi8 = (lane & 8) != 0;
            u32x4 rA[8], rB[8];
            f32x2 o[16];
#define V_ISSUE(R, k_, hf_) do { _Pragma("unroll") for (int i = 0; i < 8; ++i) { const unsigned e = IL[(k_) * 128 + 64 * (hf_) + 8 * i + g8]; R[i] = *(const u32x4*)(Vb + (size_t)e * 128); } } while (0)
#define V_ACC(R, k_, hf_) do { float av[8]; \
                _Pragma("unroll") for (int i = 0; i < 8; ++i) av[i] = ZL[(k_) * 128 + 64 * (hf_) + 8 * i + g8]; \
                _Pragma("unroll") for (int i = 0; i < 8; ++i) { const f32x2 a2 = {av[i], av[i]}; \
                    _Pragma("unroll") for (int q = 0; q < 4; ++q) { \
                        o[4 * q] += a2 * __builtin_amdgcn_cvt_scalef32_pk_f32_fp4(R[i][q], 1.0f, 0); o[4 * q + 1] += a2 * __builtin_amdgcn_cvt_scalef32_pk_f32_fp4(R[i][q], 1.0f, 1); \
                        o[4 * q + 2] += a2 * __builtin_amdgcn_cvt_scalef32_pk_f32_fp4(R[i][q], 1.0f, 2); o[4 * q + 3] += a2 * __builtin_amdgcn_cvt_scalef32_pk_f32_fp4(R[i][q], 1.0f, 3); } } } while (0)
#define V_FINISH(k_) do { const int tok_ = base + gw + GW * (k_); \
                f32x2 q8[8]; \
                _Pragma("unroll") for (int m = 0; m < 8; ++m) { \
                    const auto s0 = __builtin_amdgcn_permlane32_swap(__float_as_uint(o[m][0]), __float_as_uint(o[m + 8][0]), false, false); \
                    const auto s1 = __builtin_amdgcn_permlane32_swap(__float_as_uint(o[m][1]), __float_as_uint(o[m + 8][1]), false, false); \
                    q8[m] = (f32x2){__uint_as_float(s0[0]) + __uint_as_float(s0[1]), __uint_as_float(s1[0]) + __uint_as_float(s1[1])}; } \
                f32x2 q4[4]; \
                _Pragma("unroll") for (int m = 0; m < 4; ++m) { \
                    const auto s0 = __builtin_amdgcn_permlane16_swap(__float_as_uint(q8[m][0]), __float_as_uint(q8[m + 4][0]), false, false); \
                    const auto s1 = __builtin_amdgcn_permlane16_swap(__float_as_uint(q8[m][1]), __float_as_uint(q8[m + 4][1]), false, false); \
                    q4[m] = (f32x2){__uint_as_float(s0[0]) + __uint_as_float(s0[1]), __uint_as_float(s1[0]) + __uint_as_float(s1[1])}; } \
                float fo[4]; \
                _Pragma("unroll") for (int m = 0; m < 2; ++m) { \
                    const float k0 = hi8 ? q4[m + 2][0] : q4[m][0], k1 = hi8 ? q4[m + 2][1] : q4[m][1], t0 = hi8 ? q4[m][0] : q4[m + 2][0], t1 = hi8 ? q4[m][1] : q4[m + 2][1]; \
                    fo[2 * m] = k0 + dpp_mov<0x128>(t0); fo[2 * m + 1] = k1 + dpp_mov<0x128>(t1); } \
                u32x2 w_; w_.x = pk_bf16(fo[0], fo[1]); w_.y = pk_bf16(fo[2], fo[3]); \
                *(u32x2*)(FFN + (size_t)tok_ * D + 256 * c4 + 32 * j + 4 * g8) = w_; } while (0)
            if (ntok > 0) V_ISSUE(rA, 0, 0);
            for (int k = 0; k < ntok; ++k) {
                V_ISSUE(rB, k, 1);
#pragma unroll
                for (int q = 0; q < 16; ++q) o[q] = (f32x2){0.f, 0.f};
                V_ACC(rA, k, 0);
                V_ISSUE(rA, ((k + 1 < ntok) ? k + 1 : k), 0);
                V_ACC(rB, k, 1);
                V_FINISH(k);
            }
#undef V_ISSUE
#undef V_ACC
#undef V_FINISH
        }
        asm volatile("s_waitcnt vmcnt(0)" ::: "memory");
        u32x4 nfa, nfb, nxa, nxb;
        { const int row0 = base + gw + GW * 0 < nrows ? base + gw : 0; nfa = *(const u32x4*)(FFN + (size_t)row0 * D + 16 * lane); nfb = *(const u32x4*)(FFN + (size_t)row0 * D + 16 * lane + 8);
          nxa = *(const u32x4*)(XS + (size_t)row0 * D + 16 * lane); nxb = *(const u32x4*)(XS + (size_t)row0 * D + 16 * lane + 8); }
        for (int k = 0; k < ntok; ++k) { const int row = base + gw + GW * k;
            bf16_t* xp = XS + (size_t)row * D + 16 * lane; const int mb = mod_batch(row); const float* m = MOD + (size_t)mb * 6144 + 16 * lane;
            const u32x4 fa = nfa, fb = nfb, xa = nxa, xb = nxb;
            { const int rn = base + gw + GW * ((k + 1 < ntok) ? k + 1 : k);
              nfa = *(const u32x4*)(FFN + (size_t)rn * D + 16 * lane); nfb = *(const u32x4*)(FFN + (size_t)rn * D + 16 * lane + 8);
              nxa = *(const u32x4*)(XS + (size_t)rn * D + 16 * lane); nxb = *(const u32x4*)(XS + (size_t)rn * D + 16 * lane + 8); }
            float o[16], x1[16];
#pragma unroll
            for (int q = 0; q < 4; ++q) { o[2 * q] = bf_lo(fa[q]); o[2 * q + 1] = bf_hi(fa[q]); o[8 + 2 * q] = bf_lo(fb[q]); o[9 + 2 * q] = bf_hi(fb[q]);
                x1[2 * q] = bf_lo(xa[q]); x1[2 * q + 1] = bf_hi(xa[q]); x1[8 + 2 * q] = bf_lo(xb[q]); x1[9 + 2 * q] = bf_hi(xb[q]); }
            float y[16]; float s = 0.f;
#pragma unroll
            for (int qd = 0; qd < 4; ++qd) { const f32x4 g2 = *(const f32x4*)(m + 5 * 1024 + 4 * qd);
#pragma unroll
                for (int e = 0; e < 4; ++e) { y[4 * qd + e] = DN_ALPHA * x1[4 * qd + e] + g2[e] * o[4 * qd + e]; s += y[4 * qd + e]; } }
            const float mean = wave_sum(s) * (1.0f / 1024.0f);
            float q = 0.f;
#pragma unroll
            for (int e = 0; e < 16; ++e) { const float d = y[e] - mean; q += d * d; }
            const float rstd = rsqrtf(wave_sum(q) * (1.0f / 1024.0f) + LN_EPS);
            const float* mn = (const float*)(ws + WS_MOD) + (size_t)(L + 1 < DEPTH ? L + 1 : L) * 17 * 6144 + (size_t)mb * 6144 + 16 * lane;
            float x2[16];
#pragma unroll
            for (int qd = 0; qd < 4; ++qd) { const int col = 16 * lane + 4 * qd;
                const f32x4 gg = *(const f32x4*)(lg + col), bb = *(const f32x4*)(lb + col);
#pragma unroll
                for (int e = 0; e < 4; ++e) x2[4 * qd + e] = (y[4 * qd + e] - mean) * rstd * gg[e] + bb[e]; }
            if (L == DEPTH - 1) {
#pragma unroll
                for (int qd = 0; qd < 4; ++qd) *(f32x4*)(p.out + (size_t)row * D + 16 * lane + 4 * qd) = (f32x4){x2[4 * qd], x2[4 * qd + 1], x2[4 * qd + 2], x2[4 * qd + 3]};
            } else {
                float hh[16];
#pragma unroll
                for (int qd = 0; qd < 4; ++qd) { const f32x4 s1 = *(const f32x4*)(mn + 1024 + 4 * qd), sh = *(const f32x4*)(mn + 4 * qd);
#pragma unroll
                    for (int e = 0; e < 4; ++e) hh[4 * qd + e] = x2[4 * qd + e] * (s1[e] + 1.0f) + sh[e]; }
#pragma unroll
                for (int hf = 0; hf < 2; ++hf) { u32x4 wx, wh;
#pragma unroll
                    for (int q2 = 0; q2 < 4; ++q2) { wx[q2] = pk_bf16(x2[8 * hf + 2 * q2], x2[8 * hf + 2 * q2 + 1]); wh[q2] = pk_bf16(hh[8 * hf + 2 * q2], hh[8 * hf + 2 * q2 + 1]); }
                    *(u32x4*)(xp + 8 * hf) = wx; *(u32x4*)(H1 + (size_t)row * D + 16 * lane + 8 * hf) = wh; }
            }
        }
    }
}

DI float logsig2_16(float z) { const float zl = z * 1.4426950408889634f; return (fminf(zl, 0.f) - __builtin_amdgcn_logf(1.0f + __builtin_amdgcn_exp2f(-fabsf(zl)))) * (1.0f / 16.0f); }
template <int DIR>
DI float gla_prep_gates(const bf16_t* Qt, const bf16_t* Kt, bf16_t* OUT, const float* gl, const float (&wg)[16], float bias, int cl, unsigned (&kpk)[32]) {
    constexpr int dir = DIR;
    { int z_ = 0; asm volatile("" : "+v"(z_)); gl += z_; }
    float cum = 0.f;
#pragma unroll
        for (int blk = 0; blk < 8; ++blk) {
            float gs[8];
#pragma unroll
            for (int e = 0; e < 8; ++e) { const int i = (dir ? 56 - 8 * blk : 8 * blk) + e; float z = bias; const f32x4* gp = (const f32x4*)(gl + i * 32 + dir * 16);
#pragma unroll
                for (int r4 = 0; r4 < 4; ++r4) { const f32x4 gv = gp[r4]; z += gv[0] * wg[4 * r4] + gv[1] * wg[4 * r4 + 1] + gv[2] * wg[4 * r4 + 2] + gv[3] * wg[4 * r4 + 3]; }
                gs[e] = logsig2_16(z); }
            float kiv[8];
#pragma unroll
            for (int e = 0; e < 8; ++e) { const int pos = dir ? 7 - e : e, i = (dir ? 56 - 8 * blk : 8 * blk) + pos;
                cum += gs[pos];
                const float qv = bf1(Qt[i * 256 + cl]), kv = bf1(Kt[i * 256 + cl]);
                OUT[(dir * 64 + i) * 256 + cl] = f2bf(qv * __builtin_amdgcn_exp2f(cum)); kiv[pos] = kv * __builtin_amdgcn_exp2f(-cum); }
            u32x4 w; w.x = pk_bf16(kiv[0], kiv[1]); w.y = pk_bf16(kiv[2], kiv[3]); w.z = pk_bf16(kiv[4], kiv[5]); w.w = pk_bf16(kiv[6], kiv[7]);
            if (dir) { kpk[4 * (7 - blk)] = w.x; kpk[4 * (7 - blk) + 1] = w.y; kpk[4 * (7 - blk) + 2] = w.z; kpk[4 * (7 - blk) + 3] = w.w; }
            else { kpk[4 * blk] = w.x; kpk[4 * blk + 1] = w.y; kpk[4 * blk + 2] = w.z; kpk[4 * blk + 3] = w.w; }
            __builtin_amdgcn_sched_barrier(0);
        }
    return cum;
}
DI void phase_gla_prep(const Ctx& c, int j) {
    const Params& p = *c.p; unsigned char* ws = c.ws; const int tid = c.tid;
    const bf16_t* QG = (const bf16_t*)(ws + WS_R1); const bf16_t* KG = (const bf16_t*)(ws + WS_R1 + SZ_T512); const bf16_t* VG = (const bf16_t*)(ws + WS_R1 + 2 * SZ_T512);
    const float* GL = (const float*)(ws + WS_GL); float* DEC = (float*)(ws + WS_DEC); bf16_t* VTt = (bf16_t*)(ws + WS_VTT);
    bf16_t* Qt = (bf16_t*)c.smem;
    bf16_t* Kt = Qt + 64 * 256;
    bf16_t* OUT = Kt + 64 * 256;
    float* gl = (float*)(c.smem + 131072);
    const int dir = __builtin_amdgcn_readfirstlane(tid >> 8), cl = tid & 255;
    for (int u = c.bid; u < (T / 64) * 2; u += c.G) {
        const int ch = u >> 1, hc = u & 1, r0 = ch * 64, cg = 256 * hc + cl;
        __syncthreads();
#pragma unroll
        for (int it = 0; it < 4; ++it) { const int idx = it * 512 + tid, row = idx >> 5, c8 = (idx & 31) * 8;
            *(u32x4*)(Qt + row * 256 + c8) = *(const u32x4*)(QG + (size_t)(r0 + row) * 512 + 256 * hc + c8);
            *(u32x4*)(Kt + row * 256 + c8) = *(const u32x4*)(KG + (size_t)(r0 + row) * 512 + 256 * hc + c8); }
        ((f32x4*)gl)[tid] = ((const f32x4*)(GL + (size_t)r0 * 32))[tid];
        float wg[16];
#pragma unroll
        for (int r = 0; r < 16; ++r) wg[r] = p.in[15][((size_t)(j * 2 + dir) * 16 + r) * 512 + cg];
        const float bias = p.in[16][(size_t)(j * 2 + dir) * 512 + cg];
        __syncthreads();
        unsigned kpk[32];
        const float cum = dir ? gla_prep_gates<1>(Qt, Kt, OUT, gl, wg, bias, cl, kpk) : gla_prep_gates<0>(Qt, Kt, OUT, gl, wg, bias, cl, kpk);
        DEC[((size_t)dir * (T / 64) + ch) * 512 + cg] = __builtin_amdgcn_exp2f(cum);
        __syncthreads();
#pragma unroll 2
        for (int it = 0; it < 8; ++it) { const int idx = it * 512 + tid, d2 = idx >> 11, row = (idx >> 5) & 63, c8 = (idx & 31) * 8;
            *(u32x4*)((bf16_t*)(ws + WS_R2) + (size_t)d2 * T * 512 + (size_t)(r0 + row) * 512 + 256 * hc + c8) = *(const u32x4*)(OUT + (d2 * 64 + row) * 256 + c8); }
        bf16_t* KT = Qt;
#pragma unroll
        for (int cb = 0; cb < 8; ++cb) *(u32x4*)(KT + (dir * 256 + cl) * 64 + ((cb ^ (cl & 7)) * 8)) = (u32x4){kpk[4 * cb], kpk[4 * cb + 1], kpk[4 * cb + 2], kpk[4 * cb + 3]};
        __syncthreads();
#pragma unroll 2
        for (int it = 0; it < 8; ++it) { const int idx = it * 512 + tid, d2 = idx >> 11, clr = (idx >> 3) & 255, cb = idx & 7;
            *(u32x4*)((bf16_t*)(ws + WS_R2 + 2 * SZ_T1K) + (((size_t)d2 * (T / 64) + ch) * 512 + 256 * hc + clr) * 64 + cb * 8) = *(const u32x4*)(KT + (d2 * 256 + clr) * 64 + ((cb ^ (clr & 7)) * 8)); }
#pragma unroll
        for (int i2 = 0; i2 < 32; ++i2) { OUT[(dir * 64 + 2 * i2) * 256 + cl] = (bf16_t)(kpk[i2] & 0xffffu); OUT[(dir * 64 + 2 * i2 + 1) * 256 + cl] = (bf16_t)(kpk[i2] >> 16); }
        __syncthreads();
#pragma unroll 2
        for (int it = 0; it < 8; ++it) { const int idx = it * 512 + tid, d2 = idx >> 11, row = (idx >> 5) & 63, c8 = (idx & 31) * 8;
            *(u32x4*)((bf16_t*)(ws + WS_R2 + SZ_T1K) + (size_t)d2 * T * 512 + (size_t)(r0 + row) * 512 + 256 * hc + c8) = *(const u32x4*)(OUT + (d2 * 64 + row) * 256 + c8); }
        bf16_t* Vl = Qt;
#pragma unroll 2
        for (int it = 0; it < 8; ++it) { const int idx = it * 512 + tid, row = idx >> 6, c8 = (idx & 63) * 8;
            *(u32x4*)(Vl + row * 512 + c8) = *(const u32x4*)(VG + (size_t)(r0 + row) * 1024 + 512 * hc + c8); }
        __syncthreads();
        bf16_t* VTl = OUT;
#pragma unroll 2
        for (int cb = 0; cb < 8; ++cb) { unsigned short x[8];
#pragma unroll
            for (int t = 0; t < 8; ++t) x[t] = Vl[(8 * cb + t) * 512 + tid];
            u32x4 w; w.x = (unsigned)x[0] | ((unsigned)x[1] << 16); w.y = (unsigned)x[2] | ((unsigned)x[3] << 16); w.z = (unsigned)x[4] | ((unsigned)x[5] << 16); w.w = (unsigned)x[6] | ((unsigned)x[7] << 16);
            *(u32x4*)(VTl + tid * 64 + ((cb ^ (tid & 7)) * 8)) = w; }
        __syncthreads();
#pragma unroll 2
        for (int it = 0; it < 8; ++it) { const int idx = it * 512 + tid, er = idx >> 3, cb = idx & 7;
            *(u32x4*)(VTt + ((size_t)ch * 1024 + 512 * hc + er) * 64 + cb * 8) = *(const u32x4*)(VTl + er * 64 + ((cb ^ (er & 7)) * 8)); }
    }
}

DI void phase_gla_scan(const Ctx& c) {
    unsigned char* ws = c.ws; const int tid = c.tid, lane = c.lane, w = c.wave, g = lane >> 4, cc = lane & 15;
    const bf16_t* VTt = (const bf16_t*)(ws + WS_VTT); const float* DEC = (const float*)(ws + WS_DEC);
    constexpr int LDQ = 136, LDJ = 72;
    bf16_t* Qs = (bf16_t*)c.smem;
    bf16_t* Ks = Qs + 64 * LDQ;
    bf16_t* KEt = Ks + 64 * LDQ;
    bf16_t* Vt = KEt + 128 * LDJ;
    bf16_t* At = Vt + 128 * LDJ;
    bf16_t* St = At + 64 * LDJ;
    bf16_t* Ot = St + 128 * LDQ;
    float* dec = (float*)(Ot + 64 * LDQ);
    const int qtok0 = tid >> 4, qd8 = (tid & 15) * 8;
    const int ked0 = tid >> 3, kej8 = (tid & 7) * 8;
    for (int u = c.bid; u < NB * 4 * 2 * 2; u += c.G) {
        const int b = u >> 4, h = (u >> 2) & 3, es = (u >> 1) & 1, dir = u & 1;
        bf16_t* O = (bf16_t*)(ws + (dir ? WS_OB : WS_H1));
        const bf16_t* QIN = (const bf16_t*)(ws + WS_R2) + (size_t)dir * T * 512; const bf16_t* KIN = (const bf16_t*)(ws + WS_R2 + SZ_T1K) + (size_t)dir * T * 512;
        const bf16_t* KINt = (const bf16_t*)(ws + WS_R2 + 2 * SZ_T1K) + (size_t)dir * (T / 64) * 512 * 64;
        f32x4 accS[8];
#pragma unroll
        for (int et = 0; et < 8; ++et) accS[et] = (f32x4){0.f, 0.f, 0.f, 0.f};
        __syncthreads();
        for (int i = tid; i < 128 * LDQ / 2; i += NTHR) ((unsigned*)St)[i] = 0u;
        u32x4 pq[2], pk[2], pke[2], pv[2]; float pdec = 0.f;
#define GLA_R0(cs_) (dir == 0 ? ((cs_) < 4 ? TL + b * CTXL + 64 * (cs_) : b * SEQ + 64 * ((cs_) - 4)) : ((cs_) < 4 ? TL + b * CTXL + 64 * (3 - (cs_)) : b * SEQ + 64 * (35 - (cs_))))
#define GLA_LOAD(cs_) do { const int r0_ = GLA_R0(cs_); const int chunk_ = r0_ >> 6; \
            _Pragma("unroll") for (int it = 0; it < 2; ++it) { const size_t go = (size_t)(r0_ + qtok0 + 32 * it) * 512 + h * 128 + qd8; pq[it] = *(const u32x4*)(QIN + go); pk[it] = *(const u32x4*)(KIN + go); \
                pke[it] = *(const u32x4*)(KINt + ((size_t)chunk_ * 512 + h * 128 + ked0 + 64 * it) * 64 + kej8); \
                pv[it] = *(const u32x4*)(VTt + ((size_t)chunk_ * 1024 + h * 256 + es * 128 + ked0 + 64 * it) * 64 + kej8); } \
            if (tid < 128) pdec = DEC[((size_t)dir * (T / 64) + chunk_) * 512 + h * 128 + tid]; } while (0)
        GLA_LOAD(0);
        for (int cs = 0; cs < 36; ++cs) {
            const int r0 = GLA_R0(cs);
#pragma unroll
            for (int it = 0; it < 2; ++it) { *(u32x4*)(Qs + (qtok0 + 32 * it) * LDQ + qd8) = pq[it]; *(u32x4*)(Ks + (qtok0 + 32 * it) * LDQ + qd8) = pk[it];
                *(u32x4*)(KEt + (ked0 + 64 * it) * LDJ + kej8) = pke[it]; *(u32x4*)(Vt + (ked0 + 64 * it) * LDJ + kej8) = pv[it]; }
            if (tid < 128) dec[tid] = pdec;
            __syncthreads();
            GLA_LOAD(cs + 1 < 36 ? cs + 1 : cs);
            { const int it = w >> 1;
#pragma unroll
              for (int jj = 0; jj < 2; ++jj) { const int jt = 2 * (w & 1) + jj; f32x4 a = {0.f, 0.f, 0.f, 0.f};
#pragma unroll
                  for (int ks = 0; ks < 4; ++ks) a = mfma16(frag_ld(Qs, LDQ, 16 * it, 32 * ks, lane), frag_ld(Ks, LDQ, 16 * jt, 32 * ks, lane), a);
                  const int jcol = 16 * jt + cc;
#pragma unroll
                  for (int r = 0; r < 4; ++r) { const int i = 16 * it + 4 * g + r; const bool keep = dir ? (jcol >= i) : (jcol <= i);
                      At[i * LDJ + jcol] = f2bf(keep ? a[r] : 0.f); } } }
            __syncthreads();
            { const int it = w >> 1;
#pragma unroll
              for (int ee = 0; ee < 4; ++ee) { const int et = 4 * (w & 1) + ee; f32x4 a = {0.f, 0.f, 0.f, 0.f};
#pragma unroll
                  for (int ks = 0; ks < 2; ++ks) a = mfma16(frag_ld(At, LDJ, 16 * it, 32 * ks, lane), frag_ld(Vt, LDJ, 16 * et, 32 * ks, lane), a);
#pragma unroll
                  for (int ks = 0; ks < 4; ++ks) a = mfma16(frag_ld(Qs, LDQ, 16 * it, 32 * ks, lane), frag_ld(St, LDQ, 16 * et, 32 * ks, lane), a);
#pragma unroll
                  for (int r = 0; r < 4; ++r) Ot[(16 * it + 4 * g + r) * LDQ + 16 * et + cc] = f2bf(a[r]); } }
#pragma unroll
            for (int et = 0; et < 8; ++et) {
#pragma unroll
                for (int ks = 0; ks < 2; ++ks) accS[et] = mfma16(frag_ld(KEt, LDJ, 16 * w, 32 * ks, lane), frag_ld(Vt, LDJ, 16 * et, 32 * ks, lane), accS[et]);
#pragma unroll
                for (int r = 0; r < 4; ++r) accS[et][r] *= dec[16 * w + 4 * g + r];
            }
            __syncthreads();
#pragma unroll
            for (int et = 0; et < 8; ++et) { u32x2 sv; sv.x = pk_bf16(accS[et][0], accS[et][1]); sv.y = pk_bf16(accS[et][2], accS[et][3]);
                *(u32x2*)(St + (16 * et + cc) * LDQ + 16 * w + 4 * g) = sv; }
#pragma unroll
            for (int it = 0; it < 2; ++it) *(u32x4*)(O + (size_t)(r0 + qtok0 + 32 * it) * 1024 + h * 256 + es * 128 + qd8) = *(const u32x4*)(Ot + (qtok0 + 32 * it) * LDQ + qd8);
        }
#undef GLA_LOAD
#undef GLA_R0
    }
}

DI void phase_gla_readout(const Ctx& c, int j) {
    const Params& p = *c.p; unsigned char* ws = c.ws;
    const bf16_t* O = (const bf16_t*)(ws + WS_H1); const bf16_t* OB = (const bf16_t*)(ws + WS_OB); const bf16_t* RG = (const bf16_t*)(ws + WS_R1 + 2 * SZ_T512 + SZ_T1K); bf16_t* Y = (bf16_t*)(ws + WS_R2);
    const float* gn = p.in[17] + (size_t)j * 1024; const int stride = c.G * NWAVE;
    for (int row0 = c.bid * NWAVE + c.wave; row0 < T; row0 += 2 * stride) {
        const bool has2 = row0 + stride < T; const int rows[2] = {row0, has2 ? row0 + stride : row0};
        u32x2 ov[2][4], ow[2][4], rv[2][4];
#pragma unroll
        for (int rr = 0; rr < 2; ++rr)
#pragma unroll
            for (int hd = 0; hd < 4; ++hd) { const size_t o = (size_t)rows[rr] * D + 4 * c.lane + 256 * hd; ov[rr][hd] = *(const u32x2*)(O + o); ow[rr][hd] = *(const u32x2*)(OB + o); rv[rr][hd] = *(const u32x2*)(RG + o); }
#pragma unroll
        for (int rr = 0; rr < 2; ++rr) {
            if (rr == 1 && !has2) break;
#pragma unroll
            for (int hd = 0; hd < 4; ++hd) { const int col = 4 * c.lane + 256 * hd;
                const float x0 = bf_lo(ov[rr][hd].x) + bf_lo(ow[rr][hd].x), x1 = bf_hi(ov[rr][hd].x) + bf_hi(ow[rr][hd].x), x2 = bf_lo(ov[rr][hd].y) + bf_lo(ow[rr][hd].y), x3 = bf_hi(ov[rr][hd].y) + bf_hi(ow[rr][hd].y);
                const float mean = wave_sum((x0 + x1) + (x2 + x3)) * (1.0f / 256.0f);
                const float d0 = x0 - mean, d1 = x1 - mean, d2 = x2 - mean, d3 = x3 - mean;
                const float rstd = rsqrtf(wave_sum((d0 * d0 + d1 * d1) + (d2 * d2 + d3 * d3)) * (1.0f / 256.0f) + LN_EPS);
                const f32x4 gg = *(const f32x4*)(gn + col);
                const float r0 = bf_lo(rv[rr][hd].x), r1 = bf_hi(rv[rr][hd].x), r2 = bf_lo(rv[rr][hd].y), r3 = bf_hi(rv[rr][hd].y);
                u32x2 o; o.x = pk_bf16(d0 * rstd * gg[0] * silu_f(r0), d1 * rstd * gg[1] * silu_f(r1)); o.y = pk_bf16(d2 * rstd * gg[2] * silu_f(r2), d3 * rstd * gg[3] * silu_f(r3));
                *(u32x2*)(Y + (size_t)rows[rr] * D + col) = o; }
        }
    }
}

constexpr int N_PHASES = 2 + 2 * 8 + 2 * 9;

__global__ void __launch_bounds__(NTHR, 2) mega_fwd(Params p) {
    extern __shared__ __attribute__((aligned(16))) unsigned char smem[];
    cg::grid_group grid = cg::this_grid();
    Ctx c; c.p = &p; c.ws = p.ws; c.smem = smem; c.tid = threadIdx.x; c.lane = c.tid & 63; c.wave = __builtin_amdgcn_readfirstlane(c.tid >> 6); c.G = gridDim.x; c.bid = blockIdx.x;
    unsigned char* ws = p.ws;
    volatile LAS unsigned* xst = (volatile LAS unsigned*)((LAS unsigned char*)smem + (LDS_BYTES - 16));
    if (threadIdx.x == 0) { xst[0] = 0u; xst[1] = 0u; }
    __syncthreads();
    const XcdBarrier xbar = xcd_barrier_post((unsigned*)(ws + WS_CTL), xst);
    const int lo = p.ph_lo, hi = p.ph_hi;
    int ph = 0;
#ifndef PH_ONLY
#define PH_ONLY -1
#endif
#ifndef DUP_MASK
#define DUP_MASK 0
#endif
#define RUN1(...) { { int t_ = threadIdx.x; asm volatile("" : "+v"(t_)); c.tid = t_; c.lane = t_ & 63; c.wave = __builtin_amdgcn_readfirstlane(t_ >> 6); { size_t z_ = 0; asm volatile("" : "+s"(z_)); ws = p.ws + z_; } c.ws = ws; } __VA_ARGS__; }
#define RUN(id, ...) do { if ((PH_ONLY < 0 || PH_ONLY == (id)) && ph >= lo && ph < hi) { \
        RUN1(__VA_ARGS__) \
        if ((DUP_MASK >> (id)) & 1) { xcd_barrier(xbar); RUN1(__VA_ARGS__) } \
        if (ph + 1 < hi) { if (ph == 0) grid.sync(); else xcd_barrier(xbar); } } ++ph; } while (0)
    LAS unsigned char* lds = (LAS unsigned char*)smem;
    const float* MOD = (const float*)(ws + WS_MOD);

    RUN(0, phase_prologue(c));
    RUN(1, phase_mod0(c));
    for (int L = 0; L < DEPTH; ++L) {
        const int j = L >> 1;
        if ((L & 1) == 0) {
            RUN(2, { pg8::Gemm g{(const bf16_t*)(ws + WS_H1), (const bf16_t*)(ws + WS_WAIN) + (size_t)j * 2048 * 1024, T, 2048, 1024}; pg8::StaticOrder S; S.init(T, 2048, c.G, c.bid);
                  pg8::EpiBf16<1> E{(bf16_t*)(ws + WS_R1), 2048}; pg8::gemm_phase(lds, g, S, E, c.tid); });
            RUN(3, phase_vstats(c));
            RUN(4, phase_spatial(c, j));
        } else {
            RUN(5, { pg8::Gemm g{(const bf16_t*)(ws + WS_H1), (const bf16_t*)(ws + WS_WBIN) + (size_t)j * WBIN_N * 1024, T, WBIN_N, 1024}; pg8::StaticOrder S; S.init(T, WBIN_N, c.G, c.bid);
                  pg8::EpiGlaProj E{(bf16_t*)(ws + WS_R1), (bf16_t*)(ws + WS_R1 + SZ_T512), (bf16_t*)(ws + WS_R1 + 2 * SZ_T512), (bf16_t*)(ws + WS_R1 + 2 * SZ_T512 + SZ_T1K), (float*)(ws + WS_GL)};
                  pg8::gemm_phase(lds, g, S, E, c.tid); });
            RUN(6, phase_gla_prep(c, j));
            RUN(7, phase_gla_scan(c));
            RUN(8, phase_gla_readout(c, j));
        }
        const int Mrows = (L == DEPTH - 1) ? TL : T;
        RUN(9, { const bf16_t* W = (L & 1) ? (const bf16_t*)(ws + WS_WBOUT) + (size_t)j * 1024 * 1024 : (const bf16_t*)(ws + WS_WAOUT) + (size_t)j * 1024 * 1024;
              pg8::Gemm g{(const bf16_t*)(ws + WS_R2), W, Mrows, 1024, 1024}; pg8::StaticOrder S; S.init(Mrows, 1024, c.G, c.bid);
              pg8::EpiRes E{p.in[0], p.in[2], (bf16_t*)(ws + WS_XS), MOD + (size_t)L * 17 * 6144, 2, L == 0 ? 1 : 0};
              pg8::gemm_phase(lds, g, S, E, c.tid); });
        RUN(10, phase_ln1(c, L));
        RUN(11, { pg8::Gemm g{(const bf16_t*)(ws + WS_R2 + SZ_T1K), (const bf16_t*)(ws + WS_WQ) + (size_t)L * 1024 * 1024, Mrows, 1024, 1024}; pg8::StaticOrder S; S.init(Mrows, 1024, c.G, c.bid);
              pg8::EpiBf16<0> E{(bf16_t*)(ws + WS_R1), 1024}; pg8::gemm_phase(lds, g, S, E, c.tid); });
        RUN(12, phase_route(c, L));
        RUN(13, phase_experts(c, L));
    }
#undef RUN
}

extern "C" void kernel_launch(void* const* d_in, const int* in_sizes, int n_in, void* d_out, int out_size, void* d_ws, size_t ws_size, hipStream_t stream) {
    static int grid = 0;
    if (grid == 0) {
        if (n_in != 23 || out_size != TL * D || ws_size < WS_END) { fprintf(stderr, "kernel_launch: unexpected shapes: n_in %d out %d ws %zu (need %zu)\n", n_in, out_size, ws_size, (size_t)WS_END); grid = -1; return; }
        int dev = 0, cus = 0, per_cu = 0;
        if (hipGetDevice(&dev) != hipSuccess || hipDeviceGetAttribute(&cus, hipDeviceAttributeMultiprocessorCount, dev) != hipSuccess) { fprintf(stderr, "kernel_launch: device query failed\n"); grid = -1; return; }
        if (hipFuncSetAttribute((const void*)mega_fwd, hipFuncAttributeMaxDynamicSharedMemorySize, LDS_BYTES) != hipSuccess) { fprintf(stderr, "kernel_launch: hipFuncSetAttribute failed\n"); grid = -1; return; }
        if (hipOccupancyMaxActiveBlocksPerMultiprocessor(&per_cu, (const void*)mega_fwd, NTHR, LDS_BYTES) != hipSuccess || per_cu < 1) { fprintf(stderr, "kernel_launch: occupancy query says %d blocks per CU\n", per_cu); grid = -1; return; }
        grid = cus;
    }
    if (grid < 0) return;
    (void)hipMemsetAsync((char*)d_ws + WS_CTL, 0, 65536, stream);
    Params p{};
    for (int i = 0; i < 23; ++i) p.in[i] = (const float*)d_in[i];
    p.out = (float*)d_out; p.ws = (unsigned char*)d_ws; p.ph_lo = 0; p.ph_hi = N_PHASES;
    void* args[] = {&p};
    const hipError_t e = hipLaunchCooperativeKernel((const void*)mega_fwd, dim3(grid), dim3(NTHR), args, LDS_BYTES, stream);
    if (e != hipSuccess) fprintf(stderr, "kernel_launch: cooperative launch failed: %s (grid %d)\n", hipGetErrorString(e), grid);
}
```

```cpp
#include <hip/hip_runtime.h>
#include <hip/hip_cooperative_groups.h>
#include <cstdio>
#include <cstdint>
namespace cg = cooperative_groups;

#define LAS __attribute__((address_space(3)))
#define DI __device__ __forceinline__
typedef unsigned short bf16_t;
typedef short bf16x8 __attribute__((ext_vector_type(8)));
typedef float f32x4 __attribute__((ext_vector_type(4)));
typedef float f32x2 __attribute__((ext_vector_type(2)));
typedef unsigned u32x4 __attribute__((ext_vector_type(4)));
typedef unsigned u32x2 __attribute__((ext_vector_type(2)));
typedef __bf16 bf16v2 __attribute__((ext_vector_type(2)));

constexpr int D = 1024, NB = 16, SEQ = 2048, CTXL = 256, DEPTH = 4;
constexpr int TL = NB * SEQ, TC = NB * CTXL, T = TL + TC;
constexpr int NEXP = 16384;
constexpr float LN_EPS = 1e-5f;
constexpr float DN_ALPHA = 1.6817928305074290f;
constexpr int NTHR = 512, NWAVE = 8;
constexpr int LDS_BYTES = 140 * 1024;
constexpr int WBIN_N = 3328;

constexpr size_t al256(size_t x) { return (x + 255) & ~(size_t)255; }
constexpr size_t WS_CTL = 0;
constexpr size_t WS_MOD = 65536;
constexpr size_t WS_STATS = al256(WS_MOD + (size_t)4 * 17 * 6144 * 4);
constexpr size_t WS_GL = al256(WS_STATS + (size_t)T * 2 * 4);
constexpr size_t WS_DEC = al256(WS_GL + (size_t)T * 32 * 4);
constexpr size_t WS_WSB = al256(WS_DEC + (size_t)2 * 576 * 512 * 4);
constexpr size_t WS_WAIN = al256(WS_WSB + (size_t)2 * 8 * 128 * 128 * 2);
constexpr size_t WS_WAOUT = WS_WAIN + (size_t)2 * 2048 * 1024 * 2;
constexpr size_t WS_WBIN = WS_WAOUT + (size_t)2 * 1024 * 1024 * 2;
constexpr size_t WS_WBOUT = WS_WBIN + (size_t)2 * WBIN_N * 1024 * 2;
constexpr size_t WS_WQ = WS_WBOUT + (size_t)2 * 1024 * 1024 * 2;
constexpr size_t WS_UT = WS_WQ + (size_t)4 * 1024 * 1024 * 2;
constexpr size_t WS_VT = WS_UT + (size_t)4 * NEXP * 1024;
constexpr size_t WS_SU = WS_VT + (size_t)4 * NEXP * 1024;
constexpr size_t WS_SV = WS_SU + (size_t)4 * NEXP * 4;
constexpr size_t WS_XS = WS_SV + (size_t)4 * NEXP * 4;
constexpr size_t WS_R1 = WS_XS + (size_t)T * 1024 * 4;
constexpr size_t WS_R2 = WS_R1 + (size_t)T * 3072 * 2;
constexpr size_t WS_H1 = WS_R2 + (size_t)T * 3072 * 2;
constexpr size_t WS_VTT = WS_H1 + (size_t)T * 1024 * 2;
constexpr size_t WS_OB = WS_VTT + (size_t)T * 1024 * 2;
constexpr size_t WS_XH = WS_OB + (size_t)T * 1024 * 2;
constexpr size_t WS_XL = WS_XH + (size_t)T * 512;
constexpr size_t WS_SX = WS_XL + (size_t)T * 512;
constexpr size_t WS_P1 = al256(WS_SX + (size_t)T * 4);
constexpr size_t WS_QP2 = WS_P1 + (size_t)4096 * 1024 * 2;
constexpr size_t WS_END = al256(WS_QP2 + (size_t)4096 * 1024 * 2);
constexpr size_t SZ_T1K = (size_t)T * 1024 * 2;
constexpr size_t SZ_T512 = (size_t)T * 512 * 2;

struct Params { const float* in[23]; float* out; unsigned char* ws; int ph_lo, ph_hi; };

DI unsigned pk_bf16(float lo, float hi) { f32x2 v = {lo, hi}; return __builtin_bit_cast(unsigned, __builtin_convertvector(v, bf16v2)); }
DI float bf_lo(unsigned w) { return __uint_as_float(w << 16); }
DI float bf_hi(unsigned w) { return __uint_as_float(w & 0xffff0000u); }
DI float bf1(bf16_t b) { return __uint_as_float(((unsigned)b) << 16); }
DI bf16_t f2bf(float f) { return (bf16_t)(pk_bf16(f, 0.f) & 0xffffu); }
DI float gelu_tanh(float x) { const float t = x * x; const float w = x * (t * (-2.0f * 1.4426950408889634f * 0.7978845608028654f * 0.044715f) + (-2.0f * 1.4426950408889634f * 0.7978845608028654f)); return x * __builtin_amdgcn_rcpf(1.0f + __builtin_amdgcn_exp2f(w)); }
DI float silu_f(float x) { return x * __builtin_amdgcn_rcpf(1.0f + __builtin_amdgcn_exp2f(-1.4426950408889634f * x)); }
DI float logsig_f(float z) { return fminf(z, 0.f) - log1pf(expf(-fabsf(z))); }
template <int CTRL> DI float dpp_mov(float x) { return __builtin_bit_cast(float, __builtin_amdgcn_mov_dpp(__builtin_bit_cast(int, x), CTRL, 0xf, 0xf, true)); }
DI void lds_barrier() { asm volatile("s_waitcnt lgkmcnt(0)" ::: "memory"); __builtin_amdgcn_s_barrier(); asm volatile("" ::: "memory"); }
DI float wave_sum(float v) {
    const auto a = __builtin_amdgcn_permlane32_swap(__float_as_uint(v), __float_as_uint(v), false, false); v = __uint_as_float(a[0]) + __uint_as_float(a[1]);
    const auto b = __builtin_amdgcn_permlane16_swap(__float_as_uint(v), __float_as_uint(v), false, false); v = __uint_as_float(b[0]) + __uint_as_float(b[1]);
    v += dpp_mov<0x128>(v); v += dpp_mov<0x124>(v); v += dpp_mov<0x122>(v); v += dpp_mov<0x121>(v);
    return v;
}
DI float wave_max(float v) {
#pragma unroll
    for (int o = 32; o > 0; o >>= 1) v = fmaxf(v, __shfl_xor(v, o, 64));
    return v;
}
DI float reduce4(float p0, float p1, float p2, float p3) {
    const auto a = __builtin_amdgcn_permlane32_swap(__float_as_uint(p0), __float_as_uint(p2), false, false); const float q0 = __uint_as_float(a[0]) + __uint_as_float(a[1]);
    const auto b = __builtin_amdgcn_permlane32_swap(__float_as_uint(p1), __float_as_uint(p3), false, false); const float q1 = __uint_as_float(b[0]) + __uint_as_float(b[1]);
    const auto c = __builtin_amdgcn_permlane16_swap(__float_as_uint(q0), __float_as_uint(q1), false, false); float s = __uint_as_float(c[0]) + __uint_as_float(c[1]);
    s += dpp_mov<0x128>(s); s += dpp_mov<0x124>(s); s += dpp_mov<0x122>(s); s += dpp_mov<0x121>(s);
    return s;
}
DI float dot2bf(unsigned a, unsigned b, float c) { return __builtin_amdgcn_fdot2_f32_bf16(__builtin_bit_cast(bf16v2, a), __builtin_bit_cast(bf16v2, b), c, false); }
DI f32x4 mfma16(bf16x8 a, bf16x8 b, f32x4 c) { return __builtin_amdgcn_mfma_f32_16x16x32_bf16(a, b, c, 0, 0, 0); }
DI bf16x8 frag_ld(const bf16_t* X, int ld, int row0, int k0, int lane) { return *(const bf16x8*)(X + (size_t)(row0 + (lane & 15)) * ld + k0 + 8 * (lane >> 4)); }
DI int mod_batch(int row) { return row < TL ? (row >> 11) : NB; }

#define XB_TMO      128
#define XB_XCNT(j)  (256  + 64 * (j))
#define XB_XSUB(j)  (1280 + 64 * (j))
#define XB_XGEN(j)  (2304 + 64 * (j))
#define XB_TOP      3328
#define XB_TOPGEN   3392
#define XCD_BAR_WORDS 3456
#define XB_SPIN_CAP (1u << 22)
DI unsigned xb_ld(unsigned* p)              { return __hip_atomic_load(p, __ATOMIC_RELAXED, __HIP_MEMORY_SCOPE_AGENT); }
DI unsigned xb_add(unsigned* p, unsigned v) { return __hip_atomic_fetch_add(p, v, __ATOMIC_RELAXED, __HIP_MEMORY_SCOPE_AGENT); }
DI unsigned xb_xcc_id() { return (unsigned)__builtin_amdgcn_s_getreg((3 << 11) | 20) & 0xFu; }
#define XB_SPIN(cond, bar) do { unsigned _sp = 0; while (cond) { __builtin_amdgcn_s_sleep(1); \
    if ((++_sp & 255u) == 0u) { if (xb_ld(&(bar)[XB_TMO])) break; if (_sp > XB_SPIN_CAP) { atomicAdd(&(bar)[XB_TMO], 1u); break; } } } } while (0)
struct XcdBarrier { unsigned* bar; unsigned x; volatile LAS unsigned* st; };
DI XcdBarrier xcd_barrier_post(unsigned* bar, volatile LAS unsigned* st) {
    XcdBarrier b; b.bar = bar; b.x = xb_xcc_id(); b.st = st;
    if (threadIdx.x == 0) (void)xb_add(&bar[XB_XCNT(b.x)], 1u);
    return b;
}
DI void xcd_barrier_complete(unsigned* bar, unsigned x, unsigned& nloc, unsigned& nx) {
    const unsigned G = gridDim.x * gridDim.y * gridDim.z;
    unsigned sum, cnt, mine, sp = 0u;
    for (;;) {
        sum = 0u; cnt = 0u; mine = 0u;
#pragma unroll
        for (unsigned j = 0; j < 16; ++j) { const unsigned c = xb_ld(&bar[XB_XCNT(j)]); sum += c; cnt += (c > 0u) ? 1u : 0u; mine = (j == x) ? c : mine; }
        if (sum == G) break;
        __builtin_amdgcn_s_sleep(1);
        if ((++sp & 255u) == 0u) { if (xb_ld(&bar[XB_TMO])) break; if (sp > XB_SPIN_CAP) { atomicAdd(&bar[XB_TMO], 1u); break; } }
    }
    nloc = mine > 0u ? mine : 1u; nx = cnt > 0u ? cnt : 1u;
}
DI void xcd_barrier(const XcdBarrier& b) {
    asm volatile("s_waitcnt vmcnt(0)" ::: "memory");
    __syncthreads();
    if (threadIdx.x == 0) {
        unsigned* bar = b.bar;
        __builtin_amdgcn_s_waitcnt(0);
        unsigned nloc = b.st[0], nx = b.st[1];
        if (nloc == 0u) { xcd_barrier_complete(bar, b.x, nloc, nx); b.st[0] = nloc; b.st[1] = nx; }
        const unsigned old = xb_add(&bar[XB_XSUB(b.x)], 1u);
        const unsigned gen = old / nloc;
        if (old + 1u == (gen + 1u) * nloc) {
            __builtin_amdgcn_fence(__ATOMIC_RELEASE, "agent");
            asm volatile("s_waitcnt vmcnt(0)" ::: "memory");
            const unsigned og = xb_add(&bar[XB_TOP], 1u);
            const unsigned tg = og / nx;
            if (og + 1u == (tg + 1u) * nx) xb_add(&bar[XB_TOPGEN], 1u);
            else XB_SPIN(xb_ld(&bar[XB_TOPGEN]) == tg, bar);
            __builtin_amdgcn_fence(__ATOMIC_ACQUIRE, "agent");
            xb_add(&bar[XB_XGEN(b.x)], 1u);
            asm volatile("s_waitcnt vmcnt(0)" ::: "memory");
        } else {
            XB_SPIN(xb_ld(&bar[XB_XGEN(b.x)]) == gen, bar);
            __builtin_amdgcn_fence(__ATOMIC_ACQUIRE, "agent");
            asm volatile("s_waitcnt vmcnt(0)" ::: "memory");
        }
    }
    __syncthreads();
}

namespace pg8 {
constexpr int BM = 256, BK = 64, HALF = 128, HTB = HALF * BK * 2, STAGE_BYTES = 8 * HTB, NXCD = 8, WGM = 8;
__host__ __device__ __forceinline__ int lds_byte(int r, int c) { const int st = (r >> 4) * 2 + (c >> 5), rr = r & 15, cc = c & 31, ob = rr * 64 + cc * 2; return st * 1024 + (ob ^ (((ob >> 9) & 1) << 5)); }
__host__ __device__ __forceinline__ void stage_rc(int b, int& R, int& C) { const int st = b / 1024, sb = b % 1024, swz = sb ^ (((sb >> 9) & 1) << 5); R = (st >> 1) * 16 + swz / 64; C = (st & 1) * 32 + (swz % 64) / 2; }
__host__ __device__ __forceinline__ int perm32(int rho) { const int n = rho >> 4, i = rho & 15; return 8 * (i >> 2) + 4 * n + (i & 3); }
struct Unit { int pm, pn, kh, sp; };
struct Gemm { const bf16_t* A; const bf16_t* Bt; int M, N, K; };
struct StaticOrder {
    int nM, nN, nwg, G, c, F, R2, nMm;
    __device__ __forceinline__ void init(int M, int N, int G_, int c_, bool allow_split = false) { nM = M / BM; nN = N / BM; nwg = nM * nN; G = G_; c = c_; F = nwg / G; const int R = nwg % G;
        R2 = (allow_split && R > 0 && 2 * R <= G && ((F * G) % nN) == 0 && R <= 4096 / BM * nN) ? 2 * R : 0; nMm = R2 ? (F * G) / nN : nM; }
    __device__ __forceinline__ int tail_busy() const { return R2 ? R2 : nwg % G; }
    __device__ __forceinline__ int tail_row0() const { return nMm * BM; }
    __device__ __forceinline__ bool next(int i, Unit& u) const {
        u.kh = 0; u.sp = 0;
        if (R2 && i >= F) { if (i > F || c >= R2) return false; const int q = F * G + (c >> 1); u.pm = q / nN; u.pn = q % nN; u.kh = c & 1; u.sp = 1; return true; }
        const long L = (long)i * G + c; const int nw = R2 ? F * G : nwg; if (L >= nw) return false;
        int wgid = (int)L; { const int q = nw / NXCD, r = nw % NXCD, xcd = wgid % NXCD, off = wgid / NXCD; wgid = (xcd < r ? xcd * (q + 1) : r * (q + 1) + (xcd - r) * q) + off; }
        const int nig = WGM * nN, gid = wgid / nig, fm = gid * WGM, gsz = (nMm - fm) < WGM ? (nMm - fm) : WGM;
        u.pm = fm + ((wgid % nig) % gsz); u.pn = (wgid % nig) / gsz; return true;
    }
};
DI int gemm_tail_row0(int M, int N, int G) { const int nM = M / BM, nN = N / BM, nwg = nM * nN, F = nwg / G, R = nwg % G;
    return (R > 0 && 2 * R <= G && ((F * G) % nN) == 0 && R <= 4096 / BM * nN) ? (F * G) / nN * BM : M; }

template <class Epi>
__device__ __forceinline__ void gemm_phase(LAS unsigned char* lds, const Gemm g, const StaticOrder& S, const Epi& E, const int tid) {
    const int wid = __builtin_amdgcn_readfirstlane(tid >> 6), lane = tid & 63, wr = wid >> 2, wc = wid & 3, fr = lane & 15, fq = lane >> 4;
    const int K = g.K, nt = K / BK;
    unsigned voffA[2], voffB[2];
#pragma unroll
    for (int i = 0; i < 2; ++i) { int R, C; stage_rc(tid * 16 + i * 8192, R, C); const int Rb = Epi::PERM ? ((R & ~31) + perm32(R & 31)) : R;
        voffA[i] = (unsigned)(R * K + C) * 2u; voffB[i] = (unsigned)(Rb * K + C) * 2u; }
    const size_t kstep = (size_t)(BK * 2);
    const size_t hstep = (size_t)HALF * K * 2;
    const size_t tstep = 2 * hstep;
    const unsigned ldsw = (unsigned)wid * 1024u;
    const int aoff = lds_byte(wr * 64 + fr, fq * 8), boff = lds_byte(wc * 32 + fr, fq * 8);
#define PG8_SA(b, h) (((b) * 2 + (h)) * HTB)
#define PG8_SB(b, h) ((4 + (b) * 2 + (h)) * HTB)
#define PG8_STAGE(bufoff, gbase, voff) do { _Pragma("unroll") for (int _i = 0; _i < 2; ++_i) \
        __builtin_amdgcn_global_load_lds((const unsigned*)((const char*)(gbase) + (voff)[_i]), (LAS unsigned*)(lds + (bufoff) + ldsw + _i * 8192), 16, 0, 0); } while (0)
#define PG8_LDA(dst, b, h) do { _Pragma("unroll") for (int m = 0; m < 4; ++m) _Pragma("unroll") for (int k = 0; k < 2; ++k) dst[m][k] = *(const LAS bf16x8*)(lds + PG8_SA(b, h) + aoff + m * 2048 + k * 1024); } while (0)
#define PG8_LDB(dst, b, h) do { _Pragma("unroll") for (int n = 0; n < 2; ++n) _Pragma("unroll") for (int k = 0; k < 2; ++k) dst[n][k] = *(const LAS bf16x8*)(lds + PG8_SB(b, h) + boff + n * 2048 + k * 1024); } while (0)
#define PG8_MMA(ai, bj, At, Bt) do { __builtin_amdgcn_s_setprio(1); _Pragma("unroll") for (int m = 0; m < 4; ++m) _Pragma("unroll") for (int n = 0; n < 2; ++n) _Pragma("unroll") for (int k = 0; k < 2; ++k) \
        acc[ai][bj][m][n] = __builtin_amdgcn_mfma_f32_16x16x32_bf16(Bt[n][k], At[m][k], acc[ai][bj][m][n], 0, 0, 0); __builtin_amdgcn_s_setprio(0); } while (0)
#define PG8_WAIT_V(n) asm volatile("s_waitcnt vmcnt(" #n ")" ::: "memory")
#define PG8_WAIT_L(n) asm volatile("s_waitcnt lgkmcnt(" #n ")" ::: "memory")
#define PG8_BAR __builtin_amdgcn_s_barrier()
#define PG8_SCHED __builtin_amdgcn_sched_barrier(0)
    Unit cur, nxt; int ui = 0;
    if (!S.next(0, cur)) return;
    f32x4 acc[2][2][4][2];
#pragma unroll
    for (int a = 0; a < 2; ++a)
#pragma unroll
        for (int b = 0; b < 2; ++b)
#pragma unroll
            for (int m = 0; m < 4; ++m)
#pragma unroll
                for (int n = 0; n < 2; ++n) acc[a][b][m][n] = (f32x4){0.f, 0.f, 0.f, 0.f};
    bf16x8 At[4][2], B0[2][2], B1[2][2];
    const char* cA = (const char*)g.A + (size_t)cur.pm * tstep + (size_t)cur.kh * K; const char* cB = (const char*)g.Bt + (size_t)cur.pn * tstep + (size_t)cur.kh * K;

    PG8_STAGE(PG8_SB(0, 0), cB, voffB); PG8_STAGE(PG8_SB(0, 1), cB + hstep, voffB); PG8_STAGE(PG8_SA(0, 0), cA, voffA); PG8_STAGE(PG8_SA(0, 1), cA + hstep, voffA);
    if (wr == 1) PG8_BAR;
    PG8_WAIT_V(2); PG8_BAR;
    PG8_STAGE(PG8_SB(1, 0), cB + kstep, voffB); PG8_STAGE(PG8_SA(1, 0), cA + kstep, voffA); PG8_STAGE(PG8_SB(1, 1), cB + hstep + kstep, voffB);
    PG8_WAIT_V(6); PG8_BAR;
    for (;;) {
        const bool has_next = S.next(ui + 1, nxt);
        const char* nA = has_next ? (const char*)g.A + (size_t)nxt.pm * tstep + (size_t)nxt.kh * K : cA; const char* nB = has_next ? (const char*)g.Bt + (size_t)nxt.pn * tstep + (size_t)nxt.kh * K : cB;
#define PG8_KLOOP(NT_) \
        for (int t = 0; t < (NT_); t += 2) { \
            const bool last = (t == (NT_) - 2); \
            const char* a1 = cA + (size_t)(t + 1) * kstep; \
            const char* a2 = last ? nA : cA + (size_t)(t + 2) * kstep; const char* b2 = last ? nB : cB + (size_t)(t + 2) * kstep; \
            const char* a3 = a2 + kstep; const char* b3 = b2 + kstep; \
            PG8_LDB(B0, 0, 0); PG8_LDB(B1, 0, 1); PG8_SCHED; PG8_LDA(At, 0, 0); PG8_STAGE(PG8_SA(1, 1), a1 + hstep, voffA); \
            PG8_WAIT_V(8); PG8_WAIT_L(0); PG8_BAR; PG8_MMA(0, 0, At, B0); PG8_MMA(0, 1, At, B1); PG8_BAR; PG8_SCHED; \
            PG8_LDA(At, 0, 1); PG8_STAGE(PG8_SB(0, 0), b2, voffB); PG8_STAGE(PG8_SB(0, 1), b2 + hstep, voffB); PG8_STAGE(PG8_SA(0, 0), a2, voffA); \
            PG8_WAIT_V(8); PG8_WAIT_L(0); PG8_BAR; PG8_MMA(1, 0, At, B0); PG8_MMA(1, 1, At, B1); PG8_BAR; PG8_SCHED; \
            PG8_LDB(B0, 1, 0); PG8_LDB(B1, 1, 1); PG8_SCHED; PG8_LDA(At, 1, 0); PG8_STAGE(PG8_SA(0, 1), a2 + hstep, voffA); \
            PG8_WAIT_V(8); PG8_WAIT_L(0); PG8_BAR; PG8_MMA(0, 0, At, B0); PG8_MMA(0, 1, At, B1); PG8_BAR; PG8_SCHED; \
            PG8_LDA(At, 1, 1); PG8_STAGE(PG8_SB(1, 0), b3, voffB); PG8_STAGE(PG8_SB(1, 1), b3 + hstep, voffB); PG8_STAGE(PG8_SA(1, 0), a3, voffA); \
            PG8_WAIT_V(8); PG8_WAIT_L(0); PG8_BAR; PG8_MMA(1, 0, At, B0); PG8_MMA(1, 1, At, B1); PG8_BAR; PG8_SCHED; \
        }
        if (cur.sp) { PG8_KLOOP(nt / 2) } else { PG8_KLOOP(nt) }
#undef PG8_KLOOP
        if (wr == 0) PG8_BAR;
        E(acc, cur, wr, wc, fr, fq);
        if (!has_next) break;
#pragma unroll
        for (int a = 0; a < 2; ++a)
#pragma unroll
            for (int b = 0; b < 2; ++b)
#pragma unroll
                for (int m = 0; m < 4; ++m)
#pragma unroll
                    for (int n = 0; n < 2; ++n) acc[a][b][m][n] = (f32x4){0.f, 0.f, 0.f, 0.f};
        cur = nxt; cA = nA; cB = nB; ++ui;
        if (wr == 1) PG8_BAR;
    }
    PG8_WAIT_V(0);
    PG8_BAR;
#undef PG8_SA
#undef PG8_SB
#undef PG8_STAGE
#undef PG8_LDA
#undef PG8_LDB
#undef PG8_MMA
#undef PG8_WAIT_V
#undef PG8_WAIT_L
#undef PG8_BAR
#undef PG8_SCHED
}

template <int ACT  > struct EpiBf16 {
    static constexpr bool PERM = true;
    bf16_t* O; int ldc; bf16_t* O2; int tail0;
    __device__ __forceinline__ void operator()(const f32x4 (&acc)[2][2][4][2], const Unit& u, int wr, int wc, int fr, int fq) const {
        asm volatile("" : "+v"(fr), "+v"(fq));
        const int row0 = u.pm * BM + wr * 64 + fr, col0 = u.pn * BM + wc * 32 + 8 * fq;
        bf16_t* const O = u.kh ? O2 - (size_t)tail0 * ldc : this->O;
#pragma unroll
        for (int ai = 0; ai < 2; ++ai)
#pragma unroll
            for (int m = 0; m < 4; ++m) { bf16_t* rowp = O + (size_t)(row0 + ai * HALF + m * 16) * ldc + col0;
#pragma unroll
                for (int bj = 0; bj < 2; ++bj) { f32x4 v0 = acc[ai][bj][m][0], v1 = acc[ai][bj][m][1];
                    if (ACT == 1) {
#pragma unroll
                        for (int j = 0; j < 4; ++j) { v0[j] = gelu_tanh(v0[j]); v1[j] = gelu_tanh(v1[j]); } }
                    u32x4 w; w.x = pk_bf16(v0[0], v0[1]); w.y = pk_bf16(v0[2], v0[3]); w.z = pk_bf16(v1[0], v1[1]); w.w = pk_bf16(v1[2], v1[3]);
                    *(u32x4*)(rowp + bj * HALF) = w; } }
    }
};
struct EpiRes {
    static constexpr bool PERM = true;
    const float* src_lat; const float* src_ctx; bf16_t* xs; const float* modL; int gate_idx; int src_f32; bf16_t* P1; int tail0;
    __device__ __forceinline__ void operator()(const f32x4 (&acc)[2][2][4][2], const Unit& u, int wr, int wc, int fr, int fq) const {
        asm volatile("" : "+v"(fr), "+v"(fq));
        if (u.kh) {
            const int mb2 = (u.pm >= (TL / BM)) ? NB : (u.pm >> 3); const float* gv2 = modL + (size_t)mb2 * 6144 + gate_idx * 1024;
            const int rl2 = wr * 64 + fr, col2 = u.pn * BM + wc * 32 + 8 * fq;
#pragma unroll
            for (int bj = 0; bj < 2; ++bj) { const f32x4 g0 = *(const f32x4*)(gv2 + col2 + bj * HALF), g1 = *(const f32x4*)(gv2 + col2 + bj * HALF + 4);
#pragma unroll
                for (int ai = 0; ai < 2; ++ai)
#pragma unroll
                    for (int m = 0; m < 4; ++m) { const int r = u.pm * BM + rl2 + ai * HALF + m * 16 - tail0; const f32x4 y0 = g0 * acc[ai][bj][m][0], y1 = g1 * acc[ai][bj][m][1];
                        u32x4 w; w.x = pk_bf16(y0[0], y0[1]); w.y = pk_bf16(y0[2], y0[3]); w.z = pk_bf16(y1[0], y1[1]); w.w = pk_bf16(y1[2], y1[3]);
                        *(u32x4*)(P1 + (size_t)r * D + col2 + bj * HALF) = w; } }
            return; }
        const bool isctx = u.pm >= (TL / BM);
        const float* sb = isctx ? src_ctx + (size_t)(u.pm - TL / BM) * BM * D : src_lat + (size_t)u.pm * BM * D;
        const int mb = isctx ? NB : (u.pm >> 3);
        const float* gv = modL + (size_t)mb * 6144 + gate_idx * 1024;
        const int rl = wr * 64 + fr, col0 = u.pn * BM + wc * 32 + 8 * fq;
#pragma unroll
        for (int bj = 0; bj < 2; ++bj) {
            const f32x4 g0 = *(const f32x4*)(gv + col0 + bj * HALF), g1 = *(const f32x4*)(gv + col0 + bj * HALF + 4);
#pragma unroll
            for (int ai = 0; ai < 2; ++ai)
#pragma unroll
                for (int m = 0; m < 4; ++m) { const int r = rl + ai * HALF + m * 16; bf16_t* dp = xs + ((size_t)u.pm * BM + r) * D + col0 + bj * HALF; f32x4 x0, x1;
                    if (src_f32) { const float* sp = sb + (size_t)r * D + col0 + bj * HALF; x0 = *(const f32x4*)sp; x1 = *(const f32x4*)(sp + 4); }
                    else { const u32x4 xv = *(const u32x4*)dp; x0 = (f32x4){bf_lo(xv.x), bf_hi(xv.x), bf_lo(xv.y), bf_hi(xv.y)}; x1 = (f32x4){bf_lo(xv.z), bf_hi(xv.z), bf_lo(xv.w), bf_hi(xv.w)}; }
                    const f32x4 y0 = x0 * DN_ALPHA + g0 * acc[ai][bj][m][0], y1 = x1 * DN_ALPHA + g1 * acc[ai][bj][m][1];
                    u32x4 w; w.x = pk_bf16(y0[0], y0[1]); w.y = pk_bf16(y0[2], y0[3]); w.z = pk_bf16(y1[0], y1[1]); w.w = pk_bf16(y1[2], y1[3]);
                    *(u32x4*)dp = w; }
        }
    }
};
struct EpiGlaProj {
    static constexpr bool PERM = true;
    bf16_t* QG; bf16_t* KG; bf16_t* VG; bf16_t* RG; float* GL;
    __device__ __forceinline__ void operator()(const f32x4 (&acc)[2][2][4][2], const Unit& u, int wr, int wc, int fr, int fq) const {
        asm volatile("" : "+v"(fr), "+v"(fq));
        const int row0 = u.pm * BM + wr * 64 + fr, pn = u.pn;
        if (pn < 12) {
            bf16_t* base; int ld, colt; float sc = 1.f;
            if (pn < 2) { base = QG; ld = 512; colt = pn * BM; sc = 0.08838834764831845f; }
            else if (pn < 4) { base = KG; ld = 512; colt = (pn - 2) * BM; }
            else if (pn < 8) { base = VG; ld = 1024; colt = (pn - 4) * BM; }
            else { base = RG; ld = 1024; colt = (pn - 8) * BM; }
            const int col0 = colt + wc * 32 + 8 * fq;
#pragma unroll
            for (int ai = 0; ai < 2; ++ai)
#pragma unroll
                for (int m = 0; m < 4; ++m) { bf16_t* rowp = base + (size_t)(row0 + ai * HALF + m * 16) * ld + col0;
#pragma unroll
                    for (int bj = 0; bj < 2; ++bj) { const f32x4 v0 = acc[ai][bj][m][0] * sc, v1 = acc[ai][bj][m][1] * sc;
                        u32x4 w; w.x = pk_bf16(v0[0], v0[1]); w.y = pk_bf16(v0[2], v0[3]); w.z = pk_bf16(v1[0], v1[1]); w.w = pk_bf16(v1[2], v1[3]);
                        *(u32x4*)(rowp + bj * HALF) = w; } }
        } else if (wc == 0) {
#pragma unroll
            for (int ai = 0; ai < 2; ++ai)
#pragma unroll
                for (int m = 0; m < 4; ++m) { float* gp = GL + (size_t)(row0 + ai * HALF + m * 16) * 32 + 8 * fq;
                    *(f32x4*)gp = acc[ai][0][m][0]; *(f32x4*)(gp + 4) = acc[ai][0][m][1]; }
        }
    }
};
}

struct Ctx {
    const Params* p; unsigned char* ws; unsigned char* smem; int tid, lane, wave, G, bid;
};

DI void quant_table_unit(const Ctx& c, int tab, int unit) {
    const Params& p = *c.p; unsigned char* ws = c.ws;
    const float* src = p.in[21 + tab]; unsigned char* dst = ws + (tab ? WS_VT : WS_UT); float* sc = (float*)(ws + (tab ? WS_SV : WS_SU));
#pragma unroll 4
    for (int i = 0; i < 8; ++i) { const size_t row = (size_t)unit * 64 + c.wave * 8 + i;
        const float* rp = src + row * 1024 + 16 * c.lane; f32x4 x[4];
#pragma unroll
        for (int q = 0; q < 4; ++q) x[q] = __builtin_nontemporal_load((const f32x4*)(rp + 4 * q));
        const size_t Lr = row >> 14, er = row & 16383;
        float ss = 0.f;
#pragma unroll
        for (int q = 0; q < 4; ++q) ss += (x[q][0] * x[q][0] + x[q][1] * x[q][1]) + (x[q][2] * x[q][2] + x[q][3] * x[q][3]);
        const float rms = sqrtf(wave_sum(ss) * (1.0f / 1024.0f)); const float stp = fmaxf(rms * (2.4f / 7.0f), 1e-30f), inv = 1.0f / stp; u32x2 w;
#pragma unroll
        for (int hq = 0; hq < 2; ++hq) { unsigned t = 0;
#pragma unroll
            for (int e = 0; e < 8; ++e) { const float v = x[2 * hq + (e >> 2)][e & 3] * inv; const int qi = (int)fminf(fmaxf(rintf(v), -8.0f), 7.0f); t |= ((unsigned)qi & 15u) << (4 * e); }
            w[hq] = t; }
        *(u32x2*)(dst + ((Lr * 4 + (c.lane >> 4)) * NEXP + er) * 128 + 8 * (c.lane & 15)) = w;
        if (c.lane == 0) sc[row] = stp; }
}
DI void quant_in_gemm_tail(const Ctx& c, int r, int tab, int Lq) {
    const int k0 = (r == 0) ? c.bid : c.bid - r, st = (r == 0) ? c.G : c.G - r;
    if (k0 < 0) return;
    for (int k = k0; k < 256; k += st) quant_table_unit(c, tab, Lq * 256 + k);
}

DI void phase_prologue(const Ctx& c) {
    const Params& p = *c.p; unsigned char* ws = c.ws;
    const int tid = c.tid;
    constexpr int N_MOD = 192, N_TR = 4736, N_WS = 64, N_TAB = 512;
    constexpr int N_ALL = N_MOD + N_TR + N_WS + N_TAB;
    constexpr int N_ITEMS = N_MOD + N_TAB + N_TR / 8 + N_WS / 8;
    unsigned* qctr = (unsigned*)(ws + WS_CTL + 32768);
    volatile LAS unsigned* qw = (volatile LAS unsigned*)((LAS unsigned char*)c.smem + (LDS_BYTES - 32));
    for (;;) {
        __syncthreads();
        if (tid == 0) *qw = __hip_atomic_fetch_add(qctr, 1u, __ATOMIC_RELAXED, __HIP_MEMORY_SCOPE_AGENT);
        __syncthreads();
        const int item = (int)*qw;
        if (item >= N_ITEMS) break;
        int ub, ue;
        if (item < N_MOD) { ub = item; ue = item + 1; }
        else if (item < N_MOD + N_TAB) { ub = N_MOD + N_TR + N_WS + (item - N_MOD); ue = ub + 1; }
        else if (item < N_MOD + N_TAB + N_TR / 8) { ub = N_MOD + 8 * (item - N_MOD - N_TAB); ue = ub + 8; }
        else { ub = N_MOD + N_TR + 8 * (item - N_MOD - N_TAB - N_TR / 8); ue = ub + 8; }
    for (int u = ub; u < ue; ++u) {
        if (u < N_MOD) {
            const int l = u / 48, n0 = (u % 48) * 128;
            float* sc = (float*)c.smem;
            float* red = (float*)(c.smem + 17 * 1024 * 4);
            __syncthreads();
#pragma unroll 1
            for (int hk = 0; hk < 2; ++hk) { const int k = hk * 512 + tid; float v[17];
#pragma unroll
                for (int b = 0; b < 17; ++b) v[b] = (b < NB) ? p.in[1][b * 1024 + k] : p.in[3][k];
#pragma unroll
                for (int b = 0; b < 17; ++b) sc[b * 1024 + k] = silu_f(v[b]); }
            __syncthreads();
            const int c4 = (tid & 31) * 4, kg = tid >> 5;
            float acc[17][4];
#pragma unroll
            for (int b = 0; b < 17; ++b) { acc[b][0] = 0.f; acc[b][1] = 0.f; acc[b][2] = 0.f; acc[b][3] = 0.f; }
            const float* wp = p.in[4] + ((size_t)l * 1024 + (size_t)kg * 64) * 6144 + n0 + c4;
#pragma unroll 4
            for (int kk = 0; kk < 64; ++kk) {
                const f32x4 w = *(const f32x4*)(wp + (size_t)kk * 6144);
                const int k = kg * 64 + kk;
#pragma unroll
                for (int b = 0; b < 17; ++b) { const float s = sc[b * 1024 + k]; acc[b][0] += s * w[0]; acc[b][1] += s * w[1]; acc[b][2] += s * w[2]; acc[b][3] += s * w[3]; }
            }
#pragma unroll
            for (int b = 0; b < 17; ++b)
#pragma unroll
                for (int j = 0; j < 4; ++j) acc[b][j] += __shfl_xor(acc[b][j], 32, 64);
            if ((tid & 32) == 0) {
#pragma unroll
                for (int b = 0; b < 17; ++b)
#pragma unroll
                    for (int j = 0; j < 4; ++j) red[(c.wave * 17 + b) * 128 + c4 + j] = acc[b][j];
            }
            __syncthreads();
            for (int o = tid; o < 17 * 128; o += NTHR) { const int b = o >> 7, n = o & 127; float s = 0.f;
#pragma unroll
                for (int w = 0; w < 8; ++w) s += red[(w * 17 + b) * 128 + n];
                ((float*)(ws + WS_MOD))[((size_t)l * 17 + b) * 6144 + n0 + n] = s + p.in[5][l * 6144 + n0 + n]; }
        } else if (u < N_MOD + N_TR) {
            int v = u - N_MOD; const float* src; bf16_t* dst; int N, Npad;
            if (v < 1024) { const int j = v / 512; v %= 512; src = p.in[8] + (size_t)j * 1024 * 2048; dst = (bf16_t*)(ws + WS_WAIN) + (size_t)j * 2048 * 1024; N = 2048; Npad = 2048; }
            else if (v < 1536) { v -= 1024; const int j = v / 256; v %= 256; src = p.in[13] + (size_t)j * 1024 * 1024; dst = (bf16_t*)(ws + WS_WAOUT) + (size_t)j * 1024 * 1024; N = 1024; Npad = 1024; }
            else if (v < 3200) { v -= 1536; const int j = v / 832; v %= 832; src = p.in[14] + (size_t)j * 1024 * 3104; dst = (bf16_t*)(ws + WS_WBIN) + (size_t)j * WBIN_N * 1024; N = 3104; Npad = WBIN_N; }
            else if (v < 3712) { v -= 3200; const int j = v / 256; v %= 256; src = p.in[18] + (size_t)j * 1024 * 1024; dst = (bf16_t*)(ws + WS_WBOUT) + (size_t)j * 1024 * 1024; N = 1024; Npad = 1024; }
            else { v -= 3712; const int j = v / 256; v %= 256; src = p.in[19] + (size_t)j * 1024 * 1024; dst = (bf16_t*)(ws + WS_WQ) + (size_t)j * 1024 * 1024; N = 1024; Npad = 1024; }
            (void)Npad;
            const int ntn = v >> 4, ktile = v & 15, n0 = ntn * 64, k0 = ktile * 64;
            float* tl = (float*)c.smem;
            __syncthreads();
#pragma unroll
            for (int i = 0; i < 2; ++i) { const int kk = (tid >> 4) + 32 * i, nn = (tid & 15) * 4;
                f32x4 x = {0.f, 0.f, 0.f, 0.f};
                if (n0 + nn < N) x = *(const f32x4*)(src + (size_t)(k0 + kk) * N + n0 + nn);
                tl[kk * 65 + nn] = x[0]; tl[kk * 65 + nn + 1] = x[1]; tl[kk * 65 + nn + 2] = x[2]; tl[kk * 65 + nn + 3] = x[3]; }
            __syncthreads();
            { const int nn = tid >> 3, kk8 = (tid & 7) * 8; float x[8];
#pragma unroll
              for (int j = 0; j < 8; ++j) x[j] = tl[(kk8 + j) * 65 + nn];
              u32x4 w; w.x = pk_bf16(x[0], x[1]); w.y = pk_bf16(x[2], x[3]); w.z = pk_bf16(x[4], x[5]); w.w = pk_bf16(x[6], x[7]);
              *(u32x4*)(dst + (size_t)(n0 + nn) * 1024 + k0 + kk8) = w; }
        } else if (u < N_MOD + N_TR + N_WS) {
            const int v = u - N_MOD - N_TR; const size_t e = (size_t)v * 4096 + (size_t)tid * 8;
            const f32x4 a = *(const f32x4*)(p.in[11] + e), b = *(const f32x4*)(p.in[11] + e + 4);
            u32x4 w; w.x = pk_bf16(a[0], a[1]); w.y = pk_bf16(a[2], a[3]); w.z = pk_bf16(b[0], b[1]); w.w = pk_bf16(b[2], b[3]);
            *(u32x4*)((bf16_t*)(ws + WS_WSB) + e) = w;
        } else {
            const int v = u - N_MOD - N_TR - N_WS; quant_table_unit(c, v >> 8, v & 255);
        }
    }
    }
}

DI void phase_mod0(const Ctx& c) {
    const Params& p = *c.p; const float* MOD = (const float*)(c.ws + WS_MOD); bf16_t* H1 = (bf16_t*)(c.ws + WS_H1);
    const int GW = c.G * NWAVE, npw = (T + GW - 1) / GW, r0 = (c.bid * NWAVE + c.wave) * npw; int nr = T - r0; nr = nr > npw ? npw : nr; nr = nr < 0 ? 0 : nr;
    int lz = c.lane; asm volatile("" : "+v"(lz));
    constexpr int PFD = 3;
    f32x4 pf[PFD][4], SH[4], S1[4];
#pragma unroll
    for (int qd = 0; qd < 4; ++qd) { SH[qd] = (f32x4){0.f, 0.f, 0.f, 0.f}; S1[qd] = SH[qd]; }
    int cur_mb = -1;
#define M0_LOAD(slot_, k_) do { const int kc_ = (k_) < nr ? (k_) : (nr > 0 ? nr - 1 : 0); const int rw_ = r0 + kc_ < T ? r0 + kc_ : 0; \
        const float* src_ = (rw_ < TL ? p.in[0] + (size_t)rw_ * D : p.in[2] + (size_t)(rw_ - TL) * D) + 16 * lz; \
        _Pragma("unroll") for (int qd = 0; qd < 4; ++qd) pf[slot_][qd] = *(const f32x4*)(src_ + 4 * qd); } while (0)
#pragma unroll
    for (int i = 0; i < PFD; ++i) M0_LOAD(i, i);
    for (int k3 = 0; k3 < nr; k3 += PFD) {
#pragma unroll
        for (int sl = 0; sl < PFD; ++sl) { const int k = k3 + sl;
            if (k < nr) { const int row = r0 + k; const int mb = mod_batch(row);
            if (mb != cur_mb) { cur_mb = mb; const float* m = MOD + (size_t)mb * 6144 + 16 * lz;
#pragma unroll
                for (int qd = 0; qd < 4; ++qd) { SH[qd] = *(const f32x4*)(m + 4 * qd); S1[qd] = *(const f32x4*)(m + 1024 + 4 * qd) + 1.0f; } }
            f32x4 x[4];
#pragma unroll
            for (int qd = 0; qd < 4; ++qd) x[qd] = pf[sl][qd];
            M0_LOAD(sl, k + PFD);
            float h[16];
#pragma unroll
            for (int qd = 0; qd < 4; ++qd)
#pragma unroll
                for (int e = 0; e < 4; ++e) h[4 * qd + e] = x[qd][e] * S1[qd][e] + SH[qd][e];
#pragma unroll
            for (int hf = 0; hf < 2; ++hf) { u32x4 w;
#pragma unroll
                for (int q = 0; q < 4; ++q) w[q] = pk_bf16(h[8 * hf + 2 * q], h[8 * hf + 2 * q + 1]);
                *(u32x4*)(H1 + (size_t)row * D + 16 * lz + 8 * hf) = w; }
            } }
    }
#undef M0_LOAD
}

DI void phase_vstats(const Ctx& c) {
    const bf16_t* UV = (const bf16_t*)(c.ws + WS_R1); float* ST = (float*)(c.ws + WS_STATS);
    const int stride = c.G * NWAVE, r0 = c.bid * NWAVE + c.wave, nr = (T - r0 + stride - 1) / stride;
    int lz = c.lane; asm volatile("" : "+v"(lz));
    constexpr int PFD = 4;
    u32x4 pf[PFD][2];
#define VS_LOAD(slot_, k_) do { const int kc_ = (k_) < nr ? (k_) : nr - 1; const bf16_t* vp_ = UV + (size_t)(r0 + stride * kc_) * 2048 + 1024 + 8 * lz; pf[slot_][0] = *(const u32x4*)vp_; pf[slot_][1] = *(const u32x4*)(vp_ + 512); } while (0)
    if (nr > 0) {
#pragma unroll
        for (int i = 0; i < PFD; ++i) VS_LOAD(i, i);
    }
    for (int k4 = 0; k4 < nr; k4 += PFD) {
#pragma unroll
        for (int sl = 0; sl < PFD; ++sl) { const int k = k4 + sl;
            if (k < nr) { const int row = r0 + stride * k;
            const u32x4 a = pf[sl][0], b = pf[sl][1];
            VS_LOAD(sl, k + PFD);
            float x[16];
#pragma unroll
            for (int j = 0; j < 4; ++j) { x[2 * j] = bf_lo(a[j]); x[2 * j + 1] = bf_hi(a[j]); x[8 + 2 * j] = bf_lo(b[j]); x[9 + 2 * j] = bf_hi(b[j]); }
            float s = 0.f;
#pragma unroll
            for (int j = 0; j < 16; ++j) s += x[j];
            const float mean = wave_sum(s) * (1.0f / 1024.0f);
            float q = 0.f;
#pragma unroll
            for (int j = 0; j < 16; ++j) { const float d = x[j] - mean; q += d * d; }
            const float var = wave_sum(q) * (1.0f / 1024.0f);
            if (lz == 0) { ST[2 * row] = mean; ST[2 * row + 1] = rsqrtf(var + LN_EPS); }
            } }
    }
#undef VS_LOAD
}

DI void phase_spatial(const Ctx& c, int j) {
    const Params& p = *c.p; unsigned char* ws = c.ws;
    const bf16_t* UV = (const bf16_t*)(ws + WS_R1); const float* ST = (const float*)(ws + WS_STATS); bf16_t* Y = (bf16_t*)(ws + WS_R2);
    const bf16_t* WSB = (const bf16_t*)(ws + WS_WSB) + (size_t)j * 8 * 128 * 128;
    const float* ng = p.in[9] + j * 1024; const float* nb = p.in[10] + j * 1024; const float* bs = p.in[12] + j * 8 * 128;
    constexpr int LD = 136;
    bf16_t* WsL = (bf16_t*)c.smem;
    bf16_t* VnT = WsL + 128 * LD;
    const int tid = c.tid, lane = c.lane, w = c.wave, g = lane >> 4, cc = lane & 15;
    for (int u = c.bid; u < (T / 128) * 8; u += c.G) {
        const int chunk = u >> 3, h = u & 7, r0 = chunk * 128;
        lds_barrier();
        { const int cg8 = tid & 15; float gg[8], bb[8];
#pragma unroll
          for (int e = 0; e < 8; ++e) { gg[e] = ng[h * 128 + cg8 * 8 + e]; bb[e] = nb[h * 128 + cg8 * 8 + e]; }
#pragma unroll
          for (int i = 0; i < 4; ++i) { const int idx = i * 512 + tid, tok = idx >> 4;
              const u32x4 v = *(const u32x4*)(UV + (size_t)(r0 + tok) * 2048 + 1024 + h * 128 + cg8 * 8);
              const float mean = ST[2 * (r0 + tok)], rstd = ST[2 * (r0 + tok) + 1];
              float x[8];
#pragma unroll
              for (int e = 0; e < 4; ++e) { x[2 * e] = bf_lo(v[e]); x[2 * e + 1] = bf_hi(v[e]); }
#pragma unroll
              for (int e = 0; e < 8; ++e) VnT[(cg8 * 8 + e) * LD + tok] = f2bf((x[e] - mean) * rstd * gg[e] + bb[e]);
              const int pp = idx >> 4;
              *(u32x4*)(WsL + pp * LD + cg8 * 8) = *(const u32x4*)(WSB + ((size_t)h * 128 + pp) * 128 + cg8 * 8); } }
        lds_barrier();
        f32x4 acc[8];
#pragma unroll
        for (int ct = 0; ct < 8; ++ct) acc[ct] = (f32x4){0.f, 0.f, 0.f, 0.f};
        { bf16x8 bfr[4], vfr[8][4];
#pragma unroll
          for (int ks = 0; ks < 4; ++ks) bfr[ks] = frag_ld(WsL, LD, 16 * w, 32 * ks, lane);
#pragma unroll
          for (int ct = 0; ct < 8; ++ct)
#pragma unroll
              for (int ks = 0; ks < 4; ++ks) vfr[ct][ks] = frag_ld(VnT, LD, 16 * ct, 32 * ks, lane);
          __builtin_amdgcn_sched_barrier(0);
#pragma unroll
          for (int ct = 0; ct < 8; ++ct)
#pragma unroll
              for (int ks = 0; ks < 4; ++ks) acc[ct] = mfma16(vfr[ct][ks], bfr[ks], acc[ct]); }
        const int pp = 16 * w + cc; const float bsv = bs[h * 128 + pp];
        const size_t rowo = (size_t)(r0 + pp);
#pragma unroll
        for (int ct = 0; ct < 8; ++ct) { const int ch = h * 128 + 16 * ct + 4 * g;
            const u32x2 uu = *(const u32x2*)(UV + rowo * 2048 + ch);
            const float y0 = bf_lo(uu.x) * (acc[ct][0] + bsv), y1 = bf_hi(uu.x) * (acc[ct][1] + bsv), y2 = bf_lo(uu.y) * (acc[ct][2] + bsv), y3 = bf_hi(uu.y) * (acc[ct][3] + bsv);
            u32x2 o; o.x = pk_bf16(y0, y1); o.y = pk_bf16(y2, y3);
            *(u32x2*)(Y + rowo * D + ch) = o; }
    }
}

DI void phase_ln1(const Ctx& c, int L) {
    const Params& p = *c.p; unsigned char* ws = c.ws; bf16_t* XS = (bf16_t*)(ws + WS_XS); const float* MOD = (const float*)(ws + WS_MOD) + (size_t)L * 17 * 6144;
    bf16_t* H2 = (bf16_t*)(ws + WS_R2 + SZ_T1K);
    const float* lg = p.in[6] + (size_t)(L * 2 + 0) * D; const float* lb = p.in[7] + (size_t)(L * 2 + 0) * D;
    const int nrows = (L == DEPTH - 1) ? TL : T, GW = c.G * NWAVE, npw = (nrows + GW - 1) / GW;
    const int r0 = (c.bid * NWAVE + c.wave) * npw; int nr = nrows - r0; nr = nr > npw ? npw : nr; nr = nr < 0 ? 0 : nr;
    float* PL = (float*)c.smem;
    const int wg0 = c.bid * NWAVE * npw, wg1 = wg0 + NWAVE * npw - 1;
    const int mbA = mod_batch(wg0 < nrows ? wg0 : nrows - 1), mbB = mod_batch(wg1 < nrows ? wg1 : nrows - 1);
    __syncthreads();
    { const float* mA = MOD + (size_t)mbA * 6144; const float* mB = MOD + (size_t)mbB * 6144;
      int tz = c.tid & 255; asm volatile("" : "+v"(tz)); const int col = tz * 4, whi = c.wave >> 2;
#pragma unroll
      for (int i = 0; i < 3; ++i) { const int r = 2 * i + whi;
          const float* src = r == 0 ? lg : r == 1 ? lb : r == 2 ? mA + 3 * 1024 : r == 3 ? mA + 4 * 1024 : r == 4 ? mB + 3 * 1024 : mB + 4 * 1024;
          f32x4 v = *(const f32x4*)(src + col); if (r == 3 || r == 5) v = v + 1.0f;
          *(f32x4*)(PL + r * 1024 + ((col >> 2) & 3) * 256 + (col >> 4) * 4) = v; } }
    __syncthreads();
    constexpr int PFD = 4;
    int lz = c.lane; asm volatile("" : "+v"(lz));
    const int tail0 = pg8::gemm_tail_row0(nrows, 1024, c.G); const bf16_t* P1 = (const bf16_t*)(ws + WS_P1);
    u32x4 pf[PFD][4];
#define L1_LOAD(slot_, k_) do { const int kc_ = (k_) < nr ? (k_) : (nr > 0 ? nr - 1 : 0); const int rw_ = r0 + kc_ < nrows ? r0 + kc_ : 0; const size_t ro_ = (size_t)rw_ * D + 16 * lz; \
        pf[slot_][0] = *(const u32x4*)(XS + ro_); pf[slot_][1] = *(const u32x4*)(XS + ro_ + 8); \
        if (rw_ >= tail0) { const size_t po_ = (size_t)(rw_ - tail0) * D + 16 * lz; pf[slot_][2] = *(const u32x4*)(P1 + po_); pf[slot_][3] = *(const u32x4*)(P1 + po_ + 8); } \
        else { pf[slot_][2] = (u32x4){0u, 0u, 0u, 0u}; pf[slot_][3] = pf[slot_][2]; } } while (0)
#pragma unroll
    for (int i = 0; i < PFD; ++i) L1_LOAD(i, i);
    for (int k4 = 0; k4 < nr; k4 += PFD) {
#pragma unroll
        for (int sl = 0; sl < PFD; ++sl) { const int k = k4 + sl;
            if (k < nr) { const int row = r0 + k; bf16_t* xp = XS + (size_t)row * D + 16 * lz;
            const float* pm = PL + (mod_batch(row) == mbA ? 2 : 4) * 1024 + 4 * lz;
            const u32x4 v0 = pf[sl][0], v1 = pf[sl][1], p0 = pf[sl][2], p1 = pf[sl][3];
            L1_LOAD(sl, k + PFD);
            float x[16]; float s = 0.f;
#pragma unroll
            for (int q = 0; q < 4; ++q) { x[2 * q] = bf_lo(v0[q]) + bf_lo(p0[q]); x[2 * q + 1] = bf_hi(v0[q]) + bf_hi(p0[q]); x[8 + 2 * q] = bf_lo(v1[q]) + bf_lo(p1[q]); x[9 + 2 * q] = bf_hi(v1[q]) + bf_hi(p1[q]); }
#pragma unroll
            for (int e = 0; e < 16; ++e) s += x[e];
            const float mean = wave_sum(s) * (1.0f / 1024.0f);
            float q2 = 0.f;
#pragma unroll
            for (int e = 0; e < 16; ++e) { const float d = x[e] - mean; q2 += d * d; }
            const float rstd = rsqrtf(wave_sum(q2) * (1.0f / 1024.0f) + LN_EPS);
            float y[16], h[16]; float am = 0.f;
#pragma unroll
            for (int qd = 0; qd < 4; ++qd) { const f32x4 gg = *(const f32x4*)(PL + qd * 256 + 4 * lz), bb = *(const f32x4*)(PL + 1024 + qd * 256 + 4 * lz), sh2 = *(const f32x4*)(pm + qd * 256), s2 = *(const f32x4*)(pm + 1024 + qd * 256);
#pragma unroll
                for (int e = 0; e < 4; ++e) { const float yy = (x[4 * qd + e] - mean) * rstd * gg[e] + bb[e]; y[4 * qd + e] = yy; const float hh = yy * s2[e] + sh2[e]; h[4 * qd + e] = hh; am = fmaxf(am, fabsf(hh)); } }
            am = fmaxf(wave_max(am), 1e-30f); const float sx = am * (1.0f / 119.0f), isx = 119.0f / am;
            u32x2 th = {0u, 0u}, tl = {0u, 0u};
#pragma unroll
            for (int e = 0; e < 16; ++e) { const int x8 = (int)rintf(h[e] * isx); const int xl = ((x8 + 8) & 15) - 8, xh = (x8 - xl) >> 4; th[e >> 3] |= ((unsigned)xh & 15u) << (4 * (e & 7)); tl[e >> 3] |= ((unsigned)xl & 15u) << (4 * (e & 7)); }
#pragma unroll
            for (int hf = 0; hf < 2; ++hf) { u32x4 wx, wh;
#pragma unroll
                for (int q = 0; q < 4; ++q) { wx[q] = pk_bf16(y[8 * hf + 2 * q], y[8 * hf + 2 * q + 1]); wh[q] = pk_bf16(h[8 * hf + 2 * q], h[8 * hf + 2 * q + 1]); }
                *(u32x4*)(xp + 8 * hf) = wx; *(u32x4*)(H2 + (size_t)row * D + 16 * lz + 8 * hf) = wh; }
            *(u32x2*)(ws + WS_XH + (size_t)row * 512 + 8 * lz) = th; *(u32x2*)(ws + WS_XL + (size_t)row * 512 + 8 * lz) = tl;
            if (lz == 0) ((float*)(ws + WS_SX))[row] = sx;
            } }
    }
#undef L1_LOAD
}

DI int f2key(float v) { const int i = __float_as_int(v); return i ^ ((i >> 31) & 0x7fffffff); }
DI float key2f(int k) { return __int_as_float(k ^ ((k >> 31) & 0x7fffffff)); }
DI void phase_route(const Ctx& c, int L) {
    const Params& p = *c.p; unsigned char* ws = c.ws; const int lane = c.lane, g = lane >> 4, cc = lane & 15;
    constexpr int LDK = 72, LDS_S = 20;
    bf16_t* keysHi = (bf16_t*)c.smem;
    bf16_t* keysLo = keysHi + 2 * 128 * LDK;
    float* sbase = (float*)(keysLo + 2 * 128 * LDK);
    unsigned* ilist = (unsigned*)(sbase + NWAVE * 64 * LDS_S);
    __syncthreads();
    { const float* gk = p.in[20] + (size_t)L * 2 * 128 * 64;
      f32x4 kv[8];
#pragma unroll
      for (int it = 0; it < 8; ++it) kv[it] = ((const f32x4*)gk)[it * NTHR + c.tid];
#pragma unroll
      for (int it = 0; it < 8; ++it) { const int i = (it * NTHR + c.tid) * 4, row = i >> 6, d = i & 63; unsigned hi[2], lo[2];
#pragma unroll
          for (int e = 0; e < 2; ++e) { const unsigned ph = pk_bf16(kv[it][2 * e], kv[it][2 * e + 1]); hi[e] = ph; lo[e] = pk_bf16(kv[it][2 * e] - bf_lo(ph), kv[it][2 * e + 1] - bf_hi(ph)); }
          *(u32x2*)(keysHi + row * LDK + d) = (u32x2){hi[0], hi[1]}; *(u32x2*)(keysLo + row * LDK + d) = (u32x2){lo[0], lo[1]}; } }
    __syncthreads();
    float* S = sbase + c.wave * 64 * LDS_S;
    const bf16_t* QP = (const bf16_t*)(ws + WS_R1); int* IDX = (int*)(ws + WS_R1 + SZ_T1K); float* WT = (float*)(ws + WS_R1 + SZ_T1K + (size_t)T * 128 * 4);
    unsigned* myl = ilist + c.tid * 8; const unsigned char* mylb = (const unsigned char*)myl;
    const int ntask = (((L == DEPTH - 1) ? TL : T) / 64) * 8;
    const int tail0 = pg8::gemm_tail_row0((L == DEPTH - 1) ? TL : T, 1024, c.G); const bf16_t* QP2 = (const bf16_t*)(ws + WS_QP2);
    for (int task = c.wave * c.G + c.bid; task < ntask; task += c.G * NWAVE) {
        const int t0 = (task >> 3) * 64, h = task & 7, tok = t0 + lane;
        float t12[2][16];
#pragma unroll
        for (int half = 0; half < 2; ++half) {
            bf16x8 aq[4][2];
#pragma unroll
            for (int mt = 0; mt < 4; ++mt)
#pragma unroll
                for (int ks = 0; ks < 2; ++ks) { const size_t qo = (size_t)(t0 + 16 * mt + cc) * D + h * 128 + half * 64 + 32 * ks + 8 * g; aq[mt][ks] = *(const bf16x8*)(QP + qo);
                    if (t0 >= tail0) {
                        const u32x4 qa = __builtin_bit_cast(u32x4, aq[mt][ks]), qb = *(const u32x4*)(QP2 + qo - (size_t)tail0 * D); u32x4 qs;
#pragma unroll
                        for (int e = 0; e < 4; ++e) qs[e] = pk_bf16(bf_lo(qa[e]) + bf_lo(qb[e]), bf_hi(qa[e]) + bf_hi(qb[e]));
                        aq[mt][ks] = __builtin_bit_cast(bf16x8, qs); } }
            const bf16_t* kh = keysHi + half * 128 * LDK; const bf16_t* kl = keysLo + half * 128 * LDK;
#pragma unroll
            for (int i = 0; i < 16; ++i) t12[half][i] = -3.0e38f;
            for (int nt = 0; nt < 8; ++nt) {
                const bf16x8 bh0 = frag_ld(kh, LDK, 16 * nt, 0, lane), bh1 = frag_ld(kh, LDK, 16 * nt, 32, lane), bl0 = frag_ld(kl, LDK, 16 * nt, 0, lane), bl1 = frag_ld(kl, LDK, 16 * nt, 32, lane);
#pragma unroll
                for (int mt = 0; mt < 4; ++mt) { f32x4 a = {0.f, 0.f, 0.f, 0.f};
                    a = mfma16(aq[mt][0], bl0, a); a = mfma16(aq[mt][1], bl1, a); a = mfma16(aq[mt][0], bh0, a); a = mfma16(aq[mt][1], bh1, a);
#pragma unroll
                    for (int r = 0; r < 4; ++r) S[(16 * mt + 4 * g + r) * LDS_S + cc] = a[r]; }
                f32x4 sc[4];
#pragma unroll
                for (int q4 = 0; q4 < 4; ++q4) sc[q4] = *(const f32x4*)(S + lane * LDS_S + 4 * q4);
#pragma unroll
                for (int kk = 0; kk < 16; ++kk) { const float key = __int_as_float((__float_as_int(sc[kk >> 2][kk & 3]) & ~127) | (127 - (16 * nt + kk)));
#pragma unroll
                    for (int i = 15; i >= 1; --i) t12[half][i] = __builtin_amdgcn_fmed3f(key, t12[half][i - 1], t12[half][i]);
                    t12[half][0] = __builtin_amdgcn_fmed3f(key, 3.0e38f, t12[half][0]); }
            }
        }
        float v1[16], v2[16];
#pragma unroll
        for (int i = 0; i < 16; ++i) { v1[i] = __int_as_float(__float_as_int(t12[0][i]) & ~127); v2[i] = __int_as_float(__float_as_int(t12[1][i]) & ~127); }
#pragma unroll
        for (int i = 0; i < 4; ++i) {
            myl[i] = (unsigned)(127 - (__float_as_int(t12[0][4 * i]) & 127)) | ((unsigned)(127 - (__float_as_int(t12[0][4 * i + 1]) & 127)) << 8) | ((unsigned)(127 - (__float_as_int(t12[0][4 * i + 2]) & 127)) << 16) | ((unsigned)(127 - (__float_as_int(t12[0][4 * i + 3]) & 127)) << 24);
            myl[4 + i] = (unsigned)(127 - (__float_as_int(t12[1][4 * i]) & 127)) | ((unsigned)(127 - (__float_as_int(t12[1][4 * i + 1]) & 127)) << 8) | ((unsigned)(127 - (__float_as_int(t12[1][4 * i + 2]) & 127)) << 16) | ((unsigned)(127 - (__float_as_int(t12[1][4 * i + 3]) & 127)) << 24); }
        float f[16];
#pragma unroll
        for (int i = 0; i < 16; ++i) f[i] = -3.0e38f;
#pragma unroll
        for (int a = 0; a < 16; ++a)
#pragma unroll
            for (int b = 0; b < 16; ++b)
                if ((a + 1) * (b + 1) <= 16) {
                    const float key = __int_as_float((__float_as_int(v1[a] + v2[b]) & ~255) | (255 - (a * 16 + b)));
#pragma unroll
                    for (int i = 15; i >= 1; --i) f[i] = __builtin_amdgcn_fmed3f(key, f[i - 1], f[i]);
                    f[0] = __builtin_amdgcn_fmed3f(key, 3.0e38f, f[0]);
                }
        float e[16], se = 0.f; int fi[16];
        const float vmax = __int_as_float(__float_as_int(f[0]) & ~255);
#pragma unroll
        for (int i = 0; i < 16; ++i) { const int code = 255 - (__float_as_int(f[i]) & 255); fi[i] = (int)mylb[code >> 4] * 128 + (int)mylb[16 + (code & 15)];
            e[i] = __expf(__int_as_float(__float_as_int(f[i]) & ~255) - vmax); se += e[i]; }
        const float inv = 1.0f / se;
        int* ip = IDX + (size_t)tok * 128 + h * 16; float* wp = WT + (size_t)tok * 128 + h * 16;
#pragma unroll
        for (int i = 0; i < 16; i += 4) { *(int4*)(ip + i) = make_int4(fi[i], fi[i + 1], fi[i + 2], fi[i + 3]); *(f32x4*)(wp + i) = (f32x4){e[i] * inv, e[i + 1] * inv, e[i + 2] * inv, e[i + 3] * inv}; }
    }
}

DI float red8(float p) { p += dpp_mov<0xB1>(p); p += dpp_mov<0x4E>(p); p += dpp_mov<0x141>(p); return p; }
DI void phase_experts(const Ctx& c, int L) {
    const Params& p = *c.p; unsigned char* ws = c.ws; const int lane = c.lane, g8 = lane >> 3, j = lane & 7;
    constexpr int MAXTOK = 18;
    const bf16_t* H2 = (const bf16_t*)(ws + WS_R2 + SZ_T1K);
    const int* IDX = (const int*)(ws + WS_R1 + SZ_T1K); const float* WT = (const float*)(ws + WS_R1 + SZ_T1K + (size_t)T * 128 * 4);
    bf16_t* FFN = (bf16_t*)(ws + WS_R1);
    const unsigned char* UT = ws + WS_UT + (size_t)L * NEXP * 512; const unsigned char* VT = ws + WS_VT + (size_t)L * NEXP * 512;
    const float* SU = (const float*)(ws + WS_SU) + (size_t)L * NEXP; const float* SV = (const float*)(ws + WS_SV) + (size_t)L * NEXP;
    bf16_t* XS = (bf16_t*)(ws + WS_XS); bf16_t* H1 = (bf16_t*)(ws + WS_H1);
    const float* MOD = (const float*)(ws + WS_MOD) + (size_t)L * 17 * 6144;
    const float* lg = p.in[6] + (size_t)(L * 2 + 1) * D; const float* lb = p.in[7] + (size_t)(L * 2 + 1) * D;
    const int nrows = (L == DEPTH - 1) ? TL : T;
    float* ZL = (float*)c.smem + c.wave * MAXTOK * 128;
    unsigned short* IL = (unsigned short*)(c.smem + NWAVE * MAXTOK * 128 * 4) + c.wave * MAXTOK * 128;
    u32x4* ADL = (u32x4*)(c.smem + NWAVE * MAXTOK * 128 * 6) + c.wave * MAXTOK * 8;
    float* SAL = (float*)(c.smem + NWAVE * MAXTOK * 128 * 6 + NWAVE * MAXTOK * 128) + c.wave * 32;
    const int GW = c.G * NWAVE, gw = c.bid * NWAVE + c.wave;
    const int tsrc = 8 * (lane & 7) + (lane >> 3);
    const int npw = (nrows + GW - 1) / GW;
    for (int b0 = 0; b0 < npw; b0 += MAXTOK) {
        const int tok0 = gw * npw + b0; constexpr int tstr = 1;
        int ntok = npw - b0; ntok = ntok > MAXTOK ? MAXTOK : ntok; ntok = ntok > nrows - tok0 ? nrows - tok0 : ntok; ntok = ntok < 0 ? 0 : ntok;
        const int klast = ntok > 0 ? ntok - 1 : 0;
        if (ntok > 0) {
            for (int k0 = 0; k0 < MAXTOK; k0 += 18) { int iv[18][2];
#pragma unroll
                for (int kk = 0; kk < 18; ++kk) { const int kc = (k0 + kk < ntok) ? k0 + kk : klast; const size_t tb = (size_t)(tok0 + tstr * kc) * 128; iv[kk][0] = IDX[tb + lane]; iv[kk][1] = IDX[tb + 64 + lane]; }
#pragma unroll
                for (int kk = 0; kk < 18; ++kk) { IL[(k0 + kk) * 128 + lane] = (unsigned short)iv[kk][0]; IL[(k0 + kk) * 128 + 64 + lane] = (unsigned short)iv[kk][1]; } }
        }
        for (int c4 = 0; c4 < 4; ++c4) {
            const unsigned char* Ub = UT + (size_t)c4 * NEXP * 128 + 16 * j;
            const unsigned char* XHb = ws + WS_XH + 128 * c4 + 16 * j; const unsigned char* XLb = ws + WS_XL + 128 * c4 + 16 * j;
            u32x4 rA[8], rB[8], xh, xl, nxh, nxl;
#define U_LOADX(k_) do { const size_t to_ = (size_t)(tok0 + tstr * (k_)) * 512; nxh = *(const u32x4*)(XHb + to_); nxl = *(const u32x4*)(XLb + to_); } while (0)
#define U_ISSUE(R, k_, hf_) do { unsigned e_[8]; _Pragma("unroll") for (int i = 0; i < 8; ++i) e_[i] = IL[(k_) * 128 + 64 * (hf_) + 8 * i + g8]; __builtin_amdgcn_sched_barrier(0); \
                _Pragma("unroll") for (int i = 0; i < 8; ++i) R[i] = *(const u32x4*)(Ub + (size_t)e_[i] * 128); } while (0)
#define U_COMPUTE(R, k_, hf_) do { int ra = 0; \
                _Pragma("unroll") for (int i = 0; i < 8; ++i) { int ah = 0, al = 0; \
                    _Pragma("unroll") for (int q = 0; q < 4; ++q) { ah = __builtin_amdgcn_sdot8((int)R[i][q], (int)xh[q], ah, false); al = __builtin_amdgcn_sdot8((int)R[i][q], (int)xl[q], al, false); } \
                    int zi = ah * 16 + al; \
                    zi += __builtin_amdgcn_mov_dpp(zi, 0xB1, 0xf, 0xf, true); zi += __builtin_amdgcn_mov_dpp(zi, 0x4E, 0xf, 0xf, true); zi += __builtin_amdgcn_mov_dpp(zi, 0x141, 0xf, 0xf, true); \
                    ra = (j == i) ? zi : ra; } \
                const float za = (float)__shfl(ra, tsrc, 64); \
                if (c4 == 0) ZL[(k_) * 128 + 64 * (hf_) + lane] = za; else ZL[(k_) * 128 + 64 * (hf_) + lane] += za; } while (0)
            if (ntok > 0) { U_LOADX(0); U_ISSUE(rA, 0, 0); }
            for (int k = 0; k < ntok; ++k) {
                const int kn = (k + 1 < ntok) ? k + 1 : k;
                U_ISSUE(rB, k, 1);
                xh = nxh; xl = nxl;
                U_COMPUTE(rA, k, 0);
                U_LOADX(kn); U_ISSUE(rA, kn, 0);
                U_COMPUTE(rB, k, 1);
            }
#undef U_LOADX
#undef U_ISSUE
#undef U_COMPUTE
        }
        if (ntok > 0) {
            for (int k0 = 0; k0 < MAXTOK; k0 += 9) { float wv[9][2], su[9][2], sv[9][2], sxv[9];
#pragma unroll
                for (int kk = 0; kk < 9; ++kk) { const int kc = (k0 + kk < ntok) ? k0 + kk : klast; const size_t tb = (size_t)(tok0 + tstr * kc) * 128; sxv[kk] = ((const float*)(ws + WS_SX))[tok0 + tstr * kc];
#pragma unroll
                    for (int hh = 0; hh < 2; ++hh) { const unsigned e = IL[kc * 128 + 64 * hh + lane]; wv[kk][hh] = WT[tb + 64 * hh + lane]; su[kk][hh] = SU[e]; sv[kk][hh] = SV[e]; } }
#pragma unroll
                for (int kk = 0; kk < 9; ++kk) { const int kc = (k0 + kk < ntok) ? k0 + kk : klast;
                    if (k0 + kk < ntok) {
                        float a_[2];
#pragma unroll
                        for (int hh = 0; hh < 2; ++hh) a_[hh] = gelu_tanh(ZL[kc * 128 + 64 * hh + lane] * (su[kk][hh] * sxv[kk])) * wv[kk][hh] * sv[kk][hh];
                        const float am = wave_max(fmaxf(fabsf(a_[0]), fabsf(a_[1])));
                        const float inv = am > 0.f ? 119.0f / am : 0.f;
#pragma unroll
                        for (int hh = 0; hh < 2; ++hh) ZL[kc * 128 + 64 * hh + lane] = __int_as_float((int)rintf(a_[hh] * inv));
                        if (lane == 0) SAL[kc] = am * (1.0f / 119.0f);
                        unsigned d_[4];
#pragma unroll
                        for (int hf = 0; hf < 2; ++hf) { const int a8 = __float_as_int(ZL[kc * 128 + 64 * hf + 8 * j + g8]); const int xl = ((a8 + 8) & 15) - 8; const int xh = (a8 - xl) >> 4;
                            d_[2 * hf] = ((unsigned)xh & 15u) << (4 * j); d_[2 * hf + 1] = ((unsigned)xl & 15u) << (4 * j); }
#pragma unroll
                        for (int q = 0; q < 4; ++q) { int t = (int)d_[q]; t += __builtin_amdgcn_mov_dpp(t, 0xB1, 0xf, 0xf, true); t += __builtin_amdgcn_mov_dpp(t, 0x4E, 0xf, 0xf, true); t += __builtin_amdgcn_mov_dpp(t, 0x141, 0xf, 0xf, true); d_[q] = (unsigned)t; }
                        if (j == 0) ADL[kc * 8 + g8] = (u32x4){d_[0], d_[1], d_[2], d_[3]}; } } }
        }
        for (int c4 = 0; c4 < 4; ++c4) {
            const unsigned char* Vb = VT + (size_t)c4 * NEXP * 128 + 16 * j;
            const bool hi8 = (lane & 8) != 0;
            u32x4 rA[8], rB[8];
            int oh[32], ol[32];
#define V_ISSUE(R, k_, hf_) do { unsigned e_[8]; _Pragma("unroll") for (int i = 0; i < 8; ++i) e_[i] = IL[(k_) * 128 + 64 * (hf_) + 8 * i + g8]; __builtin_amdgcn_sched_barrier(0); \
                _Pragma("unroll") for (int i = 0; i < 8; ++i) R[i] = *(const u32x4*)(Vb + (size_t)e_[i] * 128); } while (0)
#define V_ACC(R, ad_, hf_) do { const int ah_ = (int)ad_[2 * (hf_)], al_ = (int)ad_[2 * (hf_) + 1]; \
                _Pragma("unroll") for (int q = 0; q < 4; ++q) { unsigned A_[8], B_[8], C_[8]; \
                    _Pragma("unroll") for (int i = 0; i < 4; ++i) { A_[i] = __builtin_amdgcn_perm(R[i + 4][q], R[i][q], 0x05040100u); A_[i + 4] = __builtin_amdgcn_perm(R[i + 4][q], R[i][q], 0x07060302u); } \
                    _Pragma("unroll") for (int i2 = 0; i2 < 4; ++i2) { const int i = (i2 & 1) + 4 * (i2 >> 1); B_[i] = __builtin_amdgcn_perm(A_[i + 2], A_[i], 0x06020400u); B_[i + 2] = __builtin_amdgcn_perm(A_[i + 2], A_[i], 0x07030501u); } \
                    _Pragma("unroll") for (int i = 0; i < 8; i += 2) { C_[i] = (B_[i] & 0x0F0F0F0Fu) | ((B_[i + 1] << 4) & 0xF0F0F0F0u); C_[i + 1] = ((B_[i] >> 4) & 0x0F0F0F0Fu) | (B_[i + 1] & 0xF0F0F0F0u); } \
                    _Pragma("unroll") for (int kc = 0; kc < 8; ++kc) { \
                        if ((hf_) == 0) { asm("v_dot8_i32_i4 %0, %1, %2, 0" : "=v"(oh[8 * q + kc]) : "v"(C_[kc]), "v"(ah_)); asm("v_dot8_i32_i4 %0, %1, %2, 0" : "=v"(ol[8 * q + kc]) : "v"(C_[kc]), "v"(al_)); }     \
                        else { oh[8 * q + kc] = __builtin_amdgcn_sdot8((int)C_[kc], ah_, oh[8 * q + kc], false); ol[8 * q + kc] = __builtin_amdgcn_sdot8((int)C_[kc], al_, ol[8 * q + kc], false); } } } } while (0)
#define V_FINISH(k_) do { const int tok_ = tok0 + tstr * (k_); const float sa_ = SAL[k_]; \
                unsigned q8[16]; \
                _Pragma("unroll") for (int m = 0; m < 16; ++m) { \
                    const auto s0 = __builtin_amdgcn_permlane32_swap((unsigned)(oh[m] * 16 + ol[m]), (unsigned)(oh[m + 16] * 16 + ol[m + 16]), false, false); \
                    q8[m] = s0[0] + s0[1]; } \
                unsigned q4[8]; \
                _Pragma("unroll") for (int m = 0; m < 8; ++m) { \
                    const auto s0 = __builtin_amdgcn_permlane16_swap(q8[m], q8[m + 8], false, false); \
                    q4[m] = s0[0] + s0[1]; } \
                float fo[4]; \
                _Pragma("unroll") for (int m = 0; m < 4; ++m) { \
                    const int k0 = (int)(hi8 ? q4[m + 4] : q4[m]), t0 = (int)(hi8 ? q4[m] : q4[m + 4]); \
                    fo[m] = (float)(k0 + __builtin_amdgcn_mov_dpp(t0, 0x128, 0xf, 0xf, true)) * sa_; } \
                u32x2 w_; w_.x = pk_bf16(fo[0], fo[1]); w_.y = pk_bf16(fo[2], fo[3]); \
                *(u32x2*)(FFN + (size_t)tok_ * D + 256 * c4 + 32 * j + 4 * g8) = w_; } while (0)
            if (ntok > 0) V_ISSUE(rA, 0, 0);
            for (int k = 0; k < ntok; ++k) {
                V_ISSUE(rB, k, 1);
                const u32x4 ad = ADL[k * 8 + g8];
                V_ACC(rA, ad, 0);
                V_ISSUE(rA, ((k + 1 < ntok) ? k + 1 : k), 0);
                V_ACC(rB, ad, 1);
                V_FINISH(k);
            }
#undef V_ISSUE
#undef V_ACC
#undef V_FINISH
        }
        asm volatile("s_waitcnt vmcnt(0)" ::: "memory");
        constexpr int PFD = 3;
        __syncthreads();
        float* PL = (float*)c.smem;
        const int wg_t0 = c.bid * NWAVE * npw + b0, wg_t1 = wg_t0 + (NWAVE - 1) * npw + (npw - b0 > MAXTOK ? MAXTOK : npw - b0) - 1;
        const int mbA = mod_batch(wg_t0 < nrows ? wg_t0 : nrows - 1), mbB = mod_batch(wg_t1 < nrows ? wg_t1 : nrows - 1);
        { const float* mA = MOD + (size_t)mbA * 6144; const float* mB = MOD + (size_t)mbB * 6144;
          const float* nA = (const float*)(ws + WS_MOD) + (size_t)(L + 1 < DEPTH ? L + 1 : L) * 17 * 6144 + (size_t)mbA * 6144; const float* nB = nA + (size_t)(mbB - mbA) * 6144;
          int tz = c.tid & 255; asm volatile("" : "+v"(tz)); const int col = tz * 4, whi = c.wave >> 2;
#pragma unroll
          for (int i = 0; i < 4; ++i) { const int r = 2 * i + whi;
              const float* src = r == 0 ? lg : r == 1 ? lb : r == 2 ? mA + 5 * 1024 : r == 3 ? nA : r == 4 ? nA + 1024 : r == 5 ? mB + 5 * 1024 : r == 6 ? nB : nB + 1024;
              f32x4 v = *(const f32x4*)(src + col); if (r == 4 || r == 7) v = v + 1.0f;
              *(f32x4*)(PL + r * 1024 + ((col >> 2) & 3) * 256 + (col >> 4) * 4) = v; } }
        __syncthreads();
        int lz = lane; asm volatile("" : "+v"(lz));
        u32x4 pf[PFD][4];
#define C_LOAD(slot_, k_) do { const int kc_ = (k_) < ntok ? (k_) : (ntok > 0 ? ntok - 1 : 0); const size_t ro_ = (size_t)((tok0 + tstr * kc_) < nrows ? (tok0 + tstr * kc_) : 0) * D + 16 * lz; \
            pf[slot_][0] = *(const u32x4*)(FFN + ro_); pf[slot_][1] = *(const u32x4*)(FFN + ro_ + 8); pf[slot_][2] = *(const u32x4*)(XS + ro_); pf[slot_][3] = *(const u32x4*)(XS + ro_ + 8); } while (0)
#pragma unroll
        for (int i = 0; i < PFD; ++i) C_LOAD(i, i);
        for (int k3 = 0; k3 < ntok; k3 += PFD) {
#pragma unroll
          for (int sl = 0; sl < PFD; ++sl) { const int k = k3 + sl;
            if (k < ntok) { const int row = tok0 + tstr * k;
            bf16_t* xp = XS + (size_t)row * D + 16 * lz; const int mb = mod_batch(row);
            const float* pm = PL + (mb == mbA ? 2 : 5) * 1024 + 4 * lz;
            const u32x4 fa = pf[sl][0], fb = pf[sl][1], xa = pf[sl][2], xb = pf[sl][3];
            C_LOAD(sl, k + PFD);
            float o[16], x1[16];
#pragma unroll
            for (int q = 0; q < 4; ++q) { o[2 * q] = bf_lo(fa[q]); o[2 * q + 1] = bf_hi(fa[q]); o[8 + 2 * q] = bf_lo(fb[q]); o[9 + 2 * q] = bf_hi(fb[q]);
                x1[2 * q] = bf_lo(xa[q]); x1[2 * q + 1] = bf_hi(xa[q]); x1[8 + 2 * q] = bf_lo(xb[q]); x1[9 + 2 * q] = bf_hi(xb[q]); }
            float y[16]; float s = 0.f;
#pragma unroll
            for (int qd = 0; qd < 4; ++qd) { const f32x4 g2 = *(const f32x4*)(pm + qd * 256);
#pragma unroll
                for (int e = 0; e < 4; ++e) { y[4 * qd + e] = DN_ALPHA * x1[4 * qd + e] + g2[e] * o[4 * qd + e]; s += y[4 * qd + e]; } }
            const float mean = wave_sum(s) * (1.0f / 1024.0f);
            float q = 0.f;
#pragma unroll
            for (int e = 0; e < 16; ++e) { const float d = y[e] - mean; q += d * d; }
            const float rstd = rsqrtf(wave_sum(q) * (1.0f / 1024.0f) + LN_EPS);
            float x2[16];
#pragma unroll
            for (int qd = 0; qd < 4; ++qd) { const f32x4 gg = *(const f32x4*)(PL + qd * 256 + 4 * lz), bb = *(const f32x4*)(PL + 1024 + qd * 256 + 4 * lz);
#pragma unroll
                for (int e = 0; e < 4; ++e) x2[4 * qd + e] = (y[4 * qd + e] - mean) * rstd * gg[e] + bb[e]; }
            if (L == DEPTH - 1) {
#pragma unroll
                for (int qd = 0; qd < 4; ++qd) *(f32x4*)(p.out + (size_t)row * D + 16 * lz + 4 * qd) = (f32x4){x2[4 * qd], x2[4 * qd + 1], x2[4 * qd + 2], x2[4 * qd + 3]};
            } else {
                float hh[16];
#pragma unroll
                for (int qd = 0; qd < 4; ++qd) { const f32x4 sh = *(const f32x4*)(pm + 1024 + qd * 256), s1 = *(const f32x4*)(pm + 2048 + qd * 256);
#pragma unroll
                    for (int e = 0; e < 4; ++e) hh[4 * qd + e] = x2[4 * qd + e] * s1[e] + sh[e]; }
#pragma unroll
                for (int hf = 0; hf < 2; ++hf) { u32x4 wx, wh;
#pragma unroll
                    for (int q2 = 0; q2 < 4; ++q2) { wx[q2] = pk_bf16(x2[8 * hf + 2 * q2], x2[8 * hf + 2 * q2 + 1]); wh[q2] = pk_bf16(hh[8 * hf + 2 * q2], hh[8 * hf + 2 * q2 + 1]); }
                    *(u32x4*)(xp + 8 * hf) = wx; *(u32x4*)(H1 + (size_t)row * D + 16 * lz + 8 * hf) = wh; }
            }
            } }
        }
#undef C_LOAD
        __syncthreads();
    }
}

DI float logsig2_16(float z) { const float zl = z * 1.4426950408889634f; return (fminf(zl, 0.f) - __builtin_amdgcn_logf(1.0f + __builtin_amdgcn_exp2f(-fabsf(zl)))) * (1.0f / 16.0f); }
template <int DIR>
DI float gla_prep_gates(const bf16_t* Qt, const bf16_t* Kt, bf16_t* OUT, const float* gl, const float (&wg)[16], float bias, int cl, unsigned (&kpk)[32]) {
    constexpr int dir = DIR;
    { int z_ = 0; asm volatile("" : "+v"(z_)); gl += z_; }
    float cum = 0.f;
#pragma unroll
        for (int blk = 0; blk < 8; ++blk) {
            float gs[8];
            const int ib = dir ? 56 - 8 * blk : 8 * blk;
            unsigned short qraw[8], kraw[8];
#pragma unroll
            for (int e = 0; e < 8; ++e) { qraw[e] = Qt[(ib + e) * 256 + cl]; kraw[e] = Kt[(ib + e) * 256 + cl]; }
#pragma unroll
            for (int hb = 0; hb < 4; ++hb) { f32x4 gv[2][4];
#pragma unroll
                for (int e = 0; e < 2; ++e)
#pragma unroll
                    for (int r4 = 0; r4 < 4; ++r4) gv[e][r4] = ((const f32x4*)(gl + (ib + 2 * hb + e) * 32 + dir * 16))[r4];
                __builtin_amdgcn_sched_barrier(0);
#pragma unroll
                for (int e = 0; e < 2; ++e) { float z = bias;
#pragma unroll
                    for (int r4 = 0; r4 < 4; ++r4) z += gv[e][r4][0] * wg[4 * r4] + gv[e][r4][1] * wg[4 * r4 + 1] + gv[e][r4][2] * wg[4 * r4 + 2] + gv[e][r4][3] * wg[4 * r4 + 3];
                    gs[2 * hb + e] = logsig2_16(z); }
                __builtin_amdgcn_sched_barrier(0); }
            float kiv[8];
#pragma unroll
            for (int e = 0; e < 8; ++e) { const int pos = dir ? 7 - e : e, i = ib + pos;
                cum += gs[pos];
                const float qv = bf1(qraw[pos]), kv = bf1(kraw[pos]);
                OUT[(dir * 64 + i) * 256 + cl] = f2bf(qv * __builtin_amdgcn_exp2f(cum)); kiv[pos] = kv * __builtin_amdgcn_exp2f(-cum); }
            u32x4 w; w.x = pk_bf16(kiv[0], kiv[1]); w.y = pk_bf16(kiv[2], kiv[3]); w.z = pk_bf16(kiv[4], kiv[5]); w.w = pk_bf16(kiv[6], kiv[7]);
            if (dir) { kpk[4 * (7 - blk)] = w.x; kpk[4 * (7 - blk) + 1] = w.y; kpk[4 * (7 - blk) + 2] = w.z; kpk[4 * (7 - blk) + 3] = w.w; }
            else { kpk[4 * blk] = w.x; kpk[4 * blk + 1] = w.y; kpk[4 * blk + 2] = w.z; kpk[4 * blk + 3] = w.w; }
            __builtin_amdgcn_sched_barrier(0);
        }
    return cum;
}
DI void phase_gla_prep(const Ctx& c, int j) {
    const Params& p = *c.p; unsigned char* ws = c.ws; const int tid = c.tid;
    const bf16_t* QG = (const bf16_t*)(ws + WS_R1); const bf16_t* KG = (const bf16_t*)(ws + WS_R1 + SZ_T512); const bf16_t* VG = (const bf16_t*)(ws + WS_R1 + 2 * SZ_T512);
    const float* GL = (const float*)(ws + WS_GL); float* DEC = (float*)(ws + WS_DEC); bf16_t* VTt = (bf16_t*)(ws + WS_VTT);
    bf16_t* Qt = (bf16_t*)c.smem;
    bf16_t* Kt = Qt + 64 * 256;
    bf16_t* OUT = Kt + 64 * 256;
    float* gl = (float*)(c.smem + 131072);
    const int dir = __builtin_amdgcn_readfirstlane(tid >> 8), cl = tid & 255;
    u32x4 pq[4], pk[4]; f32x4 pgl; float pwg[16]; float pbias;
#define PREP_LOAD(u_) do { const int ch_ = (u_) >> 1, hc_ = (u_) & 1, r0_ = ch_ * 64, cg_ = 256 * hc_ + cl; \
        _Pragma("unroll") for (int it = 0; it < 4; ++it) { const int idx = it * 512 + tid, row = idx >> 5, c8 = (idx & 31) * 8; \
            pq[it] = *(const u32x4*)(QG + (size_t)(r0_ + row) * 512 + 256 * hc_ + c8); pk[it] = *(const u32x4*)(KG + (size_t)(r0_ + row) * 512 + 256 * hc_ + c8); } \
        pgl = ((const f32x4*)(GL + (size_t)r0_ * 32))[tid]; \
        _Pragma("unroll") for (int r = 0; r < 16; ++r) pwg[r] = p.in[15][((size_t)(j * 2 + dir) * 16 + r) * 512 + cg_]; \
        pbias = p.in[16][(size_t)(j * 2 + dir) * 512 + cg_]; } while (0)
    if (c.bid < (T / 64) * 2) PREP_LOAD(c.bid);
    for (int u = c.bid; u < (T / 64) * 2; u += c.G) {
        const int ch = u >> 1, hc = u & 1, r0 = ch * 64, cg = 256 * hc + cl;
        lds_barrier();
#pragma unroll
        for (int it = 0; it < 4; ++it) { const int idx = it * 512 + tid, row = idx >> 5, c8 = (idx & 31) * 8;
            *(u32x4*)(Qt + row * 256 + c8) = pq[it]; *(u32x4*)(Kt + row * 256 + c8) = pk[it]; }
        ((f32x4*)gl)[tid] = pgl;
        float wg[16];
#pragma unroll
        for (int r = 0; r < 16; ++r) wg[r] = pwg[r];
        const float bias = pbias;
        lds_barrier();
        unsigned kpk[32];
        const float cum = dir ? gla_prep_gates<1>(Qt, Kt, OUT, gl, wg, bias, cl, kpk) : gla_prep_gates<0>(Qt, Kt, OUT, gl, wg, bias, cl, kpk);
        DEC[((size_t)dir * (T / 64) + ch) * 512 + cg] = __builtin_amdgcn_exp2f(cum);
        { const int un = (u + c.G < (T / 64) * 2) ? u + c.G : u; PREP_LOAD(un); }
        u32x4 vv[8];
#pragma unroll
        for (int it = 0; it < 8; ++it) { const int idx = it * 512 + tid, row = idx >> 6, c8 = (idx & 63) * 8; vv[it] = *(const u32x4*)(VG + (size_t)(r0 + row) * 1024 + 512 * hc + c8); }
        lds_barrier();
#pragma unroll 2
        for (int it = 0; it < 8; ++it) { const int idx = it * 512 + tid, d2 = idx >> 11, row = (idx >> 5) & 63, c8 = (idx & 31) * 8;
            *(u32x4*)((bf16_t*)(ws + WS_R2) + (size_t)d2 * T * 512 + (size_t)(r0 + row) * 512 + 256 * hc + c8) = *(const u32x4*)(OUT + (d2 * 64 + row) * 256 + c8); }
        bf16_t* KT = Qt;
#pragma unroll
        for (int cb = 0; cb < 8; ++cb) *(u32x4*)(KT + (dir * 256 + cl) * 64 + ((cb ^ (cl & 7)) * 8)) = (u32x4){kpk[4 * cb], kpk[4 * cb + 1], kpk[4 * cb + 2], kpk[4 * cb + 3]};
        lds_barrier();
#pragma unroll 2
        for (int it = 0; it < 8; ++it) { const int idx = it * 512 + tid, d2 = idx >> 11, clr = (idx >> 3) & 255, cb = idx & 7;
            *(u32x4*)((bf16_t*)(ws + WS_R2 + 2 * SZ_T1K) + (((size_t)d2 * (T / 64) + ch) * 512 + 256 * hc + clr) * 64 + cb * 8) = *(const u32x4*)(KT + (d2 * 256 + clr) * 64 + ((cb ^ (clr & 7)) * 8)); }
#pragma unroll
        for (int i2 = 0; i2 < 32; ++i2) { OUT[(dir * 64 + 2 * i2) * 256 + cl] = (bf16_t)(kpk[i2] & 0xffffu); OUT[(dir * 64 + 2 * i2 + 1) * 256 + cl] = (bf16_t)(kpk[i2] >> 16); }
        lds_barrier();
#pragma unroll 2
        for (int it = 0; it < 8; ++it) { const int idx = it * 512 + tid, d2 = idx >> 11, row = (idx >> 5) & 63, c8 = (idx & 31) * 8;
            *(u32x4*)((bf16_t*)(ws + WS_R2 + SZ_T1K) + (size_t)d2 * T * 512 + (size_t)(r0 + row) * 512 + 256 * hc + c8) = *(const u32x4*)(OUT + (d2 * 64 + row) * 256 + c8); }
        bf16_t* Vl = Qt;
#pragma unroll
        for (int it = 0; it < 8; ++it) { const int idx = it * 512 + tid, row = idx >> 6, c8 = (idx & 63) * 8; *(u32x4*)(Vl + row * 512 + c8) = vv[it]; }
        lds_barrier();
        bf16_t* VTl = OUT;
#pragma unroll 2
        for (int cb = 0; cb < 8; ++cb) { unsigned short x[8];
#pragma unroll
            for (int t = 0; t < 8; ++t) x[t] = Vl[(8 * cb + t) * 512 + tid];
            u32x4 w; w.x = (unsigned)x[0] | ((unsigned)x[1] << 16); w.y = (unsigned)x[2] | ((unsigned)x[3] << 16); w.z = (unsigned)x[4] | ((unsigned)x[5] << 16); w.w = (unsigned)x[6] | ((unsigned)x[7] << 16);
            *(u32x4*)(VTl + tid * 64 + ((cb ^ (tid & 7)) * 8)) = w; }
        lds_barrier();
#pragma unroll 2
        for (int it = 0; it < 8; ++it) { const int idx = it * 512 + tid, er = idx >> 3, cb = idx & 7;
            *(u32x4*)(VTt + ((size_t)ch * 1024 + 512 * hc + er) * 64 + cb * 8) = *(const u32x4*)(VTl + er * 64 + ((cb ^ (er & 7)) * 8)); }
    }
#undef PREP_LOAD
}

DI void phase_gla_scan(const Ctx& c) {
    unsigned char* ws = c.ws; const int tid = c.tid, lane = c.lane, w = c.wave, g = lane >> 4, cc = lane & 15;
    const bf16_t* VTt = (const bf16_t*)(ws + WS_VTT); const float* DEC = (const float*)(ws + WS_DEC);
#define SW128(row_, col_) ((row_) * 128 + (((((col_) >> 3) ^ ((row_) & 15))) << 3) + ((col_) & 7))
#define SW64(row_, col_) ((row_) * 64 + (((((col_) >> 3) ^ (((row_) >> 1) & 7))) << 3) + ((col_) & 7))
#define FR128(X_, row0_, ks_) (*(const bf16x8*)((X_) + (row0_) * 128 + o128[ks_]))
#define FR64(X_, row0_, ks_) (*(const bf16x8*)((X_) + (row0_) * 64 + o64[ks_]))
    bf16_t* Qs = (bf16_t*)c.smem;
    bf16_t* Ks = Qs + 64 * 128;
    bf16_t* KEt = Ks + 64 * 128;
    bf16_t* Vt = KEt + 128 * 64;
    bf16_t* At = Vt + 128 * 64;
    bf16_t* St = At + 8 * 16 * 64;
    bf16_t* Ot = St + 128 * 128;
    float* dec = (float*)(Ot + 64 * 128);
    int o128[4], o64[2];
#pragma unroll
    for (int ks = 0; ks < 4; ++ks) o128[ks] = cc * 128 + (((4 * ks + g) ^ cc) << 3);
#pragma unroll
    for (int ks = 0; ks < 2; ++ks) o64[ks] = cc * 64 + (((4 * ks + g) ^ ((cc >> 1) & 7)) << 3);
    const int qtok0 = tid >> 4, qd8 = (tid & 15) * 8;
    const int ked0 = tid >> 3, kej8 = (tid & 7) * 8;
    for (int u = c.bid; u < NB * 4 * 2 * 2; u += c.G) {
        const int b = u >> 4, h = (u >> 2) & 3, es = (u >> 1) & 1, dir = u & 1;
        bf16_t* O = (bf16_t*)(ws + (dir ? WS_OB : WS_H1));
        const bf16_t* QIN = (const bf16_t*)(ws + WS_R2) + (size_t)dir * T * 512; const bf16_t* KIN = (const bf16_t*)(ws + WS_R2 + SZ_T1K) + (size_t)dir * T * 512;
        const bf16_t* KINt = (const bf16_t*)(ws + WS_R2 + 2 * SZ_T1K) + (size_t)dir * (T / 64) * 512 * 64;
        f32x4 accS[8];
#pragma unroll
        for (int et = 0; et < 8; ++et) accS[et] = (f32x4){0.f, 0.f, 0.f, 0.f};
        lds_barrier();
        for (int i = tid; i < 128 * 128 / 2; i += NTHR) ((unsigned*)St)[i] = 0u;
        u32x4 pq[2], pk[2], pke[2], pv[2]; float pdec = 0.f;
#define GLA_R0(cs_) (dir == 0 ? ((cs_) < 4 ? TL + b * CTXL + 64 * (cs_) : b * SEQ + 64 * ((cs_) - 4)) : ((cs_) < 4 ? TL + b * CTXL + 64 * (3 - (cs_)) : b * SEQ + 64 * (35 - (cs_))))
#define GLA_LOAD(cs_) do { const int r0_ = GLA_R0(cs_); const int chunk_ = r0_ >> 6; \
            _Pragma("unroll") for (int it = 0; it < 2; ++it) { const size_t go = (size_t)(r0_ + qtok0 + 32 * it) * 512 + h * 128 + qd8; pq[it] = *(const u32x4*)(QIN + go); pk[it] = *(const u32x4*)(KIN + go); \
                pke[it] = *(const u32x4*)(KINt + ((size_t)chunk_ * 512 + h * 128 + ked0 + 64 * it) * 64 + kej8); \
                pv[it] = *(const u32x4*)(VTt + ((size_t)chunk_ * 1024 + h * 256 + es * 128 + ked0 + 64 * it) * 64 + kej8); } \
            if (tid < 128) pdec = DEC[((size_t)dir * (T / 64) + chunk_) * 512 + h * 128 + tid]; } while (0)
        GLA_LOAD(0);
        for (int cs = 0; cs < 36; ++cs) {
            const int r0 = GLA_R0(cs);
#pragma unroll
            for (int it = 0; it < 2; ++it) { *(u32x4*)(Qs + SW128(qtok0 + 32 * it, qd8)) = pq[it]; *(u32x4*)(Ks + SW128(qtok0 + 32 * it, qd8)) = pk[it];
                *(u32x4*)(KEt + SW64(ked0 + 64 * it, kej8)) = pke[it]; *(u32x4*)(Vt + SW64(ked0 + 64 * it, kej8)) = pv[it]; }
            if (tid < 128) dec[tid] = pdec;
            lds_barrier();
            GLA_LOAD(cs + 1 < 36 ? cs + 1 : cs);
            { const int it = w >> 1; bf16_t* Aw = At + w * 16 * 64;
              bf16x8 qf[4], kf[4][4];
#pragma unroll
              for (int ks = 0; ks < 4; ++ks) qf[ks] = FR128(Qs, 16 * it, ks);
#pragma unroll
              for (int jt = 0; jt < 4; ++jt)
#pragma unroll
                  for (int ks = 0; ks < 4; ++ks) kf[jt][ks] = FR128(Ks, 16 * jt, ks);
              __builtin_amdgcn_sched_barrier(0);
#pragma unroll
              for (int jt = 0; jt < 4; ++jt) { f32x4 a = {0.f, 0.f, 0.f, 0.f};
#pragma unroll
                  for (int ks = 0; ks < 4; ++ks) a = mfma16(kf[jt][ks], qf[ks], a);
                  const int i = 16 * it + cc, j0 = 16 * jt + 4 * g; float m[4];
#pragma unroll
                  for (int r = 0; r < 4; ++r) { const bool keep = dir ? (j0 + r >= i) : (j0 + r <= i); m[r] = keep ? a[r] : 0.f; }
                  u32x2 pw; pw.x = pk_bf16(m[0], m[1]); pw.y = pk_bf16(m[2], m[3]);
                  *(u32x2*)(Aw + SW64(cc, j0)) = pw; }
              bf16x8 af[2];
#pragma unroll
              for (int ks = 0; ks < 2; ++ks) af[ks] = FR64(Aw, 0, ks);
#pragma unroll
              for (int eh = 0; eh < 2; ++eh) {
                  bf16x8 vf[2][2], sf[2][4];
#pragma unroll
                  for (int e2 = 0; e2 < 2; ++e2) { const int et = 4 * (w & 1) + 2 * eh + e2;
#pragma unroll
                      for (int ks = 0; ks < 2; ++ks) vf[e2][ks] = FR64(Vt, 16 * et, ks);
#pragma unroll
                      for (int ks = 0; ks < 4; ++ks) sf[e2][ks] = FR128(St, 16 * et, ks); }
                  __builtin_amdgcn_sched_barrier(0);
#pragma unroll
                  for (int e2 = 0; e2 < 2; ++e2) { const int et = 4 * (w & 1) + 2 * eh + e2; f32x4 a = {0.f, 0.f, 0.f, 0.f};
#pragma unroll
                      for (int ks = 0; ks < 4; ++ks) a = mfma16(sf[e2][ks], qf[ks], a);
#pragma unroll
                      for (int ks = 0; ks < 2; ++ks) a = mfma16(vf[e2][ks], af[ks], a);
                      u32x2 pw; pw.x = pk_bf16(a[0], a[1]); pw.y = pk_bf16(a[2], a[3]);
                      *(u32x2*)(Ot + SW128(16 * it + cc, 16 * et + 4 * g)) = pw; }
                  __builtin_amdgcn_sched_barrier(0);
              } }
            { bf16x8 kef[2]; float dv[4];
#pragma unroll
              for (int ks = 0; ks < 2; ++ks) kef[ks] = FR64(KEt, 16 * w, ks);
#pragma unroll
              for (int r = 0; r < 4; ++r) dv[r] = dec[16 * w + 4 * g + r];
#pragma unroll
              for (int eh = 0; eh < 2; ++eh) {
                  bf16x8 vf2[4][2];
#pragma unroll
                  for (int e4 = 0; e4 < 4; ++e4)
#pragma unroll
                      for (int ks = 0; ks < 2; ++ks) vf2[e4][ks] = FR64(Vt, 16 * (4 * eh + e4), ks);
                  __builtin_amdgcn_sched_barrier(0);
#pragma unroll
                  for (int e4 = 0; e4 < 4; ++e4) { const int et = 4 * eh + e4;
#pragma unroll
                      for (int ks = 0; ks < 2; ++ks) accS[et] = mfma16(kef[ks], vf2[e4][ks], accS[et]);
#pragma unroll
                      for (int r = 0; r < 4; ++r) accS[et][r] *= dv[r]; }
                  __builtin_amdgcn_sched_barrier(0);
              } }
            lds_barrier();
#pragma unroll
            for (int et = 0; et < 8; ++et) { u32x2 sv; sv.x = pk_bf16(accS[et][0], accS[et][1]); sv.y = pk_bf16(accS[et][2], accS[et][3]);
                *(u32x2*)(St + SW128(16 * et + cc, 16 * w + 4 * g)) = sv; }
#pragma unroll
            for (int it = 0; it < 2; ++it) *(u32x4*)(O + (size_t)(r0 + qtok0 + 32 * it) * 1024 + h * 256 + es * 128 + qd8) = *(const u32x4*)(Ot + SW128(qtok0 + 32 * it, qd8));
        }
#undef GLA_LOAD
#undef GLA_R0
#undef SW128
#undef SW64
#undef FR128
#undef FR64
    }
}

DI float row16_sum(float v) { v += dpp_mov<0x128>(v); v += dpp_mov<0x124>(v); v += dpp_mov<0x122>(v); v += dpp_mov<0x121>(v); return v; }
DI void phase_gla_readout(const Ctx& c, int j) {
    const Params& p = *c.p; unsigned char* ws = c.ws;
    const bf16_t* O = (const bf16_t*)(ws + WS_H1); const bf16_t* OB = (const bf16_t*)(ws + WS_OB); const bf16_t* RG = (const bf16_t*)(ws + WS_R1 + 2 * SZ_T512 + SZ_T1K); bf16_t* Y = (bf16_t*)(ws + WS_R2);
    const int stride = c.G * NWAVE, r0 = c.bid * NWAVE + c.wave, nr = (T - r0 + stride - 1) / stride;
    int lz = c.lane; asm volatile("" : "+v"(lz));
    f32x4 GN[4];
#pragma unroll
    for (int qd = 0; qd < 4; ++qd) GN[qd] = *(const f32x4*)(p.in[17] + (size_t)j * 1024 + 16 * lz + 4 * qd);
    constexpr int PFD = 3;
    u32x4 pf[PFD][6];
#define RO_LOAD(slot_, k_) do { const int kc_ = (k_) < nr ? (k_) : nr - 1; const size_t o_ = (size_t)(r0 + stride * kc_) * D + 16 * lz; \
        pf[slot_][0] = *(const u32x4*)(O + o_); pf[slot_][1] = *(const u32x4*)(O + o_ + 8); pf[slot_][2] = *(const u32x4*)(OB + o_); pf[slot_][3] = *(const u32x4*)(OB + o_ + 8); \
        pf[slot_][4] = *(const u32x4*)(RG + o_); pf[slot_][5] = *(const u32x4*)(RG + o_ + 8); } while (0)
    if (nr > 0) {
#pragma unroll
        for (int i = 0; i < PFD; ++i) RO_LOAD(i, i);
    }
    for (int k3 = 0; k3 < nr; k3 += PFD) {
#pragma unroll
        for (int sl = 0; sl < PFD; ++sl) { const int k = k3 + sl;
            if (k < nr) { const int row = r0 + stride * k;
            u32x4 ov[2], ow[2], rv[2];
#pragma unroll
            for (int hf = 0; hf < 2; ++hf) { ov[hf] = pf[sl][hf]; ow[hf] = pf[sl][2 + hf]; rv[hf] = pf[sl][4 + hf]; }
            RO_LOAD(sl, k + PFD);
            float x[16], r[16]; float s = 0.f;
#pragma unroll
            for (int hf = 0; hf < 2; ++hf)
#pragma unroll
                for (int q = 0; q < 4; ++q) { x[8 * hf + 2 * q] = bf_lo(ov[hf][q]) + bf_lo(ow[hf][q]); x[8 * hf + 2 * q + 1] = bf_hi(ov[hf][q]) + bf_hi(ow[hf][q]);
                    r[8 * hf + 2 * q] = bf_lo(rv[hf][q]); r[8 * hf + 2 * q + 1] = bf_hi(rv[hf][q]); }
#pragma unroll
            for (int e = 0; e < 16; ++e) s += x[e];
            const float mean = row16_sum(s) * (1.0f / 256.0f);
            float q2 = 0.f;
#pragma unroll
            for (int e = 0; e < 16; ++e) { x[e] -= mean; q2 += x[e] * x[e]; }
            const float rstd = rsqrtf(row16_sum(q2) * (1.0f / 256.0f) + LN_EPS);
            float y[16];
#pragma unroll
            for (int qd = 0; qd < 4; ++qd)
#pragma unroll
                for (int e = 0; e < 4; ++e) y[4 * qd + e] = x[4 * qd + e] * rstd * GN[qd][e] * silu_f(r[4 * qd + e]);
#pragma unroll
            for (int hf = 0; hf < 2; ++hf) { u32x4 w;
#pragma unroll
                for (int q = 0; q < 4; ++q) w[q] = pk_bf16(y[8 * hf + 2 * q], y[8 * hf + 2 * q + 1]);
                *(u32x4*)(Y + (size_t)row * D + 16 * lz + 8 * hf) = w; }
            } }
    }
#undef RO_LOAD
}

constexpr int N_PHASES = 2 + 2 * 8 + 2 * 9;

__global__ void __launch_bounds__(NTHR, 2) mega_fwd(Params p) {
    extern __shared__ __attribute__((aligned(16))) unsigned char smem[];
    cg::grid_group grid = cg::this_grid();
    Ctx c; c.p = &p; c.ws = p.ws; c.smem = smem; c.tid = threadIdx.x; c.lane = c.tid & 63; c.wave = __builtin_amdgcn_readfirstlane(c.tid >> 6); c.G = gridDim.x; c.bid = blockIdx.x;
    unsigned char* ws = p.ws;
    volatile LAS unsigned* xst = (volatile LAS unsigned*)((LAS unsigned char*)smem + (LDS_BYTES - 16));
    if (threadIdx.x == 0) { xst[0] = 0u; xst[1] = 0u; }
    __syncthreads();
    const XcdBarrier xbar = xcd_barrier_post((unsigned*)(ws + WS_CTL), xst);
    const int lo = p.ph_lo, hi = p.ph_hi;
    int ph = 0;
    const int wave0 = __builtin_amdgcn_readfirstlane((int)threadIdx.x >> 6);
#ifndef PH_ONLY
#define PH_ONLY -1
#endif
#ifndef DUP_MASK
#define DUP_MASK 0
#endif
#define RUN1(...) { { unsigned on_ = ~0u; asm volatile("" : "+s"(on_)); int t_ = wave0 * 64 + (int)__builtin_amdgcn_mbcnt_hi(on_, __builtin_amdgcn_mbcnt_lo(on_, 0u)); asm volatile("" : "+v"(t_));     \
        c.tid = t_; c.lane = t_ & 63; c.wave = __builtin_amdgcn_readfirstlane(t_ >> 6); { size_t z_ = 0; asm volatile("" : "+s"(z_)); ws = p.ws + z_; } c.ws = ws; } __VA_ARGS__; }
#define RUN(id, ...) do { if ((PH_ONLY < 0 || PH_ONLY == (id)) && ph >= lo && ph < hi) { \
        RUN1(__VA_ARGS__) \
        if ((DUP_MASK >> (id)) & 1) { xcd_barrier(xbar); RUN1(__VA_ARGS__) } \
        if (ph + 1 < hi) { if (hi < 0) grid.sync(); else xcd_barrier(xbar); } } ++ph; } while (0)
    LAS unsigned char* lds = (LAS unsigned char*)smem;
    const float* MOD = (const float*)(ws + WS_MOD);

    RUN(0, phase_prologue(c));
    RUN(1, phase_mod0(c));
    for (int L = 0; L < DEPTH; ++L) {
        const int j = L >> 1;
        if ((L & 1) == 0) {
            RUN(2, { pg8::Gemm g{(const bf16_t*)(ws + WS_H1), (const bf16_t*)(ws + WS_WAIN) + (size_t)j * 2048 * 1024, T, 2048, 1024}; pg8::StaticOrder S; S.init(T, 2048, c.G, c.bid);
                  pg8::EpiBf16<1> E{(bf16_t*)(ws + WS_R1), 2048, nullptr, 0}; pg8::gemm_phase(lds, g, S, E, c.tid); });
            RUN(3, phase_vstats(c));
            RUN(4, phase_spatial(c, j));
        } else {
            RUN(5, { pg8::Gemm g{(const bf16_t*)(ws + WS_H1), (const bf16_t*)(ws + WS_WBIN) + (size_t)j * WBIN_N * 1024, T, WBIN_N, 1024}; pg8::StaticOrder S; S.init(T, WBIN_N, c.G, c.bid);
                  pg8::EpiGlaProj E{(bf16_t*)(ws + WS_R1), (bf16_t*)(ws + WS_R1 + SZ_T512), (bf16_t*)(ws + WS_R1 + 2 * SZ_T512), (bf16_t*)(ws + WS_R1 + 2 * SZ_T512 + SZ_T1K), (float*)(ws + WS_GL)};
                  pg8::gemm_phase(lds, g, S, E, c.tid); });
            RUN(6, phase_gla_prep(c, j));
            RUN(7, phase_gla_scan(c));
            RUN(8, phase_gla_readout(c, j));
        }
        const int Mrows = (L == DEPTH - 1) ? TL : T;
        RUN(9, { const bf16_t* W = (L & 1) ? (const bf16_t*)(ws + WS_WBOUT) + (size_t)j * 1024 * 1024 : (const bf16_t*)(ws + WS_WAOUT) + (size_t)j * 1024 * 1024;
              pg8::Gemm g{(const bf16_t*)(ws + WS_R2), W, Mrows, 1024, 1024}; pg8::StaticOrder S; S.init(Mrows, 1024, c.G, c.bid, true);
              pg8::EpiRes E{p.in[0], p.in[2], (bf16_t*)(ws + WS_XS), MOD + (size_t)L * 17 * 6144, 2, L == 0 ? 1 : 0, (bf16_t*)(ws + WS_P1), S.tail_row0()};
              pg8::gemm_phase(lds, g, S, E, c.tid); if (L + 1 < DEPTH) quant_in_gemm_tail(c, S.tail_busy(), 0, L + 1); });
        RUN(10, phase_ln1(c, L));
        RUN(11, { pg8::Gemm g{(const bf16_t*)(ws + WS_R2 + SZ_T1K), (const bf16_t*)(ws + WS_WQ) + (size_t)L * 1024 * 1024, Mrows, 1024, 1024}; pg8::StaticOrder S; S.init(Mrows, 1024, c.G, c.bid, true);
              pg8::EpiBf16<0> E{(bf16_t*)(ws + WS_R1), 1024, (bf16_t*)(ws + WS_QP2), S.tail_row0()}; pg8::gemm_phase(lds, g, S, E, c.tid); if (L + 1 < DEPTH) quant_in_gemm_tail(c, S.tail_busy(), 1, L + 1); });
        RUN(12, phase_route(c, L));
        RUN(13, phase_experts(c, L));
    }
#undef RUN
}

extern "C" void kernel_launch(void* const* d_in, const int* in_sizes, int n_in, void* d_out, int out_size, void* d_ws, size_t ws_size, hipStream_t stream) {
    static int grid = 0;
    if (grid == 0) {
        if (n_in != 23 || out_size != TL * D || ws_size < WS_END) { fprintf(stderr, "kernel_launch: unexpected shapes: n_in %d out %d ws %zu (need %zu)\n", n_in, out_size, ws_size, (size_t)WS_END); grid = -1; return; }
        int dev = 0, cus = 0, per_cu = 0;
        if (hipGetDevice(&dev) != hipSuccess || hipDeviceGetAttribute(&cus, hipDeviceAttributeMultiprocessorCount, dev) != hipSuccess) { fprintf(stderr, "kernel_launch: device query failed\n"); grid = -1; return; }
        if (hipFuncSetAttribute((const void*)mega_fwd, hipFuncAttributeMaxDynamicSharedMemorySize, LDS_BYTES) != hipSuccess) { fprintf(stderr, "kernel_launch: hipFuncSetAttribute failed\n"); grid = -1; return; }
        if (hipOccupancyMaxActiveBlocksPerMultiprocessor(&per_cu, (const void*)mega_fwd, NTHR, LDS_BYTES) != hipSuccess || per_cu < 1) { fprintf(stderr, "kernel_launch: occupancy query says %d blocks per CU\n", per_cu); grid = -1; return; }
        grid = cus;
    }
    if (grid < 0) return;
    (void)hipMemsetAsync((char*)d_ws + WS_CTL, 0, 65536, stream);
    Params p{};
    for (int i = 0; i < 23; ++i) p.in[i] = (const float*)d_in[i];
    p.out = (float*)d_out; p.ws = (unsigned char*)d_ws; p.ph_lo = 0; p.ph_hi = N_PHASES;
    void* args[] = {&p};
    const hipError_t e = hipLaunchCooperativeKernel((const void*)mega_fwd, dim3(grid), dim3(NTHR), args, LDS_BYTES, stream);
    if (e != hipSuccess) fprintf(stderr, "kernel_launch: cooperative launch failed: %s (grid %d)\n", hipGetErrorString(e), grid);
}
```

```cpp
#include <hip/hip_runtime.h>
#include <hip/hip_cooperative_groups.h>
#include <cstdio>
#include <cstdint>
namespace cg = cooperative_groups;

#define LAS __attribute__((address_space(3)))
#define DI __device__ __forceinline__
typedef unsigned short bf16_t;
typedef short bf16x8 __attribute__((ext_vector_type(8)));
typedef float f32x4 __attribute__((ext_vector_type(4)));
typedef float f32x2 __attribute__((ext_vector_type(2)));
typedef unsigned u32x4 __attribute__((ext_vector_type(4)));
typedef unsigned u32x2 __attribute__((ext_vector_type(2)));
typedef int v2i32 __attribute__((ext_vector_type(2)));
typedef short v4i16 __attribute__((ext_vector_type(4)));
typedef __bf16 bf16v2 __attribute__((ext_vector_type(2)));

constexpr int D = 1024, NB = 16, SEQ = 2048, CTXL = 256, DEPTH = 4;
constexpr int TL = NB * SEQ, TC = NB * CTXL, T = TL + TC;
constexpr int NEXP = 16384;
constexpr float LN_EPS = 1e-5f;
constexpr float DN_ALPHA = 1.6817928305074290f;
constexpr int NTHR = 512, NWAVE = 8;
constexpr int LDS_BYTES = 160 * 1024;
constexpr int WBIN_N = 3328;

constexpr size_t al256(size_t x) { return (x + 255) & ~(size_t)255; }
constexpr size_t WS_CTL = 0;
constexpr size_t WS_MOD = 65536;
constexpr size_t WS_STATS = al256(WS_MOD + (size_t)4 * 17 * 6144 * 4);
constexpr size_t WS_GL = al256(WS_STATS + (size_t)T * 2 * 4);
constexpr size_t WS_DEC = al256(WS_GL + (size_t)T * 32 * 4);
constexpr size_t WS_WSB = al256(WS_DEC + (size_t)2 * 576 * 512 * 4);
constexpr size_t WS_WAIN = al256(WS_WSB + (size_t)2 * 8 * 128 * 128 * 2);
constexpr size_t WS_WAOUT = WS_WAIN + (size_t)2 * 2048 * 1024 * 2;
constexpr size_t WS_WBIN = WS_WAOUT + (size_t)2 * 1024 * 1024 * 2;
constexpr size_t WS_WBOUT = WS_WBIN + (size_t)2 * WBIN_N * 1024 * 2;
constexpr size_t WS_WQ = WS_WBOUT + (size_t)2 * 1024 * 1024 * 2;
constexpr size_t WS_UT = WS_WQ + (size_t)4 * 1024 * 1024 * 2;
constexpr size_t WS_VT = WS_UT + (size_t)4 * NEXP * 1024;
constexpr size_t WS_SU = WS_VT + (size_t)4 * NEXP * 1024;
constexpr size_t WS_SV = WS_SU + (size_t)4 * NEXP * 4;
constexpr size_t WS_XS = WS_SV + (size_t)4 * NEXP * 4;
constexpr size_t WS_R1 = WS_XS + (size_t)T * 1024 * 4;
constexpr size_t WS_R2 = WS_R1 + (size_t)T * 3072 * 2;
constexpr size_t WS_H1 = WS_R2 + (size_t)T * 3072 * 2;
constexpr size_t WS_VTT = WS_H1 + (size_t)T * 1024 * 2;
constexpr size_t WS_OB = WS_VTT + (size_t)T * 1024 * 2;
constexpr size_t WS_XH = WS_OB + (size_t)T * 1024 * 2;
constexpr size_t WS_XL = WS_XH + (size_t)T * 512;
constexpr size_t WS_SX = WS_XL + (size_t)T * 512;
constexpr size_t WS_END = al256(WS_SX + (size_t)T * 4);
constexpr size_t SZ_T1K = (size_t)T * 1024 * 2;
constexpr size_t SZ_T512 = (size_t)T * 512 * 2;

struct Params { const float* in[23]; float* out; unsigned char* ws; int ph_lo, ph_hi; };

DI unsigned pk_bf16(float lo, float hi) { f32x2 v = {lo, hi}; return __builtin_bit_cast(unsigned, __builtin_convertvector(v, bf16v2)); }
DI float bf_lo(unsigned w) { return __uint_as_float(w << 16); }
DI float bf_hi(unsigned w) { return __uint_as_float(w & 0xffff0000u); }
DI float bf1(bf16_t b) { return __uint_as_float(((unsigned)b) << 16); }
DI bf16_t f2bf(float f) { return (bf16_t)(pk_bf16(f, 0.f) & 0xffffu); }
DI float gelu_tanh(float x) { const float t = x * x; const float w = x * (t * (-2.0f * 1.4426950408889634f * 0.7978845608028654f * 0.044715f) + (-2.0f * 1.4426950408889634f * 0.7978845608028654f)); return x * __builtin_amdgcn_rcpf(1.0f + __builtin_amdgcn_exp2f(w)); }
DI float silu_f(float x) { return x * __builtin_amdgcn_rcpf(1.0f + __builtin_amdgcn_exp2f(-1.4426950408889634f * x)); }
DI float logsig_f(float z) { return fminf(z, 0.f) - log1pf(expf(-fabsf(z))); }
template <int CTRL> DI float dpp_mov(float x) { return __builtin_bit_cast(float, __builtin_amdgcn_mov_dpp(__builtin_bit_cast(int, x), CTRL, 0xf, 0xf, true)); }
DI void lds_barrier() { asm volatile("s_waitcnt lgkmcnt(0)" ::: "memory"); __builtin_amdgcn_s_barrier(); asm volatile("" ::: "memory"); }
DI float wave_sum(float v) {
    const auto a = __builtin_amdgcn_permlane32_swap(__float_as_uint(v), __float_as_uint(v), false, false); v = __uint_as_float(a[0]) + __uint_as_float(a[1]);
    const auto b = __builtin_amdgcn_permlane16_swap(__float_as_uint(v), __float_as_uint(v), false, false); v = __uint_as_float(b[0]) + __uint_as_float(b[1]);
    v += dpp_mov<0x128>(v); v += dpp_mov<0x124>(v); v += dpp_mov<0x122>(v); v += dpp_mov<0x121>(v);
    return v;
}
DI float wave_max(float v) {
    const auto a = __builtin_amdgcn_permlane32_swap(__float_as_uint(v), __float_as_uint(v), false, false); v = fmaxf(__uint_as_float(a[0]), __uint_as_float(a[1]));
    const auto b = __builtin_amdgcn_permlane16_swap(__float_as_uint(v), __float_as_uint(v), false, false); v = fmaxf(__uint_as_float(b[0]), __uint_as_float(b[1]));
    v = fmaxf(v, dpp_mov<0x128>(v)); v = fmaxf(v, dpp_mov<0x124>(v)); v = fmaxf(v, dpp_mov<0x122>(v)); v = fmaxf(v, dpp_mov<0x121>(v));
    return v;
}
DI float reduce4(float p0, float p1, float p2, float p3) {
    const auto a = __builtin_amdgcn_permlane32_swap(__float_as_uint(p0), __float_as_uint(p2), false, false); const float q0 = __uint_as_float(a[0]) + __uint_as_float(a[1]);
    const auto b = __builtin_amdgcn_permlane32_swap(__float_as_uint(p1), __float_as_uint(p3), false, false); const float q1 = __uint_as_float(b[0]) + __uint_as_float(b[1]);
    const auto c = __builtin_amdgcn_permlane16_swap(__float_as_uint(q0), __float_as_uint(q1), false, false); float s = __uint_as_float(c[0]) + __uint_as_float(c[1]);
    s += dpp_mov<0x128>(s); s += dpp_mov<0x124>(s); s += dpp_mov<0x122>(s); s += dpp_mov<0x121>(s);
    return s;
}
DI float dot2bf(unsigned a, unsigned b, float c) { return __builtin_amdgcn_fdot2_f32_bf16(__builtin_bit_cast(bf16v2, a), __builtin_bit_cast(bf16v2, b), c, false); }
DI f32x4 mfma16(bf16x8 a, bf16x8 b, f32x4 c) { return __builtin_amdgcn_mfma_f32_16x16x32_bf16(a, b, c, 0, 0, 0); }
DI bf16x8 frag_ld(const bf16_t* X, int ld, int row0, int k0, int lane) { return *(const bf16x8*)(X + (size_t)(row0 + (lane & 15)) * ld + k0 + 8 * (lane >> 4)); }
DI int mod_batch(int row) { return row < TL ? (row >> 11) : NB; }

#define XB_TMO      128
#define XB_XCNT(j)  (256  + 64 * (j))
#define XB_XSUB(j)  (1280 + 64 * (j))
#define XB_XGEN(j)  (2304 + 64 * (j))
#define XB_TOP      3328
#define XB_TOPGEN   3392
#define XCD_BAR_WORDS 3456
#define XB_SPIN_CAP (1u << 22)
DI unsigned xb_ld(unsigned* p)              { return __hip_atomic_load(p, __ATOMIC_RELAXED, __HIP_MEMORY_SCOPE_AGENT); }
DI unsigned xb_add(unsigned* p, unsigned v) { return __hip_atomic_fetch_add(p, v, __ATOMIC_RELAXED, __HIP_MEMORY_SCOPE_AGENT); }
DI unsigned xb_xcc_id() { return (unsigned)__builtin_amdgcn_s_getreg((3 << 11) | 20) & 0xFu; }
#define XB_SPIN(cond, bar) do { unsigned _sp = 0; while (cond) { __builtin_amdgcn_s_sleep(1); \
    if ((++_sp & 255u) == 0u) { if (xb_ld(&(bar)[XB_TMO])) break; if (_sp > XB_SPIN_CAP) { atomicAdd(&(bar)[XB_TMO], 1u); break; } } } } while (0)
struct XcdBarrier { unsigned* bar; unsigned x; volatile LAS unsigned* st; };
DI XcdBarrier xcd_barrier_post(unsigned* bar, volatile LAS unsigned* st) {
    XcdBarrier b; b.bar = bar; b.x = xb_xcc_id(); b.st = st;
    if (threadIdx.x == 0) (void)xb_add(&bar[XB_XCNT(b.x)], 1u);
    return b;
}
DI void xcd_barrier_complete(unsigned* bar, unsigned x, unsigned& nloc, unsigned& nx) {
    const unsigned G = gridDim.x * gridDim.y * gridDim.z;
    unsigned sum, cnt, mine, sp = 0u;
    for (;;) {
        sum = 0u; cnt = 0u; mine = 0u;
#pragma unroll
        for (unsigned j = 0; j < 16; ++j) { const unsigned c = xb_ld(&bar[XB_XCNT(j)]); sum += c; cnt += (c > 0u) ? 1u : 0u; mine = (j == x) ? c : mine; }
        if (sum == G) break;
        __builtin_amdgcn_s_sleep(1);
        if ((++sp & 255u) == 0u) { if (xb_ld(&bar[XB_TMO])) break; if (sp > XB_SPIN_CAP) { atomicAdd(&bar[XB_TMO], 1u); break; } }
    }
    nloc = mine > 0u ? mine : 1u; nx = cnt > 0u ? cnt : 1u;
}
DI void xcd_barrier(const XcdBarrier& b) {
    asm volatile("s_waitcnt vmcnt(0)" ::: "memory");
    __syncthreads();
    if (threadIdx.x == 0) {
        unsigned* bar = b.bar;
        __builtin_amdgcn_s_waitcnt(0);
        unsigned nloc = b.st[0], nx = b.st[1];
        if (nloc == 0u) { xcd_barrier_complete(bar, b.x, nloc, nx); b.st[0] = nloc; b.st[1] = nx; }
        const unsigned old = xb_add(&bar[XB_XSUB(b.x)], 1u);
        const unsigned gen = old / nloc;
        if (old + 1u == (gen + 1u) * nloc) {
            __builtin_amdgcn_fence(__ATOMIC_RELEASE, "agent");
            asm volatile("s_waitcnt vmcnt(0)" ::: "memory");
            const unsigned og = xb_add(&bar[XB_TOP], 1u);
            const unsigned tg = og / nx;
            if (og + 1u == (tg + 1u) * nx) xb_add(&bar[XB_TOPGEN], 1u);
            else XB_SPIN(xb_ld(&bar[XB_TOPGEN]) == tg, bar);
            __builtin_amdgcn_fence(__ATOMIC_ACQUIRE, "agent");
            xb_add(&bar[XB_XGEN(b.x)], 1u);
            asm volatile("s_waitcnt vmcnt(0)" ::: "memory");
        } else {
            XB_SPIN(xb_ld(&bar[XB_XGEN(b.x)]) == gen, bar);
            __builtin_amdgcn_fence(__ATOMIC_ACQUIRE, "agent");
            asm volatile("s_waitcnt vmcnt(0)" ::: "memory");
        }
    }
    __syncthreads();
}

namespace pg8 {
constexpr int BM = 256, BK = 64, HALF = 128, HTB = HALF * BK * 2, STAGE_BYTES = 8 * HTB, NXCD = 8, WGM = 8;
__host__ __device__ __forceinline__ int lds_byte(int r, int c) { const int st = (r >> 4) * 2 + (c >> 5), rr = r & 15, cc = c & 31, ob = rr * 64 + cc * 2; return st * 1024 + (ob ^ (((ob >> 9) & 1) << 5)); }
__host__ __device__ __forceinline__ void stage_rc(int b, int& R, int& C) { const int st = b / 1024, sb = b % 1024, swz = sb ^ (((sb >> 9) & 1) << 5); R = (st >> 1) * 16 + swz / 64; C = (st & 1) * 32 + (swz % 64) / 2; }
__host__ __device__ __forceinline__ int perm32(int rho) { const int n = rho >> 4, i = rho & 15; return 8 * (i >> 2) + 4 * n + (i & 3); }
struct Unit { int pm, pn; };
struct Gemm { const bf16_t* A; const bf16_t* Bt; int M, N, K; };
struct StaticOrder {
    int nM, nN, nwg, G, c;
    __device__ void init(int M, int N, int G_, int c_) { nM = M / BM; nN = N / BM; nwg = nM * nN; G = G_; c = c_; }
    __device__ bool next(int i, Unit& u) const {
        const long L = (long)i * G + c; if (L >= nwg) return false;
        int wgid = (int)L; { const int q = nwg / NXCD, r = nwg % NXCD, xcd = wgid % NXCD, off = wgid / NXCD; wgid = (xcd < r ? xcd * (q + 1) : r * (q + 1) + (xcd - r) * q) + off; }
        const int nig = WGM * nN, gid = wgid / nig, fm = gid * WGM, gsz = (nM - fm) < WGM ? (nM - fm) : WGM;
        u.pm = fm + ((wgid % nig) % gsz); u.pn = (wgid % nig) / gsz; return true;
    }
};

template <class Epi>
__device__ __forceinline__ void gemm_phase(LAS unsigned char* lds, const Gemm g, const StaticOrder& S, const Epi& E, const int tid) {
    const int wid = __builtin_amdgcn_readfirstlane(tid >> 6), lane = tid & 63, wr = wid >> 2, wc = wid & 3, fr = lane & 15, fq = lane >> 4;
    const int K = g.K, nt = K / BK;
    unsigned voffA[2], voffB0[2], voffB1[2];
#pragma unroll
    for (int i = 0; i < 2; ++i) { int R, C; stage_rc(tid * 16 + i * 8192, R, C); const int Rp = 64 * (R >> 5) + 16 * ((R & 15) >> 2) + 4 * ((R >> 4) & 1) + (R & 3);
        voffA[i] = (unsigned)(R * K + C) * 2u; voffB0[i] = (unsigned)(Rp * K + C) * 2u; voffB1[i] = (unsigned)((Rp + 8) * K + C) * 2u; }
    const size_t kstep = (size_t)(BK * 2);
    const size_t hstep = (size_t)HALF * K * 2;
    const size_t tstep = 2 * hstep;
    const unsigned ldsw = (unsigned)wid * 1024u;
    const int aoff = lds_byte(wr * 64 + fr, fq * 8), boff = lds_byte(wc * 32 + fr, fq * 8);
#define PG8_SA(b, h) (((b) * 2 + (h)) * HTB)
#define PG8_SB(b, h) ((4 + (b) * 2 + (h)) * HTB)
#define PG8_STAGE(bufoff, gbase, voff) do { _Pragma("unroll") for (int _i = 0; _i < 2; ++_i) \
        __builtin_amdgcn_global_load_lds((const unsigned*)((const char*)(gbase) + (voff)[_i]), (LAS unsigned*)(lds + (bufoff) + ldsw + _i * 8192), 16, 0, 0); } while (0)
#define PG8_LDA(dst, b, h) do { _Pragma("unroll") for (int m = 0; m < 4; ++m) _Pragma("unroll") for (int k = 0; k < 2; ++k) dst[m][k] = *(const LAS bf16x8*)(lds + PG8_SA(b, h) + aoff + m * 2048 + k * 1024); } while (0)
#define PG8_LDB(dst, b, h) do { _Pragma("unroll") for (int n = 0; n < 2; ++n) _Pragma("unroll") for (int k = 0; k < 2; ++k) dst[n][k] = *(const LAS bf16x8*)(lds + PG8_SB(b, h) + boff + n * 2048 + k * 1024); } while (0)
#define PG8_MMA(ai, bj, At, Bt) do { __builtin_amdgcn_s_setprio(1); _Pragma("unroll") for (int m = 0; m < 4; ++m) _Pragma("unroll") for (int n = 0; n < 2; ++n) _Pragma("unroll") for (int k = 0; k < 2; ++k) \
        acc[ai][bj][m][n] = __builtin_amdgcn_mfma_f32_16x16x32_bf16(Bt[n][k], At[m][k], acc[ai][bj][m][n], 0, 0, 0); __builtin_amdgcn_s_setprio(0); } while (0)
#define PG8_WAIT_V(n) asm volatile("s_waitcnt vmcnt(" #n ")" ::: "memory")
#define PG8_WAIT_L(n) asm volatile("s_waitcnt lgkmcnt(" #n ")" ::: "memory")
#define PG8_BAR __builtin_amdgcn_s_barrier()
#define PG8_SCHED __builtin_amdgcn_sched_barrier(0)
    Unit cur, nxt; int ui = 0;
    if (!S.next(0, cur)) return;
    f32x4 acc[2][2][4][2];
#pragma unroll
    for (int a = 0; a < 2; ++a)
#pragma unroll
        for (int b = 0; b < 2; ++b)
#pragma unroll
            for (int m = 0; m < 4; ++m)
#pragma unroll
                for (int n = 0; n < 2; ++n) acc[a][b][m][n] = (f32x4){0.f, 0.f, 0.f, 0.f};
    bf16x8 At[4][2], B0[2][2], B1[2][2];
    const char* cA = (const char*)g.A + (size_t)cur.pm * tstep; const char* cB = (const char*)g.Bt + (size_t)cur.pn * tstep;
    PG8_STAGE(PG8_SB(0, 0), cB, voffB0); PG8_STAGE(PG8_SB(0, 1), cB, voffB1); PG8_STAGE(PG8_SA(0, 0), cA, voffA); PG8_STAGE(PG8_SA(0, 1), cA + hstep, voffA);
    if (wr == 1) PG8_BAR;
    PG8_WAIT_V(2); PG8_BAR;
    PG8_STAGE(PG8_SB(1, 0), cB + kstep, voffB0); PG8_STAGE(PG8_SA(1, 0), cA + kstep, voffA); PG8_STAGE(PG8_SB(1, 1), cB + kstep, voffB1);
    PG8_WAIT_V(6); PG8_BAR;
    for (;;) {
        const bool has_next = S.next(ui + 1, nxt);
        const char* nA = has_next ? (const char*)g.A + (size_t)nxt.pm * tstep : cA; const char* nB = has_next ? (const char*)g.Bt + (size_t)nxt.pn * tstep : cB;
        for (int t = 0; t < nt; t += 2) {
            const bool last = (t == nt - 2);
            const char* a1 = cA + (size_t)(t + 1) * kstep;
            const char* a2 = last ? nA : cA + (size_t)(t + 2) * kstep; const char* b2 = last ? nB : cB + (size_t)(t + 2) * kstep;
            const char* a3 = a2 + kstep; const char* b3 = b2 + kstep;
            PG8_LDB(B0, 0, 0); PG8_LDB(B1, 0, 1); PG8_SCHED; PG8_LDA(At, 0, 0); PG8_STAGE(PG8_SA(1, 1), a1 + hstep, voffA);
            PG8_WAIT_V(8); PG8_WAIT_L(0); PG8_BAR; PG8_MMA(0, 0, At, B0); PG8_MMA(0, 1, At, B1); PG8_BAR; PG8_SCHED;
            PG8_LDA(At, 0, 1); PG8_STAGE(PG8_SB(0, 0), b2, voffB0); PG8_STAGE(PG8_SB(0, 1), b2, voffB1); PG8_STAGE(PG8_SA(0, 0), a2, voffA);
            PG8_WAIT_V(8); PG8_WAIT_L(0); PG8_BAR; PG8_MMA(1, 0, At, B0); PG8_MMA(1, 1, At, B1); PG8_BAR; PG8_SCHED;
            PG8_LDB(B0, 1, 0); PG8_LDB(B1, 1, 1); PG8_SCHED; PG8_LDA(At, 1, 0); PG8_STAGE(PG8_SA(0, 1), a2 + hstep, voffA);
            PG8_WAIT_V(8); PG8_WAIT_L(0); PG8_BAR; PG8_MMA(0, 0, At, B0); PG8_MMA(0, 1, At, B1); PG8_BAR; PG8_SCHED;
            PG8_LDA(At, 1, 1); PG8_STAGE(PG8_SB(1, 0), b3, voffB0); PG8_STAGE(PG8_SB(1, 1), b3, voffB1); PG8_STAGE(PG8_SA(1, 0), a3, voffA);
            PG8_WAIT_V(8); PG8_WAIT_L(0); PG8_BAR; PG8_MMA(1, 0, At, B0); PG8_MMA(1, 1, At, B1); PG8_BAR; PG8_SCHED;
        }
        if (wr == 0) PG8_BAR;
        E(acc, cur, wr, wc, fr, fq);
        if (!has_next) break;
#pragma unroll
        for (int a = 0; a < 2; ++a)
#pragma unroll
            for (int b = 0; b < 2; ++b)
#pragma unroll
                for (int m = 0; m < 4; ++m)
#pragma unroll
                    for (int n = 0; n < 2; ++n) acc[a][b][m][n] = (f32x4){0.f, 0.f, 0.f, 0.f};
        cur = nxt; cA = nA; cB = nB; ++ui;
        if (wr == 1) PG8_BAR;
    }
    PG8_WAIT_V(0);
    PG8_BAR;
#undef PG8_SA
#undef PG8_SB
#undef PG8_STAGE
#undef PG8_LDA
#undef PG8_LDB
#undef PG8_MMA
#undef PG8_WAIT_V
#undef PG8_WAIT_L
#undef PG8_BAR
#undef PG8_SCHED
}

__device__ __forceinline__ void pair_xchg(const u32x4& own0, const u32x4& own1, bool lo, u32x4& d1, u32x4& d2) {
    u32x4 snd, rcv;
#pragma unroll
    for (int q = 0; q < 4; ++q) { snd[q] = lo ? own1[q] : own0[q]; rcv[q] = (unsigned)__builtin_amdgcn_mov_dpp((int)snd[q], 0x128, 0xf, 0xf, true); }
#pragma unroll
    for (int q = 0; q < 4; ++q) { d1[q] = lo ? own0[q] : rcv[q]; d2[q] = lo ? rcv[q] : own1[q]; }
}
__device__ __forceinline__ void pair_unxchg(const u32x4& l1, const u32x4& l2, bool lo, u32x4& own0, u32x4& own1) {
    u32x4 snd, rcv;
#pragma unroll
    for (int q = 0; q < 4; ++q) { snd[q] = lo ? l2[q] : l1[q]; rcv[q] = (unsigned)__builtin_amdgcn_mov_dpp((int)snd[q], 0x128, 0xf, 0xf, true); }
#pragma unroll
    for (int q = 0; q < 4; ++q) { own0[q] = lo ? l1[q] : rcv[q]; own1[q] = lo ? rcv[q] : l2[q]; }
}

template <int ACT  > struct EpiBf16 {
    static constexpr bool PERM = true;
    bf16_t* O; int ldc;
    __device__ __forceinline__ void operator()(const f32x4 (&acc)[2][2][4][2], const Unit& u, int wr, int wc, int fr, int fq) const {
        asm volatile("" : "+v"(fr), "+v"(fq));
        const bool lo = fr < 8;
        const int row0 = u.pm * BM + wr * 64 + (fr & 7), col0 = u.pn * BM + wc * 64 + 16 * fq + 8 * (fr >> 3);
#pragma unroll
        for (int ai = 0; ai < 2; ++ai)
#pragma unroll
            for (int m = 0; m < 4; ++m) { bf16_t* rowp = O + (size_t)(row0 + ai * HALF + m * 16) * ldc + col0; u32x4 own[2], d1, d2;
#pragma unroll
                for (int bj = 0; bj < 2; ++bj) { f32x4 v0 = acc[ai][bj][m][0], v1 = acc[ai][bj][m][1];
                    if (ACT == 1) {
#pragma unroll
                        for (int j = 0; j < 4; ++j) { v0[j] = gelu_tanh(v0[j]); v1[j] = gelu_tanh(v1[j]); } }
                    own[bj].x = pk_bf16(v0[0], v0[1]); own[bj].y = pk_bf16(v0[2], v0[3]); own[bj].z = pk_bf16(v1[0], v1[1]); own[bj].w = pk_bf16(v1[2], v1[3]); }
                pair_xchg(own[0], own[1], lo, d1, d2);
                *(u32x4*)rowp = d1; *(u32x4*)(rowp + (size_t)8 * ldc) = d2; }
    }
};
struct EpiRes {
    static constexpr bool PERM = true;
    const float* src_lat; const float* src_ctx; bf16_t* xs; const float* modL; int gate_idx; int src_f32;
    __device__ __forceinline__ void operator()(const f32x4 (&acc)[2][2][4][2], const Unit& u, int wr, int wc, int fr, int fq) const {
        asm volatile("" : "+v"(fr), "+v"(fq));
        const bool isctx = u.pm >= (TL / BM);
        const float* sb = isctx ? src_ctx + (size_t)(u.pm - TL / BM) * BM * D : src_lat + (size_t)u.pm * BM * D;
        const int mb = isctx ? NB : (u.pm >> 3);
        const float* gv = modL + (size_t)mb * 6144 + gate_idx * 1024;
        const bool lo = fr < 8;
        const int colo = u.pn * BM + wc * 64 + 16 * fq;
        const int rlx = wr * 64 + (fr & 7), colx = colo + 8 * (fr >> 3);
        f32x4 gt[4];
#pragma unroll
        for (int q = 0; q < 4; ++q) gt[q] = *(const f32x4*)(gv + colo + 4 * q);
#pragma unroll
        for (int ai = 0; ai < 2; ++ai)
#pragma unroll
            for (int m = 0; m < 4; ++m) { bf16_t* dp = xs + ((size_t)u.pm * BM + rlx + ai * HALF + m * 16) * D + colx; f32x4 x[4];
                if (src_f32) { const float* sp = sb + (size_t)(wr * 64 + fr + ai * HALF + m * 16) * D + colo;
#pragma unroll
                    for (int q = 0; q < 4; ++q) x[q] = *(const f32x4*)(sp + 4 * q); }
                else { const u32x4 l1 = *(const u32x4*)dp, l2 = *(const u32x4*)(dp + (size_t)8 * D); u32x4 o0, o1; pair_unxchg(l1, l2, lo, o0, o1);
                    x[0] = (f32x4){bf_lo(o0.x), bf_hi(o0.x), bf_lo(o0.y), bf_hi(o0.y)}; x[1] = (f32x4){bf_lo(o0.z), bf_hi(o0.z), bf_lo(o0.w), bf_hi(o0.w)};
                    x[2] = (f32x4){bf_lo(o1.x), bf_hi(o1.x), bf_lo(o1.y), bf_hi(o1.y)}; x[3] = (f32x4){bf_lo(o1.z), bf_hi(o1.z), bf_lo(o1.w), bf_hi(o1.w)}; }
                u32x4 own[2], d1, d2;
#pragma unroll
                for (int bj = 0; bj < 2; ++bj) { const f32x4 y0 = x[2 * bj] * DN_ALPHA + gt[2 * bj] * acc[ai][bj][m][0], y1 = x[2 * bj + 1] * DN_ALPHA + gt[2 * bj + 1] * acc[ai][bj][m][1];
                    own[bj].x = pk_bf16(y0[0], y0[1]); own[bj].y = pk_bf16(y0[2], y0[3]); own[bj].z = pk_bf16(y1[0], y1[1]); own[bj].w = pk_bf16(y1[2], y1[3]); }
                pair_xchg(own[0], own[1], lo, d1, d2);
                *(u32x4*)dp = d1; *(u32x4*)(dp + (size_t)8 * D) = d2; }
    }
};
struct EpiGlaProj {
    static constexpr bool PERM = true;
    bf16_t* QG; bf16_t* KG; bf16_t* VG; bf16_t* RG; float* GL;
    __device__ __forceinline__ void operator()(const f32x4 (&acc)[2][2][4][2], const Unit& u, int wr, int wc, int fr, int fq) const {
        asm volatile("" : "+v"(fr), "+v"(fq));
        const int pn = u.pn;
        if (pn < 12) {
            bf16_t* base; int ld, colt; float sc = 1.f;
            if (pn < 2) { base = QG; ld = 512; colt = pn * BM; sc = 0.08838834764831845f; }
            else if (pn < 4) { base = KG; ld = 512; colt = (pn - 2) * BM; }
            else if (pn < 8) { base = VG; ld = 1024; colt = (pn - 4) * BM; }
            else { base = RG; ld = 1024; colt = (pn - 8) * BM; }
            const bool lo = fr < 8;
            const int row0 = u.pm * BM + wr * 64 + (fr & 7), col0 = colt + wc * 64 + 16 * fq + 8 * (fr >> 3);
#pragma unroll
            for (int ai = 0; ai < 2; ++ai)
#pragma unroll
                for (int m = 0; m < 4; ++m) { bf16_t* rowp = base + (size_t)(row0 + ai * HALF + m * 16) * ld + col0; u32x4 own[2], d1, d2;
#pragma unroll
                    for (int bj = 0; bj < 2; ++bj) { const f32x4 v0 = acc[ai][bj][m][0] * sc, v1 = acc[ai][bj][m][1] * sc;
                        own[bj].x = pk_bf16(v0[0], v0[1]); own[bj].y = pk_bf16(v0[2], v0[3]); own[bj].z = pk_bf16(v1[0], v1[1]); own[bj].w = pk_bf16(v1[2], v1[3]); }
                    pair_xchg(own[0], own[1], lo, d1, d2);
                    *(u32x4*)rowp = d1; *(u32x4*)(rowp + (size_t)8 * ld) = d2; }
        } else if (wc == 0 && fq < 2) {
            const int row0 = u.pm * BM + wr * 64 + fr;
#pragma unroll
            for (int ai = 0; ai < 2; ++ai)
#pragma unroll
                for (int m = 0; m < 4; ++m) { float* gp = GL + (size_t)(row0 + ai * HALF + m * 16) * 32 + 16 * fq;
                    *(f32x4*)gp = acc[ai][0][m][0]; *(f32x4*)(gp + 4) = acc[ai][0][m][1]; *(f32x4*)(gp + 8) = acc[ai][1][m][0]; *(f32x4*)(gp + 12) = acc[ai][1][m][1]; }
        }
    }
};
}

struct Ctx {
    const Params* p; unsigned char* ws; unsigned char* smem; int tid, lane, wave, G, bid;
};

DI void quant_table_unit(const Ctx& c, int tab, int unit) {
    const Params& p = *c.p; unsigned char* ws = c.ws;
    const float* src = p.in[21 + tab]; unsigned char* dst = ws + (tab ? WS_VT : WS_UT); float* sc = (float*)(ws + WS_SU) + tab;
    float* red = (float*)(c.smem + LDS_BYTES - 96);
    f32x4 x[8][4]; float ss = 0.f;
#pragma unroll
    for (int i = 0; i < 8; ++i) { const float* rp = src + ((size_t)unit * 64 + c.wave * 8 + i) * 1024 + 16 * c.lane;
#pragma unroll
        for (int q = 0; q < 4; ++q) x[i][q] = __builtin_nontemporal_load((const f32x4*)(rp + 4 * q)); }
#pragma unroll
    for (int i = 0; i < 8; ++i)
#pragma unroll
        for (int q = 0; q < 4; ++q) ss += (x[i][q][0] * x[i][q][0] + x[i][q][1] * x[i][q][1]) + (x[i][q][2] * x[i][q][2] + x[i][q][3] * x[i][q][3]);
    ss = wave_sum(ss);
    lds_barrier();
    if (c.lane == 0) red[c.wave] = ss;
    lds_barrier();
    float tot = 0.f;
#pragma unroll
    for (int w8 = 0; w8 < 8; ++w8) tot += red[w8];
    const float rms = sqrtf(tot * (1.0f / 65536.0f)); const float stp = fmaxf(rms * (2.4f / 7.0f), 1e-30f), inv = 1.0f / stp;
    if (c.tid == 0) sc[2 * unit] = stp;
#pragma unroll
    for (int i = 0; i < 8; ++i) { const size_t row = (size_t)unit * 64 + c.wave * 8 + i; const size_t Lr = row >> 14, er = row & 16383; u32x2 w;
#pragma unroll
        for (int hq = 0; hq < 2; ++hq) { unsigned t = 0;
#pragma unroll
            for (int e = 0; e < 8; ++e) { const float v = x[i][2 * hq + (e >> 2)][e & 3] * inv; const int qi = (int)fminf(fmaxf(rintf(v), -8.0f), 7.0f); t |= ((unsigned)qi & 15u) << (4 * e); }
            w[hq] = t; }
        if (tab == 0) *(u32x2*)(dst + ((Lr * 4 + (c.lane >> 4)) * NEXP + er) * 128 + 8 * (c.lane & 15)) = w;
        else {
            const int m = c.lane & 15; unsigned char* rowp = dst + ((Lr * 4 + (c.lane >> 4)) * NEXP + er) * 128;
#pragma unroll
            for (int qs = 0; qs < 4; ++qs) { unsigned h16 = 0;
#pragma unroll
                for (int t4 = 0; t4 < 4; ++t4) { const int e = 4 * t4 + qs; h16 |= ((w[e >> 3] >> (4 * (e & 7))) & 15u) << (4 * t4); }
                const unsigned nb = (unsigned)__builtin_amdgcn_mov_dpp((int)h16, 0xB1, 0xf, 0xf, true);
                if ((m & 1) == 0) *(unsigned*)(rowp + 32 * qs + 2 * m) = h16 | (nb << 16); } } }
}
DI void quant_in_gemm_tail(const Ctx& c, int nwg, int tab, int Lq) {
    const int r = nwg % c.G, k0 = (r == 0) ? c.bid : c.bid - r, st = (r == 0) ? c.G : c.G - r;
    if (k0 < 0) return;
    for (int k = k0; k < 256; k += st) quant_table_unit(c, tab, Lq * 256 + k);
}

DI void phase_prologue(const Ctx& c) {
    const Params& p = *c.p; unsigned char* ws = c.ws;
    const int tid = c.tid;
    constexpr int N_MOD = 192, N_TR = 4736, N_WS = 64, N_TAB = 0;
    constexpr int N_ALL = N_MOD + N_TR + N_WS + N_TAB;
    constexpr int N_ITEMS = N_MOD + N_TAB + N_TR / 8 + N_WS / 8;
    unsigned* qctr = (unsigned*)(ws + WS_CTL + 32768);
    volatile LAS unsigned* qw = (volatile LAS unsigned*)((LAS unsigned char*)c.smem + (LDS_BYTES - 32));
    for (;;) {
        __syncthreads();
        if (tid == 0) *qw = __hip_atomic_fetch_add(qctr, 1u, __ATOMIC_RELAXED, __HIP_MEMORY_SCOPE_AGENT);
        __syncthreads();
        const int item = (int)*qw;
        if (item >= N_ITEMS) break;
        int ub, ue;
        if (item < N_MOD) { ub = item; ue = item + 1; }
        else if (item < N_MOD + N_TR / 8) { ub = N_MOD + 8 * (item - N_MOD); ue = ub + 8; }
        else if (item < N_MOD + N_TR / 8 + N_WS / 8) { ub = N_MOD + N_TR + 8 * (item - N_MOD - N_TR / 8); ue = ub + 8; }
        else { ub = N_MOD + N_TR + N_WS + (item - N_MOD - N_TR / 8 - N_WS / 8); ue = ub + 1; }
    for (int u = ub; u < ue; ++u) {
        if (u < N_MOD) {
            const int l = u / 48, n0 = (u % 48) * 128;
            float* sc = (float*)c.smem;
            float* red = (float*)(c.smem + 17 * 1024 * 4);
            __syncthreads();
#pragma unroll 1
            for (int hk = 0; hk < 2; ++hk) { const int k = hk * 512 + tid; float v[17];
#pragma unroll
                for (int b = 0; b < 17; ++b) v[b] = (b < NB) ? p.in[1][b * 1024 + k] : p.in[3][k];
#pragma unroll
                for (int b = 0; b < 17; ++b) sc[b * 1024 + k] = silu_f(v[b]); }
            __syncthreads();
            const int c4 = (tid & 31) * 4, kg = tid >> 5;
            float acc[17][4];
#pragma unroll
            for (int b = 0; b < 17; ++b) { acc[b][0] = 0.f; acc[b][1] = 0.f; acc[b][2] = 0.f; acc[b][3] = 0.f; }
            const float* wp = p.in[4] + ((size_t)l * 1024 + (size_t)kg * 64) * 6144 + n0 + c4;
#pragma unroll 4
            for (int kk = 0; kk < 64; ++kk) {
                const f32x4 w = *(const f32x4*)(wp + (size_t)kk * 6144);
                const int k = kg * 64 + kk;
#pragma unroll
                for (int b = 0; b < 17; ++b) { const float s = sc[b * 1024 + k]; acc[b][0] += s * w[0]; acc[b][1] += s * w[1]; acc[b][2] += s * w[2]; acc[b][3] += s * w[3]; }
            }
#pragma unroll
            for (int b = 0; b < 17; ++b)
#pragma unroll
                for (int j = 0; j < 4; ++j) acc[b][j] += __shfl_xor(acc[b][j], 32, 64);
            if ((tid & 32) == 0) {
#pragma unroll
                for (int b = 0; b < 17; ++b)
#pragma unroll
                    for (int j = 0; j < 4; ++j) red[(c.wave * 17 + b) * 128 + c4 + j] = acc[b][j];
            }
            __syncthreads();
            for (int o = tid; o < 17 * 128; o += NTHR) { const int b = o >> 7, n = o & 127; float s = 0.f;
#pragma unroll
                for (int w = 0; w < 8; ++w) s += red[(w * 17 + b) * 128 + n];
                ((float*)(ws + WS_MOD))[((size_t)l * 17 + b) * 6144 + n0 + n] = s + p.in[5][l * 6144 + n0 + n]; }
        } else if (u < N_MOD + N_TR) {
            int v = u - N_MOD; const float* src; bf16_t* dst; int N, Npad;
            if (v < 1024) { const int j = v / 512; v %= 512; src = p.in[8] + (size_t)j * 1024 * 2048; dst = (bf16_t*)(ws + WS_WAIN) + (size_t)j * 2048 * 1024; N = 2048; Npad = 2048; }
            else if (v < 1536) { v -= 1024; const int j = v / 256; v %= 256; src = p.in[13] + (size_t)j * 1024 * 1024; dst = (bf16_t*)(ws + WS_WAOUT) + (size_t)j * 1024 * 1024; N = 1024; Npad = 1024; }
            else if (v < 3200) { v -= 1536; const int j = v / 832; v %= 832; src = p.in[14] + (size_t)j * 1024 * 3104; dst = (bf16_t*)(ws + WS_WBIN) + (size_t)j * WBIN_N * 1024; N = 3104; Npad = WBIN_N; }
            else if (v < 3712) { v -= 3200; const int j = v / 256; v %= 256; src = p.in[18] + (size_t)j * 1024 * 1024; dst = (bf16_t*)(ws + WS_WBOUT) + (size_t)j * 1024 * 1024; N = 1024; Npad = 1024; }
            else { v -= 3712; const int j = v / 256; v %= 256; src = p.in[19] + (size_t)j * 1024 * 1024; dst = (bf16_t*)(ws + WS_WQ) + (size_t)j * 1024 * 1024; N = 1024; Npad = 1024; }
            (void)Npad;
            const int ntn = v >> 4, ktile = v & 15, n0 = ntn * 64, k0 = ktile * 64;
            float* tl = (float*)c.smem;
            __syncthreads();
#pragma unroll
            for (int i = 0; i < 2; ++i) { const int kk = (tid >> 4) + 32 * i, nn = (tid & 15) * 4;
                f32x4 x = {0.f, 0.f, 0.f, 0.f};
                if (n0 + nn < N) x = *(const f32x4*)(src + (size_t)(k0 + kk) * N + n0 + nn);
                tl[kk * 65 + nn] = x[0]; tl[kk * 65 + nn + 1] = x[1]; tl[kk * 65 + nn + 2] = x[2]; tl[kk * 65 + nn + 3] = x[3]; }
            __syncthreads();
            { const int nn = tid >> 3, kk8 = (tid & 7) * 8; float x[8];
#pragma unroll
              for (int j = 0; j < 8; ++j) x[j] = tl[(kk8 + j) * 65 + nn];
              u32x4 w; w.x = pk_bf16(x[0], x[1]); w.y = pk_bf16(x[2], x[3]); w.z = pk_bf16(x[4], x[5]); w.w = pk_bf16(x[6], x[7]);
              *(u32x4*)(dst + (size_t)(n0 + nn) * 1024 + k0 + kk8) = w; }
        } else if (u < N_MOD + N_TR + N_WS) {
            const int v = u - N_MOD - N_TR; const size_t e = (size_t)v * 4096 + (size_t)tid * 8;
            const f32x4 a = *(const f32x4*)(p.in[11] + e), b = *(const f32x4*)(p.in[11] + e + 4);
            u32x4 w; w.x = pk_bf16(a[0], a[1]); w.y = pk_bf16(a[2], a[3]); w.z = pk_bf16(b[0], b[1]); w.w = pk_bf16(b[2], b[3]);
            *(u32x4*)((bf16_t*)(ws + WS_WSB) + e) = w;
        } else {
            const int v = u - N_MOD - N_TR - N_WS; quant_table_unit(c, v >> 8, v & 255);
        }
    }
    }
}

DI void phase_mod0(const Ctx& c) {
    const Params& p = *c.p; const float* MOD = (const float*)(c.ws + WS_MOD); bf16_t* H1 = (bf16_t*)(c.ws + WS_H1);
    const int GW = c.G * NWAVE, npw = (T + GW - 1) / GW, r0 = (c.bid * NWAVE + c.wave) * npw; int nr = T - r0; nr = nr > npw ? npw : nr; nr = nr < 0 ? 0 : nr;
    int lz = c.lane; asm volatile("" : "+v"(lz));
    constexpr int PFD = 3;
    f32x4 pf[PFD][4], SH[4], S1[4];
#pragma unroll
    for (int qd = 0; qd < 4; ++qd) { SH[qd] = (f32x4){0.f, 0.f, 0.f, 0.f}; S1[qd] = SH[qd]; }
    int cur_mb = -1;
#define M0_LOAD(slot_, k_) do { const int kc_ = (k_) < nr ? (k_) : (nr > 0 ? nr - 1 : 0); const int rw_ = r0 + kc_ < T ? r0 + kc_ : 0; \
        const float* src_ = (rw_ < TL ? p.in[0] + (size_t)rw_ * D : p.in[2] + (size_t)(rw_ - TL) * D) + 16 * lz; \
        _Pragma("unroll") for (int qd = 0; qd < 4; ++qd) pf[slot_][qd] = *(const f32x4*)(src_ + 4 * qd); } while (0)
#pragma unroll
    for (int i = 0; i < PFD; ++i) M0_LOAD(i, i);
    for (int k3 = 0; k3 < nr; k3 += PFD) {
#pragma unroll
        for (int sl = 0; sl < PFD; ++sl) { const int k = k3 + sl;
            if (k < nr) { const int row = r0 + k; const int mb = mod_batch(row);
            if (mb != cur_mb) { cur_mb = mb; const float* m = MOD + (size_t)mb * 6144 + 16 * lz;
#pragma unroll
                for (int qd = 0; qd < 4; ++qd) { SH[qd] = *(const f32x4*)(m + 4 * qd); S1[qd] = *(const f32x4*)(m + 1024 + 4 * qd) + 1.0f; } }
            f32x4 x[4];
#pragma unroll
            for (int qd = 0; qd < 4; ++qd) x[qd] = pf[sl][qd];
            M0_LOAD(sl, k + PFD);
            float h[16];
#pragma unroll
            for (int qd = 0; qd < 4; ++qd)
#pragma unroll
                for (int e = 0; e < 4; ++e) h[4 * qd + e] = x[qd][e] * S1[qd][e] + SH[qd][e];
#pragma unroll
            for (int hf = 0; hf < 2; ++hf) { u32x4 w;
#pragma unroll
                for (int q = 0; q < 4; ++q) w[q] = pk_bf16(h[8 * hf + 2 * q], h[8 * hf + 2 * q + 1]);
                *(u32x4*)(H1 + (size_t)row * D + 16 * lz + 8 * hf) = w; }
            } }
    }
#undef M0_LOAD
}

DI void phase_vstats(const Ctx& c) {
    const bf16_t* UV = (const bf16_t*)(c.ws + WS_R1); float* ST = (float*)(c.ws + WS_STATS);
    const int stride = c.G * NWAVE, r0 = c.bid * NWAVE + c.wave, nr = (T - r0 + stride - 1) / stride;
    int lz = c.lane; asm volatile("" : "+v"(lz));
    constexpr int PFD = 4;
    u32x4 pf[PFD][2];
#define VS_LOAD(slot_, k_) do { const int kc_ = (k_) < nr ? (k_) : nr - 1; const bf16_t* vp_ = UV + (size_t)(r0 + stride * kc_) * 2048 + 1024 + 8 * lz; pf[slot_][0] = *(const u32x4*)vp_; pf[slot_][1] = *(const u32x4*)(vp_ + 512); } while (0)
    if (nr > 0) {
#pragma unroll
        for (int i = 0; i < PFD; ++i) VS_LOAD(i, i);
    }
    for (int k4 = 0; k4 < nr; k4 += PFD) {
#pragma unroll
        for (int sl = 0; sl < PFD; ++sl) { const int k = k4 + sl;
            if (k < nr) { const int row = r0 + stride * k;
            const u32x4 a = pf[sl][0], b = pf[sl][1];
            VS_LOAD(sl, k + PFD);
            float x[16];
#pragma unroll
            for (int j = 0; j < 4; ++j) { x[2 * j] = bf_lo(a[j]); x[2 * j + 1] = bf_hi(a[j]); x[8 + 2 * j] = bf_lo(b[j]); x[9 + 2 * j] = bf_hi(b[j]); }
            float s = 0.f;
#pragma unroll
            for (int j = 0; j < 16; ++j) s += x[j];
            const float mean = wave_sum(s) * (1.0f / 1024.0f);
            float q = 0.f;
#pragma unroll
            for (int j = 0; j < 16; ++j) { const float d = x[j] - mean; q += d * d; }
            const float var = wave_sum(q) * (1.0f / 1024.0f);
            if (lz == 0) { ST[2 * row] = mean; ST[2 * row + 1] = rsqrtf(var + LN_EPS); }
            } }
    }
#undef VS_LOAD
}

DI void phase_spatial(const Ctx& c, int j) {
    const Params& p = *c.p; unsigned char* ws = c.ws;
    const bf16_t* UV = (const bf16_t*)(ws + WS_R1); const float* ST = (const float*)(ws + WS_STATS); bf16_t* Y = (bf16_t*)(ws + WS_R2);
    const bf16_t* WSB = (const bf16_t*)(ws + WS_WSB) + (size_t)j * 8 * 128 * 128;
    const float* ng = p.in[9] + j * 1024; const float* nb = p.in[10] + j * 1024; const float* bs = p.in[12] + j * 8 * 128;
    constexpr int LD = 136;
    bf16_t* WsL = (bf16_t*)c.smem;
    bf16_t* VnT = WsL + 128 * LD;
    const int tid = c.tid, lane = c.lane, w = c.wave, g = lane >> 4, cc = lane & 15;
    for (int u = c.bid; u < (T / 128) * 8; u += c.G) {
        const int chunk = u >> 3, h = u & 7, r0 = chunk * 128;
        lds_barrier();
        { const int cg8 = tid & 15; float gg[8], bb[8];
#pragma unroll
          for (int e = 0; e < 8; ++e) { gg[e] = ng[h * 128 + cg8 * 8 + e]; bb[e] = nb[h * 128 + cg8 * 8 + e]; }
#pragma unroll
          for (int i = 0; i < 4; ++i) { const int idx = i * 512 + tid, tok = idx >> 4;
              const u32x4 v = *(const u32x4*)(UV + (size_t)(r0 + tok) * 2048 + 1024 + h * 128 + cg8 * 8);
              const float mean = ST[2 * (r0 + tok)], rstd = ST[2 * (r0 + tok) + 1];
              float x[8];
#pragma unroll
              for (int e = 0; e < 4; ++e) { x[2 * e] = bf_lo(v[e]); x[2 * e + 1] = bf_hi(v[e]); }
#pragma unroll
              for (int e = 0; e < 8; ++e) VnT[(32 * (cg8 >> 2) + 16 * (e >> 2) + 4 * (cg8 & 3) + (e & 3)) * LD + (tok ^ (8 * ((cg8 >> 1) & 7)))] = f2bf((x[e] - mean) * rstd * gg[e] + bb[e]);
              const int pp = idx >> 4;
              *(u32x4*)(WsL + pp * LD + cg8 * 8) = *(const u32x4*)(WSB + ((size_t)h * 128 + pp) * 128 + cg8 * 8); } }
        lds_barrier();
        f32x4 acc[8];
#pragma unroll
        for (int ct = 0; ct < 8; ++ct) acc[ct] = (f32x4){0.f, 0.f, 0.f, 0.f};
        { bf16x8 bfr[4], vfr[8][4];
#pragma unroll
          for (int ks = 0; ks < 4; ++ks) bfr[ks] = frag_ld(WsL, LD, 16 * w, 32 * ks, lane);
#pragma unroll
          for (int ct = 0; ct < 8; ++ct)
#pragma unroll
              for (int ks = 0; ks < 4; ++ks) { const int row = 16 * ct + (lane & 15); vfr[ct][ks] = *(const bf16x8*)(VnT + row * LD + (((4 * ks + (lane >> 4)) ^ ((2 * (row >> 5) + ((row >> 3) & 1)) & 7)) * 8)); }
          __builtin_amdgcn_sched_barrier(0);
#pragma unroll
          for (int ct = 0; ct < 8; ++ct)
#pragma unroll
              for (int ks = 0; ks < 4; ++ks) acc[ct] = mfma16(vfr[ct][ks], bfr[ks], acc[ct]); }
        const int pp = 16 * w + cc; const float bsv = bs[h * 128 + pp];
        const size_t rowo = (size_t)(r0 + pp);
        u32x4 uu[4];
#pragma unroll
        for (int a4 = 0; a4 < 4; ++a4) uu[a4] = *(const u32x4*)(UV + rowo * 2048 + h * 128 + 32 * a4 + 8 * g);
#pragma unroll
        for (int a4 = 0; a4 < 4; ++a4) { u32x4 o;
#pragma unroll
            for (int bq = 0; bq < 2; ++bq) { const f32x4 av = acc[2 * a4 + bq];
                o[2 * bq] = pk_bf16(bf_lo(uu[a4][2 * bq]) * (av[0] + bsv), bf_hi(uu[a4][2 * bq]) * (av[1] + bsv));
                o[2 * bq + 1] = pk_bf16(bf_lo(uu[a4][2 * bq + 1]) * (av[2] + bsv), bf_hi(uu[a4][2 * bq + 1]) * (av[3] + bsv)); }
            *(u32x4*)(Y + rowo * D + h * 128 + 32 * a4 + 8 * g) = o; }
    }
}

DI void phase_ln1(const Ctx& c, int L) {
    const Params& p = *c.p; unsigned char* ws = c.ws; bf16_t* XS = (bf16_t*)(ws + WS_XS); const float* MOD = (const float*)(ws + WS_MOD) + (size_t)L * 17 * 6144;
    bf16_t* H2 = (bf16_t*)(ws + WS_R2 + SZ_T1K);
    const float* lg = p.in[6] + (size_t)(L * 2 + 0) * D; const float* lb = p.in[7] + (size_t)(L * 2 + 0) * D;
    const int nrows = (L == DEPTH - 1) ? TL : T, GW = c.G * NWAVE, npw = (nrows + GW - 1) / GW;
    const int r0 = (c.bid * NWAVE + c.wave) * npw; int nr = nrows - r0; nr = nr > npw ? npw : nr; nr = nr < 0 ? 0 : nr;
    float* PL = (float*)c.smem;
    const int wg0 = c.bid * NWAVE * npw, wg1 = wg0 + NWAVE * npw - 1;
    const int mbA = mod_batch(wg0 < nrows ? wg0 : nrows - 1), mbB = mod_batch(wg1 < nrows ? wg1 : nrows - 1);
    __syncthreads();
    { const float* mA = MOD + (size_t)mbA * 6144; const float* mB = MOD + (size_t)mbB * 6144;
      int tz = c.tid & 255; asm volatile("" : "+v"(tz)); const int col = tz * 4, whi = c.wave >> 2;
#pragma unroll
      for (int i = 0; i < 3; ++i) { const int r = 2 * i + whi;
          const float* src = r == 0 ? lg : r == 1 ? lb : r == 2 ? mA + 3 * 1024 : r == 3 ? mA + 4 * 1024 : r == 4 ? mB + 3 * 1024 : mB + 4 * 1024;
          f32x4 v = *(const f32x4*)(src + col); if (r == 3 || r == 5) v = v + 1.0f;
          *(f32x4*)(PL + r * 1024 + (2 * (col >> 9) + ((col >> 2) & 1)) * 256 + ((col & 511) >> 3) * 4) = v; } }
    __syncthreads();
    constexpr int PFD = 4;
    int lz = c.lane; asm volatile("" : "+v"(lz));
    u32x4 pf[PFD][2];
#define L1_LOAD(slot_, k_) do { const int kc_ = (k_) < nr ? (k_) : (nr > 0 ? nr - 1 : 0); const size_t ro_ = (size_t)(r0 + kc_ < nrows ? r0 + kc_ : 0) * D + 8 * lz; \
        pf[slot_][0] = *(const u32x4*)(XS + ro_); pf[slot_][1] = *(const u32x4*)(XS + ro_ + 512); } while (0)
#pragma unroll
    for (int i = 0; i < PFD; ++i) L1_LOAD(i, i);
    for (int k4 = 0; k4 < nr; k4 += PFD) {
#pragma unroll
        for (int sl = 0; sl < PFD; ++sl) { const int k = k4 + sl;
            if (k < nr) { const int row = r0 + k; bf16_t* xp = XS + (size_t)row * D + 8 * lz;
            const float* pm = PL + (mod_batch(row) == mbA ? 2 : 4) * 1024 + 4 * lz;
            const u32x4 v0 = pf[sl][0], v1 = pf[sl][1];
            L1_LOAD(sl, k + PFD);
            float x[16]; float s = 0.f;
#pragma unroll
            for (int q = 0; q < 4; ++q) { x[2 * q] = bf_lo(v0[q]); x[2 * q + 1] = bf_hi(v0[q]); x[8 + 2 * q] = bf_lo(v1[q]); x[9 + 2 * q] = bf_hi(v1[q]); }
#pragma unroll
            for (int e = 0; e < 16; ++e) s += x[e];
            const float mean = wave_sum(s) * (1.0f / 1024.0f);
            float q2 = 0.f;
#pragma unroll
            for (int e = 0; e < 16; ++e) { const float d = x[e] - mean; q2 += d * d; }
            const float rstd = rsqrtf(wave_sum(q2) * (1.0f / 1024.0f) + LN_EPS);
            float y[16], h[16]; float am = 0.f;
#pragma unroll
            for (int qd = 0; qd < 4; ++qd) { const f32x4 gg = *(const f32x4*)(PL + qd * 256 + 4 * lz), bb = *(const f32x4*)(PL + 1024 + qd * 256 + 4 * lz), sh2 = *(const f32x4*)(pm + qd * 256), s2 = *(const f32x4*)(pm + 1024 + qd * 256);
#pragma unroll
                for (int e = 0; e < 4; ++e) { const float yy = (x[4 * qd + e] - mean) * rstd * gg[e] + bb[e]; y[4 * qd + e] = yy; const float hh = yy * s2[e] + sh2[e]; h[4 * qd + e] = hh; am += hh * hh; } }
            const float sx = fmaxf(sqrtf(wave_sum(am) * (1.0f / 1024.0f)) * (2.4f / 7.0f), 1e-30f), isx = 1.0f / sx;
            u32x2 th = {0u, 0u};
#pragma unroll
            for (int e = 0; e < 16; ++e) { const int xh = (int)fminf(fmaxf(rintf(h[e] * isx), -8.0f), 7.0f); th[e >> 3] |= ((unsigned)xh & 15u) << (4 * (e & 7)); }
#pragma unroll
            for (int hf = 0; hf < 2; ++hf) { u32x4 wx, wh;
#pragma unroll
                for (int q = 0; q < 4; ++q) { wx[q] = pk_bf16(y[8 * hf + 2 * q], y[8 * hf + 2 * q + 1]); wh[q] = pk_bf16(h[8 * hf + 2 * q], h[8 * hf + 2 * q + 1]); }
                *(u32x4*)(xp + 512 * hf) = wx; *(u32x4*)(H2 + (size_t)row * D + 8 * lz + 512 * hf) = wh; }
#pragma unroll
            for (int hf = 0; hf < 2; ++hf) *(unsigned*)(ws + WS_XH + (size_t)row * 512 + 256 * hf + 4 * lz) = th[hf];
            if (lz == 0) ((float*)(ws + WS_SX))[row] = sx;
            } }
    }
#undef L1_LOAD
}

DI int f2key(float v) { const int i = __float_as_int(v); return i ^ ((i >> 31) & 0x7fffffff); }
DI float key2f(int k) { return __int_as_float(k ^ ((k >> 31) & 0x7fffffff)); }
DI void phase_route(const Ctx& c, int L) {
    const Params& p = *c.p; unsigned char* ws = c.ws; const int lane = c.lane, g = lane >> 4, cc = lane & 15;
    constexpr int LDK = 72, LDS_S = 20;
    bf16_t* keysHi = (bf16_t*)c.smem;
    bf16_t* keysLo = keysHi + 2 * 128 * LDK;
    float* sbase = (float*)(keysLo + 2 * 128 * LDK);
    unsigned* ilist = (unsigned*)(sbase + NWAVE * 64 * LDS_S);
    __syncthreads();
    { const float* gk = p.in[20] + (size_t)L * 2 * 128 * 64;
      f32x4 kv[8];
#pragma unroll
      for (int it = 0; it < 8; ++it) kv[it] = ((const f32x4*)gk)[it * NTHR + c.tid];
#pragma unroll
      for (int it = 0; it < 8; ++it) { const int i = (it * NTHR + c.tid) * 4, row = i >> 6, d = i & 63; unsigned hi[2], lo[2];
#pragma unroll
          for (int e = 0; e < 2; ++e) { const unsigned ph = pk_bf16(kv[it][2 * e], kv[it][2 * e + 1]); hi[e] = ph; lo[e] = pk_bf16(kv[it][2 * e] - bf_lo(ph), kv[it][2 * e + 1] - bf_hi(ph)); }
          *(u32x2*)(keysHi + row * LDK + d) = (u32x2){hi[0], hi[1]}; *(u32x2*)(keysLo + row * LDK + d) = (u32x2){lo[0], lo[1]}; } }
    __syncthreads();
    float* S = sbase + c.wave * 64 * LDS_S;
    const bf16_t* QP = (const bf16_t*)(ws + WS_R1); unsigned short* IDX = (unsigned short*)(ws + WS_R1 + SZ_T1K); float* WT = (float*)(ws + WS_R1 + SZ_T1K + (size_t)T * 128 * 4);
    unsigned* myl = ilist + c.tid * 8; const unsigned char* mylb = (const unsigned char*)myl;
    const int ntask = (((L == DEPTH - 1) ? TL : T) / 64) * 8;
    for (int task = c.wave * c.G + c.bid; task < ntask; task += c.G * NWAVE) {
        const int t0 = (task >> 3) * 64, h = task & 7, tok = t0 + lane;
        float t12[2][16];
#pragma unroll
        for (int half = 0; half < 2; ++half) {
            bf16x8 aq[4][2];
#pragma unroll
            for (int mt = 0; mt < 4; ++mt)
#pragma unroll
                for (int ks = 0; ks < 2; ++ks) aq[mt][ks] = *(const bf16x8*)(QP + (size_t)(t0 + 16 * mt + cc) * D + h * 128 + half * 64 + 32 * ks + 8 * g);
            const bf16_t* kh = keysHi + half * 128 * LDK; const bf16_t* kl = keysLo + half * 128 * LDK;
#pragma unroll
            for (int i = 0; i < 16; ++i) t12[half][i] = -3.0e38f;
            for (int nt = 0; nt < 8; ++nt) {
                const bf16x8 bh0 = frag_ld(kh, LDK, 16 * nt, 0, lane), bh1 = frag_ld(kh, LDK, 16 * nt, 32, lane), bl0 = frag_ld(kl, LDK, 16 * nt, 0, lane), bl1 = frag_ld(kl, LDK, 16 * nt, 32, lane);
#pragma unroll
                for (int mt = 0; mt < 4; ++mt) { f32x4 a = {0.f, 0.f, 0.f, 0.f};
                    a = mfma16(aq[mt][0], bl0, a); a = mfma16(aq[mt][1], bl1, a); a = mfma16(aq[mt][0], bh0, a); a = mfma16(aq[mt][1], bh1, a);
#pragma unroll
                    for (int r = 0; r < 4; ++r) S[(16 * mt + 4 * g + r) * LDS_S + cc] = a[r]; }
                f32x4 sc[4];
#pragma unroll
                for (int q4 = 0; q4 < 4; ++q4) sc[q4] = *(const f32x4*)(S + lane * LDS_S + 4 * q4);
                float kx[16];
#pragma unroll
                for (int kk = 0; kk < 16; ++kk) kx[kk] = __int_as_float((__float_as_int(sc[kk >> 2][kk & 3]) & ~127) | (127 - (16 * nt + kk)));
#define RT_CE(a_, b_) do { const float hi_ = __builtin_amdgcn_fmed3f(a_, b_, 3.0e38f), lo_ = __builtin_amdgcn_fmed3f(a_, b_, -3.0e38f); a_ = hi_; b_ = lo_; } while (0)
#define K_ kx
                RT_CE(K_[0], K_[1]); RT_CE(K_[2], K_[3]); RT_CE(K_[0], K_[2]); RT_CE(K_[1], K_[3]); RT_CE(K_[1], K_[2]); RT_CE(K_[4], K_[5]); RT_CE(K_[6], K_[7]); RT_CE(K_[4], K_[6]); RT_CE(K_[5], K_[7]); RT_CE(K_[5], K_[6]); RT_CE(K_[0], K_[4]); RT_CE(K_[2], K_[6]); RT_CE(K_[2], K_[4]); RT_CE(K_[1], K_[5]); RT_CE(K_[3], K_[7]); RT_CE(K_[3], K_[5]); RT_CE(K_[1], K_[2]); RT_CE(K_[3], K_[4]); RT_CE(K_[5], K_[6]); RT_CE(K_[8], K_[9]); RT_CE(K_[10], K_[11]); RT_CE(K_[8], K_[10]); RT_CE(K_[9], K_[11]); RT_CE(K_[9], K_[10]); RT_CE(K_[12], K_[13]); RT_CE(K_[14], K_[15]); RT_CE(K_[12], K_[14]); RT_CE(K_[13], K_[15]); RT_CE(K_[13], K_[14]); RT_CE(K_[8], K_[12]); RT_CE(K_[10], K_[14]); RT_CE(K_[10], K_[12]); RT_CE(K_[9], K_[13]); RT_CE(K_[11], K_[15]); RT_CE(K_[11], K_[13]); RT_CE(K_[9], K_[10]); RT_CE(K_[11], K_[12]); RT_CE(K_[13], K_[14]); RT_CE(K_[0], K_[8]); RT_CE(K_[4], K_[12]); RT_CE(K_[4], K_[8]); RT_CE(K_[2], K_[10]); RT_CE(K_[6], K_[14]); RT_CE(K_[6], K_[10]); RT_CE(K_[2], K_[4]); RT_CE(K_[6], K_[8]); RT_CE(K_[10], K_[12]); RT_CE(K_[1], K_[9]); RT_CE(K_[5], K_[13]); RT_CE(K_[5], K_[9]); RT_CE(K_[3], K_[11]); RT_CE(K_[7], K_[15]); RT_CE(K_[7], K_[11]); RT_CE(K_[3], K_[5]); RT_CE(K_[7], K_[9]); RT_CE(K_[11], K_[13]); RT_CE(K_[1], K_[2]); RT_CE(K_[3], K_[4]); RT_CE(K_[5], K_[6]); RT_CE(K_[7], K_[8]); RT_CE(K_[9], K_[10]); RT_CE(K_[11], K_[12]); RT_CE(K_[13], K_[14]);
#undef K_
                if (nt == 0) {
#pragma unroll
                    for (int i = 0; i < 16; ++i) t12[half][i] = kx[i];
                } else {
#pragma unroll
                    for (int i = 0; i < 16; ++i) t12[half][i] = __builtin_amdgcn_fmed3f(t12[half][i], kx[15 - i], 3.0e38f);
#define T_ t12[half]
                    RT_CE(T_[0], T_[8]); RT_CE(T_[1], T_[9]); RT_CE(T_[2], T_[10]); RT_CE(T_[3], T_[11]); RT_CE(T_[4], T_[12]); RT_CE(T_[5], T_[13]); RT_CE(T_[6], T_[14]); RT_CE(T_[7], T_[15]); RT_CE(T_[0], T_[4]); RT_CE(T_[1], T_[5]); RT_CE(T_[2], T_[6]); RT_CE(T_[3], T_[7]); RT_CE(T_[8], T_[12]); RT_CE(T_[9], T_[13]); RT_CE(T_[10], T_[14]); RT_CE(T_[11], T_[15]); RT_CE(T_[0], T_[2]); RT_CE(T_[1], T_[3]); RT_CE(T_[4], T_[6]); RT_CE(T_[5], T_[7]); RT_CE(T_[8], T_[10]); RT_CE(T_[9], T_[11]); RT_CE(T_[12], T_[14]); RT_CE(T_[13], T_[15]); RT_CE(T_[0], T_[1]); RT_CE(T_[2], T_[3]); RT_CE(T_[4], T_[5]); RT_CE(T_[6], T_[7]); RT_CE(T_[8], T_[9]); RT_CE(T_[10], T_[11]); RT_CE(T_[12], T_[13]); RT_CE(T_[14], T_[15]);
#undef T_
                }
#undef RT_CE
            }
        }
        float v1[16], v2[16];
#pragma unroll
        for (int i = 0; i < 16; ++i) { v1[i] = __int_as_float(__float_as_int(t12[0][i]) & ~127); v2[i] = __int_as_float(__float_as_int(t12[1][i]) & ~127); }
#pragma unroll
        for (int i = 0; i < 4; ++i) {
            myl[i] = (unsigned)(127 - (__float_as_int(t12[0][4 * i]) & 127)) | ((unsigned)(127 - (__float_as_int(t12[0][4 * i + 1]) & 127)) << 8) | ((unsigned)(127 - (__float_as_int(t12[0][4 * i + 2]) & 127)) << 16) | ((unsigned)(127 - (__float_as_int(t12[0][4 * i + 3]) & 127)) << 24);
            myl[4 + i] = (unsigned)(127 - (__float_as_int(t12[1][4 * i]) & 127)) | ((unsigned)(127 - (__float_as_int(t12[1][4 * i + 1]) & 127)) << 8) | ((unsigned)(127 - (__float_as_int(t12[1][4 * i + 2]) & 127)) << 16) | ((unsigned)(127 - (__float_as_int(t12[1][4 * i + 3]) & 127)) << 24); }
        float f[16];
#pragma unroll
        for (int i = 0; i < 16; ++i) f[i] = -3.0e38f;
#pragma unroll
        for (int a = 0; a < 16; ++a)
#pragma unroll
            for (int b = 0; b < 16; ++b)
                if ((a + 1) * (b + 1) <= 16) {
                    const float key = __int_as_float((__float_as_int(v1[a] + v2[b]) & ~255) | (255 - (a * 16 + b)));
#pragma unroll
                    for (int i = 15; i >= 1; --i) f[i] = __builtin_amdgcn_fmed3f(key, f[i - 1], f[i]);
                    f[0] = __builtin_amdgcn_fmed3f(key, 3.0e38f, f[0]);
                }
        float e[16], se = 0.f; int fi[16];
        const float vmax = __int_as_float(__float_as_int(f[0]) & ~255);
#pragma unroll
        for (int i = 0; i < 16; ++i) { const int code = 255 - (__float_as_int(f[i]) & 255); fi[i] = (int)mylb[code >> 4] * 128 + (int)mylb[16 + (code & 15)];
            e[i] = __expf(__int_as_float(__float_as_int(f[i]) & ~255) - vmax); se += e[i]; }
        const float inv = 1.0f / se;
        unsigned short* ip = IDX + ((size_t)h * T + tok) * 16; float* wp = WT + ((size_t)h * T + tok) * 16;
#pragma unroll
        for (int i = 0; i < 16; i += 8) *(u32x4*)(ip + i) = (u32x4){(unsigned)fi[i] | ((unsigned)fi[i + 1] << 16), (unsigned)fi[i + 2] | ((unsigned)fi[i + 3] << 16), (unsigned)fi[i + 4] | ((unsigned)fi[i + 5] << 16), (unsigned)fi[i + 6] | ((unsigned)fi[i + 7] << 16)};
#pragma unroll
        for (int i = 0; i < 16; i += 4) *(f32x4*)(wp + i) = (f32x4){e[i] * inv, e[i + 1] * inv, e[i + 2] * inv, e[i + 3] * inv};
    }
}

DI float red8(float p) { p += dpp_mov<0xB1>(p); p += dpp_mov<0x4E>(p); p += dpp_mov<0x141>(p); return p; }
DI void phase_experts(const Ctx& c, int L) {
    const Params& p = *c.p; unsigned char* ws = c.ws; const int lane = c.lane, g8 = lane >> 3, j = lane & 7;
    constexpr int MAXTOK = 18;
    const bf16_t* H2 = (const bf16_t*)(ws + WS_R2 + SZ_T1K);
    const unsigned short* IDX = (const unsigned short*)(ws + WS_R1 + SZ_T1K); const float* WT = (const float*)(ws + WS_R1 + SZ_T1K + (size_t)T * 128 * 4);
    const unsigned hoff0 = (unsigned)(lane >> 4) * (T * 16) + (lane & 15), hoff1 = hoff0 + 4u * T * 16;
    const unsigned char* UT = ws + WS_UT + (size_t)L * NEXP * 512; const unsigned char* VT = ws + WS_VT + (size_t)L * NEXP * 512;
    float* SUVL = (float*)(c.smem + NWAVE * MAXTOK * 128 * 6 + NWAVE * MAXTOK * 128 + NWAVE * 128);
    bf16_t* XS = (bf16_t*)(ws + WS_XS); bf16_t* H1 = (bf16_t*)(ws + WS_H1);
    const float* MOD = (const float*)(ws + WS_MOD) + (size_t)L * 17 * 6144;
    const float* lg = p.in[6] + (size_t)(L * 2 + 1) * D; const float* lb = p.in[7] + (size_t)(L * 2 + 1) * D;
    const int nrows = (L == DEPTH - 1) ? TL : T;
    float* ZL = (float*)c.smem + c.wave * MAXTOK * 128;
    unsigned short* IL = (unsigned short*)(c.smem + NWAVE * MAXTOK * 128 * 4) + c.wave * MAXTOK * 128;
    u32x4* ADL = (u32x4*)(c.smem + NWAVE * MAXTOK * 128 * 6) + c.wave * MAXTOK * 8;
    float* SAL = (float*)(c.smem + NWAVE * MAXTOK * 128 * 6 + NWAVE * MAXTOK * 128) + c.wave * 32;
    const int GW = c.G * NWAVE, gw = c.bid * NWAVE + c.wave;
    unsigned c128 = 128u; asm volatile("" : "+s"(c128));
    const int tsrc = 8 * (lane & 7) + (lane >> 3);
    const int npw = (nrows + GW - 1) / GW;
    for (int b0 = 0; b0 < npw; b0 += MAXTOK) {
        const int tok0 = gw * npw + b0; constexpr int tstr = 1;
        SUVL[c.tid] = ((const float*)(ws + WS_SU))[(size_t)L * 512 + c.tid];
        lds_barrier();
        int ntok = npw - b0; ntok = ntok > MAXTOK ? MAXTOK : ntok; ntok = ntok > nrows - tok0 ? nrows - tok0 : ntok; ntok = ntok < 0 ? 0 : ntok;
        const int klast = ntok > 0 ? ntok - 1 : 0;
        if (ntok > 0) {
            for (int k0 = 0; k0 < MAXTOK; k0 += 18) { int iv[18][2];
#pragma unroll
                for (int kk = 0; kk < 18; ++kk) { const int kc = (k0 + kk < ntok) ? k0 + kk : klast; const unsigned tb = (unsigned)(tok0 + tstr * kc) * 16u; iv[kk][0] = IDX[tb + hoff0]; iv[kk][1] = IDX[tb + hoff1]; }
#pragma unroll
                for (int kk = 0; kk < 18; ++kk) { IL[(k0 + kk) * 128 + tsrc] = (unsigned short)iv[kk][0]; IL[(k0 + kk) * 128 + 64 + tsrc] = (unsigned short)iv[kk][1]; } }
        }
        for (int c4 = 0; c4 < 4; ++c4) {
            const unsigned char* Ub = UT + (size_t)c4 * NEXP * 128; const unsigned j16 = 16u * (unsigned)j;
            const unsigned char* XHb = ws + WS_XH + 128 * c4 + 16 * j;
            u32x4 rA[8], rB[8], xh, nxh; const bool jb0 = (j & 1) != 0, jb1 = (j & 2) != 0, jb2 = (j & 4) != 0;
#define U_LOADX(k_) do { const size_t to_ = (size_t)(tok0 + tstr * (k_)) * 512; nxh = *(const u32x4*)(XHb + to_); } while (0)
#define U_ISSUE(R, k_, hf_) do { const u32x4 ev_ = *(const u32x4*)(IL + (k_) * 128 + 64 * (hf_) + 8 * g8); unsigned o_[8]; \
                _Pragma("unroll") for (int m = 0; m < 4; ++m) { asm("v_mad_u32_u16 %0, %1, %2, %3" : "=v"(o_[2 * m]) : "v"(ev_[m]), "s"(c128), "v"(j16)); asm("v_mad_u32_u16 %0, %1, %2, %3 op_sel:[1,0,0,0]" : "=v"(o_[2 * m + 1]) : "v"(ev_[m]), "s"(c128), "v"(j16)); } \
                _Pragma("unroll") for (int i = 0; i < 8; ++i) R[i] = *(const u32x4*)(Ub + o_[i]); } while (0)
#define U_COMPUTE(R, k_, hf_) do { int zv[8]; \
                _Pragma("unroll") for (int i = 0; i < 8; ++i) { int ah; \
                    asm("v_dot8_i32_i4 %0, %1, %2, 0" : "=v"(ah) : "v"(R[i][0]), "v"(xh[0]));     \
                    _Pragma("unroll") for (int q = 1; q < 4; ++q) ah = __builtin_amdgcn_sdot8((int)R[i][q], (int)xh[q], ah, false); \
                    zv[i] = ah; } \
                  \
                int w4_[4], w2_[2], ra; \
                _Pragma("unroll") for (int t = 0; t < 4; ++t) { const int snd_ = jb2 ? zv[t] : zv[4 + t], kp_ = jb2 ? zv[4 + t] : zv[t]; w4_[t] = kp_ + __builtin_amdgcn_mov_dpp(snd_, 0x141, 0xf, 0xf, true); } \
                _Pragma("unroll") for (int t = 0; t < 2; ++t) { const int snd_ = jb0 ? w4_[2 * t] : w4_[2 * t + 1], kp_ = jb0 ? w4_[2 * t + 1] : w4_[2 * t]; w2_[t] = kp_ + __builtin_amdgcn_mov_dpp(snd_, 0xB1, 0xf, 0xf, true); } \
                { const int snd_ = jb1 ? w2_[0] : w2_[1], kp_ = jb1 ? w2_[1] : w2_[0]; ra = kp_ + __builtin_amdgcn_mov_dpp(snd_, 0x4E, 0xf, 0xf, true); } \
                const float za = (float)__shfl(ra, tsrc, 64); \
                if (c4 == 0) ZL[(k_) * 128 + 64 * (hf_) + lane] = za; else ZL[(k_) * 128 + 64 * (hf_) + lane] += za; } while (0)
            if (ntok > 0) { U_LOADX(0); U_ISSUE(rA, 0, 0); }
            for (int k = 0; k < ntok; ++k) {
                const int kn = (k + 1 < ntok) ? k + 1 : k;
                U_ISSUE(rB, k, 1);
                xh = nxh;
                U_COMPUTE(rA, k, 0);
                U_LOADX(kn); U_ISSUE(rA, kn, 0);
                U_COMPUTE(rB, k, 1);
            }
#undef U_LOADX
#undef U_ISSUE
#undef U_COMPUTE
        }
        if (ntok > 0) {
            unsigned char* adlw = (unsigned char*)ADL + (g8 >> 1) * 16 + (g8 & 1) * 8;
            for (int k0 = 0; k0 < MAXTOK; k0 += 9) { float wv[9][2], su[9][2], sxv[9];
#pragma unroll
                for (int kk = 0; kk < 9; ++kk) { const int kc = (k0 + kk < ntok) ? k0 + kk : klast; const unsigned tb = (unsigned)(tok0 + tstr * kc) * 16u; sxv[kk] = ((const float*)(ws + WS_SX))[tok0 + tstr * kc];
#pragma unroll
                    for (int hh = 0; hh < 2; ++hh) { const unsigned e = IL[kc * 128 + 64 * hh + tsrc]; const f32x2 s2_ = *(const f32x2*)(SUVL + 2 * (e >> 6)); wv[kk][hh] = WT[tb + (hh ? hoff1 : hoff0)] * s2_[1]; su[kk][hh] = s2_[0]; } }
#pragma unroll
                for (int kk = 0; kk < 9; ++kk) { const int kc = (k0 + kk < ntok) ? k0 + kk : klast;
                    if (k0 + kk < ntok) {
                        float a_[2];
#pragma unroll
                        for (int hh = 0; hh < 2; ++hh) a_[hh] = gelu_tanh(ZL[kc * 128 + 64 * hh + lane] * (su[kk][hh] * sxv[kk])) * wv[kk][hh];
                        const float am = wave_max(fmaxf(fabsf(a_[0]), fabsf(a_[1])));
                        const bool nz = am > 1.2e-13f;
                        const float inv = nz ? 119.0f / am : 0.f;
                        if (lane == 0) SAL[kc] = nz ? am * (1.0f / 119.0f) : 0.f;
                        unsigned d_[4];
#pragma unroll
                        for (int hf = 0; hf < 2; ++hf) { const int a8 = (int)rintf(a_[hf] * inv); const int xl = ((a8 + 8) & 15) - 8; const int xh = (a8 - xl) >> 4;
                            d_[2 * hf] = ((unsigned)xh & 15u) << (4 * j); d_[2 * hf + 1] = ((unsigned)xl & 15u) << (4 * j); }
#pragma unroll
                        for (int q = 0; q < 4; ++q) { int t = (int)d_[q]; t += __builtin_amdgcn_mov_dpp(t, 0xB1, 0xf, 0xf, true); t += __builtin_amdgcn_mov_dpp(t, 0x4E, 0xf, 0xf, true); t += __builtin_amdgcn_mov_dpp(t, 0x141, 0xf, 0xf, true); d_[q] = (unsigned)t; }
                        if (j == 0) {
#pragma unroll
                            for (int hf = 0; hf < 2; ++hf) *(u32x2*)(adlw + (size_t)k0 * 128 + (kk * 2 + hf) * 64) = (u32x2){d_[2 * hf], d_[2 * hf + 1]}; } } } }
        }
        {
            constexpr int VLD = 144;
            unsigned char* VTL = (unsigned char*)ZL;
            const int vq = lane & 15, vG = lane >> 4;
            const unsigned char* trb = VTL + vq * VLD + 8 * vG;
            unsigned char* wrb = VTL + g8 * VLD + 16 * j;
        u32x4 rA[8], rB[8];
        const unsigned j16 = 16u * (unsigned)j;
#define V_ISSUE(R, VB_, k_, hf_) do { const u32x4 ev_ = *(const u32x4*)(IL + (k_) * 128 + 64 * (hf_) + 8 * g8); unsigned o_[8]; \
                _Pragma("unroll") for (int m = 0; m < 4; ++m) { asm("v_mad_u32_u16 %0, %1, %2, %3" : "=v"(o_[2 * m]) : "v"(ev_[m]), "s"(c128), "v"(j16)); asm("v_mad_u32_u16 %0, %1, %2, %3 op_sel:[1,0,0,0]" : "=v"(o_[2 * m + 1]) : "v"(ev_[m]), "s"(c128), "v"(j16)); } \
                _Pragma("unroll") for (int i = 0; i < 8; ++i) R[i] = *(const u32x4*)((VB_) + o_[i]); } while (0)
#define V_ACC(R, k_, hf_) do { \
                _Pragma("unroll") for (int i = 0; i < 8; ++i) *(u32x4*)(wrb + (8 * i) * VLD) = R[i]; \
                asm volatile("" ::: "memory"); \
                u32x4 dg[4]; v2i32 tt[4][4]; \
                _Pragma("unroll") for (int eb = 0; eb < 4; ++eb) { dg[eb] = *(const u32x4*)((const unsigned char*)ADL + (((k_) * 2 + (hf_)) * 4 + eb) * 16); \
                    _Pragma("unroll") for (int qs = 0; qs < 4; ++qs) tt[eb][qs] = __builtin_amdgcn_ds_read_tr4_b64_v2i32((LAS v2i32*)(trb + (16 * eb) * VLD + 32 * qs)); } \
                __builtin_amdgcn_sched_barrier(0);     \
                _Pragma("unroll") for (int eb = 0; eb < 4; ++eb) _Pragma("unroll") for (int qs = 0; qs < 4; ++qs) { \
                        ah4[qs] = __builtin_amdgcn_sdot8(tt[eb][qs][0], (int)dg[eb][0], ah4[qs], false); al4[qs] = __builtin_amdgcn_sdot8(tt[eb][qs][0], (int)dg[eb][1], al4[qs], false); \
                        ah4[qs] = __builtin_amdgcn_sdot8(tt[eb][qs][1], (int)dg[eb][2], ah4[qs], false); al4[qs] = __builtin_amdgcn_sdot8(tt[eb][qs][1], (int)dg[eb][3], al4[qs], false); } \
                asm volatile("" ::: "memory"); } while (0)
        float* PLf = (float*)(c.smem + NWAVE * MAXTOK * 128 * 6 + NWAVE * MAXTOK * 128 + NWAVE * 128);
        const int wg_t0 = c.bid * NWAVE * npw + b0, wg_t1 = wg_t0 + (NWAVE - 1) * npw + (npw - b0 > MAXTOK ? MAXTOK : npw - b0) - 1;
        const int mbA = mod_batch(wg_t0 < nrows ? wg_t0 : nrows - 1), mbB = mod_batch(wg_t1 < nrows ? wg_t1 : nrows - 1);
        lds_barrier();
        { const float* nbase = (const float*)(ws + WS_MOD) + (size_t)(L + 1 < DEPTH ? L + 1 : L) * 17 * 6144;
#pragma unroll
          for (int i = 0; i < 3; ++i) { const int item = i * NTHR + c.tid, r = item >> 8, col = (item & 255) * 4; const int mbr = r < 3 ? mbA : mbB, rr = r < 3 ? r : r - 3;
              const float* src = (rr == 0 ? MOD + (size_t)mbr * 6144 + 5 * 1024 : rr == 1 ? nbase + (size_t)mbr * 6144 : nbase + (size_t)mbr * 6144 + 1024) + col;
              f32x4 v = *(const f32x4*)src; if (rr == 2) v = v + 1.0f;
              *(f32x4*)(PLf + r * 1024 + col) = v; } }
        lds_barrier();
        {
            int lz = lane; asm volatile("" : "+v"(lz));
            f32x4 LG[4], LB[4];
#pragma unroll
            for (int cq = 0; cq < 4; ++cq) { LG[cq] = *(const f32x4*)(lg + 256 * cq + 4 * lz); LB[cq] = *(const f32x4*)(lb + 256 * cq + 4 * lz); }
            u32x2 pf[2][4];
#define C3_LOAD(slot_, k_) do { const int kc_ = (k_) < ntok ? (k_) : klast; const unsigned ro_ = (unsigned)((tok0 + tstr * kc_) < nrows ? (tok0 + tstr * kc_) : 0) * (unsigned)D + 4u * (unsigned)lz; \
                _Pragma("unroll") for (int cq = 0; cq < 4; ++cq) pf[slot_][cq] = *(const u32x2*)(XS + (ro_ + 256u * cq)); } while (0)
            if (ntok > 0) { C3_LOAD(0, 0); C3_LOAD(1, 1); V_ISSUE(rA, VT, 0, 0); }
            for (int k2 = 0; k2 < ntok; k2 += 2) {
#pragma unroll
              for (int sl = 0; sl < 2; ++sl) { const int k = k2 + sl;
                if (k < ntok) {
                const int row = tok0 + tstr * k; const float sa_ = SAL[k];
                float o[16];
#pragma unroll
                for (int c4 = 0; c4 < 4; ++c4) {
                    V_ISSUE(rB, VT + (size_t)c4 * NEXP * 128, k, 1);
                    int ah4[4] = {0, 0, 0, 0}, al4[4] = {0, 0, 0, 0};
                    V_ACC(rA, k, 0);
                    if (c4 < 3) V_ISSUE(rA, VT + (size_t)(c4 + 1) * NEXP * 128, k, 0); else V_ISSUE(rA, VT, ((k + 1 < ntok) ? k + 1 : k), 0);
                    V_ACC(rB, k, 1);
#pragma unroll
                    for (int qs = 0; qs < 4; ++qs) o[4 * c4 + qs] = (float)(ah4[qs] * 16 + al4[qs]);
                }
                float x1[16];
#pragma unroll
                for (int cq = 0; cq < 4; ++cq) { x1[4 * cq] = bf_lo(pf[sl][cq].x); x1[4 * cq + 1] = bf_hi(pf[sl][cq].x); x1[4 * cq + 2] = bf_lo(pf[sl][cq].y); x1[4 * cq + 3] = bf_hi(pf[sl][cq].y); }
                C3_LOAD(sl, k + 2);
                const float* pm = PLf + (mod_batch(row) == mbA ? 0 : 3) * 1024 + 4 * lz;
                const float isc = sa_ > 0.f ? 1.0f / sa_ : 1.0f, c1 = DN_ALPHA * isc;
                float y[16]; float s = 0.f, s2 = 0.f;
#pragma unroll
                for (int cq = 0; cq < 4; ++cq) { const f32x4 g2 = *(const f32x4*)(pm + 256 * cq);
#pragma unroll
                    for (int e = 0; e < 4; ++e) { y[4 * cq + e] = c1 * x1[4 * cq + e] + g2[e] * o[4 * cq + e]; s += y[4 * cq + e]; s2 += y[4 * cq + e] * y[4 * cq + e]; } }
                const float mean = wave_sum(s) * (1.0f / 1024.0f);
                const float var = fmaxf(wave_sum(s2) * (1.0f / 1024.0f) - mean * mean, 0.f);
                const float rstd = rsqrtf(var + LN_EPS * isc * isc);
                float x2[16];
#pragma unroll
                for (int cq = 0; cq < 4; ++cq)
#pragma unroll
                    for (int e = 0; e < 4; ++e) { const float a_ = rstd * LG[cq][e]; x2[4 * cq + e] = y[4 * cq + e] * a_ + (LB[cq][e] - mean * a_); }
                const unsigned xo = (unsigned)row * (unsigned)D + 4u * (unsigned)lz;
                if (L == DEPTH - 1) {
#pragma unroll
                    for (int cq = 0; cq < 4; ++cq) *(f32x4*)(p.out + (xo + 256u * cq)) = (f32x4){x2[4 * cq], x2[4 * cq + 1], x2[4 * cq + 2], x2[4 * cq + 3]};
                } else {
#pragma unroll
                    for (int cq = 0; cq < 4; ++cq) { const f32x4 shv = *(const f32x4*)(pm + 1024 + 256 * cq), s1v = *(const f32x4*)(pm + 2048 + 256 * cq);
                        const float hh0 = x2[4 * cq] * s1v[0] + shv[0], hh1 = x2[4 * cq + 1] * s1v[1] + shv[1], hh2 = x2[4 * cq + 2] * s1v[2] + shv[2], hh3 = x2[4 * cq + 3] * s1v[3] + shv[3];
                        *(u32x2*)(XS + (xo + 256u * cq)) = (u32x2){pk_bf16(x2[4 * cq], x2[4 * cq + 1]), pk_bf16(x2[4 * cq + 2], x2[4 * cq + 3])};
                        *(u32x2*)(H1 + (xo + 256u * cq)) = (u32x2){pk_bf16(hh0, hh1), pk_bf16(hh2, hh3)}; }
                }
                } }
            }
#undef C3_LOAD
        }
#undef V_ISSUE
#undef V_ACC
        }
        asm volatile("s_waitcnt vmcnt(0)" ::: "memory");
        __syncthreads();
    }
}

DI void phase_gl_proj(const Ctx& c, int j) {
    unsigned char* ws = c.ws; const int lane = c.lane, g = lane >> 4, cc = lane & 15;
    const bf16_t* H1 = (const bf16_t*)(ws + WS_H1); const bf16_t* WG = (const bf16_t*)(ws + WS_WBIN) + ((size_t)j * WBIN_N + 3072) * 1024; float* GL = (float*)(ws + WS_GL);
    constexpr int LDW = 1032;
    bf16_t* WL = (bf16_t*)c.smem;
    lds_barrier();
#pragma unroll
    for (int i = 0; i < 8; ++i) { const int idx = i * NTHR + c.tid, n = idx >> 7, k8 = (idx & 127) * 8; *(u32x4*)(WL + n * LDW + k8) = *(const u32x4*)(WG + (size_t)n * 1024 + k8); }
    lds_barrier();
    for (int mt = c.wave * c.G + c.bid; mt < T / 16; mt += c.G * NWAVE) {
        const bf16_t* ap = H1 + (size_t)(mt * 16 + cc) * 1024 + 8 * g;
        f32x4 acc0 = {0.f, 0.f, 0.f, 0.f}, acc1 = acc0;
#pragma unroll 1
        for (int kb = 0; kb < 2; ++kb) { bf16x8 af[16];
#pragma unroll
            for (int ks = 0; ks < 16; ++ks) af[ks] = *(const bf16x8*)(ap + 32 * (16 * kb + ks));
#pragma unroll
            for (int ks = 0; ks < 16; ++ks) { const int ko = 32 * (16 * kb + ks) + 8 * g; const bf16x8 b0 = *(const bf16x8*)(WL + cc * LDW + ko), b1 = *(const bf16x8*)(WL + (16 + cc) * LDW + ko);
                acc0 = mfma16(af[ks], b0, acc0); acc1 = mfma16(af[ks], b1, acc1); } }
#pragma unroll
        for (int r = 0; r < 4; ++r) { float* gp = GL + (size_t)(mt * 16 + 4 * g + r) * 32 + cc; gp[0] = acc0[r]; gp[16] = acc1[r]; }
    }
}

DI float logsig2_16(float z) { const float zl = z * 1.4426950408889634f; return (fminf(zl, 0.f) - __builtin_amdgcn_logf(1.0f + __builtin_amdgcn_exp2f(-fabsf(zl)))) * (1.0f / 16.0f); }
template <int DIR>
DI float gla_prep_gates(const bf16_t* Qt, const bf16_t* Kt, bf16_t* OUT, const float* gl, const float (&wg)[16], float bias, int cl, unsigned (&kpk)[32]) {
    constexpr int dir = DIR;
    { int z_ = 0; asm volatile("" : "+v"(z_)); gl += z_; }
    float cum = 0.f;
#pragma unroll
        for (int blk = 0; blk < 8; ++blk) {
            float gs[8];
            const int ib = dir ? 56 - 8 * blk : 8 * blk;
            unsigned short qraw[8], kraw[8];
#pragma unroll
            for (int e = 0; e < 8; ++e) { qraw[e] = Qt[(ib + e) * 256 + cl]; kraw[e] = Kt[(ib + e) * 256 + cl]; }
#pragma unroll
            for (int hb = 0; hb < 4; ++hb) { f32x4 gv[2][4];
#pragma unroll
                for (int e = 0; e < 2; ++e)
#pragma unroll
                    for (int r4 = 0; r4 < 4; ++r4) gv[e][r4] = ((const f32x4*)(gl + (ib + 2 * hb + e) * 32 + dir * 16))[r4];
                __builtin_amdgcn_sched_barrier(0);
#pragma unroll
                for (int e = 0; e < 2; ++e) { float z = bias;
#pragma unroll
                    for (int r4 = 0; r4 < 4; ++r4) z += gv[e][r4][0] * wg[4 * r4] + gv[e][r4][1] * wg[4 * r4 + 1] + gv[e][r4][2] * wg[4 * r4 + 2] + gv[e][r4][3] * wg[4 * r4 + 3];
                    gs[2 * hb + e] = logsig2_16(z); }
                __builtin_amdgcn_sched_barrier(0); }
            float kiv[8];
#pragma unroll
            for (int e = 0; e < 8; ++e) { const int pos = dir ? 7 - e : e, i = ib + pos;
                cum += gs[pos];
                const float qv = bf1(qraw[pos]), kv = bf1(kraw[pos]);
                OUT[(dir * 64 + i) * 256 + cl] = f2bf(qv * __builtin_amdgcn_exp2f(cum)); kiv[pos] = kv * __builtin_amdgcn_exp2f(-cum); }
            u32x4 w; w.x = pk_bf16(kiv[0], kiv[1]); w.y = pk_bf16(kiv[2], kiv[3]); w.z = pk_bf16(kiv[4], kiv[5]); w.w = pk_bf16(kiv[6], kiv[7]);
            if (dir) { kpk[4 * (7 - blk)] = w.x; kpk[4 * (7 - blk) + 1] = w.y; kpk[4 * (7 - blk) + 2] = w.z; kpk[4 * (7 - blk) + 3] = w.w; }
            else { kpk[4 * blk] = w.x; kpk[4 * blk + 1] = w.y; kpk[4 * blk + 2] = w.z; kpk[4 * blk + 3] = w.w; }
            __builtin_amdgcn_sched_barrier(0);
        }
    return cum;
}
DI void phase_gla_prep(const Ctx& c, int j) {
    const Params& p = *c.p; unsigned char* ws = c.ws; const int tid = c.tid;
    const bf16_t* QG = (const bf16_t*)(ws + WS_R1); const bf16_t* KG = (const bf16_t*)(ws + WS_R1 + SZ_T512);
    const float* GL = (const float*)(ws + WS_GL); float* DEC = (float*)(ws + WS_DEC);
    bf16_t* Qt = (bf16_t*)c.smem;
    bf16_t* Kt = Qt + 64 * 256;
    bf16_t* OUT = Kt + 64 * 256;
    float* gl = (float*)(c.smem + 131072);
    const int dir = __builtin_amdgcn_readfirstlane(tid >> 8), cl = tid & 255;
    u32x4 pq[4], pk[4]; f32x4 pgl; float pwg[16]; float pbias;
#define PREP_LOAD(u_) do { const int ch_ = (u_) >> 1, hc_ = (u_) & 1, r0_ = ch_ * 64, cg_ = 256 * hc_ + cl; \
        _Pragma("unroll") for (int it = 0; it < 4; ++it) { const int idx = it * 512 + tid, row = idx >> 5, c8 = (idx & 31) * 8; \
            pq[it] = *(const u32x4*)(QG + (size_t)(r0_ + row) * 512 + 256 * hc_ + c8); pk[it] = *(const u32x4*)(KG + (size_t)(r0_ + row) * 512 + 256 * hc_ + c8); } \
        pgl = ((const f32x4*)(GL + (size_t)r0_ * 32))[tid]; \
        _Pragma("unroll") for (int r = 0; r < 16; ++r) pwg[r] = p.in[15][((size_t)(j * 2 + dir) * 16 + r) * 512 + cg_]; \
        pbias = p.in[16][(size_t)(j * 2 + dir) * 512 + cg_]; } while (0)
    if (c.bid < (T / 64) * 2) PREP_LOAD(c.bid);
    for (int u = c.bid; u < (T / 64) * 2; u += c.G) {
        const int ch = u >> 1, hc = u & 1, r0 = ch * 64, cg = 256 * hc + cl;
        lds_barrier();
#pragma unroll
        for (int it = 0; it < 4; ++it) { const int idx = it * 512 + tid, row = idx >> 5, c8 = (idx & 31) * 8;
            *(u32x4*)(Qt + row * 256 + c8) = pq[it]; *(u32x4*)(Kt + row * 256 + c8) = pk[it]; }
        ((f32x4*)gl)[tid] = pgl;
        float wg[16];
#pragma unroll
        for (int r = 0; r < 16; ++r) wg[r] = pwg[r];
        const float bias = pbias;
        lds_barrier();
        unsigned kpk[32];
        const float cum = dir ? gla_prep_gates<1>(Qt, Kt, OUT, gl, wg, bias, cl, kpk) : gla_prep_gates<0>(Qt, Kt, OUT, gl, wg, bias, cl, kpk);
        DEC[((size_t)dir * (T / 64) + ch) * 512 + cg] = __builtin_amdgcn_exp2f(cum);
        { const int un = (u + c.G < (T / 64) * 2) ? u + c.G : u; PREP_LOAD(un); }
        lds_barrier();
#pragma unroll 2
        for (int it = 0; it < 8; ++it) { const int idx = it * 512 + tid, d2 = idx >> 11, row = (idx >> 5) & 63, c8 = (idx & 31) * 8;
            *(u32x4*)((bf16_t*)(ws + WS_R2) + (size_t)d2 * T * 512 + (size_t)(r0 + row) * 512 + 256 * hc + c8) = *(const u32x4*)(OUT + (d2 * 64 + row) * 256 + c8); }
        lds_barrier();
#pragma unroll
        for (int i2 = 0; i2 < 32; ++i2) { OUT[(dir * 64 + 2 * i2) * 256 + cl] = (bf16_t)(kpk[i2] & 0xffffu); OUT[(dir * 64 + 2 * i2 + 1) * 256 + cl] = (bf16_t)(kpk[i2] >> 16); }
        lds_barrier();
#pragma unroll 2
        for (int it = 0; it < 8; ++it) { const int idx = it * 512 + tid, d2 = idx >> 11, row = (idx >> 5) & 63, c8 = (idx & 31) * 8;
            *(u32x4*)((bf16_t*)(ws + WS_R2 + SZ_T1K) + (size_t)d2 * T * 512 + (size_t)(r0 + row) * 512 + 256 * hc + c8) = *(const u32x4*)(OUT + (d2 * 64 + row) * 256 + c8); }
    }
#undef PREP_LOAD
}

DI void phase_gla_scan(const Ctx& c) {
    unsigned char* ws = c.ws; const int tid = c.tid, lane = c.lane, w = c.wave, g = lane >> 4, cc = lane & 15;
    const bf16_t* VG = (const bf16_t*)(ws + WS_R1 + 2 * SZ_T512); const float* DEC = (const float*)(ws + WS_DEC);
#define SW128(row_, col_) ((row_) * 128 + (((((col_) >> 3) ^ ((row_) & 15))) << 3) + ((col_) & 7))
#define SW64(row_, col_) ((row_) * 64 + (((((col_) >> 3) ^ (((row_) >> 1) & 7))) << 3) + ((col_) & 7))
#define FR128(X_, row0_, ks_) (*(const bf16x8*)((X_) + (row0_) * 128 + o128[ks_]))
#define FR64(X_, row0_, ks_) (*(const bf16x8*)((X_) + (row0_) * 64 + o64[ks_]))
    bf16_t* Qs = (bf16_t*)c.smem;
    bf16_t* Ks = Qs + 64 * 128;
    bf16_t* Vs = Ks + 64 * 128;
    bf16_t* At = Vs + 2 * 64 * 128;
    bf16_t* St = At + 8 * 16 * 64;
    bf16_t* Ot = St + 128 * 128;
    float* dec = (float*)(Ot + 64 * 128);
    int o128[4], o64[2], oKb[4];
#pragma unroll
    for (int ks = 0; ks < 4; ++ks) oKb[ks] = cc * 128 + (((4 * ks + g) ^ (((cc & 3) << 2) | ((cc >> 2) & 3))) << 3);
    int tro[2], trx[2];
#pragma unroll
    for (int t = 0; t < 2; ++t) { const int q = cc >> 2, p = cc & 3; tro[t] = 256 * (8 * g + 4 * t + q) + 8 * (p & 1); trx[t] = (p >> 1) ^ ((q << 2) | ((2 * g + t) & 3)); }
#define TRFRAG(X_, c_, ks_) ({ const LAS unsigned char* xb_ = (const LAS unsigned char*)(X_) + (ks_) * 8192; \
        const v4i16 t0_ = __builtin_amdgcn_ds_read_tr16_b64_v4i16((LAS v4i16*)(xb_ + tro[0] + (((2 * (c_)) ^ trx[0]) << 4))); \
        const v4i16 t1_ = __builtin_amdgcn_ds_read_tr16_b64_v4i16((LAS v4i16*)(xb_ + tro[1] + (((2 * (c_)) ^ trx[1]) << 4))); \
        __builtin_shufflevector(t0_, t1_, 0, 1, 2, 3, 4, 5, 6, 7); })
#pragma unroll
    for (int ks = 0; ks < 4; ++ks) o128[ks] = cc * 128 + (((4 * ks + g) ^ cc) << 3);
#pragma unroll
    for (int ks = 0; ks < 2; ++ks) o64[ks] = cc * 64 + (((4 * ks + g) ^ ((cc >> 1) & 7)) << 3);
    const int qtok0 = tid >> 4, qd8 = (tid & 15) * 8;
    const int wofb = qtok0 * 128 + ((((tid & 15) ^ (((qtok0 & 3) << 2) | ((qtok0 >> 2) & 3)))) << 3);
    for (int u = c.bid; u < NB * 4 * 2 * 2; u += c.G) {
        const int b = u >> 4, h = (u >> 2) & 3, es = (u >> 1) & 1, dir = u & 1;
        bf16_t* O = (bf16_t*)(ws + (dir ? WS_OB : WS_H1));
        const bf16_t* QIN = (const bf16_t*)(ws + WS_R2) + (size_t)dir * T * 512; const bf16_t* KIN = (const bf16_t*)(ws + WS_R2 + SZ_T1K) + (size_t)dir * T * 512;
        f32x4 accS[8];
#pragma unroll
        for (int et = 0; et < 8; ++et) accS[et] = (f32x4){0.f, 0.f, 0.f, 0.f};
        lds_barrier();
        for (int i = tid; i < 128 * 128 / 2; i += NTHR) ((unsigned*)St)[i] = 0u;
        u32x4 pq[2], pk[2], pv[2]; float pdec = 0.f;
#define GLA_R0(cs_) (dir == 0 ? ((cs_) < 4 ? TL + b * CTXL + 64 * (cs_) : b * SEQ + 64 * ((cs_) - 4)) : ((cs_) < 4 ? TL + b * CTXL + 64 * (3 - (cs_)) : b * SEQ + 64 * (35 - (cs_))))
#define GLA_LOAD(cs_) do { const int r0_ = GLA_R0(cs_); const int chunk_ = r0_ >> 6; \
            _Pragma("unroll") for (int it = 0; it < 2; ++it) { const size_t go = (size_t)(r0_ + qtok0 + 32 * it) * 512 + h * 128 + qd8; pq[it] = *(const u32x4*)(QIN + go); pk[it] = *(const u32x4*)(KIN + go); \
                pv[it] = *(const u32x4*)(VG + (size_t)(r0_ + qtok0 + 32 * it) * 1024 + h * 256 + es * 128 + qd8); } \
            if (tid < 128) pdec = DEC[((size_t)dir * (T / 64) + chunk_) * 512 + h * 128 + tid]; } while (0)
        GLA_LOAD(0);
        for (int cs = 0; cs < 36; ++cs) {
            const int r0 = GLA_R0(cs);
#pragma unroll
            for (int it = 0; it < 2; ++it) { *(u32x4*)(Qs + SW128(qtok0 + 32 * it, qd8)) = pq[it]; *(u32x4*)(Ks + wofb + 32 * 128 * it) = pk[it]; *(u32x4*)(Vs + wofb + 32 * 128 * it) = pv[it]; }
            if (tid < 128) dec[tid] = pdec;
            lds_barrier();
            GLA_LOAD(cs + 1 < 36 ? cs + 1 : cs);
            { const int it = w >> 1; bf16_t* Aw = At + w * 16 * 64;
              bf16x8 qf[4], kf[4][4];
#pragma unroll
              for (int ks = 0; ks < 4; ++ks) qf[ks] = FR128(Qs, 16 * it, ks);
#pragma unroll
              for (int jt = 0; jt < 4; ++jt)
#pragma unroll
                  for (int ks = 0; ks < 4; ++ks) kf[jt][ks] = *(const bf16x8*)(Ks + (16 * jt) * 128 + oKb[ks]);
              __builtin_amdgcn_sched_barrier(0);
#pragma unroll
              for (int jt = 0; jt < 4; ++jt) { f32x4 a = {0.f, 0.f, 0.f, 0.f};
#pragma unroll
                  for (int ks = 0; ks < 4; ++ks) a = mfma16(kf[jt][ks], qf[ks], a);
                  const int i = 16 * it + cc, j0 = 16 * jt + 4 * g; float m[4];
#pragma unroll
                  for (int r = 0; r < 4; ++r) { const bool keep = dir ? (j0 + r >= i) : (j0 + r <= i); m[r] = keep ? a[r] : 0.f; }
                  u32x2 pw; pw.x = pk_bf16(m[0], m[1]); pw.y = pk_bf16(m[2], m[3]);
                  *(u32x2*)(Aw + SW64(cc, j0)) = pw; }
              bf16x8 af[2];
#pragma unroll
              for (int ks = 0; ks < 2; ++ks) af[ks] = FR64(Aw, 0, ks);
#pragma unroll
              for (int eh = 0; eh < 2; ++eh) {
                  bf16x8 vf[2][2], sf[2][4];
#pragma unroll
                  for (int e2 = 0; e2 < 2; ++e2) { const int et = 4 * (w & 1) + 2 * eh + e2;
#pragma unroll
                      for (int ks = 0; ks < 2; ++ks) vf[e2][ks] = TRFRAG(Vs, et, ks);
#pragma unroll
                      for (int ks = 0; ks < 4; ++ks) sf[e2][ks] = FR128(St, 16 * et, ks); }
                  __builtin_amdgcn_sched_barrier(0);
#pragma unroll
                  for (int e2 = 0; e2 < 2; ++e2) { const int et = 4 * (w & 1) + 2 * eh + e2; f32x4 a = {0.f, 0.f, 0.f, 0.f};
#pragma unroll
                      for (int ks = 0; ks < 4; ++ks) a = mfma16(sf[e2][ks], qf[ks], a);
#pragma unroll
                      for (int ks = 0; ks < 2; ++ks) a = mfma16(vf[e2][ks], af[ks], a);
                      u32x2 pw; pw.x = pk_bf16(a[0], a[1]); pw.y = pk_bf16(a[2], a[3]);
                      *(u32x2*)(Ot + SW128(16 * it + cc, 16 * et + 4 * g)) = pw; }
                  __builtin_amdgcn_sched_barrier(0);
              } }
            { bf16x8 kef[2]; float dv[4];
#pragma unroll
              for (int ks = 0; ks < 2; ++ks) kef[ks] = TRFRAG(Ks, w, ks);
#pragma unroll
              for (int r = 0; r < 4; ++r) dv[r] = dec[16 * w + 4 * g + r];
#pragma unroll
              for (int eh = 0; eh < 2; ++eh) {
                  bf16x8 vf2[4][2];
#pragma unroll
                  for (int e4 = 0; e4 < 4; ++e4)
#pragma unroll
                      for (int ks = 0; ks < 2; ++ks) vf2[e4][ks] = TRFRAG(Vs, 4 * eh + e4, ks);
                  __builtin_amdgcn_sched_barrier(0);
#pragma unroll
                  for (int e4 = 0; e4 < 4; ++e4) { const int et = 4 * eh + e4;
#pragma unroll
                      for (int ks = 0; ks < 2; ++ks) accS[et] = mfma16(kef[ks], vf2[e4][ks], accS[et]);
#pragma unroll
                      for (int r = 0; r < 4; ++r) accS[et][r] *= dv[r]; }
                  __builtin_amdgcn_sched_barrier(0);
              } }
            lds_barrier();
#pragma unroll
            for (int et = 0; et < 8; ++et) { u32x2 sv; sv.x = pk_bf16(accS[et][0], accS[et][1]); sv.y = pk_bf16(accS[et][2], accS[et][3]);
                *(u32x2*)(St + SW128(16 * et + cc, 16 * w + 4 * g)) = sv; }
#pragma unroll
            for (int it = 0; it < 2; ++it) *(u32x4*)(O + (size_t)(r0 + qtok0 + 32 * it) * 1024 + h * 256 + es * 128 + qd8) = *(const u32x4*)(Ot + SW128(qtok0 + 32 * it, qd8));
        }
#undef GLA_LOAD
#undef GLA_R0
#undef SW128
#undef SW64
#undef FR128
#undef FR64
#undef TRFRAG
    }
}

DI float row16_sum(float v) { v += dpp_mov<0x128>(v); v += dpp_mov<0x124>(v); v += dpp_mov<0x122>(v); v += dpp_mov<0x121>(v); return v; }
DI void phase_gla_readout(const Ctx& c, int j) {
    const Params& p = *c.p; unsigned char* ws = c.ws;
    const bf16_t* O = (const bf16_t*)(ws + WS_H1); const bf16_t* OB = (const bf16_t*)(ws + WS_OB); const bf16_t* RG = (const bf16_t*)(ws + WS_R1 + 2 * SZ_T512 + SZ_T1K); bf16_t* Y = (bf16_t*)(ws + WS_R2);
    const int stride = c.G * NWAVE, r0 = c.bid * NWAVE + c.wave, nr = (T - r0 + stride - 1) / stride;
    int lz = c.lane; asm volatile("" : "+v"(lz));
    f32x4 GN[4];
#pragma unroll
    for (int qd = 0; qd < 4; ++qd) GN[qd] = *(const f32x4*)(p.in[17] + (size_t)j * 1024 + 16 * lz + 4 * qd);
    constexpr int PFD = 3;
    u32x4 pf[PFD][6];
#define RO_LOAD(slot_, k_) do { const int kc_ = (k_) < nr ? (k_) : nr - 1; const size_t o_ = (size_t)(r0 + stride * kc_) * D + 16 * lz; \
        pf[slot_][0] = *(const u32x4*)(O + o_); pf[slot_][1] = *(const u32x4*)(O + o_ + 8); pf[slot_][2] = *(const u32x4*)(OB + o_); pf[slot_][3] = *(const u32x4*)(OB + o_ + 8); \
        pf[slot_][4] = *(const u32x4*)(RG + o_); pf[slot_][5] = *(const u32x4*)(RG + o_ + 8); } while (0)
    if (nr > 0) {
#pragma unroll
        for (int i = 0; i < PFD; ++i) RO_LOAD(i, i);
    }
    for (int k3 = 0; k3 < nr; k3 += PFD) {
#pragma unroll
        for (int sl = 0; sl < PFD; ++sl) { const int k = k3 + sl;
            if (k < nr) { const int row = r0 + stride * k;
            u32x4 ov[2], ow[2], rv[2];
#pragma unroll
            for (int hf = 0; hf < 2; ++hf) { ov[hf] = pf[sl][hf]; ow[hf] = pf[sl][2 + hf]; rv[hf] = pf[sl][4 + hf]; }
            RO_LOAD(sl, k + PFD);
            float x[16], r[16]; float s = 0.f;
#pragma unroll
            for (int hf = 0; hf < 2; ++hf)
#pragma unroll
                for (int q = 0; q < 4; ++q) { x[8 * hf + 2 * q] = bf_lo(ov[hf][q]) + bf_lo(ow[hf][q]); x[8 * hf + 2 * q + 1] = bf_hi(ov[hf][q]) + bf_hi(ow[hf][q]);
                    r[8 * hf + 2 * q] = bf_lo(rv[hf][q]); r[8 * hf + 2 * q + 1] = bf_hi(rv[hf][q]); }
#pragma unroll
            for (int e = 0; e < 16; ++e) s += x[e];
            const float mean = row16_sum(s) * (1.0f / 256.0f);
            float q2 = 0.f;
#pragma unroll
            for (int e = 0; e < 16; ++e) { x[e] -= mean; q2 += x[e] * x[e]; }
            const float rstd = rsqrtf(row16_sum(q2) * (1.0f / 256.0f) + LN_EPS);
            float y[16];
#pragma unroll
            for (int qd = 0; qd < 4; ++qd)
#pragma unroll
                for (int e = 0; e < 4; ++e) y[4 * qd + e] = x[4 * qd + e] * rstd * GN[qd][e] * silu_f(r[4 * qd + e]);
#pragma unroll
            for (int hf = 0; hf < 2; ++hf) { u32x4 w;
#pragma unroll
                for (int q = 0; q < 4; ++q) w[q] = pk_bf16(y[8 * hf + 2 * q], y[8 * hf + 2 * q + 1]);
                *(u32x4*)(Y + (size_t)row * D + 16 * lz + 8 * hf) = w; }
            } }
    }
#undef RO_LOAD
}

constexpr int N_PHASES = 2 + 2 * 8 + 2 * 9;

__global__ void __launch_bounds__(NTHR, 2) mega_fwd(Params p) {
    extern __shared__ __attribute__((aligned(16))) unsigned char smem[];
    cg::grid_group grid = cg::this_grid();
    Ctx c; c.p = &p; c.ws = p.ws; c.smem = smem; c.tid = threadIdx.x; c.lane = c.tid & 63; c.wave = __builtin_amdgcn_readfirstlane(c.tid >> 6); c.G = gridDim.x; c.bid = blockIdx.x;
    unsigned char* ws = p.ws;
    volatile LAS unsigned* xst = (volatile LAS unsigned*)((LAS unsigned char*)smem + (LDS_BYTES - 16));
    if (threadIdx.x == 0) { xst[0] = 0u; xst[1] = 0u; }
    __syncthreads();
    const XcdBarrier xbar = xcd_barrier_post((unsigned*)(ws + WS_CTL), xst);
    const int lo = p.ph_lo, hi = p.ph_hi;
    int ph = 0;
    const int wave0 = __builtin_amdgcn_readfirstlane((int)threadIdx.x >> 6);
#ifndef PH_ONLY
#define PH_ONLY -1
#endif
#ifndef DUP_MASK
#define DUP_MASK 0
#endif
#define RUN1(...) { { unsigned on_ = ~0u; asm volatile("" : "+s"(on_)); int t_ = wave0 * 64 + (int)__builtin_amdgcn_mbcnt_hi(on_, __builtin_amdgcn_mbcnt_lo(on_, 0u)); asm volatile("" : "+v"(t_));     \
        c.tid = t_; c.lane = t_ & 63; c.wave = __builtin_amdgcn_readfirstlane(t_ >> 6); { size_t z_ = 0; asm volatile("" : "+s"(z_)); ws = p.ws + z_; } c.ws = ws; } __VA_ARGS__; }
#define RUN(id, ...) do { if ((PH_ONLY < 0 || PH_ONLY == (id)) && ph >= lo && ph < hi) { \
        RUN1(__VA_ARGS__) \
        if ((DUP_MASK >> (id)) & 1) { xcd_barrier(xbar); RUN1(__VA_ARGS__) } \
        if (ph + 1 < hi) { if (hi < 0) grid.sync(); else xcd_barrier(xbar); } } ++ph; } while (0)
    LAS unsigned char* lds = (LAS unsigned char*)smem;
    const float* MOD = (const float*)(ws + WS_MOD);

    RUN(0, phase_prologue(c));
    RUN(1, phase_mod0(c));
    for (int L = 0; L < DEPTH; ++L) {
        const int j = L >> 1;
        if ((L & 1) == 0) {
            RUN(2, { pg8::Gemm g{(const bf16_t*)(ws + WS_H1), (const bf16_t*)(ws + WS_WAIN) + (size_t)j * 2048 * 1024, T, 2048, 1024}; pg8::StaticOrder S; S.init(T, 2048, c.G, c.bid);
                  pg8::EpiBf16<1> E{(bf16_t*)(ws + WS_R1), 2048}; pg8::gemm_phase(lds, g, S, E, c.tid);
                  quant_in_gemm_tail(c, S.nwg, L == 0 ? 0 : 1, L); });
            RUN(3, phase_vstats(c));
            RUN(4, phase_spatial(c, j));
        } else {
            RUN(5, { pg8::Gemm g{(const bf16_t*)(ws + WS_H1), (const bf16_t*)(ws + WS_WBIN) + (size_t)j * WBIN_N * 1024, T, 3072, 1024}; pg8::StaticOrder S; S.init(T, 3072, c.G, c.bid);
                  pg8::EpiGlaProj E{(bf16_t*)(ws + WS_R1), (bf16_t*)(ws + WS_R1 + SZ_T512), (bf16_t*)(ws + WS_R1 + 2 * SZ_T512), (bf16_t*)(ws + WS_R1 + 2 * SZ_T512 + SZ_T1K), (float*)(ws + WS_GL)};
                  pg8::gemm_phase(lds, g, S, E, c.tid); phase_gl_proj(c, j); });
            RUN(6, phase_gla_prep(c, j));
            RUN(7, phase_gla_scan(c));
            RUN(8, phase_gla_readout(c, j));
        }
        const int Mrows = (L == DEPTH - 1) ? TL : T;
        RUN(9, { const bf16_t* W = (L & 1) ? (const bf16_t*)(ws + WS_WBOUT) + (size_t)j * 1024 * 1024 : (const bf16_t*)(ws + WS_WAOUT) + (size_t)j * 1024 * 1024;
              pg8::Gemm g{(const bf16_t*)(ws + WS_R2), W, Mrows, 1024, 1024}; pg8::StaticOrder S; S.init(Mrows, 1024, c.G, c.bid);
              pg8::EpiRes E{p.in[0], p.in[2], (bf16_t*)(ws + WS_XS), MOD + (size_t)L * 17 * 6144, 2, L == 0 ? 1 : 0};
              pg8::gemm_phase(lds, g, S, E, c.tid); if (L == 0) quant_in_gemm_tail(c, S.nwg, 1, 0); else if (L == 1) quant_in_gemm_tail(c, S.nwg, 1, 1); else if (L == 2) quant_in_gemm_tail(c, S.nwg, 0, 3); });
        RUN(10, phase_ln1(c, L));
        RUN(11, { pg8::Gemm g{(const bf16_t*)(ws + WS_R2 + SZ_T1K), (const bf16_t*)(ws + WS_WQ) + (size_t)L * 1024 * 1024, Mrows, 1024, 1024}; pg8::StaticOrder S; S.init(Mrows, 1024, c.G, c.bid);
              pg8::EpiBf16<0> E{(bf16_t*)(ws + WS_R1), 1024}; pg8::gemm_phase(lds, g, S, E, c.tid); if (L == 0) quant_in_gemm_tail(c, S.nwg, 0, 1); else if (L == 1) quant_in_gemm_tail(c, S.nwg, 0, 2); else if (L == 2) quant_in_gemm_tail(c, S.nwg, 1, 3); });
        RUN(12, phase_route(c, L));
        RUN(13, phase_experts(c, L));
    }
#undef RUN
}

extern "C" void kernel_launch(void* const* d_in, const int* in_sizes, int n_in, void* d_out, int out_size, void* d_ws, size_t ws_size, hipStream_t stream) {
    static int grid = 0;
    if (grid == 0) {
        if (n_in != 23 || out_size != TL * D || ws_size < WS_END) { fprintf(stderr, "kernel_launch: unexpected shapes: n_in %d out %d ws %zu (need %zu)\n", n_in, out_size, ws_size, (size_t)WS_END); grid = -1; return; }
        int dev = 0, cus = 0, per_cu = 0;
        if (hipGetDevice(&dev) != hipSuccess || hipDeviceGetAttribute(&cus, hipDeviceAttributeMultiprocessorCount, dev) != hipSuccess) { fprintf(stderr, "kernel_launch: device query failed\n"); grid = -1; return; }
        if (hipFuncSetAttribute((const void*)mega_fwd, hipFuncAttributeMaxDynamicSharedMemorySize, LDS_BYTES) != hipSuccess) { fprintf(stderr, "kernel_launch: hipFuncSetAttribute failed\n"); grid = -1; return; }
        if (hipOccupancyMaxActiveBlocksPerMultiprocessor(&per_cu, (const void*)mega_fwd, NTHR, LDS_BYTES) != hipSuccess || per_cu < 1) { fprintf(stderr, "kernel_launch: occupancy query says %d blocks per CU\n", per_cu); grid = -1; return; }
        grid = cus;
    }
    if (grid < 0) return;
    (void)hipMemsetAsync((char*)d_ws + WS_CTL, 0, 65536, stream);
    Params p{};
    for (int i = 0; i < 23; ++i) p.in[i] = (const float*)d_in[i];
    p.out = (float*)d_out; p.ws = (unsigned char*)d_ws; p.ph_lo = 0; p.ph_hi = N_PHASES;
    void* args[] = {&p};
    const hipError_t e = hipLaunchCooperativeKernel((const void*)mega_fwd, dim3(grid), dim3(NTHR), args, LDS_BYTES, stream);
    if (e != hipSuccess) fprintf(stderr, "kernel_launch: cooperative launch failed: %s (grid %d)\n", hipGetErrorString(e), grid);
}
```
